# Optimizing an MI355X kernel written in HIP

```python
import math
import jax, jax.numpy as jnp
from jax import lax
import numpy as np

D_MODEL = 1024
BATCH = 4
SEQ = 4096
DEPTH = 2

GRID_W = 64
CTX_LEN = 256
N_GROUPS = 4
BRANCH_W = D_MODEL // N_GROUPS
D_MIX = N_GROUPS * BRANCH_W
HEAD_DIM = 64
EPS = 1e-6
ROPE_BASE = 10000.0
GLA_HEADS = BRANCH_W // HEAD_DIM
GLA_DV = HEAD_DIM
GLA_DK = HEAD_DIM // 2
GLA_RANK = 16
GLA_TAU = 16.0
GLA_CHUNK = 64
FNET_GROUPS = 4
FNET_GW = BRANCH_W // FNET_GROUPS
SWA_HEADS = BRANCH_W // HEAD_DIM
SWA_KV_HEADS = 2
SWA_GROUP = SWA_HEADS // SWA_KV_HEADS
SWA_WINDOW = 128
SWA_BLOCK = 128
NA_HEADS = BRANCH_W // HEAD_DIM
NA_KH_MAX = 8
NA_KW = 16

PROJ_SPLITS = (
    ("a_q", GLA_HEADS * GLA_DK), ("a_k", GLA_HEADS * GLA_DK), ("a_v", GLA_HEADS * GLA_DV),
    ("a_g", BRANCH_W), ("a_lr", 2 * GLA_RANK),
    ("b_v", BRANCH_W), ("b_g", BRANCH_W),
    ("c_q", SWA_HEADS * HEAD_DIM), ("c_k", SWA_KV_HEADS * HEAD_DIM), ("c_v", SWA_KV_HEADS * HEAD_DIM),
    ("c_g", BRANCH_W),
    ("d_q", BRANCH_W), ("d_k", BRANCH_W), ("d_v", BRANCH_W), ("d_g", BRANCH_W),
)
PROJ_WIDTH = (4 * GLA_HEADS * GLA_DK + 2 * GLA_RANK + 2 * BRANCH_W
              + 2 * BRANCH_W
              + 2 * BRANCH_W + 2 * SWA_KV_HEADS * HEAD_DIM
              + 4 * BRANCH_W)

kernel_name = "hybrid_parallel_group_flow_trunk"


def rms_norm(x, w):
    xf = x.astype(jnp.float32)
    y = xf * lax.rsqrt(jnp.mean(xf * xf, axis=-1, keepdims=True) + EPS)
    return (y * w).astype(x.dtype)


def split_proj(p):
    out, off = {}, 0
    for name, w in PROJ_SPLITS:
        out[name] = p[..., off:off + w]
        off += w
    return out


def to_heads(t, n_heads):
    b_, L, w = t.shape
    return t.reshape(b_, L, n_heads, w // n_heads).transpose(0, 2, 1, 3)


def from_heads(t):
    b_, h, L, d = t.shape
    return t.transpose(0, 2, 1, 3).reshape(b_, L, h * d)


def axial_rope_tables(n):
    t = jnp.arange(n)
    row = (t // GRID_W).astype(jnp.float32)
    col = (t % GRID_W).astype(jnp.float32)
    axis_dim = HEAD_DIM // 2
    inv = ROPE_BASE ** (-jnp.arange(0, axis_dim, 2, dtype=jnp.float32) / axis_dim)
    ang = jnp.stack([row[:, None] * inv, col[:, None] * inv], axis=1)
    return jnp.cos(ang), jnp.sin(ang)


def apply_rope(x, cos, sin):
    shp = x.shape
    xr = x.astype(jnp.float32).reshape(shp[:-1] + (2, 2, HEAD_DIM // 4))
    x1, x2 = xr[..., 0, :], xr[..., 1, :]
    o1 = x1 * cos - x2 * sin
    o2 = x2 * cos + x1 * sin
    return jnp.stack([o1, o2], axis=-2).reshape(shp).astype(x.dtype)


def gla_chunk_scan(q, k, v, log_a, s0):
    b_, h_, L, _ = q.shape
    nc = L // GLA_CHUNK

    def to_chunks(t):
        t = t.astype(jnp.float32).reshape(b_, h_, nc, GLA_CHUNK, t.shape[-1])
        return jnp.moveaxis(t, 2, 0)

    causal = jnp.tril(jnp.ones((GLA_CHUNK, GLA_CHUNK), bool))

    def step(s, inp):
        qc, kc, vc, ac = inp
        cum = jnp.cumsum(ac, axis=2)
        inter = jnp.einsum('bhtd,bhde->bhte', qc * jnp.exp(cum), s)
        diff = cum[:, :, :, None, :] - cum[:, :, None, :, :]
        decay = jnp.exp(jnp.where(causal[:, :, None], diff, -jnp.inf))
        scores = jnp.einsum('bhtd,bhsd,bhtsd->bhts', qc, kc, decay)
        intra = jnp.einsum('bhts,bhse->bhte', scores, vc)
        last = cum[:, :, -1:, :]
        s_new = (jnp.exp(last[:, :, 0, :])[..., None] * s
                 + jnp.einsum('bhsd,bhse->bhde', kc * jnp.exp(last - cum), vc))
        return s_new, inter + intra

    s_fin, out = lax.scan(step, s0, (to_chunks(q), to_chunks(k), to_chunks(v), to_chunks(log_a)))
    out = jnp.moveaxis(out, 0, 2).reshape(b_, h_, L, v.shape[-1])
    return out, s_fin


def gla_mixer(pl, pc, dec_w, dec_b, out_norm, need_ctx):
    def prep(p):
        q = to_heads(p['a_q'], GLA_HEADS) * (GLA_DK ** -0.5)
        k = to_heads(p['a_k'], GLA_HEADS)
        v = to_heads(p['a_v'], GLA_HEADS)
        lr = p['a_lr']
        log_a = [to_heads(jax.nn.log_sigmoid(
            (lr[..., d * GLA_RANK:(d + 1) * GLA_RANK] @ dec_w[d] + dec_b[d]).astype(jnp.float32)) / GLA_TAU,
            GLA_HEADS) for d in range(2)]
        return q, k, v, log_a

    ql, kl, vl, al = prep(pl)
    qc, kc, vc, ac = prep(pc)
    b_ = ql.shape[0]
    s0 = jnp.zeros((b_, GLA_HEADS, GLA_DK, GLA_DV), jnp.float32)
    out_l = jnp.zeros(vl.shape, jnp.float32)
    out_c = jnp.zeros(vc.shape, jnp.float32)
    for d in range(2):
        flip = (lambda t: t) if d == 0 else (lambda t: jnp.flip(t, axis=2))
        o_c, s_c = gla_chunk_scan(flip(qc), flip(kc), flip(vc), flip(ac[d]), s0)
        o_l, _ = gla_chunk_scan(flip(ql), flip(kl), flip(vl), flip(al[d]), s_c)
        out_l = out_l + flip(o_l)
        if need_ctx:
            out_c = out_c + flip(o_c)
    y_l = from_heads(rms_norm(out_l, out_norm)).astype(pl['a_v'].dtype)
    y_c = from_heads(rms_norm(out_c, out_norm)).astype(pc['a_v'].dtype) if need_ctx else None
    return y_l, y_c


def fourier_mix(v, w_f):
    b_, L, _ = v.shape
    vg = v.astype(jnp.float32).reshape(b_, L, FNET_GROUPS, FNET_GW)
    f = jnp.fft.fft2(vg, axes=(1, 3), norm='ortho').real
    return (f.reshape(b_, L, BRANCH_W) @ w_f).astype(v.dtype)


def swa_mixer(pl, pc, q_norm, k_norm, sink, cos, sin, need_ctx):
    b_, n, _ = pl['c_q'].shape
    scale = HEAD_DIM ** -0.5
    nb = n // SWA_BLOCK
    q = apply_rope(rms_norm(to_heads(pl['c_q'], SWA_HEADS), q_norm), cos, sin)
    k = apply_rope(rms_norm(to_heads(pl['c_k'], SWA_KV_HEADS), k_norm), cos, sin)
    v = to_heads(pl['c_v'], SWA_KV_HEADS)
    qcx = rms_norm(to_heads(pc['c_q'], SWA_HEADS), q_norm)
    kcx = rms_norm(to_heads(pc['c_k'], SWA_KV_HEADS), k_norm)
    vcx = to_heads(pc['c_v'], SWA_KV_HEADS)

    def band(t):
        tp = jnp.pad(t, ((0, 0), (0, 0), (SWA_BLOCK, SWA_BLOCK), (0, 0)))
        tb = tp.reshape(b_, SWA_KV_HEADS, nb + 2, SWA_BLOCK, HEAD_DIM)
        return jnp.concatenate([tb[:, :, :-2], tb[:, :, 1:-1], tb[:, :, 2:]], axis=3)

    k_win, v_win = band(k), band(v)
    qb = q.reshape(b_, SWA_KV_HEADS, SWA_GROUP, nb, SWA_BLOCK, HEAD_DIM)
    s_loc = jnp.einsum('bkgnqd,bknjd->bkgnqj', qb, k_win).astype(jnp.float32) * scale
    qpos = jnp.arange(nb)[:, None] * SWA_BLOCK + jnp.arange(SWA_BLOCK)[None, :]
    kpos = (jnp.arange(nb)[:, None] - 1) * SWA_BLOCK + jnp.arange(3 * SWA_BLOCK)[None, :]
    valid = ((jnp.abs(qpos[:, :, None] - kpos[:, None, :]) <= SWA_WINDOW)
             & (kpos[:, None, :] >= 0) & (kpos[:, None, :] < n))
    s_loc = jnp.where(valid, s_loc, -jnp.inf)
    s_ctx = jnp.einsum('bkgnqd,bkcd->bkgnqc', qb, kcx).astype(jnp.float32) * scale
    sink_l = jnp.broadcast_to(sink.astype(jnp.float32).reshape(1, SWA_KV_HEADS, SWA_GROUP, 1, 1, 1),
                              s_loc.shape[:-1] + (1,))
    p = jax.nn.softmax(jnp.concatenate([s_loc, s_ctx, sink_l], axis=-1), axis=-1).astype(v.dtype)
    nw = 3 * SWA_BLOCK
    o = (jnp.einsum('bkgnqj,bknjd->bkgnqd', p[..., :nw], v_win)
         + jnp.einsum('bkgnqc,bkcd->bkgnqd', p[..., nw:nw + CTX_LEN], vcx))
    y_l = from_heads(o.reshape(b_, SWA_HEADS, n, HEAD_DIM))
    y_c = None
    if need_ctx:
        qcb = qcx.reshape(b_, SWA_KV_HEADS, SWA_GROUP, CTX_LEN, HEAD_DIM)
        s_cc = jnp.einsum('bkgqd,bkcd->bkgqc', qcb, kcx).astype(jnp.float32) * scale
        sink_c = jnp.broadcast_to(sink.astype(jnp.float32).reshape(1, SWA_KV_HEADS, SWA_GROUP, 1, 1),
                                  s_cc.shape[:-1] + (1,))
        pc_ = jax.nn.softmax(jnp.concatenate([s_cc, sink_c], axis=-1), axis=-1).astype(v.dtype)
        o_c = jnp.einsum('bkgqc,bkcd->bkgqd', pc_[..., :CTX_LEN], vcx)
        y_c = from_heads(o_c.reshape(b_, SWA_HEADS, CTX_LEN, HEAD_DIM))
    return y_l, y_c


def na_mixer(pl, pc, q_norm, k_norm, rel_bias, need_ctx):
    b_, n, _ = pl['d_q'].shape
    rows = n // GRID_W
    kh = min(NA_KH_MAX, rows)
    scale = HEAD_DIM ** -0.5
    q = rms_norm(to_heads(pl['d_q'], NA_HEADS), q_norm)
    k = rms_norm(to_heads(pl['d_k'], NA_HEADS), k_norm)
    v = to_heads(pl['d_v'], NA_HEADS)
    qcx = rms_norm(to_heads(pc['d_q'], NA_HEADS), q_norm)
    kcx = rms_norm(to_heads(pc['d_k'], NA_HEADS), k_norm)
    vcx = to_heads(pc['d_v'], NA_HEADS)

    grid = lambda t: t.reshape(b_, NA_HEADS, rows, GRID_W, HEAD_DIM)
    qg, kg, vg = grid(q), grid(k), grid(v)
    r = jnp.arange(rows)
    row_start = jnp.clip(r - kh // 2, 0, rows - kh)
    row_idx = row_start[:, None] + jnp.arange(kh)[None, :]
    k_rows = kg[:, :, row_idx]
    v_rows = vg[:, :, row_idx]
    s_nb = jnp.einsum('bhrqd,bhrkwd->bhrqkw', qg, k_rows).astype(jnp.float32) * scale
    cq = jnp.arange(GRID_W)
    col_start = jnp.clip(cq - NA_KW // 2, 0, GRID_W - NA_KW)
    col_ok = (cq[None, :] >= col_start[:, None]) & (cq[None, :] < col_start[:, None] + NA_KW)
    dy = row_idx - r[:, None] + (NA_KH_MAX - 1)
    dx = jnp.clip(cq[None, :] - cq[:, None], -(NA_KW - 1), NA_KW - 1) + (NA_KW - 1)
    bias = rel_bias[:, dy[:, None, :, None], dx[None, :, None, :]].astype(jnp.float32)
    s_nb = jnp.where(col_ok[:, None, :], s_nb + bias, -jnp.inf)
    s_nb = s_nb.reshape(b_, NA_HEADS, rows, GRID_W, kh * GRID_W)
    s_ctx = jnp.einsum('bhrqd,bhcd->bhrqc', qg, kcx).astype(jnp.float32) * scale
    p = jax.nn.softmax(jnp.concatenate([s_nb, s_ctx], axis=-1), axis=-1).astype(v.dtype)
    p_nb = p[..., :kh * GRID_W].reshape(b_, NA_HEADS, rows, GRID_W, kh, GRID_W)
    o = (jnp.einsum('bhrqkw,bhrkwd->bhrqd', p_nb, v_rows)
         + jnp.einsum('bhrqc,bhcd->bhrqd', p[..., kh * GRID_W:], vcx))
    y_l = from_heads(o.reshape(b_, NA_HEADS, n, HEAD_DIM))
    y_c = None
    if need_ctx:
        s_cc = jnp.einsum('bhqd,bhcd->bhqc', qcx, kcx).astype(jnp.float32) * scale
        o_c = jnp.einsum('bhqc,bhcd->bhqd', jax.nn.softmax(s_cc, axis=-1).astype(v.dtype), vcx)
        y_c = from_heads(o_c)
    return y_l, y_c


def hybrid_layer(x, ctx, c, c_ctx, norm_w, ada_w, ada_b, w_in, w_out, gla_dec_w, gla_dec_b, gla_out_norm,
                 fnet_w, swa_q_norm, swa_k_norm, swa_sink, na_q_norm, na_k_norm, na_rel_bias,
                 cos, sin, need_ctx):
    shift_l, scale_l, gate_l = jnp.split(jax.nn.silu(c) @ ada_w + ada_b, 3, axis=-1)
    shift_c, scale_c, gate_c = jnp.split(jax.nn.silu(c_ctx) @ ada_w + ada_b, 3, axis=-1)
    h_l = rms_norm(x, norm_w) * (1.0 + scale_l[:, None, :]) + shift_l[:, None, :]
    h_c = rms_norm(ctx, norm_w) * (1.0 + scale_c) + shift_c
    pl = split_proj(h_l @ w_in)
    pc = split_proj(h_c @ w_in)

    a_l, a_c = gla_mixer(pl, pc, gla_dec_w, gla_dec_b, gla_out_norm, need_ctx)
    b_l = fourier_mix(pl['b_v'], fnet_w)
    c_l, c_c = swa_mixer(pl, pc, swa_q_norm, swa_k_norm, swa_sink, cos, sin, need_ctx)
    d_l, d_c = na_mixer(pl, pc, na_q_norm, na_k_norm, na_rel_bias, need_ctx)

    y_l = jnp.concatenate([a_l * jax.nn.silu(pl['a_g']), b_l * jax.nn.silu(pl['b_g']),
                           c_l * jax.nn.silu(pl['c_g']), d_l * jax.nn.silu(pl['d_g'])], axis=-1) @ w_out
    x = x + gate_l[:, None, :] * y_l
    if need_ctx:
        b_c = fourier_mix(pc['b_v'], fnet_w)
        y_c = jnp.concatenate([a_c * jax.nn.silu(pc['a_g']), b_c * jax.nn.silu(pc['b_g']),
                               c_c * jax.nn.silu(pc['c_g']), d_c * jax.nn.silu(pc['d_g'])], axis=-1) @ w_out
        ctx = ctx + gate_c * y_c
    return x, ctx


def setup_inputs(seed: int = 0) -> dict:
    key = jax.random.key(seed)
    ks = jax.random.split(key, 20)

    def nrm(k, shape, s):
        return jax.random.normal(k, shape, jnp.float32) * s

    return {
        "x": nrm(ks[0], (BATCH, SEQ, D_MODEL), 1.0),
        "c": nrm(ks[1], (BATCH, D_MODEL), 1.0),
        "ctx": nrm(ks[2], (BATCH, CTX_LEN, D_MODEL), 1.0),
        "c_ctx": nrm(ks[3], (D_MODEL,), 1.0),
        "norm_w": 1.0 + nrm(ks[4], (DEPTH, D_MODEL), 0.02),
        "ada_w": nrm(ks[5], (DEPTH, D_MODEL, 3 * D_MODEL), 0.5 * D_MODEL ** -0.5),
        "ada_b": nrm(ks[6], (DEPTH, 3 * D_MODEL), 0.02),
        "w_in": nrm(ks[7], (DEPTH, D_MODEL, PROJ_WIDTH), D_MODEL ** -0.5),
        "w_out": nrm(ks[8], (DEPTH, D_MIX, D_MODEL), D_MIX ** -0.5),
        "gla_dec_w": nrm(ks[9], (DEPTH, 2, GLA_RANK, GLA_HEADS * GLA_DK), GLA_RANK ** -0.5),
        "gla_dec_b": nrm(ks[10], (DEPTH, 2, GLA_HEADS * GLA_DK), 0.5),
        "gla_out_norm": 1.0 + nrm(ks[11], (DEPTH, GLA_DV), 0.02),
        "fnet_w": nrm(ks[12], (DEPTH, BRANCH_W, BRANCH_W), BRANCH_W ** -0.5),
        "swa_q_norm": 1.0 + nrm(ks[13], (DEPTH, HEAD_DIM), 0.02),
        "swa_k_norm": 1.0 + nrm(ks[14], (DEPTH, HEAD_DIM), 0.02),
        "swa_sink": nrm(ks[15], (DEPTH, SWA_HEADS), 0.5),
        "na_q_norm": 1.0 + nrm(ks[16], (DEPTH, HEAD_DIM), 0.02),
        "na_k_norm": 1.0 + nrm(ks[17], (DEPTH, HEAD_DIM), 0.02),
        "na_rel_bias": nrm(ks[18], (DEPTH, NA_HEADS, 2 * NA_KH_MAX - 1, 2 * NA_KW - 1), 0.1),
    }


def reference(x, c, ctx, c_ctx, norm_w, ada_w, ada_b, w_in, w_out, gla_dec_w, gla_dec_b, gla_out_norm,
              fnet_w, swa_q_norm, swa_k_norm, swa_sink, na_q_norm, na_k_norm, na_rel_bias):
    cos, sin = axial_rope_tables(x.shape[1])
    for i in range(DEPTH):
        x, ctx = hybrid_layer(x, ctx, c, c_ctx, norm_w[i], ada_w[i], ada_b[i], w_in[i], w_out[i],
                              gla_dec_w[i], gla_dec_b[i], gla_out_norm[i], fnet_w[i],
                              swa_q_norm[i], swa_k_norm[i], swa_sink[i],
                              na_q_norm[i], na_k_norm[i], na_rel_bias[i],
                              cos, sin, need_ctx=(i < DEPTH - 1))
    return x
```

```cpp
#include <hip/hip_runtime.h>
#include <math.h>
#include <stdint.h>

#ifndef BRMASK
#define BRMASK 15
#endif
namespace nv {
constexpr int D = 1024, NB = 4, SEQ = 4096, CTX = 256, PW = 3104, PWW = 3360  , LT = SEQ + CTX, G = 2, GLT = G * LT;
constexpr int O_AQ = 0, O_AK = 128, O_AV = 256, O_AG = 512, O_LR = 768, O_BV = 800, O_BG = 1056, O_CQ = 1312, O_CK = 1568, O_CV = 1696,
              O_CG = 1824, O_DQ = 2080, O_DK = 2336, O_DV = 2592, O_DG = 2848;

__device__ __forceinline__ float silu(float x) { return x / (1.f + expf(-x)); }
__device__ __forceinline__ float logsig(float x) { return x < 0.f ? x - log1pf(expf(x)) : -log1pf(expf(-x)); }
__device__ __forceinline__ float wave_sum(float v) {
#pragma unroll
  for (int o = 32; o >= 1; o >>= 1) v += __shfl_xor(v, o);
  return v;
}
__device__ __forceinline__ float wave_max(float v) {
#pragma unroll
  for (int o = 32; o >= 1; o >>= 1) v = fmaxf(v, __shfl_xor(v, o));
  return v;
}

__global__ void k_ada(const float* c, const float* c_ctx, const float* ada_w, const float* ada_b, float* MOD) {
  __shared__ float s[D];
  const int col = blockIdx.x * 256 + threadIdx.x, r = blockIdx.y, l = blockIdx.z;
  const float* cv = r < 4 ? c + r * D : c_ctx;
  for (int k = threadIdx.x; k < D; k += 256) s[k] = silu(cv[k]);
  __syncthreads();
  const float* w = ada_w + (size_t)l * D * 3072;
  float acc = 0.f;
  for (int k = 0; k < D; ++k) acc += s[k] * w[(size_t)k * 3072 + col];
  MOD[((size_t)l * 5 + r) * 3072 + col] = acc + ada_b[l * 3072 + col];
}

__global__ void k_prenorm(const float* xin, const float* ctxin, const float* nw, const float* modL, float* H, int b0) {
  __shared__ float red[4];
  const int r = blockIdx.x, tid = threadIdx.x, b = b0 + blockIdx.y;
  H += (size_t)blockIdx.y * LT * D;
  const float* src = r < SEQ ? xin + ((size_t)b * SEQ + r) * D : ctxin + ((size_t)b * CTX + (r - SEQ)) * D;
  const float* mod = modL + (size_t)(r < SEQ ? b : 4) * 3072;
  float4 v = *(const float4*)(src + tid * 4);
  float ss = v.x * v.x + v.y * v.y + v.z * v.z + v.w * v.w;
  ss = wave_sum(ss);
  if ((tid & 63) == 0) red[tid >> 6] = ss;
  __syncthreads();
  ss = red[0] + red[1] + red[2] + red[3];
  const float rs = 1.0f / sqrtf(ss * (1.f / D) + 1e-6f);
  float xv[4] = {v.x, v.y, v.z, v.w};
  float o[4];
#pragma unroll
  for (int j = 0; j < 4; ++j) { const int k = tid * 4 + j; o[j] = xv[j] * rs * nw[k] * (1.f + mod[1024 + k]) + mod[k]; }
  *(float4*)(H + (size_t)r * D + tid * 4) = make_float4(o[0], o[1], o[2], o[3]);
}

__global__ __launch_bounds__(256) void k_gemm(const float* A, int lda, const float* Bm, int ldb, float* C, int ldc, int M, int N, int K) {
  __shared__ float As[16][64 + 4];
  __shared__ float Bs[16][64 + 4];
  const int tid = threadIdx.x, tx = tid & 15, ty = tid >> 4;
  const int m0 = blockIdx.y * 64, n0 = blockIdx.x * 64;
  float acc[4][4] = {};
  const int ar = tid >> 2, ak = (tid & 3) * 4;
  const int bk = tid >> 4, bn = (tid & 15) * 4;
  for (int k0 = 0; k0 < K; k0 += 16) {
    float4 av = *(const float4*)(A + (size_t)(m0 + ar) * lda + k0 + ak);
    float4 bv = make_float4(0.f, 0.f, 0.f, 0.f);
    if (n0 + bn < N) bv = *(const float4*)(Bm + (size_t)(k0 + bk) * ldb + n0 + bn);
    As[ak + 0][ar] = av.x; As[ak + 1][ar] = av.y; As[ak + 2][ar] = av.z; As[ak + 3][ar] = av.w;
    *(float4*)&Bs[bk][bn] = bv;
    __syncthreads();
#pragma unroll
    for (int k = 0; k < 16; ++k) {
      float4 a4 = *(const float4*)&As[k][ty * 4];
      float4 b4 = *(const float4*)&Bs[k][tx * 4];
      float a[4] = {a4.x, a4.y, a4.z, a4.w}, bb[4] = {b4.x, b4.y, b4.z, b4.w};
#pragma unroll
      for (int i = 0; i < 4; ++i)
#pragma unroll
        for (int j = 0; j < 4; ++j) acc[i][j] += a[i] * bb[j];
    }
    __syncthreads();
  }
  if (n0 + tx * 4 < N)
#pragma unroll
    for (int i = 0; i < 4; ++i) *(float4*)(C + (size_t)(m0 + ty * 4 + i) * ldc + n0 + tx * 4) = make_float4(acc[i][0], acc[i][1], acc[i][2], acc[i][3]);
}

__device__ __forceinline__ void gla_decay_row(const float* PL, const float* dec_w, const float* dec_b, float* AD, int t) {
  const int dir = threadIdx.x >> 7, col = threadIdx.x & 127;
  float acc = dec_b[dir * 128 + col];
  for (int r = 0; r < 16; ++r) acc += PL[(size_t)t * PW + O_LR + dir * 16 + r] * dec_w[(dir * 16 + r) * 128 + col];
  AD[(size_t)t * 256 + dir * 128 + col] = expf(logsig(acc) * (1.f / 16.f));
}

__global__ __launch_bounds__(64) void k_gla_scan(const float* PL, const float* AD, float* O2) {
  __shared__ float sq[64][32], sk[64][32], sa[64][32];
  const int h = blockIdx.x & 3, dir = blockIdx.x >> 2, e = threadIdx.x;
  PL += (size_t)blockIdx.y * LT * PW; AD += (size_t)blockIdx.y * LT * 256; O2 += (size_t)blockIdx.y * LT * 256;
  float S[32];
#pragma unroll
  for (int d = 0; d < 32; ++d) S[d] = 0.f;
  const float qs = 0.17677669529663687f;
  for (int c0 = 0; c0 < LT; c0 += 64) {
    __syncthreads();
    for (int i = e; i < 64 * 32; i += 64) {
      const int st = i >> 5, d = i & 31, step = c0 + st;
      int t;
      if (dir == 0) t = step < CTX ? SEQ + step : step - CTX;
      else t = step < CTX ? SEQ + (CTX - 1 - step) : SEQ - 1 - (step - CTX);
      sq[st][d] = PL[(size_t)t * PW + O_AQ + h * 32 + d] * qs;
      sk[st][d] = PL[(size_t)t * PW + O_AK + h * 32 + d];
      sa[st][d] = AD[(size_t)t * 256 + dir * 128 + h * 32 + d];
    }
    __syncthreads();
    for (int st = 0; st < 64; ++st) {
      const int step = c0 + st;
      int t;
      if (dir == 0) t = step < CTX ? SEQ + step : step - CTX;
      else t = step < CTX ? SEQ + (CTX - 1 - step) : SEQ - 1 - (step - CTX);
      const float v = PL[(size_t)t * PW + O_AV + h * 64 + e];
      float o = 0.f;
#pragma unroll
      for (int d = 0; d < 32; ++d) { S[d] = sa[st][d] * S[d] + sk[st][d] * v; o += sq[st][d] * S[d]; }
      O2[((size_t)dir * GLT + t) * 256 + h * 64 + e] = o;
    }
  }
}

__global__ void k_gla_fin(const float* PL, const float* O2, const float* out_norm, float* YC) {
  const int t = blockIdx.x, h = threadIdx.x >> 6, e = threadIdx.x & 63;
  const float o = O2[(size_t)t * 256 + h * 64 + e] + O2[((size_t)GLT + t) * 256 + h * 64 + e];
  const float ss = wave_sum(o * o);
  const float y = o * (1.0f / sqrtf(ss * (1.f / 64.f) + 1e-6f)) * out_norm[e];
  YC[(size_t)t * D + h * 64 + e] = (BRMASK & 1) ? y * silu(PL[(size_t)t * PW + O_AG + h * 64 + e]) : 0.f;
}

__global__ void k_f1(const float* PL, float2* U, const float* dec_w, const float* dec_b, float* AD) {
  __shared__ float cs[64], sn[64], xs[256];
  const int t = blockIdx.x, c = threadIdx.x, g = c >> 6, m = c & 63;
  gla_decay_row(PL, dec_w, dec_b, AD, t);
  if (c < 64) { float s_, c_; sincospif(2.f * c / 64.f, &s_, &c_); cs[c] = c_; sn[c] = s_; }
  xs[c] = PL[(size_t)t * PW + O_BV + c];
  __syncthreads();
  float ur = 0.f, ui = 0.f;
  for (int j = 0; j < 64; ++j) { const int idx = (m * j) & 63; const float x = xs[g * 64 + j]; ur += x * cs[idx]; ui -= x * sn[idx]; }
  U[(size_t)t * 256 + c] = make_float2(ur, ui);
}
__global__ void k_f2(const float2* U, float2* Z) {
  __shared__ float cs[64], sn[64];
  const int k1 = blockIdx.x >> 6, n2 = blockIdx.x & 63, c = threadIdx.x;
  U += (size_t)blockIdx.y * LT * 256; Z += (size_t)blockIdx.y * SEQ * 256;
  if (c < 64) { float s_, c_; sincospif(2.f * c / 64.f, &s_, &c_); cs[c] = c_; sn[c] = s_; }
  __syncthreads();
  float yr = 0.f, yi = 0.f;
  for (int n1 = 0; n1 < 64; ++n1) {
    const float2 u = U[(size_t)(n1 * 64 + n2) * 256 + c];
    const int idx = (k1 * n1) & 63; const float cc = cs[idx], ss = sn[idx];
    yr += u.x * cc + u.y * ss; yi += u.y * cc - u.x * ss;
  }
  float ts, tc; sincospif(2.f * (float)((k1 * n2) & 4095) / 4096.f, &ts, &tc);
  Z[(size_t)(k1 * 64 + n2) * 256 + c] = make_float2(yr * tc + yi * ts, yi * tc - yr * ts);
}
__global__ void k_f3(const float2* Z, const float2* U, float* FR) {
  __shared__ float cs[256], sn[256];
  const int c = threadIdx.x;
  Z += (size_t)blockIdx.y * SEQ * 256; U += (size_t)blockIdx.y * LT * 256; FR += (size_t)blockIdx.y * LT * 256;
  if (blockIdx.x >= 4096) {
    const int k = blockIdx.x - 4096;
    { float s_, c_; sincospif(2.f * c / 256.f, &s_, &c_); cs[c] = c_; sn[c] = s_; }
    __syncthreads();
    float fr = 0.f;
    for (int n = 0; n < 256; ++n) { const float2 u = U[(size_t)(SEQ + n) * 256 + c]; const int idx = (k * n) & 255; fr += u.x * cs[idx] + u.y * sn[idx]; }
    FR[(size_t)(SEQ + k) * 256 + c] = fr * (1.f / 128.f);
    return;
  }
  const int k1 = blockIdx.x >> 6, k2 = blockIdx.x & 63;
  if (c < 64) { float s_, c_; sincospif(2.f * c / 64.f, &s_, &c_); cs[c] = c_; sn[c] = s_; }
  __syncthreads();
  float fr = 0.f;
  for (int n2 = 0; n2 < 64; ++n2) { const float2 z = Z[(size_t)(k1 * 64 + n2) * 256 + c]; const int idx = (k2 * n2) & 63; fr += z.x * cs[idx] + z.y * sn[idx]; }
  FR[(size_t)(k1 + 64 * k2) * 256 + c] = fr * (1.f / 512.f);
}
__global__ void k_fgate(const float* PL, const float* BL, float* YC) {
  const int t = blockIdx.x, c = threadIdx.x;
  YC[(size_t)t * D + 256 + c] = (BRMASK & 2) ? BL[(size_t)t * 256 + c] * silu(PL[(size_t)t * PW + O_BG + c]) : 0.f;
}

__global__ void k_qknorm(const float* PL, const float* cqn, const float* ckn, const float* dqn, const float* dkn, float* QKN) {
  const int row = blockIdx.x, t = row % LT, hd = threadIdx.x >> 6, d = threadIdx.x & 63;
  PL += (size_t)(row - t) * PW; QKN += (size_t)(row - t) * 896;
  int src, dst; const float* w; bool rope = false;
  if (hd < 4) { src = O_CQ + hd * 64; dst = hd * 64; w = cqn; rope = true; }
  else if (hd < 6) { src = O_CK + (hd - 4) * 64; dst = 256 + (hd - 4) * 64; w = ckn; rope = true; }
  else if (hd < 10) { src = O_DQ + (hd - 6) * 64; dst = 384 + (hd - 6) * 64; w = dqn; }
  else { src = O_DK + (hd - 10) * 64; dst = 640 + (hd - 10) * 64; w = dkn; }
  const float x = PL[(size_t)t * PW + src + d];
  const float ss = wave_sum(x * x);
  float y = x * (1.0f / sqrtf(ss * (1.f / 64.f) + 1e-6f)) * w[d];
  if (rope && t < SEQ) {
    const int axis = d >> 5, half = (d >> 4) & 1, f = d & 15;
    const float pos = axis == 0 ? (float)(t >> 6) : (float)(t & 63);
    const float inv = powf(10000.f, -(float)f / 16.f);
    const float ang = pos * inv;
    const float cs = cosf(ang), sn = sinf(ang);
    const float other = __shfl_xor(y, 16);
    y = half == 0 ? y * cs - other * sn : y * cs + other * sn;
  }
  QKN[(size_t)t * 896 + dst + d] = y;
}

__global__ __launch_bounds__(64) void k_swa(const float* PL, const float* QKN, const float* sink, float* YC, int need_ctx) {
  __shared__ float qs[64];
  __shared__ float sc[640];
  const int t = blockIdx.x, hq = blockIdx.y, kvh = hq >> 1, lane = threadIdx.x;
  PL += (size_t)blockIdx.z * LT * PW; QKN += (size_t)blockIdx.z * LT * 896; YC += (size_t)blockIdx.z * LT * D;
  if (t >= SEQ && !need_ctx) return;
  qs[lane] = QKN[(size_t)t * 896 + hq * 64 + lane];
  __syncthreads();
  float q[64];
#pragma unroll
  for (int d = 0; d < 64; ++d) q[d] = qs[d];
  int lo = 0, nloc = 0;
  if (t < SEQ) { lo = t - 128 < 0 ? 0 : t - 128; int hi = t + 128 > SEQ - 1 ? SEQ - 1 : t + 128; nloc = hi - lo + 1; }
  const int nk = nloc + CTX;
  float mx = sink[hq];
  for (int j = lane; j < nk; j += 64) {
    const int kt = j < nloc ? lo + j : SEQ + (j - nloc);
    const float* kp = QKN + (size_t)kt * 896 + 256 + kvh * 64;
    float s = 0.f;
#pragma unroll
    for (int d = 0; d < 64; ++d) s += q[d] * kp[d];
    s *= 0.125f; sc[j] = s; mx = fmaxf(mx, s);
  }
  mx = wave_max(mx);
  float sum = 0.f;
  for (int j = lane; j < nk; j += 64) { const float p = expf(sc[j] - mx); sc[j] = p; sum += p; }
  sum = wave_sum(sum) + expf(sink[hq] - mx);
  __syncthreads();
  float o = 0.f;
  for (int j = 0; j < nk; ++j) {
    const int kt = j < nloc ? lo + j : SEQ + (j - nloc);
    o += sc[j] * PL[(size_t)kt * PW + O_CV + kvh * 64 + lane];
  }
  o /= sum;
  YC[(size_t)t * D + 512 + hq * 64 + lane] = (BRMASK & 4) ? o * silu(PL[(size_t)t * PW + O_CG + hq * 64 + lane]) : 0.f;
}

__global__ __launch_bounds__(64) void k_na(const float* PL, const float* QKN, const float* rel_bias, float* YC, int need_ctx) {
  __shared__ float qs[64];
  __shared__ float sc[384];
  const int t = blockIdx.x, h = blockIdx.y, lane = threadIdx.x;
  PL += (size_t)blockIdx.z * LT * PW; QKN += (size_t)blockIdx.z * LT * 896; YC += (size_t)blockIdx.z * LT * D;
  if (t >= SEQ && !need_ctx) return;
  qs[lane] = QKN[(size_t)t * 896 + 384 + h * 64 + lane];
  __syncthreads();
  float q[64];
#pragma unroll
  for (int d = 0; d < 64; ++d) q[d] = qs[d];
  const int nloc = t < SEQ ? 128 : 0;
  const int r = t >> 6, cq = t & 63;
  int rs = r - 4; rs = rs < 0 ? 0 : (rs > 56 ? 56 : rs);
  int c0 = cq - 8; c0 = c0 < 0 ? 0 : (c0 > 48 ? 48 : c0);
  const int nk = nloc + CTX;
  float mx = -1e30f;
  for (int j = lane; j < nk; j += 64) {
    int kt; float bias = 0.f;
    if (j < nloc) {
      const int kr = rs + (j >> 4), kc = c0 + (j & 15);
      kt = kr * 64 + kc;
      const int dy = kr - r + 7; int dx = kc - cq; dx = dx < -15 ? -15 : (dx > 15 ? 15 : dx); dx += 15;
      bias = rel_bias[(h * 15 + dy) * 31 + dx];
    } else kt = SEQ + (j - nloc);
    const float* kp = QKN + (size_t)kt * 896 + 640 + h * 64;
    float s = 0.f;
#pragma unroll
    for (int d = 0; d < 64; ++d) s += q[d] * kp[d];
    s = s * 0.125f + bias; sc[j] = s; mx = fmaxf(mx, s);
  }
  mx = wave_max(mx);
  float sum = 0.f;
  for (int j = lane; j < nk; j += 64) { const float p = expf(sc[j] - mx); sc[j] = p; sum += p; }
  sum = wave_sum(sum);
  __syncthreads();
  float o = 0.f;
  for (int j = 0; j < nk; ++j) {
    int kt;
    if (j < nloc) kt = (rs + (j >> 4)) * 64 + c0 + (j & 15); else kt = SEQ + (j - nloc);
    o += sc[j] * PL[(size_t)kt * PW + O_DV + h * 64 + lane];
  }
  o /= sum;
  YC[(size_t)t * D + 768 + h * 64 + lane] = (BRMASK & 8) ? o * silu(PL[(size_t)t * PW + O_DG + h * 64 + lane]) : 0.f;
}

__global__ void k_resid(const float* xin, const float* ctxin, const float* YL, const float* modL, float* xout, float* ctxout, int b0, int need_ctx) {
  const int r = blockIdx.x, tid = threadIdx.x, b = b0 + blockIdx.y;
  YL += (size_t)blockIdx.y * LT * D;
  if (r >= SEQ && !need_ctx) return;
  const float* src = r < SEQ ? xin + ((size_t)b * SEQ + r) * D : ctxin + ((size_t)b * CTX + (r - SEQ)) * D;
  float* dst = r < SEQ ? xout + ((size_t)b * SEQ + r) * D : ctxout + ((size_t)b * CTX + (r - SEQ)) * D;
  const float* gate = modL + (size_t)(r < SEQ ? b : 4) * 3072 + 2048;
  for (int k = tid; k < D; k += 256) dst[k] = src[k] + gate[k] * YL[(size_t)r * D + k];
}
}

extern "C" void kernel_launch(void* const* d_in, const int* in_sizes, int n_in, void* d_out, int out_size, void* d_ws, size_t ws_size, hipStream_t stream) {
  using namespace nv;
  const float* x = (const float*)d_in[0]; const float* c = (const float*)d_in[1]; const float* ctx = (const float*)d_in[2]; const float* c_ctx = (const float*)d_in[3];
  const float* norm_w = (const float*)d_in[4]; const float* ada_w = (const float*)d_in[5]; const float* ada_b = (const float*)d_in[6];
  const float* w_in = (const float*)d_in[7]; const float* w_out = (const float*)d_in[8]; const float* dec_w = (const float*)d_in[9]; const float* dec_b = (const float*)d_in[10];
  const float* gla_on = (const float*)d_in[11]; const float* fnet_w = (const float*)d_in[12]; const float* sqn = (const float*)d_in[13]; const float* skn = (const float*)d_in[14];
  const float* ssink = (const float*)d_in[15]; const float* nqn = (const float*)d_in[16]; const float* nkn = (const float*)d_in[17]; const float* nbias = (const float*)d_in[18];
  float* out = (float*)d_out;
  float* ws = (float*)d_ws; size_t off = 0;
  auto take = [&](size_t n) { float* p = ws + off; off += (n + 63) & ~(size_t)63; return p; };
  float* MOD = take(2 * 5 * 3072);
  float* CTX1 = take((size_t)NB * CTX * D);
  float* H = take((size_t)GLT * D);
  float* YL = H;
  float* PL = take((size_t)GLT * PW);
  float* YC = take((size_t)GLT * D);
  float* SCR = take((size_t)GLT * 1536);
  float* AD = SCR; float* O2 = SCR + (size_t)GLT * 256;
  float2* U = (float2*)SCR; float2* Z = (float2*)(SCR + (size_t)GLT * 512);
  float* FR = SCR + (size_t)GLT * 1024; float* BL = SCR + (size_t)GLT * 1280;
  float* QKN = SCR;

  hipLaunchKernelGGL(k_ada, dim3(12, 5, 2), dim3(256), 0, stream, c, c_ctx, ada_w, ada_b, MOD);
  for (int l = 0; l < 2; ++l) {
    const int need_ctx = (l == 0);
    const float* xin = l == 0 ? x : out; const float* ctxin = l == 0 ? ctx : CTX1;
    const float* modL = MOD + (size_t)l * 5 * 3072;
    for (int b0 = 0; b0 < NB; b0 += G) {
      hipLaunchKernelGGL(k_prenorm, dim3(LT, G), dim3(256), 0, stream, xin, ctxin, norm_w + l * D, modL, H, b0);
      hipLaunchKernelGGL(k_gemm, dim3((PW + 63) / 64, GLT / 64), dim3(256), 0, stream, H, D, w_in + (size_t)l * D * PWW, PWW, PL, PW, GLT, PW, D);
      hipLaunchKernelGGL(k_qknorm, dim3(GLT), dim3(14 * 64), 0, stream, PL, sqn + l * 64, skn + l * 64, nqn + l * 64, nkn + l * 64, QKN);
      hipLaunchKernelGGL(k_swa, dim3(LT, 4, G), dim3(64), 0, stream, PL, QKN, ssink + l * 4, YC, need_ctx);
      hipLaunchKernelGGL(k_na, dim3(LT, 4, G), dim3(64), 0, stream, PL, QKN, nbias + (size_t)l * 4 * 15 * 31, YC, need_ctx);
      hipLaunchKernelGGL(k_f1, dim3(GLT), dim3(256), 0, stream, PL, U, dec_w + l * 2 * 16 * 128, dec_b + l * 256, FR);
      hipLaunchKernelGGL(k_f2, dim3(4096, G), dim3(256), 0, stream, U, Z);
      hipLaunchKernelGGL(k_f3, dim3(4096 + CTX, G), dim3(256), 0, stream, Z, U, BL);
      hipLaunchKernelGGL(k_gemm, dim3(4, GLT / 64), dim3(256), 0, stream, BL, 256, fnet_w + (size_t)l * 256 * 256, 256, (float*)U, 256, GLT, 256, 256);
      hipLaunchKernelGGL(k_fgate, dim3(GLT), dim3(256), 0, stream, PL, (float*)U, YC);
      hipLaunchKernelGGL(k_gla_scan, dim3(8, G), dim3(64), 0, stream, PL, FR, O2);
      hipLaunchKernelGGL(k_gla_fin, dim3(GLT), dim3(256), 0, stream, PL, O2, gla_on + l * 64, YC);
      hipLaunchKernelGGL(k_gemm, dim3(16, GLT / 64), dim3(256), 0, stream, YC, D, w_out + (size_t)l * D * D, D, YL, D, GLT, D, D);
      hipLaunchKernelGGL(k_resid, dim3(LT, G), dim3(256), 0, stream, xin, ctxin, YL, modL, out, CTX1, b0, need_ctx);
    }
  }
}
```

```cpp
#include <hip/hip_runtime.h>
#include <math.h>
#include <stdint.h>

namespace pg8 {
#define PG8_LAS __attribute__((address_space(3)))
typedef unsigned short bf16_t;
typedef short bf16x8 __attribute__((ext_vector_type(8)));
typedef float f32x4 __attribute__((ext_vector_type(4)));
typedef unsigned u32x4 __attribute__((ext_vector_type(4)));
constexpr int BM = 256, BK = 64, HALF = 128, HTB = HALF * BK * 2  , STAGE_BYTES = 8 * HTB, NXCD = 8, WGM = 8;

__host__ __device__ __forceinline__ int lds_byte(int r, int c) { const int st = (r >> 4) * 2 + (c >> 5), rr = r & 15, cc = c & 31, ob = rr * 64 + cc * 2; return st * 1024 + (ob ^ (((ob >> 9) & 1) << 5)); }
__host__ __device__ __forceinline__ void stage_rc(int b, int& R, int& C) { const int st = b / 1024, sb = b % 1024, swz = sb ^ (((sb >> 9) & 1) << 5); R = (st >> 1) * 16 + swz / 64; C = (st & 1) * 32 + (swz % 64) / 2; }
__host__ __device__ __forceinline__ int perm32(int rho) { const int n = rho >> 4, i = rho & 15; return 8 * (i >> 2) + 4 * n + (i & 3); }

struct Unit { int pm, pn; };
struct Gemm { const bf16_t* A; const bf16_t* Bt; int M, N, K; };

struct StaticOrder {
    int nM, nN, nwg, G, c;
    __host__ __device__ void init(int M, int N, int G_, int c_) { nM = M / BM; nN = N / BM; nwg = nM * nN; G = G_; c = c_; }
    __host__ __device__ bool next(int i, Unit& u) const {
        const long L = (long)i * G + c; if (L >= nwg) return false;
        int wgid = (int)L; { const int q = nwg / NXCD, r = nwg % NXCD, xcd = wgid % NXCD, off = wgid / NXCD; wgid = (xcd < r ? xcd * (q + 1) : r * (q + 1) + (xcd - r) * q) + off; }
        const int nig = WGM * nN, gid = wgid / nig, fm = gid * WGM, gsz = (nM - fm) < WGM ? (nM - fm) : WGM;
        u.pm = fm + ((wgid % nig) % gsz); u.pn = (wgid % nig) / gsz; return true;
    }
    __device__ __forceinline__ void a_ready(const Unit&) const {}
    __device__ __forceinline__ void done(const Unit&) const {}
};

template <class Epi, class Sched, bool STAMP = false>
__device__ __forceinline__ void gemm_phase(PG8_LAS unsigned char* lds, const Gemm g, const Sched& S, const Epi& E, unsigned long long* stamps) {
    int tid_ = threadIdx.x; asm volatile("" : "+v"(tid_));
    const int tid = tid_, wid = __builtin_amdgcn_readfirstlane(tid >> 6), lane = tid & 63, wr = wid >> 2, wc = wid & 3, fr = lane & 15, fq = lane >> 4;
    const int K = g.K, nt = K / BK;
    int ts_lo = 0, ts_hi = 0, nts = 0; const unsigned long long rt_entry = STAMP ? (unsigned long long)wall_clock64() : 0ull;
#define PG8_STAMP() do { if (STAMP && wid == 0 && nts < 64) { const unsigned long long _c = (unsigned long long)clock64(); \
        ts_lo = (lane == nts) ? (int)(unsigned)_c : ts_lo; ts_hi = (lane == nts) ? (int)(unsigned)(_c >> 32) : ts_hi; ++nts; } } while (0)
    PG8_STAMP();
    unsigned voffA[2], voffB[2];
#pragma unroll
    for (int i = 0; i < 2; ++i) { int R, C; stage_rc(tid * 16 + i * 8192, R, C); const int Rb = Epi::PERM ? ((R & ~31) + perm32(R & 31)) : R;
        voffA[i] = (unsigned)(R * K + C) * 2u; voffB[i] = (unsigned)(Rb * K + C) * 2u; }
    const size_t kstep = (size_t)(BK * 2);
    const size_t hstep = (size_t)HALF * K * 2;
    const size_t tstep = 2 * hstep;
    const unsigned ldsw = (unsigned)wid * 1024u;
    const int aoff = lds_byte(wr * 64 + fr, fq * 8), boff = lds_byte(wc * 32 + fr, fq * 8);
#define PG8_SA(b, h) (((b) * 2 + (h)) * HTB)
#define PG8_SB(b, h) ((4 + (b) * 2 + (h)) * HTB)
#define PG8_STAGE(bufoff, gbase, voff) do { _Pragma("unroll") for (int _i = 0; _i < 2; ++_i) \
        __builtin_amdgcn_global_load_lds((const unsigned*)((const char*)(gbase) + (voff)[_i]), (PG8_LAS unsigned*)(lds + (bufoff) + ldsw + _i * 8192), 16, 0, 0); } while (0)
#define PG8_LDA(dst, b, h) do { _Pragma("unroll") for (int m = 0; m < 4; ++m) _Pragma("unroll") for (int k = 0; k < 2; ++k) dst[m][k] = *(const PG8_LAS bf16x8*)(lds + PG8_SA(b, h) + aoff + m * 2048 + k * 1024); } while (0)
#define PG8_LDB(dst, b, h) do { _Pragma("unroll") for (int n = 0; n < 2; ++n) _Pragma("unroll") for (int k = 0; k < 2; ++k) dst[n][k] = *(const PG8_LAS bf16x8*)(lds + PG8_SB(b, h) + boff + n * 2048 + k * 1024); } while (0)
#define PG8_MMA(ai, bj, At, Bt) do { __builtin_amdgcn_s_setprio(1); _Pragma("unroll") for (int m = 0; m < 4; ++m) _Pragma("unroll") for (int n = 0; n < 2; ++n) _Pragma("unroll") for (int k = 0; k < 2; ++k) \
        acc[ai][bj][m][n] = __builtin_amdgcn_mfma_f32_16x16x32_bf16(Bt[n][k], At[m][k], acc[ai][bj][m][n], 0, 0, 0); __builtin_amdgcn_s_setprio(0); } while (0)
#define PG8_WAIT_V(n) asm volatile("s_waitcnt vmcnt(" #n ")" ::: "memory")
#define PG8_WAIT_L(n) asm volatile("s_waitcnt lgkmcnt(" #n ")" ::: "memory")
#define PG8_BAR __builtin_amdgcn_s_barrier()
#define PG8_SCHED __builtin_amdgcn_sched_barrier(0)
    Unit cur, nxt; int ui = 0;
    if (!S.next(0, cur)) return;
    f32x4 acc[2][2][4][2];
#pragma unroll
    for (int a = 0; a < 2; ++a)
#pragma unroll
        for (int b = 0; b < 2; ++b)
#pragma unroll
            for (int m = 0; m < 4; ++m)
#pragma unroll
                for (int n = 0; n < 2; ++n) acc[a][b][m][n] = (f32x4){0.f, 0.f, 0.f, 0.f};
    bf16x8 At[4][2], B0[2][2], B1[2][2];
    const char* cA = (const char*)g.A + (size_t)cur.pm * tstep; const char* cB = (const char*)g.Bt + (size_t)cur.pn * tstep;
    S.a_ready(cur);
    PG8_STAGE(PG8_SB(0, 0), cB, voffB); PG8_STAGE(PG8_SA(0, 0), cA, voffA); PG8_STAGE(PG8_SB(0, 1), cB + hstep, voffB); PG8_STAGE(PG8_SA(0, 1), cA + hstep, voffA);
    if (wr == 1) PG8_BAR;
    PG8_WAIT_V(4); PG8_BAR;
    PG8_STAGE(PG8_SB(1, 0), cB + kstep, voffB); PG8_STAGE(PG8_SA(1, 0), cA + kstep, voffA); PG8_STAGE(PG8_SB(1, 1), cB + hstep + kstep, voffB);
    PG8_WAIT_V(6); PG8_BAR;
    PG8_STAMP();
    for (;;) {
        const bool has_next = S.next(ui + 1, nxt);
        const char* nA = has_next ? (const char*)g.A + (size_t)nxt.pm * tstep : cA; const char* nB = has_next ? (const char*)g.Bt + (size_t)nxt.pn * tstep : cB;
        for (int t = 0; t < nt; t += 2) {
            const bool last = (t == nt - 2);
            const char* a1 = cA + (size_t)(t + 1) * kstep;
            const char* a2 = last ? nA : cA + (size_t)(t + 2) * kstep; const char* b2 = last ? nB : cB + (size_t)(t + 2) * kstep;
            const char* a3 = a2 + kstep; const char* b3 = b2 + kstep;
            if (last && has_next) S.a_ready(nxt);
            PG8_LDB(B0, 0, 0); PG8_SCHED; PG8_LDA(At, 0, 0); PG8_STAGE(PG8_SA(1, 1), a1 + hstep, voffA);
            PG8_WAIT_L(8); PG8_BAR; PG8_WAIT_L(0); PG8_MMA(0, 0, At, B0); PG8_BAR; PG8_SCHED;
            PG8_LDB(B1, 0, 1); PG8_STAGE(PG8_SB(0, 0), b2, voffB);
            PG8_BAR; PG8_WAIT_L(0); PG8_MMA(0, 1, At, B1); PG8_BAR;
            PG8_LDA(At, 0, 1); PG8_STAGE(PG8_SA(0, 0), a2, voffA);
            PG8_BAR; PG8_WAIT_L(0); PG8_MMA(1, 0, At, B0); PG8_BAR; PG8_SCHED;
            PG8_STAGE(PG8_SB(0, 1), b2 + hstep, voffB);
            PG8_WAIT_V(6); PG8_BAR; PG8_MMA(1, 1, At, B1); PG8_BAR;
            PG8_LDB(B0, 1, 0); PG8_SCHED; PG8_LDA(At, 1, 0); PG8_STAGE(PG8_SA(0, 1), a2 + hstep, voffA);
            PG8_WAIT_L(8); PG8_BAR; PG8_WAIT_L(0); PG8_MMA(0, 0, At, B0); PG8_BAR; PG8_SCHED;
            PG8_LDB(B1, 1, 1); PG8_STAGE(PG8_SB(1, 0), b3, voffB);
            PG8_BAR; PG8_WAIT_L(0); PG8_MMA(0, 1, At, B1); PG8_BAR;
            PG8_LDA(At, 1, 1); PG8_STAGE(PG8_SA(1, 0), a3, voffA);
            PG8_BAR; PG8_WAIT_L(0); PG8_MMA(1, 0, At, B0); PG8_BAR; PG8_SCHED;
            PG8_STAGE(PG8_SB(1, 1), b3 + hstep, voffB);
            PG8_WAIT_V(6); PG8_BAR; PG8_MMA(1, 1, At, B1); PG8_BAR;
        }
        PG8_STAMP();
        if constexpr (!Epi::AFTER_DRAIN) { E(acc, cur, wr, wc, fr, fq); S.done(cur); }
        PG8_STAMP();
        if (!has_next) break;
#pragma unroll
        for (int a = 0; a < 2; ++a)
#pragma unroll
            for (int b = 0; b < 2; ++b)
#pragma unroll
                for (int m = 0; m < 4; ++m)
#pragma unroll
                    for (int n = 0; n < 2; ++n) acc[a][b][m][n] = (f32x4){0.f, 0.f, 0.f, 0.f};
        cur = nxt; cA = nA; cB = nB; ++ui;
    }
    PG8_WAIT_V(0);
    if (wr == 0) PG8_BAR;
    PG8_BAR;
    if constexpr (Epi::AFTER_DRAIN) { E.fused(acc, cur, wr, wc, fr, fq, lds, wid, lane); S.done(cur); }
    PG8_STAMP();
    if (STAMP && wid == 0) { stamps[lane] = lane < nts ? (((unsigned long long)(unsigned)ts_hi << 32) | (unsigned)ts_lo) : 0ull;
        if (lane == 62) stamps[62] = rt_entry; if (lane == 63) stamps[63] = (unsigned long long)wall_clock64(); }
#undef PG8_STAMP
#undef PG8_SA
#undef PG8_SB
#undef PG8_STAGE
#undef PG8_LDA
#undef PG8_LDB
#undef PG8_MMA
#undef PG8_WAIT_V
#undef PG8_WAIT_L
#undef PG8_BAR
#undef PG8_SCHED
}
}

namespace mk {
#define LAS __attribute__((address_space(3)))
typedef unsigned short bf16;
typedef float f32x4 __attribute__((ext_vector_type(4)));
typedef float f32x16 __attribute__((ext_vector_type(16)));
typedef unsigned u32x4 __attribute__((ext_vector_type(4)));
typedef unsigned u32x2 __attribute__((ext_vector_type(2)));
typedef short bf16x8 __attribute__((ext_vector_type(8)));
typedef short s16x4 __attribute__((ext_vector_type(4)));

constexpr int D = 1024, NB = 4, SEQ = 4096, CTX = 256, PWW = 3360;
constexpr int MLAT = NB * SEQ, MT = MLAT + NB * CTX;
constexpr int NT1 = 14, N1 = NT1 * 256;
constexpr int NSLOT = 11, PLW = NSLOT * 256;
constexpr int TROW = SEQ + CTX;
constexpr int O_AQ = 0, O_AK = 128, O_AV = 256, O_AG = 512, O_LR = 768, O_BV = 800, O_BG = 1056, O_CQ = 1312, O_CK = 1568, O_CV = 1696,
              O_CG = 1824, O_DQ = 2080, O_DK = 2336, O_DV = 2592, O_DG = 2848;
constexpr int S_AQK = 0, S_AV = 1, S_AG = 2, S_BG = 3, S_CQ = 4, S_CKV = 5, S_CG = 6, S_DQ = 7, S_DK = 8, S_DV = 9, S_DG = 10;
constexpr float LOG2E = 1.4426950408889634f, QSCALE = 0.125f * LOG2E, GLA_QS = 0.17677669529663687f;

constexpr size_t WS_CTL = 0, CTL_BYTES = 65536;
constexpr size_t WS_MOD = WS_CTL + CTL_BYTES;
constexpr size_t WS_ROPE = WS_MOD + 2 * 5 * 3072 * 4;
constexpr size_t WS_WC = WS_ROPE + 2 * 64 * 16 * 4;
constexpr size_t WS_CS256 = WS_WC + 128 * 128 * 2;
constexpr size_t WS_W1T = 1u << 20;
constexpr size_t WS_W2T = WS_W1T + (size_t)2 * N1 * D * 2;
constexpr size_t WS_H = WS_W2T + (size_t)2 * D * D * 2;
constexpr size_t WS_PLB = WS_H + (size_t)MT * D * 2;
constexpr size_t WS_LA = WS_PLB + (size_t)MT * PLW * 2;
constexpr size_t WS_FA2 = WS_LA + (size_t)MT * 256 * 4;
constexpr size_t WS_CTX1 = WS_FA2 + (size_t)NB * 64 * TROW * 8 * 2;
constexpr size_t WS_SCR = WS_CTX1 + (size_t)NB * CTX * D * 4;
static_assert(WS_CS256 + 256 * 512 * 2 <= WS_W1T, "tables");

__device__ __forceinline__ float bf2f(bf16 v) { return __uint_as_float(((unsigned)v) << 16); }
__device__ __forceinline__ unsigned f2bf(float f) { unsigned u = __float_as_uint(f); return (u + 0x7fffu + ((u >> 16) & 1u)) >> 16; }
typedef float f32x2_t __attribute__((ext_vector_type(2))); typedef __bf16 bf16x2_t __attribute__((ext_vector_type(2)));
__device__ __forceinline__ unsigned pk2(float lo, float hi) { const f32x2_t v = {lo, hi}; const bf16x2_t b = __builtin_convertvector(v, bf16x2_t); return __builtin_bit_cast(unsigned, b); }
__device__ __forceinline__ float wave_sum(float v) {
#pragma unroll
  for (int o = 1; o < 64; o <<= 1) v += __shfl_xor(v, o);
  return v;
}
__device__ __forceinline__ float fsilu(float x) { return x * __builtin_amdgcn_rcpf(1.f + __expf(-x)); }
__device__ __forceinline__ float flogsig(float x) { return fminf(x, 0.f) - __logf(1.f + __expf(-fabsf(x))); }

#define GAS __attribute__((address_space(1)))
template <class T> __device__ __forceinline__ T* opq(T* p) { GAS T* g = (GAS T*)p; asm volatile("" : "+s"(g)); return (T*)g; }
__device__ __forceinline__ int crow(int r, int hi) { return (r & 3) + 8 * (r >> 2) + 4 * hi; }
struct Args {
  const float* in[19]; float* out; unsigned char* ws; int ph_lo, ph_hi;
};
struct Frame {
  int tid, lane, wave, vcu, G;
  LAS unsigned char* lds;
};
__device__ __forceinline__ Frame relaunder(const Frame& F0) {
  Frame F = F0; F.tid = threadIdx.x; asm volatile("" : "+v"(F.tid)); F.lane = F.tid & 63; asm volatile("" : "+s"(F.wave), "+s"(F.vcu), "+s"(F.G)); return F; }
}

namespace mk {
__device__ __forceinline__ void p0_ada_item(const Frame& F, const Args& a, int item) {
  LAS float* s = (LAS float*)F.lds; LAS float* red = s + 5 * 1024;
  const float* c = opq(a.in[1]); const float* cc = opq(a.in[3]);
  for (int i = F.tid; i < 5 * 1024; i += 512) { const int r = i >> 10, k = i & 1023; const float v = r < 4 ? c[r * 1024 + k] : cc[k]; s[i] = v / (1.f + expf(-v)); }
  __syncthreads();
  const int kp = F.tid / 24, cl = F.tid % 24;
  const int gcol = item * 24 + cl, l = gcol / 3072, col = gcol % 3072;
  if (kp < 21) {
    const float* w = opq(a.in[5]) + (size_t)l * 1024 * 3072 + col;
    float acc[5] = {0.f, 0.f, 0.f, 0.f, 0.f};
#pragma unroll 8
    for (int k = kp; k < 1024; k += 21) { const float wv = w[(size_t)k * 3072];
#pragma unroll
      for (int r = 0; r < 5; ++r) acc[r] += s[r * 1024 + k] * wv; }
#pragma unroll
    for (int r = 0; r < 5; ++r) red[(kp * 24 + cl) * 5 + r] = acc[r];
  }
  __syncthreads();
  if (F.tid < 120) {
    const int cl2 = F.tid / 5, r = F.tid % 5; float t = 0.f;
    for (int q = 0; q < 21; ++q) t += red[(q * 24 + cl2) * 5 + r];
    const int g2 = item * 24 + cl2, l2 = g2 / 3072, col2 = g2 % 3072;
    float* MOD = (float*)(opq(a.ws) + WS_MOD);
    MOD[((size_t)l2 * 5 + r) * 3072 + col2] = t + opq(a.in[6])[l2 * 3072 + col2];
  }
  __syncthreads();
}
__device__ __forceinline__ int rope_perm(int n) { return 16 * ((n >> 2) & 1) + 4 * (n >> 3) + (n & 3); }
__device__ __forceinline__ void p0_tr_item(const float* W, int ldw, int cbase, int permkind, float scale, bf16* dst, int k0, LAS float* scr, int lane) {
  { float t_[32];
#pragma unroll
    for (int i = 0; i < 32; ++i) t_[i] = W[(size_t)(k0 + 2 * i + (lane >> 5)) * ldw + cbase + (lane & 31)];
#pragma unroll
    for (int i = 0; i < 32; ++i) scr[(2 * i + (lane >> 5)) * 33 + (lane & 31)] = t_[i]; }
  asm volatile("s_waitcnt lgkmcnt(0)" ::: "memory");
  const int c = lane & 7;
#pragma unroll
  for (int j = 0; j < 4; ++j) { const int n = (lane >> 3) + 8 * j; const int sidx = permkind ? rope_perm(n) : n; const LAS float* sp = scr + (8 * c) * 33 + sidx;
    u32x4 o; o.x = pk2(sp[0 * 33] * scale, sp[1 * 33] * scale); o.y = pk2(sp[2 * 33] * scale, sp[3 * 33] * scale); o.z = pk2(sp[4 * 33] * scale, sp[5 * 33] * scale); o.w = pk2(sp[6 * 33] * scale, sp[7 * 33] * scale);
    *(u32x4*)(dst + (size_t)n * 1024 + k0 + 8 * c) = o; }
  asm volatile("s_waitcnt lgkmcnt(0)" ::: "memory");
}
__device__ __forceinline__ void p0_la_item(const float* Win, const float* decw  , int dir, int j0, bf16* dst, int k0, LAS float* scr, int lane) {
  float dw[16];
#pragma unroll
  for (int r = 0; r < 16; ++r) dw[r] = decw[(dir * 16 + r) * 128 + j0 + (lane & 31)];
#pragma unroll 4
  for (int i = 0; i < 32; ++i) { const int kk = 2 * i + (lane >> 5); const float* wp = Win + (size_t)(k0 + kk) * PWW + O_LR + dir * 16; float acc = 0.f;
#pragma unroll
    for (int r = 0; r < 16; ++r) acc += wp[r] * dw[r];
    scr[kk * 33 + (lane & 31)] = acc; }
  asm volatile("s_waitcnt lgkmcnt(0)" ::: "memory");
  const int c = lane & 7;
#pragma unroll
  for (int j = 0; j < 4; ++j) { const int n = (lane >> 3) + 8 * j; const LAS float* sp = scr + (8 * c) * 33 + n;
    u32x4 o; o.x = pk2(sp[0 * 33], sp[1 * 33]); o.y = pk2(sp[2 * 33], sp[3 * 33]); o.z = pk2(sp[4 * 33], sp[5 * 33]); o.w = pk2(sp[6 * 33], sp[7 * 33]);
    *(u32x4*)(dst + (size_t)n * 1024 + k0 + 8 * c) = o; }
  asm volatile("s_waitcnt lgkmcnt(0)" ::: "memory");
}
constexpr int FA_AST = 528, FA_WST = 528;
__device__ __forceinline__ void p0_fa_item(const Frame& F, const Args& a, int item) {
  const int l = item >> 4, pn = 4 + ((item >> 3) & 1), g32 = item & 7, bj = g32 >> 2, wc = g32 & 3;
  LAS float* cs = (LAS float*)F.lds; LAS float* sn = cs + 64; LAS float* wfl = sn + 64;
  LAS unsigned char* Ai = F.lds + 512 + 16384;
  LAS unsigned char* Wi = F.lds + F.wave * (32 * FA_WST);
  __syncthreads();
  if (F.tid < 64) { float s_, c_; sincospif(2.f * F.tid / 64.f, &s_, &c_); cs[F.tid] = c_; sn[F.tid] = s_; }
  const float* wf = opq(a.in[12]) + (size_t)l * 256 * 256;
  const int slice0 = 32 * (pn - 4) + 16 * bj + 4 * wc;
  for (int i = F.tid; i < 1024; i += 512) { const int r = i >> 2, q = i & 3; *(LAS f32x4*)(wfl + r * 16 + 4 * q) = *(const f32x4*)(wf + (size_t)r * 256 + 4 * slice0 + 4 * q); }
  __syncthreads();
  {
    const int c = F.tid & 255, part = F.tid >> 8, g = c >> 6, jj = c & 63;
    f32x4 acc[4];
#pragma unroll
    for (int q = 0; q < 4; ++q) acc[q] = (f32x4){0.f, 0.f, 0.f, 0.f};
#pragma unroll 4
    for (int m = 0; m < 64; ++m) { const int idx = (m * jj) & 63; const float t = part ? -sn[idx] : cs[idx];
#pragma unroll
      for (int q = 0; q < 4; ++q) acc[q] += t * *(LAS const f32x4*)(wfl + (g * 64 + m) * 16 + 4 * q); }
#pragma unroll
    for (int fq = 0; fq < 4; ++fq)
#pragma unroll
      for (int j = 0; j < 4; ++j) *(LAS unsigned short*)(Ai + (8 * fq + 4 * part + j) * FA_AST + c * 2) = (unsigned short)f2bf(acc[fq][j] * 0.125f);
  }
  __syncthreads();
  const int r32 = F.lane & 31, hi = F.lane >> 5;
  bf16x8 af[16];
#pragma unroll
  for (int s = 0; s < 16; ++s) af[s] = *(LAS const bf16x8*)(Ai + r32 * FA_AST + (16 * s + 8 * hi) * 2);
  __syncthreads();
  const float* Win = opq(a.in[7]) + (size_t)l * 1024 * PWW + O_BV;
  bf16* dst = (bf16*)(opq(a.ws) + WS_W1T) + ((size_t)l * N1 + pn * 256 + 32 * g32) * 1024;
  for (int kb = 0; kb < 4; ++kb) {
    const int k0 = F.wave * 128 + kb * 32;
#pragma unroll
    for (int rh = 0; rh < 2; ++rh) { f32x4 w[16];
#pragma unroll
      for (int r = 0; r < 16; ++r) w[r] = *(const f32x4*)(Win + (size_t)(k0 + 16 * rh + r) * PWW + 4 * F.lane);
#pragma unroll
      for (int r = 0; r < 16; ++r) *(LAS u32x2*)(Wi + (16 * rh + r) * FA_WST + 8 * F.lane) = (u32x2){pk2(w[r].x, w[r].y), pk2(w[r].z, w[r].w)}; }
    asm volatile("s_waitcnt lgkmcnt(0)" ::: "memory");
    f32x16 acc;
#pragma unroll
    for (int i = 0; i < 16; ++i) acc[i] = 0.f;
#pragma unroll
    for (int s = 0; s < 16; ++s) { const bf16x8 bfr = *(LAS const bf16x8*)(Wi + r32 * FA_WST + (16 * s + 8 * hi) * 2); acc = __builtin_amdgcn_mfma_f32_32x32x16_bf16(af[s], bfr, acc, 0, 0, 0); }
#pragma unroll
    for (int r = 0; r < 16; ++r) dst[(size_t)crow(r, hi) * 1024 + k0 + r32] = (bf16)f2bf(acc[r]);
    asm volatile("s_waitcnt lgkmcnt(0)" ::: "memory");
  }
  __syncthreads();
}
#ifndef P0_REPS
#define P0_REPS 1
#endif
__device__ __forceinline__ void p0_prologue(const Frame& F0, const Args& a) {
#pragma clang loop unroll(disable)
 for (int rep_ = 0; rep_ < P0_REPS; ++rep_) {
  const Frame F = relaunder(F0);
  unsigned char* ws = opq(a.ws);
#ifndef RP_T
#define RP_T 1
#endif
  for (int q_ = 0; q_ < RP_T; ++q_)
  { const int gt = F.vcu * 512 + F.tid, GT = F.G * 512;
    float* rope = (float*)(ws + WS_ROPE);
    for (int i = gt; i < 1024; i += GT) { const int pos = i >> 4, f = i & 15; const float ang = (float)pos * powf(10000.f, -(float)f / 16.f); rope[i] = cosf(ang); rope[1024 + i] = sinf(ang); }
    bf16* wc = (bf16*)(ws + WS_WC);
    for (int i = gt; i < 128 * 128; i += GT) { const int r = i >> 7, c = i & 127, rr = r & 63, cc = c & 63; float s_, c_; sincospif(2.f * (float)((rr * cc) & 63) / 64.f, &s_, &c_);
      float v; if (r < 64) v = c < 64 ? c_ : s_; else v = c < 64 ? -s_ : c_; wc[i] = (bf16)f2bf(v * 0.125f); }
    bf16* cs256 = (bf16*)(ws + WS_CS256);
    for (int i = gt; i < 256 * 512; i += GT) { const int k = i >> 9, n = i & 511, nn = n & 255; float s_, c_; sincospif(2.f * (float)((k * nn) & 255) / 256.f, &s_, &c_); cs256[i] = (bf16)f2bf((n < 256 ? c_ : s_) * 0.0625f); }
  }
#ifndef RP_A
#define RP_A 1
#define RP_F 1
#define RP_W 1
#endif
  for (int it = F.vcu; it < 256 + 32; it += F.G) { if (it < 256) { for (int q_ = 0; q_ < RP_A; ++q_) p0_ada_item(F, a, it); } else { for (int q_ = 0; q_ < RP_F; ++q_) p0_fa_item(F, a, it - 256); } }
  LAS float* scr = (LAS float*)(F.lds + F.wave * 16384);
  const int gw = F.vcu * 8 + F.wave, NGW = F.G * 8;
  constexpr int I_DIR = 11 * 8 * 16, I_LA = 8 * 16, I_W2 = 32 * 16, I_L = I_DIR + I_LA + I_W2;
  for (int q_ = 0; q_ < RP_W; ++q_)
  for (int it = gw; it < 2 * I_L; it += NGW) {
    const int l = it / I_L; int r = it % I_L;
    const float* Win = opq(a.in[7]) + (size_t)l * 1024 * PWW;
    bf16* W1T = (bf16*)(ws + WS_W1T) + (size_t)l * N1 * 1024;
    if (r < I_DIR) {
      const int ti = r / 128, g32 = (r >> 4) & 7, kb = r & 15;
      const int pn = ti < 3 ? ti : ti + 3;
      const int bj = g32 >> 2, wc = g32 & 3, mcb = 64 * wc + 32 * bj;
      int cbase = 0, pk = 0; float sc = 1.f;
      switch (pn) {
        case 0: if (mcb < 128) { cbase = O_AQ + mcb; sc = GLA_QS; } else cbase = O_AK + mcb - 128; break;
        case 1: cbase = O_AV + mcb; break;
        case 2: cbase = O_AG + mcb; break;
        case 6: cbase = O_BG + mcb; break;
        case 7: cbase = O_CQ + mcb; pk = 1; break;
        case 8: if (wc < 2) { cbase = O_CK + mcb; pk = 1; } else cbase = O_CV + mcb - 128; break;
        case 9: cbase = O_CG + mcb; break;
        case 10: cbase = O_DQ + mcb; break;
        case 11: cbase = O_DK + mcb; break;
        case 12: cbase = O_DV + mcb; break;
        default: cbase = O_DG + mcb; break;
      }
      p0_tr_item(Win, PWW, cbase, pk, sc, W1T + (size_t)(pn * 256 + 32 * g32) * 1024, kb * 64, scr, F.lane);
    } else if (r < I_DIR + I_LA) {
      r -= I_DIR; const int g32 = r >> 4, kb = r & 15, bj = g32 >> 2, wc = g32 & 3, mcb = 64 * wc + 32 * bj;
      p0_la_item(Win, opq(a.in[9]) + (size_t)l * 2 * 16 * 128, mcb >> 7, mcb & 127, W1T + (size_t)(3 * 256 + 32 * g32) * 1024, kb * 64, scr, F.lane);
    } else {
      r -= I_DIR + I_LA; const int g = r >> 4, kb = r & 15;
      p0_tr_item(opq(a.in[8]) + (size_t)l * 1024 * 1024, 1024, 32 * g, 0, 1.f, (bf16*)(ws + WS_W2T) + ((size_t)l * 1024 + 32 * g) * 1024, kb * 64, scr, F.lane);
    }
  }
 }
}
__device__ __forceinline__ void p1_prenorm(const Frame& F0, const Args& a, int layer) {
  const Frame F = relaunder(F0);
  const float* xin = layer == 0 ? opq(a.in[0]) : opq(a.out);
  const float* cin = layer == 0 ? opq(a.in[2]) : (const float*)(opq(a.ws) + WS_CTX1);
  const float* nw = opq(a.in[4]) + layer * 1024;
  const float* MOD = (const float*)(opq(a.ws) + WS_MOD) + (size_t)layer * 5 * 3072;
  bf16* H = (bf16*)(opq(a.ws) + WS_H);
  const int gw = F.vcu * 8 + F.wave, NGW = F.G * 8;
  constexpr int RB = 3;
  f32x4 w_[4];
#pragma unroll
  for (int j = 0; j < 4; ++j) w_[j] = *(const f32x4*)(nw + 4 * F.lane + 256 * j);
  for (int row0 = gw; row0 < MT; row0 += RB * NGW) {
    f32x4 v[RB][4], sc_[RB][4], sh_[RB][4]; float ss[RB];
#pragma unroll
    for (int q = 0; q < RB; ++q) { int row = row0 + q * NGW; row = row < MT ? row : MT - 1;
      const float* src; const float* mod;
      if (row < MLAT) { src = xin + (size_t)row * 1024; mod = MOD + (size_t)(row >> 12) * 3072; }
      else { src = cin + (size_t)(row - MLAT) * 1024; mod = MOD + (size_t)4 * 3072; }
      const f32x4* xr = (const f32x4*)src + F.lane;
#pragma unroll
      for (int j = 0; j < 4; ++j) { v[q][j] = xr[64 * j]; sc_[q][j] = *(const f32x4*)(mod + 1024 + 4 * F.lane + 256 * j); sh_[q][j] = *(const f32x4*)(mod + 4 * F.lane + 256 * j); } }
    __builtin_amdgcn_sched_barrier(0);
#pragma unroll
    for (int q = 0; q < RB; ++q) { float s_ = 0.f;
#pragma unroll
      for (int j = 0; j < 4; ++j) s_ += (v[q][j].x * v[q][j].x + v[q][j].y * v[q][j].y) + (v[q][j].z * v[q][j].z + v[q][j].w * v[q][j].w);
      ss[q] = s_; }
#pragma unroll
    for (int o = 1; o < 64; o <<= 1)
#pragma unroll
      for (int q = 0; q < RB; ++q) ss[q] += __shfl_xor(ss[q], o);
#pragma unroll
    for (int q = 0; q < RB; ++q) { const int row = row0 + q * NGW; if (row >= MT) continue;
      const float rs = 1.0f / sqrtf(ss[q] * (1.f / 1024.f) + 1e-6f);
      unsigned long long* o8 = (unsigned long long*)(H + (size_t)row * 1024) + F.lane;
#pragma unroll
      for (int j = 0; j < 4; ++j) {
        const f32x4 h = v[q][j] * rs * w_[j] * (1.f + sc_[q][j]) + sh_[q][j];
        o8[64 * j] = (unsigned long long)pk2(h.x, h.y) | ((unsigned long long)pk2(h.z, h.w) << 32);
      } }
  }
}
}

namespace mk {
using pg8::Unit;
struct EpiIn {
  static constexpr bool PERM = true, AFTER_DRAIN = false;
  bf16* PLB; float* LA; bf16* FA2; const float* decb; const float* rope; const float* cqn; const float* ckn; const float* dqn; const float* dkn;
  __device__ __forceinline__ void operator()(const f32x4 (&acc)[2][2][4][2], const Unit& u, int wr, int wc, int fr, int fq) const {
    const int pn = u.pn;
    const bool ctxrows = u.pm >= 64;
    int kind, slot = 0; const float* nw = nullptr; bool roped = false; float qs = 1.f;
    switch (pn) {
      case 0: kind = 0; slot = S_AQK; break;
      case 1: kind = 0; slot = S_AV; break;
      case 2: kind = 1; slot = S_AG; break;
      case 3: kind = 2; break;
      case 4: case 5: kind = 3; break;
      case 6: kind = 1; slot = S_BG; break;
      case 7: kind = 4; slot = S_CQ; nw = cqn; roped = true; qs = QSCALE; break;
      case 8: slot = S_CKV; if (wc < 2) { kind = 4; nw = ckn; roped = true; } else kind = 0; break;
      case 9: kind = 1; slot = S_CG; break;
      case 10: kind = 4; slot = S_DQ; nw = dqn; qs = QSCALE; break;
      case 11: kind = 4; slot = S_DK; nw = dkn; break;
      case 12: kind = 0; slot = S_DV; break;
      default: kind = 1; slot = S_DG; break;
    }
    const int row0 = u.pm * 256 + wr * 64 + fr;
    float w8[2][8];
    if (kind == 4) {
#pragma unroll
      for (int bj = 0; bj < 2; ++bj)
#pragma unroll
        for (int s = 0; s < 8; ++s) { const int d = roped ? (32 * bj + 16 * (s >> 2) + 4 * fq + (s & 3)) : (32 * bj + 8 * fq + s); w8[bj][s] = nw[d] * qs; }
    }
#pragma unroll
    for (int ai = 0; ai < 2; ++ai)
#pragma unroll
      for (int m = 0; m < 4; ++m) {
        const int r = row0 + ai * 128 + m * 16;
        float v[2][8];
#pragma unroll
        for (int bj = 0; bj < 2; ++bj)
#pragma unroll
          for (int n = 0; n < 2; ++n)
#pragma unroll
            for (int e = 0; e < 4; ++e) v[bj][4 * n + e] = acc[ai][bj][m][n][e];
        if (kind == 2) {
#pragma unroll
          for (int bj = 0; bj < 2; ++bj) { const int mc = 64 * wc + 32 * bj + 8 * fq; float* dp = LA + (size_t)r * 256 + mc;
            f32x4 o0, o1;
#pragma unroll
            for (int e = 0; e < 4; ++e) { o0[e] = flogsig(v[bj][e] + decb[mc + e]) * 0.0625f; o1[e] = flogsig(v[bj][4 + e] + decb[mc + 4 + e]) * 0.0625f; }
            *(f32x4*)dp = o0; *(f32x4*)(dp + 4) = o1; }
        } else if (kind == 3) {
          int b, t; if (!ctxrows) { b = r >> 12; t = r & 4095; } else { const int rc = r - MLAT; b = rc >> 8; t = SEQ + (rc & 255); }
#pragma unroll
          for (int bj = 0; bj < 2; ++bj) { const int slice = 32 * (pn - 4) + 16 * bj + 4 * wc + fq;
            u32x4 o; o.x = pk2(v[bj][0], v[bj][1]); o.y = pk2(v[bj][2], v[bj][3]); o.z = pk2(v[bj][4], v[bj][5]); o.w = pk2(v[bj][6], v[bj][7]);
            *(u32x4*)(FA2 + (((size_t)b * 64 + slice) * TROW + t) * 8) = o; }
        } else {
          if (kind == 1) {
#pragma unroll
            for (int bj = 0; bj < 2; ++bj)
#pragma unroll
              for (int s = 0; s < 8; ++s) v[bj][s] = fsilu(v[bj][s]);
          } else if (kind == 4) {
            float ss = 0.f;
#pragma unroll
            for (int bj = 0; bj < 2; ++bj)
#pragma unroll
              for (int s = 0; s < 8; ++s) ss += v[bj][s] * v[bj][s];
            ss += __shfl_xor(ss, 16); ss += __shfl_xor(ss, 32);
            const float rs = 1.0f / sqrtf(ss * (1.f / 64.f) + 1e-6f);
#pragma unroll
            for (int bj = 0; bj < 2; ++bj)
#pragma unroll
              for (int s = 0; s < 8; ++s) v[bj][s] *= rs * w8[bj][s];
            if (roped && !ctxrows) {
              const int t = r & 4095;
#pragma unroll
              for (int bj = 0; bj < 2; ++bj) { const int pos = bj == 0 ? (t >> 6) : (t & 63);
                const f32x4 c4 = *(const f32x4*)(rope + pos * 16 + 4 * fq), s4 = *(const f32x4*)(rope + 1024 + pos * 16 + 4 * fq);
#pragma unroll
                for (int e = 0; e < 4; ++e) { const float x1 = v[bj][e], x2 = v[bj][4 + e]; v[bj][e] = x1 * c4[e] - x2 * s4[e]; v[bj][4 + e] = x2 * c4[e] + x1 * s4[e]; } }
            }
          }
#pragma unroll
          for (int bj = 0; bj < 2; ++bj) { const int mc = 64 * wc + 32 * bj + 8 * fq;
            u32x4 o; o.x = pk2(v[bj][0], v[bj][1]); o.y = pk2(v[bj][2], v[bj][3]); o.z = pk2(v[bj][4], v[bj][5]); o.w = pk2(v[bj][6], v[bj][7]);
            *(u32x4*)(PLB + (size_t)r * PLW + slot * 256 + mc) = o; }
        }
        asm volatile("" ::: "memory");
      }
  }
};
struct EpiOut {
  static constexpr bool PERM = true, AFTER_DRAIN = false;
  const float* xin; const float* cin; float* xout; float* cout; const float* MODl;
  __device__ __forceinline__ void operator()(const f32x4 (&acc)[2][2][4][2], const Unit& u, int wr, int wc, int fr_, int fq_) const {
    int fr = fr_, fq = fq_; asm volatile("" : "+v"(fr), "+v"(fq));
    const int row0 = u.pm * 256 + wr * 64 + fr, col0 = u.pn * 256 + wc * 32 + 8 * fq;
    const bool ctxrows = u.pm >= 64;
    const float* gate = MODl + (size_t)(ctxrows ? 4 : (u.pm >> 4)) * 3072 + 2048;
    f32x4 gv[2][2];
#pragma unroll
    for (int bj = 0; bj < 2; ++bj)
#pragma unroll
      for (int n = 0; n < 2; ++n) gv[bj][n] = *(const f32x4*)(gate + col0 + bj * 128 + n * 4);
#pragma unroll
    for (int ai = 0; ai < 2; ++ai)
#pragma unroll
      for (int m = 0; m < 4; ++m) {
        const int r = row0 + ai * 128 + m * 16;
        const float* sp; float* dp;
        if (!ctxrows) { sp = xin + (size_t)r * 1024 + col0; dp = xout + (size_t)r * 1024 + col0; }
        else { sp = cin + (size_t)(r - MLAT) * 1024 + col0; dp = cout + (size_t)(r - MLAT) * 1024 + col0; }
        f32x4 xv[2][2];
#pragma unroll
        for (int bj = 0; bj < 2; ++bj)
#pragma unroll
          for (int n = 0; n < 2; ++n) xv[bj][n] = *(const f32x4*)(sp + bj * 128 + n * 4);
#pragma unroll
        for (int bj = 0; bj < 2; ++bj)
#pragma unroll
          for (int n = 0; n < 2; ++n) *(f32x4*)(dp + bj * 128 + n * 4) = xv[bj][n] + gv[bj][n] * acc[ai][bj][m][n];
        asm volatile("" ::: "memory");
      }
  }
};
__device__ __forceinline__ void p2_inproj(const Frame& F, const Args& a, int layer) {
  unsigned char* ws = opq(a.ws);
  pg8::Gemm g{(const pg8::bf16_t*)(ws + WS_H), (const pg8::bf16_t*)(ws + WS_W1T) + (size_t)layer * N1 * 1024, MT, N1, 1024};
  pg8::StaticOrder S; S.init(MT, N1, F.G, (int)blockIdx.x);
  EpiIn E{(bf16*)(ws + WS_PLB), (float*)(ws + WS_LA), (bf16*)(ws + WS_FA2), opq(a.in[10]) + layer * 256, (const float*)(ws + WS_ROPE),
          opq(a.in[13]) + layer * 64, opq(a.in[14]) + layer * 64, opq(a.in[16]) + layer * 64, opq(a.in[17]) + layer * 64};
#ifndef P2_REPS
#define P2_REPS 1
#endif
#pragma clang loop unroll(disable)
  for (int rep_ = 0; rep_ < P2_REPS; ++rep_) pg8::gemm_phase<EpiIn, pg8::StaticOrder>(F.lds, g, S, E, nullptr);
}

__device__ __forceinline__ void ctx_out_item(const Frame& F, const Args& a, int item) {
  unsigned char* ws = opq(a.ws);
  const bf16* Yc = (const bf16*)(ws + WS_H) + (size_t)MLAT * 1024; const bf16* W2 = (const bf16*)(ws + WS_W2T);
  const int tm = item >> 4, tn = item & 15, sub = F.wave & 3, kh = F.wave >> 2, r32 = F.lane & 31, hi = F.lane >> 5;
  const int row0 = 64 * tm + 32 * (sub >> 1), col0 = 64 * tn + 32 * (sub & 1);
  const bf16* ap = Yc + (size_t)(row0 + r32) * 1024 + kh * 512 + 8 * hi;
  const bf16* bp = W2 + (size_t)(col0 + r32) * 1024 + kh * 512 + 8 * hi;
  f32x16 acc;
#pragma unroll
  for (int i = 0; i < 16; ++i) acc[i] = 0.f;
#pragma unroll 1
  for (int sb = 0; sb < 4; ++sb) {
    bf16x8 af[8], bf[8];
#pragma unroll
    for (int s = 0; s < 8; ++s) { af[s] = *(const bf16x8*)(ap + (sb * 8 + s) * 16); bf[s] = *(const bf16x8*)(bp + (sb * 8 + s) * 16); }
    __builtin_amdgcn_sched_barrier(0);
#pragma unroll
    for (int s = 0; s < 8; ++s) acc = __builtin_amdgcn_mfma_f32_32x32x16_bf16(af[s], bf[s], acc, 0, 0, 0);
  }
  LAS float* X = (LAS float*)F.lds + sub * 1024;
  __syncthreads();
  if (kh == 1) {
#pragma unroll
    for (int r = 0; r < 16; ++r) X[r * 64 + F.lane] = acc[r];
  }
  __syncthreads();
  if (kh == 0) {
    const float* cin = opq(a.in[2]); float* cout = (float*)(ws + WS_CTX1);
    const float gate = ((const float*)(ws + WS_MOD))[4 * 3072 + 2048 + col0 + r32];
    float ci[16];
#pragma unroll
    for (int r = 0; r < 16; ++r) ci[r] = cin[(size_t)(row0 + crow(r, hi)) * 1024 + col0 + r32];
    __builtin_amdgcn_sched_barrier(0);
#pragma unroll
    for (int r = 0; r < 16; ++r) { const size_t o = (size_t)(row0 + crow(r, hi)) * 1024 + col0 + r32; cout[o] = ci[r] + gate * (acc[r] + X[r * 64 + F.lane]); }
  }
}
__device__ __forceinline__ void p5_outproj(const Frame& F, const Args& a, int layer) {
  unsigned char* ws = opq(a.ws);
  const int M = MLAT;
  pg8::Gemm g{(const pg8::bf16_t*)(ws + WS_H), (const pg8::bf16_t*)(ws + WS_W2T) + (size_t)layer * 1024 * 1024, M, 1024, 1024};
  pg8::StaticOrder S; S.init(M, 1024, F.G, (int)blockIdx.x);
  EpiOut E{layer == 0 ? opq(a.in[0]) : opq(a.out), layer == 0 ? opq(a.in[2]) : (const float*)(ws + WS_CTX1), opq(a.out), (float*)(ws + WS_CTX1), (const float*)(ws + WS_MOD) + (size_t)layer * 5 * 3072};
#ifndef P5_REPS
#define P5_REPS 1
#endif
#pragma clang loop unroll(disable)
  for (int rep_ = 0; rep_ < (layer == 0 ? P5_REPS : 1); ++rep_) pg8::gemm_phase<EpiOut, pg8::StaticOrder>(F.lds, g, S, E, nullptr);
  if (layer == 0) { const Frame F2 = relaunder(F); for (int it = F2.vcu; it < 256; it += F2.G) ctx_out_item(F2, a, it); }
}
}

namespace mk {
typedef short v4i16_t __attribute__((ext_vector_type(4)));
__device__ __forceinline__ s16x4 vtr(LAS const unsigned char* p) { return __builtin_bit_cast(s16x4, __builtin_amdgcn_ds_read_tr16_b64_v4i16((LAS v4i16_t*)p)); }
struct AttnState { float m, l; f32x16 o0, o1; };
template <class MaskF>
__device__ __forceinline__ void attn_tile(AttnState& st, const bf16x8 (&qf)[4], LAS const unsigned char* Kt, LAS const unsigned char* Vt, int lane, MaskF&& maskf) {
  constexpr float THR = 8.f;
  const int r32 = lane & 31, hi = lane >> 5;
  f32x16 p0, p1;
  const int ksw = (r32 >> 1) & 7;
  bf16x8 ka[4], kb[4];
#pragma unroll
  for (int s = 0; s < 4; ++s) { const int ch = ((2 * s + hi) ^ ksw) << 4; ka[s] = *(LAS const bf16x8*)(Kt + r32 * 128 + ch); kb[s] = *(LAS const bf16x8*)(Kt + (32 + r32) * 128 + ch); }
  { const f32x16 z = {0.f, 0.f, 0.f, 0.f, 0.f, 0.f, 0.f, 0.f, 0.f, 0.f, 0.f, 0.f, 0.f, 0.f, 0.f, 0.f};
    p0 = __builtin_amdgcn_mfma_f32_32x32x16_bf16(ka[0], qf[0], z, 0, 0, 0); p1 = __builtin_amdgcn_mfma_f32_32x32x16_bf16(kb[0], qf[0], z, 0, 0, 0); }
#pragma unroll
  for (int s = 1; s < 4; ++s) { p0 = __builtin_amdgcn_mfma_f32_32x32x16_bf16(ka[s], qf[s], p0, 0, 0, 0); p1 = __builtin_amdgcn_mfma_f32_32x32x16_bf16(kb[s], qf[s], p1, 0, 0, 0); }
  maskf(p0, p1);
  if (__builtin_expect(__any(st.m != 0.f), 0)) {
#pragma unroll
    for (int i = 0; i < 16; ++i) { p0[i] -= st.m; p1[i] -= st.m; }
  }
  float tm = fmaxf(p0[0], p1[0]);
#pragma unroll
  for (int i = 1; i < 16; ++i) tm = fmaxf(tm, fmaxf(p0[i], p1[i]));
  tm = fmaxf(tm, __shfl_xor(tm, 32));
  if (__builtin_expect(__any(tm > THR), 0)) {
    const float delta = fmaxf(tm, 0.f), alpha = __builtin_amdgcn_exp2f(-delta);
    st.m += delta; st.l *= alpha;
#pragma unroll
    for (int i = 0; i < 16; ++i) { p0[i] -= delta; p1[i] -= delta; st.o0[i] *= alpha; st.o1[i] *= alpha; }
  }
  float ps = 0.f;
#pragma unroll
  for (int i = 0; i < 16; ++i) { p0[i] = __builtin_amdgcn_exp2f(p0[i]); p1[i] = __builtin_amdgcn_exp2f(p1[i]); ps += p0[i] + p1[i]; }
  st.l += ps;
  u32x4 pw[4];
#pragma unroll
  for (int k = 0; k < 2; ++k) {
    pw[k] = (u32x4){pk2(p0[8 * k + 0], p0[8 * k + 1]), pk2(p0[8 * k + 2], p0[8 * k + 3]), pk2(p0[8 * k + 4], p0[8 * k + 5]), pk2(p0[8 * k + 6], p0[8 * k + 7])};
    pw[2 + k] = (u32x4){pk2(p1[8 * k + 0], p1[8 * k + 1]), pk2(p1[8 * k + 2], p1[8 * k + 3]), pk2(p1[8 * k + 4], p1[8 * k + 5]), pk2(p1[8 * k + 6], p1[8 * k + 7])};
  }
  const int q = (lane & 15) >> 2, p = lane & 3, gsel = (lane >> 4) & 1;
  const int vrow = (4 * hi + q) * 128 + 8 * (p & 1);
  const int chb = 2 * gsel + (p >> 1);
#pragma unroll
  for (int ks = 0; ks < 4; ++ks) {
    const int c0_ = ((chb | ((0 ^ (q >> 1)) << 2)) << 4), c1_ = ((chb | ((1 ^ (q >> 1)) << 2)) << 4);
    const s16x4 l0 = vtr(Vt + ks * 2048 + vrow + c0_), h0 = vtr(Vt + ks * 2048 + 1024 + vrow + c0_), l1 = vtr(Vt + ks * 2048 + vrow + c1_), h1 = vtr(Vt + ks * 2048 + 1024 + vrow + c1_);
    const bf16x8 va0 = (bf16x8){l0[0], l0[1], l0[2], l0[3], h0[0], h0[1], h0[2], h0[3]}, va1 = (bf16x8){l1[0], l1[1], l1[2], l1[3], h1[0], h1[1], h1[2], h1[3]};
    st.o0 = __builtin_amdgcn_mfma_f32_32x32x16_bf16(va0, __builtin_bit_cast(bf16x8, pw[ks]), st.o0, 0, 0, 0);
    st.o1 = __builtin_amdgcn_mfma_f32_32x32x16_bf16(va1, __builtin_bit_cast(bf16x8, pw[ks]), st.o1, 0, 0, 0);
  }
}
__device__ __forceinline__ void attn_store(const AttnState& st, float inv, const bf16* grow  , bf16* yrow  , int lane) {
  const int hi = lane >> 5;
  u32x2 gv[8];
#pragma unroll
  for (int i = 0; i < 8; ++i) gv[i] = *(const u32x2*)(grow + 32 * (i >> 2) + 8 * (i & 3) + 4 * hi);
  __builtin_amdgcn_sched_barrier(0);
#pragma unroll
  for (int d0 = 0; d0 < 2; ++d0)
#pragma unroll
    for (int gi = 0; gi < 4; ++gi) {
      const int db = 32 * d0 + 8 * gi + 4 * hi; const u32x2 g = gv[4 * d0 + gi];
      const f32x16& o = d0 == 0 ? st.o0 : st.o1;
      const float g0 = __uint_as_float(g.x << 16), g1 = __uint_as_float(g.x & 0xffff0000u), g2 = __uint_as_float(g.y << 16), g3 = __uint_as_float(g.y & 0xffff0000u);
      u32x2 ov; ov.x = pk2(o[4 * gi + 0] * inv * g0, o[4 * gi + 1] * inv * g1); ov.y = pk2(o[4 * gi + 2] * inv * g2, o[4 * gi + 3] * inv * g3);
      *(u32x2*)(yrow + db) = ov;
    }
}
template <int NH> struct TileRegs { u32x4 k[NH], v[NH]; };
template <int NH>
__device__ __forceinline__ void tile_load(TileRegs<NH>& R, const bf16* kbase  , const bf16* vbase, int tid) {
  const int key = tid >> 3, ch = tid & 7;
#pragma unroll
  for (int h = 0; h < NH; ++h) { R.k[h] = *(const u32x4*)(kbase + (size_t)key * PLW + h * 64 + ch * 8); R.v[h] = *(const u32x4*)(vbase + (size_t)key * PLW + h * 64 + ch * 8); }
}
template <int NH>
__device__ __forceinline__ void tile_store(const TileRegs<NH>& R, LAS unsigned char* buf, int tid) {
  const int key = tid >> 3, ch = tid & 7;
  const int ko = key * 128 + ((ch ^ ((key >> 1) & 7)) << 4), vo = key * 128 + ((ch ^ (((key >> 1) & 1) << 2)) << 4);
#pragma unroll
  for (int h = 0; h < NH; ++h) { *(LAS u32x4*)(buf + h * 8192 + ko) = R.k[h]; *(LAS u32x4*)(buf + NH * 8192 + h * 8192 + vo) = R.v[h]; }
}

__device__ __forceinline__ void swa_item(const Frame& F0, const Args& a, int layer, int item) {
  const Frame F = relaunder(F0);
  unsigned char* ws = opq(a.ws);
  const bf16* PLB = (const bf16*)(ws + WS_PLB); bf16* Y = (bf16*)(ws + WS_H);
  const bool isctx = item >= 256;
  int b, kvh, n;
  if (!isctx) { b = item >> 6; kvh = (item >> 5) & 1; n = item & 31; } else { const int ci = item - 256; b = ci >> 2; kvh = (ci >> 1) & 1; n = ci & 1; }
  const int g = F.wave >> 2, quarter = F.wave & 3, hq = 2 * kvh + g, r32 = F.lane & 31, hi = F.lane >> 5;
  const int tq = 128 * n + 32 * quarter + r32;
  const size_t qrow = isctx ? (size_t)MLAT + b * CTX + tq : (size_t)b * SEQ + tq;
  bf16x8 qf[4];
#pragma unroll
  for (int s = 0; s < 4; ++s) qf[s] = *(const bf16x8*)(PLB + qrow * PLW + S_CQ * 256 + hq * 64 + 16 * s + 8 * hi);
  int jlo = 0, jhi = 0;
  if (!isctx) { jlo = n == 0 ? 2 : 0; jhi = n == 31 ? 4 : 6; }
  const int nloc = jhi - jlo, T = nloc + 4;
  const bf16* kcol = PLB + S_CKV * 256 + kvh * 64;
  auto tile_row = [&](int t) -> size_t { return t < nloc ? (size_t)b * SEQ + 128 * (n - 1) + 64 * (jlo + t) : (size_t)MLAT + b * CTX + 64 * (t - nloc); };
  AttnState st; st.m = 0.f; st.l = 0.f;
#pragma unroll
  for (int i = 0; i < 16; ++i) { st.o0[i] = 0.f; st.o1[i] = 0.f; }
  TileRegs<1> R;
  __syncthreads();
  tile_load<1>(R, kcol + tile_row(0) * PLW, kcol + 128 + tile_row(0) * PLW, F.tid);
  tile_store<1>(R, F.lds, F.tid);
  __syncthreads();
  for (int t = 0; t < T; ++t) {
    if (t + 1 < T) tile_load<1>(R, kcol + tile_row(t + 1) * PLW, kcol + 128 + tile_row(t + 1) * PLW, F.tid);
    LAS const unsigned char* buf = F.lds + (t & 1) * 16384;
    if (t < nloc) {
      const int kb = 128 * (n - 1) + 64 * (jlo + t), q0 = 128 * n + 32 * quarter;
      if (!(kb + 63 < q0 - 128 || kb > q0 + 31 + 128)) {
        const int dq = kb - tq;
        attn_tile(st, qf, buf, buf + 8192, F.lane, [&](f32x16& p0, f32x16& p1) {
#pragma unroll
          for (int r = 0; r < 16; ++r) { const int d0_ = dq + 128 + crow(r, hi), d1_ = d0_ + 32;
            p0[r] = ((unsigned)d0_ <= 256u) ? p0[r] : -INFINITY; p1[r] = ((unsigned)d1_ <= 256u) ? p1[r] : -INFINITY; } });
      }
    } else { attn_tile(st, qf, buf, buf + 8192, F.lane, [](f32x16&, f32x16&) {});
    }
    if (t + 1 < T) tile_store<1>(R, F.lds + ((t + 1) & 1) * 16384, F.tid);
    __syncthreads();
  }
  float l = st.l + __shfl_xor(st.l, 32);
  const float sk2 = opq(a.in[15])[layer * 4 + hq] * LOG2E;
  const float mnew = fmaxf(st.m, sk2), al = __builtin_amdgcn_exp2f(st.m - mnew);
  l = l * al + __builtin_amdgcn_exp2f(sk2 - mnew);
  int qr = (int)qrow; asm volatile("" : "+v"(qr));
  attn_store(st, al / l, PLB + (size_t)qr * PLW + S_CG * 256 + hq * 64, Y + (size_t)qr * 1024 + 512 + hq * 64, F.lane);
}
__device__ __forceinline__ void na_item(const Frame& F0, const Args& a, int layer, int item) {
  const Frame F = relaunder(F0);
  unsigned char* ws = opq(a.ws);
  const bf16* PLB = (const bf16*)(ws + WS_PLB); bf16* Y = (bf16*)(ws + WS_H);
  const bool isctx = item >= 256;
  int b, r;
  if (!isctx) { b = item >> 6; r = item & 63; } else { const int ci = item - 256; b = ci >> 2; r = ci & 3; }
  const int head = F.wave >> 1, half = F.wave & 1, r32 = F.lane & 31, hi = F.lane >> 5;
  const int qc = 32 * half + r32;
  const size_t qrow = isctx ? (size_t)MLAT + b * CTX + 64 * r + qc : (size_t)b * SEQ + 64 * r + qc;
  bf16x8 qf[4];
#pragma unroll
  for (int s = 0; s < 4; ++s) qf[s] = *(const bf16x8*)(PLB + qrow * PLW + S_DQ * 256 + head * 64 + 16 * s + 8 * hi);
  int rs = r - 4; rs = rs < 0 ? 0 : (rs > 56 ? 56 : rs);
  const int nloc = isctx ? 0 : 8, T = nloc + 4;
  auto tile_row = [&](int t) -> size_t { return t < nloc ? (size_t)b * SEQ + 64 * (rs + t) : (size_t)MLAT + b * CTX + 64 * (t - nloc); };
  const bf16* kcol = PLB + S_DK * 256; const bf16* vcol = PLB + S_DV * 256;
  LAS float* btab = (LAS float*)(F.lds + 2 * 65536);
  AttnState st; st.m = 0.f; st.l = 0.f;
#pragma unroll
  for (int i = 0; i < 16; ++i) { st.o0[i] = 0.f; st.o1[i] = 0.f; }
  TileRegs<4> R;
  __syncthreads();
  { const float* rb = opq(a.in[18]) + (size_t)layer * 4 * 15 * 31; float t_[4];
#pragma unroll
    for (int i = 0; i < 4; ++i) { const int ix = F.tid + 512 * i; t_[i] = ix < 4 * 15 * 31 ? rb[ix] : 0.f; }
#pragma unroll
    for (int i = 0; i < 4; ++i) { const int ix = F.tid + 512 * i; if (ix < 4 * 15 * 31) btab[ix] = t_[i] * LOG2E; } }
  tile_load<4>(R, kcol + tile_row(0) * PLW, vcol + tile_row(0) * PLW, F.tid);
  tile_store<4>(R, F.lds, F.tid);
  __syncthreads();
  int c0 = qc - 8; c0 = c0 < 0 ? 0 : (c0 > 48 ? 48 : c0);
  for (int t = 0; t < T; ++t) {
    if (t + 1 < T) tile_load<4>(R, kcol + tile_row(t + 1) * PLW, vcol + tile_row(t + 1) * PLW, F.tid);
    LAS const unsigned char* buf = F.lds + (t & 1) * 65536;
    if (t < nloc) {
      const int dy = rs + t - r + 7;
      int c0l = c0; asm volatile("" : "+v"(c0l));
      LAS const float* bt = btab + (head * 15 + dy) * 31;
      int dxb = 15 - qc; asm volatile("" : "+v"(dxb));
      attn_tile(st, qf, buf + head * 8192, buf + 32768 + head * 8192, F.lane, [&](f32x16& p0, f32x16& p1) {
        float bb[16];
#pragma unroll
        for (int rr = 0; rr < 16; ++rr) { int i0 = crow(rr, hi) + dxb; i0 = i0 < 0 ? 0 : (i0 > 30 ? 30 : i0); bb[rr] = bt[i0]; }
#pragma unroll
        for (int rr = 0; rr < 16; ++rr) p0[rr] = ((unsigned)(crow(rr, hi) - c0l) < 16u) ? p0[rr] + bb[rr] : -INFINITY;
#pragma unroll
        for (int rr = 0; rr < 16; ++rr) { int i1 = crow(rr, hi) + 32 + dxb; i1 = i1 < 0 ? 0 : (i1 > 30 ? 30 : i1); bb[rr] = bt[i1]; }
#pragma unroll
        for (int rr = 0; rr < 16; ++rr) p1[rr] = ((unsigned)(crow(rr, hi) + 32 - c0l) < 16u) ? p1[rr] + bb[rr] : -INFINITY; });
    } else attn_tile(st, qf, buf + head * 8192, buf + 32768 + head * 8192, F.lane, [](f32x16&, f32x16&) {});
    if (t + 1 < T) tile_store<4>(R, F.lds + ((t + 1) & 1) * 65536, F.tid);
    __syncthreads();
  }
  const float l = st.l + __shfl_xor(st.l, 32);
  int qr = (int)qrow; asm volatile("" : "+v"(qr));
  attn_store(st, 1.f / l, PLB + (size_t)qr * PLW + S_DG * 256 + head * 64, Y + (size_t)qr * 1024 + 768 + head * 64, F.lane);
}
}

namespace mk {
constexpr int XT_STRIDE = 272;
constexpr int FFT_WC = 256 * XT_STRIDE;
__device__ __forceinline__ void fft_item(const Frame& F0, const Args& a, int item) {
  const Frame F = relaunder(F0);
  unsigned char* ws = opq(a.ws);
  const bf16* PLB = (const bf16*)(ws + WS_PLB); bf16* Y = (bf16*)(ws + WS_H);
  const int b = item >> 6, slice = item & 63, r32 = F.lane & 31, hi = F.lane >> 5, w = F.wave;
  LAS unsigned char* Xt = F.lds; LAS unsigned char* Wl = F.lds + FFT_WC;
  __syncthreads();
  {
    const bf16* WC = (const bf16*)(ws + WS_WC);
    u32x4 wt[4];
#pragma unroll
    for (int i = 0; i < 4; ++i) { const int idx = F.tid + 512 * i, row = idx >> 4, ch = idx & 15; wt[i] = *(const u32x4*)(WC + row * 128 + ch * 8); }
    const bf16* src = (const bf16*)(ws + WS_FA2) + ((size_t)b * 64 + slice) * TROW * 8;
    u32x4 v[8];
#pragma unroll
    for (int i = 0; i < 8; ++i) v[i] = *(const u32x4*)(src + (size_t)(F.tid + 512 * i) * 8);
    __builtin_amdgcn_sched_barrier(0);
#pragma unroll
    for (int i = 0; i < 4; ++i) { const int idx = F.tid + 512 * i, row = idx >> 4, ch = idx & 15; *(LAS u32x4*)(Wl + row * XT_STRIDE + ch * 16) = wt[i]; }
#pragma unroll
    for (int i = 0; i < 8; ++i) { const int t = F.tid + 512 * i, n1 = t >> 6, n2 = t & 63;
      const unsigned vv[4] = {v[i].x, v[i].y, v[i].z, v[i].w};
#pragma unroll
      for (int j = 0; j < 8; ++j) { const int c = j & 3, part = j >> 2; const unsigned short e = (unsigned short)((j & 1) ? (vv[j >> 1] >> 16) : (vv[j >> 1] & 0xffffu));
        *(LAS unsigned short*)(Xt + (n2 * 4 + c) * XT_STRIDE + (part * 64 + n1) * 2) = e; } }
  }
  __syncthreads();
  f32x16 acc[4];
#pragma unroll
  for (int rb = 0; rb < 4; ++rb)
#pragma unroll
    for (int i = 0; i < 16; ++i) acc[rb][i] = 0.f;
  {
    bf16x8 bf[8];
#pragma unroll
    for (int s = 0; s < 8; ++s) bf[s] = *(LAS const bf16x8*)(Xt + (32 * w + r32) * XT_STRIDE + (16 * s + 8 * hi) * 2);
#pragma unroll
    for (int rb = 0; rb < 4; ++rb)
#pragma unroll
      for (int s = 0; s < 8; ++s) { const bf16x8 af = *(LAS const bf16x8*)(Wl + (32 * rb + r32) * XT_STRIDE + (16 * s + 8 * hi) * 2); acc[rb] = __builtin_amdgcn_mfma_f32_32x32x16_bf16(af, bf[s], acc[rb], 0, 0, 0); }
  }
  __syncthreads();
  {
    const int n2 = 8 * w + (r32 >> 2), c = r32 & 3;
#pragma unroll
    for (int rbp = 0; rbp < 2; ++rbp)
#pragma unroll
      for (int r = 0; r < 16; ++r) { const int k1 = 32 * rbp + crow(r, hi); float x = (float)((k1 * n2) & 4095) * (1.f / 4096.f);
        asm volatile("" : "+v"(x) :: "memory");
        const float tc = __builtin_amdgcn_cosf(x), ts = __builtin_amdgcn_sinf(x);
        const float yr = acc[rbp][r], yi = acc[rbp + 2][r];
        const float zr = yr * tc + yi * ts, zi = yi * tc - yr * ts;
        LAS unsigned char* zp = Xt + (k1 * 4 + c) * XT_STRIDE + n2 * 2;
        *(LAS unsigned short*)zp = (unsigned short)f2bf(zr); *(LAS unsigned short*)(zp + 128) = (unsigned short)f2bf(zi); }
  }
  __syncthreads();
  f32x16 o2[2];
#pragma unroll
  for (int rb = 0; rb < 2; ++rb)
#pragma unroll
    for (int i = 0; i < 16; ++i) o2[rb][i] = 0.f;
  {
    bf16x8 bf[8];
#pragma unroll
    for (int s = 0; s < 8; ++s) bf[s] = *(LAS const bf16x8*)(Xt + (32 * w + r32) * XT_STRIDE + (16 * s + 8 * hi) * 2);
#pragma unroll
    for (int rb = 0; rb < 2; ++rb)
#pragma unroll
      for (int s = 0; s < 8; ++s) { const bf16x8 af = *(LAS const bf16x8*)(Wl + (32 * rb + r32) * XT_STRIDE + (16 * s + 8 * hi) * 2); o2[rb] = __builtin_amdgcn_mfma_f32_32x32x16_bf16(af, bf[s], o2[rb], 0, 0, 0); }
  }
  __syncthreads();
  { const int k1 = 8 * w + (r32 >> 2), c = r32 & 3;
#pragma unroll
    for (int rb = 0; rb < 2; ++rb)
#pragma unroll
      for (int r = 0; r < 16; ++r) { const int k = k1 + 64 * (32 * rb + crow(r, hi)); *(LAS unsigned short*)(Xt + k * 8 + c * 2) = (unsigned short)f2bf(o2[rb][r]); }
  }
  __syncthreads();
  { const int o0 = 4 * slice; u32x2 gv[8];
#pragma unroll
    for (int i = 0; i < 8; ++i) gv[i] = *(const u32x2*)(PLB + ((size_t)b * SEQ + F.tid + 512 * i) * PLW + S_BG * 256 + o0);
    __builtin_amdgcn_sched_barrier(0);
#pragma unroll
    for (int i = 0; i < 8; ++i) { const int k = F.tid + 512 * i; const size_t row = (size_t)b * SEQ + k;
      const u32x2 ov = *(LAS const u32x2*)(Xt + k * 8);
      u32x2 y; y.x = pk2(__uint_as_float(ov.x << 16) * __uint_as_float(gv[i].x << 16), __uint_as_float(ov.x & 0xffff0000u) * __uint_as_float(gv[i].x & 0xffff0000u));
      y.y = pk2(__uint_as_float(ov.y << 16) * __uint_as_float(gv[i].y << 16), __uint_as_float(ov.y & 0xffff0000u) * __uint_as_float(gv[i].y & 0xffff0000u));
      *(u32x2*)(Y + row * 1024 + 256 + o0) = y; }
  }
}
constexpr int XC_STRIDE = 1040;
__device__ __forceinline__ void fftc_item(const Frame& F0, const Args& a, int item) {
  const Frame F = relaunder(F0);
  unsigned char* ws = opq(a.ws);
  const bf16* PLB = (const bf16*)(ws + WS_PLB); bf16* Y = (bf16*)(ws + WS_H);
  const bf16* CS = (const bf16*)(ws + WS_CS256);
  const int b = item >> 3, cs = item & 7, r32 = F.lane & 31, hi = F.lane >> 5, w = F.wave;
  LAS unsigned char* Xc = F.lds;
  __syncthreads();
  u32x4 vq[4];
#pragma unroll
  for (int i = 0; i < 4; ++i) { const int idx = F.tid + 512 * i, sl = idx >> 8, n = idx & 255;
    vq[i] = *(const u32x4*)((const bf16*)(ws + WS_FA2) + (((size_t)b * 64 + 8 * cs + sl) * TROW + SEQ + n) * 8); }
  __builtin_amdgcn_sched_barrier(0);
#pragma unroll
  for (int i = 0; i < 4; ++i) { const int idx = F.tid + 512 * i, sl = idx >> 8, n = idx & 255;
    const unsigned vv[4] = {vq[i].x, vq[i].y, vq[i].z, vq[i].w};
#pragma unroll
    for (int j = 0; j < 8; ++j) { const int c = j & 3, part = j >> 2; const unsigned short e = (unsigned short)((j & 1) ? (vv[j >> 1] >> 16) : (vv[j >> 1] & 0xffffu));
      *(LAS unsigned short*)(Xc + (4 * sl + c) * XC_STRIDE + (part * 256 + n) * 2) = e; } }
  __syncthreads();
  f32x16 acc;
#pragma unroll
  for (int i = 0; i < 16; ++i) acc[i] = 0.f;
#pragma unroll 8
  for (int s = 0; s < 32; ++s) {
    const bf16x8 af = *(const bf16x8*)(CS + (size_t)(32 * w + r32) * 512 + 16 * s + 8 * hi);
    const bf16x8 bf = *(LAS const bf16x8*)(Xc + r32 * XC_STRIDE + (16 * s + 8 * hi) * 2);
    acc = __builtin_amdgcn_mfma_f32_32x32x16_bf16(af, bf, acc, 0, 0, 0);
  }
  const int o = 32 * cs + r32;
#pragma unroll
  for (int r = 0; r < 16; ++r) { const size_t row = (size_t)MLAT + b * CTX + 32 * w + crow(r, hi);
    Y[row * 1024 + 256 + o] = (bf16)f2bf(acc[r] * bf2f(PLB[row * PLW + S_BG * 256 + o])); }
}
}

namespace mk {
constexpr int GU_STRIDE = 2048 + 64;
constexpr size_t WS_GU = WS_SCR, WS_GS = WS_GU + (size_t)32 * 68 * GU_STRIDE * 4;
__device__ __forceinline__ size_t gla_row(int b, int c, int i) { return c < 64 ? (size_t)b * SEQ + 64 * c + i : (size_t)MLAT + b * CTX + 64 * (c - 64) + i; }
__device__ __forceinline__ int gla_pos(int c, int dir) { return c < 64 ? (dir ? 4 + 63 - c : 4 + c) : (dir ? 3 - (c - 64) : (c - 64)); }
__device__ __forceinline__ void gla_stage_v(const Frame& F, const bf16* PLB, int b, int c, LAS unsigned char* vbase) {
  const int key = F.tid >> 3, ch = F.tid & 7;
  const bf16* src = PLB + gla_row(b, c, key) * PLW + S_AV * 256 + ch * 8;
  const int vo = key * 128 + ((ch ^ (((key >> 1) & 1) << 2)) << 4);
  u32x4 t_[4];
#pragma unroll
  for (int h = 0; h < 4; ++h) t_[h] = *(const u32x4*)(src + h * 64);
#pragma unroll
  for (int h = 0; h < 4; ++h) *(LAS u32x4*)(vbase + h * 8192 + vo) = t_[h];
}
__device__ __forceinline__ void gla_cum(const float* LA, int b, int c, int h, int dir, int lane, float (&cw)[32], float& T) {
  const int d = lane & 31, half = lane >> 5;
  float a[32];
#pragma unroll
  for (int ii = 0; ii < 32; ++ii) a[ii] = LA[gla_row(b, c, 32 * half + ii) * 256 + dir * 128 + h * 32 + d];
  float run = 0.f;
#pragma unroll
  for (int ii = 0; ii < 32; ++ii) { run += a[ii]; cw[ii] = run; }
  const float other = __shfl_xor(run, 32);
  const float tot0 = half ? other : run;
  T = run + other;
#pragma unroll
  for (int ii = 0; ii < 32; ++ii) { const float cf = cw[ii] + (half ? tot0 : 0.f); cw[ii] = dir ? (T - cf + a[ii]) : cf; }
}
constexpr int KT_STRIDE = 144;
__device__ __forceinline__ void gla_local_item(const Frame& F0, const Args& a, int item) {
  const Frame F = relaunder(F0);
  unsigned char* ws = opq(a.ws);
  const bf16* PLB = (const bf16*)(ws + WS_PLB); const float* LA = (const float*)(ws + WS_LA);
  const int b = item / 68, c = item % 68, h = F.wave >> 1, dir = F.wave & 1, d = F.lane & 31, half = F.lane >> 5, r32 = d, hi = half;
  LAS unsigned char* Vt = F.lds + h * 8192; LAS unsigned char* KT = F.lds + 32768 + F.wave * (32 * KT_STRIDE);
  __syncthreads();
  gla_stage_v(F, PLB, b, c, F.lds);
  float cw[32], T;
  gla_cum(LA, b, c, h, dir, F.lane, cw, T);
  {
    unsigned pkd[16]; bf16 kr[32];
    const bf16* kp = PLB + gla_row(b, c, 32 * half) * PLW + S_AQK * 256 + 128 + h * 32 + d;
#pragma unroll
    for (int ii = 0; ii < 32; ++ii) kr[ii] = kp[(size_t)ii * PLW];
#pragma unroll
    for (int ii = 0; ii < 32; ii += 2) pkd[ii >> 1] = pk2(bf2f(kr[ii]) * __expf(T - cw[ii]), bf2f(kr[ii + 1]) * __expf(T - cw[ii + 1]));
#pragma unroll
    for (int q4 = 0; q4 < 4; ++q4) *(LAS u32x4*)(KT + d * KT_STRIDE + half * 64 + q4 * 16) = (u32x4){pkd[4 * q4], pkd[4 * q4 + 1], pkd[4 * q4 + 2], pkd[4 * q4 + 3]};
  }
  __syncthreads();
  f32x16 acc[2];
#pragma unroll
  for (int eb = 0; eb < 2; ++eb)
#pragma unroll
    for (int i = 0; i < 16; ++i) acc[eb][i] = 0.f;
  const int q = (F.lane & 15) >> 2, p = F.lane & 3, gsel = (F.lane >> 4) & 1;
  const int chb = 2 * gsel + (p >> 1);
#pragma unroll
  for (int st = 0; st < 4; ++st) {
    const bf16x8 kb = *(LAS const bf16x8*)(KT + r32 * KT_STRIDE + (16 * st + 8 * hi) * 2);
#pragma unroll
    for (int eb = 0; eb < 2; ++eb) {
      const int ch = ((chb | ((eb ^ (q >> 1)) << 2)) << 4);
      LAS const unsigned char* vp = Vt + (16 * st + 8 * hi + q) * 128 + 8 * (p & 1) + ch;
      const s16x4 lo = vtr(vp), hh = vtr(vp + 512);
      const bf16x8 va = (bf16x8){lo[0], lo[1], lo[2], lo[3], hh[0], hh[1], hh[2], hh[3]};
      acc[eb] = __builtin_amdgcn_mfma_f32_32x32x16_bf16(va, kb, acc[eb], 0, 0, 0);
    }
  }
  const int chain = (b * 4 + h) * 2 + dir, pos = gla_pos(c, dir);
  float* gu = (float*)(ws + WS_GU) + ((size_t)chain * 68 + pos) * GU_STRIDE;
#pragma unroll
  for (int eb = 0; eb < 2; ++eb)
#pragma unroll
    for (int r = 0; r < 16; ++r) gu[(32 * eb + crow(r, hi)) * 32 + r32] = acc[eb][r];
  if (half == 0) gu[2048 + d] = __expf(T);
}
__device__ __forceinline__ void gla_scan(const Frame& F0, const Args& a) {
  const Frame F = relaunder(F0);
  unsigned char* ws = opq(a.ws);
  const int gt = F.vcu * 512 + F.tid;
  if (gt >= 32 * 2048) return;
  const int chain = gt >> 11, el = gt & 2047, d = el & 31;
  const float* gu = (const float*)(ws + WS_GU) + (size_t)chain * 68 * GU_STRIDE;
  bf16* gs = (bf16*)(ws + WS_GS) + (size_t)chain * 68 * 2048 + el;
  float S = 0.f;
#pragma unroll 34
  for (int pos = 0; pos < 68; ++pos) { gs[(size_t)pos * 2048] = (bf16)f2bf(S); S = gu[(size_t)pos * GU_STRIDE + 2048 + d] * S + gu[(size_t)pos * GU_STRIDE + el]; }
}
constexpr int QK_STRIDE = 80;
__device__ __forceinline__ void gla_out_item(const Frame& F0, const Args& a, int layer, int item) {
  const Frame F = relaunder(F0);
  unsigned char* ws = opq(a.ws);
  const bf16* PLB = (const bf16*)(ws + WS_PLB); const float* LA = (const float*)(ws + WS_LA); bf16* Y = (bf16*)(ws + WS_H);
  const int b = item / 68, c = item % 68, h = F.wave >> 1, dir = F.wave & 1, d = F.lane & 31, half = F.lane >> 5, r32 = d, hi = half;
  LAS unsigned char* Vt = F.lds + h * 8192;
  LAS unsigned char* QT = F.lds + 32768 + F.wave * (2 * 64 * QK_STRIDE); LAS unsigned char* KT = QT + 64 * QK_STRIDE;
  LAS float* X = (LAS float*)(F.lds + 32768) + h * 4096;
  __syncthreads();
  gla_stage_v(F, PLB, b, c, F.lds);
  {
    float cw[32], T;
    gla_cum(LA, b, c, h, dir, F.lane, cw, T);
    bf16 qr[32], kr[32];
    const bf16* pr = PLB + gla_row(b, c, 32 * half) * PLW + S_AQK * 256 + h * 32 + d;
#pragma unroll
    for (int ii = 0; ii < 32; ++ii) { qr[ii] = pr[(size_t)ii * PLW]; kr[ii] = pr[(size_t)ii * PLW + 128]; }
#pragma unroll
    for (int ii = 0; ii < 32; ++ii) { const int i = 32 * half + ii;
      const float ec = __expf(cw[ii]);
      *(LAS unsigned short*)(QT + i * QK_STRIDE + d * 2) = (unsigned short)f2bf(bf2f(qr[ii]) * ec);
      *(LAS unsigned short*)(KT + i * QK_STRIDE + d * 2) = (unsigned short)f2bf(bf2f(kr[ii]) * __builtin_amdgcn_rcpf(ec)); }
  }
  __syncthreads();
  f32x16 oacc[2][2];
#pragma unroll
  for (int eb = 0; eb < 2; ++eb)
#pragma unroll
    for (int ib = 0; ib < 2; ++ib)
#pragma unroll
      for (int i = 0; i < 16; ++i) oacc[eb][ib][i] = 0.f;
  bf16x8 qb[2][2];
#pragma unroll
  for (int ib = 0; ib < 2; ++ib)
#pragma unroll
    for (int st = 0; st < 2; ++st) qb[ib][st] = *(LAS const bf16x8*)(QT + (32 * ib + r32) * QK_STRIDE + (16 * st + 8 * hi) * 2);
  const int chain = (b * 4 + h) * 2 + dir, pos = gla_pos(c, dir);
  {
    const bf16* gs = (const bf16*)(ws + WS_GS) + ((size_t)chain * 68 + pos) * 2048;
#pragma unroll
    for (int eb = 0; eb < 2; ++eb)
#pragma unroll
      for (int st = 0; st < 2; ++st) { const bf16x8 sf = *(const bf16x8*)(gs + (32 * eb + r32) * 32 + 16 * st + 8 * hi);
#pragma unroll
        for (int ib = 0; ib < 2; ++ib) oacc[eb][ib] = __builtin_amdgcn_mfma_f32_32x32x16_bf16(sf, qb[ib][st], oacc[eb][ib], 0, 0, 0); }
  }
  const int q = (F.lane & 15) >> 2, p = F.lane & 3, gsel = (F.lane >> 4) & 1;
  const int vrow = (4 * hi + q) * 128 + 8 * (p & 1), chb = 2 * gsel + (p >> 1);
#pragma unroll
  for (int sb = 0; sb < 2; ++sb) {
    bf16x8 kf[2];
#pragma unroll
    for (int st = 0; st < 2; ++st) kf[st] = *(LAS const bf16x8*)(KT + (32 * sb + r32) * QK_STRIDE + (16 * st + 8 * hi) * 2);
#pragma unroll
    for (int ib = 0; ib < 2; ++ib) {
      const bool need = dir == 0 ? (sb <= ib) : (sb >= ib);
      if (!need) continue;
      f32x16 sc;
#pragma unroll
      for (int i = 0; i < 16; ++i) sc[i] = 0.f;
#pragma unroll
      for (int st = 0; st < 2; ++st) sc = __builtin_amdgcn_mfma_f32_32x32x16_bf16(kf[st], qb[ib][st], sc, 0, 0, 0);
      if (sb == ib) {
#pragma unroll
        for (int r = 0; r < 16; ++r) { const int s = crow(r, hi); const bool keep = dir == 0 ? (s <= r32) : (s >= r32); sc[r] = keep ? sc[r] : 0.f; }
      }
      u32x4 pw[2];
#pragma unroll
      for (int k = 0; k < 2; ++k) pw[k] = (u32x4){pk2(sc[8 * k + 0], sc[8 * k + 1]), pk2(sc[8 * k + 2], sc[8 * k + 3]), pk2(sc[8 * k + 4], sc[8 * k + 5]), pk2(sc[8 * k + 6], sc[8 * k + 7])};
#pragma unroll
      for (int ks = 0; ks < 2; ++ks)
#pragma unroll
        for (int eb = 0; eb < 2; ++eb) {
          const int ch = ((chb | ((eb ^ (q >> 1)) << 2)) << 4);
          const s16x4 lo = vtr(Vt + (2 * sb + ks) * 2048 + vrow + ch), hh = vtr(Vt + (2 * sb + ks) * 2048 + 1024 + vrow + ch);
          const bf16x8 va = (bf16x8){lo[0], lo[1], lo[2], lo[3], hh[0], hh[1], hh[2], hh[3]};
          oacc[eb][ib] = __builtin_amdgcn_mfma_f32_32x32x16_bf16(va, __builtin_bit_cast(bf16x8, pw[ks]), oacc[eb][ib], 0, 0, 0);
        }
    }
  }
  __syncthreads();
  if (dir == 1) {
#pragma unroll
    for (int eb = 0; eb < 2; ++eb)
#pragma unroll
      for (int ib = 0; ib < 2; ++ib)
#pragma unroll
        for (int r = 0; r < 16; ++r) X[((eb * 2 + ib) * 16 + r) * 64 + F.lane] = oacc[eb][ib][r];
  }
  __syncthreads();
  if (dir == 0) {
    const float* on = opq(a.in[11]) + layer * 64;
#pragma unroll
    for (int ib = 0; ib < 2; ++ib) {
      float ss = 0.f;
#pragma unroll
      for (int eb = 0; eb < 2; ++eb)
#pragma unroll
        for (int r = 0; r < 16; ++r) { oacc[eb][ib][r] += X[((eb * 2 + ib) * 16 + r) * 64 + F.lane]; ss += oacc[eb][ib][r] * oacc[eb][ib][r]; }
      ss += __shfl_xor(ss, 32);
      const float rs = 1.0f / sqrtf(ss * (1.f / 64.f) + 1e-6f);
      const size_t row = gla_row(b, c, 32 * ib + r32);
      u32x2 gv8[8];
#pragma unroll
      for (int i = 0; i < 8; ++i) gv8[i] = *(const u32x2*)(PLB + row * PLW + S_AG * 256 + h * 64 + 32 * (i >> 2) + 8 * (i & 3) + 4 * hi);
      __builtin_amdgcn_sched_barrier(0);
#pragma unroll
      for (int eb = 0; eb < 2; ++eb)
#pragma unroll
        for (int gi = 0; gi < 4; ++gi) {
          const int e0 = 32 * eb + 8 * gi + 4 * hi;
          const f32x4 w4 = *(const f32x4*)(on + e0);
          const u32x2 gv = gv8[4 * eb + gi];
          const float g0 = __uint_as_float(gv.x << 16), g1 = __uint_as_float(gv.x & 0xffff0000u), g2 = __uint_as_float(gv.y << 16), g3 = __uint_as_float(gv.y & 0xffff0000u);
          u32x2 ov; ov.x = pk2(oacc[eb][ib][4 * gi + 0] * rs * w4[0] * g0, oacc[eb][ib][4 * gi + 1] * rs * w4[1] * g1);
          ov.y = pk2(oacc[eb][ib][4 * gi + 2] * rs * w4[2] * g2, oacc[eb][ib][4 * gi + 3] * rs * w4[3] * g3);
          *(u32x2*)(Y + row * 1024 + h * 64 + e0) = ov;
        }
    }
  }
}
}

namespace mk {
__device__ __forceinline__ void p3_mixers(const Frame& F0, const Args& a, int layer) {
  const Frame F = relaunder(F0);
  const int nx = layer == 0 ? 16 : 0, nswa = 256 + nx, nna = 256 + nx, nfc = layer == 0 ? 32 : 0;
  for (int it = F.vcu; it < 272 + 256 + nfc + nswa + nna; it += F.G) {
    int r = it;
#ifndef REP_GL
#define REP_GL 1
#define REP_FF 1
#define REP_SW 1
#define REP_NA 1
#endif
    if (r < 272) { for (int q_ = 0; q_ < REP_GL; ++q_) gla_local_item(F, a, r); continue; } r -= 272;
    if (r < 256) { for (int q_ = 0; q_ < REP_FF; ++q_) fft_item(F, a, r); continue; } r -= 256;
    if (r < nfc) { fftc_item(F, a, r); continue; } r -= nfc;
    if (r < nswa) { for (int q_ = 0; q_ < REP_SW; ++q_) swa_item(F, a, layer, r); } else { for (int q_ = 0; q_ < REP_NA; ++q_) na_item(F, a, layer, r - nswa); }
  }
}
__device__ __forceinline__ void p4b_glaout(const Frame& F0, const Args& a, int layer) {
  const Frame F = relaunder(F0);
  for (int it = F.vcu; it < 272; it += F.G) { if (layer == 1 && (it % 68) >= 64) continue; gla_out_item(F, a, layer, it); }
}
}
#define XB_TMO      128
#define XB_XCNT(j)  (256  + 64 * (j))
#define XB_XSUB(j)  (1280 + 64 * (j))
#define XB_XGEN(j)  (2304 + 64 * (j))
#define XB_TOP      3328
#define XB_TOPGEN   3392
#define XCD_BAR_WORDS 3456
#define XB_SPIN_CAP (1u << 18)

__device__ __forceinline__ unsigned xb_ld(unsigned* p)              { return __hip_atomic_load(p, __ATOMIC_RELAXED, __HIP_MEMORY_SCOPE_AGENT); }
__device__ __forceinline__ unsigned xb_add(unsigned* p, unsigned v) { return __hip_atomic_fetch_add(p, v, __ATOMIC_RELAXED, __HIP_MEMORY_SCOPE_AGENT); }
__device__ __forceinline__ unsigned xb_xcc_id() { return (unsigned)__builtin_amdgcn_s_getreg((3 << 11) | 20) & 0xFu; }
#define XB_SPIN(cond, bar) do { unsigned _sp = 0; while (cond) { __builtin_amdgcn_s_sleep(1); \
    if ((++_sp & 255u) == 0u) { if (xb_ld(&(bar)[XB_TMO])) break; if (_sp > XB_SPIN_CAP) { atomicAdd(&(bar)[XB_TMO], 1u); break; } } } } while (0)

struct XcdBarrier {
    unsigned* bar; unsigned x;
    volatile LAS unsigned* st;
};

__device__ __forceinline__ XcdBarrier xcd_barrier_post(unsigned* bar, volatile LAS unsigned* st) {
    XcdBarrier b; b.bar = bar; b.x = xb_xcc_id(); b.st = st;
    if (threadIdx.x == 0) (void)xb_add(&bar[XB_XCNT(b.x)], 1u);
    return b;
}
__device__ __forceinline__ void xcd_barrier_complete(unsigned* bar, unsigned x, unsigned& nloc, unsigned& nx) {
    const unsigned G = gridDim.x * gridDim.y * gridDim.z;
    unsigned sum, cnt, mine, sp = 0u;
    for (;;) {
        sum = 0u; cnt = 0u; mine = 0u;
#pragma unroll
        for (unsigned j = 0; j < 16; ++j) { const unsigned c = xb_ld(&bar[XB_XCNT(j)]); sum += c; cnt += (c > 0u) ? 1u : 0u; }
        mine = xb_ld(&bar[XB_XCNT(x)]);
        if (sum == G) break;
        __builtin_amdgcn_s_sleep(1);
        if ((++sp & 255u) == 0u) { if (xb_ld(&bar[XB_TMO])) break; if (sp > XB_SPIN_CAP) { atomicAdd(&bar[XB_TMO], 1u); break; } }
    }
    nloc = mine > 0u ? mine : 1u; nx = cnt > 0u ? cnt : 1u;
}

__device__ __forceinline__ void xcd_barrier(const XcdBarrier& b) {
    asm volatile("s_waitcnt vmcnt(0)" ::: "memory");
    __syncthreads();
    if (threadIdx.x == 0) {
        unsigned* bar = b.bar;
        __builtin_amdgcn_s_waitcnt(0);
        unsigned nloc = b.st[0], nx = b.st[1];
        if (nloc == 0u) { xcd_barrier_complete(bar, b.x, nloc, nx); b.st[0] = nloc; b.st[1] = nx; }
        const unsigned old = xb_add(&bar[XB_XSUB(b.x)], 1u);
        const unsigned gen = old / nloc;
        if (old + 1u == (gen + 1u) * nloc) {
            __builtin_amdgcn_fence(__ATOMIC_RELEASE, "agent");
            asm volatile("s_waitcnt vmcnt(0)" ::: "memory");
            const unsigned og = xb_add(&bar[XB_TOP], 1u);
            const unsigned tg = og / nx;
            if (og + 1u == (tg + 1u) * nx) xb_add(&bar[XB_TOPGEN], 1u);
            else XB_SPIN(xb_ld(&bar[XB_TOPGEN]) == tg, bar);
            __builtin_amdgcn_fence(__ATOMIC_ACQUIRE, "agent");
            xb_add(&bar[XB_XGEN(b.x)], 1u);
            asm volatile("s_waitcnt vmcnt(0)" ::: "memory");
        } else {
            XB_SPIN(xb_ld(&bar[XB_XGEN(b.x)]) == gen, bar);
            __builtin_amdgcn_fence(__ATOMIC_ACQUIRE, "agent");
            asm volatile("s_waitcnt vmcnt(0)" ::: "memory");
        }
    }
    __syncthreads();
}

constexpr int LDS_BYTES = 147456, MISC_OFF = LDS_BYTES - 256;
constexpr int CW_BAR = 4096;
__global__ void __launch_bounds__(512, 2) mega(mk::Args a) {
  extern __shared__ __attribute__((aligned(16))) unsigned char lds[];
  mk::Frame F;
  F.lds = (LAS unsigned char*)lds;
  F.tid = threadIdx.x; F.lane = F.tid & 63; F.wave = __builtin_amdgcn_readfirstlane(F.tid >> 6);
  F.G = gridDim.x; { const int bx = blockIdx.x; F.vcu = (F.G % 8 == 0) ? (bx % 8) * (F.G / 8) + bx / 8 : bx; }
  volatile LAS unsigned* MISC = (volatile LAS unsigned*)(F.lds + MISC_OFF);
  if (F.tid < 64) MISC[F.tid] = 0u;
  __syncthreads();
  XcdBarrier bar; bar.bar = nullptr; bar.x = 0; bar.st = nullptr;
  const bool multi = (a.ph_hi - a.ph_lo) > 1;
  if (multi) bar = xcd_barrier_post((unsigned*)(a.ws + mk::WS_CTL) + CW_BAR, MISC + 8);
#pragma clang loop unroll(disable)
  for (int ph = a.ph_lo; ph < a.ph_hi; ++ph) {
    if (ph == 0) mk::p0_prologue(F, a);
    else {
      const int layer = (ph - 1) / 6, sub = (ph - 1) % 6;
      if (sub == 0) mk::p1_prenorm(F, a, layer);
      else if (sub == 1) mk::p2_inproj(F, a, layer);
      else if (sub == 2) mk::p3_mixers(F, a, layer);
      else if (sub == 3) mk::gla_scan(F, a);
      else if (sub == 4) mk::p4b_glaout(F, a, layer);
      else mk::p5_outproj(F, a, layer);
    }
#ifdef DUP_PHASE
    if (ph == DUP_PHASE) { xcd_barrier(bar);
#if DUP_PHASE == 0
      mk::p0_prologue(F, a);
#elif (DUP_PHASE - 1) % 6 == 0
      mk::p1_prenorm(F, a, (DUP_PHASE - 1) / 6);
#elif (DUP_PHASE - 1) % 6 == 1
      mk::p2_inproj(F, a, (DUP_PHASE - 1) / 6);
#elif (DUP_PHASE - 1) % 6 == 2
      mk::p3_mixers(F, a, (DUP_PHASE - 1) / 6);
#elif (DUP_PHASE - 1) % 6 == 3
      mk::gla_scan(F, a);
#elif (DUP_PHASE - 1) % 6 == 4
      mk::p4b_glaout(F, a, (DUP_PHASE - 1) / 6);
#else
      mk::p5_outproj(F, a, (DUP_PHASE - 1) / 6);
#endif
    }
#endif
    if (ph + 1 < a.ph_hi) xcd_barrier(bar);
  }
}

#ifndef MK_SPLIT
#define MK_SPLIT 0
#endif
extern "C" void kernel_launch(void* const* d_in, const int* in_sizes, int n_in, void* d_out, int out_size, void* d_ws, size_t ws_size, hipStream_t stream) {
  using namespace mk;
  static int grid = 0;
  if (grid == 0) {
    int dev = 0, cus = 0, per_cu = 0; (void)hipGetDevice(&dev); (void)hipDeviceGetAttribute(&cus, hipDeviceAttributeMultiprocessorCount, dev);
    (void)hipFuncSetAttribute((const void*)mega, hipFuncAttributeMaxDynamicSharedMemorySize, LDS_BYTES);
    if (hipOccupancyMaxActiveBlocksPerMultiprocessor(&per_cu, (const void*)mega, 512, LDS_BYTES) != hipSuccess || per_cu < 1) per_cu = 1;
    (void)hipGetLastError();
    grid = (cus > 0 ? cus : 256) * (per_cu < 1 ? 1 : 1);
  }
  (void)hipMemsetAsync((char*)d_ws + WS_CTL, 0, CTL_BYTES, stream);
  Args a{};
  for (int i = 0; i < 19; ++i) a.in[i] = (const float*)d_in[i];
  a.out = (float*)d_out; a.ws = (unsigned char*)d_ws;
#if MK_SPLIT
  for (int ph = 0; ph < 13; ++ph) { a.ph_lo = ph; a.ph_hi = ph + 1; hipLaunchKernelGGL(mega, dim3(grid), dim3(512), LDS_BYTES, stream, a); }
#else
  a.ph_lo = 0; a.ph_hi = 13;
  void* args[] = {&a};
  if (hipLaunchCooperativeKernel((const void*)mega, dim3(grid), dim3(512), args, LDS_BYTES, stream) != hipSuccess) {
    (void)hipGetLastError();
    hipLaunchKernelGGL(mega, dim3(grid), dim3(512), LDS_BYTES, stream, a);
  }
#endif
}
```

```cpp
#include <hip/hip_runtime.h>
#include <math.h>
#include <stdint.h>

namespace pg8 {
#define PG8_LAS __attribute__((address_space(3)))
typedef unsigned short bf16_t;
typedef short bf16x8 __attribute__((ext_vector_type(8)));
typedef float f32x4 __attribute__((ext_vector_type(4)));
typedef unsigned u32x4 __attribute__((ext_vector_type(4)));
constexpr int BM = 256, BK = 64, HALF = 128, HTB = HALF * BK * 2  , STAGE_BYTES = 8 * HTB, NXCD = 8, WGM = 8;

__host__ __device__ __forceinline__ int lds_byte(int r, int c) { const int st = (r >> 4) * 2 + (c >> 5), rr = r & 15, cc = c & 31, ob = rr * 64 + cc * 2; return st * 1024 + (ob ^ (((ob >> 9) & 1) << 5)); }
__host__ __device__ __forceinline__ void stage_rc(int b, int& R, int& C) { const int st = b / 1024, sb = b % 1024, swz = sb ^ (((sb >> 9) & 1) << 5); R = (st >> 1) * 16 + swz / 64; C = (st & 1) * 32 + (swz % 64) / 2; }
__host__ __device__ __forceinline__ int perm32(int rho) { const int n = rho >> 4, i = rho & 15; return 8 * (i >> 2) + 4 * n + (i & 3); }

struct Unit { int pm, pn; };
struct Gemm { const bf16_t* A; const bf16_t* Bt; int M, N, K; };

struct StaticOrder {
    int nM, nN, nwg, G, c;
    __host__ __device__ void init(int M, int N, int G_, int c_) { nM = M / BM; nN = N / BM; nwg = nM * nN; G = G_; c = c_; }
    __host__ __device__ bool next(int i, Unit& u) const {
        const long L = (long)i * G + c; if (L >= nwg) return false;
        int wgid = (int)L; { const int q = nwg / NXCD, r = nwg % NXCD, xcd = wgid % NXCD, off = wgid / NXCD; wgid = (xcd < r ? xcd * (q + 1) : r * (q + 1) + (xcd - r) * q) + off; }
        const int nig = WGM * nN, gid = wgid / nig, fm = gid * WGM, gsz = (nM - fm) < WGM ? (nM - fm) : WGM;
        u.pm = fm + ((wgid % nig) % gsz); u.pn = (wgid % nig) / gsz; return true;
    }
    __device__ __forceinline__ void a_ready(const Unit&) const {}
    __device__ __forceinline__ void done(const Unit&) const {}
};

template <class Epi, class Sched, bool STAMP = false>
__device__ __forceinline__ void gemm_phase(PG8_LAS unsigned char* lds, const Gemm g, const Sched& S, const Epi& E, unsigned long long* stamps) {
    int tid_ = threadIdx.x; asm volatile("" : "+v"(tid_));
    const int tid = tid_, wid = __builtin_amdgcn_readfirstlane(tid >> 6), lane = tid & 63, wr = wid >> 2, wc = wid & 3, fr = lane & 15, fq = lane >> 4;
    const int K = g.K, nt = K / BK;
    int ts_lo = 0, ts_hi = 0, nts = 0; const unsigned long long rt_entry = STAMP ? (unsigned long long)wall_clock64() : 0ull;
#define PG8_STAMP() do { if (STAMP && wid == 0 && nts < 64) { const unsigned long long _c = (unsigned long long)clock64(); \
        ts_lo = (lane == nts) ? (int)(unsigned)_c : ts_lo; ts_hi = (lane == nts) ? (int)(unsigned)(_c >> 32) : ts_hi; ++nts; } } while (0)
    PG8_STAMP();
    unsigned voffA[2], voffB[2];
#pragma unroll
    for (int i = 0; i < 2; ++i) { int R, C; stage_rc(tid * 16 + i * 8192, R, C); const int Rb = Epi::PERM ? ((R & ~31) + perm32(R & 31)) : R;
        voffA[i] = (unsigned)(R * K + C) * 2u; voffB[i] = (unsigned)(Rb * K + C) * 2u; }
    const size_t kstep = (size_t)(BK * 2);
    const size_t hstep = (size_t)HALF * K * 2;
    const size_t tstep = 2 * hstep;
    const unsigned ldsw = (unsigned)wid * 1024u;
    const int aoff = lds_byte(wr * 64 + fr, fq * 8), boff = lds_byte(wc * 32 + fr, fq * 8);
#define PG8_SA(b, h) (((b) * 2 + (h)) * HTB)
#define PG8_SB(b, h) ((4 + (b) * 2 + (h)) * HTB)
#define PG8_STAGE(bufoff, gbase, voff) do { _Pragma("unroll") for (int _i = 0; _i < 2; ++_i) \
        __builtin_amdgcn_global_load_lds((const unsigned*)((const char*)(gbase) + (voff)[_i]), (PG8_LAS unsigned*)(lds + (bufoff) + ldsw + _i * 8192), 16, 0, 0); } while (0)
#define PG8_LDA(dst, b, h) do { _Pragma("unroll") for (int m = 0; m < 4; ++m) _Pragma("unroll") for (int k = 0; k < 2; ++k) dst[m][k] = *(const PG8_LAS bf16x8*)(lds + PG8_SA(b, h) + aoff + m * 2048 + k * 1024); } while (0)
#define PG8_LDB(dst, b, h) do { _Pragma("unroll") for (int n = 0; n < 2; ++n) _Pragma("unroll") for (int k = 0; k < 2; ++k) dst[n][k] = *(const PG8_LAS bf16x8*)(lds + PG8_SB(b, h) + boff + n * 2048 + k * 1024); } while (0)
#define PG8_MMA(ai, bj, At, Bt) do { __builtin_amdgcn_s_setprio(1); _Pragma("unroll") for (int m = 0; m < 4; ++m) _Pragma("unroll") for (int n = 0; n < 2; ++n) _Pragma("unroll") for (int k = 0; k < 2; ++k) \
        acc[ai][bj][m][n] = __builtin_amdgcn_mfma_f32_16x16x32_bf16(Bt[n][k], At[m][k], acc[ai][bj][m][n], 0, 0, 0); __builtin_amdgcn_s_setprio(0); } while (0)
#define PG8_WAIT_V(n) asm volatile("s_waitcnt vmcnt(" #n ")" ::: "memory")
#define PG8_WAIT_L(n) asm volatile("s_waitcnt lgkmcnt(" #n ")" ::: "memory")
#define PG8_BAR __builtin_amdgcn_s_barrier()
#define PG8_SCHED __builtin_amdgcn_sched_barrier(0)
    Unit cur, nxt; int ui = 0;
    if (!S.next(0, cur)) return;
    f32x4 acc[2][2][4][2];
#pragma unroll
    for (int a = 0; a < 2; ++a)
#pragma unroll
        for (int b = 0; b < 2; ++b)
#pragma unroll
            for (int m = 0; m < 4; ++m)
#pragma unroll
                for (int n = 0; n < 2; ++n) acc[a][b][m][n] = (f32x4){0.f, 0.f, 0.f, 0.f};
    bf16x8 At[4][2], B0[2][2], B1[2][2];
    const char* cA = (const char*)g.A + (size_t)cur.pm * tstep; const char* cB = (const char*)g.Bt + (size_t)cur.pn * tstep;
    S.a_ready(cur);
    PG8_STAGE(PG8_SB(0, 0), cB, voffB); PG8_STAGE(PG8_SA(0, 0), cA, voffA); PG8_STAGE(PG8_SB(0, 1), cB + hstep, voffB); PG8_STAGE(PG8_SA(0, 1), cA + hstep, voffA);
    if (wr == 1) PG8_BAR;
    PG8_WAIT_V(4); PG8_BAR;
    PG8_STAGE(PG8_SB(1, 0), cB + kstep, voffB); PG8_STAGE(PG8_SA(1, 0), cA + kstep, voffA); PG8_STAGE(PG8_SB(1, 1), cB + hstep + kstep, voffB);
    PG8_WAIT_V(6); PG8_BAR;
    PG8_STAMP();
    for (;;) {
        const bool has_next = S.next(ui + 1, nxt);
        const char* nA = has_next ? (const char*)g.A + (size_t)nxt.pm * tstep : cA; const char* nB = has_next ? (const char*)g.Bt + (size_t)nxt.pn * tstep : cB;
        for (int t = 0; t < nt; t += 2) {
            const bool last = (t == nt - 2);
            const char* a1 = cA + (size_t)(t + 1) * kstep;
            const char* a2 = last ? nA : cA + (size_t)(t + 2) * kstep; const char* b2 = last ? nB : cB + (size_t)(t + 2) * kstep;
            const char* a3 = a2 + kstep; const char* b3 = b2 + kstep;
            if (last && has_next) S.a_ready(nxt);
            PG8_LDB(B0, 0, 0); PG8_SCHED; PG8_LDA(At, 0, 0); PG8_STAGE(PG8_SA(1, 1), a1 + hstep, voffA);
            PG8_WAIT_L(8); PG8_BAR; PG8_WAIT_L(0); PG8_MMA(0, 0, At, B0); PG8_BAR; PG8_SCHED;
            PG8_LDB(B1, 0, 1); PG8_STAGE(PG8_SB(0, 0), b2, voffB);
            PG8_BAR; PG8_WAIT_L(0); PG8_MMA(0, 1, At, B1); PG8_BAR;
            PG8_LDA(At, 0, 1); PG8_STAGE(PG8_SA(0, 0), a2, voffA);
            PG8_BAR; PG8_WAIT_L(0); PG8_MMA(1, 0, At, B0); PG8_BAR; PG8_SCHED;
            PG8_STAGE(PG8_SB(0, 1), b2 + hstep, voffB);
            PG8_WAIT_V(6); PG8_BAR; PG8_MMA(1, 1, At, B1); PG8_BAR;
            PG8_LDB(B0, 1, 0); PG8_SCHED; PG8_LDA(At, 1, 0); PG8_STAGE(PG8_SA(0, 1), a2 + hstep, voffA);
            PG8_WAIT_L(8); PG8_BAR; PG8_WAIT_L(0); PG8_MMA(0, 0, At, B0); PG8_BAR; PG8_SCHED;
            PG8_LDB(B1, 1, 1); PG8_STAGE(PG8_SB(1, 0), b3, voffB);
            PG8_BAR; PG8_WAIT_L(0); PG8_MMA(0, 1, At, B1); PG8_BAR;
            PG8_LDA(At, 1, 1); PG8_STAGE(PG8_SA(1, 0), a3, voffA);
            PG8_BAR; PG8_WAIT_L(0); PG8_MMA(1, 0, At, B0); PG8_BAR; PG8_SCHED;
            PG8_STAGE(PG8_SB(1, 1), b3 + hstep, voffB);
            PG8_WAIT_V(6); PG8_BAR; PG8_MMA(1, 1, At, B1); PG8_BAR;
        }
        PG8_STAMP();
        if constexpr (!Epi::AFTER_DRAIN) { E(acc, cur, wr, wc, fr, fq); S.done(cur); }
        PG8_STAMP();
        if (!has_next) break;
#pragma unroll
        for (int a = 0; a < 2; ++a)
#pragma unroll
            for (int b = 0; b < 2; ++b)
#pragma unroll
                for (int m = 0; m < 4; ++m)
#pragma unroll
                    for (int n = 0; n < 2; ++n) acc[a][b][m][n] = (f32x4){0.f, 0.f, 0.f, 0.f};
        cur = nxt; cA = nA; cB = nB; ++ui;
    }
    PG8_WAIT_V(0);
    if (wr == 0) PG8_BAR;
    PG8_BAR;
    if constexpr (Epi::AFTER_DRAIN) { E.fused(acc, cur, wr, wc, fr, fq, lds, wid, lane); S.done(cur); }
    PG8_STAMP();
    if (STAMP && wid == 0) { stamps[lane] = lane < nts ? (((unsigned long long)(unsigned)ts_hi << 32) | (unsigned)ts_lo) : 0ull;
        if (lane == 62) stamps[62] = rt_entry; if (lane == 63) stamps[63] = (unsigned long long)wall_clock64(); }
#undef PG8_STAMP
#undef PG8_SA
#undef PG8_SB
#undef PG8_STAGE
#undef PG8_LDA
#undef PG8_LDB
#undef PG8_MMA
#undef PG8_WAIT_V
#undef PG8_WAIT_L
#undef PG8_BAR
#undef PG8_SCHED
}
}

namespace mk {
#define LAS __attribute__((address_space(3)))
typedef unsigned short bf16;
typedef float f32x4 __attribute__((ext_vector_type(4)));
typedef float f32x16 __attribute__((ext_vector_type(16)));
typedef unsigned u32x4 __attribute__((ext_vector_type(4)));
typedef unsigned u32x2 __attribute__((ext_vector_type(2)));
typedef short bf16x8 __attribute__((ext_vector_type(8)));
typedef short s16x4 __attribute__((ext_vector_type(4)));

constexpr int D = 1024, NB = 4, SEQ = 4096, CTX = 256, PWW = 3360;
constexpr int MLAT = NB * SEQ, MT = MLAT + NB * CTX;
constexpr int NT1 = 14, N1 = NT1 * 256;
constexpr int NSLOT = 11, PLW = NSLOT * 256;
constexpr int TROW = SEQ + CTX;
constexpr int O_AQ = 0, O_AK = 128, O_AV = 256, O_AG = 512, O_LR = 768, O_BV = 800, O_BG = 1056, O_CQ = 1312, O_CK = 1568, O_CV = 1696,
              O_CG = 1824, O_DQ = 2080, O_DK = 2336, O_DV = 2592, O_DG = 2848;
constexpr int S_AQK = 0, S_AV = 1, S_AG = 2, S_BG = 3, S_CQ = 4, S_CKV = 5, S_CG = 6, S_DQ = 7, S_DK = 8, S_DV = 9, S_DG = 10;
constexpr float LOG2E = 1.4426950408889634f, QSCALE = 0.125f * LOG2E, GLA_QS = 0.17677669529663687f;

constexpr size_t WS_CTL = 0, CTL_BYTES = 65536;
constexpr size_t WS_MOD = WS_CTL + CTL_BYTES;
constexpr size_t WS_ROPE = WS_MOD + 2 * 5 * 3072 * 4;
constexpr size_t WS_WC = WS_ROPE + 2 * 64 * 16 * 4;
constexpr size_t WS_CS256 = WS_WC + 128 * 128 * 2;
constexpr size_t WS_W1T = 1u << 20;
constexpr size_t WS_W2T = WS_W1T + (size_t)2 * N1 * D * 2;
constexpr size_t WS_H = WS_W2T + (size_t)2 * D * D * 2;
constexpr size_t WS_PLB = WS_H + (size_t)MT * D * 2;
constexpr size_t WS_LA = WS_PLB + (size_t)MT * PLW * 2;
constexpr size_t WS_FA2 = WS_LA + (size_t)MT * 256 * 4;
constexpr size_t WS_CTX1 = WS_FA2 + (size_t)NB * 64 * TROW * 8 * 2;
constexpr size_t WS_SCR = WS_CTX1 + (size_t)NB * CTX * D * 4;
static_assert(WS_CS256 + 256 * 512 * 2 <= WS_W1T, "tables");

__device__ __forceinline__ float bf2f(bf16 v) { return __uint_as_float(((unsigned)v) << 16); }
__device__ __forceinline__ unsigned f2bf(float f) { unsigned u = __float_as_uint(f); return (u + 0x7fffu + ((u >> 16) & 1u)) >> 16; }
typedef float f32x2_t __attribute__((ext_vector_type(2))); typedef __bf16 bf16x2_t __attribute__((ext_vector_type(2)));
__device__ __forceinline__ unsigned pk2(float lo, float hi) { const f32x2_t v = {lo, hi}; const bf16x2_t b = __builtin_convertvector(v, bf16x2_t); return __builtin_bit_cast(unsigned, b); }
__device__ __forceinline__ float wave_sum(float v) {
#pragma unroll
  for (int o = 1; o < 64; o <<= 1) v += __shfl_xor(v, o);
  return v;
}
__device__ __forceinline__ float fsilu(float x) { return x * __builtin_amdgcn_rcpf(1.f + __expf(-x)); }
__device__ __forceinline__ float flogsig(float x) { return fminf(x, 0.f) - __logf(1.f + __expf(-fabsf(x))); }

#define GAS __attribute__((address_space(1)))
template <class T> __device__ __forceinline__ T* opq(T* p) { GAS T* g = (GAS T*)p; asm volatile("" : "+s"(g)); return (T*)g; }
__device__ __forceinline__ int crow(int r, int hi) { return (r & 3) + 8 * (r >> 2) + 4 * hi; }
struct Args {
  const float* in[19]; float* out; unsigned char* ws; int ph_lo, ph_hi;
};
struct Frame {
  int tid, lane, wave, vcu, G;
  LAS unsigned char* lds;
};
__device__ __forceinline__ Frame relaunder(const Frame& F0) {
  Frame F = F0; F.tid = threadIdx.x; asm volatile("" : "+v"(F.tid)); F.lane = F.tid & 63; asm volatile("" : "+s"(F.wave), "+s"(F.vcu), "+s"(F.G)); return F; }
}

namespace mk {
__device__ __forceinline__ void p0_ada_item(const Frame& F, const Args& a, int item) {
  LAS float* s = (LAS float*)F.lds; LAS float* red = s + 5 * 1024;
  const float* c = opq(a.in[1]); const float* cc = opq(a.in[3]);
  for (int i = F.tid; i < 5 * 1024; i += 512) { const int r = i >> 10, k = i & 1023; const float v = r < 4 ? c[r * 1024 + k] : cc[k]; s[i] = v / (1.f + expf(-v)); }
  __syncthreads();
  const int kp = F.tid / 24, cl = F.tid % 24;
  const int gcol = item * 24 + cl, l = gcol / 3072, col = gcol % 3072;
  if (kp < 21) {
    const float* w = opq(a.in[5]) + (size_t)l * 1024 * 3072 + col;
    float acc[5] = {0.f, 0.f, 0.f, 0.f, 0.f};
#pragma unroll 8
    for (int k = kp; k < 1024; k += 21) { const float wv = w[(size_t)k * 3072];
#pragma unroll
      for (int r = 0; r < 5; ++r) acc[r] += s[r * 1024 + k] * wv; }
#pragma unroll
    for (int r = 0; r < 5; ++r) red[(kp * 24 + cl) * 5 + r] = acc[r];
  }
  __syncthreads();
  if (F.tid < 120) {
    const int cl2 = F.tid / 5, r = F.tid % 5; float t = 0.f;
    for (int q = 0; q < 21; ++q) t += red[(q * 24 + cl2) * 5 + r];
    const int g2 = item * 24 + cl2, l2 = g2 / 3072, col2 = g2 % 3072;
    float* MOD = (float*)(opq(a.ws) + WS_MOD);
    MOD[((size_t)l2 * 5 + r) * 3072 + col2] = t + opq(a.in[6])[l2 * 3072 + col2];
  }
  __syncthreads();
}
__device__ __forceinline__ int rope_perm(int n) { return 16 * ((n >> 2) & 1) + 4 * (n >> 3) + (n & 3); }
__device__ __forceinline__ void p0_tr_item(const float* W, int ldw, int cbase, int permkind, float scale, bf16* dst, int k0, LAS float* scr, int lane) {
  { float t_[32];
#pragma unroll
    for (int i = 0; i < 32; ++i) t_[i] = W[(size_t)(k0 + 2 * i + (lane >> 5)) * ldw + cbase + (lane & 31)];
#pragma unroll
    for (int i = 0; i < 32; ++i) scr[(2 * i + (lane >> 5)) * 33 + (lane & 31)] = t_[i]; }
  asm volatile("s_waitcnt lgkmcnt(0)" ::: "memory");
  const int c = lane & 7;
#pragma unroll
  for (int j = 0; j < 4; ++j) { const int n = (lane >> 3) + 8 * j; const int sidx = permkind ? rope_perm(n) : n; const LAS float* sp = scr + (8 * c) * 33 + sidx;
    u32x4 o; o.x = pk2(sp[0 * 33] * scale, sp[1 * 33] * scale); o.y = pk2(sp[2 * 33] * scale, sp[3 * 33] * scale); o.z = pk2(sp[4 * 33] * scale, sp[5 * 33] * scale); o.w = pk2(sp[6 * 33] * scale, sp[7 * 33] * scale);
    *(u32x4*)(dst + (size_t)n * 1024 + k0 + 8 * c) = o; }
  asm volatile("s_waitcnt lgkmcnt(0)" ::: "memory");
}
__device__ __forceinline__ void p0_la_item(const float* Win, const float* decw  , int dir, int j0, bf16* dst, int k0, LAS float* scr, int lane) {
  float dw[16];
#pragma unroll
  for (int r = 0; r < 16; ++r) dw[r] = decw[(dir * 16 + r) * 128 + j0 + (lane & 31)];
#pragma unroll 4
  for (int i = 0; i < 32; ++i) { const int kk = 2 * i + (lane >> 5); const float* wp = Win + (size_t)(k0 + kk) * PWW + O_LR + dir * 16; float acc = 0.f;
#pragma unroll
    for (int r = 0; r < 16; ++r) acc += wp[r] * dw[r];
    scr[kk * 33 + (lane & 31)] = acc; }
  asm volatile("s_waitcnt lgkmcnt(0)" ::: "memory");
  const int c = lane & 7;
#pragma unroll
  for (int j = 0; j < 4; ++j) { const int n = (lane >> 3) + 8 * j; const LAS float* sp = scr + (8 * c) * 33 + n;
    u32x4 o; o.x = pk2(sp[0 * 33], sp[1 * 33]); o.y = pk2(sp[2 * 33], sp[3 * 33]); o.z = pk2(sp[4 * 33], sp[5 * 33]); o.w = pk2(sp[6 * 33], sp[7 * 33]);
    *(u32x4*)(dst + (size_t)n * 1024 + k0 + 8 * c) = o; }
  asm volatile("s_waitcnt lgkmcnt(0)" ::: "memory");
}
constexpr int FA_AST = 528, FA_WST = 528;
__device__ __forceinline__ void p0_fa_item(const Frame& F, const Args& a, int item) {
  const int l = item >> 4, pn = 4 + ((item >> 3) & 1), g32 = item & 7, bj = g32 >> 2, wc = g32 & 3;
  LAS float* cs = (LAS float*)F.lds; LAS float* sn = cs + 64; LAS float* wfl = sn + 64;
  LAS unsigned char* Ai = F.lds + 512 + 16384;
  LAS unsigned char* Wi = F.lds + F.wave * (32 * FA_WST);
  __syncthreads();
  if (F.tid < 64) { float s_, c_; sincospif(2.f * F.tid / 64.f, &s_, &c_); cs[F.tid] = c_; sn[F.tid] = s_; }
  const float* wf = opq(a.in[12]) + (size_t)l * 256 * 256;
  const int slice0 = 32 * (pn - 4) + 16 * bj + 4 * wc;
  for (int i = F.tid; i < 1024; i += 512) { const int r = i >> 2, q = i & 3; *(LAS f32x4*)(wfl + r * 16 + 4 * q) = *(const f32x4*)(wf + (size_t)r * 256 + 4 * slice0 + 4 * q); }
  __syncthreads();
  {
    const int c = F.tid & 255, part = F.tid >> 8, g = c >> 6, jj = c & 63;
    f32x4 acc[4];
#pragma unroll
    for (int q = 0; q < 4; ++q) acc[q] = (f32x4){0.f, 0.f, 0.f, 0.f};
#pragma unroll 4
    for (int m = 0; m < 64; ++m) { const int idx = (m * jj) & 63; const float t = part ? -sn[idx] : cs[idx];
#pragma unroll
      for (int q = 0; q < 4; ++q) acc[q] += t * *(LAS const f32x4*)(wfl + (g * 64 + m) * 16 + 4 * q); }
#pragma unroll
    for (int fq = 0; fq < 4; ++fq)
#pragma unroll
      for (int j = 0; j < 4; ++j) *(LAS unsigned short*)(Ai + (8 * fq + 4 * part + j) * FA_AST + c * 2) = (unsigned short)f2bf(acc[fq][j] * 0.125f);
  }
  __syncthreads();
  const int r32 = F.lane & 31, hi = F.lane >> 5;
  bf16x8 af[16];
#pragma unroll
  for (int s = 0; s < 16; ++s) af[s] = *(LAS const bf16x8*)(Ai + r32 * FA_AST + (16 * s + 8 * hi) * 2);
  __syncthreads();
  const float* Win = opq(a.in[7]) + (size_t)l * 1024 * PWW + O_BV;
  bf16* dst = (bf16*)(opq(a.ws) + WS_W1T) + ((size_t)l * N1 + pn * 256 + 32 * g32) * 1024;
  for (int kb = 0; kb < 4; ++kb) {
    const int k0 = F.wave * 128 + kb * 32;
#pragma unroll
    for (int rh = 0; rh < 2; ++rh) { f32x4 w[16];
#pragma unroll
      for (int r = 0; r < 16; ++r) w[r] = *(const f32x4*)(Win + (size_t)(k0 + 16 * rh + r) * PWW + 4 * F.lane);
#pragma unroll
      for (int r = 0; r < 16; ++r) *(LAS u32x2*)(Wi + (16 * rh + r) * FA_WST + 8 * F.lane) = (u32x2){pk2(w[r].x, w[r].y), pk2(w[r].z, w[r].w)}; }
    asm volatile("s_waitcnt lgkmcnt(0)" ::: "memory");
    f32x16 acc;
#pragma unroll
    for (int i = 0; i < 16; ++i) acc[i] = 0.f;
#pragma unroll
    for (int s = 0; s < 16; ++s) { const bf16x8 bfr = *(LAS const bf16x8*)(Wi + r32 * FA_WST + (16 * s + 8 * hi) * 2); acc = __builtin_amdgcn_mfma_f32_32x32x16_bf16(af[s], bfr, acc, 0, 0, 0); }
#pragma unroll
    for (int r = 0; r < 16; ++r) dst[(size_t)crow(r, hi) * 1024 + k0 + r32] = (bf16)f2bf(acc[r]);
    asm volatile("s_waitcnt lgkmcnt(0)" ::: "memory");
  }
  __syncthreads();
}
#ifndef P0_REPS
#define P0_REPS 1
#endif
__device__ __forceinline__ void p0_prologue(const Frame& F0, const Args& a) {
#pragma clang loop unroll(disable)
 for (int rep_ = 0; rep_ < P0_REPS; ++rep_) {
  const Frame F = relaunder(F0);
  unsigned char* ws = opq(a.ws);
#ifndef RP_T
#define RP_T 1
#endif
  for (int q_ = 0; q_ < RP_T; ++q_)
  { const int gt = F.vcu * 512 + F.tid, GT = F.G * 512;
    float* rope = (float*)(ws + WS_ROPE);
    for (int i = gt; i < 1024; i += GT) { const int pos = i >> 4, f = i & 15; const float ang = (float)pos * powf(10000.f, -(float)f / 16.f); rope[i] = cosf(ang); rope[1024 + i] = sinf(ang); }
    bf16* wc = (bf16*)(ws + WS_WC);
    for (int i = gt; i < 128 * 128; i += GT) { const int r = i >> 7, c = i & 127, rr = r & 63, cc = c & 63; float s_, c_; sincospif(2.f * (float)((rr * cc) & 63) / 64.f, &s_, &c_);
      float v; if (r < 64) v = c < 64 ? c_ : s_; else v = c < 64 ? -s_ : c_; wc[i] = (bf16)f2bf(v * 0.125f); }
    bf16* cs256 = (bf16*)(ws + WS_CS256);
    for (int i = gt; i < 256 * 512; i += GT) { const int k = i >> 9, n = i & 511, nn = n & 255; float s_, c_; sincospif(2.f * (float)((k * nn) & 255) / 256.f, &s_, &c_); cs256[i] = (bf16)f2bf((n < 256 ? c_ : s_) * 0.0625f); }
  }
#ifndef RP_A
#define RP_A 1
#define RP_F 1
#define RP_W 1
#endif
  for (int it = F.vcu; it < 256 + 32; it += F.G) { if (it < 256) { for (int q_ = 0; q_ < RP_A; ++q_) p0_ada_item(F, a, it); } else { for (int q_ = 0; q_ < RP_F; ++q_) p0_fa_item(F, a, it - 256); } }
  LAS float* scr = (LAS float*)(F.lds + F.wave * 16384);
  const int gw = F.vcu * 8 + F.wave, NGW = F.G * 8;
  constexpr int I_DIR = 11 * 8 * 16, I_LA = 8 * 16, I_W2 = 32 * 16, I_L = I_DIR + I_LA + I_W2;
  for (int q_ = 0; q_ < RP_W; ++q_)
  for (int it = gw; it < 2 * I_L; it += NGW) {
    const int l = it / I_L; int r = it % I_L;
    const float* Win = opq(a.in[7]) + (size_t)l * 1024 * PWW;
    bf16* W1T = (bf16*)(ws + WS_W1T) + (size_t)l * N1 * 1024;
    if (r < I_DIR) {
      const int ti = r / 128, g32 = (r >> 4) & 7, kb = r & 15;
      const int pn = ti < 3 ? ti : ti + 3;
      const int bj = g32 >> 2, wc = g32 & 3, mcb = 64 * wc + 32 * bj;
      int cbase = 0, pk = 0; float sc = 1.f;
      switch (pn) {
        case 0: if (mcb < 128) { cbase = O_AQ + mcb; sc = GLA_QS; } else cbase = O_AK + mcb - 128; break;
        case 1: cbase = O_AV + mcb; break;
        case 2: cbase = O_AG + mcb; break;
        case 6: cbase = O_BG + mcb; break;
        case 7: cbase = O_CQ + mcb; pk = 1; break;
        case 8: if (wc < 2) { cbase = O_CK + mcb; pk = 1; } else cbase = O_CV + mcb - 128; break;
        case 9: cbase = O_CG + mcb; break;
        case 10: cbase = O_DQ + mcb; break;
        case 11: cbase = O_DK + mcb; break;
        case 12: cbase = O_DV + mcb; break;
        default: cbase = O_DG + mcb; break;
      }
      p0_tr_item(Win, PWW, cbase, pk, sc, W1T + (size_t)(pn * 256 + 32 * g32) * 1024, kb * 64, scr, F.lane);
    } else if (r < I_DIR + I_LA) {
      r -= I_DIR; const int g32 = r >> 4, kb = r & 15, bj = g32 >> 2, wc = g32 & 3, mcb = 64 * wc + 32 * bj;
      p0_la_item(Win, opq(a.in[9]) + (size_t)l * 2 * 16 * 128, mcb >> 7, mcb & 127, W1T + (size_t)(3 * 256 + 32 * g32) * 1024, kb * 64, scr, F.lane);
    } else {
      r -= I_DIR + I_LA; const int g = r >> 4, kb = r & 15;
      p0_tr_item(opq(a.in[8]) + (size_t)l * 1024 * 1024, 1024, 32 * g, 0, 1.f, (bf16*)(ws + WS_W2T) + ((size_t)l * 1024 + 32 * g) * 1024, kb * 64, scr, F.lane);
    }
  }
 }
}
__device__ __forceinline__ void p1_prenorm(const Frame& F0, const Args& a, int layer) {
  const Frame F = relaunder(F0);
  const float* xin = layer == 0 ? opq(a.in[0]) : opq(a.out);
  const float* cin = layer == 0 ? opq(a.in[2]) : (const float*)(opq(a.ws) + WS_CTX1);
  const float* nw = opq(a.in[4]) + layer * 1024;
  const float* MOD = (const float*)(opq(a.ws) + WS_MOD) + (size_t)layer * 5 * 3072;
  bf16* H = (bf16*)(opq(a.ws) + WS_H);
  const int gw = F.vcu * 8 + F.wave, NGW = F.G * 8;
  constexpr int RB = 3;
  f32x4 w_[4];
#pragma unroll
  for (int j = 0; j < 4; ++j) w_[j] = *(const f32x4*)(nw + 4 * F.lane + 256 * j);
  for (int row0 = gw; row0 < MT; row0 += RB * NGW) {
    f32x4 v[RB][4], sc_[RB][4], sh_[RB][4]; float ss[RB];
#pragma unroll
    for (int q = 0; q < RB; ++q) { int row = row0 + q * NGW; row = row < MT ? row : MT - 1;
      const float* src; const float* mod;
      if (row < MLAT) { src = xin + (size_t)row * 1024; mod = MOD + (size_t)(row >> 12) * 3072; }
      else { src = cin + (size_t)(row - MLAT) * 1024; mod = MOD + (size_t)4 * 3072; }
      const f32x4* xr = (const f32x4*)src + F.lane;
#pragma unroll
      for (int j = 0; j < 4; ++j) { v[q][j] = xr[64 * j]; sc_[q][j] = *(const f32x4*)(mod + 1024 + 4 * F.lane + 256 * j); sh_[q][j] = *(const f32x4*)(mod + 4 * F.lane + 256 * j); } }
    __builtin_amdgcn_sched_barrier(0);
#pragma unroll
    for (int q = 0; q < RB; ++q) { float s_ = 0.f;
#pragma unroll
      for (int j = 0; j < 4; ++j) s_ += (v[q][j].x * v[q][j].x + v[q][j].y * v[q][j].y) + (v[q][j].z * v[q][j].z + v[q][j].w * v[q][j].w);
      ss[q] = s_; }
#pragma unroll
    for (int o = 1; o < 64; o <<= 1)
#pragma unroll
      for (int q = 0; q < RB; ++q) ss[q] += __shfl_xor(ss[q], o);
#pragma unroll
    for (int q = 0; q < RB; ++q) { const int row = row0 + q * NGW; if (row >= MT) continue;
      const float rs = 1.0f / sqrtf(ss[q] * (1.f / 1024.f) + 1e-6f);
      unsigned long long* o8 = (unsigned long long*)(H + (size_t)row * 1024) + F.lane;
#pragma unroll
      for (int j = 0; j < 4; ++j) {
        const f32x4 h = v[q][j] * rs * w_[j] * (1.f + sc_[q][j]) + sh_[q][j];
        o8[64 * j] = (unsigned long long)pk2(h.x, h.y) | ((unsigned long long)pk2(h.z, h.w) << 32);
      } }
  }
}
}

namespace mk {
using pg8::Unit;
struct EpiIn {
  static constexpr bool PERM = true, AFTER_DRAIN = false;
  bf16* PLB; float* LA; bf16* FA2; const float* decb; const float* rope; const float* cqn; const float* ckn; const float* dqn; const float* dkn;
  __device__ __forceinline__ void operator()(const f32x4 (&acc)[2][2][4][2], const Unit& u, int wr, int wc, int fr, int fq) const {
    const int pn = u.pn;
    const bool ctxrows = u.pm >= 64;
    int kind, slot = 0; const float* nw = nullptr; bool roped = false; float qs = 1.f;
    switch (pn) {
      case 0: kind = 0; slot = S_AQK; break;
      case 1: kind = 0; slot = S_AV; break;
      case 2: kind = 1; slot = S_AG; break;
      case 3: kind = 2; break;
      case 4: case 5: kind = 3; break;
      case 6: kind = 1; slot = S_BG; break;
      case 7: kind = 4; slot = S_CQ; nw = cqn; roped = true; qs = QSCALE; break;
      case 8: slot = S_CKV; if (wc < 2) { kind = 4; nw = ckn; roped = true; } else kind = 0; break;
      case 9: kind = 1; slot = S_CG; break;
      case 10: kind = 4; slot = S_DQ; nw = dqn; qs = QSCALE; break;
      case 11: kind = 4; slot = S_DK; nw = dkn; break;
      case 12: kind = 0; slot = S_DV; break;
      default: kind = 1; slot = S_DG; break;
    }
    const int row0 = u.pm * 256 + wr * 64 + fr;
    float w8[2][8];
    if (kind == 4) {
#pragma unroll
      for (int bj = 0; bj < 2; ++bj)
#pragma unroll
        for (int s = 0; s < 8; ++s) { const int d = roped ? (32 * bj + 16 * (s >> 2) + 4 * fq + (s & 3)) : (32 * bj + 8 * fq + s); w8[bj][s] = nw[d] * qs; }
    }
#pragma unroll
    for (int ai = 0; ai < 2; ++ai)
#pragma unroll
      for (int m = 0; m < 4; ++m) {
        const int r = row0 + ai * 128 + m * 16;
        float v[2][8];
#pragma unroll
        for (int bj = 0; bj < 2; ++bj)
#pragma unroll
          for (int n = 0; n < 2; ++n)
#pragma unroll
            for (int e = 0; e < 4; ++e) v[bj][4 * n + e] = acc[ai][bj][m][n][e];
        if (kind == 2) {
#pragma unroll
          for (int bj = 0; bj < 2; ++bj) { const int mc = 64 * wc + 32 * bj + 8 * fq; float* dp = LA + (size_t)r * 256 + mc;
            f32x4 o0, o1;
#pragma unroll
            for (int e = 0; e < 4; ++e) { o0[e] = flogsig(v[bj][e] + decb[mc + e]) * 0.0625f; o1[e] = flogsig(v[bj][4 + e] + decb[mc + 4 + e]) * 0.0625f; }
            *(f32x4*)dp = o0; *(f32x4*)(dp + 4) = o1; }
        } else if (kind == 3) {
          int b, t; if (!ctxrows) { b = r >> 12; t = r & 4095; } else { const int rc = r - MLAT; b = rc >> 8; t = SEQ + (rc & 255); }
#pragma unroll
          for (int bj = 0; bj < 2; ++bj) { const int slice = 32 * (pn - 4) + 16 * bj + 4 * wc + fq;
            u32x4 o; o.x = pk2(v[bj][0], v[bj][1]); o.y = pk2(v[bj][2], v[bj][3]); o.z = pk2(v[bj][4], v[bj][5]); o.w = pk2(v[bj][6], v[bj][7]);
            *(u32x4*)(FA2 + (((size_t)b * 64 + slice) * TROW + t) * 8) = o; }
        } else {
          if (kind == 1) {
#pragma unroll
            for (int bj = 0; bj < 2; ++bj)
#pragma unroll
              for (int s = 0; s < 8; ++s) v[bj][s] = fsilu(v[bj][s]);
          } else if (kind == 4) {
            float ss = 0.f;
#pragma unroll
            for (int bj = 0; bj < 2; ++bj)
#pragma unroll
              for (int s = 0; s < 8; ++s) ss += v[bj][s] * v[bj][s];
            ss += __shfl_xor(ss, 16); ss += __shfl_xor(ss, 32);
            const float rs = 1.0f / sqrtf(ss * (1.f / 64.f) + 1e-6f);
#pragma unroll
            for (int bj = 0; bj < 2; ++bj)
#pragma unroll
              for (int s = 0; s < 8; ++s) v[bj][s] *= rs * w8[bj][s];
            if (roped && !ctxrows) {
              const int t = r & 4095;
#pragma unroll
              for (int bj = 0; bj < 2; ++bj) { const int pos = bj == 0 ? (t >> 6) : (t & 63);
                const f32x4 c4 = *(const f32x4*)(rope + pos * 16 + 4 * fq), s4 = *(const f32x4*)(rope + 1024 + pos * 16 + 4 * fq);
#pragma unroll
                for (int e = 0; e < 4; ++e) { const float x1 = v[bj][e], x2 = v[bj][4 + e]; v[bj][e] = x1 * c4[e] - x2 * s4[e]; v[bj][4 + e] = x2 * c4[e] + x1 * s4[e]; } }
            }
          }
#pragma unroll
          for (int bj = 0; bj < 2; ++bj) { const int mc = 64 * wc + 32 * bj + 8 * fq;
            u32x4 o; o.x = pk2(v[bj][0], v[bj][1]); o.y = pk2(v[bj][2], v[bj][3]); o.z = pk2(v[bj][4], v[bj][5]); o.w = pk2(v[bj][6], v[bj][7]);
            *(u32x4*)(PLB + (size_t)r * PLW + slot * 256 + mc) = o; }
        }
        asm volatile("" ::: "memory");
      }
  }
};
struct EpiOut {
  static constexpr bool PERM = true, AFTER_DRAIN = false;
  const float* xin; const float* cin; float* xout; float* cout; const float* MODl;
  __device__ __forceinline__ void operator()(const f32x4 (&acc)[2][2][4][2], const Unit& u, int wr, int wc, int fr_, int fq_) const {
    int fr = fr_, fq = fq_; asm volatile("" : "+v"(fr), "+v"(fq));
    const int row0 = u.pm * 256 + wr * 64 + fr, col0 = u.pn * 256 + wc * 32 + 8 * fq;
    const bool ctxrows = u.pm >= 64;
    const float* gate = MODl + (size_t)(ctxrows ? 4 : (u.pm >> 4)) * 3072 + 2048;
    f32x4 gv[2][2];
#pragma unroll
    for (int bj = 0; bj < 2; ++bj)
#pragma unroll
      for (int n = 0; n < 2; ++n) gv[bj][n] = *(const f32x4*)(gate + col0 + bj * 128 + n * 4);
#pragma unroll
    for (int ai = 0; ai < 2; ++ai)
#pragma unroll
      for (int m = 0; m < 4; ++m) {
        const int r = row0 + ai * 128 + m * 16;
        const float* sp; float* dp;
        if (!ctxrows) { sp = xin + (size_t)r * 1024 + col0; dp = xout + (size_t)r * 1024 + col0; }
        else { sp = cin + (size_t)(r - MLAT) * 1024 + col0; dp = cout + (size_t)(r - MLAT) * 1024 + col0; }
        f32x4 xv[2][2];
#pragma unroll
        for (int bj = 0; bj < 2; ++bj)
#pragma unroll
          for (int n = 0; n < 2; ++n) xv[bj][n] = *(const f32x4*)(sp + bj * 128 + n * 4);
#pragma unroll
        for (int bj = 0; bj < 2; ++bj)
#pragma unroll
          for (int n = 0; n < 2; ++n) *(f32x4*)(dp + bj * 128 + n * 4) = xv[bj][n] + gv[bj][n] * acc[ai][bj][m][n];
        asm volatile("" ::: "memory");
      }
  }
};
__device__ __forceinline__ void p2_inproj(const Frame& F, const Args& a, int layer) {
  unsigned char* ws = opq(a.ws);
  pg8::Gemm g{(const pg8::bf16_t*)(ws + WS_H), (const pg8::bf16_t*)(ws + WS_W1T) + (size_t)layer * N1 * 1024, MT, N1, 1024};
  pg8::StaticOrder S; S.init(MT, N1, F.G, (int)blockIdx.x);
  EpiIn E{(bf16*)(ws + WS_PLB), (float*)(ws + WS_LA), (bf16*)(ws + WS_FA2), opq(a.in[10]) + layer * 256, (const float*)(ws + WS_ROPE),
          opq(a.in[13]) + layer * 64, opq(a.in[14]) + layer * 64, opq(a.in[16]) + layer * 64, opq(a.in[17]) + layer * 64};
#ifndef P2_REPS
#define P2_REPS 1
#endif
#pragma clang loop unroll(disable)
  for (int rep_ = 0; rep_ < P2_REPS; ++rep_) pg8::gemm_phase<EpiIn, pg8::StaticOrder>(F.lds, g, S, E, nullptr);
}

__device__ __forceinline__ void ctx_out_item(const Frame& F, const Args& a, int item) {
  unsigned char* ws = opq(a.ws);
  const bf16* Yc = (const bf16*)(ws + WS_H) + (size_t)MLAT * 1024; const bf16* W2 = (const bf16*)(ws + WS_W2T);
  const int tm = item >> 4, tn = item & 15, sub = F.wave & 3, kh = F.wave >> 2, r32 = F.lane & 31, hi = F.lane >> 5;
  const int row0 = 64 * tm + 32 * (sub >> 1), col0 = 64 * tn + 32 * (sub & 1);
  const bf16* ap = Yc + (size_t)(row0 + r32) * 1024 + kh * 512 + 8 * hi;
  const bf16* bp = W2 + (size_t)(col0 + r32) * 1024 + kh * 512 + 8 * hi;
  f32x16 acc;
#pragma unroll
  for (int i = 0; i < 16; ++i) acc[i] = 0.f;
#pragma unroll 1
  for (int sb = 0; sb < 4; ++sb) {
    bf16x8 af[8], bf[8];
#pragma unroll
    for (int s = 0; s < 8; ++s) { af[s] = *(const bf16x8*)(ap + (sb * 8 + s) * 16); bf[s] = *(const bf16x8*)(bp + (sb * 8 + s) * 16); }
    __builtin_amdgcn_sched_barrier(0);
#pragma unroll
    for (int s = 0; s < 8; ++s) acc = __builtin_amdgcn_mfma_f32_32x32x16_bf16(af[s], bf[s], acc, 0, 0, 0);
  }
  LAS float* X = (LAS float*)F.lds + sub * 1024;
  __syncthreads();
  if (kh == 1) {
#pragma unroll
    for (int r = 0; r < 16; ++r) X[r * 64 + F.lane] = acc[r];
  }
  __syncthreads();
  if (kh == 0) {
    const float* cin = opq(a.in[2]); float* cout = (float*)(ws + WS_CTX1);
    const float gate = ((const float*)(ws + WS_MOD))[4 * 3072 + 2048 + col0 + r32];
    float ci[16];
#pragma unroll
    for (int r = 0; r < 16; ++r) ci[r] = cin[(size_t)(row0 + crow(r, hi)) * 1024 + col0 + r32];
    __builtin_amdgcn_sched_barrier(0);
#pragma unroll
    for (int r = 0; r < 16; ++r) { const size_t o = (size_t)(row0 + crow(r, hi)) * 1024 + col0 + r32; cout[o] = ci[r] + gate * (acc[r] + X[r * 64 + F.lane]); }
  }
}
__device__ __forceinline__ void p5_outproj(const Frame& F, const Args& a, int layer) {
  unsigned char* ws = opq(a.ws);
  const int M = MLAT;
  pg8::Gemm g{(const pg8::bf16_t*)(ws + WS_H), (const pg8::bf16_t*)(ws + WS_W2T) + (size_t)layer * 1024 * 1024, M, 1024, 1024};
  pg8::StaticOrder S; S.init(M, 1024, F.G, (int)blockIdx.x);
  EpiOut E{layer == 0 ? opq(a.in[0]) : opq(a.out), layer == 0 ? opq(a.in[2]) : (const float*)(ws + WS_CTX1), opq(a.out), (float*)(ws + WS_CTX1), (const float*)(ws + WS_MOD) + (size_t)layer * 5 * 3072};
#ifndef P5_REPS
#define P5_REPS 1
#endif
#pragma clang loop unroll(disable)
  for (int rep_ = 0; rep_ < (layer == 0 ? P5_REPS : 1); ++rep_) pg8::gemm_phase<EpiOut, pg8::StaticOrder>(F.lds, g, S, E, nullptr);
  if (layer == 0) { const Frame F2 = relaunder(F); for (int it = F2.vcu; it < 256; it += F2.G) ctx_out_item(F2, a, it); }
}
}

namespace mk {
typedef short v4i16_t __attribute__((ext_vector_type(4)));
__device__ __forceinline__ s16x4 vtr(LAS const unsigned char* p) { return __builtin_bit_cast(s16x4, __builtin_amdgcn_ds_read_tr16_b64_v4i16((LAS v4i16_t*)p)); }
struct AttnState { float m, l; f32x16 o0, o1; };
template <class MaskF>
__device__ __forceinline__ void attn_tile(AttnState& st, const bf16x8 (&qf)[4], LAS const unsigned char* Kt, LAS const unsigned char* Vt, int lane, MaskF&& maskf) {
  const int r32 = lane & 31, hi = lane >> 5;
  f32x16 p0, p1;
  const int ksw = (r32 >> 1) & 7;
  bf16x8 ka[4], kb[4];
#pragma unroll
  for (int s = 0; s < 4; ++s) { const int ch = ((2 * s + hi) ^ ksw) << 4; ka[s] = *(LAS const bf16x8*)(Kt + r32 * 128 + ch); kb[s] = *(LAS const bf16x8*)(Kt + (32 + r32) * 128 + ch); }
  { const f32x16 z = {0.f, 0.f, 0.f, 0.f, 0.f, 0.f, 0.f, 0.f, 0.f, 0.f, 0.f, 0.f, 0.f, 0.f, 0.f, 0.f};
    p0 = __builtin_amdgcn_mfma_f32_32x32x16_bf16(ka[0], qf[0], z, 0, 0, 0); p1 = __builtin_amdgcn_mfma_f32_32x32x16_bf16(kb[0], qf[0], z, 0, 0, 0); }
#pragma unroll
  for (int s = 1; s < 4; ++s) { p0 = __builtin_amdgcn_mfma_f32_32x32x16_bf16(ka[s], qf[s], p0, 0, 0, 0); p1 = __builtin_amdgcn_mfma_f32_32x32x16_bf16(kb[s], qf[s], p1, 0, 0, 0); }
  maskf(p0, p1);
  float ps = 0.f;
#pragma unroll
  for (int i = 0; i < 16; ++i) { p0[i] = __builtin_amdgcn_exp2f(p0[i]); p1[i] = __builtin_amdgcn_exp2f(p1[i]); ps += p0[i] + p1[i]; }
  st.l += ps;
  u32x4 pw[4];
#pragma unroll
  for (int k = 0; k < 2; ++k) {
    pw[k] = (u32x4){pk2(p0[8 * k + 0], p0[8 * k + 1]), pk2(p0[8 * k + 2], p0[8 * k + 3]), pk2(p0[8 * k + 4], p0[8 * k + 5]), pk2(p0[8 * k + 6], p0[8 * k + 7])};
    pw[2 + k] = (u32x4){pk2(p1[8 * k + 0], p1[8 * k + 1]), pk2(p1[8 * k + 2], p1[8 * k + 3]), pk2(p1[8 * k + 4], p1[8 * k + 5]), pk2(p1[8 * k + 6], p1[8 * k + 7])};
  }
  const int q = (lane & 15) >> 2, p = lane & 3, gsel = (lane >> 4) & 1;
  const int vrow = (4 * hi + q) * 128 + 8 * (p & 1);
  const int chb = 2 * gsel + (p >> 1);
#pragma unroll
  for (int ks = 0; ks < 4; ++ks) {
    const int c0_ = ((chb | ((0 ^ (q >> 1)) << 2)) << 4), c1_ = ((chb | ((1 ^ (q >> 1)) << 2)) << 4);
    const s16x4 l0 = vtr(Vt + ks * 2048 + vrow + c0_), h0 = vtr(Vt + ks * 2048 + 1024 + vrow + c0_), l1 = vtr(Vt + ks * 2048 + vrow + c1_), h1 = vtr(Vt + ks * 2048 + 1024 + vrow + c1_);
    const bf16x8 va0 = (bf16x8){l0[0], l0[1], l0[2], l0[3], h0[0], h0[1], h0[2], h0[3]}, va1 = (bf16x8){l1[0], l1[1], l1[2], l1[3], h1[0], h1[1], h1[2], h1[3]};
    st.o0 = __builtin_amdgcn_mfma_f32_32x32x16_bf16(va0, __builtin_bit_cast(bf16x8, pw[ks]), st.o0, 0, 0, 0);
    st.o1 = __builtin_amdgcn_mfma_f32_32x32x16_bf16(va1, __builtin_bit_cast(bf16x8, pw[ks]), st.o1, 0, 0, 0);
  }
}
__device__ __forceinline__ void attn_store(const AttnState& st, float inv, const bf16* grow  , bf16* yrow  , int lane) {
  const int hi = lane >> 5;
  u32x2 gv[8];
#pragma unroll
  for (int i = 0; i < 8; ++i) gv[i] = *(const u32x2*)(grow + 32 * (i >> 2) + 8 * (i & 3) + 4 * hi);
  __builtin_amdgcn_sched_barrier(0);
#pragma unroll
  for (int d0 = 0; d0 < 2; ++d0)
#pragma unroll
    for (int gi = 0; gi < 4; ++gi) {
      const int db = 32 * d0 + 8 * gi + 4 * hi; const u32x2 g = gv[4 * d0 + gi];
      const f32x16& o = d0 == 0 ? st.o0 : st.o1;
      const float g0 = __uint_as_float(g.x << 16), g1 = __uint_as_float(g.x & 0xffff0000u), g2 = __uint_as_float(g.y << 16), g3 = __uint_as_float(g.y & 0xffff0000u);
      u32x2 ov; ov.x = pk2(o[4 * gi + 0] * inv * g0, o[4 * gi + 1] * inv * g1); ov.y = pk2(o[4 * gi + 2] * inv * g2, o[4 * gi + 3] * inv * g3);
      *(u32x2*)(yrow + db) = ov;
    }
}
template <int NH> struct TileRegs { u32x4 k[NH], v[NH]; };
template <int NH>
__device__ __forceinline__ void tile_load(TileRegs<NH>& R, const bf16* kbase  , const bf16* vbase, int tid) {
  const int key = tid >> 3, ch = tid & 7;
#pragma unroll
  for (int h = 0; h < NH; ++h) { R.k[h] = *(const u32x4*)(kbase + (size_t)key * PLW + h * 64 + ch * 8); R.v[h] = *(const u32x4*)(vbase + (size_t)key * PLW + h * 64 + ch * 8); }
}
template <int NH>
__device__ __forceinline__ void tile_store(const TileRegs<NH>& R, LAS unsigned char* buf, int tid) {
  const int key = tid >> 3, ch = tid & 7;
  const int ko = key * 128 + ((ch ^ ((key >> 1) & 7)) << 4), vo = key * 128 + ((ch ^ (((key >> 1) & 1) << 2)) << 4);
#pragma unroll
  for (int h = 0; h < NH; ++h) { *(LAS u32x4*)(buf + h * 8192 + ko) = R.k[h]; *(LAS u32x4*)(buf + NH * 8192 + h * 8192 + vo) = R.v[h]; }
}

template <int NH> struct TileRegs2 { TileRegs<NH> a, b; };
__device__ __forceinline__ void swa_item(const Frame& F0, const Args& a, int layer, int item) {
  const Frame F = relaunder(F0);
  unsigned char* ws = opq(a.ws);
  const bf16* PLB = (const bf16*)(ws + WS_PLB); bf16* Y = (bf16*)(ws + WS_H);
  const bool isctx = item >= 256;
  int b, kvh, n;
  if (!isctx) { b = item >> 6; kvh = (item >> 5) & 1; n = item & 31; } else { const int ci = item - 256; b = ci >> 2; kvh = (ci >> 1) & 1; n = ci & 1; }
  const int g = F.wave >> 2, quarter = F.wave & 3, hq = 2 * kvh + g, r32 = F.lane & 31, hi = F.lane >> 5;
  const int tq = 128 * n + 32 * quarter + r32;
  const size_t qrow = isctx ? (size_t)MLAT + b * CTX + tq : (size_t)b * SEQ + tq;
  bf16x8 qf[4];
#pragma unroll
  for (int s = 0; s < 4; ++s) qf[s] = *(const bf16x8*)(PLB + qrow * PLW + S_CQ * 256 + hq * 64 + 16 * s + 8 * hi);
  int jlo = 0, jhi = 0;
  if (!isctx) { jlo = n == 0 ? 1 : 0; jhi = n == 31 ? 2 : 3; }
  const int nloc = jhi - jlo, T = nloc + 2;
  const bf16* kcol = PLB + S_CKV * 256 + kvh * 64;
  auto tile_row = [&](int t) -> size_t { return t < nloc ? (size_t)b * SEQ + 128 * (n - 1 + jlo + t) : (size_t)MLAT + b * CTX + 128 * (t - nloc); };
  AttnState st; st.m = 0.f; st.l = 0.f;
#pragma unroll
  for (int i = 0; i < 16; ++i) { st.o0[i] = 0.f; st.o1[i] = 0.f; }
  TileRegs2<1> R;
  __syncthreads();
  { const size_t r0 = tile_row(0); tile_load<1>(R.a, kcol + r0 * PLW, kcol + 128 + r0 * PLW, F.tid); tile_load<1>(R.b, kcol + (r0 + 64) * PLW, kcol + 128 + (r0 + 64) * PLW, F.tid); }
  tile_store<1>(R.a, F.lds, F.tid); tile_store<1>(R.b, F.lds + 16384, F.tid);
  __syncthreads();
  for (int t = 0; t < T; ++t) {
    if (t + 1 < T) { const size_t r0 = tile_row(t + 1); tile_load<1>(R.a, kcol + r0 * PLW, kcol + 128 + r0 * PLW, F.tid); tile_load<1>(R.b, kcol + (r0 + 64) * PLW, kcol + 128 + (r0 + 64) * PLW, F.tid); }
    LAS const unsigned char* buf = F.lds + (t & 1) * 32768;
#pragma unroll
    for (int hf = 0; hf < 2; ++hf) {
      LAS const unsigned char* hb = buf + hf * 16384;
      if (t < nloc) {
        const int kb = 128 * (n - 1 + jlo + t) + 64 * hf, q0 = 128 * n + 32 * quarter;
        if (!(kb + 63 < q0 - 128 || kb > q0 + 31 + 128)) {
          const int dq = kb - tq;
          if (kb >= q0 + 31 - 128 && kb + 63 <= q0 + 128) attn_tile(st, qf, hb, hb + 8192, F.lane, [](f32x16&, f32x16&) {});
          else attn_tile(st, qf, hb, hb + 8192, F.lane, [&](f32x16& p0, f32x16& p1) {
#pragma unroll
            for (int r = 0; r < 16; ++r) { const int d0_ = dq + 128 + crow(r, hi), d1_ = d0_ + 32;
              p0[r] = ((unsigned)d0_ <= 256u) ? p0[r] : -INFINITY; p1[r] = ((unsigned)d1_ <= 256u) ? p1[r] : -INFINITY; } });
        }
      } else attn_tile(st, qf, hb, hb + 8192, F.lane, [](f32x16&, f32x16&) {});
    }
    if (t + 1 < T) { tile_store<1>(R.a, F.lds + ((t + 1) & 1) * 32768, F.tid); tile_store<1>(R.b, F.lds + ((t + 1) & 1) * 32768 + 16384, F.tid); }
    __syncthreads();
  }
  float l = st.l + __shfl_xor(st.l, 32);
  const float sk2 = opq(a.in[15])[layer * 4 + hq] * LOG2E;
  const float mnew = fmaxf(st.m, sk2), al = __builtin_amdgcn_exp2f(st.m - mnew);
  l = l * al + __builtin_amdgcn_exp2f(sk2 - mnew);
  int qr = (int)qrow; asm volatile("" : "+v"(qr));
  attn_store(st, al / l, PLB + (size_t)qr * PLW + S_CG * 256 + hq * 64, Y + (size_t)qr * 1024 + 512 + hq * 64, F.lane);
}
__device__ __forceinline__ void na_item(const Frame& F0, const Args& a, int layer, int item) {
  const Frame F = relaunder(F0);
  unsigned char* ws = opq(a.ws);
  const bf16* PLB = (const bf16*)(ws + WS_PLB); bf16* Y = (bf16*)(ws + WS_H);
  const bool isctx = item >= 256;
  int b, r;
  if (!isctx) { b = item >> 6; r = item & 63; } else { const int ci = item - 256; b = ci >> 2; r = ci & 3; }
  const int head = F.wave >> 1, half = F.wave & 1, r32 = F.lane & 31, hi = F.lane >> 5;
  const int qc = 32 * half + r32;
  const size_t qrow = isctx ? (size_t)MLAT + b * CTX + 64 * r + qc : (size_t)b * SEQ + 64 * r + qc;
  bf16x8 qf[4];
#pragma unroll
  for (int s = 0; s < 4; ++s) qf[s] = *(const bf16x8*)(PLB + qrow * PLW + S_DQ * 256 + head * 64 + 16 * s + 8 * hi);
  int rs = r - 4; rs = rs < 0 ? 0 : (rs > 56 ? 56 : rs);
  const int nloc = isctx ? 0 : 8, T = nloc + 4;
  auto tile_row = [&](int t) -> size_t { return t < nloc ? (size_t)b * SEQ + 64 * (rs + t) : (size_t)MLAT + b * CTX + 64 * (t - nloc); };
  const bf16* kcol = PLB + S_DK * 256; const bf16* vcol = PLB + S_DV * 256;
  LAS float* btab = (LAS float*)(F.lds + 2 * 65536);
  AttnState st; st.m = 0.f; st.l = 0.f;
#pragma unroll
  for (int i = 0; i < 16; ++i) { st.o0[i] = 0.f; st.o1[i] = 0.f; }
  TileRegs<4> R;
  __syncthreads();
  {
    const float* rb = opq(a.in[18]) + (size_t)layer * 4 * 15 * 31; float t_[15];
#pragma unroll
    for (int i = 0; i < 15; ++i) { const int ix = F.tid + 512 * i, hd = ix >> 7, dx = (ix & 127) - 63; const bool ok = dx >= -15 && dx <= 15; t_[i] = ok ? rb[hd * 31 + dx + 15] : 0.f; }
#pragma unroll
    for (int i = 0; i < 15; ++i) btab[F.tid + 512 * i] = t_[i] * LOG2E; }
  tile_load<4>(R, kcol + tile_row(0) * PLW, vcol + tile_row(0) * PLW, F.tid);
  tile_store<4>(R, F.lds, F.tid);
  __syncthreads();
  int c0 = qc - 8; c0 = c0 < 0 ? 0 : (c0 > 48 ? 48 : c0);
  for (int t = 0; t < T; ++t) {
    if (t + 1 < T) tile_load<4>(R, kcol + tile_row(t + 1) * PLW, vcol + tile_row(t + 1) * PLW, F.tid);
    LAS const unsigned char* buf = F.lds + (t & 1) * 65536;
    if (t < nloc) {
      const int dy = rs + t - r + 7;
      int c0l = c0; asm volatile("" : "+v"(c0l));
      LAS const float* bt = btab + (head * 15 + dy) * 128 + 63 - qc + 4 * hi;
      attn_tile(st, qf, buf + head * 8192, buf + 32768 + head * 8192, F.lane, [&](f32x16& p0, f32x16& p1) {
        float bb[16];
#pragma unroll
        for (int rr = 0; rr < 16; ++rr) bb[rr] = bt[(rr & 3) + 8 * (rr >> 2)];
#pragma unroll
        for (int rr = 0; rr < 16; ++rr) p0[rr] = ((unsigned)((rr & 3) + 8 * (rr >> 2) + 4 * hi - c0l) < 16u) ? p0[rr] + bb[rr] : -INFINITY;
#pragma unroll
        for (int rr = 0; rr < 16; ++rr) bb[rr] = bt[(rr & 3) + 8 * (rr >> 2) + 32];
#pragma unroll
        for (int rr = 0; rr < 16; ++rr) p1[rr] = ((unsigned)((rr & 3) + 8 * (rr >> 2) + 32 + 4 * hi - c0l) < 16u) ? p1[rr] + bb[rr] : -INFINITY; });
    } else attn_tile(st, qf, buf + head * 8192, buf + 32768 + head * 8192, F.lane, [](f32x16&, f32x16&) {});
    if (t + 1 < T) tile_store<4>(R, F.lds + ((t + 1) & 1) * 65536, F.tid);
    __syncthreads();
  }
  const float l = st.l + __shfl_xor(st.l, 32);
  int qr = (int)qrow; asm volatile("" : "+v"(qr));
  attn_store(st, 1.f / l, PLB + (size_t)qr * PLW + S_DG * 256 + head * 64, Y + (size_t)qr * 1024 + 768 + head * 64, F.lane);
}
}

namespace mk {
constexpr int XT_STRIDE = 272;
constexpr int FFT_WC = 256 * XT_STRIDE;
__device__ __forceinline__ void fft_item(const Frame& F0, const Args& a, int item) {
  const Frame F = relaunder(F0);
  unsigned char* ws = opq(a.ws);
  const bf16* PLB = (const bf16*)(ws + WS_PLB); bf16* Y = (bf16*)(ws + WS_H);
  const int b = item >> 6, slice = item & 63, r32 = F.lane & 31, hi = F.lane >> 5, w = F.wave;
  LAS unsigned char* Xt = F.lds; LAS unsigned char* Wl = F.lds + FFT_WC;
  __syncthreads();
  {
    const bf16* WC = (const bf16*)(ws + WS_WC);
    u32x4 wt[4];
#pragma unroll
    for (int i = 0; i < 4; ++i) { const int idx = F.tid + 512 * i, row = idx >> 4, ch = idx & 15; wt[i] = *(const u32x4*)(WC + row * 128 + ch * 8); }
    const bf16* src = (const bf16*)(ws + WS_FA2) + ((size_t)b * 64 + slice) * TROW * 8;
    u32x4 v[8];
#pragma unroll
    for (int i = 0; i < 8; ++i) v[i] = *(const u32x4*)(src + (size_t)(F.tid + 512 * i) * 8);
    __builtin_amdgcn_sched_barrier(0);
#pragma unroll
    for (int i = 0; i < 4; ++i) { const int idx = F.tid + 512 * i, row = idx >> 4, ch = idx & 15; *(LAS u32x4*)(Wl + row * XT_STRIDE + ch * 16) = wt[i]; }
#pragma unroll
    for (int i = 0; i < 8; ++i) { const int t = F.tid + 512 * i, n1 = t >> 6, n2 = t & 63;
      const unsigned vv[4] = {v[i].x, v[i].y, v[i].z, v[i].w};
#pragma unroll
      for (int j = 0; j < 8; ++j) { const int c = j & 3, part = j >> 2; const unsigned short e = (unsigned short)((j & 1) ? (vv[j >> 1] >> 16) : (vv[j >> 1] & 0xffffu));
        *(LAS unsigned short*)(Xt + (n2 * 4 + c) * XT_STRIDE + (part * 64 + n1) * 2) = e; } }
  }
  __syncthreads();
  f32x16 acc[4];
#pragma unroll
  for (int rb = 0; rb < 4; ++rb)
#pragma unroll
    for (int i = 0; i < 16; ++i) acc[rb][i] = 0.f;
  {
    bf16x8 bf[8];
#pragma unroll
    for (int s = 0; s < 8; ++s) bf[s] = *(LAS const bf16x8*)(Xt + (32 * w + r32) * XT_STRIDE + (16 * s + 8 * hi) * 2);
#pragma unroll
    for (int rb = 0; rb < 4; ++rb)
#pragma unroll
      for (int s = 0; s < 8; ++s) { const bf16x8 af = *(LAS const bf16x8*)(Wl + (32 * rb + r32) * XT_STRIDE + (16 * s + 8 * hi) * 2); acc[rb] = __builtin_amdgcn_mfma_f32_32x32x16_bf16(af, bf[s], acc[rb], 0, 0, 0); }
  }
  __syncthreads();
  {
    const int n2 = 8 * w + (r32 >> 2), c = r32 & 3;
#pragma unroll
    for (int rbp = 0; rbp < 2; ++rbp)
#pragma unroll
      for (int r = 0; r < 16; ++r) { const int k1 = 32 * rbp + crow(r, hi); float x = (float)((k1 * n2) & 4095) * (1.f / 4096.f);
        asm volatile("" : "+v"(x) :: "memory");
        const float tc = __builtin_amdgcn_cosf(x), ts = __builtin_amdgcn_sinf(x);
        const float yr = acc[rbp][r], yi = acc[rbp + 2][r];
        const float zr = yr * tc + yi * ts, zi = yi * tc - yr * ts;
        LAS unsigned char* zp = Xt + (k1 * 4 + c) * XT_STRIDE + n2 * 2;
        *(LAS unsigned short*)zp = (unsigned short)f2bf(zr); *(LAS unsigned short*)(zp + 128) = (unsigned short)f2bf(zi); }
  }
  __syncthreads();
  f32x16 o2[2];
#pragma unroll
  for (int rb = 0; rb < 2; ++rb)
#pragma unroll
    for (int i = 0; i < 16; ++i) o2[rb][i] = 0.f;
  {
    bf16x8 bf[8];
#pragma unroll
    for (int s = 0; s < 8; ++s) bf[s] = *(LAS const bf16x8*)(Xt + (32 * w + r32) * XT_STRIDE + (16 * s + 8 * hi) * 2);
#pragma unroll
    for (int rb = 0; rb < 2; ++rb)
#pragma unroll
      for (int s = 0; s < 8; ++s) { const bf16x8 af = *(LAS const bf16x8*)(Wl + (32 * rb + r32) * XT_STRIDE + (16 * s + 8 * hi) * 2); o2[rb] = __builtin_amdgcn_mfma_f32_32x32x16_bf16(af, bf[s], o2[rb], 0, 0, 0); }
  }
  __syncthreads();
  { const int k1 = 8 * w + (r32 >> 2), c = r32 & 3;
#pragma unroll
    for (int rb = 0; rb < 2; ++rb)
#pragma unroll
      for (int r = 0; r < 16; ++r) { const int k = k1 + 64 * (32 * rb + crow(r, hi)); *(LAS unsigned short*)(Xt + k * 8 + c * 2) = (unsigned short)f2bf(o2[rb][r]); }
  }
  __syncthreads();
  { const int o0 = 4 * slice; u32x2 gv[8];
#pragma unroll
    for (int i = 0; i < 8; ++i) gv[i] = *(const u32x2*)(PLB + ((size_t)b * SEQ + F.tid + 512 * i) * PLW + S_BG * 256 + o0);
    __builtin_amdgcn_sched_barrier(0);
#pragma unroll
    for (int i = 0; i < 8; ++i) { const int k = F.tid + 512 * i; const size_t row = (size_t)b * SEQ + k;
      const u32x2 ov = *(LAS const u32x2*)(Xt + k * 8);
      u32x2 y; y.x = pk2(__uint_as_float(ov.x << 16) * __uint_as_float(gv[i].x << 16), __uint_as_float(ov.x & 0xffff0000u) * __uint_as_float(gv[i].x & 0xffff0000u));
      y.y = pk2(__uint_as_float(ov.y << 16) * __uint_as_float(gv[i].y << 16), __uint_as_float(ov.y & 0xffff0000u) * __uint_as_float(gv[i].y & 0xffff0000u));
      *(u32x2*)(Y + row * 1024 + 256 + o0) = y; }
  }
}
constexpr int XC_STRIDE = 1040;
__device__ __forceinline__ void fftc_item(const Frame& F0, const Args& a, int item) {
  const Frame F = relaunder(F0);
  unsigned char* ws = opq(a.ws);
  const bf16* PLB = (const bf16*)(ws + WS_PLB); bf16* Y = (bf16*)(ws + WS_H);
  const bf16* CS = (const bf16*)(ws + WS_CS256);
  const int b = item >> 3, cs = item & 7, r32 = F.lane & 31, hi = F.lane >> 5, w = F.wave;
  LAS unsigned char* Xc = F.lds;
  __syncthreads();
  u32x4 vq[4];
#pragma unroll
  for (int i = 0; i < 4; ++i) { const int idx = F.tid + 512 * i, sl = idx >> 8, n = idx & 255;
    vq[i] = *(const u32x4*)((const bf16*)(ws + WS_FA2) + (((size_t)b * 64 + 8 * cs + sl) * TROW + SEQ + n) * 8); }
  __builtin_amdgcn_sched_barrier(0);
#pragma unroll
  for (int i = 0; i < 4; ++i) { const int idx = F.tid + 512 * i, sl = idx >> 8, n = idx & 255;
    const unsigned vv[4] = {vq[i].x, vq[i].y, vq[i].z, vq[i].w};
#pragma unroll
    for (int j = 0; j < 8; ++j) { const int c = j & 3, part = j >> 2; const unsigned short e = (unsigned short)((j & 1) ? (vv[j >> 1] >> 16) : (vv[j >> 1] & 0xffffu));
      *(LAS unsigned short*)(Xc + (4 * sl + c) * XC_STRIDE + (part * 256 + n) * 2) = e; } }
  __syncthreads();
  f32x16 acc;
#pragma unroll
  for (int i = 0; i < 16; ++i) acc[i] = 0.f;
#pragma unroll 8
  for (int s = 0; s < 32; ++s) {
    const bf16x8 af = *(const bf16x8*)(CS + (size_t)(32 * w + r32) * 512 + 16 * s + 8 * hi);
    const bf16x8 bf = *(LAS const bf16x8*)(Xc + r32 * XC_STRIDE + (16 * s + 8 * hi) * 2);
    acc = __builtin_amdgcn_mfma_f32_32x32x16_bf16(af, bf, acc, 0, 0, 0);
  }
  const int o = 32 * cs + r32;
#pragma unroll
  for (int r = 0; r < 16; ++r) { const size_t row = (size_t)MLAT + b * CTX + 32 * w + crow(r, hi);
    Y[row * 1024 + 256 + o] = (bf16)f2bf(acc[r] * bf2f(PLB[row * PLW + S_BG * 256 + o])); }
}
}

namespace mk {
constexpr int GU_STRIDE = 2048 + 64;
constexpr size_t WS_GU = WS_SCR, WS_GS = WS_GU + (size_t)32 * 68 * GU_STRIDE * 4;
__device__ __forceinline__ size_t gla_row(int b, int c, int i) { return c < 64 ? (size_t)b * SEQ + 64 * c + i : (size_t)MLAT + b * CTX + 64 * (c - 64) + i; }
__device__ __forceinline__ int gla_pos(int c, int dir) { return c < 64 ? (dir ? 4 + 63 - c : 4 + c) : (dir ? 3 - (c - 64) : (c - 64)); }
__device__ __forceinline__ void gla_stage_v(const Frame& F, const bf16* PLB, int b, int c, LAS unsigned char* vbase) {
  const int key = F.tid >> 3, ch = F.tid & 7;
  const bf16* src = PLB + gla_row(b, c, key) * PLW + S_AV * 256 + ch * 8;
  const int vo = key * 128 + ((ch ^ (((key >> 1) & 1) << 2)) << 4);
  u32x4 t_[4];
#pragma unroll
  for (int h = 0; h < 4; ++h) t_[h] = *(const u32x4*)(src + h * 64);
#pragma unroll
  for (int h = 0; h < 4; ++h) *(LAS u32x4*)(vbase + h * 8192 + vo) = t_[h];
}
__device__ __forceinline__ void gla_cum(const float* LA, int b, int c, int h, int dir, int lane, float (&cw)[32], float& T) {
  const int d = lane & 31, half = lane >> 5;
  float a[32];
#pragma unroll
  for (int ii = 0; ii < 32; ++ii) a[ii] = LA[gla_row(b, c, 32 * half + ii) * 256 + dir * 128 + h * 32 + d];
  float run = 0.f;
#pragma unroll
  for (int ii = 0; ii < 32; ++ii) { run += a[ii]; cw[ii] = run; }
  const float other = __shfl_xor(run, 32);
  const float tot0 = half ? other : run;
  T = run + other;
#pragma unroll
  for (int ii = 0; ii < 32; ++ii) { const float cf = cw[ii] + (half ? tot0 : 0.f); cw[ii] = dir ? (T - cf + a[ii]) : cf; }
}
constexpr int KT_STRIDE = 144;
__device__ __forceinline__ void gla_local_item(const Frame& F0, const Args& a, int item) {
  const Frame F = relaunder(F0);
  unsigned char* ws = opq(a.ws);
  const bf16* PLB = (const bf16*)(ws + WS_PLB); const float* LA = (const float*)(ws + WS_LA);
  const int b = item / 68, c = item % 68, h = F.wave >> 1, dir = F.wave & 1, d = F.lane & 31, half = F.lane >> 5, r32 = d, hi = half;
  LAS unsigned char* Vt = F.lds + h * 8192; LAS unsigned char* KT = F.lds + 32768 + F.wave * (32 * KT_STRIDE);
  __syncthreads();
  gla_stage_v(F, PLB, b, c, F.lds);
  float cw[32], T;
  gla_cum(LA, b, c, h, dir, F.lane, cw, T);
  {
    unsigned pkd[16]; bf16 kr[32];
    const bf16* kp = PLB + gla_row(b, c, 32 * half) * PLW + S_AQK * 256 + 128 + h * 32 + d;
#pragma unroll
    for (int ii = 0; ii < 32; ++ii) kr[ii] = kp[(size_t)ii * PLW];
#pragma unroll
    for (int ii = 0; ii < 32; ii += 2) pkd[ii >> 1] = pk2(bf2f(kr[ii]) * __expf(T - cw[ii]), bf2f(kr[ii + 1]) * __expf(T - cw[ii + 1]));
#pragma unroll
    for (int q4 = 0; q4 < 4; ++q4) *(LAS u32x4*)(KT + d * KT_STRIDE + half * 64 + q4 * 16) = (u32x4){pkd[4 * q4], pkd[4 * q4 + 1], pkd[4 * q4 + 2], pkd[4 * q4 + 3]};
  }
  __syncthreads();
  f32x16 acc[2];
#pragma unroll
  for (int eb = 0; eb < 2; ++eb)
#pragma unroll
    for (int i = 0; i < 16; ++i) acc[eb][i] = 0.f;
  const int q = (F.lane & 15) >> 2, p = F.lane & 3, gsel = (F.lane >> 4) & 1;
  const int chb = 2 * gsel + (p >> 1);
#pragma unroll
  for (int st = 0; st < 4; ++st) {
    const bf16x8 kb = *(LAS const bf16x8*)(KT + r32 * KT_STRIDE + (16 * st + 8 * hi) * 2);
#pragma unroll
    for (int eb = 0; eb < 2; ++eb) {
      const int ch = ((chb | ((eb ^ (q >> 1)) << 2)) << 4);
      LAS const unsigned char* vp = Vt + (16 * st + 8 * hi + q) * 128 + 8 * (p & 1) + ch;
      const s16x4 lo = vtr(vp), hh = vtr(vp + 512);
      const bf16x8 va = (bf16x8){lo[0], lo[1], lo[2], lo[3], hh[0], hh[1], hh[2], hh[3]};
      acc[eb] = __builtin_amdgcn_mfma_f32_32x32x16_bf16(va, kb, acc[eb], 0, 0, 0);
    }
  }
  const int chain = (b * 4 + h) * 2 + dir, pos = gla_pos(c, dir);
  float* gu = (float*)(ws + WS_GU) + ((size_t)chain * 68 + pos) * GU_STRIDE;
#pragma unroll
  for (int eb = 0; eb < 2; ++eb)
#pragma unroll
    for (int r = 0; r < 16; ++r) gu[(32 * eb + crow(r, hi)) * 32 + r32] = acc[eb][r];
  if (half == 0) gu[2048 + d] = __expf(T);
}
__device__ __forceinline__ void gla_scan(const Frame& F0, const Args& a) {
  const Frame F = relaunder(F0);
  unsigned char* ws = opq(a.ws);
  const int gt = F.vcu * 512 + F.tid;
  if (gt >= 32 * 2048) return;
  const int chain = gt >> 11, el = gt & 2047, d = el & 31;
  const float* gu = (const float*)(ws + WS_GU) + (size_t)chain * 68 * GU_STRIDE;
  bf16* gs = (bf16*)(ws + WS_GS) + (size_t)chain * 68 * 2048 + el;
  float S = 0.f;
#pragma unroll 34
  for (int pos = 0; pos < 68; ++pos) { gs[(size_t)pos * 2048] = (bf16)f2bf(S); S = gu[(size_t)pos * GU_STRIDE + 2048 + d] * S + gu[(size_t)pos * GU_STRIDE + el]; }
}
constexpr int QK_STRIDE = 80;
__device__ __forceinline__ void gla_out_item(const Frame& F0, const Args& a, int layer, int item) {
  const Frame F = relaunder(F0);
  unsigned char* ws = opq(a.ws);
  const bf16* PLB = (const bf16*)(ws + WS_PLB); const float* LA = (const float*)(ws + WS_LA); bf16* Y = (bf16*)(ws + WS_H);
  const int b = item / 68, c = item % 68, h = F.wave >> 1, dir = F.wave & 1, d = F.lane & 31, half = F.lane >> 5, r32 = d, hi = half;
  LAS unsigned char* Vt = F.lds + h * 8192;
  LAS unsigned char* QT = F.lds + 32768 + F.wave * (2 * 64 * QK_STRIDE); LAS unsigned char* KT = QT + 64 * QK_STRIDE;
  LAS float* X = (LAS float*)(F.lds + 32768) + h * 4096;
  __syncthreads();
  gla_stage_v(F, PLB, b, c, F.lds);
  {
    float cw[32], T;
    gla_cum(LA, b, c, h, dir, F.lane, cw, T);
    bf16 qr[32], kr[32];
    const bf16* pr = PLB + gla_row(b, c, 32 * half) * PLW + S_AQK * 256 + h * 32 + d;
#pragma unroll
    for (int ii = 0; ii < 32; ++ii) { qr[ii] = pr[(size_t)ii * PLW]; kr[ii] = pr[(size_t)ii * PLW + 128]; }
#pragma unroll
    for (int ii = 0; ii < 32; ++ii) { const int i = 32 * half + ii;
      const float ec = __expf(cw[ii]);
      *(LAS unsigned short*)(QT + i * QK_STRIDE + d * 2) = (unsigned short)f2bf(bf2f(qr[ii]) * ec);
      *(LAS unsigned short*)(KT + i * QK_STRIDE + d * 2) = (unsigned short)f2bf(bf2f(kr[ii]) * __builtin_amdgcn_rcpf(ec)); }
  }
  __syncthreads();
  f32x16 oacc[2][2];
#pragma unroll
  for (int eb = 0; eb < 2; ++eb)
#pragma unroll
    for (int ib = 0; ib < 2; ++ib)
#pragma unroll
      for (int i = 0; i < 16; ++i) oacc[eb][ib][i] = 0.f;
  bf16x8 qb[2][2];
#pragma unroll
  for (int ib = 0; ib < 2; ++ib)
#pragma unroll
    for (int st = 0; st < 2; ++st) qb[ib][st] = *(LAS const bf16x8*)(QT + (32 * ib + r32) * QK_STRIDE + (16 * st + 8 * hi) * 2);
  const int chain = (b * 4 + h) * 2 + dir, pos = gla_pos(c, dir);
  {
    const bf16* gs = (const bf16*)(ws + WS_GS) + ((size_t)chain * 68 + pos) * 2048;
#pragma unroll
    for (int eb = 0; eb < 2; ++eb)
#pragma unroll
      for (int st = 0; st < 2; ++st) { const bf16x8 sf = *(const bf16x8*)(gs + (32 * eb + r32) * 32 + 16 * st + 8 * hi);
#pragma unroll
        for (int ib = 0; ib < 2; ++ib) oacc[eb][ib] = __builtin_amdgcn_mfma_f32_32x32x16_bf16(sf, qb[ib][st], oacc[eb][ib], 0, 0, 0); }
  }
  const int q = (F.lane & 15) >> 2, p = F.lane & 3, gsel = (F.lane >> 4) & 1;
  const int vrow = (4 * hi + q) * 128 + 8 * (p & 1), chb = 2 * gsel + (p >> 1);
#pragma unroll
  for (int sb = 0; sb < 2; ++sb) {
    bf16x8 kf[2];
#pragma unroll
    for (int st = 0; st < 2; ++st) kf[st] = *(LAS const bf16x8*)(KT + (32 * sb + r32) * QK_STRIDE + (16 * st + 8 * hi) * 2);
#pragma unroll
    for (int ib = 0; ib < 2; ++ib) {
      const bool need = dir == 0 ? (sb <= ib) : (sb >= ib);
      if (!need) continue;
      f32x16 sc;
#pragma unroll
      for (int i = 0; i < 16; ++i) sc[i] = 0.f;
#pragma unroll
      for (int st = 0; st < 2; ++st) sc = __builtin_amdgcn_mfma_f32_32x32x16_bf16(kf[st], qb[ib][st], sc, 0, 0, 0);
      if (sb == ib) {
#pragma unroll
        for (int r = 0; r < 16; ++r) { const int s = crow(r, hi); const bool keep = dir == 0 ? (s <= r32) : (s >= r32); sc[r] = keep ? sc[r] : 0.f; }
      }
      u32x4 pw[2];
#pragma unroll
      for (int k = 0; k < 2; ++k) pw[k] = (u32x4){pk2(sc[8 * k + 0], sc[8 * k + 1]), pk2(sc[8 * k + 2], sc[8 * k + 3]), pk2(sc[8 * k + 4], sc[8 * k + 5]), pk2(sc[8 * k + 6], sc[8 * k + 7])};
#pragma unroll
      for (int ks = 0; ks < 2; ++ks)
#pragma unroll
        for (int eb = 0; eb < 2; ++eb) {
          const int ch = ((chb | ((eb ^ (q >> 1)) << 2)) << 4);
          const s16x4 lo = vtr(Vt + (2 * sb + ks) * 2048 + vrow + ch), hh = vtr(Vt + (2 * sb + ks) * 2048 + 1024 + vrow + ch);
          const bf16x8 va = (bf16x8){lo[0], lo[1], lo[2], lo[3], hh[0], hh[1], hh[2], hh[3]};
          oacc[eb][ib] = __builtin_amdgcn_mfma_f32_32x32x16_bf16(va, __builtin_bit_cast(bf16x8, pw[ks]), oacc[eb][ib], 0, 0, 0);
        }
    }
  }
  __syncthreads();
  if (dir == 1) {
#pragma unroll
    for (int eb = 0; eb < 2; ++eb)
#pragma unroll
      for (int ib = 0; ib < 2; ++ib)
#pragma unroll
        for (int r = 0; r < 16; ++r) X[((eb * 2 + ib) * 16 + r) * 64 + F.lane] = oacc[eb][ib][r];
  }
  __syncthreads();
  if (dir == 0) {
    const float* on = opq(a.in[11]) + layer * 64;
#pragma unroll
    for (int ib = 0; ib < 2; ++ib) {
      float ss = 0.f;
#pragma unroll
      for (int eb = 0; eb < 2; ++eb)
#pragma unroll
        for (int r = 0; r < 16; ++r) { oacc[eb][ib][r] += X[((eb * 2 + ib) * 16 + r) * 64 + F.lane]; ss += oacc[eb][ib][r] * oacc[eb][ib][r]; }
      ss += __shfl_xor(ss, 32);
      const float rs = 1.0f / sqrtf(ss * (1.f / 64.f) + 1e-6f);
      const size_t row = gla_row(b, c, 32 * ib + r32);
      u32x2 gv8[8];
#pragma unroll
      for (int i = 0; i < 8; ++i) gv8[i] = *(const u32x2*)(PLB + row * PLW + S_AG * 256 + h * 64 + 32 * (i >> 2) + 8 * (i & 3) + 4 * hi);
      __builtin_amdgcn_sched_barrier(0);
#pragma unroll
      for (int eb = 0; eb < 2; ++eb)
#pragma unroll
        for (int gi = 0; gi < 4; ++gi) {
          const int e0 = 32 * eb + 8 * gi + 4 * hi;
          const f32x4 w4 = *(const f32x4*)(on + e0);
          const u32x2 gv = gv8[4 * eb + gi];
          const float g0 = __uint_as_float(gv.x << 16), g1 = __uint_as_float(gv.x & 0xffff0000u), g2 = __uint_as_float(gv.y << 16), g3 = __uint_as_float(gv.y & 0xffff0000u);
          u32x2 ov; ov.x = pk2(oacc[eb][ib][4 * gi + 0] * rs * w4[0] * g0, oacc[eb][ib][4 * gi + 1] * rs * w4[1] * g1);
          ov.y = pk2(oacc[eb][ib][4 * gi + 2] * rs * w4[2] * g2, oacc[eb][ib][4 * gi + 3] * rs * w4[3] * g3);
          *(u32x2*)(Y + row * 1024 + h * 64 + e0) = ov;
        }
    }
  }
}
}

namespace mk {
__device__ __forceinline__ void p3_mixers(const Frame& F0, const Args& a, int layer) {
  const Frame F = relaunder(F0);
  const int nx = layer == 0 ? 16 : 0, nswa = 256 + nx, nna = 256 + nx, nfc = layer == 0 ? 32 : 0;
  for (int it = F.vcu; it < 272 + 256 + nfc + nswa + nna; it += F.G) {
    int r = it;
#ifndef REP_GL
#define REP_GL 1
#define REP_FF 1
#define REP_SW 1
#define REP_NA 1
#endif
    if (r < 272) { for (int q_ = 0; q_ < REP_GL; ++q_) gla_local_item(F, a, r); continue; } r -= 272;
    if (r < 256) { for (int q_ = 0; q_ < REP_FF; ++q_) fft_item(F, a, r); continue; } r -= 256;
    if (r < nfc) { fftc_item(F, a, r); continue; } r -= nfc;
    if (r < nswa) { for (int q_ = 0; q_ < REP_SW; ++q_) swa_item(F, a, layer, r); } else { for (int q_ = 0; q_ < REP_NA; ++q_) na_item(F, a, layer, r - nswa); }
  }
}
__device__ __forceinline__ void p4b_glaout(const Frame& F0, const Args& a, int layer) {
  const Frame F = relaunder(F0);
  for (int it = F.vcu; it < 272; it += F.G) { if (layer == 1 && (it % 68) >= 64) continue; gla_out_item(F, a, layer, it); }
}
}
#define XB_TMO      128
#define XB_XCNT(j)  (256  + 64 * (j))
#define XB_XSUB(j)  (1280 + 64 * (j))
#define XB_XGEN(j)  (2304 + 64 * (j))
#define XB_TOP      3328
#define XB_TOPGEN   3392
#define XCD_BAR_WORDS 3456
#define XB_SPIN_CAP (1u << 18)

__device__ __forceinline__ unsigned xb_ld(unsigned* p)              { return __hip_atomic_load(p, __ATOMIC_RELAXED, __HIP_MEMORY_SCOPE_AGENT); }
__device__ __forceinline__ unsigned xb_add(unsigned* p, unsigned v) { return __hip_atomic_fetch_add(p, v, __ATOMIC_RELAXED, __HIP_MEMORY_SCOPE_AGENT); }
__device__ __forceinline__ unsigned xb_xcc_id() { return (unsigned)__builtin_amdgcn_s_getreg((3 << 11) | 20) & 0xFu; }
#define XB_SPIN(cond, bar) do { unsigned _sp = 0; while (cond) { __builtin_amdgcn_s_sleep(1); \
    if ((++_sp & 255u) == 0u) { if (xb_ld(&(bar)[XB_TMO])) break; if (_sp > XB_SPIN_CAP) { atomicAdd(&(bar)[XB_TMO], 1u); break; } } } } while (0)

struct XcdBarrier {
    unsigned* bar; unsigned x;
    volatile LAS unsigned* st;
};

__device__ __forceinline__ XcdBarrier xcd_barrier_post(unsigned* bar, volatile LAS unsigned* st) {
    XcdBarrier b; b.bar = bar; b.x = xb_xcc_id(); b.st = st;
    if (threadIdx.x == 0) (void)xb_add(&bar[XB_XCNT(b.x)], 1u);
    return b;
}
__device__ __forceinline__ void xcd_barrier_complete(unsigned* bar, unsigned x, unsigned& nloc, unsigned& nx) {
    const unsigned G = gridDim.x * gridDim.y * gridDim.z;
    unsigned sum, cnt, mine, sp = 0u;
    for (;;) {
        sum = 0u; cnt = 0u; mine = 0u;
#pragma unroll
        for (unsigned j = 0; j < 16; ++j) { const unsigned c = xb_ld(&bar[XB_XCNT(j)]); sum += c; cnt += (c > 0u) ? 1u : 0u; }
        mine = xb_ld(&bar[XB_XCNT(x)]);
        if (sum == G) break;
        __builtin_amdgcn_s_sleep(1);
        if ((++sp & 255u) == 0u) { if (xb_ld(&bar[XB_TMO])) break; if (sp > XB_SPIN_CAP) { atomicAdd(&bar[XB_TMO], 1u); break; } }
    }
    nloc = mine > 0u ? mine : 1u; nx = cnt > 0u ? cnt : 1u;
}

__device__ __forceinline__ void xcd_barrier(const XcdBarrier& b) {
    asm volatile("s_waitcnt vmcnt(0)" ::: "memory");
    __syncthreads();
    if (threadIdx.x == 0) {
        unsigned* bar = b.bar;
        __builtin_amdgcn_s_waitcnt(0);
        unsigned nloc = b.st[0], nx = b.st[1];
        if (nloc == 0u) { xcd_barrier_complete(bar, b.x, nloc, nx); b.st[0] = nloc; b.st[1] = nx; }
        const unsigned old = xb_add(&bar[XB_XSUB(b.x)], 1u);
        const unsigned gen = old / nloc;
        if (old + 1u == (gen + 1u) * nloc) {
            __builtin_amdgcn_fence(__ATOMIC_RELEASE, "agent");
            asm volatile("s_waitcnt vmcnt(0)" ::: "memory");
            const unsigned og = xb_add(&bar[XB_TOP], 1u);
            const unsigned tg = og / nx;
            if (og + 1u == (tg + 1u) * nx) xb_add(&bar[XB_TOPGEN], 1u);
            else XB_SPIN(xb_ld(&bar[XB_TOPGEN]) == tg, bar);
            __builtin_amdgcn_fence(__ATOMIC_ACQUIRE, "agent");
            xb_add(&bar[XB_XGEN(b.x)], 1u);
            asm volatile("s_waitcnt vmcnt(0)" ::: "memory");
        } else {
            XB_SPIN(xb_ld(&bar[XB_XGEN(b.x)]) == gen, bar);
            __builtin_amdgcn_fence(__ATOMIC_ACQUIRE, "agent");
            asm volatile("s_waitcnt vmcnt(0)" ::: "memory");
        }
    }
    __syncthreads();
}

constexpr int LDS_BYTES = 163840, MISC_OFF = LDS_BYTES - 256;
constexpr int CW_BAR = 4096;
__global__ void __launch_bounds__(512, 2) mega(mk::Args a) {
  extern __shared__ __attribute__((aligned(16))) unsigned char lds[];
  mk::Frame F;
  F.lds = (LAS unsigned char*)lds;
  F.tid = threadIdx.x; F.lane = F.tid & 63; F.wave = __builtin_amdgcn_readfirstlane(F.tid >> 6);
  F.G = gridDim.x; { const int bx = blockIdx.x; F.vcu = (F.G % 8 == 0) ? (bx % 8) * (F.G / 8) + bx / 8 : bx; }
  volatile LAS unsigned* MISC = (volatile LAS unsigned*)(F.lds + MISC_OFF);
  if (F.tid < 64) MISC[F.tid] = 0u;
  __syncthreads();
  XcdBarrier bar; bar.bar = nullptr; bar.x = 0; bar.st = nullptr;
  const bool multi = (a.ph_hi - a.ph_lo) > 1;
  if (multi) bar = xcd_barrier_post((unsigned*)(a.ws + mk::WS_CTL) + CW_BAR, MISC + 8);
#pragma clang loop unroll(disable)
  for (int ph = a.ph_lo; ph < a.ph_hi; ++ph) {
    if (ph == 0) mk::p0_prologue(F, a);
    else {
      const int layer = (ph - 1) / 6, sub = (ph - 1) % 6;
      if (sub == 0) mk::p1_prenorm(F, a, layer);
      else if (sub == 1) mk::p2_inproj(F, a, layer);
      else if (sub == 2) mk::p3_mixers(F, a, layer);
      else if (sub == 3) mk::gla_scan(F, a);
      else if (sub == 4) mk::p4b_glaout(F, a, layer);
      else mk::p5_outproj(F, a, layer);
    }
#ifdef DUP_PHASE
    if (ph == DUP_PHASE) { xcd_barrier(bar);
#if DUP_PHASE == 0
      mk::p0_prologue(F, a);
#elif (DUP_PHASE - 1) % 6 == 0
      mk::p1_prenorm(F, a, (DUP_PHASE - 1) / 6);
#elif (DUP_PHASE - 1) % 6 == 1
      mk::p2_inproj(F, a, (DUP_PHASE - 1) / 6);
#elif (DUP_PHASE - 1) % 6 == 2
      mk::p3_mixers(F, a, (DUP_PHASE - 1) / 6);
#elif (DUP_PHASE - 1) % 6 == 3
      mk::gla_scan(F, a);
#elif (DUP_PHASE - 1) % 6 == 4
      mk::p4b_glaout(F, a, (DUP_PHASE - 1) / 6);
#else
      mk::p5_outproj(F, a, (DUP_PHASE - 1) / 6);
#endif
    }
#endif
    if (ph + 1 < a.ph_hi) xcd_barrier(bar);
  }
}

#ifndef MK_SPLIT
#define MK_SPLIT 0
#endif
extern "C" void kernel_launch(void* const* d_in, const int* in_sizes, int n_in, void* d_out, int out_size, void* d_ws, size_t ws_size, hipStream_t stream) {
  using namespace mk;
  static int grid = 0;
  if (grid == 0) {
    int dev = 0, cus = 0, per_cu = 0; (void)hipGetDevice(&dev); (void)hipDeviceGetAttribute(&cus, hipDeviceAttributeMultiprocessorCount, dev);
    (void)hipFuncSetAttribute((const void*)mega, hipFuncAttributeMaxDynamicSharedMemorySize, LDS_BYTES);
    if (hipOccupancyMaxActiveBlocksPerMultiprocessor(&per_cu, (const void*)mega, 512, LDS_BYTES) != hipSuccess || per_cu < 1) per_cu = 1;
    (void)hipGetLastError();
    grid = (cus > 0 ? cus : 256) * (per_cu < 1 ? 1 : 1);
  }
  (void)hipMemsetAsync((char*)d_ws + WS_CTL, 0, CTL_BYTES, stream);
  Args a{};
  for (int i = 0; i < 19; ++i) a.in[i] = (const float*)d_in[i];
  a.out = (float*)d_out; a.ws = (unsigned char*)d_ws;
#if MK_SPLIT
  for (int ph = 0; ph < 13; ++ph) { a.ph_lo = ph; a.ph_hi = ph + 1; hipLaunchKernelGGL(mega, dim3(grid), dim3(512), LDS_BYTES, stream, a); }
#else
  a.ph_lo = 0; a.ph_hi = 13;
  void* args[] = {&a};
  if (hipLaunchCooperativeKernel((const void*)mega, dim3(grid), dim3(512), args, LDS_BYTES, stream) != hipSuccess) {
    (void)hipGetLastError();
    hipLaunchKernelGGL(mega, dim3(grid), dim3(512), LDS_BYTES, stream, a);
  }
#endif
}
```

```cpp
#include <hip/hip_runtime.h>
#include <math.h>
#include <stdint.h>

namespace pg8 {
#define PG8_LAS __attribute__((address_space(3)))
typedef unsigned short bf16_t;
typedef short bf16x8 __attribute__((ext_vector_type(8)));
typedef float f32x4 __attribute__((ext_vector_type(4)));
typedef unsigned u32x4 __attribute__((ext_vector_type(4)));
constexpr int BM = 256, BK = 64, HALF = 128, HTB = HALF * BK * 2  , STAGE_BYTES = 8 * HTB, NXCD = 8, WGM = 8;

__host__ __device__ __forceinline__ int lds_byte(int r, int c) { const int st = (r >> 4) * 2 + (c >> 5), rr = r & 15, cc = c & 31, ob = rr * 64 + cc * 2; return st * 1024 + (ob ^ (((ob >> 9) & 1) << 5)); }
__host__ __device__ __forceinline__ void stage_rc(int b, int& R, int& C) { const int st = b / 1024, sb = b % 1024, swz = sb ^ (((sb >> 9) & 1) << 5); R = (st >> 1) * 16 + swz / 64; C = (st & 1) * 32 + (swz % 64) / 2; }
__host__ __device__ __forceinline__ int perm32(int rho) { const int n = rho >> 4, i = rho & 15; return 8 * (i >> 2) + 4 * n + (i & 3); }

struct Unit { int pm, pn; };
struct Gemm { const bf16_t* A; const bf16_t* Bt; int M, N, K; };

struct StaticOrder {
    int nM, nN, nwg, G, c;
    __host__ __device__ void init(int M, int N, int G_, int c_) { nM = M / BM; nN = N / BM; nwg = nM * nN; G = G_; c = c_; }
    __host__ __device__ bool next(int i, Unit& u) const {
        const long L = (long)i * G + c; if (L >= nwg) return false;
        int wgid = (int)L; { const int q = nwg / NXCD, r = nwg % NXCD, xcd = wgid % NXCD, off = wgid / NXCD; wgid = (xcd < r ? xcd * (q + 1) : r * (q + 1) + (xcd - r) * q) + off; }
        const int nig = WGM * nN, gid = wgid / nig, fm = gid * WGM, gsz = (nM - fm) < WGM ? (nM - fm) : WGM;
        u.pm = fm + ((wgid % nig) % gsz); u.pn = (wgid % nig) / gsz; return true;
    }
    __device__ __forceinline__ void a_ready(const Unit&) const {}
    __device__ __forceinline__ void done(const Unit&) const {}
};

template <class Epi, class Sched, bool STAMP = false>
__device__ __forceinline__ void gemm_phase(PG8_LAS unsigned char* lds, const Gemm g, const Sched& S, const Epi& E, unsigned long long* stamps) {
    int tid_ = threadIdx.x; asm volatile("" : "+v"(tid_));
    const int tid = tid_, wid = __builtin_amdgcn_readfirstlane(tid >> 6), lane = tid & 63, wr = wid >> 2, wc = wid & 3, fr = lane & 15, fq = lane >> 4;
    const int K = g.K, nt = K / BK;
    int ts_lo = 0, ts_hi = 0, nts = 0; const unsigned long long rt_entry = STAMP ? (unsigned long long)wall_clock64() : 0ull;
#define PG8_STAMP() do { if (STAMP && wid == 0 && nts < 64) { const unsigned long long _c = (unsigned long long)clock64(); \
        ts_lo = (lane == nts) ? (int)(unsigned)_c : ts_lo; ts_hi = (lane == nts) ? (int)(unsigned)(_c >> 32) : ts_hi; ++nts; } } while (0)
    PG8_STAMP();
    unsigned voffA[2], voffB[2];
#pragma unroll
    for (int i = 0; i < 2; ++i) { int R, C; stage_rc(tid * 16 + i * 8192, R, C); const int Rb = Epi::PERM ? ((R & ~31) + perm32(R & 31)) : R;
        voffA[i] = (unsigned)(R * K + C) * 2u; voffB[i] = (unsigned)(Rb * K + C) * 2u; }
    const size_t kstep = (size_t)(BK * 2);
    const size_t hstep = (size_t)HALF * K * 2;
    const size_t tstep = 2 * hstep;
    const unsigned ldsw = (unsigned)wid * 1024u;
    const int aoff = lds_byte(wr * 64 + fr, fq * 8), boff = lds_byte(wc * 32 + fr, fq * 8);
#define PG8_SA(b, h) (((b) * 2 + (h)) * HTB)
#define PG8_SB(b, h) ((4 + (b) * 2 + (h)) * HTB)
#define PG8_STAGE(bufoff, gbase, voff) do { _Pragma("unroll") for (int _i = 0; _i < 2; ++_i) \
        __builtin_amdgcn_global_load_lds((const unsigned*)((const char*)(gbase) + (voff)[_i]), (PG8_LAS unsigned*)(lds + (bufoff) + ldsw + _i * 8192), 16, 0, 0); } while (0)
#define PG8_LDA(dst, b, h) do { _Pragma("unroll") for (int m = 0; m < 4; ++m) _Pragma("unroll") for (int k = 0; k < 2; ++k) dst[m][k] = *(const PG8_LAS bf16x8*)(lds + PG8_SA(b, h) + aoff + m * 2048 + k * 1024); } while (0)
#define PG8_LDB(dst, b, h) do { _Pragma("unroll") for (int n = 0; n < 2; ++n) _Pragma("unroll") for (int k = 0; k < 2; ++k) dst[n][k] = *(const PG8_LAS bf16x8*)(lds + PG8_SB(b, h) + boff + n * 2048 + k * 1024); } while (0)
#define PG8_MMA(ai, bj, At, Bt) do { __builtin_amdgcn_s_setprio(1); _Pragma("unroll") for (int m = 0; m < 4; ++m) _Pragma("unroll") for (int n = 0; n < 2; ++n) _Pragma("unroll") for (int k = 0; k < 2; ++k) \
        acc[ai][bj][m][n] = __builtin_amdgcn_mfma_f32_16x16x32_bf16(Bt[n][k], At[m][k], acc[ai][bj][m][n], 0, 0, 0); __builtin_amdgcn_s_setprio(0); } while (0)
#define PG8_WAIT_V(n) asm volatile("s_waitcnt vmcnt(" #n ")" ::: "memory")
#define PG8_WAIT_L(n) asm volatile("s_waitcnt lgkmcnt(" #n ")" ::: "memory")
#define PG8_BAR __builtin_amdgcn_s_barrier()
#define PG8_SCHED __builtin_amdgcn_sched_barrier(0)
    Unit cur, nxt; int ui = 0;
    if (!S.next(0, cur)) return;
    f32x4 acc[2][2][4][2];
#pragma unroll
    for (int a = 0; a < 2; ++a)
#pragma unroll
        for (int b = 0; b < 2; ++b)
#pragma unroll
            for (int m = 0; m < 4; ++m)
#pragma unroll
                for (int n = 0; n < 2; ++n) acc[a][b][m][n] = (f32x4){0.f, 0.f, 0.f, 0.f};
    bf16x8 At[4][2], B0[2][2], B1[2][2];
    const char* cA = (const char*)g.A + (size_t)cur.pm * tstep; const char* cB = (const char*)g.Bt + (size_t)cur.pn * tstep;
    S.a_ready(cur);
    PG8_STAGE(PG8_SB(0, 0), cB, voffB); PG8_STAGE(PG8_SA(0, 0), cA, voffA); PG8_STAGE(PG8_SB(0, 1), cB + hstep, voffB); PG8_STAGE(PG8_SA(0, 1), cA + hstep, voffA);
    if (wr == 1) PG8_BAR;
    PG8_WAIT_V(4); PG8_BAR;
    PG8_STAGE(PG8_SB(1, 0), cB + kstep, voffB); PG8_STAGE(PG8_SA(1, 0), cA + kstep, voffA); PG8_STAGE(PG8_SB(1, 1), cB + hstep + kstep, voffB);
    PG8_WAIT_V(6); PG8_BAR;
    PG8_STAMP();
    for (;;) {
        const bool has_next = S.next(ui + 1, nxt);
        const char* nA = has_next ? (const char*)g.A + (size_t)nxt.pm * tstep : cA; const char* nB = has_next ? (const char*)g.Bt + (size_t)nxt.pn * tstep : cB;
        for (int t = 0; t < nt; t += 2) {
            const bool last = (t == nt - 2);
            const char* a1 = cA + (size_t)(t + 1) * kstep;
            const char* a2 = last ? nA : cA + (size_t)(t + 2) * kstep; const char* b2 = last ? nB : cB + (size_t)(t + 2) * kstep;
            const char* a3 = a2 + kstep; const char* b3 = b2 + kstep;
            if (last && has_next) S.a_ready(nxt);
            PG8_LDB(B0, 0, 0); PG8_SCHED; PG8_LDA(At, 0, 0); PG8_STAGE(PG8_SA(1, 1), a1 + hstep, voffA);
            PG8_WAIT_L(8); PG8_BAR; PG8_WAIT_L(0); PG8_MMA(0, 0, At, B0); PG8_BAR; PG8_SCHED;
            PG8_LDB(B1, 0, 1); PG8_STAGE(PG8_SB(0, 0), b2, voffB);
            PG8_BAR; PG8_WAIT_L(0); PG8_MMA(0, 1, At, B1); PG8_BAR;
            PG8_LDA(At, 0, 1); PG8_STAGE(PG8_SA(0, 0), a2, voffA);
            PG8_BAR; PG8_WAIT_L(0); PG8_MMA(1, 0, At, B0); PG8_BAR; PG8_SCHED;
            PG8_STAGE(PG8_SB(0, 1), b2 + hstep, voffB);
            PG8_WAIT_V(6); PG8_BAR; PG8_MMA(1, 1, At, B1); PG8_BAR;
            PG8_LDB(B0, 1, 0); PG8_SCHED; PG8_LDA(At, 1, 0); PG8_STAGE(PG8_SA(0, 1), a2 + hstep, voffA);
            PG8_WAIT_L(8); PG8_BAR; PG8_WAIT_L(0); PG8_MMA(0, 0, At, B0); PG8_BAR; PG8_SCHED;
            PG8_LDB(B1, 1, 1); PG8_STAGE(PG8_SB(1, 0), b3, voffB);
            PG8_BAR; PG8_WAIT_L(0); PG8_MMA(0, 1, At, B1); PG8_BAR;
            PG8_LDA(At, 1, 1); PG8_STAGE(PG8_SA(1, 0), a3, voffA);
            PG8_BAR; PG8_WAIT_L(0); PG8_MMA(1, 0, At, B0); PG8_BAR; PG8_SCHED;
            PG8_STAGE(PG8_SB(1, 1), b3 + hstep, voffB);
            PG8_WAIT_V(6); PG8_BAR; PG8_MMA(1, 1, At, B1); PG8_BAR;
        }
        PG8_STAMP();
        if constexpr (!Epi::AFTER_DRAIN) { E(acc, cur, wr, wc, fr, fq); S.done(cur); }
        PG8_STAMP();
        if (!has_next) break;
#pragma unroll
        for (int a = 0; a < 2; ++a)
#pragma unroll
            for (int b = 0; b < 2; ++b)
#pragma unroll
                for (int m = 0; m < 4; ++m)
#pragma unroll
                    for (int n = 0; n < 2; ++n) acc[a][b][m][n] = (f32x4){0.f, 0.f, 0.f, 0.f};
        cur = nxt; cA = nA; cB = nB; ++ui;
    }
    PG8_WAIT_V(0);
    if (wr == 0) PG8_BAR;
    PG8_BAR;
    if constexpr (Epi::AFTER_DRAIN) { E.fused(acc, cur, wr, wc, fr, fq, lds, wid, lane); S.done(cur); }
    PG8_STAMP();
    if (STAMP && wid == 0) { stamps[lane] = lane < nts ? (((unsigned long long)(unsigned)ts_hi << 32) | (unsigned)ts_lo) : 0ull;
        if (lane == 62) stamps[62] = rt_entry; if (lane == 63) stamps[63] = (unsigned long long)wall_clock64(); }
#undef PG8_STAMP
#undef PG8_SA
#undef PG8_SB
#undef PG8_STAGE
#undef PG8_LDA
#undef PG8_LDB
#undef PG8_MMA
#undef PG8_WAIT_V
#undef PG8_WAIT_L
#undef PG8_BAR
#undef PG8_SCHED
}
}

namespace mk {
#define LAS __attribute__((address_space(3)))
typedef unsigned short bf16;
typedef float f32x4 __attribute__((ext_vector_type(4)));
typedef float f32x16 __attribute__((ext_vector_type(16)));
typedef unsigned u32x4 __attribute__((ext_vector_type(4)));
typedef unsigned u32x2 __attribute__((ext_vector_type(2)));
typedef short bf16x8 __attribute__((ext_vector_type(8)));
typedef short s16x4 __attribute__((ext_vector_type(4)));

constexpr int D = 1024, NB = 4, SEQ = 4096, CTX = 256, PWW = 3360;
constexpr int MLAT = NB * SEQ, MT = MLAT + NB * CTX;
constexpr int NT1 = 14, N1 = NT1 * 256;
constexpr int NSLOT = 11, PLW = NSLOT * 256;
constexpr int TROW = SEQ + CTX;
constexpr int O_AQ = 0, O_AK = 128, O_AV = 256, O_AG = 512, O_LR = 768, O_BV = 800, O_BG = 1056, O_CQ = 1312, O_CK = 1568, O_CV = 1696,
              O_CG = 1824, O_DQ = 2080, O_DK = 2336, O_DV = 2592, O_DG = 2848;
constexpr int S_AQK = 0, S_AV = 1, S_AG = 2, S_BG = 3, S_CQ = 4, S_CKV = 5, S_CG = 6, S_DQ = 7, S_DK = 8, S_DV = 9, S_DG = 10;
constexpr float LOG2E = 1.4426950408889634f, QSCALE = 0.125f * LOG2E, GLA_QS = 0.17677669529663687f;

constexpr size_t WS_CTL = 0, CTL_BYTES = 65536;
constexpr size_t WS_MOD = WS_CTL + CTL_BYTES;
constexpr size_t WS_ROPE = WS_MOD + 2 * 5 * 3072 * 4;
constexpr size_t WS_WC = WS_ROPE + 2 * 64 * 16 * 4;
constexpr size_t WS_CS256 = WS_WC + 128 * 128 * 2;
constexpr size_t WS_W1T = 1u << 20;
constexpr size_t WS_W2T = WS_W1T + (size_t)2 * N1 * D * 2;
constexpr size_t WS_H = WS_W2T + (size_t)2 * D * D * 2;
constexpr size_t WS_PLB = WS_H + (size_t)MT * D * 2;
constexpr size_t WS_LA = WS_PLB + (size_t)MT * PLW * 2;
constexpr size_t WS_FA2 = WS_LA + (size_t)MT * 256 * 4;
constexpr size_t WS_CTX1 = WS_FA2 + (size_t)NB * 64 * TROW * 8 * 2;
constexpr size_t WS_SCR = WS_CTX1 + (size_t)NB * CTX * D * 4;
static_assert(WS_CS256 + 256 * 512 * 2 <= WS_W1T, "tables");

__device__ __forceinline__ float bf2f(bf16 v) { return __uint_as_float(((unsigned)v) << 16); }
__device__ __forceinline__ unsigned f2bf(float f) { unsigned u = __float_as_uint(f); return (u + 0x7fffu + ((u >> 16) & 1u)) >> 16; }
typedef float f32x2_t __attribute__((ext_vector_type(2))); typedef __bf16 bf16x2_t __attribute__((ext_vector_type(2)));
__device__ __forceinline__ unsigned pk2(float lo, float hi) { const f32x2_t v = {lo, hi}; const bf16x2_t b = __builtin_convertvector(v, bf16x2_t); return __builtin_bit_cast(unsigned, b); }
__device__ __forceinline__ float wave_sum(float v) {
#pragma unroll
  for (int o = 1; o < 64; o <<= 1) v += __shfl_xor(v, o);
  return v;
}
__device__ __forceinline__ float fsilu(float x) { return x * __builtin_amdgcn_rcpf(1.f + __expf(-x)); }
__device__ __forceinline__ float flogsig(float x) { return fminf(x, 0.f) - __logf(1.f + __expf(-fabsf(x))); }

#define GAS __attribute__((address_space(1)))
template <class T> __device__ __forceinline__ T* opq(T* p) { GAS T* g = (GAS T*)p; asm volatile("" : "+s"(g)); return (T*)g; }
__device__ __forceinline__ int crow(int r, int hi) { return (r & 3) + 8 * (r >> 2) + 4 * hi; }
struct Args {
  const float* in[19]; float* out; unsigned char* ws; int ph_lo, ph_hi;
};
struct Frame {
  int tid, lane, wave, vcu, G;
  LAS unsigned char* lds;
};
__device__ __forceinline__ Frame relaunder(const Frame& F0) {
  Frame F = F0; F.tid = threadIdx.x; asm volatile("" : "+v"(F.tid)); F.lane = F.tid & 63; asm volatile("" : "+s"(F.wave), "+s"(F.vcu), "+s"(F.G)); return F; }
}

namespace mk {
__device__ __forceinline__ void p0_ada_item(const Frame& F, const Args& a, int item) {
  LAS float* s = (LAS float*)F.lds; LAS float* red = s + 5 * 1024;
  const float* c = opq(a.in[1]); const float* cc = opq(a.in[3]);
  for (int i = F.tid; i < 5 * 1024; i += 512) { const int r = i >> 10, k = i & 1023; const float v = r < 4 ? c[r * 1024 + k] : cc[k]; s[i] = v / (1.f + expf(-v)); }
  __syncthreads();
  const int kp = F.tid / 24, cl = F.tid % 24;
  const int gcol = item * 24 + cl, l = gcol / 3072, col = gcol % 3072;
  if (kp < 21) {
    const float* w = opq(a.in[5]) + (size_t)l * 1024 * 3072 + col;
    float acc[5] = {0.f, 0.f, 0.f, 0.f, 0.f};
#pragma unroll 8
    for (int k = kp; k < 1024; k += 21) { const float wv = w[(size_t)k * 3072];
#pragma unroll
      for (int r = 0; r < 5; ++r) acc[r] += s[r * 1024 + k] * wv; }
#pragma unroll
    for (int r = 0; r < 5; ++r) red[(kp * 24 + cl) * 5 + r] = acc[r];
  }
  __syncthreads();
  if (F.tid < 120) {
    const int cl2 = F.tid / 5, r = F.tid % 5; float t = 0.f;
    for (int q = 0; q < 21; ++q) t += red[(q * 24 + cl2) * 5 + r];
    const int g2 = item * 24 + cl2, l2 = g2 / 3072, col2 = g2 % 3072;
    float* MOD = (float*)(opq(a.ws) + WS_MOD);
    MOD[((size_t)l2 * 5 + r) * 3072 + col2] = t + opq(a.in[6])[l2 * 3072 + col2];
  }
  __syncthreads();
}
__device__ __forceinline__ int rope_perm(int n) { return 16 * ((n >> 2) & 1) + 4 * (n >> 3) + (n & 3); }
__device__ __forceinline__ void p0_tr_item(const float* W, int ldw, int cbase, int permkind, float scale, bf16* dst, int k0, LAS float* scr, int lane) {
  { float t_[32];
#pragma unroll
    for (int i = 0; i < 32; ++i) t_[i] = W[(size_t)(k0 + 2 * i + (lane >> 5)) * ldw + cbase + (lane & 31)];
#pragma unroll
    for (int i = 0; i < 32; ++i) scr[(2 * i + (lane >> 5)) * 33 + (lane & 31)] = t_[i]; }
  asm volatile("s_waitcnt lgkmcnt(0)" ::: "memory");
  const int c = lane & 7;
#pragma unroll
  for (int j = 0; j < 4; ++j) { const int n = (lane >> 3) + 8 * j; const int sidx = permkind ? rope_perm(n) : n; const LAS float* sp = scr + (8 * c) * 33 + sidx;
    u32x4 o; o.x = pk2(sp[0 * 33] * scale, sp[1 * 33] * scale); o.y = pk2(sp[2 * 33] * scale, sp[3 * 33] * scale); o.z = pk2(sp[4 * 33] * scale, sp[5 * 33] * scale); o.w = pk2(sp[6 * 33] * scale, sp[7 * 33] * scale);
    *(u32x4*)(dst + (size_t)n * 1024 + k0 + 8 * c) = o; }
  asm volatile("s_waitcnt lgkmcnt(0)" ::: "memory");
}
__device__ __forceinline__ void p0_la_item(const float* Win, const float* decw  , int dir, int j0, bf16* dst, int k0, LAS float* scr, int lane) {
  float dw[16];
#pragma unroll
  for (int r = 0; r < 16; ++r) dw[r] = decw[(dir * 16 + r) * 128 + j0 + (lane & 31)];
#pragma unroll 4
  for (int i = 0; i < 32; ++i) { const int kk = 2 * i + (lane >> 5); const float* wp = Win + (size_t)(k0 + kk) * PWW + O_LR + dir * 16; float acc = 0.f;
#pragma unroll
    for (int r = 0; r < 16; ++r) acc += wp[r] * dw[r];
    scr[kk * 33 + (lane & 31)] = acc; }
  asm volatile("s_waitcnt lgkmcnt(0)" ::: "memory");
  const int c = lane & 7;
#pragma unroll
  for (int j = 0; j < 4; ++j) { const int n = (lane >> 3) + 8 * j; const LAS float* sp = scr + (8 * c) * 33 + n;
    u32x4 o; o.x = pk2(sp[0 * 33], sp[1 * 33]); o.y = pk2(sp[2 * 33], sp[3 * 33]); o.z = pk2(sp[4 * 33], sp[5 * 33]); o.w = pk2(sp[6 * 33], sp[7 * 33]);
    *(u32x4*)(dst + (size_t)n * 1024 + k0 + 8 * c) = o; }
  asm volatile("s_waitcnt lgkmcnt(0)" ::: "memory");
}
constexpr int FA_AST = 528, FA_WST = 528;
__device__ __forceinline__ void p0_fa_item(const Frame& F, const Args& a, int item) {
  const int l = item >> 4, pn = 4 + ((item >> 3) & 1), g32 = item & 7, bj = g32 >> 2, wc = g32 & 3;
  LAS float* cs = (LAS float*)F.lds; LAS float* sn = cs + 64; LAS float* wfl = sn + 64;
  LAS unsigned char* Ai = F.lds + 512 + 16384;
  LAS unsigned char* Wi = F.lds + F.wave * (32 * FA_WST);
  __syncthreads();
  if (F.tid < 64) { float s_, c_; sincospif(2.f * F.tid / 64.f, &s_, &c_); cs[F.tid] = c_; sn[F.tid] = s_; }
  const float* wf = opq(a.in[12]) + (size_t)l * 256 * 256;
  const int slice0 = 32 * (pn - 4) + 16 * bj + 4 * wc;
  for (int i = F.tid; i < 1024; i += 512) { const int r = i >> 2, q = i & 3; *(LAS f32x4*)(wfl + r * 16 + 4 * q) = *(const f32x4*)(wf + (size_t)r * 256 + 4 * slice0 + 4 * q); }
  __syncthreads();
  {
    const int c = F.tid & 255, part = F.tid >> 8, g = c >> 6, jj = c & 63;
    f32x4 acc[4];
#pragma unroll
    for (int q = 0; q < 4; ++q) acc[q] = (f32x4){0.f, 0.f, 0.f, 0.f};
#pragma unroll 4
    for (int m = 0; m < 64; ++m) { const int idx = (m * jj) & 63; const float t = part ? -sn[idx] : cs[idx];
#pragma unroll
      for (int q = 0; q < 4; ++q) acc[q] += t * *(LAS const f32x4*)(wfl + (g * 64 + m) * 16 + 4 * q); }
#pragma unroll
    for (int fq = 0; fq < 4; ++fq)
#pragma unroll
      for (int j = 0; j < 4; ++j) *(LAS unsigned short*)(Ai + (8 * fq + 4 * part + j) * FA_AST + c * 2) = (unsigned short)f2bf(acc[fq][j] * 0.125f);
  }
  __syncthreads();
  const int r32 = F.lane & 31, hi = F.lane >> 5;
  bf16x8 af[16];
#pragma unroll
  for (int s = 0; s < 16; ++s) af[s] = *(LAS const bf16x8*)(Ai + r32 * FA_AST + (16 * s + 8 * hi) * 2);
  __syncthreads();
  const float* Win = opq(a.in[7]) + (size_t)l * 1024 * PWW + O_BV;
  bf16* dst = (bf16*)(opq(a.ws) + WS_W1T) + ((size_t)l * N1 + pn * 256 + 32 * g32) * 1024;
  for (int kb = 0; kb < 4; ++kb) {
    const int k0 = F.wave * 128 + kb * 32;
#pragma unroll
    for (int rh = 0; rh < 2; ++rh) { f32x4 w[16];
#pragma unroll
      for (int r = 0; r < 16; ++r) w[r] = *(const f32x4*)(Win + (size_t)(k0 + 16 * rh + r) * PWW + 4 * F.lane);
#pragma unroll
      for (int r = 0; r < 16; ++r) *(LAS u32x2*)(Wi + (16 * rh + r) * FA_WST + 8 * F.lane) = (u32x2){pk2(w[r].x, w[r].y), pk2(w[r].z, w[r].w)}; }
    asm volatile("s_waitcnt lgkmcnt(0)" ::: "memory");
    f32x16 acc;
#pragma unroll
    for (int i = 0; i < 16; ++i) acc[i] = 0.f;
#pragma unroll
    for (int s = 0; s < 16; ++s) { const bf16x8 bfr = *(LAS const bf16x8*)(Wi + r32 * FA_WST + (16 * s + 8 * hi) * 2); acc = __builtin_amdgcn_mfma_f32_32x32x16_bf16(af[s], bfr, acc, 0, 0, 0); }
#pragma unroll
    for (int r = 0; r < 16; ++r) dst[(size_t)crow(r, hi) * 1024 + k0 + r32] = (bf16)f2bf(acc[r]);
    asm volatile("s_waitcnt lgkmcnt(0)" ::: "memory");
  }
  __syncthreads();
}
__device__ __forceinline__ void p0_prologue(const Frame& F0, const Args& a) {
 {
  const Frame F = relaunder(F0);
  unsigned char* ws = opq(a.ws);
  { const int gt = F.vcu * 512 + F.tid, GT = F.G * 512;
    float* rope = (float*)(ws + WS_ROPE);
    for (int i = gt; i < 1024; i += GT) { const int pos = i >> 4, f = i & 15; const float ang = (float)pos * powf(10000.f, -(float)f / 16.f); rope[i] = cosf(ang); rope[1024 + i] = sinf(ang); }
    bf16* wc = (bf16*)(ws + WS_WC);
    for (int i = gt; i < 128 * 128; i += GT) { const int r = i >> 7, c = i & 127, rr = r & 63, cc = c & 63; float s_, c_; sincospif(2.f * (float)((rr * cc) & 63) / 64.f, &s_, &c_);
      float v; if (r < 64) v = c < 64 ? c_ : s_; else v = c < 64 ? -s_ : c_; wc[i] = (bf16)f2bf(v * 0.125f); }
    bf16* cs256 = (bf16*)(ws + WS_CS256);
    for (int i = gt; i < 256 * 512; i += GT) { const int k = i >> 9, n = i & 511, nn = n & 255; float s_, c_; sincospif(2.f * (float)((k * nn) & 255) / 256.f, &s_, &c_); cs256[i] = (bf16)f2bf((n < 256 ? c_ : s_) * 0.0625f); }
  }
  for (int it = F.vcu; it < 256 + 32; it += F.G) { if (it < 256) p0_ada_item(F, a, it); else p0_fa_item(F, a, it - 256); }
  LAS float* scr = (LAS float*)(F.lds + F.wave * 16384);
  const int gw = F.vcu * 8 + F.wave, NGW = F.G * 8;
  constexpr int I_DIR = 11 * 8 * 16, I_LA = 8 * 16, I_W2 = 32 * 16, I_L = I_DIR + I_LA + I_W2;
  for (int it = gw; it < 2 * I_L; it += NGW) {
    const int l = it / I_L; int r = it % I_L;
    const float* Win = opq(a.in[7]) + (size_t)l * 1024 * PWW;
    bf16* W1T = (bf16*)(ws + WS_W1T) + (size_t)l * N1 * 1024;
    if (r < I_DIR) {
      const int ti = r / 128, g32 = (r >> 4) & 7, kb = r & 15;
      const int pn = ti < 3 ? ti : ti + 3;
      const int bj = g32 >> 2, wc = g32 & 3, mcb = 64 * wc + 32 * bj;
      int cbase = 0, pk = 0; float sc = 1.f;
      switch (pn) {
        case 0: if (mcb < 128) { cbase = O_AQ + mcb; sc = GLA_QS; } else cbase = O_AK + mcb - 128; break;
        case 1: cbase = O_AV + mcb; break;
        case 2: cbase = O_AG + mcb; break;
        case 6: cbase = O_BG + mcb; break;
        case 7: cbase = O_CQ + mcb; pk = 1; break;
        case 8: if (wc < 2) { cbase = O_CK + mcb; pk = 1; } else cbase = O_CV + mcb - 128; break;
        case 9: cbase = O_CG + mcb; break;
        case 10: cbase = O_DQ + mcb; break;
        case 11: cbase = O_DK + mcb; break;
        case 12: cbase = O_DV + mcb; break;
        default: cbase = O_DG + mcb; break;
      }
      p0_tr_item(Win, PWW, cbase, pk, sc, W1T + (size_t)(pn * 256 + 32 * g32) * 1024, kb * 64, scr, F.lane);
    } else if (r < I_DIR + I_LA) {
      r -= I_DIR; const int g32 = r >> 4, kb = r & 15, bj = g32 >> 2, wc = g32 & 3, mcb = 64 * wc + 32 * bj;
      p0_la_item(Win, opq(a.in[9]) + (size_t)l * 2 * 16 * 128, mcb >> 7, mcb & 127, W1T + (size_t)(3 * 256 + 32 * g32) * 1024, kb * 64, scr, F.lane);
    } else {
      r -= I_DIR + I_LA; const int g = r >> 4, kb = r & 15;
      p0_tr_item(opq(a.in[8]) + (size_t)l * 1024 * 1024, 1024, 32 * g, 0, 1.f, (bf16*)(ws + WS_W2T) + ((size_t)l * 1024 + 32 * g) * 1024, kb * 64, scr, F.lane);
    }
  }
 }
}
__device__ __forceinline__ void p1_prenorm(const Frame& F0, const Args& a, int layer) {
  const Frame F = relaunder(F0);
  const float* xin = layer == 0 ? opq(a.in[0]) : opq(a.out);
  const float* cin = layer == 0 ? opq(a.in[2]) : (const float*)(opq(a.ws) + WS_CTX1);
  const float* nw = opq(a.in[4]) + layer * 1024;
  const float* MOD = (const float*)(opq(a.ws) + WS_MOD) + (size_t)layer * 5 * 3072;
  bf16* H = (bf16*)(opq(a.ws) + WS_H);
  const int gw = F.vcu * 8 + F.wave, NGW = F.G * 8;
  constexpr int RB = 3;
  f32x4 w_[4];
#pragma unroll
  for (int j = 0; j < 4; ++j) w_[j] = *(const f32x4*)(nw + 4 * F.lane + 256 * j);
  for (int row0 = gw; row0 < MT; row0 += RB * NGW) {
    f32x4 v[RB][4], sc_[RB][4], sh_[RB][4]; float ss[RB];
#pragma unroll
    for (int q = 0; q < RB; ++q) { int row = row0 + q * NGW; row = row < MT ? row : MT - 1;
      const float* src; const float* mod;
      if (row < MLAT) { src = xin + (size_t)row * 1024; mod = MOD + (size_t)(row >> 12) * 3072; }
      else { src = cin + (size_t)(row - MLAT) * 1024; mod = MOD + (size_t)4 * 3072; }
      const f32x4* xr = (const f32x4*)src + F.lane;
#pragma unroll
      for (int j = 0; j < 4; ++j) { v[q][j] = xr[64 * j]; sc_[q][j] = *(const f32x4*)(mod + 1024 + 4 * F.lane + 256 * j); sh_[q][j] = *(const f32x4*)(mod + 4 * F.lane + 256 * j); } }
    __builtin_amdgcn_sched_barrier(0);
#pragma unroll
    for (int q = 0; q < RB; ++q) { float s_ = 0.f;
#pragma unroll
      for (int j = 0; j < 4; ++j) s_ += (v[q][j].x * v[q][j].x + v[q][j].y * v[q][j].y) + (v[q][j].z * v[q][j].z + v[q][j].w * v[q][j].w);
      ss[q] = s_; }
#pragma unroll
    for (int o = 1; o < 64; o <<= 1)
#pragma unroll
      for (int q = 0; q < RB; ++q) ss[q] += __shfl_xor(ss[q], o);
#pragma unroll
    for (int q = 0; q < RB; ++q) { const int row = row0 + q * NGW; if (row >= MT) continue;
      const float rs = 1.0f / sqrtf(ss[q] * (1.f / 1024.f) + 1e-6f);
      unsigned long long* o8 = (unsigned long long*)(H + (size_t)row * 1024) + F.lane;
#pragma unroll
      for (int j = 0; j < 4; ++j) {
        const f32x4 h = v[q][j] * rs * w_[j] * (1.f + sc_[q][j]) + sh_[q][j];
        o8[64 * j] = (unsigned long long)pk2(h.x, h.y) | ((unsigned long long)pk2(h.z, h.w) << 32);
      } }
  }
}
}

namespace mk {
using pg8::Unit;
struct EpiIn {
  static constexpr bool PERM = true, AFTER_DRAIN = false;
  bf16* PLB; float* LA; bf16* FA2; const float* decb; const float* rope; const float* cqn; const float* ckn; const float* dqn; const float* dkn;
  __device__ __forceinline__ void operator()(const f32x4 (&acc)[2][2][4][2], const Unit& u, int wr, int wc, int fr, int fq) const {
    const int pn = u.pn;
    const bool ctxrows = u.pm >= 64;
    int kind, slot = 0; const float* nw = nullptr; bool roped = false; float qs = 1.f;
    switch (pn) {
      case 0: kind = 0; slot = S_AQK; break;
      case 1: kind = 0; slot = S_AV; break;
      case 2: kind = 1; slot = S_AG; break;
      case 3: kind = 2; break;
      case 4: case 5: kind = 3; break;
      case 6: kind = 1; slot = S_BG; break;
      case 7: kind = 4; slot = S_CQ; nw = cqn; roped = true; qs = QSCALE; break;
      case 8: slot = S_CKV; if (wc < 2) { kind = 4; nw = ckn; roped = true; } else kind = 0; break;
      case 9: kind = 1; slot = S_CG; break;
      case 10: kind = 4; slot = S_DQ; nw = dqn; qs = QSCALE; break;
      case 11: kind = 4; slot = S_DK; nw = dkn; break;
      case 12: kind = 0; slot = S_DV; break;
      default: kind = 1; slot = S_DG; break;
    }
    const int row0 = u.pm * 256 + wr * 64 + fr;
    float w8[2][8];
    if (kind == 4) {
#pragma unroll
      for (int bj = 0; bj < 2; ++bj)
#pragma unroll
        for (int s = 0; s < 8; ++s) { const int d = roped ? (32 * bj + 16 * (s >> 2) + 4 * fq + (s & 3)) : (32 * bj + 8 * fq + s); w8[bj][s] = nw[d] * qs; }
    }
#pragma unroll
    for (int ai = 0; ai < 2; ++ai)
#pragma unroll
      for (int m = 0; m < 4; ++m) {
        const int r = row0 + ai * 128 + m * 16;
        float v[2][8];
#pragma unroll
        for (int bj = 0; bj < 2; ++bj)
#pragma unroll
          for (int n = 0; n < 2; ++n)
#pragma unroll
            for (int e = 0; e < 4; ++e) v[bj][4 * n + e] = acc[ai][bj][m][n][e];
        if (kind == 2) {
#pragma unroll
          for (int bj = 0; bj < 2; ++bj) { const int mc = 64 * wc + 32 * bj + 8 * fq; float* dp = LA + (size_t)r * 256 + mc;
            f32x4 o0, o1;
#pragma unroll
            for (int e = 0; e < 4; ++e) { o0[e] = flogsig(v[bj][e] + decb[mc + e]) * 0.0625f; o1[e] = flogsig(v[bj][4 + e] + decb[mc + 4 + e]) * 0.0625f; }
            *(f32x4*)dp = o0; *(f32x4*)(dp + 4) = o1; }
        } else if (kind == 3) {
          int b, t; if (!ctxrows) { b = r >> 12; t = r & 4095; } else { const int rc = r - MLAT; b = rc >> 8; t = SEQ + (rc & 255); }
#pragma unroll
          for (int bj = 0; bj < 2; ++bj) { const int slice = 32 * (pn - 4) + 16 * bj + 4 * wc + fq;
            u32x4 o; o.x = pk2(v[bj][0], v[bj][1]); o.y = pk2(v[bj][2], v[bj][3]); o.z = pk2(v[bj][4], v[bj][5]); o.w = pk2(v[bj][6], v[bj][7]);
            *(u32x4*)(FA2 + (((size_t)b * 64 + slice) * TROW + t) * 8) = o; }
        } else {
          if (kind == 1) {
#pragma unroll
            for (int bj = 0; bj < 2; ++bj)
#pragma unroll
              for (int s = 0; s < 8; ++s) v[bj][s] = fsilu(v[bj][s]);
          } else if (kind == 4) {
            float ss = 0.f;
#pragma unroll
            for (int bj = 0; bj < 2; ++bj)
#pragma unroll
              for (int s = 0; s < 8; ++s) ss += v[bj][s] * v[bj][s];
            ss += __shfl_xor(ss, 16); ss += __shfl_xor(ss, 32);
            const float rs = 1.0f / sqrtf(ss * (1.f / 64.f) + 1e-6f);
#pragma unroll
            for (int bj = 0; bj < 2; ++bj)
#pragma unroll
              for (int s = 0; s < 8; ++s) v[bj][s] *= rs * w8[bj][s];
            if (roped && !ctxrows) {
              const int t = r & 4095;
#pragma unroll
              for (int bj = 0; bj < 2; ++bj) { const int pos = bj == 0 ? (t >> 6) : (t & 63);
                const f32x4 c4 = *(const f32x4*)(rope + pos * 16 + 4 * fq), s4 = *(const f32x4*)(rope + 1024 + pos * 16 + 4 * fq);
#pragma unroll
                for (int e = 0; e < 4; ++e) { const float x1 = v[bj][e], x2 = v[bj][4 + e]; v[bj][e] = x1 * c4[e] - x2 * s4[e]; v[bj][4 + e] = x2 * c4[e] + x1 * s4[e]; } }
            }
          }
#pragma unroll
          for (int bj = 0; bj < 2; ++bj) { const int mc = 64 * wc + 32 * bj + 8 * fq;
            u32x4 o; o.x = pk2(v[bj][0], v[bj][1]); o.y = pk2(v[bj][2], v[bj][3]); o.z = pk2(v[bj][4], v[bj][5]); o.w = pk2(v[bj][6], v[bj][7]);
            *(u32x4*)(PLB + (size_t)r * PLW + slot * 256 + mc) = o; }
        }
        asm volatile("" ::: "memory");
      }
  }
};
struct EpiOut {
  static constexpr bool PERM = true, AFTER_DRAIN = false;
  const float* xin; const float* cin; float* xout; float* cout; const float* MODl;
  __device__ __forceinline__ void operator()(const f32x4 (&acc)[2][2][4][2], const Unit& u, int wr, int wc, int fr_, int fq_) const {
    int fr = fr_, fq = fq_; asm volatile("" : "+v"(fr), "+v"(fq));
    const int row0 = u.pm * 256 + wr * 64 + fr, col0 = u.pn * 256 + wc * 32 + 8 * fq;
    const bool ctxrows = u.pm >= 64;
    const float* gate = MODl + (size_t)(ctxrows ? 4 : (u.pm >> 4)) * 3072 + 2048;
    f32x4 gv[2][2];
#pragma unroll
    for (int bj = 0; bj < 2; ++bj)
#pragma unroll
      for (int n = 0; n < 2; ++n) gv[bj][n] = *(const f32x4*)(gate + col0 + bj * 128 + n * 4);
#pragma unroll
    for (int ai = 0; ai < 2; ++ai)
#pragma unroll
      for (int m = 0; m < 4; ++m) {
        const int r = row0 + ai * 128 + m * 16;
        const float* sp; float* dp;
        if (!ctxrows) { sp = xin + (size_t)r * 1024 + col0; dp = xout + (size_t)r * 1024 + col0; }
        else { sp = cin + (size_t)(r - MLAT) * 1024 + col0; dp = cout + (size_t)(r - MLAT) * 1024 + col0; }
        f32x4 xv[2][2];
#pragma unroll
        for (int bj = 0; bj < 2; ++bj)
#pragma unroll
          for (int n = 0; n < 2; ++n) xv[bj][n] = *(const f32x4*)(sp + bj * 128 + n * 4);
#pragma unroll
        for (int bj = 0; bj < 2; ++bj)
#pragma unroll
          for (int n = 0; n < 2; ++n) *(f32x4*)(dp + bj * 128 + n * 4) = xv[bj][n] + gv[bj][n] * acc[ai][bj][m][n];
        asm volatile("" ::: "memory");
      }
  }
};
__device__ __forceinline__ void p2_inproj(const Frame& F, const Args& a, int layer) {
  unsigned char* ws = opq(a.ws);
  pg8::Gemm g{(const pg8::bf16_t*)(ws + WS_H), (const pg8::bf16_t*)(ws + WS_W1T) + (size_t)layer * N1 * 1024, MT, N1, 1024};
  pg8::StaticOrder S; S.init(MT, N1, F.G, (int)blockIdx.x);
  EpiIn E{(bf16*)(ws + WS_PLB), (float*)(ws + WS_LA), (bf16*)(ws + WS_FA2), opq(a.in[10]) + layer * 256, (const float*)(ws + WS_ROPE),
          opq(a.in[13]) + layer * 64, opq(a.in[14]) + layer * 64, opq(a.in[16]) + layer * 64, opq(a.in[17]) + layer * 64};
  pg8::gemm_phase<EpiIn, pg8::StaticOrder>(F.lds, g, S, E, nullptr);
}

__device__ __forceinline__ void ctx_out_item(const Frame& F, const Args& a, int item) {
  unsigned char* ws = opq(a.ws);
  const bf16* Yc = (const bf16*)(ws + WS_H) + (size_t)MLAT * 1024; const bf16* W2 = (const bf16*)(ws + WS_W2T);
  const int tm = item >> 4, tn = item & 15, sub = F.wave & 3, kh = F.wave >> 2, r32 = F.lane & 31, hi = F.lane >> 5;
  const int row0 = 64 * tm + 32 * (sub >> 1), col0 = 64 * tn + 32 * (sub & 1);
  const bf16* ap = Yc + (size_t)(row0 + r32) * 1024 + kh * 512 + 8 * hi;
  const bf16* bp = W2 + (size_t)(col0 + r32) * 1024 + kh * 512 + 8 * hi;
  f32x16 acc;
#pragma unroll
  for (int i = 0; i < 16; ++i) acc[i] = 0.f;
#pragma unroll 1
  for (int sb = 0; sb < 4; ++sb) {
    bf16x8 af[8], bf[8];
#pragma unroll
    for (int s = 0; s < 8; ++s) { af[s] = *(const bf16x8*)(ap + (sb * 8 + s) * 16); bf[s] = *(const bf16x8*)(bp + (sb * 8 + s) * 16); }
    __builtin_amdgcn_sched_barrier(0);
#pragma unroll
    for (int s = 0; s < 8; ++s) acc = __builtin_amdgcn_mfma_f32_32x32x16_bf16(af[s], bf[s], acc, 0, 0, 0);
  }
  LAS float* X = (LAS float*)F.lds + sub * 1024;
  __syncthreads();
  if (kh == 1) {
#pragma unroll
    for (int r = 0; r < 16; ++r) X[r * 64 + F.lane] = acc[r];
  }
  __syncthreads();
  if (kh == 0) {
    const float* cin = opq(a.in[2]); float* cout = (float*)(ws + WS_CTX1);
    const float gate = ((const float*)(ws + WS_MOD))[4 * 3072 + 2048 + col0 + r32];
    float ci[16];
#pragma unroll
    for (int r = 0; r < 16; ++r) ci[r] = cin[(size_t)(row0 + crow(r, hi)) * 1024 + col0 + r32];
    __builtin_amdgcn_sched_barrier(0);
#pragma unroll
    for (int r = 0; r < 16; ++r) { const size_t o = (size_t)(row0 + crow(r, hi)) * 1024 + col0 + r32; cout[o] = ci[r] + gate * (acc[r] + X[r * 64 + F.lane]); }
  }
}
__device__ __forceinline__ void p5_outproj(const Frame& F, const Args& a, int layer) {
  unsigned char* ws = opq(a.ws);
  const int M = MLAT;
  pg8::Gemm g{(const pg8::bf16_t*)(ws + WS_H), (const pg8::bf16_t*)(ws + WS_W2T) + (size_t)layer * 1024 * 1024, M, 1024, 1024};
  pg8::StaticOrder S; S.init(M, 1024, F.G, (int)blockIdx.x);
  EpiOut E{layer == 0 ? opq(a.in[0]) : opq(a.out), layer == 0 ? opq(a.in[2]) : (const float*)(ws + WS_CTX1), opq(a.out), (float*)(ws + WS_CTX1), (const float*)(ws + WS_MOD) + (size_t)layer * 5 * 3072};
  pg8::gemm_phase<EpiOut, pg8::StaticOrder>(F.lds, g, S, E, nullptr);
  if (layer == 0) { const Frame F2 = relaunder(F); for (int it = F2.vcu; it < 256; it += F2.G) ctx_out_item(F2, a, it); }
}
}

namespace mk {
typedef short v4i16_t __attribute__((ext_vector_type(4)));
__device__ __forceinline__ s16x4 vtr(LAS const unsigned char* p) { return __builtin_bit_cast(s16x4, __builtin_amdgcn_ds_read_tr16_b64_v4i16((LAS v4i16_t*)p)); }
struct AttnState { float m, l; f32x16 o0, o1; };
template <class MaskF>
__device__ __forceinline__ void attn_tile(AttnState& st, const bf16x8 (&qf)[4], LAS const unsigned char* Kt, LAS const unsigned char* Vt, int lane, MaskF&& maskf) {
  const int r32 = lane & 31, hi = lane >> 5;
  f32x16 p0, p1;
  const int ksw = (r32 >> 1) & 7;
  bf16x8 ka[4], kb[4];
#pragma unroll
  for (int s = 0; s < 4; ++s) { const int ch = ((2 * s + hi) ^ ksw) << 4; ka[s] = *(LAS const bf16x8*)(Kt + r32 * 128 + ch); kb[s] = *(LAS const bf16x8*)(Kt + (32 + r32) * 128 + ch); }
  { const f32x16 z = {0.f, 0.f, 0.f, 0.f, 0.f, 0.f, 0.f, 0.f, 0.f, 0.f, 0.f, 0.f, 0.f, 0.f, 0.f, 0.f};
    p0 = __builtin_amdgcn_mfma_f32_32x32x16_bf16(ka[0], qf[0], z, 0, 0, 0); p1 = __builtin_amdgcn_mfma_f32_32x32x16_bf16(kb[0], qf[0], z, 0, 0, 0); }
#pragma unroll
  for (int s = 1; s < 4; ++s) { p0 = __builtin_amdgcn_mfma_f32_32x32x16_bf16(ka[s], qf[s], p0, 0, 0, 0); p1 = __builtin_amdgcn_mfma_f32_32x32x16_bf16(kb[s], qf[s], p1, 0, 0, 0); }
  maskf(p0, p1);
  float ps = 0.f;
#pragma unroll
  for (int i = 0; i < 16; ++i) { p0[i] = __builtin_amdgcn_exp2f(p0[i]); p1[i] = __builtin_amdgcn_exp2f(p1[i]); ps += p0[i] + p1[i]; }
  st.l += ps;
  u32x4 pw[4];
#pragma unroll
  for (int k = 0; k < 2; ++k) {
    pw[k] = (u32x4){pk2(p0[8 * k + 0], p0[8 * k + 1]), pk2(p0[8 * k + 2], p0[8 * k + 3]), pk2(p0[8 * k + 4], p0[8 * k + 5]), pk2(p0[8 * k + 6], p0[8 * k + 7])};
    pw[2 + k] = (u32x4){pk2(p1[8 * k + 0], p1[8 * k + 1]), pk2(p1[8 * k + 2], p1[8 * k + 3]), pk2(p1[8 * k + 4], p1[8 * k + 5]), pk2(p1[8 * k + 6], p1[8 * k + 7])};
  }
  const int q = (lane & 15) >> 2, p = lane & 3, gsel = (lane >> 4) & 1;
  const int vrow = (4 * hi + q) * 128 + 8 * (p & 1);
  const int chb = 2 * gsel + (p >> 1);
#pragma unroll
  for (int ks = 0; ks < 4; ++ks) {
    const int c0_ = ((chb | ((0 ^ (q >> 1)) << 2)) << 4), c1_ = ((chb | ((1 ^ (q >> 1)) << 2)) << 4);
    const s16x4 l0 = vtr(Vt + ks * 2048 + vrow + c0_), h0 = vtr(Vt + ks * 2048 + 1024 + vrow + c0_), l1 = vtr(Vt + ks * 2048 + vrow + c1_), h1 = vtr(Vt + ks * 2048 + 1024 + vrow + c1_);
    const bf16x8 va0 = (bf16x8){l0[0], l0[1], l0[2], l0[3], h0[0], h0[1], h0[2], h0[3]}, va1 = (bf16x8){l1[0], l1[1], l1[2], l1[3], h1[0], h1[1], h1[2], h1[3]};
    st.o0 = __builtin_amdgcn_mfma_f32_32x32x16_bf16(va0, __builtin_bit_cast(bf16x8, pw[ks]), st.o0, 0, 0, 0);
    st.o1 = __builtin_amdgcn_mfma_f32_32x32x16_bf16(va1, __builtin_bit_cast(bf16x8, pw[ks]), st.o1, 0, 0, 0);
  }
}
__device__ __forceinline__ void attn_store(const AttnState& st, float inv, const bf16* grow  , bf16* yrow  , int lane) {
  const int hi = lane >> 5;
  u32x2 gv[8];
#pragma unroll
  for (int i = 0; i < 8; ++i) gv[i] = *(const u32x2*)(grow + 32 * (i >> 2) + 8 * (i & 3) + 4 * hi);
  __builtin_amdgcn_sched_barrier(0);
#pragma unroll
  for (int d0 = 0; d0 < 2; ++d0)
#pragma unroll
    for (int gi = 0; gi < 4; ++gi) {
      const int db = 32 * d0 + 8 * gi + 4 * hi; const u32x2 g = gv[4 * d0 + gi];
      const f32x16& o = d0 == 0 ? st.o0 : st.o1;
      const float g0 = __uint_as_float(g.x << 16), g1 = __uint_as_float(g.x & 0xffff0000u), g2 = __uint_as_float(g.y << 16), g3 = __uint_as_float(g.y & 0xffff0000u);
      u32x2 ov; ov.x = pk2(o[4 * gi + 0] * inv * g0, o[4 * gi + 1] * inv * g1); ov.y = pk2(o[4 * gi + 2] * inv * g2, o[4 * gi + 3] * inv * g3);
      *(u32x2*)(yrow + db) = ov;
    }
}
template <int NH> struct TileRegs { u32x4 k[NH], v[NH]; };
template <int NH>
__device__ __forceinline__ void tile_load(TileRegs<NH>& R, const bf16* kbase  , const bf16* vbase, int tid) {
  const int key = tid >> 3, ch = tid & 7;
#pragma unroll
  for (int h = 0; h < NH; ++h) { R.k[h] = *(const u32x4*)(kbase + (size_t)key * PLW + h * 64 + ch * 8); R.v[h] = *(const u32x4*)(vbase + (size_t)key * PLW + h * 64 + ch * 8); }
}
template <int NH>
__device__ __forceinline__ void tile_store(const TileRegs<NH>& R, LAS unsigned char* buf, int tid) {
  const int key = tid >> 3, ch = tid & 7;
  const int ko = key * 128 + ((ch ^ ((key >> 1) & 7)) << 4), vo = key * 128 + ((ch ^ (((key >> 1) & 1) << 2)) << 4);
#pragma unroll
  for (int h = 0; h < NH; ++h) { *(LAS u32x4*)(buf + h * 8192 + ko) = R.k[h]; *(LAS u32x4*)(buf + NH * 8192 + h * 8192 + vo) = R.v[h]; }
}

template <int NH> struct TileRegs2 { TileRegs<NH> a, b; };
__device__ __forceinline__ void swa_item(const Frame& F0, const Args& a, int layer, int item) {
  const Frame F = relaunder(F0);
  unsigned char* ws = opq(a.ws);
  const bf16* PLB = (const bf16*)(ws + WS_PLB); bf16* Y = (bf16*)(ws + WS_H);
  const bool isctx = item >= 256;
  int b, kvh, n;
  if (!isctx) { b = item >> 6; kvh = (item >> 5) & 1; n = item & 31; } else { const int ci = item - 256; b = ci >> 2; kvh = (ci >> 1) & 1; n = ci & 1; }
  const int g = F.wave >> 2, quarter = F.wave & 3, hq = 2 * kvh + g, r32 = F.lane & 31, hi = F.lane >> 5;
  const int tq = 128 * n + 32 * quarter + r32;
  const size_t qrow = isctx ? (size_t)MLAT + b * CTX + tq : (size_t)b * SEQ + tq;
  bf16x8 qf[4];
#pragma unroll
  for (int s = 0; s < 4; ++s) qf[s] = *(const bf16x8*)(PLB + qrow * PLW + S_CQ * 256 + hq * 64 + 16 * s + 8 * hi);
  int jlo = 0, jhi = 0;
  if (!isctx) { jlo = n == 0 ? 1 : 0; jhi = n == 31 ? 2 : 3; }
  const int nloc = jhi - jlo, T = nloc + 2;
  const bf16* kcol = PLB + S_CKV * 256 + kvh * 64;
  auto tile_row = [&](int t) -> size_t { return t < nloc ? (size_t)b * SEQ + 128 * (n - 1 + jlo + t) : (size_t)MLAT + b * CTX + 128 * (t - nloc); };
  AttnState st; st.m = 0.f; st.l = 0.f;
#pragma unroll
  for (int i = 0; i < 16; ++i) { st.o0[i] = 0.f; st.o1[i] = 0.f; }
  TileRegs2<1> R;
  __syncthreads();
  { const size_t r0 = tile_row(0); tile_load<1>(R.a, kcol + r0 * PLW, kcol + 128 + r0 * PLW, F.tid); tile_load<1>(R.b, kcol + (r0 + 64) * PLW, kcol + 128 + (r0 + 64) * PLW, F.tid); }
  tile_store<1>(R.a, F.lds, F.tid); tile_store<1>(R.b, F.lds + 16384, F.tid);
  __syncthreads();
  for (int t = 0; t < T; ++t) {
    if (t + 1 < T) { const size_t r0 = tile_row(t + 1); tile_load<1>(R.a, kcol + r0 * PLW, kcol + 128 + r0 * PLW, F.tid); tile_load<1>(R.b, kcol + (r0 + 64) * PLW, kcol + 128 + (r0 + 64) * PLW, F.tid); }
    LAS const unsigned char* buf = F.lds + (t & 1) * 32768;
#pragma unroll
    for (int hf = 0; hf < 2; ++hf) {
      LAS const unsigned char* hb = buf + hf * 16384;
      if (t < nloc) {
        const int kb = 128 * (n - 1 + jlo + t) + 64 * hf, q0 = 128 * n + 32 * quarter;
        if (!(kb + 63 < q0 - 128 || kb > q0 + 31 + 128)) {
          const int dq = kb - tq;
          if (kb >= q0 + 31 - 128 && kb + 63 <= q0 + 128) attn_tile(st, qf, hb, hb + 8192, F.lane, [](f32x16&, f32x16&) {});
          else attn_tile(st, qf, hb, hb + 8192, F.lane, [&](f32x16& p0, f32x16& p1) {
#pragma unroll
            for (int r = 0; r < 16; ++r) { const int d0_ = dq + 128 + crow(r, hi), d1_ = d0_ + 32;
              p0[r] = ((unsigned)d0_ <= 256u) ? p0[r] : -INFINITY; p1[r] = ((unsigned)d1_ <= 256u) ? p1[r] : -INFINITY; } });
        }
      } else attn_tile(st, qf, hb, hb + 8192, F.lane, [](f32x16&, f32x16&) {});
    }
    if (t + 1 < T) { tile_store<1>(R.a, F.lds + ((t + 1) & 1) * 32768, F.tid); tile_store<1>(R.b, F.lds + ((t + 1) & 1) * 32768 + 16384, F.tid); }
    __syncthreads();
  }
  float l = st.l + __shfl_xor(st.l, 32);
  const float sk2 = opq(a.in[15])[layer * 4 + hq] * LOG2E;
  const float mnew = fmaxf(st.m, sk2), al = __builtin_amdgcn_exp2f(st.m - mnew);
  l = l * al + __builtin_amdgcn_exp2f(sk2 - mnew);
  int qr = (int)qrow; asm volatile("" : "+v"(qr));
  attn_store(st, al / l, PLB + (size_t)qr * PLW + S_CG * 256 + hq * 64, Y + (size_t)qr * 1024 + 512 + hq * 64, F.lane);
}
__device__ __forceinline__ void na_item(const Frame& F0, const Args& a, int layer, int item) {
  const Frame F = relaunder(F0);
  unsigned char* ws = opq(a.ws);
  const bf16* PLB = (const bf16*)(ws + WS_PLB); bf16* Y = (bf16*)(ws + WS_H);
  const bool isctx = item >= 256;
  int b, r;
  if (!isctx) { b = item >> 6; r = item & 63; } else { const int ci = item - 256; b = ci >> 2; r = ci & 3; }
  const int head = F.wave >> 1, half = F.wave & 1, r32 = F.lane & 31, hi = F.lane >> 5;
  const int qc = 32 * half + r32;
  const size_t qrow = isctx ? (size_t)MLAT + b * CTX + 64 * r + qc : (size_t)b * SEQ + 64 * r + qc;
  bf16x8 qf[4];
#pragma unroll
  for (int s = 0; s < 4; ++s) qf[s] = *(const bf16x8*)(PLB + qrow * PLW + S_DQ * 256 + head * 64 + 16 * s + 8 * hi);
  int rs = r - 4; rs = rs < 0 ? 0 : (rs > 56 ? 56 : rs);
  const int nloc = isctx ? 0 : 8, T = nloc + 4;
  auto tile_row = [&](int t) -> size_t { return t < nloc ? (size_t)b * SEQ + 64 * (rs + t) : (size_t)MLAT + b * CTX + 64 * (t - nloc); };
  const bf16* kcol = PLB + S_DK * 256; const bf16* vcol = PLB + S_DV * 256;
  LAS float* btab = (LAS float*)(F.lds + 2 * 65536);
  AttnState st; st.m = 0.f; st.l = 0.f;
#pragma unroll
  for (int i = 0; i < 16; ++i) { st.o0[i] = 0.f; st.o1[i] = 0.f; }
  TileRegs<4> R;
  __syncthreads();
  {
    const float* rb = opq(a.in[18]) + (size_t)layer * 4 * 15 * 31; float t_[15];
#pragma unroll
    for (int i = 0; i < 15; ++i) { const int ix = F.tid + 512 * i, hd = ix >> 7, dx = (ix & 127) - 63; const bool ok = dx >= -15 && dx <= 15; t_[i] = ok ? rb[hd * 31 + dx + 15] : 0.f; }
#pragma unroll
    for (int i = 0; i < 15; ++i) btab[F.tid + 512 * i] = t_[i] * LOG2E; }
  tile_load<4>(R, kcol + tile_row(0) * PLW, vcol + tile_row(0) * PLW, F.tid);
  tile_store<4>(R, F.lds, F.tid);
  __syncthreads();
  int c0 = qc - 8; c0 = c0 < 0 ? 0 : (c0 > 48 ? 48 : c0);
  for (int t = 0; t < T; ++t) {
    if (t + 1 < T) tile_load<4>(R, kcol + tile_row(t + 1) * PLW, vcol + tile_row(t + 1) * PLW, F.tid);
    LAS const unsigned char* buf = F.lds + (t & 1) * 65536;
    if (t < nloc) {
      const int dy = rs + t - r + 7;
      int c0l = c0; asm volatile("" : "+v"(c0l));
      LAS const float* bt = btab + (head * 15 + dy) * 128 + 63 - qc + 4 * hi;
      attn_tile(st, qf, buf + head * 8192, buf + 32768 + head * 8192, F.lane, [&](f32x16& p0, f32x16& p1) {
        float bb[16];
#pragma unroll
        for (int rr = 0; rr < 16; ++rr) bb[rr] = bt[(rr & 3) + 8 * (rr >> 2)];
#pragma unroll
        for (int rr = 0; rr < 16; ++rr) p0[rr] = ((unsigned)((rr & 3) + 8 * (rr >> 2) + 4 * hi - c0l) < 16u) ? p0[rr] + bb[rr] : -INFINITY;
#pragma unroll
        for (int rr = 0; rr < 16; ++rr) bb[rr] = bt[(rr & 3) + 8 * (rr >> 2) + 32];
#pragma unroll
        for (int rr = 0; rr < 16; ++rr) p1[rr] = ((unsigned)((rr & 3) + 8 * (rr >> 2) + 32 + 4 * hi - c0l) < 16u) ? p1[rr] + bb[rr] : -INFINITY; });
    } else attn_tile(st, qf, buf + head * 8192, buf + 32768 + head * 8192, F.lane, [](f32x16&, f32x16&) {});
    if (t + 1 < T) tile_store<4>(R, F.lds + ((t + 1) & 1) * 65536, F.tid);
    __syncthreads();
  }
  const float l = st.l + __shfl_xor(st.l, 32);
  int qr = (int)qrow; asm volatile("" : "+v"(qr));
  attn_store(st, 1.f / l, PLB + (size_t)qr * PLW + S_DG * 256 + head * 64, Y + (size_t)qr * 1024 + 768 + head * 64, F.lane);
}
}

namespace mk {
constexpr int XT_STRIDE = 272;
constexpr int FFT_WC = 256 * XT_STRIDE;
__device__ __forceinline__ void fft_item(const Frame& F0, const Args& a, int item) {
  const Frame F = relaunder(F0);
  unsigned char* ws = opq(a.ws);
  const bf16* PLB = (const bf16*)(ws + WS_PLB); bf16* Y = (bf16*)(ws + WS_H);
  const int b = item >> 6, slice = item & 63, r32 = F.lane & 31, hi = F.lane >> 5, w = F.wave;
  LAS unsigned char* Xt = F.lds; LAS unsigned char* Wl = F.lds + FFT_WC;
  __syncthreads();
  {
    const bf16* WC = (const bf16*)(ws + WS_WC);
    u32x4 wt[4];
#pragma unroll
    for (int i = 0; i < 4; ++i) { const int idx = F.tid + 512 * i, row = idx >> 4, ch = idx & 15; wt[i] = *(const u32x4*)(WC + row * 128 + ch * 8); }
    const bf16* src = (const bf16*)(ws + WS_FA2) + ((size_t)b * 64 + slice) * TROW * 8;
    u32x4 v[8];
#pragma unroll
    for (int i = 0; i < 8; ++i) v[i] = *(const u32x4*)(src + (size_t)(F.tid + 512 * i) * 8);
    __builtin_amdgcn_sched_barrier(0);
#pragma unroll
    for (int i = 0; i < 4; ++i) { const int idx = F.tid + 512 * i, row = idx >> 4, ch = idx & 15; *(LAS u32x4*)(Wl + row * XT_STRIDE + ch * 16) = wt[i]; }
#pragma unroll
    for (int i = 0; i < 8; ++i) { const int t = F.tid + 512 * i, n1 = t >> 6, n2 = t & 63;
      const unsigned vv[4] = {v[i].x, v[i].y, v[i].z, v[i].w};
#pragma unroll
      for (int j = 0; j < 8; ++j) { const int c = j & 3, part = j >> 2; const unsigned short e = (unsigned short)((j & 1) ? (vv[j >> 1] >> 16) : (vv[j >> 1] & 0xffffu));
        *(LAS unsigned short*)(Xt + (n2 * 4 + c) * XT_STRIDE + (part * 64 + n1) * 2) = e; } }
  }
  __syncthreads();
  f32x16 acc[4];
#pragma unroll
  for (int rb = 0; rb < 4; ++rb)
#pragma unroll
    for (int i = 0; i < 16; ++i) acc[rb][i] = 0.f;
  {
    bf16x8 bf[8];
#pragma unroll
    for (int s = 0; s < 8; ++s) bf[s] = *(LAS const bf16x8*)(Xt + (32 * w + r32) * XT_STRIDE + (16 * s + 8 * hi) * 2);
#pragma unroll
    for (int rb = 0; rb < 4; ++rb)
#pragma unroll
      for (int s = 0; s < 8; ++s) { const bf16x8 af = *(LAS const bf16x8*)(Wl + (32 * rb + r32) * XT_STRIDE + (16 * s + 8 * hi) * 2); acc[rb] = __builtin_amdgcn_mfma_f32_32x32x16_bf16(af, bf[s], acc[rb], 0, 0, 0); }
  }
  __syncthreads();
  {
    const int n2 = 8 * w + (r32 >> 2), c = r32 & 3;
#pragma unroll
    for (int rbp = 0; rbp < 2; ++rbp)
#pragma unroll
      for (int r = 0; r < 16; ++r) { const int k1 = 32 * rbp + crow(r, hi); float x = (float)((k1 * n2) & 4095) * (1.f / 4096.f);
        asm volatile("" : "+v"(x) :: "memory");
        const float tc = __builtin_amdgcn_cosf(x), ts = __builtin_amdgcn_sinf(x);
        const float yr = acc[rbp][r], yi = acc[rbp + 2][r];
        const float zr = yr * tc + yi * ts, zi = yi * tc - yr * ts;
        LAS unsigned char* zp = Xt + (k1 * 4 + c) * XT_STRIDE + n2 * 2;
        *(LAS unsigned short*)zp = (unsigned short)f2bf(zr); *(LAS unsigned short*)(zp + 128) = (unsigned short)f2bf(zi); }
  }
  __syncthreads();
  f32x16 o2[2];
#pragma unroll
  for (int rb = 0; rb < 2; ++rb)
#pragma unroll
    for (int i = 0; i < 16; ++i) o2[rb][i] = 0.f;
  {
    bf16x8 bf[8];
#pragma unroll
    for (int s = 0; s < 8; ++s) bf[s] = *(LAS const bf16x8*)(Xt + (32 * w + r32) * XT_STRIDE + (16 * s + 8 * hi) * 2);
#pragma unroll
    for (int rb = 0; rb < 2; ++rb)
#pragma unroll
      for (int s = 0; s < 8; ++s) { const bf16x8 af = *(LAS const bf16x8*)(Wl + (32 * rb + r32) * XT_STRIDE + (16 * s + 8 * hi) * 2); o2[rb] = __builtin_amdgcn_mfma_f32_32x32x16_bf16(af, bf[s], o2[rb], 0, 0, 0); }
  }
  __syncthreads();
  { const int k1 = 8 * w + (r32 >> 2), c = r32 & 3;
#pragma unroll
    for (int rb = 0; rb < 2; ++rb)
#pragma unroll
      for (int r = 0; r < 16; ++r) { const int k = k1 + 64 * (32 * rb + crow(r, hi)); *(LAS unsigned short*)(Xt + k * 8 + c * 2) = (unsigned short)f2bf(o2[rb][r]); }
  }
  __syncthreads();
  { const int o0 = 4 * slice; u32x2 gv[8];
#pragma unroll
    for (int i = 0; i < 8; ++i) gv[i] = *(const u32x2*)(PLB + ((size_t)b * SEQ + F.tid + 512 * i) * PLW + S_BG * 256 + o0);
    __builtin_amdgcn_sched_barrier(0);
#pragma unroll
    for (int i = 0; i < 8; ++i) { const int k = F.tid + 512 * i; const size_t row = (size_t)b * SEQ + k;
      const u32x2 ov = *(LAS const u32x2*)(Xt + k * 8);
      u32x2 y; y.x = pk2(__uint_as_float(ov.x << 16) * __uint_as_float(gv[i].x << 16), __uint_as_float(ov.x & 0xffff0000u) * __uint_as_float(gv[i].x & 0xffff0000u));
      y.y = pk2(__uint_as_float(ov.y << 16) * __uint_as_float(gv[i].y << 16), __uint_as_float(ov.y & 0xffff0000u) * __uint_as_float(gv[i].y & 0xffff0000u));
      *(u32x2*)(Y + row * 1024 + 256 + o0) = y; }
  }
}
constexpr int XC_STRIDE = 1040;
__device__ __forceinline__ void fftc_item(const Frame& F0, const Args& a, int item) {
  const Frame F = relaunder(F0);
  unsigned char* ws = opq(a.ws);
  const bf16* PLB = (const bf16*)(ws + WS_PLB); bf16* Y = (bf16*)(ws + WS_H);
  const bf16* CS = (const bf16*)(ws + WS_CS256);
  const int b = item >> 3, cs = item & 7, r32 = F.lane & 31, hi = F.lane >> 5, w = F.wave;
  LAS unsigned char* Xc = F.lds;
  __syncthreads();
  u32x4 vq[4];
#pragma unroll
  for (int i = 0; i < 4; ++i) { const int idx = F.tid + 512 * i, sl = idx >> 8, n = idx & 255;
    vq[i] = *(const u32x4*)((const bf16*)(ws + WS_FA2) + (((size_t)b * 64 + 8 * cs + sl) * TROW + SEQ + n) * 8); }
  __builtin_amdgcn_sched_barrier(0);
#pragma unroll
  for (int i = 0; i < 4; ++i) { const int idx = F.tid + 512 * i, sl = idx >> 8, n = idx & 255;
    const unsigned vv[4] = {vq[i].x, vq[i].y, vq[i].z, vq[i].w};
#pragma unroll
    for (int j = 0; j < 8; ++j) { const int c = j & 3, part = j >> 2; const unsigned short e = (unsigned short)((j & 1) ? (vv[j >> 1] >> 16) : (vv[j >> 1] & 0xffffu));
      *(LAS unsigned short*)(Xc + (4 * sl + c) * XC_STRIDE + (part * 256 + n) * 2) = e; } }
  __syncthreads();
  f32x16 acc;
#pragma unroll
  for (int i = 0; i < 16; ++i) acc[i] = 0.f;
#pragma unroll 8
  for (int s = 0; s < 32; ++s) {
    const bf16x8 af = *(const bf16x8*)(CS + (size_t)(32 * w + r32) * 512 + 16 * s + 8 * hi);
    const bf16x8 bf = *(LAS const bf16x8*)(Xc + r32 * XC_STRIDE + (16 * s + 8 * hi) * 2);
    acc = __builtin_amdgcn_mfma_f32_32x32x16_bf16(af, bf, acc, 0, 0, 0);
  }
  const int o = 32 * cs + r32;
#pragma unroll
  for (int r = 0; r < 16; ++r) { const size_t row = (size_t)MLAT + b * CTX + 32 * w + crow(r, hi);
    Y[row * 1024 + 256 + o] = (bf16)f2bf(acc[r] * bf2f(PLB[row * PLW + S_BG * 256 + o])); }
}
}

namespace mk {
constexpr int GU_STRIDE = 2048 + 64;
constexpr size_t WS_GU = WS_SCR, WS_GS = WS_GU + (size_t)32 * 68 * GU_STRIDE * 4;
__device__ __forceinline__ size_t gla_row(int b, int c, int i) { return c < 64 ? (size_t)b * SEQ + 64 * c + i : (size_t)MLAT + b * CTX + 64 * (c - 64) + i; }
__device__ __forceinline__ int gla_pos(int c, int dir) { return c < 64 ? (dir ? 4 + 63 - c : 4 + c) : (dir ? 3 - (c - 64) : (c - 64)); }
__device__ __forceinline__ void gla_stage_v(const Frame& F, const bf16* PLB, int b, int c, LAS unsigned char* vbase) {
  const int key = F.tid >> 3, ch = F.tid & 7;
  const bf16* src = PLB + gla_row(b, c, key) * PLW + S_AV * 256 + ch * 8;
  const int vo = key * 128 + ((ch ^ (((key >> 1) & 1) << 2)) << 4);
  u32x4 t_[4];
#pragma unroll
  for (int h = 0; h < 4; ++h) t_[h] = *(const u32x4*)(src + h * 64);
#pragma unroll
  for (int h = 0; h < 4; ++h) *(LAS u32x4*)(vbase + h * 8192 + vo) = t_[h];
}
__device__ __forceinline__ void gla_cum(const float* LA, int b, int c, int h, int dir, int lane, float (&cw)[32], float& T) {
  const int d = lane & 31, half = lane >> 5;
  float a[32];
#pragma unroll
  for (int ii = 0; ii < 32; ++ii) a[ii] = LA[gla_row(b, c, 32 * half + ii) * 256 + dir * 128 + h * 32 + d];
  float run = 0.f;
#pragma unroll
  for (int ii = 0; ii < 32; ++ii) { run += a[ii]; cw[ii] = run; }
  const float other = __shfl_xor(run, 32);
  const float tot0 = half ? other : run;
  T = run + other;
#pragma unroll
  for (int ii = 0; ii < 32; ++ii) { const float cf = cw[ii] + (half ? tot0 : 0.f); cw[ii] = dir ? (T - cf + a[ii]) : cf; }
}
constexpr int KT_STRIDE = 144;
__device__ __forceinline__ void gla_local_item(const Frame& F0, const Args& a, int item) {
  const Frame F = relaunder(F0);
  unsigned char* ws = opq(a.ws);
  const bf16* PLB = (const bf16*)(ws + WS_PLB); const float* LA = (const float*)(ws + WS_LA);
  const int b = item / 68, c = item % 68, h = F.wave >> 1, dir = F.wave & 1, d = F.lane & 31, half = F.lane >> 5, r32 = d, hi = half;
  LAS unsigned char* Vt = F.lds + h * 8192; LAS unsigned char* KT = F.lds + 32768 + F.wave * (32 * KT_STRIDE);
  __syncthreads();
  gla_stage_v(F, PLB, b, c, F.lds);
  float cw[32], T;
  gla_cum(LA, b, c, h, dir, F.lane, cw, T);
  {
    unsigned pkd[16]; bf16 kr[32];
    const bf16* kp = PLB + gla_row(b, c, 32 * half) * PLW + S_AQK * 256 + 128 + h * 32 + d;
#pragma unroll
    for (int ii = 0; ii < 32; ++ii) kr[ii] = kp[(size_t)ii * PLW];
#pragma unroll
    for (int ii = 0; ii < 32; ii += 2) pkd[ii >> 1] = pk2(bf2f(kr[ii]) * __expf(T - cw[ii]), bf2f(kr[ii + 1]) * __expf(T - cw[ii + 1]));
#pragma unroll
    for (int q4 = 0; q4 < 4; ++q4) *(LAS u32x4*)(KT + d * KT_STRIDE + half * 64 + q4 * 16) = (u32x4){pkd[4 * q4], pkd[4 * q4 + 1], pkd[4 * q4 + 2], pkd[4 * q4 + 3]};
  }
  __syncthreads();
  f32x16 acc[2];
#pragma unroll
  for (int eb = 0; eb < 2; ++eb)
#pragma unroll
    for (int i = 0; i < 16; ++i) acc[eb][i] = 0.f;
  const int q = (F.lane & 15) >> 2, p = F.lane & 3, gsel = (F.lane >> 4) & 1;
  const int chb = 2 * gsel + (p >> 1);
#pragma unroll
  for (int st = 0; st < 4; ++st) {
    const bf16x8 kb = *(LAS const bf16x8*)(KT + r32 * KT_STRIDE + (16 * st + 8 * hi) * 2);
#pragma unroll
    for (int eb = 0; eb < 2; ++eb) {
      const int ch = ((chb | ((eb ^ (q >> 1)) << 2)) << 4);
      LAS const unsigned char* vp = Vt + (16 * st + 8 * hi + q) * 128 + 8 * (p & 1) + ch;
      const s16x4 lo = vtr(vp), hh = vtr(vp + 512);
      const bf16x8 va = (bf16x8){lo[0], lo[1], lo[2], lo[3], hh[0], hh[1], hh[2], hh[3]};
      acc[eb] = __builtin_amdgcn_mfma_f32_32x32x16_bf16(va, kb, acc[eb], 0, 0, 0);
    }
  }
  const int chain = (b * 4 + h) * 2 + dir, pos = gla_pos(c, dir);
  float* gu = (float*)(ws + WS_GU) + ((size_t)chain * 68 + pos) * GU_STRIDE;
#pragma unroll
  for (int eb = 0; eb < 2; ++eb)
#pragma unroll
    for (int r = 0; r < 16; ++r) gu[(32 * eb + crow(r, hi)) * 32 + r32] = acc[eb][r];
  if (half == 0) gu[2048 + d] = __expf(T);
}
__device__ __forceinline__ void gla_scan(const Frame& F0, const Args& a) {
  const Frame F = relaunder(F0);
  unsigned char* ws = opq(a.ws);
  const int gt = F.vcu * 512 + F.tid;
  if (gt >= 32 * 2048) return;
  const int chain = gt >> 11, el = gt & 2047, d = el & 31;
  const float* gu = (const float*)(ws + WS_GU) + (size_t)chain * 68 * GU_STRIDE;
  bf16* gs = (bf16*)(ws + WS_GS) + (size_t)chain * 68 * 2048 + el;
  float S = 0.f;
#pragma unroll 34
  for (int pos = 0; pos < 68; ++pos) { gs[(size_t)pos * 2048] = (bf16)f2bf(S); S = gu[(size_t)pos * GU_STRIDE + 2048 + d] * S + gu[(size_t)pos * GU_STRIDE + el]; }
}
constexpr int QK_STRIDE = 80;
__device__ __forceinline__ void gla_out_item(const Frame& F0, const Args& a, int layer, int item) {
  const Frame F = relaunder(F0);
  unsigned char* ws = opq(a.ws);
  const bf16* PLB = (const bf16*)(ws + WS_PLB); const float* LA = (const float*)(ws + WS_LA); bf16* Y = (bf16*)(ws + WS_H);
  const int b = item / 68, c = item % 68, h = F.wave >> 1, dir = F.wave & 1, d = F.lane & 31, half = F.lane >> 5, r32 = d, hi = half;
  LAS unsigned char* Vt = F.lds + h * 8192;
  LAS unsigned char* QT = F.lds + 32768 + F.wave * (2 * 64 * QK_STRIDE); LAS unsigned char* KT = QT + 64 * QK_STRIDE;
  LAS float* X = (LAS float*)(F.lds + 32768) + h * 4096;
  __syncthreads();
  gla_stage_v(F, PLB, b, c, F.lds);
  {
    float cw[32], T;
    gla_cum(LA, b, c, h, dir, F.lane, cw, T);
    bf16 qr[32], kr[32];
    const bf16* pr = PLB + gla_row(b, c, 32 * half) * PLW + S_AQK * 256 + h * 32 + d;
#pragma unroll
    for (int ii = 0; ii < 32; ++ii) { qr[ii] = pr[(size_t)ii * PLW]; kr[ii] = pr[(size_t)ii * PLW + 128]; }
#pragma unroll
    for (int ii = 0; ii < 32; ++ii) { const int i = 32 * half + ii;
      const float ec = __expf(cw[ii]);
      *(LAS unsigned short*)(QT + i * QK_STRIDE + d * 2) = (unsigned short)f2bf(bf2f(qr[ii]) * ec);
      *(LAS unsigned short*)(KT + i * QK_STRIDE + d * 2) = (unsigned short)f2bf(bf2f(kr[ii]) * __builtin_amdgcn_rcpf(ec)); }
  }
  __syncthreads();
  f32x16 oacc[2][2];
#pragma unroll
  for (int eb = 0; eb < 2; ++eb)
#pragma unroll
    for (int ib = 0; ib < 2; ++ib)
#pragma unroll
      for (int i = 0; i < 16; ++i) oacc[eb][ib][i] = 0.f;
  bf16x8 qb[2][2];
#pragma unroll
  for (int ib = 0; ib < 2; ++ib)
#pragma unroll
    for (int st = 0; st < 2; ++st) qb[ib][st] = *(LAS const bf16x8*)(QT + (32 * ib + r32) * QK_STRIDE + (16 * st + 8 * hi) * 2);
  const int chain = (b * 4 + h) * 2 + dir, pos = gla_pos(c, dir);
  {
    const bf16* gs = (const bf16*)(ws + WS_GS) + ((size_t)chain * 68 + pos) * 2048;
#pragma unroll
    for (int eb = 0; eb < 2; ++eb)
#pragma unroll
      for (int st = 0; st < 2; ++st) { const bf16x8 sf = *(const bf16x8*)(gs + (32 * eb + r32) * 32 + 16 * st + 8 * hi);
#pragma unroll
        for (int ib = 0; ib < 2; ++ib) oacc[eb][ib] = __builtin_amdgcn_mfma_f32_32x32x16_bf16(sf, qb[ib][st], oacc[eb][ib], 0, 0, 0); }
  }
  const int q = (F.lane & 15) >> 2, p = F.lane & 3, gsel = (F.lane >> 4) & 1;
  const int vrow = (4 * hi + q) * 128 + 8 * (p & 1), chb = 2 * gsel + (p >> 1);
#pragma unroll
  for (int sb = 0; sb < 2; ++sb) {
    bf16x8 kf[2];
#pragma unroll
    for (int st = 0; st < 2; ++st) kf[st] = *(LAS const bf16x8*)(KT + (32 * sb + r32) * QK_STRIDE + (16 * st + 8 * hi) * 2);
#pragma unroll
    for (int ib = 0; ib < 2; ++ib) {
      const bool need = dir == 0 ? (sb <= ib) : (sb >= ib);
      if (!need) continue;
      f32x16 sc;
#pragma unroll
      for (int i = 0; i < 16; ++i) sc[i] = 0.f;
#pragma unroll
      for (int st = 0; st < 2; ++st) sc = __builtin_amdgcn_mfma_f32_32x32x16_bf16(kf[st], qb[ib][st], sc, 0, 0, 0);
      if (sb == ib) {
#pragma unroll
        for (int r = 0; r < 16; ++r) { const int s = crow(r, hi); const bool keep = dir == 0 ? (s <= r32) : (s >= r32); sc[r] = keep ? sc[r] : 0.f; }
      }
      u32x4 pw[2];
#pragma unroll
      for (int k = 0; k < 2; ++k) pw[k] = (u32x4){pk2(sc[8 * k + 0], sc[8 * k + 1]), pk2(sc[8 * k + 2], sc[8 * k + 3]), pk2(sc[8 * k + 4], sc[8 * k + 5]), pk2(sc[8 * k + 6], sc[8 * k + 7])};
#pragma unroll
      for (int ks = 0; ks < 2; ++ks)
#pragma unroll
        for (int eb = 0; eb < 2; ++eb) {
          const int ch = ((chb | ((eb ^ (q >> 1)) << 2)) << 4);
          const s16x4 lo = vtr(Vt + (2 * sb + ks) * 2048 + vrow + ch), hh = vtr(Vt + (2 * sb + ks) * 2048 + 1024 + vrow + ch);
          const bf16x8 va = (bf16x8){lo[0], lo[1], lo[2], lo[3], hh[0], hh[1], hh[2], hh[3]};
          oacc[eb][ib] = __builtin_amdgcn_mfma_f32_32x32x16_bf16(va, __builtin_bit_cast(bf16x8, pw[ks]), oacc[eb][ib], 0, 0, 0);
        }
    }
  }
  __syncthreads();
  if (dir == 1) {
#pragma unroll
    for (int eb = 0; eb < 2; ++eb)
#pragma unroll
      for (int ib = 0; ib < 2; ++ib)
#pragma unroll
        for (int r = 0; r < 16; ++r) X[((eb * 2 + ib) * 16 + r) * 64 + F.lane] = oacc[eb][ib][r];
  }
  __syncthreads();
  if (dir == 0) {
    const float* on = opq(a.in[11]) + layer * 64;
#pragma unroll
    for (int ib = 0; ib < 2; ++ib) {
      float ss = 0.f;
#pragma unroll
      for (int eb = 0; eb < 2; ++eb)
#pragma unroll
        for (int r = 0; r < 16; ++r) { oacc[eb][ib][r] += X[((eb * 2 + ib) * 16 + r) * 64 + F.lane]; ss += oacc[eb][ib][r] * oacc[eb][ib][r]; }
      ss += __shfl_xor(ss, 32);
      const float rs = 1.0f / sqrtf(ss * (1.f / 64.f) + 1e-6f);
      const size_t row = gla_row(b, c, 32 * ib + r32);
      u32x2 gv8[8];
#pragma unroll
      for (int i = 0; i < 8; ++i) gv8[i] = *(const u32x2*)(PLB + row * PLW + S_AG * 256 + h * 64 + 32 * (i >> 2) + 8 * (i & 3) + 4 * hi);
      __builtin_amdgcn_sched_barrier(0);
#pragma unroll
      for (int eb = 0; eb < 2; ++eb)
#pragma unroll
        for (int gi = 0; gi < 4; ++gi) {
          const int e0 = 32 * eb + 8 * gi + 4 * hi;
          const f32x4 w4 = *(const f32x4*)(on + e0);
          const u32x2 gv = gv8[4 * eb + gi];
          const float g0 = __uint_as_float(gv.x << 16), g1 = __uint_as_float(gv.x & 0xffff0000u), g2 = __uint_as_float(gv.y << 16), g3 = __uint_as_float(gv.y & 0xffff0000u);
          u32x2 ov; ov.x = pk2(oacc[eb][ib][4 * gi + 0] * rs * w4[0] * g0, oacc[eb][ib][4 * gi + 1] * rs * w4[1] * g1);
          ov.y = pk2(oacc[eb][ib][4 * gi + 2] * rs * w4[2] * g2, oacc[eb][ib][4 * gi + 3] * rs * w4[3] * g3);
          *(u32x2*)(Y + row * 1024 + h * 64 + e0) = ov;
        }
    }
  }
}
}

namespace mk {
__device__ __forceinline__ void p3_mixers(const Frame& F0, const Args& a, int layer) {
  const Frame F = relaunder(F0);
  const int nx = layer == 0 ? 16 : 0, nswa = 256 + nx, nna = 256 + nx, nfc = layer == 0 ? 32 : 0;
  for (int it = F.vcu; it < 272 + 256 + nfc + nswa + nna; it += F.G) {
    int r = it;
    if (r < 272) { gla_local_item(F, a, r); continue; } r -= 272;
    if (r < 256) { fft_item(F, a, r); continue; } r -= 256;
    if (r < nfc) { fftc_item(F, a, r); continue; } r -= nfc;
    if (r < nswa) swa_item(F, a, layer, r); else na_item(F, a, layer, r - nswa);
  }
}
__device__ __forceinline__ void p4b_glaout(const Frame& F0, const Args& a, int layer) {
  const Frame F = relaunder(F0);
  for (int it = F.vcu; it < 272; it += F.G) { if (layer == 1 && (it % 68) >= 64) continue; gla_out_item(F, a, layer, it); }
}
}
#define XB_TMO      128
#define XB_XCNT(j)  (256  + 64 * (j))
#define XB_XSUB(j)  (1280 + 64 * (j))
#define XB_XGEN(j)  (2304 + 64 * (j))
#define XB_TOP      3328
#define XB_TOPGEN   3392
#define XCD_BAR_WORDS 3456
#define XB_SPIN_CAP (1u << 18)

__device__ __forceinline__ unsigned xb_ld(unsigned* p)              { return __hip_atomic_load(p, __ATOMIC_RELAXED, __HIP_MEMORY_SCOPE_AGENT); }
__device__ __forceinline__ unsigned xb_add(unsigned* p, unsigned v) { return __hip_atomic_fetch_add(p, v, __ATOMIC_RELAXED, __HIP_MEMORY_SCOPE_AGENT); }
__device__ __forceinline__ unsigned xb_xcc_id() { return (unsigned)__builtin_amdgcn_s_getreg((3 << 11) | 20) & 0xFu; }
#define XB_SPIN(cond, bar) do { unsigned _sp = 0; while (cond) { __builtin_amdgcn_s_sleep(1); \
    if ((++_sp & 255u) == 0u) { if (xb_ld(&(bar)[XB_TMO])) break; if (_sp > XB_SPIN_CAP) { atomicAdd(&(bar)[XB_TMO], 1u); break; } } } } while (0)

struct XcdBarrier {
    unsigned* bar; unsigned x;
    volatile LAS unsigned* st;
};

__device__ __forceinline__ XcdBarrier xcd_barrier_post(unsigned* bar, volatile LAS unsigned* st) {
    XcdBarrier b; b.bar = bar; b.x = xb_xcc_id(); b.st = st;
    if (threadIdx.x == 0) (void)xb_add(&bar[XB_XCNT(b.x)], 1u);
    return b;
}
__device__ __forceinline__ void xcd_barrier_complete(unsigned* bar, unsigned x, unsigned& nloc, unsigned& nx) {
    const unsigned G = gridDim.x * gridDim.y * gridDim.z;
    unsigned sum, cnt, mine, sp = 0u;
    for (;;) {
        sum = 0u; cnt = 0u; mine = 0u;
#pragma unroll
        for (unsigned j = 0; j < 16; ++j) { const unsigned c = xb_ld(&bar[XB_XCNT(j)]); sum += c; cnt += (c > 0u) ? 1u : 0u; }
        mine = xb_ld(&bar[XB_XCNT(x)]);
        if (sum == G) break;
        __builtin_amdgcn_s_sleep(1);
        if ((++sp & 255u) == 0u) { if (xb_ld(&bar[XB_TMO])) break; if (sp > XB_SPIN_CAP) { atomicAdd(&bar[XB_TMO], 1u); break; } }
    }
    nloc = mine > 0u ? mine : 1u; nx = cnt > 0u ? cnt : 1u;
}

__device__ __forceinline__ void xcd_barrier(const XcdBarrier& b) {
    asm volatile("s_waitcnt vmcnt(0)" ::: "memory");
    __syncthreads();
    if (threadIdx.x == 0) {
        unsigned* bar = b.bar;
        __builtin_amdgcn_s_waitcnt(0);
        unsigned nloc = b.st[0], nx = b.st[1];
        if (nloc == 0u) { xcd_barrier_complete(bar, b.x, nloc, nx); b.st[0] = nloc; b.st[1] = nx; }
        const unsigned old = xb_add(&bar[XB_XSUB(b.x)], 1u);
        const unsigned gen = old / nloc;
        if (old + 1u == (gen + 1u) * nloc) {
            __builtin_amdgcn_fence(__ATOMIC_RELEASE, "agent");
            asm volatile("s_waitcnt vmcnt(0)" ::: "memory");
            const unsigned og = xb_add(&bar[XB_TOP], 1u);
            const unsigned tg = og / nx;
            if (og + 1u == (tg + 1u) * nx) xb_add(&bar[XB_TOPGEN], 1u);
            else XB_SPIN(xb_ld(&bar[XB_TOPGEN]) == tg, bar);
            __builtin_amdgcn_fence(__ATOMIC_ACQUIRE, "agent");
            xb_add(&bar[XB_XGEN(b.x)], 1u);
            asm volatile("s_waitcnt vmcnt(0)" ::: "memory");
        } else {
            XB_SPIN(xb_ld(&bar[XB_XGEN(b.x)]) == gen, bar);
            __builtin_amdgcn_fence(__ATOMIC_ACQUIRE, "agent");
            asm volatile("s_waitcnt vmcnt(0)" ::: "memory");
        }
    }
    __syncthreads();
}

constexpr int LDS_BYTES = 163840, MISC_OFF = LDS_BYTES - 256;
constexpr int CW_BAR = 4096;
__global__ void __launch_bounds__(512, 2) mega(mk::Args a) {
  extern __shared__ __attribute__((aligned(16))) unsigned char lds[];
  mk::Frame F;
  F.lds = (LAS unsigned char*)lds;
  F.tid = threadIdx.x; F.lane = F.tid & 63; F.wave = __builtin_amdgcn_readfirstlane(F.tid >> 6);
  F.G = gridDim.x; { const int bx = blockIdx.x; F.vcu = (F.G % 8 == 0) ? (bx % 8) * (F.G / 8) + bx / 8 : bx; }
  volatile LAS unsigned* MISC = (volatile LAS unsigned*)(F.lds + MISC_OFF);
  if (F.tid < 64) MISC[F.tid] = 0u;
  __syncthreads();
  XcdBarrier bar; bar.bar = nullptr; bar.x = 0; bar.st = nullptr;
  const bool multi = (a.ph_hi - a.ph_lo) > 1;
  if (multi) bar = xcd_barrier_post((unsigned*)(a.ws + mk::WS_CTL) + CW_BAR, MISC + 8);
#pragma clang loop unroll(disable)
  for (int ph = a.ph_lo; ph < a.ph_hi; ++ph) {
    if (ph == 0) mk::p0_prologue(F, a);
    else {
      const int layer = (ph - 1) / 6, sub = (ph - 1) % 6;
      if (sub == 0) mk::p1_prenorm(F, a, layer);
      else if (sub == 1) mk::p2_inproj(F, a, layer);
      else if (sub == 2) mk::p3_mixers(F, a, layer);
      else if (sub == 3) mk::gla_scan(F, a);
      else if (sub == 4) mk::p4b_glaout(F, a, layer);
      else mk::p5_outproj(F, a, layer);
    }
    if (ph + 1 < a.ph_hi) xcd_barrier(bar);
  }
}

extern "C" void kernel_launch(void* const* d_in, const int* in_sizes, int n_in, void* d_out, int out_size, void* d_ws, size_t ws_size, hipStream_t stream) {
  using namespace mk;
  static int grid = 0;
  if (grid == 0) {
    int dev = 0, cus = 0, per_cu = 0; (void)hipGetDevice(&dev); (void)hipDeviceGetAttribute(&cus, hipDeviceAttributeMultiprocessorCount, dev);
    (void)hipFuncSetAttribute((const void*)mega, hipFuncAttributeMaxDynamicSharedMemorySize, LDS_BYTES);
    if (hipOccupancyMaxActiveBlocksPerMultiprocessor(&per_cu, (const void*)mega, 512, LDS_BYTES) != hipSuccess || per_cu < 1) per_cu = 1;
    (void)hipGetLastError();
    grid = (cus > 0 ? cus : 256) * (per_cu < 1 ? 1 : 1);
  }
  (void)hipMemsetAsync((char*)d_ws + WS_CTL, 0, CTL_BYTES, stream);
  Args a{};
  for (int i = 0; i < 19; ++i) a.in[i] = (const float*)d_in[i];
  a.out = (float*)d_out; a.ws = (unsigned char*)d_ws;
  a.ph_lo = 0; a.ph_hi = 13;
  void* args[] = {&a};
  if (hipLaunchCooperativeKernel((const void*)mega, dim3(grid), dim3(512), args, LDS_BYTES, stream) != hipSuccess) {
    (void)hipGetLastError();
    hipLaunchKernelGGL(mega, dim3(grid), dim3(512), LDS_BYTES, stream, a);
  }
}
```

```cpp
#include <hip/hip_runtime.h>
#include <math.h>
#include <stdint.h>

namespace pg8 {
#define PG8_LAS __attribute__((address_space(3)))
typedef unsigned short bf16_t;
typedef short bf16x8 __attribute__((ext_vector_type(8)));
typedef float f32x4 __attribute__((ext_vector_type(4)));
typedef unsigned u32x4 __attribute__((ext_vector_type(4)));
constexpr int BM = 256, BK = 64, HALF = 128, HTB = HALF * BK * 2  , STAGE_BYTES = 8 * HTB, NXCD = 8, WGM = 8;

__host__ __device__ __forceinline__ int lds_byte(int r, int c) { const int st = (r >> 4) * 2 + (c >> 5), rr = r & 15, cc = c & 31, ob = rr * 64 + cc * 2; return st * 1024 + (ob ^ (((ob >> 9) & 1) << 5)); }
__host__ __device__ __forceinline__ void stage_rc(int b, int& R, int& C) { const int st = b / 1024, sb = b % 1024, swz = sb ^ (((sb >> 9) & 1) << 5); R = (st >> 1) * 16 + swz / 64; C = (st & 1) * 32 + (swz % 64) / 2; }
__host__ __device__ __forceinline__ int perm32(int rho) { const int n = rho >> 4, i = rho & 15; return 8 * (i >> 2) + 4 * n + (i & 3); }

struct Unit { int pm, pn; };
struct Gemm { const bf16_t* A; const bf16_t* Bt; int M, N, K; };

struct StaticOrder {
    int nM, nN, nwg, G, c;
    __host__ __device__ void init(int M, int N, int G_, int c_) { nM = M / BM; nN = N / BM; nwg = nM * nN; G = G_; c = c_; }
    __host__ __device__ bool next(int i, Unit& u) const {
        const long L = (long)i * G + c; if (L >= nwg) return false;
        int wgid = (int)L; { const int q = nwg / NXCD, r = nwg % NXCD, xcd = wgid % NXCD, off = wgid / NXCD; wgid = (xcd < r ? xcd * (q + 1) : r * (q + 1) + (xcd - r) * q) + off; }
        const int nig = WGM * nN, gid = wgid / nig, fm = gid * WGM, gsz = (nM - fm) < WGM ? (nM - fm) : WGM;
        u.pm = fm + ((wgid % nig) % gsz); u.pn = (wgid % nig) / gsz; return true;
    }
    __device__ __forceinline__ void a_ready(const Unit&) const {}
    __device__ __forceinline__ void done(const Unit&) const {}
};

template <class Epi, class Sched, bool STAMP = false>
__device__ __forceinline__ void gemm_phase(PG8_LAS unsigned char* lds, const Gemm g, const Sched& S, const Epi& E, unsigned long long* stamps) {
    int tid_ = threadIdx.x; asm volatile("" : "+v"(tid_));
    const int tid = tid_, wid = __builtin_amdgcn_readfirstlane(tid >> 6), lane = tid & 63, wr = wid >> 2, wc = wid & 3, fr = lane & 15, fq = lane >> 4;
    const int K = g.K, nt = K / BK;
    int ts_lo = 0, ts_hi = 0, nts = 0; const unsigned long long rt_entry = STAMP ? (unsigned long long)wall_clock64() : 0ull;
#define PG8_STAMP() do { if (STAMP && wid == 0 && nts < 64) { const unsigned long long _c = (unsigned long long)clock64(); \
        ts_lo = (lane == nts) ? (int)(unsigned)_c : ts_lo; ts_hi = (lane == nts) ? (int)(unsigned)(_c >> 32) : ts_hi; ++nts; } } while (0)
    PG8_STAMP();
    unsigned voffA[2], voffB[2];
#pragma unroll
    for (int i = 0; i < 2; ++i) { int R, C; stage_rc(tid * 16 + i * 8192, R, C); const int Rb = Epi::PERM ? ((R & ~31) + perm32(R & 31)) : R;
        voffA[i] = (unsigned)(R * K + C) * 2u; voffB[i] = (unsigned)(Rb * K + C) * 2u; }
    const size_t kstep = (size_t)(BK * 2);
    const size_t hstep = (size_t)HALF * K * 2;
    const size_t tstep = 2 * hstep;
    const unsigned ldsw = (unsigned)wid * 1024u;
    const int aoff = lds_byte(wr * 64 + fr, fq * 8), boff = lds_byte(wc * 32 + fr, fq * 8);
#define PG8_SA(b, h) (((b) * 2 + (h)) * HTB)
#define PG8_SB(b, h) ((4 + (b) * 2 + (h)) * HTB)
#define PG8_STAGE(bufoff, gbase, voff) do { _Pragma("unroll") for (int _i = 0; _i < 2; ++_i) \
        __builtin_amdgcn_global_load_lds((const unsigned*)((const char*)(gbase) + (voff)[_i]), (PG8_LAS unsigned*)(lds + (bufoff) + ldsw + _i * 8192), 16, 0, 0); } while (0)
#define PG8_LDA(dst, b, h) do { _Pragma("unroll") for (int m = 0; m < 4; ++m) _Pragma("unroll") for (int k = 0; k < 2; ++k) dst[m][k] = *(const PG8_LAS bf16x8*)(lds + PG8_SA(b, h) + aoff + m * 2048 + k * 1024); } while (0)
#define PG8_LDB(dst, b, h) do { _Pragma("unroll") for (int n = 0; n < 2; ++n) _Pragma("unroll") for (int k = 0; k < 2; ++k) dst[n][k] = *(const PG8_LAS bf16x8*)(lds + PG8_SB(b, h) + boff + n * 2048 + k * 1024); } while (0)
#define PG8_MMA(ai, bj, At, Bt) do { __builtin_amdgcn_s_setprio(1); _Pragma("unroll") for (int m = 0; m < 4; ++m) _Pragma("unroll") for (int n = 0; n < 2; ++n) _Pragma("unroll") for (int k = 0; k < 2; ++k) \
        acc[ai][bj][m][n] = __builtin_amdgcn_mfma_f32_16x16x32_bf16(Bt[n][k], At[m][k], acc[ai][bj][m][n], 0, 0, 0); __builtin_amdgcn_s_setprio(0); } while (0)
#define PG8_WAIT_V(n) asm volatile("s_waitcnt vmcnt(" #n ")" ::: "memory")
#define PG8_WAIT_L(n) asm volatile("s_waitcnt lgkmcnt(" #n ")" ::: "memory")
#define PG8_BAR __builtin_amdgcn_s_barrier()
#define PG8_SCHED __builtin_amdgcn_sched_barrier(0)
    Unit cur, nxt; int ui = 0;
    if (!S.next(0, cur)) return;
    f32x4 acc[2][2][4][2];
#pragma unroll
    for (int a = 0; a < 2; ++a)
#pragma unroll
        for (int b = 0; b < 2; ++b)
#pragma unroll
            for (int m = 0; m < 4; ++m)
#pragma unroll
                for (int n = 0; n < 2; ++n) acc[a][b][m][n] = (f32x4){0.f, 0.f, 0.f, 0.f};
    bf16x8 At[4][2], B0[2][2], B1[2][2];
    const char* cA = (const char*)g.A + (size_t)cur.pm * tstep; const char* cB = (const char*)g.Bt + (size_t)cur.pn * tstep;
    S.a_ready(cur);
    PG8_STAGE(PG8_SB(0, 0), cB, voffB); PG8_STAGE(PG8_SA(0, 0), cA, voffA); PG8_STAGE(PG8_SB(0, 1), cB + hstep, voffB); PG8_STAGE(PG8_SA(0, 1), cA + hstep, voffA);
    if (wr == 1) PG8_BAR;
    PG8_WAIT_V(4); PG8_BAR;
    PG8_STAGE(PG8_SB(1, 0), cB + kstep, voffB); PG8_STAGE(PG8_SA(1, 0), cA + kstep, voffA); PG8_STAGE(PG8_SB(1, 1), cB + hstep + kstep, voffB);
    PG8_WAIT_V(6); PG8_BAR;
    PG8_STAMP();
    for (;;) {
        const bool has_next = S.next(ui + 1, nxt);
        const char* nA = has_next ? (const char*)g.A + (size_t)nxt.pm * tstep : cA; const char* nB = has_next ? (const char*)g.Bt + (size_t)nxt.pn * tstep : cB;
        for (int t = 0; t < nt; t += 2) {
            const bool last = (t == nt - 2);
            const char* a1 = cA + (size_t)(t + 1) * kstep;
            const char* a2 = last ? nA : cA + (size_t)(t + 2) * kstep; const char* b2 = last ? nB : cB + (size_t)(t + 2) * kstep;
            const char* a3 = a2 + kstep; const char* b3 = b2 + kstep;
            if (last && has_next) S.a_ready(nxt);
            PG8_LDB(B0, 0, 0); PG8_SCHED; PG8_LDA(At, 0, 0); PG8_STAGE(PG8_SA(1, 1), a1 + hstep, voffA);
            PG8_WAIT_L(8); PG8_BAR; PG8_WAIT_L(0); PG8_MMA(0, 0, At, B0); PG8_BAR; PG8_SCHED;
            PG8_LDB(B1, 0, 1); PG8_STAGE(PG8_SB(0, 0), b2, voffB);
            PG8_BAR; PG8_WAIT_L(0); PG8_MMA(0, 1, At, B1); PG8_BAR;
            PG8_LDA(At, 0, 1); PG8_STAGE(PG8_SA(0, 0), a2, voffA);
            PG8_BAR; PG8_WAIT_L(0); PG8_MMA(1, 0, At, B0); PG8_BAR; PG8_SCHED;
            PG8_STAGE(PG8_SB(0, 1), b2 + hstep, voffB);
            PG8_WAIT_V(6); PG8_BAR; PG8_MMA(1, 1, At, B1); PG8_BAR;
            PG8_LDB(B0, 1, 0); PG8_SCHED; PG8_LDA(At, 1, 0); PG8_STAGE(PG8_SA(0, 1), a2 + hstep, voffA);
            PG8_WAIT_L(8); PG8_BAR; PG8_WAIT_L(0); PG8_MMA(0, 0, At, B0); PG8_BAR; PG8_SCHED;
            PG8_LDB(B1, 1, 1); PG8_STAGE(PG8_SB(1, 0), b3, voffB);
            PG8_BAR; PG8_WAIT_L(0); PG8_MMA(0, 1, At, B1); PG8_BAR;
            PG8_LDA(At, 1, 1); PG8_STAGE(PG8_SA(1, 0), a3, voffA);
            PG8_BAR; PG8_WAIT_L(0); PG8_MMA(1, 0, At, B0); PG8_BAR; PG8_SCHED;
            PG8_STAGE(PG8_SB(1, 1), b3 + hstep, voffB);
            PG8_WAIT_V(6); PG8_BAR; PG8_MMA(1, 1, At, B1); PG8_BAR;
        }
        PG8_STAMP();
        if constexpr (!Epi::AFTER_DRAIN) { E(acc, cur, wr, wc, fr, fq); S.done(cur); }
        PG8_STAMP();
        if (!has_next) break;
#pragma unroll
        for (int a = 0; a < 2; ++a)
#pragma unroll
            for (int b = 0; b < 2; ++b)
#pragma unroll
                for (int m = 0; m < 4; ++m)
#pragma unroll
                    for (int n = 0; n < 2; ++n) acc[a][b][m][n] = (f32x4){0.f, 0.f, 0.f, 0.f};
        cur = nxt; cA = nA; cB = nB; ++ui;
    }
    PG8_WAIT_V(0);
    if (wr == 0) PG8_BAR;
    PG8_BAR;
    if constexpr (Epi::AFTER_DRAIN) { E.fused(acc, cur, wr, wc, fr, fq, lds, wid, lane); S.done(cur); }
    PG8_STAMP();
    if (STAMP && wid == 0) { stamps[lane] = lane < nts ? (((unsigned long long)(unsigned)ts_hi << 32) | (unsigned)ts_lo) : 0ull;
        if (lane == 62) stamps[62] = rt_entry; if (lane == 63) stamps[63] = (unsigned long long)wall_clock64(); }
#undef PG8_STAMP
#undef PG8_SA
#undef PG8_SB
#undef PG8_STAGE
#undef PG8_LDA
#undef PG8_LDB
#undef PG8_MMA
#undef PG8_WAIT_V
#undef PG8_WAIT_L
#undef PG8_BAR
#undef PG8_SCHED
}
}

namespace mk {
#define LAS __attribute__((address_space(3)))
typedef unsigned short bf16;
typedef float f32x4 __attribute__((ext_vector_type(4)));
typedef float f32x16 __attribute__((ext_vector_type(16)));
typedef unsigned u32x4 __attribute__((ext_vector_type(4)));
typedef unsigned u32x2 __attribute__((ext_vector_type(2)));
typedef short bf16x8 __attribute__((ext_vector_type(8)));
typedef short s16x4 __attribute__((ext_vector_type(4)));

constexpr int D = 1024, NB = 4, SEQ = 4096, CTX = 256, PWW = 3360;
constexpr int MLAT = NB * SEQ, MT = MLAT + NB * CTX;
constexpr int NT1 = 14, N1 = NT1 * 256;
constexpr int NSLOT = 11, PLW = NSLOT * 256;
constexpr int TROW = SEQ + CTX;
constexpr int O_AQ = 0, O_AK = 128, O_AV = 256, O_AG = 512, O_LR = 768, O_BV = 800, O_BG = 1056, O_CQ = 1312, O_CK = 1568, O_CV = 1696,
              O_CG = 1824, O_DQ = 2080, O_DK = 2336, O_DV = 2592, O_DG = 2848;
constexpr int S_AQK = 0, S_AV = 1, S_AG = 2, S_BG = 3, S_CQ = 4, S_CKV = 5, S_CG = 6, S_DQ = 7, S_DK = 8, S_DV = 9, S_DG = 10;
constexpr float LOG2E = 1.4426950408889634f, QSCALE = 0.125f * LOG2E, GLA_QS = 0.17677669529663687f;

constexpr size_t WS_CTL = 0, CTL_BYTES = 65536;
constexpr size_t WS_MOD = WS_CTL + CTL_BYTES;
constexpr size_t WS_ROPE = WS_MOD + 2 * 5 * 3072 * 4;
constexpr size_t WS_WC = WS_ROPE + 2 * 64 * 16 * 4;
constexpr size_t WS_CS256 = WS_WC + 128 * 128 * 2;
constexpr size_t WS_W1T = 1u << 20;
constexpr size_t WS_W2T = WS_W1T + (size_t)2 * N1 * D * 2;
constexpr size_t WS_H = WS_W2T + (size_t)2 * D * D * 2;
constexpr size_t WS_PLB = WS_H + (size_t)MT * D * 2;
constexpr size_t WS_LA = WS_PLB + (size_t)MT * PLW * 2;
constexpr size_t WS_FA2 = WS_LA + (size_t)MT * 256 * 4;
constexpr size_t WS_CTX1 = WS_FA2 + (size_t)NB * 64 * TROW * 8 * 2;
constexpr size_t WS_SCR = WS_CTX1 + (size_t)NB * CTX * D * 4;
static_assert(WS_CS256 + 256 * 512 * 2 <= WS_W1T, "tables");

__device__ __forceinline__ float bf2f(bf16 v) { return __uint_as_float(((unsigned)v) << 16); }
__device__ __forceinline__ unsigned f2bf(float f) { unsigned u = __float_as_uint(f); return (u + 0x7fffu + ((u >> 16) & 1u)) >> 16; }
typedef float f32x2_t __attribute__((ext_vector_type(2))); typedef __bf16 bf16x2_t __attribute__((ext_vector_type(2)));
__device__ __forceinline__ unsigned pk2(float lo, float hi) { const f32x2_t v = {lo, hi}; const bf16x2_t b = __builtin_convertvector(v, bf16x2_t); return __builtin_bit_cast(unsigned, b); }
__device__ __forceinline__ float wave_sum(float v) {
#pragma unroll
  for (int o = 1; o < 64; o <<= 1) v += __shfl_xor(v, o);
  return v;
}
__device__ __forceinline__ float fsilu(float x) { return x * __builtin_amdgcn_rcpf(1.f + __expf(-x)); }
__device__ __forceinline__ float flogsig(float x) { return fminf(x, 0.f) - __logf(1.f + __expf(-fabsf(x))); }

#define GAS __attribute__((address_space(1)))
template <class T> __device__ __forceinline__ T* opq(T* p) { GAS T* g = (GAS T*)p; asm volatile("" : "+s"(g)); return (T*)g; }
__device__ __forceinline__ int crow(int r, int hi) { return (r & 3) + 8 * (r >> 2) + 4 * hi; }
struct Args {
  const float* in[19]; float* out; unsigned char* ws; int ph_lo, ph_hi;
};
struct Frame {
  int tid, lane, wave, vcu, G;
  LAS unsigned char* lds;
};
__device__ __forceinline__ Frame relaunder(const Frame& F0) {
  Frame F = F0; F.tid = threadIdx.x; asm volatile("" : "+v"(F.tid)); F.lane = F.tid & 63; asm volatile("" : "+s"(F.wave), "+s"(F.vcu), "+s"(F.G)); return F; }
}

namespace mk {
__device__ __forceinline__ void p0_ada_item(const Frame& F, const Args& a, int item) {
  LAS float* s = (LAS float*)F.lds; LAS float* red = s + 5 * 1024;
  const float* c = opq(a.in[1]); const float* cc = opq(a.in[3]);
  for (int i = F.tid; i < 5 * 1024; i += 512) { const int r = i >> 10, k = i & 1023; const float v = r < 4 ? c[r * 1024 + k] : cc[k]; s[i] = v / (1.f + expf(-v)); }
  __syncthreads();
  const int kp = F.tid / 24, cl = F.tid % 24;
  const int gcol = item * 24 + cl, l = gcol / 3072, col = gcol % 3072;
  if (kp < 21) {
    const float* w = opq(a.in[5]) + (size_t)l * 1024 * 3072 + col;
    float acc[5] = {0.f, 0.f, 0.f, 0.f, 0.f};
#pragma unroll 8
    for (int k = kp; k < 1024; k += 21) { const float wv = w[(size_t)k * 3072];
#pragma unroll
      for (int r = 0; r < 5; ++r) acc[r] += s[r * 1024 + k] * wv; }
#pragma unroll
    for (int r = 0; r < 5; ++r) red[(kp * 24 + cl) * 5 + r] = acc[r];
  }
  __syncthreads();
  if (F.tid < 120) {
    const int cl2 = F.tid / 5, r = F.tid % 5; float t = 0.f;
    for (int q = 0; q < 21; ++q) t += red[(q * 24 + cl2) * 5 + r];
    const int g2 = item * 24 + cl2, l2 = g2 / 3072, col2 = g2 % 3072;
    float* MOD = (float*)(opq(a.ws) + WS_MOD);
    MOD[((size_t)l2 * 5 + r) * 3072 + col2] = t + opq(a.in[6])[l2 * 3072 + col2];
  }
  __syncthreads();
}
__device__ __forceinline__ int rope_perm(int n) { return 16 * ((n >> 2) & 1) + 4 * (n >> 3) + (n & 3); }
__device__ __forceinline__ void p0_tr_item(const float* W, int ldw, int cbase, int permkind, float scale, bf16* dst, int k0, LAS float* scr, int lane) {
  { float t_[32];
#pragma unroll
    for (int i = 0; i < 32; ++i) t_[i] = W[(size_t)(k0 + 2 * i + (lane >> 5)) * ldw + cbase + (lane & 31)];
#pragma unroll
    for (int i = 0; i < 32; ++i) scr[(2 * i + (lane >> 5)) * 33 + (lane & 31)] = t_[i]; }
  asm volatile("s_waitcnt lgkmcnt(0)" ::: "memory");
  const int c = lane & 7;
#pragma unroll
  for (int j = 0; j < 4; ++j) { const int n = (lane >> 3) + 8 * j; const int sidx = permkind ? rope_perm(n) : n; const LAS float* sp = scr + (8 * c) * 33 + sidx;
    u32x4 o; o.x = pk2(sp[0 * 33] * scale, sp[1 * 33] * scale); o.y = pk2(sp[2 * 33] * scale, sp[3 * 33] * scale); o.z = pk2(sp[4 * 33] * scale, sp[5 * 33] * scale); o.w = pk2(sp[6 * 33] * scale, sp[7 * 33] * scale);
    *(u32x4*)(dst + (size_t)n * 1024 + k0 + 8 * c) = o; }
  asm volatile("s_waitcnt lgkmcnt(0)" ::: "memory");
}
__device__ __forceinline__ void p0_la_item(const float* Win, const float* decw  , int dir, int j0, bf16* dst, int k0, LAS float* scr, int lane) {
  float dw[16];
#pragma unroll
  for (int r = 0; r < 16; ++r) dw[r] = decw[(dir * 16 + r) * 128 + j0 + (lane & 31)];
#pragma unroll 4
  for (int i = 0; i < 32; ++i) { const int kk = 2 * i + (lane >> 5); const float* wp = Win + (size_t)(k0 + kk) * PWW + O_LR + dir * 16; float acc = 0.f;
#pragma unroll
    for (int r = 0; r < 16; ++r) acc += wp[r] * dw[r];
    scr[kk * 33 + (lane & 31)] = acc; }
  asm volatile("s_waitcnt lgkmcnt(0)" ::: "memory");
  const int c = lane & 7;
#pragma unroll
  for (int j = 0; j < 4; ++j) { const int n = (lane >> 3) + 8 * j; const LAS float* sp = scr + (8 * c) * 33 + n;
    u32x4 o; o.x = pk2(sp[0 * 33], sp[1 * 33]); o.y = pk2(sp[2 * 33], sp[3 * 33]); o.z = pk2(sp[4 * 33], sp[5 * 33]); o.w = pk2(sp[6 * 33], sp[7 * 33]);
    *(u32x4*)(dst + (size_t)n * 1024 + k0 + 8 * c) = o; }
  asm volatile("s_waitcnt lgkmcnt(0)" ::: "memory");
}
constexpr int FA_AST = 528, FA_WST = 528;
__device__ __forceinline__ void p0_fa_item(const Frame& F, const Args& a, int item) {
  const int l = item >> 4, pn = 4 + ((item >> 3) & 1), g32 = item & 7, bj = g32 >> 2, wc = g32 & 3;
  LAS float* cs = (LAS float*)F.lds; LAS float* sn = cs + 64; LAS float* wfl = sn + 64;
  LAS unsigned char* Ai = F.lds + 512 + 16384;
  LAS unsigned char* Wi = F.lds + F.wave * (32 * FA_WST);
  __syncthreads();
  if (F.tid < 64) { float s_, c_; sincospif(2.f * F.tid / 64.f, &s_, &c_); cs[F.tid] = c_; sn[F.tid] = s_; }
  const float* wf = opq(a.in[12]) + (size_t)l * 256 * 256;
  const int slice0 = 32 * (pn - 4) + 16 * bj + 4 * wc;
  for (int i = F.tid; i < 1024; i += 512) { const int r = i >> 2, q = i & 3; *(LAS f32x4*)(wfl + r * 16 + 4 * q) = *(const f32x4*)(wf + (size_t)r * 256 + 4 * slice0 + 4 * q); }
  __syncthreads();
  {
    const int c = F.tid & 255, part = F.tid >> 8, g = c >> 6, jj = c & 63;
    f32x4 acc[4];
#pragma unroll
    for (int q = 0; q < 4; ++q) acc[q] = (f32x4){0.f, 0.f, 0.f, 0.f};
#pragma unroll 4
    for (int m = 0; m < 64; ++m) { const int idx = (m * jj) & 63; const float t = part ? -sn[idx] : cs[idx];
#pragma unroll
      for (int q = 0; q < 4; ++q) acc[q] += t * *(LAS const f32x4*)(wfl + (g * 64 + m) * 16 + 4 * q); }
#pragma unroll
    for (int fq = 0; fq < 4; ++fq)
#pragma unroll
      for (int j = 0; j < 4; ++j) *(LAS unsigned short*)(Ai + (8 * fq + 4 * part + j) * FA_AST + c * 2) = (unsigned short)f2bf(acc[fq][j] * 0.125f);
  }
  __syncthreads();
  const int r32 = F.lane & 31, hi = F.lane >> 5;
  bf16x8 af[16];
#pragma unroll
  for (int s = 0; s < 16; ++s) af[s] = *(LAS const bf16x8*)(Ai + r32 * FA_AST + (16 * s + 8 * hi) * 2);
  __syncthreads();
  const float* Win = opq(a.in[7]) + (size_t)l * 1024 * PWW + O_BV;
  bf16* dst = (bf16*)(opq(a.ws) + WS_W1T) + ((size_t)l * N1 + pn * 256 + 32 * g32) * 1024;
  for (int kb = 0; kb < 4; ++kb) {
    const int k0 = F.wave * 128 + kb * 32;
#pragma unroll
    for (int rh = 0; rh < 2; ++rh) { f32x4 w[16];
#pragma unroll
      for (int r = 0; r < 16; ++r) w[r] = *(const f32x4*)(Win + (size_t)(k0 + 16 * rh + r) * PWW + 4 * F.lane);
#pragma unroll
      for (int r = 0; r < 16; ++r) *(LAS u32x2*)(Wi + (16 * rh + r) * FA_WST + 8 * F.lane) = (u32x2){pk2(w[r].x, w[r].y), pk2(w[r].z, w[r].w)}; }
    asm volatile("s_waitcnt lgkmcnt(0)" ::: "memory");
    f32x16 acc;
#pragma unroll
    for (int i = 0; i < 16; ++i) acc[i] = 0.f;
#pragma unroll
    for (int s = 0; s < 16; ++s) { const bf16x8 bfr = *(LAS const bf16x8*)(Wi + r32 * FA_WST + (16 * s + 8 * hi) * 2); acc = __builtin_amdgcn_mfma_f32_32x32x16_bf16(af[s], bfr, acc, 0, 0, 0); }
#pragma unroll
    for (int r = 0; r < 16; ++r) dst[(size_t)crow(r, hi) * 1024 + k0 + r32] = (bf16)f2bf(acc[r]);
    asm volatile("s_waitcnt lgkmcnt(0)" ::: "memory");
  }
  __syncthreads();
}
__device__ __forceinline__ void p0_prologue(const Frame& F0, const Args& a) {
 {
  const Frame F = relaunder(F0);
  unsigned char* ws = opq(a.ws);
  { const int gt = F.vcu * 512 + F.tid, GT = F.G * 512;
    float* rope = (float*)(ws + WS_ROPE);
    for (int i = gt; i < 1024; i += GT) { const int pos = i >> 4, f = i & 15; const float ang = (float)pos * powf(10000.f, -(float)f / 16.f); rope[i] = cosf(ang); rope[1024 + i] = sinf(ang); }
    bf16* wc = (bf16*)(ws + WS_WC);
    for (int i = gt; i < 128 * 128; i += GT) { const int r = i >> 7, c = i & 127, rr = r & 63, cc = c & 63; float s_, c_; sincospif(2.f * (float)((rr * cc) & 63) / 64.f, &s_, &c_);
      float v; if (r < 64) v = c < 64 ? c_ : s_; else v = c < 64 ? -s_ : c_; wc[i] = (bf16)f2bf(v * 0.125f); }
    bf16* cs256 = (bf16*)(ws + WS_CS256);
    for (int i = gt; i < 256 * 512; i += GT) { const int k = i >> 9, n = i & 511, nn = n & 255; float s_, c_; sincospif(2.f * (float)((k * nn) & 255) / 256.f, &s_, &c_); cs256[i] = (bf16)f2bf((n < 256 ? c_ : s_) * 0.0625f); }
  }
  for (int it = F.vcu; it < 256 + 32; it += F.G) { if (it < 256) p0_ada_item(F, a, it); else p0_fa_item(F, a, it - 256); }
  LAS float* scr = (LAS float*)(F.lds + F.wave * 16384);
  const int gw = F.vcu * 8 + F.wave, NGW = F.G * 8;
  constexpr int I_DIR = 11 * 8 * 16, I_LA = 8 * 16, I_W2 = 32 * 16, I_L = I_DIR + I_LA + I_W2;
  for (int it = gw; it < 2 * I_L; it += NGW) {
    const int l = it / I_L; int r = it % I_L;
    const float* Win = opq(a.in[7]) + (size_t)l * 1024 * PWW;
    bf16* W1T = (bf16*)(ws + WS_W1T) + (size_t)l * N1 * 1024;
    if (r < I_DIR) {
      const int ti = r / 128, g32 = (r >> 4) & 7, kb = r & 15;
      const int pn = ti < 3 ? ti : ti + 3;
      const int bj = g32 >> 2, wc = g32 & 3, mcb = 64 * wc + 32 * bj;
      int cbase = 0, pk = 0; float sc = 1.f;
      switch (pn) {
        case 0: if (mcb < 128) { cbase = O_AQ + mcb; sc = GLA_QS; } else cbase = O_AK + mcb - 128; break;
        case 1: cbase = O_AV + mcb; break;
        case 2: cbase = O_AG + mcb; break;
        case 6: cbase = O_BG + mcb; break;
        case 7: cbase = O_CQ + mcb; pk = 1; break;
        case 8: if (wc < 2) { cbase = O_CK + mcb; pk = 1; } else cbase = O_CV + mcb - 128; break;
        case 9: cbase = O_CG + mcb; break;
        case 10: cbase = O_DQ + mcb; break;
        case 11: cbase = O_DK + mcb; break;
        case 12: cbase = O_DV + mcb; break;
        default: cbase = O_DG + mcb; break;
      }
      p0_tr_item(Win, PWW, cbase, pk, sc, W1T + (size_t)(pn * 256 + 32 * g32) * 1024, kb * 64, scr, F.lane);
    } else if (r < I_DIR + I_LA) {
      r -= I_DIR; const int g32 = r >> 4, kb = r & 15, bj = g32 >> 2, wc = g32 & 3, mcb = 64 * wc + 32 * bj;
      p0_la_item(Win, opq(a.in[9]) + (size_t)l * 2 * 16 * 128, mcb >> 7, mcb & 127, W1T + (size_t)(3 * 256 + 32 * g32) * 1024, kb * 64, scr, F.lane);
    } else {
      r -= I_DIR + I_LA; const int g = r >> 4, kb = r & 15;
      p0_tr_item(opq(a.in[8]) + (size_t)l * 1024 * 1024, 1024, 32 * g, 0, 1.f, (bf16*)(ws + WS_W2T) + ((size_t)l * 1024 + 32 * g) * 1024, kb * 64, scr, F.lane);
    }
  }
 }
}
__device__ __forceinline__ void p1_prenorm(const Frame& F0, const Args& a, int layer) {
  const Frame F = relaunder(F0);
  const float* xin = layer == 0 ? opq(a.in[0]) : opq(a.out);
  const float* cin = layer == 0 ? opq(a.in[2]) : (const float*)(opq(a.ws) + WS_CTX1);
  const float* nw = opq(a.in[4]) + layer * 1024;
  const float* MOD = (const float*)(opq(a.ws) + WS_MOD) + (size_t)layer * 5 * 3072;
  bf16* H = (bf16*)(opq(a.ws) + WS_H);
  const int gw = F.vcu * 8 + F.wave, NGW = F.G * 8;
  constexpr int RB = 3;
  f32x4 w_[4];
#pragma unroll
  for (int j = 0; j < 4; ++j) w_[j] = *(const f32x4*)(nw + 4 * F.lane + 256 * j);
  for (int row0 = gw; row0 < MT; row0 += RB * NGW) {
    f32x4 v[RB][4], sc_[RB][4], sh_[RB][4]; float ss[RB];
#pragma unroll
    for (int q = 0; q < RB; ++q) { int row = row0 + q * NGW; row = row < MT ? row : MT - 1;
      const float* src; const float* mod;
      if (row < MLAT) { src = xin + (size_t)row * 1024; mod = MOD + (size_t)(row >> 12) * 3072; }
      else { src = cin + (size_t)(row - MLAT) * 1024; mod = MOD + (size_t)4 * 3072; }
      const f32x4* xr = (const f32x4*)src + F.lane;
#pragma unroll
      for (int j = 0; j < 4; ++j) { v[q][j] = xr[64 * j]; sc_[q][j] = *(const f32x4*)(mod + 1024 + 4 * F.lane + 256 * j); sh_[q][j] = *(const f32x4*)(mod + 4 * F.lane + 256 * j); } }
    __builtin_amdgcn_sched_barrier(0);
#pragma unroll
    for (int q = 0; q < RB; ++q) { float s_ = 0.f;
#pragma unroll
      for (int j = 0; j < 4; ++j) s_ += (v[q][j].x * v[q][j].x + v[q][j].y * v[q][j].y) + (v[q][j].z * v[q][j].z + v[q][j].w * v[q][j].w);
      ss[q] = s_; }
#pragma unroll
    for (int o = 1; o < 64; o <<= 1)
#pragma unroll
      for (int q = 0; q < RB; ++q) ss[q] += __shfl_xor(ss[q], o);
#pragma unroll
    for (int q = 0; q < RB; ++q) { const int row = row0 + q * NGW; if (row >= MT) continue;
      const float rs = 1.0f / sqrtf(ss[q] * (1.f / 1024.f) + 1e-6f);
      unsigned long long* o8 = (unsigned long long*)(H + (size_t)row * 1024) + F.lane;
#pragma unroll
      for (int j = 0; j < 4; ++j) {
        const f32x4 h = v[q][j] * rs * w_[j] * (1.f + sc_[q][j]) + sh_[q][j];
        o8[64 * j] = (unsigned long long)pk2(h.x, h.y) | ((unsigned long long)pk2(h.z, h.w) << 32);
      } }
  }
}
}

namespace mk {
using pg8::Unit;
struct EpiIn {
  static constexpr bool PERM = true, AFTER_DRAIN = false;
  bf16* PLB; float* LA; bf16* FA2; const float* decb; LAS const float* rope; const float* cqn; const float* ckn; const float* dqn; const float* dkn;
  __device__ __forceinline__ void operator()(const f32x4 (&acc)[2][2][4][2], const Unit& u, int wr, int wc, int fr, int fq) const {
    const int pn = u.pn;
    const bool ctxrows = u.pm >= 64;
    int kind, slot = 0; const float* nw = nullptr; bool roped = false; float qs = 1.f;
    switch (pn) {
      case 0: kind = 0; slot = S_AQK; break;
      case 1: kind = 0; slot = S_AV; break;
      case 2: kind = 1; slot = S_AG; break;
      case 3: kind = 2; break;
      case 4: case 5: kind = 3; break;
      case 6: kind = 1; slot = S_BG; break;
      case 7: kind = 4; slot = S_CQ; nw = cqn; roped = true; qs = QSCALE; break;
      case 8: slot = S_CKV; if (wc < 2) { kind = 4; nw = ckn; roped = true; } else kind = 0; break;
      case 9: kind = 1; slot = S_CG; break;
      case 10: kind = 4; slot = S_DQ; nw = dqn; qs = QSCALE; break;
      case 11: kind = 4; slot = S_DK; nw = dkn; break;
      case 12: kind = 0; slot = S_DV; break;
      default: kind = 1; slot = S_DG; break;
    }
    const int row0 = u.pm * 256 + wr * 64 + fr;
    float w8[2][8];
    if (kind == 4) {
#pragma unroll
      for (int bj = 0; bj < 2; ++bj)
#pragma unroll
        for (int s = 0; s < 8; ++s) { const int d = roped ? (32 * bj + 16 * (s >> 2) + 4 * fq + (s & 3)) : (32 * bj + 8 * fq + s); w8[bj][s] = nw[d] * qs; }
    } else if (kind == 2) {
#pragma unroll
      for (int bj = 0; bj < 2; ++bj)
#pragma unroll
        for (int s = 0; s < 8; ++s) w8[bj][s] = decb[64 * wc + 32 * bj + 8 * fq + s];
    }
#pragma unroll
    for (int ai = 0; ai < 2; ++ai)
#pragma unroll
      for (int m = 0; m < 4; ++m) {
        const int r = row0 + ai * 128 + m * 16;
        float v[2][8];
#pragma unroll
        for (int bj = 0; bj < 2; ++bj)
#pragma unroll
          for (int n = 0; n < 2; ++n)
#pragma unroll
            for (int e = 0; e < 4; ++e) v[bj][4 * n + e] = acc[ai][bj][m][n][e];
        if (kind == 2) {
#pragma unroll
          for (int bj = 0; bj < 2; ++bj) { const int mc = 64 * wc + 32 * bj + 8 * fq; float* dp = LA + (size_t)r * 256 + mc;
            f32x4 o0, o1;
#pragma unroll
            for (int e = 0; e < 4; ++e) { o0[e] = flogsig(v[bj][e] + w8[bj][e]) * 0.0625f; o1[e] = flogsig(v[bj][4 + e] + w8[bj][4 + e]) * 0.0625f; }
            *(f32x4*)dp = o0; *(f32x4*)(dp + 4) = o1; }
        } else if (kind == 3) {
          int b, t; if (!ctxrows) { b = r >> 12; t = r & 4095; } else { const int rc = r - MLAT; b = rc >> 8; t = SEQ + (rc & 255); }
#pragma unroll
          for (int bj = 0; bj < 2; ++bj) { const int slice = 32 * (pn - 4) + 16 * bj + 4 * wc + fq;
            u32x4 o; o.x = pk2(v[bj][0], v[bj][1]); o.y = pk2(v[bj][2], v[bj][3]); o.z = pk2(v[bj][4], v[bj][5]); o.w = pk2(v[bj][6], v[bj][7]);
            *(u32x4*)(FA2 + (((size_t)b * 64 + slice) * TROW + t) * 8) = o; }
        } else {
          if (kind == 1) {
#pragma unroll
            for (int bj = 0; bj < 2; ++bj)
#pragma unroll
              for (int s = 0; s < 8; ++s) v[bj][s] = fsilu(v[bj][s]);
          } else if (kind == 4) {
            float ss = 0.f;
#pragma unroll
            for (int bj = 0; bj < 2; ++bj)
#pragma unroll
              for (int s = 0; s < 8; ++s) ss += v[bj][s] * v[bj][s];
            ss += __shfl_xor(ss, 16); ss += __shfl_xor(ss, 32);
            const float rs = 1.0f / sqrtf(ss * (1.f / 64.f) + 1e-6f);
#pragma unroll
            for (int bj = 0; bj < 2; ++bj)
#pragma unroll
              for (int s = 0; s < 8; ++s) v[bj][s] *= rs * w8[bj][s];
            if (roped && !ctxrows) {
              const int t = r & 4095;
#pragma unroll
              for (int bj = 0; bj < 2; ++bj) { const int pos = bj == 0 ? (t >> 6) : (t & 63);
                const f32x4 c4 = *(LAS const f32x4*)(rope + pos * 16 + 4 * fq), s4 = *(LAS const f32x4*)(rope + 1024 + pos * 16 + 4 * fq);
#pragma unroll
                for (int e = 0; e < 4; ++e) { const float x1 = v[bj][e], x2 = v[bj][4 + e]; v[bj][e] = x1 * c4[e] - x2 * s4[e]; v[bj][4 + e] = x2 * c4[e] + x1 * s4[e]; } }
            }
          }
#pragma unroll
          for (int bj = 0; bj < 2; ++bj) { const int mc = 64 * wc + 32 * bj + 8 * fq;
            u32x4 o; o.x = pk2(v[bj][0], v[bj][1]); o.y = pk2(v[bj][2], v[bj][3]); o.z = pk2(v[bj][4], v[bj][5]); o.w = pk2(v[bj][6], v[bj][7]);
            *(u32x4*)(PLB + (size_t)r * PLW + slot * 256 + mc) = o; }
        }
        asm volatile("" ::: "memory");
      }
  }
};
struct EpiOut {
  static constexpr bool PERM = true, AFTER_DRAIN = false;
  const float* xin; const float* cin; float* xout; float* cout; const float* MODl;
  __device__ __forceinline__ void operator()(const f32x4 (&acc)[2][2][4][2], const Unit& u, int wr, int wc, int fr_, int fq_) const {
    int fr = fr_, fq = fq_; asm volatile("" : "+v"(fr), "+v"(fq));
    const int row0 = u.pm * 256 + wr * 64 + fr, col0 = u.pn * 256 + wc * 32 + 8 * fq;
    const bool ctxrows = u.pm >= 64;
    const float* gate = MODl + (size_t)(ctxrows ? 4 : (u.pm >> 4)) * 3072 + 2048;
    f32x4 gv[2][2];
#pragma unroll
    for (int bj = 0; bj < 2; ++bj)
#pragma unroll
      for (int n = 0; n < 2; ++n) gv[bj][n] = *(const f32x4*)(gate + col0 + bj * 128 + n * 4);
#pragma unroll
    for (int ai = 0; ai < 2; ++ai)
#pragma unroll
      for (int m = 0; m < 4; ++m) {
        const int r = row0 + ai * 128 + m * 16;
        const float* sp; float* dp;
        if (!ctxrows) { sp = xin + (size_t)r * 1024 + col0; dp = xout + (size_t)r * 1024 + col0; }
        else { sp = cin + (size_t)(r - MLAT) * 1024 + col0; dp = cout + (size_t)(r - MLAT) * 1024 + col0; }
        f32x4 xv[2][2];
#pragma unroll
        for (int bj = 0; bj < 2; ++bj)
#pragma unroll
          for (int n = 0; n < 2; ++n) xv[bj][n] = *(const f32x4*)(sp + bj * 128 + n * 4);
#pragma unroll
        for (int bj = 0; bj < 2; ++bj)
#pragma unroll
          for (int n = 0; n < 2; ++n) *(f32x4*)(dp + bj * 128 + n * 4) = xv[bj][n] + gv[bj][n] * acc[ai][bj][m][n];
        asm volatile("" ::: "memory");
      }
  }
};
__device__ __forceinline__ void p2_inproj(const Frame& F, const Args& a, int layer) {
  unsigned char* ws = opq(a.ws);
  pg8::Gemm g{(const pg8::bf16_t*)(ws + WS_H), (const pg8::bf16_t*)(ws + WS_W1T) + (size_t)layer * N1 * 1024, MT, N1, 1024};
  pg8::StaticOrder S; S.init(MT, N1, F.G, (int)blockIdx.x);
  LAS float* ropeL = (LAS float*)(F.lds + pg8::STAGE_BYTES);
  { int tid = threadIdx.x; asm volatile("" : "+v"(tid)); const f32x4 t = *(const f32x4*)((const float*)(ws + WS_ROPE) + 4 * tid); *(LAS f32x4*)(ropeL + 4 * tid) = t; }
  __syncthreads();
  EpiIn E{(bf16*)(ws + WS_PLB), (float*)(ws + WS_LA), (bf16*)(ws + WS_FA2), opq(a.in[10]) + layer * 256, ropeL,
          opq(a.in[13]) + layer * 64, opq(a.in[14]) + layer * 64, opq(a.in[16]) + layer * 64, opq(a.in[17]) + layer * 64};
  pg8::gemm_phase<EpiIn, pg8::StaticOrder>(F.lds, g, S, E, nullptr);
}

__device__ __forceinline__ void ctx_out_item(const Frame& F, const Args& a, int item) {
  unsigned char* ws = opq(a.ws);
  const bf16* Yc = (const bf16*)(ws + WS_H) + (size_t)MLAT * 1024; const bf16* W2 = (const bf16*)(ws + WS_W2T);
  const int tm = item >> 4, tn = item & 15, sub = F.wave & 3, kh = F.wave >> 2, r32 = F.lane & 31, hi = F.lane >> 5;
  const int row0 = 64 * tm + 32 * (sub >> 1), col0 = 64 * tn + 32 * (sub & 1);
  const bf16* ap = Yc + (size_t)(row0 + r32) * 1024 + kh * 512 + 8 * hi;
  const bf16* bp = W2 + (size_t)(col0 + r32) * 1024 + kh * 512 + 8 * hi;
  f32x16 acc;
#pragma unroll
  for (int i = 0; i < 16; ++i) acc[i] = 0.f;
#pragma unroll 1
  for (int sb = 0; sb < 4; ++sb) {
    bf16x8 af[8], bf[8];
#pragma unroll
    for (int s = 0; s < 8; ++s) { af[s] = *(const bf16x8*)(ap + (sb * 8 + s) * 16); bf[s] = *(const bf16x8*)(bp + (sb * 8 + s) * 16); }
    __builtin_amdgcn_sched_barrier(0);
#pragma unroll
    for (int s = 0; s < 8; ++s) acc = __builtin_amdgcn_mfma_f32_32x32x16_bf16(af[s], bf[s], acc, 0, 0, 0);
  }
  LAS float* X = (LAS float*)F.lds + sub * 1024;
  __syncthreads();
  if (kh == 1) {
#pragma unroll
    for (int r = 0; r < 16; ++r) X[r * 64 + F.lane] = acc[r];
  }
  __syncthreads();
  if (kh == 0) {
    const float* cin = opq(a.in[2]); float* cout = (float*)(ws + WS_CTX1);
    const float gate = ((const float*)(ws + WS_MOD))[4 * 3072 + 2048 + col0 + r32];
    float ci[16];
#pragma unroll
    for (int r = 0; r < 16; ++r) ci[r] = cin[(size_t)(row0 + crow(r, hi)) * 1024 + col0 + r32];
    __builtin_amdgcn_sched_barrier(0);
#pragma unroll
    for (int r = 0; r < 16; ++r) { const size_t o = (size_t)(row0 + crow(r, hi)) * 1024 + col0 + r32; cout[o] = ci[r] + gate * (acc[r] + X[r * 64 + F.lane]); }
  }
}
__device__ __forceinline__ void p5_outproj(const Frame& F, const Args& a, int layer) {
  unsigned char* ws = opq(a.ws);
  const int M = MLAT;
  pg8::Gemm g{(const pg8::bf16_t*)(ws + WS_H), (const pg8::bf16_t*)(ws + WS_W2T) + (size_t)layer * 1024 * 1024, M, 1024, 1024};
  pg8::StaticOrder S; S.init(M, 1024, F.G, (int)blockIdx.x);
  EpiOut E{layer == 0 ? opq(a.in[0]) : opq(a.out), layer == 0 ? opq(a.in[2]) : (const float*)(ws + WS_CTX1), opq(a.out), (float*)(ws + WS_CTX1), (const float*)(ws + WS_MOD) + (size_t)layer * 5 * 3072};
  pg8::gemm_phase<EpiOut, pg8::StaticOrder>(F.lds, g, S, E, nullptr);
  if (layer == 0) { const Frame F2 = relaunder(F); for (int it = F2.vcu; it < 256; it += F2.G) ctx_out_item(F2, a, it); }
}
}

namespace mk {
typedef short v4i16_t __attribute__((ext_vector_type(4)));
__device__ __forceinline__ s16x4 vtr(LAS const unsigned char* p) { return __builtin_bit_cast(s16x4, __builtin_amdgcn_ds_read_tr16_b64_v4i16((LAS v4i16_t*)p)); }
struct AttnState { float m, l; f32x16 o0, o1; };
template <class MaskF>
__device__ __forceinline__ void attn_tile(AttnState& st, const bf16x8 (&qf)[4], LAS const unsigned char* Kt, LAS const unsigned char* Vt, int lane, MaskF&& maskf) {
  const int r32 = lane & 31, hi = lane >> 5;
  f32x16 p0, p1;
  const int ksw = (r32 >> 1) & 7;
  bf16x8 ka[4], kb[4];
#pragma unroll
  for (int s = 0; s < 4; ++s) { const int ch = ((2 * s + hi) ^ ksw) << 4; ka[s] = *(LAS const bf16x8*)(Kt + r32 * 128 + ch); kb[s] = *(LAS const bf16x8*)(Kt + (32 + r32) * 128 + ch); }
  { const f32x16 z = {0.f, 0.f, 0.f, 0.f, 0.f, 0.f, 0.f, 0.f, 0.f, 0.f, 0.f, 0.f, 0.f, 0.f, 0.f, 0.f};
    p0 = __builtin_amdgcn_mfma_f32_32x32x16_bf16(ka[0], qf[0], z, 0, 0, 0); p1 = __builtin_amdgcn_mfma_f32_32x32x16_bf16(kb[0], qf[0], z, 0, 0, 0); }
#pragma unroll
  for (int s = 1; s < 4; ++s) { p0 = __builtin_amdgcn_mfma_f32_32x32x16_bf16(ka[s], qf[s], p0, 0, 0, 0); p1 = __builtin_amdgcn_mfma_f32_32x32x16_bf16(kb[s], qf[s], p1, 0, 0, 0); }
  maskf(p0, p1);
  float ps = 0.f;
#pragma unroll
  for (int i = 0; i < 16; ++i) { p0[i] = __builtin_amdgcn_exp2f(p0[i]); p1[i] = __builtin_amdgcn_exp2f(p1[i]); ps += p0[i] + p1[i]; }
  st.l += ps;
  u32x4 pw[4];
#pragma unroll
  for (int k = 0; k < 2; ++k) {
    pw[k] = (u32x4){pk2(p0[8 * k + 0], p0[8 * k + 1]), pk2(p0[8 * k + 2], p0[8 * k + 3]), pk2(p0[8 * k + 4], p0[8 * k + 5]), pk2(p0[8 * k + 6], p0[8 * k + 7])};
    pw[2 + k] = (u32x4){pk2(p1[8 * k + 0], p1[8 * k + 1]), pk2(p1[8 * k + 2], p1[8 * k + 3]), pk2(p1[8 * k + 4], p1[8 * k + 5]), pk2(p1[8 * k + 6], p1[8 * k + 7])};
  }
  const int q = (lane & 15) >> 2, p = lane & 3, gsel = (lane >> 4) & 1;
  const int vrow = (4 * hi + q) * 128 + 8 * (p & 1);
  const int chb = 2 * gsel + (p >> 1);
#pragma unroll
  for (int ks = 0; ks < 4; ++ks) {
    const int c0_ = ((chb | ((0 ^ (q >> 1)) << 2)) << 4), c1_ = ((chb | ((1 ^ (q >> 1)) << 2)) << 4);
    const s16x4 l0 = vtr(Vt + ks * 2048 + vrow + c0_), h0 = vtr(Vt + ks * 2048 + 1024 + vrow + c0_), l1 = vtr(Vt + ks * 2048 + vrow + c1_), h1 = vtr(Vt + ks * 2048 + 1024 + vrow + c1_);
    const bf16x8 va0 = (bf16x8){l0[0], l0[1], l0[2], l0[3], h0[0], h0[1], h0[2], h0[3]}, va1 = (bf16x8){l1[0], l1[1], l1[2], l1[3], h1[0], h1[1], h1[2], h1[3]};
    st.o0 = __builtin_amdgcn_mfma_f32_32x32x16_bf16(va0, __builtin_bit_cast(bf16x8, pw[ks]), st.o0, 0, 0, 0);
    st.o1 = __builtin_amdgcn_mfma_f32_32x32x16_bf16(va1, __builtin_bit_cast(bf16x8, pw[ks]), st.o1, 0, 0, 0);
  }
}
__device__ __forceinline__ void attn_store(const AttnState& st, float inv, const bf16* grow  , bf16* yrow  , int lane) {
  const int hi = lane >> 5;
  u32x2 gv[8];
#pragma unroll
  for (int i = 0; i < 8; ++i) gv[i] = *(const u32x2*)(grow + 32 * (i >> 2) + 8 * (i & 3) + 4 * hi);
  __builtin_amdgcn_sched_barrier(0);
#pragma unroll
  for (int d0 = 0; d0 < 2; ++d0)
#pragma unroll
    for (int gi = 0; gi < 4; ++gi) {
      const int db = 32 * d0 + 8 * gi + 4 * hi; const u32x2 g = gv[4 * d0 + gi];
      const f32x16& o = d0 == 0 ? st.o0 : st.o1;
      const float g0 = __uint_as_float(g.x << 16), g1 = __uint_as_float(g.x & 0xffff0000u), g2 = __uint_as_float(g.y << 16), g3 = __uint_as_float(g.y & 0xffff0000u);
      u32x2 ov; ov.x = pk2(o[4 * gi + 0] * inv * g0, o[4 * gi + 1] * inv * g1); ov.y = pk2(o[4 * gi + 2] * inv * g2, o[4 * gi + 3] * inv * g3);
      *(u32x2*)(yrow + db) = ov;
    }
}
template <int NH> struct TileRegs { u32x4 k[NH], v[NH]; };
template <int NH>
__device__ __forceinline__ void tile_load(TileRegs<NH>& R, const bf16* kbase  , const bf16* vbase, int tid) {
  const int key = tid >> 3, ch = tid & 7;
#pragma unroll
  for (int h = 0; h < NH; ++h) { R.k[h] = *(const u32x4*)(kbase + (size_t)key * PLW + h * 64 + ch * 8); R.v[h] = *(const u32x4*)(vbase + (size_t)key * PLW + h * 64 + ch * 8); }
}
template <int NH>
__device__ __forceinline__ void tile_store(const TileRegs<NH>& R, LAS unsigned char* buf, int tid) {
  const int key = tid >> 3, ch = tid & 7;
  const int ko = key * 128 + ((ch ^ ((key >> 1) & 7)) << 4), vo = key * 128 + ((ch ^ (((key >> 1) & 1) << 2)) << 4);
#pragma unroll
  for (int h = 0; h < NH; ++h) { *(LAS u32x4*)(buf + h * 8192 + ko) = R.k[h]; *(LAS u32x4*)(buf + NH * 8192 + h * 8192 + vo) = R.v[h]; }
}

template <int NH> struct TileRegs2 { TileRegs<NH> a, b; };
__device__ __forceinline__ void swa_item(const Frame& F0, const Args& a, int layer, int item) {
  const Frame F = relaunder(F0);
  unsigned char* ws = opq(a.ws);
  const bf16* PLB = (const bf16*)(ws + WS_PLB); bf16* Y = (bf16*)(ws + WS_H);
  const bool isctx = item >= 256;
  int b, kvh, n;
  if (!isctx) { b = item >> 6; kvh = (item >> 5) & 1; n = item & 31; } else { const int ci = item - 256; b = ci >> 2; kvh = (ci >> 1) & 1; n = ci & 1; }
  const int g = F.wave >> 2, quarter = F.wave & 3, hq = 2 * kvh + g, r32 = F.lane & 31, hi = F.lane >> 5;
  const int tq = 128 * n + 32 * quarter + r32;
  const size_t qrow = isctx ? (size_t)MLAT + b * CTX + tq : (size_t)b * SEQ + tq;
  bf16x8 qf[4];
#pragma unroll
  for (int s = 0; s < 4; ++s) qf[s] = *(const bf16x8*)(PLB + qrow * PLW + S_CQ * 256 + hq * 64 + 16 * s + 8 * hi);
  int jlo = 0, jhi = 0;
  if (!isctx) { jlo = n == 0 ? 1 : 0; jhi = n == 31 ? 2 : 3; }
  const int nloc = jhi - jlo, T = nloc + 2;
  const bf16* kcol = PLB + S_CKV * 256 + kvh * 64;
  auto tile_row = [&](int t) -> size_t { return t < nloc ? (size_t)b * SEQ + 128 * (n - 1 + jlo + t) : (size_t)MLAT + b * CTX + 128 * (t - nloc); };
  AttnState st; st.m = 0.f; st.l = 0.f;
#pragma unroll
  for (int i = 0; i < 16; ++i) { st.o0[i] = 0.f; st.o1[i] = 0.f; }
  TileRegs2<1> R;
  __syncthreads();
  { const size_t r0 = tile_row(0); tile_load<1>(R.a, kcol + r0 * PLW, kcol + 128 + r0 * PLW, F.tid); tile_load<1>(R.b, kcol + (r0 + 64) * PLW, kcol + 128 + (r0 + 64) * PLW, F.tid); }
  tile_store<1>(R.a, F.lds, F.tid); tile_store<1>(R.b, F.lds + 16384, F.tid);
  __syncthreads();
  for (int t = 0; t < T; ++t) {
    if (t + 1 < T) { const size_t r0 = tile_row(t + 1); tile_load<1>(R.a, kcol + r0 * PLW, kcol + 128 + r0 * PLW, F.tid); tile_load<1>(R.b, kcol + (r0 + 64) * PLW, kcol + 128 + (r0 + 64) * PLW, F.tid); }
    LAS const unsigned char* buf = F.lds + (t & 1) * 32768;
#pragma unroll
    for (int hf = 0; hf < 2; ++hf) {
      LAS const unsigned char* hb = buf + hf * 16384;
      if (t < nloc) {
        const int kb = 128 * (n - 1 + jlo + t) + 64 * hf, q0 = 128 * n + 32 * quarter;
        if (!(kb + 63 < q0 - 128 || kb > q0 + 31 + 128)) {
          const int dq = kb - tq;
          if (kb >= q0 + 31 - 128 && kb + 63 <= q0 + 128) attn_tile(st, qf, hb, hb + 8192, F.lane, [](f32x16&, f32x16&) {});
          else attn_tile(st, qf, hb, hb + 8192, F.lane, [&](f32x16& p0, f32x16& p1) {
#pragma unroll
            for (int r = 0; r < 16; ++r) { const int d0_ = dq + 128 + crow(r, hi), d1_ = d0_ + 32;
              p0[r] = ((unsigned)d0_ <= 256u) ? p0[r] : -INFINITY; p1[r] = ((unsigned)d1_ <= 256u) ? p1[r] : -INFINITY; } });
        }
      } else attn_tile(st, qf, hb, hb + 8192, F.lane, [](f32x16&, f32x16&) {});
    }
    if (t + 1 < T) { tile_store<1>(R.a, F.lds + ((t + 1) & 1) * 32768, F.tid); tile_store<1>(R.b, F.lds + ((t + 1) & 1) * 32768 + 16384, F.tid); }
    __syncthreads();
  }
  float l = st.l + __shfl_xor(st.l, 32);
  const float sk2 = opq(a.in[15])[layer * 4 + hq] * LOG2E;
  const float mnew = fmaxf(st.m, sk2), al = __builtin_amdgcn_exp2f(st.m - mnew);
  l = l * al + __builtin_amdgcn_exp2f(sk2 - mnew);
  int qr = (int)qrow; asm volatile("" : "+v"(qr));
  attn_store(st, al / l, PLB + (size_t)qr * PLW + S_CG * 256 + hq * 64, Y + (size_t)qr * 1024 + 512 + hq * 64, F.lane);
}
__device__ __forceinline__ void na_item(const Frame& F0, const Args& a, int layer, int item) {
  const Frame F = relaunder(F0);
  unsigned char* ws = opq(a.ws);
  const bf16* PLB = (const bf16*)(ws + WS_PLB); bf16* Y = (bf16*)(ws + WS_H);
  const bool isctx = item >= 256;
  int b, r;
  if (!isctx) { b = item >> 6; r = item & 63; } else { const int ci = item - 256; b = ci >> 2; r = ci & 3; }
  const int head = F.wave >> 1, half = F.wave & 1, r32 = F.lane & 31, hi = F.lane >> 5;
  const int qc = 32 * half + r32;
  const size_t qrow = isctx ? (size_t)MLAT + b * CTX + 64 * r + qc : (size_t)b * SEQ + 64 * r + qc;
  bf16x8 qf[4];
#pragma unroll
  for (int s = 0; s < 4; ++s) qf[s] = *(const bf16x8*)(PLB + qrow * PLW + S_DQ * 256 + head * 64 + 16 * s + 8 * hi);
  int rs = r - 4; rs = rs < 0 ? 0 : (rs > 56 ? 56 : rs);
  const int nloc = isctx ? 0 : 8, T = nloc + 4;
  auto tile_row = [&](int t) -> size_t { return t < nloc ? (size_t)b * SEQ + 64 * (rs + t) : (size_t)MLAT + b * CTX + 64 * (t - nloc); };
  const bf16* kcol = PLB + S_DK * 256; const bf16* vcol = PLB + S_DV * 256;
  LAS float* btab = (LAS float*)(F.lds + 2 * 65536);
  AttnState st; st.m = 0.f; st.l = 0.f;
#pragma unroll
  for (int i = 0; i < 16; ++i) { st.o0[i] = 0.f; st.o1[i] = 0.f; }
  TileRegs<4> R;
  __syncthreads();
  {
    const float* rb = opq(a.in[18]) + (size_t)layer * 4 * 15 * 31; float t_[15];
#pragma unroll
    for (int i = 0; i < 15; ++i) { const int ix = F.tid + 512 * i, hd = ix >> 7, dx = (ix & 127) - 63; const bool ok = dx >= -15 && dx <= 15; t_[i] = ok ? rb[hd * 31 + dx + 15] : 0.f; }
#pragma unroll
    for (int i = 0; i < 15; ++i) btab[F.tid + 512 * i] = t_[i] * LOG2E; }
  tile_load<4>(R, kcol + tile_row(0) * PLW, vcol + tile_row(0) * PLW, F.tid);
  tile_store<4>(R, F.lds, F.tid);
  __syncthreads();
  int c0 = qc - 8; c0 = c0 < 0 ? 0 : (c0 > 48 ? 48 : c0);
  for (int t = 0; t < T; ++t) {
    if (t + 1 < T) tile_load<4>(R, kcol + tile_row(t + 1) * PLW, vcol + tile_row(t + 1) * PLW, F.tid);
    LAS const unsigned char* buf = F.lds + (t & 1) * 65536;
    if (t < nloc) {
      const int dy = rs + t - r + 7;
      int c0l = c0; asm volatile("" : "+v"(c0l));
      LAS const float* bt = btab + (head * 15 + dy) * 128 + 63 - qc + 4 * hi;
      attn_tile(st, qf, buf + head * 8192, buf + 32768 + head * 8192, F.lane, [&](f32x16& p0, f32x16& p1) {
        float bb[16];
#pragma unroll
        for (int rr = 0; rr < 16; ++rr) bb[rr] = bt[(rr & 3) + 8 * (rr >> 2)];
#pragma unroll
        for (int rr = 0; rr < 16; ++rr) p0[rr] = ((unsigned)((rr & 3) + 8 * (rr >> 2) + 4 * hi - c0l) < 16u) ? p0[rr] + bb[rr] : -INFINITY;
#pragma unroll
        for (int rr = 0; rr < 16; ++rr) bb[rr] = bt[(rr & 3) + 8 * (rr >> 2) + 32];
#pragma unroll
        for (int rr = 0; rr < 16; ++rr) p1[rr] = ((unsigned)((rr & 3) + 8 * (rr >> 2) + 32 + 4 * hi - c0l) < 16u) ? p1[rr] + bb[rr] : -INFINITY; });
    } else attn_tile(st, qf, buf + head * 8192, buf + 32768 + head * 8192, F.lane, [](f32x16&, f32x16&) {});
    if (t + 1 < T) tile_store<4>(R, F.lds + ((t + 1) & 1) * 65536, F.tid);
    __syncthreads();
  }
  const float l = st.l + __shfl_xor(st.l, 32);
  int qr = (int)qrow; asm volatile("" : "+v"(qr));
  attn_store(st, 1.f / l, PLB + (size_t)qr * PLW + S_DG * 256 + head * 64, Y + (size_t)qr * 1024 + 768 + head * 64, F.lane);
}
}

namespace mk {
constexpr int XT_STRIDE = 272;
constexpr int FFT_WC = 256 * XT_STRIDE;
__device__ __forceinline__ void fft_item(const Frame& F0, const Args& a, int item) {
  const Frame F = relaunder(F0);
  unsigned char* ws = opq(a.ws);
  const bf16* PLB = (const bf16*)(ws + WS_PLB); bf16* Y = (bf16*)(ws + WS_H);
  const int b = item >> 6, slice = item & 63, r32 = F.lane & 31, hi = F.lane >> 5, w = F.wave;
  LAS unsigned char* Xt = F.lds; LAS unsigned char* Wl = F.lds + FFT_WC;
  __syncthreads();
  {
    const bf16* WC = (const bf16*)(ws + WS_WC);
    u32x4 wt[4];
#pragma unroll
    for (int i = 0; i < 4; ++i) { const int idx = F.tid + 512 * i, row = idx >> 4, ch = idx & 15; wt[i] = *(const u32x4*)(WC + row * 128 + ch * 8); }
    const bf16* src = (const bf16*)(ws + WS_FA2) + ((size_t)b * 64 + slice) * TROW * 8;
    u32x4 v[8];
#pragma unroll
    for (int i = 0; i < 8; ++i) v[i] = *(const u32x4*)(src + (size_t)(F.tid + 512 * i) * 8);
    __builtin_amdgcn_sched_barrier(0);
#pragma unroll
    for (int i = 0; i < 4; ++i) { const int idx = F.tid + 512 * i, row = idx >> 4, ch = idx & 15; *(LAS u32x4*)(Wl + row * XT_STRIDE + ch * 16) = wt[i]; }
#pragma unroll
    for (int i = 0; i < 8; ++i) { const int t = F.tid + 512 * i, n1 = t >> 6, n2 = t & 63;
      const unsigned vv[4] = {v[i].x, v[i].y, v[i].z, v[i].w};
#pragma unroll
      for (int j = 0; j < 8; ++j) { const int c = j & 3, part = j >> 2; const unsigned short e = (unsigned short)((j & 1) ? (vv[j >> 1] >> 16) : (vv[j >> 1] & 0xffffu));
        *(LAS unsigned short*)(Xt + (n2 * 4 + c) * XT_STRIDE + (part * 64 + n1) * 2) = e; } }
  }
  __syncthreads();
  f32x16 acc[4];
#pragma unroll
  for (int rb = 0; rb < 4; ++rb)
#pragma unroll
    for (int i = 0; i < 16; ++i) acc[rb][i] = 0.f;
  {
    bf16x8 bf[8];
#pragma unroll
    for (int s = 0; s < 8; ++s) bf[s] = *(LAS const bf16x8*)(Xt + (32 * w + r32) * XT_STRIDE + (16 * s + 8 * hi) * 2);
#pragma unroll
    for (int rb = 0; rb < 4; ++rb)
#pragma unroll
      for (int s = 0; s < 8; ++s) { const bf16x8 af = *(LAS const bf16x8*)(Wl + (32 * rb + r32) * XT_STRIDE + (16 * s + 8 * hi) * 2); acc[rb] = __builtin_amdgcn_mfma_f32_32x32x16_bf16(af, bf[s], acc[rb], 0, 0, 0); }
  }
  __syncthreads();
  {
    const int n2 = 8 * w + (r32 >> 2), c = r32 & 3;
#pragma unroll
    for (int rbp = 0; rbp < 2; ++rbp)
#pragma unroll
      for (int r = 0; r < 16; ++r) { const int k1 = 32 * rbp + crow(r, hi); float x = (float)((k1 * n2) & 4095) * (1.f / 4096.f);
        asm volatile("" : "+v"(x) :: "memory");
        const float tc = __builtin_amdgcn_cosf(x), ts = __builtin_amdgcn_sinf(x);
        const float yr = acc[rbp][r], yi = acc[rbp + 2][r];
        const float zr = yr * tc + yi * ts, zi = yi * tc - yr * ts;
        LAS unsigned char* zp = Xt + (k1 * 4 + c) * XT_STRIDE + n2 * 2;
        *(LAS unsigned short*)zp = (unsigned short)f2bf(zr); *(LAS unsigned short*)(zp + 128) = (unsigned short)f2bf(zi); }
  }
  __syncthreads();
  f32x16 o2[2];
#pragma unroll
  for (int rb = 0; rb < 2; ++rb)
#pragma unroll
    for (int i = 0; i < 16; ++i) o2[rb][i] = 0.f;
  {
    bf16x8 bf[8];
#pragma unroll
    for (int s = 0; s < 8; ++s) bf[s] = *(LAS const bf16x8*)(Xt + (32 * w + r32) * XT_STRIDE + (16 * s + 8 * hi) * 2);
#pragma unroll
    for (int rb = 0; rb < 2; ++rb)
#pragma unroll
      for (int s = 0; s < 8; ++s) { const bf16x8 af = *(LAS const bf16x8*)(Wl + (32 * rb + r32) * XT_STRIDE + (16 * s + 8 * hi) * 2); o2[rb] = __builtin_amdgcn_mfma_f32_32x32x16_bf16(af, bf[s], o2[rb], 0, 0, 0); }
  }
  __syncthreads();
  { const int k1 = 8 * w + (r32 >> 2), c = r32 & 3;
#pragma unroll
    for (int rb = 0; rb < 2; ++rb)
#pragma unroll
      for (int r = 0; r < 16; ++r) { const int k = k1 + 64 * (32 * rb + crow(r, hi)); *(LAS unsigned short*)(Xt + k * 8 + c * 2) = (unsigned short)f2bf(o2[rb][r]); }
  }
  __syncthreads();
  { const int o0 = 4 * slice; u32x2 gv[8];
#pragma unroll
    for (int i = 0; i < 8; ++i) gv[i] = *(const u32x2*)(PLB + ((size_t)b * SEQ + F.tid + 512 * i) * PLW + S_BG * 256 + o0);
    __builtin_amdgcn_sched_barrier(0);
#pragma unroll
    for (int i = 0; i < 8; ++i) { const int k = F.tid + 512 * i; const size_t row = (size_t)b * SEQ + k;
      const u32x2 ov = *(LAS const u32x2*)(Xt + k * 8);
      u32x2 y; y.x = pk2(__uint_as_float(ov.x << 16) * __uint_as_float(gv[i].x << 16), __uint_as_float(ov.x & 0xffff0000u) * __uint_as_float(gv[i].x & 0xffff0000u));
      y.y = pk2(__uint_as_float(ov.y << 16) * __uint_as_float(gv[i].y << 16), __uint_as_float(ov.y & 0xffff0000u) * __uint_as_float(gv[i].y & 0xffff0000u));
      *(u32x2*)(Y + row * 1024 + 256 + o0) = y; }
  }
}
constexpr int XC_STRIDE = 1040;
__device__ __forceinline__ void fftc_item(const Frame& F0, const Args& a, int item) {
  const Frame F = relaunder(F0);
  unsigned char* ws = opq(a.ws);
  const bf16* PLB = (const bf16*)(ws + WS_PLB); bf16* Y = (bf16*)(ws + WS_H);
  const bf16* CS = (const bf16*)(ws + WS_CS256);
  const int b = item >> 3, cs = item & 7, r32 = F.lane & 31, hi = F.lane >> 5, w = F.wave;
  LAS unsigned char* Xc = F.lds;
  __syncthreads();
  u32x4 vq[4];
#pragma unroll
  for (int i = 0; i < 4; ++i) { const int idx = F.tid + 512 * i, sl = idx >> 8, n = idx & 255;
    vq[i] = *(const u32x4*)((const bf16*)(ws + WS_FA2) + (((size_t)b * 64 + 8 * cs + sl) * TROW + SEQ + n) * 8); }
  __builtin_amdgcn_sched_barrier(0);
#pragma unroll
  for (int i = 0; i < 4; ++i) { const int idx = F.tid + 512 * i, sl = idx >> 8, n = idx & 255;
    const unsigned vv[4] = {vq[i].x, vq[i].y, vq[i].z, vq[i].w};
#pragma unroll
    for (int j = 0; j < 8; ++j) { const int c = j & 3, part = j >> 2; const unsigned short e = (unsigned short)((j & 1) ? (vv[j >> 1] >> 16) : (vv[j >> 1] & 0xffffu));
      *(LAS unsigned short*)(Xc + (4 * sl + c) * XC_STRIDE + (part * 256 + n) * 2) = e; } }
  __syncthreads();
  f32x16 acc;
#pragma unroll
  for (int i = 0; i < 16; ++i) acc[i] = 0.f;
#pragma unroll 8
  for (int s = 0; s < 32; ++s) {
    const bf16x8 af = *(const bf16x8*)(CS + (size_t)(32 * w + r32) * 512 + 16 * s + 8 * hi);
    const bf16x8 bf = *(LAS const bf16x8*)(Xc + r32 * XC_STRIDE + (16 * s + 8 * hi) * 2);
    acc = __builtin_amdgcn_mfma_f32_32x32x16_bf16(af, bf, acc, 0, 0, 0);
  }
  const int o = 32 * cs + r32;
#pragma unroll
  for (int r = 0; r < 16; ++r) { const size_t row = (size_t)MLAT + b * CTX + 32 * w + crow(r, hi);
    Y[row * 1024 + 256 + o] = (bf16)f2bf(acc[r] * bf2f(PLB[row * PLW + S_BG * 256 + o])); }
}
}

namespace mk {
constexpr int GU_STRIDE = 2048 + 64;
constexpr size_t WS_GU = WS_SCR, WS_GS = WS_GU + (size_t)32 * 68 * GU_STRIDE * 4;
__device__ __forceinline__ size_t gla_row(int b, int c, int i) { return c < 64 ? (size_t)b * SEQ + 64 * c + i : (size_t)MLAT + b * CTX + 64 * (c - 64) + i; }
__device__ __forceinline__ int gla_pos(int c, int dir) { return c < 64 ? (dir ? 4 + 63 - c : 4 + c) : (dir ? 3 - (c - 64) : (c - 64)); }
__device__ __forceinline__ void gla_stage_v(const Frame& F, const bf16* PLB, int b, int c, LAS unsigned char* vbase) {
  const int key = F.tid >> 3, ch = F.tid & 7;
  const bf16* src = PLB + gla_row(b, c, key) * PLW + S_AV * 256 + ch * 8;
  const int vo = key * 128 + ((ch ^ (((key >> 1) & 1) << 2)) << 4);
  u32x4 t_[4];
#pragma unroll
  for (int h = 0; h < 4; ++h) t_[h] = *(const u32x4*)(src + h * 64);
#pragma unroll
  for (int h = 0; h < 4; ++h) *(LAS u32x4*)(vbase + h * 8192 + vo) = t_[h];
}
__device__ __forceinline__ void gla_cum(const float* LA, int b, int c, int h, int dir, int lane, float (&cw)[32], float& T) {
  const int d = lane & 31, half = lane >> 5;
  float a[32];
#pragma unroll
  for (int ii = 0; ii < 32; ++ii) a[ii] = LA[gla_row(b, c, 32 * half + ii) * 256 + dir * 128 + h * 32 + d];
  float run = 0.f;
#pragma unroll
  for (int ii = 0; ii < 32; ++ii) { run += a[ii]; cw[ii] = run; }
  const float other = __shfl_xor(run, 32);
  const float tot0 = half ? other : run;
  T = run + other;
#pragma unroll
  for (int ii = 0; ii < 32; ++ii) { const float cf = cw[ii] + (half ? tot0 : 0.f); cw[ii] = dir ? (T - cf + a[ii]) : cf; }
}
constexpr int KT_STRIDE = 144;
__device__ __forceinline__ void gla_local_item(const Frame& F0, const Args& a, int item) {
  const Frame F = relaunder(F0);
  unsigned char* ws = opq(a.ws);
  const bf16* PLB = (const bf16*)(ws + WS_PLB); const float* LA = (const float*)(ws + WS_LA);
  const int b = item / 68, c = item % 68, h = F.wave >> 1, dir = F.wave & 1, d = F.lane & 31, half = F.lane >> 5, r32 = d, hi = half;
  LAS unsigned char* Vt = F.lds + h * 8192; LAS unsigned char* KT = F.lds + 32768 + F.wave * (32 * KT_STRIDE);
  __syncthreads();
  gla_stage_v(F, PLB, b, c, F.lds);
  float cw[32], T;
  gla_cum(LA, b, c, h, dir, F.lane, cw, T);
  {
    unsigned pkd[16]; bf16 kr[32];
    const bf16* kp = PLB + gla_row(b, c, 32 * half) * PLW + S_AQK * 256 + 128 + h * 32 + d;
#pragma unroll
    for (int ii = 0; ii < 32; ++ii) kr[ii] = kp[(size_t)ii * PLW];
#pragma unroll
    for (int ii = 0; ii < 32; ii += 2) pkd[ii >> 1] = pk2(bf2f(kr[ii]) * __expf(T - cw[ii]), bf2f(kr[ii + 1]) * __expf(T - cw[ii + 1]));
#pragma unroll
    for (int q4 = 0; q4 < 4; ++q4) *(LAS u32x4*)(KT + d * KT_STRIDE + half * 64 + q4 * 16) = (u32x4){pkd[4 * q4], pkd[4 * q4 + 1], pkd[4 * q4 + 2], pkd[4 * q4 + 3]};
  }
  __syncthreads();
  f32x16 acc[2];
#pragma unroll
  for (int eb = 0; eb < 2; ++eb)
#pragma unroll
    for (int i = 0; i < 16; ++i) acc[eb][i] = 0.f;
  const int q = (F.lane & 15) >> 2, p = F.lane & 3, gsel = (F.lane >> 4) & 1;
  const int chb = 2 * gsel + (p >> 1);
#pragma unroll
  for (int st = 0; st < 4; ++st) {
    const bf16x8 kb = *(LAS const bf16x8*)(KT + r32 * KT_STRIDE + (16 * st + 8 * hi) * 2);
#pragma unroll
    for (int eb = 0; eb < 2; ++eb) {
      const int ch = ((chb | ((eb ^ (q >> 1)) << 2)) << 4);
      LAS const unsigned char* vp = Vt + (16 * st + 8 * hi + q) * 128 + 8 * (p & 1) + ch;
      const s16x4 lo = vtr(vp), hh = vtr(vp + 512);
      const bf16x8 va = (bf16x8){lo[0], lo[1], lo[2], lo[3], hh[0], hh[1], hh[2], hh[3]};
      acc[eb] = __builtin_amdgcn_mfma_f32_32x32x16_bf16(va, kb, acc[eb], 0, 0, 0);
    }
  }
  const int chain = (b * 4 + h) * 2 + dir, pos = gla_pos(c, dir);
  float* gu = (float*)(ws + WS_GU) + ((size_t)chain * 68 + pos) * GU_STRIDE;
#pragma unroll
  for (int eb = 0; eb < 2; ++eb)
#pragma unroll
    for (int r = 0; r < 16; ++r) gu[(32 * eb + crow(r, hi)) * 32 + r32] = acc[eb][r];
  if (half == 0) gu[2048 + d] = __expf(T);
}
__device__ __forceinline__ void gla_scan(const Frame& F0, const Args& a) {
  const Frame F = relaunder(F0);
  unsigned char* ws = opq(a.ws);
  const int gt = F.vcu * 512 + F.tid;
  if (gt >= 32 * 2048) return;
  const int chain = gt >> 11, el = gt & 2047, d = el & 31;
  const float* gu = (const float*)(ws + WS_GU) + (size_t)chain * 68 * GU_STRIDE;
  bf16* gs = (bf16*)(ws + WS_GS) + (size_t)chain * 68 * 2048 + el;
  float S = 0.f;
#pragma unroll 34
  for (int pos = 0; pos < 68; ++pos) { gs[(size_t)pos * 2048] = (bf16)f2bf(S); S = gu[(size_t)pos * GU_STRIDE + 2048 + d] * S + gu[(size_t)pos * GU_STRIDE + el]; }
}
constexpr int QK_STRIDE = 80;
__device__ __forceinline__ void gla_out_item(const Frame& F0, const Args& a, int layer, int item) {
  const Frame F = relaunder(F0);
  unsigned char* ws = opq(a.ws);
  const bf16* PLB = (const bf16*)(ws + WS_PLB); const float* LA = (const float*)(ws + WS_LA); bf16* Y = (bf16*)(ws + WS_H);
  const int b = item / 68, c = item % 68, h = F.wave >> 1, dir = F.wave & 1, d = F.lane & 31, half = F.lane >> 5, r32 = d, hi = half;
  LAS unsigned char* Vt = F.lds + h * 8192;
  LAS unsigned char* QT = F.lds + 32768 + F.wave * (2 * 64 * QK_STRIDE); LAS unsigned char* KT = QT + 64 * QK_STRIDE;
  LAS float* X = (LAS float*)(F.lds + 32768) + h * 4096;
  __syncthreads();
  gla_stage_v(F, PLB, b, c, F.lds);
  {
    float cw[32], T;
    gla_cum(LA, b, c, h, dir, F.lane, cw, T);
    bf16 qr[32], kr[32];
    const bf16* pr = PLB + gla_row(b, c, 32 * half) * PLW + S_AQK * 256 + h * 32 + d;
#pragma unroll
    for (int ii = 0; ii < 32; ++ii) { qr[ii] = pr[(size_t)ii * PLW]; kr[ii] = pr[(size_t)ii * PLW + 128]; }
#pragma unroll
    for (int ii = 0; ii < 32; ++ii) { const int i = 32 * half + ii;
      const float ec = __expf(cw[ii]);
      *(LAS unsigned short*)(QT + i * QK_STRIDE + d * 2) = (unsigned short)f2bf(bf2f(qr[ii]) * ec);
      *(LAS unsigned short*)(KT + i * QK_STRIDE + d * 2) = (unsigned short)f2bf(bf2f(kr[ii]) * __builtin_amdgcn_rcpf(ec)); }
  }
  __syncthreads();
  f32x16 oacc[2][2];
#pragma unroll
  for (int eb = 0; eb < 2; ++eb)
#pragma unroll
    for (int ib = 0; ib < 2; ++ib)
#pragma unroll
      for (int i = 0; i < 16; ++i) oacc[eb][ib][i] = 0.f;
  bf16x8 qb[2][2];
#pragma unroll
  for (int ib = 0; ib < 2; ++ib)
#pragma unroll
    for (int st = 0; st < 2; ++st) qb[ib][st] = *(LAS const bf16x8*)(QT + (32 * ib + r32) * QK_STRIDE + (16 * st + 8 * hi) * 2);
  const int chain = (b * 4 + h) * 2 + dir, pos = gla_pos(c, dir);
  {
    const bf16* gs = (const bf16*)(ws + WS_GS) + ((size_t)chain * 68 + pos) * 2048;
#pragma unroll
    for (int eb = 0; eb < 2; ++eb)
#pragma unroll
      for (int st = 0; st < 2; ++st) { const bf16x8 sf = *(const bf16x8*)(gs + (32 * eb + r32) * 32 + 16 * st + 8 * hi);
#pragma unroll
        for (int ib = 0; ib < 2; ++ib) oacc[eb][ib] = __builtin_amdgcn_mfma_f32_32x32x16_bf16(sf, qb[ib][st], oacc[eb][ib], 0, 0, 0); }
  }
  const int q = (F.lane & 15) >> 2, p = F.lane & 3, gsel = (F.lane >> 4) & 1;
  const int vrow = (4 * hi + q) * 128 + 8 * (p & 1), chb = 2 * gsel + (p >> 1);
#pragma unroll
  for (int sb = 0; sb < 2; ++sb) {
    bf16x8 kf[2];
#pragma unroll
    for (int st = 0; st < 2; ++st) kf[st] = *(LAS const bf16x8*)(KT + (32 * sb + r32) * QK_STRIDE + (16 * st + 8 * hi) * 2);
#pragma unroll
    for (int ib = 0; ib < 2; ++ib) {
      const bool need = dir == 0 ? (sb <= ib) : (sb >= ib);
      if (!need) continue;
      f32x16 sc;
#pragma unroll
      for (int i = 0; i < 16; ++i) sc[i] = 0.f;
#pragma unroll
      for (int st = 0; st < 2; ++st) sc = __builtin_amdgcn_mfma_f32_32x32x16_bf16(kf[st], qb[ib][st], sc, 0, 0, 0);
      if (sb == ib) {
#pragma unroll
        for (int r = 0; r < 16; ++r) { const int s = crow(r, hi); const bool keep = dir == 0 ? (s <= r32) : (s >= r32); sc[r] = keep ? sc[r] : 0.f; }
      }
      u32x4 pw[2];
#pragma unroll
      for (int k = 0; k < 2; ++k) pw[k] = (u32x4){pk2(sc[8 * k + 0], sc[8 * k + 1]), pk2(sc[8 * k + 2], sc[8 * k + 3]), pk2(sc[8 * k + 4], sc[8 * k + 5]), pk2(sc[8 * k + 6], sc[8 * k + 7])};
#pragma unroll
      for (int ks = 0; ks < 2; ++ks)
#pragma unroll
        for (int eb = 0; eb < 2; ++eb) {
          const int ch = ((chb | ((eb ^ (q >> 1)) << 2)) << 4);
          const s16x4 lo = vtr(Vt + (2 * sb + ks) * 2048 + vrow + ch), hh = vtr(Vt + (2 * sb + ks) * 2048 + 1024 + vrow + ch);
          const bf16x8 va = (bf16x8){lo[0], lo[1], lo[2], lo[3], hh[0], hh[1], hh[2], hh[3]};
          oacc[eb][ib] = __builtin_amdgcn_mfma_f32_32x32x16_bf16(va, __builtin_bit_cast(bf16x8, pw[ks]), oacc[eb][ib], 0, 0, 0);
        }
    }
  }
  __syncthreads();
  if (dir == 1) {
#pragma unroll
    for (int eb = 0; eb < 2; ++eb)
#pragma unroll
      for (int ib = 0; ib < 2; ++ib)
#pragma unroll
        for (int r = 0; r < 16; ++r) X[((eb * 2 + ib) * 16 + r) * 64 + F.lane] = oacc[eb][ib][r];
  }
  __syncthreads();
  if (dir == 0) {
    const float* on = opq(a.in[11]) + layer * 64;
#pragma unroll
    for (int ib = 0; ib < 2; ++ib) {
      float ss = 0.f;
#pragma unroll
      for (int eb = 0; eb < 2; ++eb)
#pragma unroll
        for (int r = 0; r < 16; ++r) { oacc[eb][ib][r] += X[((eb * 2 + ib) * 16 + r) * 64 + F.lane]; ss += oacc[eb][ib][r] * oacc[eb][ib][r]; }
      ss += __shfl_xor(ss, 32);
      const float rs = 1.0f / sqrtf(ss * (1.f / 64.f) + 1e-6f);
      const size_t row = gla_row(b, c, 32 * ib + r32);
      u32x2 gv8[8];
#pragma unroll
      for (int i = 0; i < 8; ++i) gv8[i] = *(const u32x2*)(PLB + row * PLW + S_AG * 256 + h * 64 + 32 * (i >> 2) + 8 * (i & 3) + 4 * hi);
      __builtin_amdgcn_sched_barrier(0);
#pragma unroll
      for (int eb = 0; eb < 2; ++eb)
#pragma unroll
        for (int gi = 0; gi < 4; ++gi) {
          const int e0 = 32 * eb + 8 * gi + 4 * hi;
          const f32x4 w4 = *(const f32x4*)(on + e0);
          const u32x2 gv = gv8[4 * eb + gi];
          const float g0 = __uint_as_float(gv.x << 16), g1 = __uint_as_float(gv.x & 0xffff0000u), g2 = __uint_as_float(gv.y << 16), g3 = __uint_as_float(gv.y & 0xffff0000u);
          u32x2 ov; ov.x = pk2(oacc[eb][ib][4 * gi + 0] * rs * w4[0] * g0, oacc[eb][ib][4 * gi + 1] * rs * w4[1] * g1);
          ov.y = pk2(oacc[eb][ib][4 * gi + 2] * rs * w4[2] * g2, oacc[eb][ib][4 * gi + 3] * rs * w4[3] * g3);
          *(u32x2*)(Y + row * 1024 + h * 64 + e0) = ov;
        }
    }
  }
}
}

namespace mk {
__device__ __forceinline__ void p3_mixers(const Frame& F0, const Args& a, int layer) {
  const Frame F = relaunder(F0);
  const int nx = layer == 0 ? 16 : 0, nswa = 256 + nx, nna = 256 + nx, nfc = layer == 0 ? 32 : 0;
  for (int it = F.vcu; it < 272 + 256 + nfc + nswa + nna; it += F.G) {
    int r = it;
    if (r < 272) { gla_local_item(F, a, r); continue; } r -= 272;
    if (r < 256) { fft_item(F, a, r); continue; } r -= 256;
    if (r < nfc) { fftc_item(F, a, r); continue; } r -= nfc;
    if (r < nswa) swa_item(F, a, layer, r); else na_item(F, a, layer, r - nswa);
  }
}
__device__ __forceinline__ void p4b_glaout(const Frame& F0, const Args& a, int layer) {
  const Frame F = relaunder(F0);
  for (int it = F.vcu; it < 272; it += F.G) { if (layer == 1 && (it % 68) >= 64) continue; gla_out_item(F, a, layer, it); }
}
}
#define XB_TMO      128
#define XB_XCNT(j)  (256  + 64 * (j))
#define XB_XSUB(j)  (1280 + 64 * (j))
#define XB_XGEN(j)  (2304 + 64 * (j))
#define XB_TOP      3328
#define XB_TOPGEN   3392
#define XCD_BAR_WORDS 3456
#define XB_SPIN_CAP (1u << 18)

__device__ __forceinline__ unsigned xb_ld(unsigned* p)              { return __hip_atomic_load(p, __ATOMIC_RELAXED, __HIP_MEMORY_SCOPE_AGENT); }
__device__ __forceinline__ unsigned xb_add(unsigned* p, unsigned v) { return __hip_atomic_fetch_add(p, v, __ATOMIC_RELAXED, __HIP_MEMORY_SCOPE_AGENT); }
__device__ __forceinline__ unsigned xb_xcc_id() { return (unsigned)__builtin_amdgcn_s_getreg((3 << 11) | 20) & 0xFu; }
#define XB_SPIN(cond, bar) do { unsigned _sp = 0; while (cond) { __builtin_amdgcn_s_sleep(1); \
    if ((++_sp & 255u) == 0u) { if (xb_ld(&(bar)[XB_TMO])) break; if (_sp > XB_SPIN_CAP) { atomicAdd(&(bar)[XB_TMO], 1u); break; } } } } while (0)

struct XcdBarrier {
    unsigned* bar; unsigned x;
    volatile LAS unsigned* st;
};

__device__ __forceinline__ XcdBarrier xcd_barrier_post(unsigned* bar, volatile LAS unsigned* st) {
    XcdBarrier b; b.bar = bar; b.x = xb_xcc_id(); b.st = st;
    if (threadIdx.x == 0) (void)xb_add(&bar[XB_XCNT(b.x)], 1u);
    return b;
}
__device__ __forceinline__ void xcd_barrier_complete(unsigned* bar, unsigned x, unsigned& nloc, unsigned& nx) {
    const unsigned G = gridDim.x * gridDim.y * gridDim.z;
    unsigned sum, cnt, mine, sp = 0u;
    for (;;) {
        sum = 0u; cnt = 0u; mine = 0u;
#pragma unroll
        for (unsigned j = 0; j < 16; ++j) { const unsigned c = xb_ld(&bar[XB_XCNT(j)]); sum += c; cnt += (c > 0u) ? 1u : 0u; }
        mine = xb_ld(&bar[XB_XCNT(x)]);
        if (sum == G) break;
        __builtin_amdgcn_s_sleep(1);
        if ((++sp & 255u) == 0u) { if (xb_ld(&bar[XB_TMO])) break; if (sp > XB_SPIN_CAP) { atomicAdd(&bar[XB_TMO], 1u); break; } }
    }
    nloc = mine > 0u ? mine : 1u; nx = cnt > 0u ? cnt : 1u;
}

__device__ __forceinline__ void xcd_barrier(const XcdBarrier& b) {
    asm volatile("s_waitcnt vmcnt(0)" ::: "memory");
    __syncthreads();
    if (threadIdx.x == 0) {
        unsigned* bar = b.bar;
        __builtin_amdgcn_s_waitcnt(0);
        unsigned nloc = b.st[0], nx = b.st[1];
        if (nloc == 0u) { xcd_barrier_complete(bar, b.x, nloc, nx); b.st[0] = nloc; b.st[1] = nx; }
        const unsigned old = xb_add(&bar[XB_XSUB(b.x)], 1u);
        const unsigned gen = old / nloc;
        if (old + 1u == (gen + 1u) * nloc) {
            __builtin_amdgcn_fence(__ATOMIC_RELEASE, "agent");
            asm volatile("s_waitcnt vmcnt(0)" ::: "memory");
            const unsigned og = xb_add(&bar[XB_TOP], 1u);
            const unsigned tg = og / nx;
            if (og + 1u == (tg + 1u) * nx) xb_add(&bar[XB_TOPGEN], 1u);
            else XB_SPIN(xb_ld(&bar[XB_TOPGEN]) == tg, bar);
            __builtin_amdgcn_fence(__ATOMIC_ACQUIRE, "agent");
            xb_add(&bar[XB_XGEN(b.x)], 1u);
            asm volatile("s_waitcnt vmcnt(0)" ::: "memory");
        } else {
            XB_SPIN(xb_ld(&bar[XB_XGEN(b.x)]) == gen, bar);
            __builtin_amdgcn_fence(__ATOMIC_ACQUIRE, "agent");
            asm volatile("s_waitcnt vmcnt(0)" ::: "memory");
        }
    }
    __syncthreads();
}

constexpr int LDS_BYTES = 163840, MISC_OFF = LDS_BYTES - 256;
constexpr int CW_BAR = 4096;
__global__ void __launch_bounds__(512, 2) mega(mk::Args a) {
  extern __shared__ __attribute__((aligned(16))) unsigned char lds[];
  mk::Frame F;
  F.lds = (LAS unsigned char*)lds;
  F.tid = threadIdx.x; F.lane = F.tid & 63; F.wave = __builtin_amdgcn_readfirstlane(F.tid >> 6);
  F.G = gridDim.x; { const int bx = blockIdx.x; F.vcu = (F.G % 8 == 0) ? (bx % 8) * (F.G / 8) + bx / 8 : bx; }
  volatile LAS unsigned* MISC = (volatile LAS unsigned*)(F.lds + MISC_OFF);
  if (F.tid < 64) MISC[F.tid] = 0u;
  __syncthreads();
  XcdBarrier bar; bar.bar = nullptr; bar.x = 0; bar.st = nullptr;
  const bool multi = (a.ph_hi - a.ph_lo) > 1;
  if (multi) bar = xcd_barrier_post((unsigned*)(a.ws + mk::WS_CTL) + CW_BAR, MISC + 8);
#pragma clang loop unroll(disable)
  for (int ph = a.ph_lo; ph < a.ph_hi; ++ph) {
    if (ph == 0) mk::p0_prologue(F, a);
    else {
      const int layer = (ph - 1) / 6, sub = (ph - 1) % 6;
      if (sub == 0) mk::p1_prenorm(F, a, layer);
      else if (sub == 1) mk::p2_inproj(F, a, layer);
      else if (sub == 2) mk::p3_mixers(F, a, layer);
      else if (sub == 3) mk::gla_scan(F, a);
      else if (sub == 4) mk::p4b_glaout(F, a, layer);
      else mk::p5_outproj(F, a, layer);
    }
    if (ph + 1 < a.ph_hi) xcd_barrier(bar);
  }
}

extern "C" void kernel_launch(void* const* d_in, const int* in_sizes, int n_in, void* d_out, int out_size, void* d_ws, size_t ws_size, hipStream_t stream) {
  using namespace mk;
  static int grid = 0;
  if (grid == 0) {
    int dev = 0, cus = 0, per_cu = 0; (void)hipGetDevice(&dev); (void)hipDeviceGetAttribute(&cus, hipDeviceAttributeMultiprocessorCount, dev);
    (void)hipFuncSetAttribute((const void*)mega, hipFuncAttributeMaxDynamicSharedMemorySize, LDS_BYTES);
    if (hipOccupancyMaxActiveBlocksPerMultiprocessor(&per_cu, (const void*)mega, 512, LDS_BYTES) != hipSuccess || per_cu < 1) per_cu = 1;
    (void)hipGetLastError();
    grid = (cus > 0 ? cus : 256) * (per_cu < 1 ? 1 : 1);
  }
  (void)hipMemsetAsync((char*)d_ws + WS_CTL, 0, CTL_BYTES, stream);
  Args a{};
  for (int i = 0; i < 19; ++i) a.in[i] = (const float*)d_in[i];
  a.out = (float*)d_out; a.ws = (unsigned char*)d_ws;
  a.ph_lo = 0; a.ph_hi = 13;
  void* args[] = {&a};
  if (hipLaunchCooperativeKernel((const void*)mega, dim3(grid), dim3(512), args, LDS_BYTES, stream) != hipSuccess) {
    (void)hipGetLastError();
    hipLaunchKernelGGL(mega, dim3(grid), dim3(512), LDS_BYTES, stream, a);
  }
}
```

```cpp
#include <hip/hip_runtime.h>
#include <math.h>
#include <stdint.h>

namespace pg8 {
#define PG8_LAS __attribute__((address_space(3)))
typedef unsigned short bf16_t;
typedef short bf16x8 __attribute__((ext_vector_type(8)));
typedef float f32x4 __attribute__((ext_vector_type(4)));
typedef unsigned u32x4 __attribute__((ext_vector_type(4)));
constexpr int BM = 256, BK = 64, HALF = 128, HTB = HALF * BK * 2  , STAGE_BYTES = 8 * HTB, NXCD = 8, WGM = 8;

__host__ __device__ __forceinline__ int lds_byte(int r, int c) { const int st = (r >> 4) * 2 + (c >> 5), rr = r & 15, cc = c & 31, ob = rr * 64 + cc * 2; return st * 1024 + (ob ^ (((ob >> 9) & 1) << 5)); }
__host__ __device__ __forceinline__ void stage_rc(int b, int& R, int& C) { const int st = b / 1024, sb = b % 1024, swz = sb ^ (((sb >> 9) & 1) << 5); R = (st >> 1) * 16 + swz / 64; C = (st & 1) * 32 + (swz % 64) / 2; }
__host__ __device__ __forceinline__ int perm32(int rho) { const int n = rho >> 4, i = rho & 15; return 8 * (i >> 2) + 4 * n + (i & 3); }

struct Unit { int pm, pn; };
struct Gemm { const bf16_t* A; const bf16_t* Bt; int M, N, K; };

struct StaticOrder {
    int nM, nN, nwg, G, c;
    __host__ __device__ void init(int M, int N, int G_, int c_) { nM = M / BM; nN = N / BM; nwg = nM * nN; G = G_; c = c_; }
    __host__ __device__ bool next(int i, Unit& u) const {
        const long L = (long)i * G + c; if (L >= nwg) return false;
        int wgid = (int)L; { const int q = nwg / NXCD, r = nwg % NXCD, xcd = wgid % NXCD, off = wgid / NXCD; wgid = (xcd < r ? xcd * (q + 1) : r * (q + 1) + (xcd - r) * q) + off; }
        const int nig = WGM * nN, gid = wgid / nig, fm = gid * WGM, gsz = (nM - fm) < WGM ? (nM - fm) : WGM;
        u.pm = fm + ((wgid % nig) % gsz); u.pn = (wgid % nig) / gsz; return true;
    }
    __device__ __forceinline__ void a_ready(const Unit&) const {}
    __device__ __forceinline__ void done(const Unit&) const {}
};

template <class Epi, class Sched, bool STAMP = false>
__device__ __forceinline__ void gemm_phase(PG8_LAS unsigned char* lds, const Gemm g, const Sched& S, const Epi& E, unsigned long long* stamps) {
    int tid_ = threadIdx.x; asm volatile("" : "+v"(tid_));
    const int tid = tid_, wid = __builtin_amdgcn_readfirstlane(tid >> 6), lane = tid & 63, wr = wid >> 2, wc = wid & 3, fr = lane & 15, fq = lane >> 4;
    const int K = g.K, nt = K / BK;
    int ts_lo = 0, ts_hi = 0, nts = 0; const unsigned long long rt_entry = STAMP ? (unsigned long long)wall_clock64() : 0ull;
#define PG8_STAMP() do { if (STAMP && wid == 0 && nts < 64) { const unsigned long long _c = (unsigned long long)clock64(); \
        ts_lo = (lane == nts) ? (int)(unsigned)_c : ts_lo; ts_hi = (lane == nts) ? (int)(unsigned)(_c >> 32) : ts_hi; ++nts; } } while (0)
    PG8_STAMP();
    unsigned voffA[2], voffB[2];
#pragma unroll
    for (int i = 0; i < 2; ++i) { int R, C; stage_rc(tid * 16 + i * 8192, R, C); const int Rb = Epi::PERM ? ((R & ~31) + perm32(R & 31)) : R;
        voffA[i] = (unsigned)(R * K + C) * 2u; voffB[i] = (unsigned)(Rb * K + C) * 2u; }
    const size_t kstep = (size_t)(BK * 2);
    const size_t hstep = (size_t)HALF * K * 2;
    const size_t tstep = 2 * hstep;
    const unsigned ldsw = (unsigned)wid * 1024u;
    const int aoff = lds_byte(wr * 64 + fr, fq * 8), boff = lds_byte(wc * 32 + fr, fq * 8);
#define PG8_SA(b, h) (((b) * 2 + (h)) * HTB)
#define PG8_SB(b, h) ((4 + (b) * 2 + (h)) * HTB)
#define PG8_STAGE(bufoff, gbase, voff) do { _Pragma("unroll") for (int _i = 0; _i < 2; ++_i) \
        __builtin_amdgcn_global_load_lds((const unsigned*)((const char*)(gbase) + (voff)[_i]), (PG8_LAS unsigned*)(lds + (bufoff) + ldsw + _i * 8192), 16, 0, 0); } while (0)
#define PG8_LDA(dst, b, h) do { _Pragma("unroll") for (int m = 0; m < 4; ++m) _Pragma("unroll") for (int k = 0; k < 2; ++k) dst[m][k] = *(const PG8_LAS bf16x8*)(lds + PG8_SA(b, h) + aoff + m * 2048 + k * 1024); } while (0)
#define PG8_LDB(dst, b, h) do { _Pragma("unroll") for (int n = 0; n < 2; ++n) _Pragma("unroll") for (int k = 0; k < 2; ++k) dst[n][k] = *(const PG8_LAS bf16x8*)(lds + PG8_SB(b, h) + boff + n * 2048 + k * 1024); } while (0)
#define PG8_MMA(ai, bj, At, Bt) do { __builtin_amdgcn_s_setprio(1); _Pragma("unroll") for (int m = 0; m < 4; ++m) _Pragma("unroll") for (int n = 0; n < 2; ++n) _Pragma("unroll") for (int k = 0; k < 2; ++k) \
        acc[ai][bj][m][n] = __builtin_amdgcn_mfma_f32_16x16x32_bf16(Bt[n][k], At[m][k], acc[ai][bj][m][n], 0, 0, 0); __builtin_amdgcn_s_setprio(0); } while (0)
#define PG8_WAIT_V(n) asm volatile("s_waitcnt vmcnt(" #n ")" ::: "memory")
#define PG8_WAIT_L(n) asm volatile("s_waitcnt lgkmcnt(" #n ")" ::: "memory")
#define PG8_BAR __builtin_amdgcn_s_barrier()
#define PG8_SCHED __builtin_amdgcn_sched_barrier(0)
    Unit cur, nxt; int ui = 0;
    if (!S.next(0, cur)) return;
    f32x4 acc[2][2][4][2];
#pragma unroll
    for (int a = 0; a < 2; ++a)
#pragma unroll
        for (int b = 0; b < 2; ++b)
#pragma unroll
            for (int m = 0; m < 4; ++m)
#pragma unroll
                for (int n = 0; n < 2; ++n) acc[a][b][m][n] = (f32x4){0.f, 0.f, 0.f, 0.f};
    bf16x8 At[4][2], B0[2][2], B1[2][2];
    const char* cA = (const char*)g.A + (size_t)cur.pm * tstep; const char* cB = (const char*)g.Bt + (size_t)cur.pn * tstep;
    S.a_ready(cur);
    PG8_STAGE(PG8_SB(0, 0), cB, voffB); PG8_STAGE(PG8_SA(0, 0), cA, voffA); PG8_STAGE(PG8_SB(0, 1), cB + hstep, voffB); PG8_STAGE(PG8_SA(0, 1), cA + hstep, voffA);
    if (wr == 1) PG8_BAR;
    PG8_WAIT_V(4); PG8_BAR;
    PG8_STAGE(PG8_SB(1, 0), cB + kstep, voffB); PG8_STAGE(PG8_SA(1, 0), cA + kstep, voffA); PG8_STAGE(PG8_SB(1, 1), cB + hstep + kstep, voffB);
    PG8_WAIT_V(6); PG8_BAR;
    PG8_STAMP();
    for (;;) {
        const bool has_next = S.next(ui + 1, nxt);
        const char* nA = has_next ? (const char*)g.A + (size_t)nxt.pm * tstep : cA; const char* nB = has_next ? (const char*)g.Bt + (size_t)nxt.pn * tstep : cB;
        for (int t = 0; t < nt; t += 2) {
            const bool last = (t == nt - 2);
            const char* a1 = cA + (size_t)(t + 1) * kstep;
            const char* a2 = last ? nA : cA + (size_t)(t + 2) * kstep; const char* b2 = last ? nB : cB + (size_t)(t + 2) * kstep;
            const char* a3 = a2 + kstep; const char* b3 = b2 + kstep;
            if (last && has_next) S.a_ready(nxt);
            PG8_LDB(B0, 0, 0); PG8_SCHED; PG8_LDA(At, 0, 0); PG8_STAGE(PG8_SA(1, 1), a1 + hstep, voffA);
            PG8_WAIT_L(8); PG8_BAR; PG8_WAIT_L(0); PG8_MMA(0, 0, At, B0); PG8_BAR; PG8_SCHED;
            PG8_LDB(B1, 0, 1); PG8_STAGE(PG8_SB(0, 0), b2, voffB);
            PG8_BAR; PG8_WAIT_L(0); PG8_MMA(0, 1, At, B1); PG8_BAR;
            PG8_LDA(At, 0, 1); PG8_STAGE(PG8_SA(0, 0), a2, voffA);
            PG8_BAR; PG8_WAIT_L(0); PG8_MMA(1, 0, At, B0); PG8_BAR; PG8_SCHED;
            PG8_STAGE(PG8_SB(0, 1), b2 + hstep, voffB);
            PG8_WAIT_V(6); PG8_BAR; PG8_MMA(1, 1, At, B1); PG8_BAR;
            PG8_LDB(B0, 1, 0); PG8_SCHED; PG8_LDA(At, 1, 0); PG8_STAGE(PG8_SA(0, 1), a2 + hstep, voffA);
            PG8_WAIT_L(8); PG8_BAR; PG8_WAIT_L(0); PG8_MMA(0, 0, At, B0); PG8_BAR; PG8_SCHED;
            PG8_LDB(B1, 1, 1); PG8_STAGE(PG8_SB(1, 0), b3, voffB);
            PG8_BAR; PG8_WAIT_L(0); PG8_MMA(0, 1, At, B1); PG8_BAR;
            PG8_LDA(At, 1, 1); PG8_STAGE(PG8_SA(1, 0), a3, voffA);
            PG8_BAR; PG8_WAIT_L(0); PG8_MMA(1, 0, At, B0); PG8_BAR; PG8_SCHED;
            PG8_STAGE(PG8_SB(1, 1), b3 + hstep, voffB);
            PG8_WAIT_V(6); PG8_BAR; PG8_MMA(1, 1, At, B1); PG8_BAR;
        }
        PG8_STAMP();
        if constexpr (!Epi::AFTER_DRAIN) { E(acc, cur, wr, wc, fr, fq); S.done(cur); }
        PG8_STAMP();
        if (!has_next) break;
#pragma unroll
        for (int a = 0; a < 2; ++a)
#pragma unroll
            for (int b = 0; b < 2; ++b)
#pragma unroll
                for (int m = 0; m < 4; ++m)
#pragma unroll
                    for (int n = 0; n < 2; ++n) acc[a][b][m][n] = (f32x4){0.f, 0.f, 0.f, 0.f};
        cur = nxt; cA = nA; cB = nB; ++ui;
    }
    PG8_WAIT_V(0);
    if (wr == 0) PG8_BAR;
    PG8_BAR;
    if constexpr (Epi::AFTER_DRAIN) { E.fused(acc, cur, wr, wc, fr, fq, lds, wid, lane); S.done(cur); }
    PG8_STAMP();
    if (STAMP && wid == 0) { stamps[lane] = lane < nts ? (((unsigned long long)(unsigned)ts_hi << 32) | (unsigned)ts_lo) : 0ull;
        if (lane == 62) stamps[62] = rt_entry; if (lane == 63) stamps[63] = (unsigned long long)wall_clock64(); }
#undef PG8_STAMP
#undef PG8_SA
#undef PG8_SB
#undef PG8_STAGE
#undef PG8_LDA
#undef PG8_LDB
#undef PG8_MMA
#undef PG8_WAIT_V
#undef PG8_WAIT_L
#undef PG8_BAR
#undef PG8_SCHED
}
}

namespace mk {
#define LAS __attribute__((address_space(3)))
typedef unsigned short bf16;
typedef float f32x4 __attribute__((ext_vector_type(4)));
typedef float f32x16 __attribute__((ext_vector_type(16)));
typedef unsigned u32x4 __attribute__((ext_vector_type(4)));
typedef unsigned u32x2 __attribute__((ext_vector_type(2)));
typedef short bf16x8 __attribute__((ext_vector_type(8)));
typedef short s16x4 __attribute__((ext_vector_type(4)));

constexpr int D = 1024, NB = 4, SEQ = 4096, CTX = 256, PWW = 3360;
constexpr int MLAT = NB * SEQ, MT = MLAT + NB * CTX;
constexpr int NT1 = 14, N1 = NT1 * 256;
constexpr int NSLOT = 11, PLW = NSLOT * 256;
constexpr int TROW = SEQ + CTX;
constexpr int O_AQ = 0, O_AK = 128, O_AV = 256, O_AG = 512, O_LR = 768, O_BV = 800, O_BG = 1056, O_CQ = 1312, O_CK = 1568, O_CV = 1696,
              O_CG = 1824, O_DQ = 2080, O_DK = 2336, O_DV = 2592, O_DG = 2848;
constexpr int S_AQK = 0, S_AV = 1, S_AG = 2, S_BG = 3, S_CQ = 4, S_CKV = 5, S_CG = 6, S_DQ = 7, S_DK = 8, S_DV = 9, S_DG = 10;
constexpr float LOG2E = 1.4426950408889634f, QSCALE = 0.125f * LOG2E, GLA_QS = 0.17677669529663687f;

constexpr size_t WS_CTL = 0, CTL_BYTES = 65536;
constexpr size_t WS_MOD = WS_CTL + CTL_BYTES;
constexpr size_t WS_ROPE = WS_MOD + 2 * 5 * 3072 * 4;
constexpr size_t WS_WC = WS_ROPE + 2 * 64 * 16 * 4;
constexpr size_t WS_CS256 = WS_WC + 128 * 128 * 2;
constexpr size_t WS_W1T = 1u << 20;
constexpr size_t WS_W2T = WS_W1T + (size_t)2 * N1 * D * 2;
constexpr size_t WS_H = WS_W2T + (size_t)2 * D * D * 2;
constexpr size_t WS_PLB = WS_H + (size_t)MT * D * 2;
constexpr size_t WS_LA = WS_PLB + (size_t)MT * PLW * 2;
constexpr size_t WS_FA2 = WS_LA + (size_t)MT * 256 * 4;
constexpr size_t WS_CTX1 = WS_FA2 + (size_t)NB * 64 * TROW * 8 * 2;
constexpr size_t WS_SCR = WS_CTX1 + (size_t)NB * CTX * D * 4;
static_assert(WS_CS256 + 256 * 512 * 2 <= WS_W1T, "tables");

__device__ __forceinline__ float bf2f(bf16 v) { return __uint_as_float(((unsigned)v) << 16); }
__device__ __forceinline__ unsigned f2bf(float f) { unsigned u = __float_as_uint(f); return (u + 0x7fffu + ((u >> 16) & 1u)) >> 16; }
typedef float f32x2_t __attribute__((ext_vector_type(2))); typedef __bf16 bf16x2_t __attribute__((ext_vector_type(2)));
__device__ __forceinline__ unsigned pk2(float lo, float hi) { const f32x2_t v = {lo, hi}; const bf16x2_t b = __builtin_convertvector(v, bf16x2_t); return __builtin_bit_cast(unsigned, b); }
__device__ __forceinline__ float wave_sum(float v) {
#pragma unroll
  for (int o = 1; o < 64; o <<= 1) v += __shfl_xor(v, o);
  return v;
}
__device__ __forceinline__ float fsilu(float x) { return x * __builtin_amdgcn_rcpf(1.f + __expf(-x)); }
__device__ __forceinline__ float flogsig(float x) { return fminf(x, 0.f) - __logf(1.f + __expf(-fabsf(x))); }

#define GAS __attribute__((address_space(1)))
template <class T> __device__ __forceinline__ T* opq(T* p) { GAS T* g = (GAS T*)p; asm volatile("" : "+s"(g)); return (T*)g; }
__device__ __forceinline__ int crow(int r, int hi) { return (r & 3) + 8 * (r >> 2) + 4 * hi; }
struct Args {
  const float* in[19]; float* out; unsigned char* ws; int ph_lo, ph_hi;
};
struct Frame {
  int tid, lane, wave, vcu, G;
  LAS unsigned char* lds;
};
__device__ __forceinline__ Frame relaunder(const Frame& F0) {
  Frame F = F0; F.tid = threadIdx.x; asm volatile("" : "+v"(F.tid)); F.lane = F.tid & 63; asm volatile("" : "+s"(F.wave), "+s"(F.vcu), "+s"(F.G)); return F; }
}

namespace mk {
__device__ __forceinline__ void p0_ada_item(const Frame& F, const Args& a, int item) {
  LAS float* s = (LAS float*)F.lds; LAS float* red = s + 5 * 1024;
  const float* c = opq(a.in[1]); const float* cc = opq(a.in[3]);
  for (int i = F.tid; i < 5 * 1024; i += 512) { const int r = i >> 10, k = i & 1023; const float v = r < 4 ? c[r * 1024 + k] : cc[k]; s[i] = v / (1.f + expf(-v)); }
  __syncthreads();
  const int kp = F.tid / 24, cl = F.tid % 24;
  const int gcol = item * 24 + cl, l = gcol / 3072, col = gcol % 3072;
  if (kp < 21) {
    const float* w = opq(a.in[5]) + (size_t)l * 1024 * 3072 + col;
    float acc[5] = {0.f, 0.f, 0.f, 0.f, 0.f};
#pragma unroll 8
    for (int k = kp; k < 1024; k += 21) { const float wv = w[(size_t)k * 3072];
#pragma unroll
      for (int r = 0; r < 5; ++r) acc[r] += s[r * 1024 + k] * wv; }
#pragma unroll
    for (int r = 0; r < 5; ++r) red[(kp * 24 + cl) * 5 + r] = acc[r];
  }
  __syncthreads();
  if (F.tid < 120) {
    const int cl2 = F.tid / 5, r = F.tid % 5; float t = 0.f;
    for (int q = 0; q < 21; ++q) t += red[(q * 24 + cl2) * 5 + r];
    const int g2 = item * 24 + cl2, l2 = g2 / 3072, col2 = g2 % 3072;
    float* MOD = (float*)(opq(a.ws) + WS_MOD);
    MOD[((size_t)l2 * 5 + r) * 3072 + col2] = t + opq(a.in[6])[l2 * 3072 + col2];
  }
  __syncthreads();
}
__device__ __forceinline__ int rope_perm(int n) { return 16 * ((n >> 2) & 1) + 4 * (n >> 3) + (n & 3); }
__device__ __forceinline__ void p0_tr_item(const float* W, int ldw, int cbase, int permkind, float scale, bf16* dst, int k0, LAS float* scr, int lane) {
  { float t_[32];
#pragma unroll
    for (int i = 0; i < 32; ++i) t_[i] = W[(size_t)(k0 + 2 * i + (lane >> 5)) * ldw + cbase + (lane & 31)];
#pragma unroll
    for (int i = 0; i < 32; ++i) scr[(2 * i + (lane >> 5)) * 33 + (lane & 31)] = t_[i]; }
  asm volatile("s_waitcnt lgkmcnt(0)" ::: "memory");
  const int c = lane & 7;
#pragma unroll
  for (int j = 0; j < 4; ++j) { const int n = (lane >> 3) + 8 * j; const int sidx = permkind ? rope_perm(n) : n; const LAS float* sp = scr + (8 * c) * 33 + sidx;
    u32x4 o; o.x = pk2(sp[0 * 33] * scale, sp[1 * 33] * scale); o.y = pk2(sp[2 * 33] * scale, sp[3 * 33] * scale); o.z = pk2(sp[4 * 33] * scale, sp[5 * 33] * scale); o.w = pk2(sp[6 * 33] * scale, sp[7 * 33] * scale);
    *(u32x4*)(dst + (size_t)n * 1024 + k0 + 8 * c) = o; }
  asm volatile("s_waitcnt lgkmcnt(0)" ::: "memory");
}
__device__ __forceinline__ void p0_la_item(const float* Win, const float* decw  , int dir, int j0, bf16* dst, int k0, LAS float* scr, int lane) {
  float dw[16];
#pragma unroll
  for (int r = 0; r < 16; ++r) dw[r] = decw[(dir * 16 + r) * 128 + j0 + (lane & 31)];
#pragma unroll 4
  for (int i = 0; i < 32; ++i) { const int kk = 2 * i + (lane >> 5); const float* wp = Win + (size_t)(k0 + kk) * PWW + O_LR + dir * 16; float acc = 0.f;
#pragma unroll
    for (int r = 0; r < 16; ++r) acc += wp[r] * dw[r];
    scr[kk * 33 + (lane & 31)] = acc; }
  asm volatile("s_waitcnt lgkmcnt(0)" ::: "memory");
  const int c = lane & 7;
#pragma unroll
  for (int j = 0; j < 4; ++j) { const int n = (lane >> 3) + 8 * j; const LAS float* sp = scr + (8 * c) * 33 + n;
    u32x4 o; o.x = pk2(sp[0 * 33], sp[1 * 33]); o.y = pk2(sp[2 * 33], sp[3 * 33]); o.z = pk2(sp[4 * 33], sp[5 * 33]); o.w = pk2(sp[6 * 33], sp[7 * 33]);
    *(u32x4*)(dst + (size_t)n * 1024 + k0 + 8 * c) = o; }
  asm volatile("s_waitcnt lgkmcnt(0)" ::: "memory");
}
constexpr int FA_AST = 528, FA_WST = 528;
__device__ __forceinline__ void p0_fa_item(const Frame& F, const Args& a, int item) {
  const int l = item >> 4, pn = 4 + ((item >> 3) & 1), g32 = item & 7, bj = g32 >> 2, wc = g32 & 3;
  LAS float* cs = (LAS float*)F.lds; LAS float* sn = cs + 64; LAS float* wfl = sn + 64;
  LAS unsigned char* Ai = F.lds + 512 + 16384;
  LAS unsigned char* Wi = F.lds + F.wave * (32 * FA_WST);
  __syncthreads();
  if (F.tid < 64) { float s_, c_; sincospif(2.f * F.tid / 64.f, &s_, &c_); cs[F.tid] = c_; sn[F.tid] = s_; }
  const float* wf = opq(a.in[12]) + (size_t)l * 256 * 256;
  const int slice0 = 32 * (pn - 4) + 16 * bj + 4 * wc;
  for (int i = F.tid; i < 1024; i += 512) { const int r = i >> 2, q = i & 3; *(LAS f32x4*)(wfl + r * 16 + 4 * q) = *(const f32x4*)(wf + (size_t)r * 256 + 4 * slice0 + 4 * q); }
  __syncthreads();
  {
    const int c = F.tid & 255, part = F.tid >> 8, g = c >> 6, jj = c & 63;
    f32x4 acc[4];
#pragma unroll
    for (int q = 0; q < 4; ++q) acc[q] = (f32x4){0.f, 0.f, 0.f, 0.f};
#pragma unroll 4
    for (int m = 0; m < 64; ++m) { const int idx = (m * jj) & 63; const float t = part ? -sn[idx] : cs[idx];
#pragma unroll
      for (int q = 0; q < 4; ++q) acc[q] += t * *(LAS const f32x4*)(wfl + (g * 64 + m) * 16 + 4 * q); }
#pragma unroll
    for (int fq = 0; fq < 4; ++fq)
#pragma unroll
      for (int j = 0; j < 4; ++j) *(LAS unsigned short*)(Ai + (8 * fq + 4 * part + j) * FA_AST + c * 2) = (unsigned short)f2bf(acc[fq][j] * 0.125f);
  }
  __syncthreads();
  const int r32 = F.lane & 31, hi = F.lane >> 5;
  bf16x8 af[16];
#pragma unroll
  for (int s = 0; s < 16; ++s) af[s] = *(LAS const bf16x8*)(Ai + r32 * FA_AST + (16 * s + 8 * hi) * 2);
  __syncthreads();
  const float* Win = opq(a.in[7]) + (size_t)l * 1024 * PWW + O_BV;
  bf16* dst = (bf16*)(opq(a.ws) + WS_W1T) + ((size_t)l * N1 + pn * 256 + 32 * g32) * 1024;
  for (int kb = 0; kb < 4; ++kb) {
    const int k0 = F.wave * 128 + kb * 32;
#pragma unroll
    for (int rh = 0; rh < 2; ++rh) { f32x4 w[16];
#pragma unroll
      for (int r = 0; r < 16; ++r) w[r] = *(const f32x4*)(Win + (size_t)(k0 + 16 * rh + r) * PWW + 4 * F.lane);
#pragma unroll
      for (int r = 0; r < 16; ++r) *(LAS u32x2*)(Wi + (16 * rh + r) * FA_WST + 8 * F.lane) = (u32x2){pk2(w[r].x, w[r].y), pk2(w[r].z, w[r].w)}; }
    asm volatile("s_waitcnt lgkmcnt(0)" ::: "memory");
    f32x16 acc;
#pragma unroll
    for (int i = 0; i < 16; ++i) acc[i] = 0.f;
#pragma unroll
    for (int s = 0; s < 16; ++s) { const bf16x8 bfr = *(LAS const bf16x8*)(Wi + r32 * FA_WST + (16 * s + 8 * hi) * 2); acc = __builtin_amdgcn_mfma_f32_32x32x16_bf16(af[s], bfr, acc, 0, 0, 0); }
#pragma unroll
    for (int r = 0; r < 16; ++r) dst[(size_t)crow(r, hi) * 1024 + k0 + r32] = (bf16)f2bf(acc[r]);
    asm volatile("s_waitcnt lgkmcnt(0)" ::: "memory");
  }
  __syncthreads();
}
__device__ __forceinline__ void p0_prologue(const Frame& F0, const Args& a) {
 {
  const Frame F = relaunder(F0);
  unsigned char* ws = opq(a.ws);
  { const int gt = F.vcu * 512 + F.tid, GT = F.G * 512;
    float* rope = (float*)(ws + WS_ROPE);
    for (int i = gt; i < 1024; i += GT) { const int pos = i >> 4, f = i & 15; const float ang = (float)pos * powf(10000.f, -(float)f / 16.f); rope[i] = cosf(ang); rope[1024 + i] = sinf(ang); }
    bf16* wc = (bf16*)(ws + WS_WC);
    for (int i = gt; i < 128 * 128; i += GT) { const int r = i >> 7, c = i & 127, rr = r & 63, cc = c & 63; float s_, c_; sincospif(2.f * (float)((rr * cc) & 63) / 64.f, &s_, &c_);
      float v; if (r < 64) v = c < 64 ? c_ : s_; else v = c < 64 ? -s_ : c_; wc[i] = (bf16)f2bf(v * 0.125f); }
    bf16* cs256 = (bf16*)(ws + WS_CS256);
    for (int i = gt; i < 256 * 512; i += GT) { const int k = i >> 9, n = i & 511, nn = n & 255; float s_, c_; sincospif(2.f * (float)((k * nn) & 255) / 256.f, &s_, &c_); cs256[i] = (bf16)f2bf((n < 256 ? c_ : s_) * 0.0625f); }
  }
  for (int it = F.vcu; it < 256 + 32; it += F.G) { if (it < 256) p0_ada_item(F, a, it); else p0_fa_item(F, a, it - 256); }
  LAS float* scr = (LAS float*)(F.lds + F.wave * 16384);
  const int gw = F.vcu * 8 + F.wave, NGW = F.G * 8;
  constexpr int I_DIR = 11 * 8 * 16, I_LA = 8 * 16, I_W2 = 32 * 16, I_L = I_DIR + I_LA + I_W2;
  for (int it = gw; it < 2 * I_L; it += NGW) {
    const int l = it / I_L; int r = it % I_L;
    const float* Win = opq(a.in[7]) + (size_t)l * 1024 * PWW;
    bf16* W1T = (bf16*)(ws + WS_W1T) + (size_t)l * N1 * 1024;
    if (r < I_DIR) {
      const int ti = r / 128, g32 = (r >> 4) & 7, kb = r & 15;
      const int pn = ti < 3 ? ti : ti + 3;
      const int bj = g32 >> 2, wc = g32 & 3, mcb = 64 * wc + 32 * bj;
      int cbase = 0, pk = 0; float sc = 1.f;
      switch (pn) {
        case 0: if (mcb < 128) { cbase = O_AQ + mcb; sc = GLA_QS; } else cbase = O_AK + mcb - 128; break;
        case 1: cbase = O_AV + mcb; break;
        case 2: cbase = O_AG + mcb; break;
        case 6: cbase = O_BG + mcb; break;
        case 7: cbase = O_CQ + mcb; pk = 1; break;
        case 8: if (wc < 2) { cbase = O_CK + mcb; pk = 1; } else cbase = O_CV + mcb - 128; break;
        case 9: cbase = O_CG + mcb; break;
        case 10: cbase = O_DQ + mcb; break;
        case 11: cbase = O_DK + mcb; break;
        case 12: cbase = O_DV + mcb; break;
        default: cbase = O_DG + mcb; break;
      }
      p0_tr_item(Win, PWW, cbase, pk, sc, W1T + (size_t)(pn * 256 + 32 * g32) * 1024, kb * 64, scr, F.lane);
    } else if (r < I_DIR + I_LA) {
      r -= I_DIR; const int g32 = r >> 4, kb = r & 15, bj = g32 >> 2, wc = g32 & 3, mcb = 64 * wc + 32 * bj;
      p0_la_item(Win, opq(a.in[9]) + (size_t)l * 2 * 16 * 128, mcb >> 7, mcb & 127, W1T + (size_t)(3 * 256 + 32 * g32) * 1024, kb * 64, scr, F.lane);
    } else {
      r -= I_DIR + I_LA; const int g = r >> 4, kb = r & 15;
      p0_tr_item(opq(a.in[8]) + (size_t)l * 1024 * 1024, 1024, 32 * g, 0, 1.f, (bf16*)(ws + WS_W2T) + ((size_t)l * 1024 + 32 * g) * 1024, kb * 64, scr, F.lane);
    }
  }
 }
}
__device__ __forceinline__ void p1_prenorm(const Frame& F0, const Args& a, int layer) {
  const Frame F = relaunder(F0);
  const float* xin = layer == 0 ? opq(a.in[0]) : opq(a.out);
  const float* cin = layer == 0 ? opq(a.in[2]) : (const float*)(opq(a.ws) + WS_CTX1);
  const float* nw = opq(a.in[4]) + layer * 1024;
  const float* MOD = (const float*)(opq(a.ws) + WS_MOD) + (size_t)layer * 5 * 3072;
  bf16* H = (bf16*)(opq(a.ws) + WS_H);
  const int gw = F.vcu * 8 + F.wave, NGW = F.G * 8;
  constexpr int RB = 3;
  f32x4 w_[4];
#pragma unroll
  for (int j = 0; j < 4; ++j) w_[j] = *(const f32x4*)(nw + 4 * F.lane + 256 * j);
  for (int row0 = gw; row0 < MT; row0 += RB * NGW) {
    f32x4 v[RB][4], sc_[RB][4], sh_[RB][4]; float ss[RB];
#pragma unroll
    for (int q = 0; q < RB; ++q) { int row = row0 + q * NGW; row = row < MT ? row : MT - 1;
      const float* src; const float* mod;
      if (row < MLAT) { src = xin + (size_t)row * 1024; mod = MOD + (size_t)(row >> 12) * 3072; }
      else { src = cin + (size_t)(row - MLAT) * 1024; mod = MOD + (size_t)4 * 3072; }
      const f32x4* xr = (const f32x4*)src + F.lane;
#pragma unroll
      for (int j = 0; j < 4; ++j) { v[q][j] = xr[64 * j]; sc_[q][j] = *(const f32x4*)(mod + 1024 + 4 * F.lane + 256 * j); sh_[q][j] = *(const f32x4*)(mod + 4 * F.lane + 256 * j); } }
    __builtin_amdgcn_sched_barrier(0);
#pragma unroll
    for (int q = 0; q < RB; ++q) { float s_ = 0.f;
#pragma unroll
      for (int j = 0; j < 4; ++j) s_ += (v[q][j].x * v[q][j].x + v[q][j].y * v[q][j].y) + (v[q][j].z * v[q][j].z + v[q][j].w * v[q][j].w);
      ss[q] = s_; }
#pragma unroll
    for (int o = 1; o < 64; o <<= 1)
#pragma unroll
      for (int q = 0; q < RB; ++q) ss[q] += __shfl_xor(ss[q], o);
#pragma unroll
    for (int q = 0; q < RB; ++q) { const int row = row0 + q * NGW; if (row >= MT) continue;
      const float rs = 1.0f / sqrtf(ss[q] * (1.f / 1024.f) + 1e-6f);
      unsigned long long* o8 = (unsigned long long*)(H + (size_t)row * 1024) + F.lane;
#pragma unroll
      for (int j = 0; j < 4; ++j) {
        const f32x4 h = v[q][j] * rs * w_[j] * (1.f + sc_[q][j]) + sh_[q][j];
        o8[64 * j] = (unsigned long long)pk2(h.x, h.y) | ((unsigned long long)pk2(h.z, h.w) << 32);
      } }
  }
}
}

namespace mk {
using pg8::Unit;
struct EpiIn {
  static constexpr bool PERM = true, AFTER_DRAIN = false;
  bf16* PLB; float* LA; bf16* FA2; LAS const float* rope;
  __device__ __forceinline__ void operator()(const f32x4 (&acc)[2][2][4][2], const Unit& u, int wr, int wc, int fr, int fq) const {
    const int pn = u.pn;
    const bool ctxrows = u.pm >= 64;
    int kind, slot = 0; LAS const float* nw = rope; bool roped = false; float qs = 1.f;
    LAS const float* cqn = rope + 2048; LAS const float* ckn = rope + 2112; LAS const float* dqn = rope + 2176; LAS const float* dkn = rope + 2240; LAS const float* decb = rope + 2304;
    switch (pn) {
      case 0: kind = 0; slot = S_AQK; break;
      case 1: kind = 0; slot = S_AV; break;
      case 2: kind = 1; slot = S_AG; break;
      case 3: kind = 2; break;
      case 4: case 5: kind = 3; break;
      case 6: kind = 1; slot = S_BG; break;
      case 7: kind = 4; slot = S_CQ; nw = cqn; roped = true; qs = QSCALE; break;
      case 8: slot = S_CKV; if (wc < 2) { kind = 4; nw = ckn; roped = true; } else kind = 0; break;
      case 9: kind = 1; slot = S_CG; break;
      case 10: kind = 4; slot = S_DQ; nw = dqn; qs = QSCALE; break;
      case 11: kind = 4; slot = S_DK; nw = dkn; break;
      case 12: kind = 0; slot = S_DV; break;
      default: kind = 1; slot = S_DG; break;
    }
    const int row0 = u.pm * 256 + wr * 64 + fr;
    float w8[2][8];
    if (kind == 4) {
#pragma unroll
      for (int bj = 0; bj < 2; ++bj)
#pragma unroll
        for (int s = 0; s < 8; ++s) { const int d = roped ? (32 * bj + 16 * (s >> 2) + 4 * fq + (s & 3)) : (32 * bj + 8 * fq + s); w8[bj][s] = nw[d] * qs; }
    } else if (kind == 2) {
#pragma unroll
      for (int bj = 0; bj < 2; ++bj)
#pragma unroll
        for (int s = 0; s < 8; ++s) w8[bj][s] = decb[64 * wc + 32 * bj + 8 * fq + s];
    }
#pragma unroll
    for (int ai = 0; ai < 2; ++ai) {
      float rsr[4];
      if (kind == 4) {
#pragma unroll
        for (int m = 0; m < 4; ++m) { float s_ = 0.f;
#pragma unroll
          for (int bj = 0; bj < 2; ++bj)
#pragma unroll
            for (int n = 0; n < 2; ++n) { const f32x4 t = acc[ai][bj][m][n]; s_ += (t.x * t.x + t.y * t.y) + (t.z * t.z + t.w * t.w); }
          rsr[m] = s_; }
#pragma unroll
        for (int o = 16; o < 64; o <<= 1)
#pragma unroll
          for (int m = 0; m < 4; ++m) rsr[m] += __shfl_xor(rsr[m], o);
#pragma unroll
        for (int m = 0; m < 4; ++m) rsr[m] = __builtin_amdgcn_rsqf(rsr[m] * (1.f / 64.f) + 1e-6f);
      }
#pragma unroll
      for (int m = 0; m < 4; ++m) {
        const int r = row0 + ai * 128 + m * 16;
        float v[2][8];
#pragma unroll
        for (int bj = 0; bj < 2; ++bj)
#pragma unroll
          for (int n = 0; n < 2; ++n)
#pragma unroll
            for (int e = 0; e < 4; ++e) v[bj][4 * n + e] = acc[ai][bj][m][n][e];
        if (kind == 2) {
#pragma unroll
          for (int bj = 0; bj < 2; ++bj) { const int mc = 64 * wc + 32 * bj + 8 * fq; float* dp = LA + (size_t)r * 256 + mc;
            f32x4 o0, o1;
#pragma unroll
            for (int e = 0; e < 4; ++e) { o0[e] = flogsig(v[bj][e] + w8[bj][e]) * 0.0625f; o1[e] = flogsig(v[bj][4 + e] + w8[bj][4 + e]) * 0.0625f; }
            *(f32x4*)dp = o0; *(f32x4*)(dp + 4) = o1; }
        } else if (kind == 3) {
          int b, t; if (!ctxrows) { b = r >> 12; t = r & 4095; } else { const int rc = r - MLAT; b = rc >> 8; t = SEQ + (rc & 255); }
#pragma unroll
          for (int bj = 0; bj < 2; ++bj) { const int slice = 32 * (pn - 4) + 16 * bj + 4 * wc + fq;
            u32x4 o; o.x = pk2(v[bj][0], v[bj][1]); o.y = pk2(v[bj][2], v[bj][3]); o.z = pk2(v[bj][4], v[bj][5]); o.w = pk2(v[bj][6], v[bj][7]);
            *(u32x4*)(FA2 + (((size_t)b * 64 + slice) * TROW + t) * 8) = o; }
        } else {
          if (kind == 1) {
#pragma unroll
            for (int bj = 0; bj < 2; ++bj)
#pragma unroll
              for (int s = 0; s < 8; ++s) v[bj][s] = fsilu(v[bj][s]);
          } else if (kind == 4) {
            const float rs = rsr[m];
#pragma unroll
            for (int bj = 0; bj < 2; ++bj)
#pragma unroll
              for (int s = 0; s < 8; ++s) v[bj][s] *= rs * w8[bj][s];
            if (roped && !ctxrows) {
              const int t = r & 4095;
#pragma unroll
              for (int bj = 0; bj < 2; ++bj) { const int pos = bj == 0 ? (t >> 6) : (t & 63);
                const f32x4 c4 = *(LAS const f32x4*)(rope + pos * 16 + 4 * fq), s4 = *(LAS const f32x4*)(rope + 1024 + pos * 16 + 4 * fq);
#pragma unroll
                for (int e = 0; e < 4; ++e) { const float x1 = v[bj][e], x2 = v[bj][4 + e]; v[bj][e] = x1 * c4[e] - x2 * s4[e]; v[bj][4 + e] = x2 * c4[e] + x1 * s4[e]; } }
            }
          }
#pragma unroll
          for (int bj = 0; bj < 2; ++bj) { const int mc = 64 * wc + 32 * bj + 8 * fq;
            u32x4 o; o.x = pk2(v[bj][0], v[bj][1]); o.y = pk2(v[bj][2], v[bj][3]); o.z = pk2(v[bj][4], v[bj][5]); o.w = pk2(v[bj][6], v[bj][7]);
            *(u32x4*)(PLB + (size_t)r * PLW + slot * 256 + mc) = o; }
        }
        asm volatile("" ::: "memory");
      }
    }
  }
};
struct EpiOut {
  static constexpr bool PERM = true, AFTER_DRAIN = false;
  const float* xin; const float* cin; float* xout; float* cout; const float* MODl;
  __device__ __forceinline__ void operator()(const f32x4 (&acc)[2][2][4][2], const Unit& u, int wr, int wc, int fr_, int fq_) const {
    int fr = fr_, fq = fq_; asm volatile("" : "+v"(fr), "+v"(fq));
    const int row0 = u.pm * 256 + wr * 64 + fr, col0 = u.pn * 256 + wc * 32 + 8 * fq;
    const bool ctxrows = u.pm >= 64;
    const float* gate = MODl + (size_t)(ctxrows ? 4 : (u.pm >> 4)) * 3072 + 2048;
    f32x4 gv[2][2];
#pragma unroll
    for (int bj = 0; bj < 2; ++bj)
#pragma unroll
      for (int n = 0; n < 2; ++n) gv[bj][n] = *(const f32x4*)(gate + col0 + bj * 128 + n * 4);
#pragma unroll
    for (int ai = 0; ai < 2; ++ai)
#pragma unroll
      for (int m = 0; m < 4; ++m) {
        const int r = row0 + ai * 128 + m * 16;
        const float* sp; float* dp;
        if (!ctxrows) { sp = xin + (size_t)r * 1024 + col0; dp = xout + (size_t)r * 1024 + col0; }
        else { sp = cin + (size_t)(r - MLAT) * 1024 + col0; dp = cout + (size_t)(r - MLAT) * 1024 + col0; }
        f32x4 xv[2][2];
#pragma unroll
        for (int bj = 0; bj < 2; ++bj)
#pragma unroll
          for (int n = 0; n < 2; ++n) xv[bj][n] = *(const f32x4*)(sp + bj * 128 + n * 4);
#pragma unroll
        for (int bj = 0; bj < 2; ++bj)
#pragma unroll
          for (int n = 0; n < 2; ++n) *(f32x4*)(dp + bj * 128 + n * 4) = xv[bj][n] + gv[bj][n] * acc[ai][bj][m][n];
        asm volatile("" ::: "memory");
      }
  }
};
__device__ __forceinline__ void p2_inproj(const Frame& F, const Args& a, int layer) {
  unsigned char* ws = opq(a.ws);
  pg8::Gemm g{(const pg8::bf16_t*)(ws + WS_H), (const pg8::bf16_t*)(ws + WS_W1T) + (size_t)layer * N1 * 1024, MT, N1, 1024};
  pg8::StaticOrder S; S.init(MT, N1, F.G, (int)blockIdx.x);
  LAS float* ropeL = (LAS float*)(F.lds + pg8::STAGE_BYTES);
  { int tid = threadIdx.x; asm volatile("" : "+v"(tid)); const f32x4 t = *(const f32x4*)((const float*)(ws + WS_ROPE) + 4 * tid); *(LAS f32x4*)(ropeL + 4 * tid) = t;
    if (tid < 128) {
      const float* n0 = opq(a.in[13]); const float* n1 = opq(a.in[14]); const float* n2 = opq(a.in[16]); const float* n3 = opq(a.in[17]); const float* db = opq(a.in[10]);
      const int k = tid >> 4; const float* src = tid < 64 ? (k == 0 ? n0 : k == 1 ? n1 : k == 2 ? n2 : n3) + layer * 64 + 4 * (tid & 15) : db + layer * 256 + 4 * (tid - 64);
      *(LAS f32x4*)(ropeL + 2048 + 4 * tid) = *(const f32x4*)src; } }
  __syncthreads();
  EpiIn E{(bf16*)(ws + WS_PLB), (float*)(ws + WS_LA), (bf16*)(ws + WS_FA2), ropeL};
  pg8::gemm_phase<EpiIn, pg8::StaticOrder>(F.lds, g, S, E, nullptr);
}

__device__ __forceinline__ void ctx_out_item(const Frame& F, const Args& a, int item) {
  unsigned char* ws = opq(a.ws);
  const bf16* Yc = (const bf16*)(ws + WS_H) + (size_t)MLAT * 1024; const bf16* W2 = (const bf16*)(ws + WS_W2T);
  const int tm = item >> 4, tn = item & 15, sub = F.wave & 3, kh = F.wave >> 2, r32 = F.lane & 31, hi = F.lane >> 5;
  const int row0 = 64 * tm + 32 * (sub >> 1), col0 = 64 * tn + 32 * (sub & 1);
  const bf16* ap = Yc + (size_t)(row0 + r32) * 1024 + kh * 512 + 8 * hi;
  const bf16* bp = W2 + (size_t)(col0 + r32) * 1024 + kh * 512 + 8 * hi;
  f32x16 acc;
#pragma unroll
  for (int i = 0; i < 16; ++i) acc[i] = 0.f;
#pragma unroll 1
  for (int sb = 0; sb < 4; ++sb) {
    bf16x8 af[8], bf[8];
#pragma unroll
    for (int s = 0; s < 8; ++s) { af[s] = *(const bf16x8*)(ap + (sb * 8 + s) * 16); bf[s] = *(const bf16x8*)(bp + (sb * 8 + s) * 16); }
    __builtin_amdgcn_sched_barrier(0);
#pragma unroll
    for (int s = 0; s < 8; ++s) acc = __builtin_amdgcn_mfma_f32_32x32x16_bf16(af[s], bf[s], acc, 0, 0, 0);
  }
  LAS float* X = (LAS float*)F.lds + sub * 1024;
  __syncthreads();
  if (kh == 1) {
#pragma unroll
    for (int r = 0; r < 16; ++r) X[r * 64 + F.lane] = acc[r];
  }
  __syncthreads();
  if (kh == 0) {
    const float* cin = opq(a.in[2]); float* cout = (float*)(ws + WS_CTX1);
    const float gate = ((const float*)(ws + WS_MOD))[4 * 3072 + 2048 + col0 + r32];
    float ci[16];
#pragma unroll
    for (int r = 0; r < 16; ++r) ci[r] = cin[(size_t)(row0 + crow(r, hi)) * 1024 + col0 + r32];
    __builtin_amdgcn_sched_barrier(0);
#pragma unroll
    for (int r = 0; r < 16; ++r) { const size_t o = (size_t)(row0 + crow(r, hi)) * 1024 + col0 + r32; cout[o] = ci[r] + gate * (acc[r] + X[r * 64 + F.lane]); }
  }
}
__device__ __forceinline__ void p5_outproj(const Frame& F, const Args& a, int layer) {
  unsigned char* ws = opq(a.ws);
  const int M = MLAT;
  pg8::Gemm g{(const pg8::bf16_t*)(ws + WS_H), (const pg8::bf16_t*)(ws + WS_W2T) + (size_t)layer * 1024 * 1024, M, 1024, 1024};
  pg8::StaticOrder S; S.init(M, 1024, F.G, (int)blockIdx.x);
  EpiOut E{layer == 0 ? opq(a.in[0]) : opq(a.out), layer == 0 ? opq(a.in[2]) : (const float*)(ws + WS_CTX1), opq(a.out), (float*)(ws + WS_CTX1), (const float*)(ws + WS_MOD) + (size_t)layer * 5 * 3072};
  pg8::gemm_phase<EpiOut, pg8::StaticOrder>(F.lds, g, S, E, nullptr);
  if (layer == 0) { const Frame F2 = relaunder(F); for (int it = F2.vcu; it < 256; it += F2.G) ctx_out_item(F2, a, it); }
}
}

namespace mk {
typedef short v4i16_t __attribute__((ext_vector_type(4)));
__device__ __forceinline__ s16x4 vtr(LAS const unsigned char* p) { return __builtin_bit_cast(s16x4, __builtin_amdgcn_ds_read_tr16_b64_v4i16((LAS v4i16_t*)p)); }
struct AttnState { float m, l; f32x16 o0, o1; };
template <class MaskF>
__device__ __forceinline__ void attn_tile(AttnState& st, const bf16x8 (&qf)[4], LAS const unsigned char* Kt, LAS const unsigned char* Vt, int lane, MaskF&& maskf) {
  const int r32 = lane & 31, hi = lane >> 5;
  f32x16 p0, p1;
  const int ksw = (r32 >> 1) & 7;
  bf16x8 ka[4], kb[4];
#pragma unroll
  for (int s = 0; s < 4; ++s) { const int ch = ((2 * s + hi) ^ ksw) << 4; ka[s] = *(LAS const bf16x8*)(Kt + r32 * 128 + ch); kb[s] = *(LAS const bf16x8*)(Kt + (32 + r32) * 128 + ch); }
  { const f32x16 z = {0.f, 0.f, 0.f, 0.f, 0.f, 0.f, 0.f, 0.f, 0.f, 0.f, 0.f, 0.f, 0.f, 0.f, 0.f, 0.f};
    p0 = __builtin_amdgcn_mfma_f32_32x32x16_bf16(ka[0], qf[0], z, 0, 0, 0); p1 = __builtin_amdgcn_mfma_f32_32x32x16_bf16(kb[0], qf[0], z, 0, 0, 0); }
#pragma unroll
  for (int s = 1; s < 4; ++s) { p0 = __builtin_amdgcn_mfma_f32_32x32x16_bf16(ka[s], qf[s], p0, 0, 0, 0); p1 = __builtin_amdgcn_mfma_f32_32x32x16_bf16(kb[s], qf[s], p1, 0, 0, 0); }
  maskf(p0, p1);
  float ps = 0.f;
#pragma unroll
  for (int i = 0; i < 16; ++i) { p0[i] = __builtin_amdgcn_exp2f(p0[i]); p1[i] = __builtin_amdgcn_exp2f(p1[i]); ps += p0[i] + p1[i]; }
  st.l += ps;
  u32x4 pw[4];
#pragma unroll
  for (int k = 0; k < 2; ++k) {
    pw[k] = (u32x4){pk2(p0[8 * k + 0], p0[8 * k + 1]), pk2(p0[8 * k + 2], p0[8 * k + 3]), pk2(p0[8 * k + 4], p0[8 * k + 5]), pk2(p0[8 * k + 6], p0[8 * k + 7])};
    pw[2 + k] = (u32x4){pk2(p1[8 * k + 0], p1[8 * k + 1]), pk2(p1[8 * k + 2], p1[8 * k + 3]), pk2(p1[8 * k + 4], p1[8 * k + 5]), pk2(p1[8 * k + 6], p1[8 * k + 7])};
  }
  const int q = (lane & 15) >> 2, p = lane & 3, gsel = (lane >> 4) & 1;
  const int vrow = (4 * hi + q) * 128 + 8 * (p & 1);
  const int chb = 2 * gsel + (p >> 1);
#pragma unroll
  for (int ks = 0; ks < 4; ++ks) {
    const int c0_ = ((chb | ((0 ^ (q >> 1)) << 2)) << 4), c1_ = ((chb | ((1 ^ (q >> 1)) << 2)) << 4);
    const s16x4 l0 = vtr(Vt + ks * 2048 + vrow + c0_), h0 = vtr(Vt + ks * 2048 + 1024 + vrow + c0_), l1 = vtr(Vt + ks * 2048 + vrow + c1_), h1 = vtr(Vt + ks * 2048 + 1024 + vrow + c1_);
    const bf16x8 va0 = (bf16x8){l0[0], l0[1], l0[2], l0[3], h0[0], h0[1], h0[2], h0[3]}, va1 = (bf16x8){l1[0], l1[1], l1[2], l1[3], h1[0], h1[1], h1[2], h1[3]};
    st.o0 = __builtin_amdgcn_mfma_f32_32x32x16_bf16(va0, __builtin_bit_cast(bf16x8, pw[ks]), st.o0, 0, 0, 0);
    st.o1 = __builtin_amdgcn_mfma_f32_32x32x16_bf16(va1, __builtin_bit_cast(bf16x8, pw[ks]), st.o1, 0, 0, 0);
  }
}
__device__ __forceinline__ void attn_store(const AttnState& st, float inv, const bf16* grow  , bf16* yrow  , int lane) {
  const int hi = lane >> 5;
  u32x2 gv[8];
#pragma unroll
  for (int i = 0; i < 8; ++i) gv[i] = *(const u32x2*)(grow + 32 * (i >> 2) + 8 * (i & 3) + 4 * hi);
  __builtin_amdgcn_sched_barrier(0);
#pragma unroll
  for (int d0 = 0; d0 < 2; ++d0)
#pragma unroll
    for (int gi = 0; gi < 4; ++gi) {
      const int db = 32 * d0 + 8 * gi + 4 * hi; const u32x2 g = gv[4 * d0 + gi];
      const f32x16& o = d0 == 0 ? st.o0 : st.o1;
      const float g0 = __uint_as_float(g.x << 16), g1 = __uint_as_float(g.x & 0xffff0000u), g2 = __uint_as_float(g.y << 16), g3 = __uint_as_float(g.y & 0xffff0000u);
      u32x2 ov; ov.x = pk2(o[4 * gi + 0] * inv * g0, o[4 * gi + 1] * inv * g1); ov.y = pk2(o[4 * gi + 2] * inv * g2, o[4 * gi + 3] * inv * g3);
      *(u32x2*)(yrow + db) = ov;
    }
}
template <int NH> struct TileRegs { u32x4 k[NH], v[NH]; };
template <int NH>
__device__ __forceinline__ void tile_load(TileRegs<NH>& R, const bf16* kbase  , const bf16* vbase, int tid) {
  const int key = tid >> 3, ch = tid & 7;
#pragma unroll
  for (int h = 0; h < NH; ++h) { R.k[h] = *(const u32x4*)(kbase + (size_t)key * PLW + h * 64 + ch * 8); R.v[h] = *(const u32x4*)(vbase + (size_t)key * PLW + h * 64 + ch * 8); }
}
template <int NH>
__device__ __forceinline__ void tile_store(const TileRegs<NH>& R, LAS unsigned char* buf, int tid) {
  const int key = tid >> 3, ch = tid & 7;
  const int ko = key * 128 + ((ch ^ ((key >> 1) & 7)) << 4), vo = key * 128 + ((ch ^ (((key >> 1) & 1) << 2)) << 4);
#pragma unroll
  for (int h = 0; h < NH; ++h) { *(LAS u32x4*)(buf + h * 8192 + ko) = R.k[h]; *(LAS u32x4*)(buf + NH * 8192 + h * 8192 + vo) = R.v[h]; }
}

template <int NH> struct TileRegs2 { TileRegs<NH> a, b; };
__device__ __forceinline__ void swa_item(const Frame& F0, const Args& a, int layer, int item) {
  const Frame F = relaunder(F0);
  unsigned char* ws = opq(a.ws);
  const bf16* PLB = (const bf16*)(ws + WS_PLB); bf16* Y = (bf16*)(ws + WS_H);
  const bool isctx = item >= 256;
  int b, kvh, n;
  if (!isctx) { b = item >> 6; kvh = (item >> 5) & 1; n = item & 31; } else { const int ci = item - 256; b = ci >> 2; kvh = (ci >> 1) & 1; n = ci & 1; }
  const int g = F.wave >> 2, quarter = F.wave & 3, hq = 2 * kvh + g, r32 = F.lane & 31, hi = F.lane >> 5;
  const int tq = 128 * n + 32 * quarter + r32;
  const size_t qrow = isctx ? (size_t)MLAT + b * CTX + tq : (size_t)b * SEQ + tq;
  bf16x8 qf[4];
#pragma unroll
  for (int s = 0; s < 4; ++s) qf[s] = *(const bf16x8*)(PLB + qrow * PLW + S_CQ * 256 + hq * 64 + 16 * s + 8 * hi);
  int jlo = 0, jhi = 0;
  if (!isctx) { jlo = n == 0 ? 1 : 0; jhi = n == 31 ? 2 : 3; }
  const int nloc = jhi - jlo, T = nloc + 2;
  const bf16* kcol = PLB + S_CKV * 256 + kvh * 64;
  auto tile_row = [&](int t) -> size_t { return t < nloc ? (size_t)b * SEQ + 128 * (n - 1 + jlo + t) : (size_t)MLAT + b * CTX + 128 * (t - nloc); };
  AttnState st; st.m = 0.f; st.l = 0.f;
#pragma unroll
  for (int i = 0; i < 16; ++i) { st.o0[i] = 0.f; st.o1[i] = 0.f; }
  TileRegs2<1> R;
  __syncthreads();
  { const size_t r0 = tile_row(0); tile_load<1>(R.a, kcol + r0 * PLW, kcol + 128 + r0 * PLW, F.tid); tile_load<1>(R.b, kcol + (r0 + 64) * PLW, kcol + 128 + (r0 + 64) * PLW, F.tid); }
  tile_store<1>(R.a, F.lds, F.tid); tile_store<1>(R.b, F.lds + 16384, F.tid);
  __syncthreads();
  for (int t = 0; t < T; ++t) {
    if (t + 1 < T) { const size_t r0 = tile_row(t + 1); tile_load<1>(R.a, kcol + r0 * PLW, kcol + 128 + r0 * PLW, F.tid); tile_load<1>(R.b, kcol + (r0 + 64) * PLW, kcol + 128 + (r0 + 64) * PLW, F.tid); }
    LAS const unsigned char* buf = F.lds + (t & 1) * 32768;
#pragma unroll
    for (int hf = 0; hf < 2; ++hf) {
      LAS const unsigned char* hb = buf + hf * 16384;
      if (t < nloc) {
        const int kb = 128 * (n - 1 + jlo + t) + 64 * hf, q0 = 128 * n + 32 * quarter;
        if (!(kb + 63 < q0 - 128 || kb > q0 + 31 + 128)) {
          const int dq = kb - tq;
          if (kb >= q0 + 31 - 128 && kb + 63 <= q0 + 128) attn_tile(st, qf, hb, hb + 8192, F.lane, [](f32x16&, f32x16&) {});
          else attn_tile(st, qf, hb, hb + 8192, F.lane, [&](f32x16& p0, f32x16& p1) {
#pragma unroll
            for (int r = 0; r < 16; ++r) { const int d0_ = dq + 128 + crow(r, hi), d1_ = d0_ + 32;
              p0[r] = ((unsigned)d0_ <= 256u) ? p0[r] : -INFINITY; p1[r] = ((unsigned)d1_ <= 256u) ? p1[r] : -INFINITY; } });
        }
      } else attn_tile(st, qf, hb, hb + 8192, F.lane, [](f32x16&, f32x16&) {});
    }
    if (t + 1 < T) { tile_store<1>(R.a, F.lds + ((t + 1) & 1) * 32768, F.tid); tile_store<1>(R.b, F.lds + ((t + 1) & 1) * 32768 + 16384, F.tid); }
    __syncthreads();
  }
  float l = st.l + __shfl_xor(st.l, 32);
  const float sk2 = opq(a.in[15])[layer * 4 + hq] * LOG2E;
  const float mnew = fmaxf(st.m, sk2), al = __builtin_amdgcn_exp2f(st.m - mnew);
  l = l * al + __builtin_amdgcn_exp2f(sk2 - mnew);
  int qr = (int)qrow; asm volatile("" : "+v"(qr));
  attn_store(st, al / l, PLB + (size_t)qr * PLW + S_CG * 256 + hq * 64, Y + (size_t)qr * 1024 + 512 + hq * 64, F.lane);
}
__device__ __forceinline__ void na_item(const Frame& F0, const Args& a, int layer, int item) {
  const Frame F = relaunder(F0);
  unsigned char* ws = opq(a.ws);
  const bf16* PLB = (const bf16*)(ws + WS_PLB); bf16* Y = (bf16*)(ws + WS_H);
  const bool isctx = item >= 256;
  int b, r;
  if (!isctx) { b = item >> 6; r = item & 63; } else { const int ci = item - 256; b = ci >> 2; r = ci & 3; }
  const int head = F.wave >> 1, half = F.wave & 1, r32 = F.lane & 31, hi = F.lane >> 5;
  const int qc = 32 * half + r32;
  const size_t qrow = isctx ? (size_t)MLAT + b * CTX + 64 * r + qc : (size_t)b * SEQ + 64 * r + qc;
  bf16x8 qf[4];
#pragma unroll
  for (int s = 0; s < 4; ++s) qf[s] = *(const bf16x8*)(PLB + qrow * PLW + S_DQ * 256 + head * 64 + 16 * s + 8 * hi);
  int rs = r - 4; rs = rs < 0 ? 0 : (rs > 56 ? 56 : rs);
  const int nloc = isctx ? 0 : 8, T = nloc + 4;
  auto tile_row = [&](int t) -> size_t { return t < nloc ? (size_t)b * SEQ + 64 * (rs + t) : (size_t)MLAT + b * CTX + 64 * (t - nloc); };
  const bf16* kcol = PLB + S_DK * 256; const bf16* vcol = PLB + S_DV * 256;
  LAS float* btab = (LAS float*)(F.lds + 2 * 65536);
  AttnState st; st.m = 0.f; st.l = 0.f;
#pragma unroll
  for (int i = 0; i < 16; ++i) { st.o0[i] = 0.f; st.o1[i] = 0.f; }
  TileRegs<4> R;
  __syncthreads();
  {
    const float* rb = opq(a.in[18]) + (size_t)layer * 4 * 15 * 31; float t_[15];
#pragma unroll
    for (int i = 0; i < 15; ++i) { const int ix = F.tid + 512 * i, hd = ix >> 7, dx = (ix & 127) - 63; const bool ok = dx >= -15 && dx <= 15; t_[i] = ok ? rb[hd * 31 + dx + 15] : 0.f; }
#pragma unroll
    for (int i = 0; i < 15; ++i) btab[F.tid + 512 * i] = t_[i] * LOG2E; }
  tile_load<4>(R, kcol + tile_row(0) * PLW, vcol + tile_row(0) * PLW, F.tid);
  tile_store<4>(R, F.lds, F.tid);
  __syncthreads();
  int c0 = qc - 8; c0 = c0 < 0 ? 0 : (c0 > 48 ? 48 : c0);
  for (int t = 0; t < T; ++t) {
    if (t + 1 < T) tile_load<4>(R, kcol + tile_row(t + 1) * PLW, vcol + tile_row(t + 1) * PLW, F.tid);
    LAS const unsigned char* buf = F.lds + (t & 1) * 65536;
    if (t < nloc) {
      const int dy = rs + t - r + 7;
      int c0l = c0; asm volatile("" : "+v"(c0l));
      LAS const float* bt = btab + (head * 15 + dy) * 128 + 63 - qc + 4 * hi;
      attn_tile(st, qf, buf + head * 8192, buf + 32768 + head * 8192, F.lane, [&](f32x16& p0, f32x16& p1) {
        float bb[16];
#pragma unroll
        for (int rr = 0; rr < 16; ++rr) bb[rr] = bt[(rr & 3) + 8 * (rr >> 2)];
#pragma unroll
        for (int rr = 0; rr < 16; ++rr) p0[rr] = ((unsigned)((rr & 3) + 8 * (rr >> 2) + 4 * hi - c0l) < 16u) ? p0[rr] + bb[rr] : -INFINITY;
#pragma unroll
        for (int rr = 0; rr < 16; ++rr) bb[rr] = bt[(rr & 3) + 8 * (rr >> 2) + 32];
#pragma unroll
        for (int rr = 0; rr < 16; ++rr) p1[rr] = ((unsigned)((rr & 3) + 8 * (rr >> 2) + 32 + 4 * hi - c0l) < 16u) ? p1[rr] + bb[rr] : -INFINITY; });
    } else attn_tile(st, qf, buf + head * 8192, buf + 32768 + head * 8192, F.lane, [](f32x16&, f32x16&) {});
    if (t + 1 < T) tile_store<4>(R, F.lds + ((t + 1) & 1) * 65536, F.tid);
    __syncthreads();
  }
  const float l = st.l + __shfl_xor(st.l, 32);
  int qr = (int)qrow; asm volatile("" : "+v"(qr));
  attn_store(st, 1.f / l, PLB + (size_t)qr * PLW + S_DG * 256 + head * 64, Y + (size_t)qr * 1024 + 768 + head * 64, F.lane);
}
}

namespace mk {
constexpr int XT_STRIDE = 272;
constexpr int FFT_WC = 256 * XT_STRIDE;
__device__ __forceinline__ void fft_item(const Frame& F0, const Args& a, int item) {
  const Frame F = relaunder(F0);
  unsigned char* ws = opq(a.ws);
  const bf16* PLB = (const bf16*)(ws + WS_PLB); bf16* Y = (bf16*)(ws + WS_H);
  const int b = item >> 6, slice = item & 63, r32 = F.lane & 31, hi = F.lane >> 5, w = F.wave;
  LAS unsigned char* Xt = F.lds; LAS unsigned char* Wl = F.lds + FFT_WC;
  __syncthreads();
  {
    const bf16* WC = (const bf16*)(ws + WS_WC);
    u32x4 wt[4];
#pragma unroll
    for (int i = 0; i < 4; ++i) { const int idx = F.tid + 512 * i, row = idx >> 4, ch = idx & 15; wt[i] = *(const u32x4*)(WC + row * 128 + ch * 8); }
    const bf16* src = (const bf16*)(ws + WS_FA2) + ((size_t)b * 64 + slice) * TROW * 8;
    u32x4 v[8];
#pragma unroll
    for (int i = 0; i < 8; ++i) v[i] = *(const u32x4*)(src + (size_t)(F.tid + 512 * i) * 8);
    __builtin_amdgcn_sched_barrier(0);
#pragma unroll
    for (int i = 0; i < 4; ++i) { const int idx = F.tid + 512 * i, row = idx >> 4, ch = idx & 15; *(LAS u32x4*)(Wl + row * XT_STRIDE + ch * 16) = wt[i]; }
#pragma unroll
    for (int i = 0; i < 8; ++i) { const int t = F.tid + 512 * i, n1 = t >> 6, n2 = t & 63;
      const unsigned vv[4] = {v[i].x, v[i].y, v[i].z, v[i].w};
#pragma unroll
      for (int j = 0; j < 8; ++j) { const int c = j & 3, part = j >> 2; const unsigned short e = (unsigned short)((j & 1) ? (vv[j >> 1] >> 16) : (vv[j >> 1] & 0xffffu));
        *(LAS unsigned short*)(Xt + (n2 * 4 + c) * XT_STRIDE + (part * 64 + n1) * 2) = e; } }
  }
  __syncthreads();
  f32x16 acc[4];
#pragma unroll
  for (int rb = 0; rb < 4; ++rb)
#pragma unroll
    for (int i = 0; i < 16; ++i) acc[rb][i] = 0.f;
  {
    bf16x8 bf[8];
#pragma unroll
    for (int s = 0; s < 8; ++s) bf[s] = *(LAS const bf16x8*)(Xt + (32 * w + r32) * XT_STRIDE + (16 * s + 8 * hi) * 2);
#pragma unroll
    for (int rb = 0; rb < 4; ++rb)
#pragma unroll
      for (int s = 0; s < 8; ++s) { const bf16x8 af = *(LAS const bf16x8*)(Wl + (32 * rb + r32) * XT_STRIDE + (16 * s + 8 * hi) * 2); acc[rb] = __builtin_amdgcn_mfma_f32_32x32x16_bf16(af, bf[s], acc[rb], 0, 0, 0); }
  }
  __syncthreads();
  {
    const int n2 = 8 * w + (r32 >> 2), c = r32 & 3;
#pragma unroll
    for (int rbp = 0; rbp < 2; ++rbp)
#pragma unroll
      for (int r = 0; r < 16; ++r) { const int k1 = 32 * rbp + crow(r, hi); float x = (float)((k1 * n2) & 4095) * (1.f / 4096.f);
        asm volatile("" : "+v"(x) :: "memory");
        const float tc = __builtin_amdgcn_cosf(x), ts = __builtin_amdgcn_sinf(x);
        const float yr = acc[rbp][r], yi = acc[rbp + 2][r];
        const float zr = yr * tc + yi * ts, zi = yi * tc - yr * ts;
        LAS unsigned char* zp = Xt + (k1 * 4 + c) * XT_STRIDE + n2 * 2;
        *(LAS unsigned short*)zp = (unsigned short)f2bf(zr); *(LAS unsigned short*)(zp + 128) = (unsigned short)f2bf(zi); }
  }
  __syncthreads();
  f32x16 o2[2];
#pragma unroll
  for (int rb = 0; rb < 2; ++rb)
#pragma unroll
    for (int i = 0; i < 16; ++i) o2[rb][i] = 0.f;
  {
    bf16x8 bf[8];
#pragma unroll
    for (int s = 0; s < 8; ++s) bf[s] = *(LAS const bf16x8*)(Xt + (32 * w + r32) * XT_STRIDE + (16 * s + 8 * hi) * 2);
#pragma unroll
    for (int rb = 0; rb < 2; ++rb)
#pragma unroll
      for (int s = 0; s < 8; ++s) { const bf16x8 af = *(LAS const bf16x8*)(Wl + (32 * rb + r32) * XT_STRIDE + (16 * s + 8 * hi) * 2); o2[rb] = __builtin_amdgcn_mfma_f32_32x32x16_bf16(af, bf[s], o2[rb], 0, 0, 0); }
  }
  __syncthreads();
  { const int k1 = 8 * w + (r32 >> 2), c = r32 & 3;
#pragma unroll
    for (int rb = 0; rb < 2; ++rb)
#pragma unroll
      for (int r = 0; r < 16; ++r) { const int k = k1 + 64 * (32 * rb + crow(r, hi)); *(LAS unsigned short*)(Xt + k * 8 + c * 2) = (unsigned short)f2bf(o2[rb][r]); }
  }
  __syncthreads();
  { const int o0 = 4 * slice; u32x2 gv[8];
#pragma unroll
    for (int i = 0; i < 8; ++i) gv[i] = *(const u32x2*)(PLB + ((size_t)b * SEQ + F.tid + 512 * i) * PLW + S_BG * 256 + o0);
    __builtin_amdgcn_sched_barrier(0);
#pragma unroll
    for (int i = 0; i < 8; ++i) { const int k = F.tid + 512 * i; const size_t row = (size_t)b * SEQ + k;
      const u32x2 ov = *(LAS const u32x2*)(Xt + k * 8);
      u32x2 y; y.x = pk2(__uint_as_float(ov.x << 16) * __uint_as_float(gv[i].x << 16), __uint_as_float(ov.x & 0xffff0000u) * __uint_as_float(gv[i].x & 0xffff0000u));
      y.y = pk2(__uint_as_float(ov.y << 16) * __uint_as_float(gv[i].y << 16), __uint_as_float(ov.y & 0xffff0000u) * __uint_as_float(gv[i].y & 0xffff0000u));
      *(u32x2*)(Y + row * 1024 + 256 + o0) = y; }
  }
}
constexpr int XC_STRIDE = 1040;
__device__ __forceinline__ void fftc_item(const Frame& F0, const Args& a, int item) {
  const Frame F = relaunder(F0);
  unsigned char* ws = opq(a.ws);
  const bf16* PLB = (const bf16*)(ws + WS_PLB); bf16* Y = (bf16*)(ws + WS_H);
  const bf16* CS = (const bf16*)(ws + WS_CS256);
  const int b = item >> 3, cs = item & 7, r32 = F.lane & 31, hi = F.lane >> 5, w = F.wave;
  LAS unsigned char* Xc = F.lds;
  __syncthreads();
  u32x4 vq[4];
#pragma unroll
  for (int i = 0; i < 4; ++i) { const int idx = F.tid + 512 * i, sl = idx >> 8, n = idx & 255;
    vq[i] = *(const u32x4*)((const bf16*)(ws + WS_FA2) + (((size_t)b * 64 + 8 * cs + sl) * TROW + SEQ + n) * 8); }
  __builtin_amdgcn_sched_barrier(0);
#pragma unroll
  for (int i = 0; i < 4; ++i) { const int idx = F.tid + 512 * i, sl = idx >> 8, n = idx & 255;
    const unsigned vv[4] = {vq[i].x, vq[i].y, vq[i].z, vq[i].w};
#pragma unroll
    for (int j = 0; j < 8; ++j) { const int c = j & 3, part = j >> 2; const unsigned short e = (unsigned short)((j & 1) ? (vv[j >> 1] >> 16) : (vv[j >> 1] & 0xffffu));
      *(LAS unsigned short*)(Xc + (4 * sl + c) * XC_STRIDE + (part * 256 + n) * 2) = e; } }
  __syncthreads();
  f32x16 acc;
#pragma unroll
  for (int i = 0; i < 16; ++i) acc[i] = 0.f;
#pragma unroll 8
  for (int s = 0; s < 32; ++s) {
    const bf16x8 af = *(const bf16x8*)(CS + (size_t)(32 * w + r32) * 512 + 16 * s + 8 * hi);
    const bf16x8 bf = *(LAS const bf16x8*)(Xc + r32 * XC_STRIDE + (16 * s + 8 * hi) * 2);
    acc = __builtin_amdgcn_mfma_f32_32x32x16_bf16(af, bf, acc, 0, 0, 0);
  }
  const int o = 32 * cs + r32;
#pragma unroll
  for (int r = 0; r < 16; ++r) { const size_t row = (size_t)MLAT + b * CTX + 32 * w + crow(r, hi);
    Y[row * 1024 + 256 + o] = (bf16)f2bf(acc[r] * bf2f(PLB[row * PLW + S_BG * 256 + o])); }
}
}

namespace mk {
constexpr int GU_STRIDE = 2048 + 64;
constexpr size_t WS_GU = WS_SCR, WS_GS = WS_GU + (size_t)32 * 68 * GU_STRIDE * 4;
__device__ __forceinline__ size_t gla_row(int b, int c, int i) { return c < 64 ? (size_t)b * SEQ + 64 * c + i : (size_t)MLAT + b * CTX + 64 * (c - 64) + i; }
__device__ __forceinline__ int gla_pos(int c, int dir) { return c < 64 ? (dir ? 4 + 63 - c : 4 + c) : (dir ? 3 - (c - 64) : (c - 64)); }
__device__ __forceinline__ void gla_stage_v(const Frame& F, const bf16* PLB, int b, int c, LAS unsigned char* vbase) {
  const int key = F.tid >> 3, ch = F.tid & 7;
  const bf16* src = PLB + gla_row(b, c, key) * PLW + S_AV * 256 + ch * 8;
  const int vo = key * 128 + ((ch ^ (((key >> 1) & 1) << 2)) << 4);
  u32x4 t_[4];
#pragma unroll
  for (int h = 0; h < 4; ++h) t_[h] = *(const u32x4*)(src + h * 64);
#pragma unroll
  for (int h = 0; h < 4; ++h) *(LAS u32x4*)(vbase + h * 8192 + vo) = t_[h];
}
__device__ __forceinline__ void gla_cum(const float* LA, int b, int c, int h, int dir, int lane, float (&cw)[32], float& T) {
  const int d = lane & 31, half = lane >> 5;
  float a[32];
#pragma unroll
  for (int ii = 0; ii < 32; ++ii) a[ii] = LA[gla_row(b, c, 32 * half + ii) * 256 + dir * 128 + h * 32 + d];
  float run = 0.f;
#pragma unroll
  for (int ii = 0; ii < 32; ++ii) { run += a[ii]; cw[ii] = run; }
  const float other = __shfl_xor(run, 32);
  const float tot0 = half ? other : run;
  T = run + other;
#pragma unroll
  for (int ii = 0; ii < 32; ++ii) { const float cf = cw[ii] + (half ? tot0 : 0.f); cw[ii] = dir ? (T - cf + a[ii]) : cf; }
}
constexpr int KT_STRIDE = 144;
__device__ __forceinline__ void gla_local_item(const Frame& F0, const Args& a, int item) {
  const Frame F = relaunder(F0);
  unsigned char* ws = opq(a.ws);
  const bf16* PLB = (const bf16*)(ws + WS_PLB); const float* LA = (const float*)(ws + WS_LA);
  const int b = item / 68, c = item % 68, h = F.wave >> 1, dir = F.wave & 1, d = F.lane & 31, half = F.lane >> 5, r32 = d, hi = half;
  LAS unsigned char* Vt = F.lds + h * 8192; LAS unsigned char* KT = F.lds + 32768 + F.wave * (32 * KT_STRIDE);
  __syncthreads();
  gla_stage_v(F, PLB, b, c, F.lds);
  float cw[32], T;
  gla_cum(LA, b, c, h, dir, F.lane, cw, T);
  {
    unsigned pkd[16]; bf16 kr[32];
    const bf16* kp = PLB + gla_row(b, c, 32 * half) * PLW + S_AQK * 256 + 128 + h * 32 + d;
#pragma unroll
    for (int ii = 0; ii < 32; ++ii) kr[ii] = kp[(size_t)ii * PLW];
#pragma unroll
    for (int ii = 0; ii < 32; ii += 2) pkd[ii >> 1] = pk2(bf2f(kr[ii]) * __expf(T - cw[ii]), bf2f(kr[ii + 1]) * __expf(T - cw[ii + 1]));
#pragma unroll
    for (int q4 = 0; q4 < 4; ++q4) *(LAS u32x4*)(KT + d * KT_STRIDE + half * 64 + q4 * 16) = (u32x4){pkd[4 * q4], pkd[4 * q4 + 1], pkd[4 * q4 + 2], pkd[4 * q4 + 3]};
  }
  __syncthreads();
  f32x16 acc[2];
#pragma unroll
  for (int eb = 0; eb < 2; ++eb)
#pragma unroll
    for (int i = 0; i < 16; ++i) acc[eb][i] = 0.f;
  const int q = (F.lane & 15) >> 2, p = F.lane & 3, gsel = (F.lane >> 4) & 1;
  const int chb = 2 * gsel + (p >> 1);
#pragma unroll
  for (int st = 0; st < 4; ++st) {
    const bf16x8 kb = *(LAS const bf16x8*)(KT + r32 * KT_STRIDE + (16 * st + 8 * hi) * 2);
#pragma unroll
    for (int eb = 0; eb < 2; ++eb) {
      const int ch = ((chb | ((eb ^ (q >> 1)) << 2)) << 4);
      LAS const unsigned char* vp = Vt + (16 * st + 8 * hi + q) * 128 + 8 * (p & 1) + ch;
      const s16x4 lo = vtr(vp), hh = vtr(vp + 512);
      const bf16x8 va = (bf16x8){lo[0], lo[1], lo[2], lo[3], hh[0], hh[1], hh[2], hh[3]};
      acc[eb] = __builtin_amdgcn_mfma_f32_32x32x16_bf16(va, kb, acc[eb], 0, 0, 0);
    }
  }
  const int chain = (b * 4 + h) * 2 + dir, pos = gla_pos(c, dir);
  float* gu = (float*)(ws + WS_GU) + ((size_t)chain * 68 + pos) * GU_STRIDE;
#pragma unroll
  for (int eb = 0; eb < 2; ++eb)
#pragma unroll
    for (int r = 0; r < 16; ++r) gu[(32 * eb + crow(r, hi)) * 32 + r32] = acc[eb][r];
  if (half == 0) gu[2048 + d] = __expf(T);
}
__device__ __forceinline__ void gla_scan(const Frame& F0, const Args& a) {
  const Frame F = relaunder(F0);
  unsigned char* ws = opq(a.ws);
  const int gt = F.vcu * 512 + F.tid;
  if (gt >= 32 * 2048) return;
  const int chain = gt >> 11, el = gt & 2047, d = el & 31;
  const float* gu = (const float*)(ws + WS_GU) + (size_t)chain * 68 * GU_STRIDE;
  bf16* gs = (bf16*)(ws + WS_GS) + (size_t)chain * 68 * 2048 + el;
  float S = 0.f;
#pragma unroll 34
  for (int pos = 0; pos < 68; ++pos) { gs[(size_t)pos * 2048] = (bf16)f2bf(S); S = gu[(size_t)pos * GU_STRIDE + 2048 + d] * S + gu[(size_t)pos * GU_STRIDE + el]; }
}
constexpr int QK_STRIDE = 80;
__device__ __forceinline__ void gla_out_item(const Frame& F0, const Args& a, int layer, int item) {
  const Frame F = relaunder(F0);
  unsigned char* ws = opq(a.ws);
  const bf16* PLB = (const bf16*)(ws + WS_PLB); const float* LA = (const float*)(ws + WS_LA); bf16* Y = (bf16*)(ws + WS_H);
  const int b = item / 68, c = item % 68, h = F.wave >> 1, dir = F.wave & 1, d = F.lane & 31, half = F.lane >> 5, r32 = d, hi = half;
  LAS unsigned char* Vt = F.lds + h * 8192;
  LAS unsigned char* QT = F.lds + 32768 + F.wave * (2 * 64 * QK_STRIDE); LAS unsigned char* KT = QT + 64 * QK_STRIDE;
  LAS float* X = (LAS float*)(F.lds + 32768) + h * 4096;
  __syncthreads();
  gla_stage_v(F, PLB, b, c, F.lds);
  {
    float cw[32], T;
    gla_cum(LA, b, c, h, dir, F.lane, cw, T);
    bf16 qr[32], kr[32];
    const bf16* pr = PLB + gla_row(b, c, 32 * half) * PLW + S_AQK * 256 + h * 32 + d;
#pragma unroll
    for (int ii = 0; ii < 32; ++ii) { qr[ii] = pr[(size_t)ii * PLW]; kr[ii] = pr[(size_t)ii * PLW + 128]; }
#pragma unroll
    for (int ii = 0; ii < 32; ++ii) { const int i = 32 * half + ii;
      const float ec = __expf(cw[ii]);
      *(LAS unsigned short*)(QT + i * QK_STRIDE + d * 2) = (unsigned short)f2bf(bf2f(qr[ii]) * ec);
      *(LAS unsigned short*)(KT + i * QK_STRIDE + d * 2) = (unsigned short)f2bf(bf2f(kr[ii]) * __builtin_amdgcn_rcpf(ec)); }
  }
  __syncthreads();
  f32x16 oacc[2][2];
#pragma unroll
  for (int eb = 0; eb < 2; ++eb)
#pragma unroll
    for (int ib = 0; ib < 2; ++ib)
#pragma unroll
      for (int i = 0; i < 16; ++i) oacc[eb][ib][i] = 0.f;
  bf16x8 qb[2][2];
#pragma unroll
  for (int ib = 0; ib < 2; ++ib)
#pragma unroll
    for (int st = 0; st < 2; ++st) qb[ib][st] = *(LAS const bf16x8*)(QT + (32 * ib + r32) * QK_STRIDE + (16 * st + 8 * hi) * 2);
  const int chain = (b * 4 + h) * 2 + dir, pos = gla_pos(c, dir);
  {
    const bf16* gs = (const bf16*)(ws + WS_GS) + ((size_t)chain * 68 + pos) * 2048;
#pragma unroll
    for (int eb = 0; eb < 2; ++eb)
#pragma unroll
      for (int st = 0; st < 2; ++st) { const bf16x8 sf = *(const bf16x8*)(gs + (32 * eb + r32) * 32 + 16 * st + 8 * hi);
#pragma unroll
        for (int ib = 0; ib < 2; ++ib) oacc[eb][ib] = __builtin_amdgcn_mfma_f32_32x32x16_bf16(sf, qb[ib][st], oacc[eb][ib], 0, 0, 0); }
  }
  const int q = (F.lane & 15) >> 2, p = F.lane & 3, gsel = (F.lane >> 4) & 1;
  const int vrow = (4 * hi + q) * 128 + 8 * (p & 1), chb = 2 * gsel + (p >> 1);
#pragma unroll
  for (int sb = 0; sb < 2; ++sb) {
    bf16x8 kf[2];
#pragma unroll
    for (int st = 0; st < 2; ++st) kf[st] = *(LAS const bf16x8*)(KT + (32 * sb + r32) * QK_STRIDE + (16 * st + 8 * hi) * 2);
#pragma unroll
    for (int ib = 0; ib < 2; ++ib) {
      const bool need = dir == 0 ? (sb <= ib) : (sb >= ib);
      if (!need) continue;
      f32x16 sc;
#pragma unroll
      for (int i = 0; i < 16; ++i) sc[i] = 0.f;
#pragma unroll
      for (int st = 0; st < 2; ++st) sc = __builtin_amdgcn_mfma_f32_32x32x16_bf16(kf[st], qb[ib][st], sc, 0, 0, 0);
      if (sb == ib) {
#pragma unroll
        for (int r = 0; r < 16; ++r) { const int s = crow(r, hi); const bool keep = dir == 0 ? (s <= r32) : (s >= r32); sc[r] = keep ? sc[r] : 0.f; }
      }
      u32x4 pw[2];
#pragma unroll
      for (int k = 0; k < 2; ++k) pw[k] = (u32x4){pk2(sc[8 * k + 0], sc[8 * k + 1]), pk2(sc[8 * k + 2], sc[8 * k + 3]), pk2(sc[8 * k + 4], sc[8 * k + 5]), pk2(sc[8 * k + 6], sc[8 * k + 7])};
#pragma unroll
      for (int ks = 0; ks < 2; ++ks)
#pragma unroll
        for (int eb = 0; eb < 2; ++eb) {
          const int ch = ((chb | ((eb ^ (q >> 1)) << 2)) << 4);
          const s16x4 lo = vtr(Vt + (2 * sb + ks) * 2048 + vrow + ch), hh = vtr(Vt + (2 * sb + ks) * 2048 + 1024 + vrow + ch);
          const bf16x8 va = (bf16x8){lo[0], lo[1], lo[2], lo[3], hh[0], hh[1], hh[2], hh[3]};
          oacc[eb][ib] = __builtin_amdgcn_mfma_f32_32x32x16_bf16(va, __builtin_bit_cast(bf16x8, pw[ks]), oacc[eb][ib], 0, 0, 0);
        }
    }
  }
  __syncthreads();
  if (dir == 1) {
#pragma unroll
    for (int eb = 0; eb < 2; ++eb)
#pragma unroll
      for (int ib = 0; ib < 2; ++ib)
#pragma unroll
        for (int r = 0; r < 16; ++r) X[((eb * 2 + ib) * 16 + r) * 64 + F.lane] = oacc[eb][ib][r];
  }
  __syncthreads();
  if (dir == 0) {
    const float* on = opq(a.in[11]) + layer * 64;
#pragma unroll
    for (int ib = 0; ib < 2; ++ib) {
      float ss = 0.f;
#pragma unroll
      for (int eb = 0; eb < 2; ++eb)
#pragma unroll
        for (int r = 0; r < 16; ++r) { oacc[eb][ib][r] += X[((eb * 2 + ib) * 16 + r) * 64 + F.lane]; ss += oacc[eb][ib][r] * oacc[eb][ib][r]; }
      ss += __shfl_xor(ss, 32);
      const float rs = 1.0f / sqrtf(ss * (1.f / 64.f) + 1e-6f);
      const size_t row = gla_row(b, c, 32 * ib + r32);
      u32x2 gv8[8];
#pragma unroll
      for (int i = 0; i < 8; ++i) gv8[i] = *(const u32x2*)(PLB + row * PLW + S_AG * 256 + h * 64 + 32 * (i >> 2) + 8 * (i & 3) + 4 * hi);
      __builtin_amdgcn_sched_barrier(0);
#pragma unroll
      for (int eb = 0; eb < 2; ++eb)
#pragma unroll
        for (int gi = 0; gi < 4; ++gi) {
          const int e0 = 32 * eb + 8 * gi + 4 * hi;
          const f32x4 w4 = *(const f32x4*)(on + e0);
          const u32x2 gv = gv8[4 * eb + gi];
          const float g0 = __uint_as_float(gv.x << 16), g1 = __uint_as_float(gv.x & 0xffff0000u), g2 = __uint_as_float(gv.y << 16), g3 = __uint_as_float(gv.y & 0xffff0000u);
          u32x2 ov; ov.x = pk2(oacc[eb][ib][4 * gi + 0] * rs * w4[0] * g0, oacc[eb][ib][4 * gi + 1] * rs * w4[1] * g1);
          ov.y = pk2(oacc[eb][ib][4 * gi + 2] * rs * w4[2] * g2, oacc[eb][ib][4 * gi + 3] * rs * w4[3] * g3);
          *(u32x2*)(Y + row * 1024 + h * 64 + e0) = ov;
        }
    }
  }
}
}

namespace mk {
__device__ __forceinline__ void p3_mixers(const Frame& F0, const Args& a, int layer) {
  const Frame F = relaunder(F0);
  const int nx = layer == 0 ? 16 : 0, nswa = 256 + nx, nna = 256 + nx, nfc = layer == 0 ? 32 : 0;
  for (int it = F.vcu; it < 272 + 256 + nfc + nswa + nna; it += F.G) {
    int r = it;
    if (r < 272) { gla_local_item(F, a, r); continue; } r -= 272;
    if (r < 256) { fft_item(F, a, r); continue; } r -= 256;
    if (r < nfc) { fftc_item(F, a, r); continue; } r -= nfc;
    if (r < nswa) swa_item(F, a, layer, r); else na_item(F, a, layer, r - nswa);
  }
}
__device__ __forceinline__ void p4b_glaout(const Frame& F0, const Args& a, int layer) {
  const Frame F = relaunder(F0);
  for (int it = F.vcu; it < 272; it += F.G) { if (layer == 1 && (it % 68) >= 64) continue; gla_out_item(F, a, layer, it); }
}
}
#define XB_TMO      128
#define XB_XCNT(j)  (256  + 64 * (j))
#define XB_XSUB(j)  (1280 + 64 * (j))
#define XB_XGEN(j)  (2304 + 64 * (j))
#define XB_TOP      3328
#define XB_TOPGEN   3392
#define XCD_BAR_WORDS 3456
#define XB_SPIN_CAP (1u << 18)

__device__ __forceinline__ unsigned xb_ld(unsigned* p)              { return __hip_atomic_load(p, __ATOMIC_RELAXED, __HIP_MEMORY_SCOPE_AGENT); }
__device__ __forceinline__ unsigned xb_add(unsigned* p, unsigned v) { return __hip_atomic_fetch_add(p, v, __ATOMIC_RELAXED, __HIP_MEMORY_SCOPE_AGENT); }
__device__ __forceinline__ unsigned xb_xcc_id() { return (unsigned)__builtin_amdgcn_s_getreg((3 << 11) | 20) & 0xFu; }
#define XB_SPIN(cond, bar) do { unsigned _sp = 0; while (cond) { __builtin_amdgcn_s_sleep(1); \
    if ((++_sp & 255u) == 0u) { if (xb_ld(&(bar)[XB_TMO])) break; if (_sp > XB_SPIN_CAP) { atomicAdd(&(bar)[XB_TMO], 1u); break; } } } } while (0)

struct XcdBarrier {
    unsigned* bar; unsigned x;
    volatile LAS unsigned* st;
};

__device__ __forceinline__ XcdBarrier xcd_barrier_post(unsigned* bar, volatile LAS unsigned* st) {
    XcdBarrier b; b.bar = bar; b.x = xb_xcc_id(); b.st = st;
    if (threadIdx.x == 0) (void)xb_add(&bar[XB_XCNT(b.x)], 1u);
    return b;
}
__device__ __forceinline__ void xcd_barrier_complete(unsigned* bar, unsigned x, unsigned& nloc, unsigned& nx) {
    const unsigned G = gridDim.x * gridDim.y * gridDim.z;
    unsigned sum, cnt, mine, sp = 0u;
    for (;;) {
        sum = 0u; cnt = 0u; mine = 0u;
#pragma unroll
        for (unsigned j = 0; j < 16; ++j) { const unsigned c = xb_ld(&bar[XB_XCNT(j)]); sum += c; cnt += (c > 0u) ? 1u : 0u; }
        mine = xb_ld(&bar[XB_XCNT(x)]);
        if (sum == G) break;
        __builtin_amdgcn_s_sleep(1);
        if ((++sp & 255u) == 0u) { if (xb_ld(&bar[XB_TMO])) break; if (sp > XB_SPIN_CAP) { atomicAdd(&bar[XB_TMO], 1u); break; } }
    }
    nloc = mine > 0u ? mine : 1u; nx = cnt > 0u ? cnt : 1u;
}

__device__ __forceinline__ void xcd_barrier(const XcdBarrier& b) {
    asm volatile("s_waitcnt vmcnt(0)" ::: "memory");
    __syncthreads();
    if (threadIdx.x == 0) {
        unsigned* bar = b.bar;
        __builtin_amdgcn_s_waitcnt(0);
        unsigned nloc = b.st[0], nx = b.st[1];
        if (nloc == 0u) { xcd_barrier_complete(bar, b.x, nloc, nx); b.st[0] = nloc; b.st[1] = nx; }
        const unsigned old = xb_add(&bar[XB_XSUB(b.x)], 1u);
        const unsigned gen = old / nloc;
        if (old + 1u == (gen + 1u) * nloc) {
            __builtin_amdgcn_fence(__ATOMIC_RELEASE, "agent");
            asm volatile("s_waitcnt vmcnt(0)" ::: "memory");
            const unsigned og = xb_add(&bar[XB_TOP], 1u);
            const unsigned tg = og / nx;
            if (og + 1u == (tg + 1u) * nx) xb_add(&bar[XB_TOPGEN], 1u);
            else XB_SPIN(xb_ld(&bar[XB_TOPGEN]) == tg, bar);
            __builtin_amdgcn_fence(__ATOMIC_ACQUIRE, "agent");
            xb_add(&bar[XB_XGEN(b.x)], 1u);
            asm volatile("s_waitcnt vmcnt(0)" ::: "memory");
        } else {
            XB_SPIN(xb_ld(&bar[XB_XGEN(b.x)]) == gen, bar);
            __builtin_amdgcn_fence(__ATOMIC_ACQUIRE, "agent");
            asm volatile("s_waitcnt vmcnt(0)" ::: "memory");
        }
    }
    __syncthreads();
}

constexpr int LDS_BYTES = 163840, MISC_OFF = LDS_BYTES - 256;
constexpr int CW_BAR = 4096;
__global__ void __launch_bounds__(512, 2) mega(mk::Args a) {
  extern __shared__ __attribute__((aligned(16))) unsigned char lds[];
  mk::Frame F;
  F.lds = (LAS unsigned char*)lds;
  F.tid = threadIdx.x; F.lane = F.tid & 63; F.wave = __builtin_amdgcn_readfirstlane(F.tid >> 6);
  F.G = gridDim.x; { const int bx = blockIdx.x; F.vcu = (F.G % 8 == 0) ? (bx % 8) * (F.G / 8) + bx / 8 : bx; }
  volatile LAS unsigned* MISC = (volatile LAS unsigned*)(F.lds + MISC_OFF);
  if (F.tid < 64) MISC[F.tid] = 0u;
  __syncthreads();
  XcdBarrier bar; bar.bar = nullptr; bar.x = 0; bar.st = nullptr;
  const bool multi = (a.ph_hi - a.ph_lo) > 1;
  if (multi) bar = xcd_barrier_post((unsigned*)(a.ws + mk::WS_CTL) + CW_BAR, MISC + 8);
#pragma clang loop unroll(disable)
  for (int ph = a.ph_lo; ph < a.ph_hi; ++ph) {
    if (ph == 0) mk::p0_prologue(F, a);
    else {
      const int layer = (ph - 1) / 6, sub = (ph - 1) % 6;
      if (sub == 0) mk::p1_prenorm(F, a, layer);
      else if (sub == 1) mk::p2_inproj(F, a, layer);
      else if (sub == 2) mk::p3_mixers(F, a, layer);
      else if (sub == 3) mk::gla_scan(F, a);
      else if (sub == 4) mk::p4b_glaout(F, a, layer);
      else mk::p5_outproj(F, a, layer);
    }
    if (ph + 1 < a.ph_hi) xcd_barrier(bar);
  }
}

extern "C" void kernel_launch(void* const* d_in, const int* in_sizes, int n_in, void* d_out, int out_size, void* d_ws, size_t ws_size, hipStream_t stream) {
  using namespace mk;
  static int grid = 0;
  if (grid == 0) {
    int dev = 0, cus = 0, per_cu = 0; (void)hipGetDevice(&dev); (void)hipDeviceGetAttribute(&cus, hipDeviceAttributeMultiprocessorCount, dev);
    (void)hipFuncSetAttribute((const void*)mega, hipFuncAttributeMaxDynamicSharedMemorySize, LDS_BYTES);
    if (hipOccupancyMaxActiveBlocksPerMultiprocessor(&per_cu, (const void*)mega, 512, LDS_BYTES) != hipSuccess || per_cu < 1) per_cu = 1;
    (void)hipGetLastError();
    grid = (cus > 0 ? cus : 256) * (per_cu < 1 ? 1 : 1);
  }
  (void)hipMemsetAsync((char*)d_ws + WS_CTL, 0, CTL_BYTES, stream);
  Args a{};
  for (int i = 0; i < 19; ++i) a.in[i] = (const float*)d_in[i];
  a.out = (float*)d_out; a.ws = (unsigned char*)d_ws;
  a.ph_lo = 0; a.ph_hi = 13;
  void* args[] = {&a};
  if (hipLaunchCooperativeKernel((const void*)mega, dim3(grid), dim3(512), args, LDS_BYTES, stream) != hipSuccess) {
    (void)hipGetLastError();
    hipLaunchKernelGGL(mega, dim3(grid), dim3(512), LDS_BYTES, stream, a);
  }
}
```

```cpp
#include <hip/hip_runtime.h>
#include <math.h>
#include <stdint.h>

namespace pg8 {
#define PG8_LAS __attribute__((address_space(3)))
typedef unsigned short bf16_t;
typedef short bf16x8 __attribute__((ext_vector_type(8)));
typedef float f32x4 __attribute__((ext_vector_type(4)));
typedef unsigned u32x4 __attribute__((ext_vector_type(4)));
constexpr int BM = 256, BK = 64, HALF = 128, HTB = HALF * BK * 2  , STAGE_BYTES = 8 * HTB, NXCD = 8, WGM = 8;

__host__ __device__ __forceinline__ int lds_byte(int r, int c) { const int st = (r >> 4) * 2 + (c >> 5), rr = r & 15, cc = c & 31, ob = rr * 64 + cc * 2; return st * 1024 + (ob ^ (((ob >> 9) & 1) << 5)); }
__host__ __device__ __forceinline__ void stage_rc(int b, int& R, int& C) { const int st = b / 1024, sb = b % 1024, swz = sb ^ (((sb >> 9) & 1) << 5); R = (st >> 1) * 16 + swz / 64; C = (st & 1) * 32 + (swz % 64) / 2; }
__host__ __device__ __forceinline__ int perm32(int rho) { const int n = rho >> 4, i = rho & 15; return 8 * (i >> 2) + 4 * n + (i & 3); }

struct Unit { int pm, pn; };
struct Gemm { const bf16_t* A; const bf16_t* Bt; int M, N, K; };

struct StaticOrder {
    int nM, nN, nwg, G, c;
    __host__ __device__ void init(int M, int N, int G_, int c_) { nM = M / BM; nN = N / BM; nwg = nM * nN; G = G_; c = c_; }
    __host__ __device__ bool next(int i, Unit& u) const {
        const long L = (long)i * G + c; if (L >= nwg) return false;
        int wgid = (int)L; { const int q = nwg / NXCD, r = nwg % NXCD, xcd = wgid % NXCD, off = wgid / NXCD; wgid = (xcd < r ? xcd * (q + 1) : r * (q + 1) + (xcd - r) * q) + off; }
        const int nig = WGM * nN, gid = wgid / nig, fm = gid * WGM, gsz = (nM - fm) < WGM ? (nM - fm) : WGM;
        u.pm = fm + ((wgid % nig) % gsz); u.pn = (wgid % nig) / gsz; return true;
    }
    __device__ __forceinline__ void a_ready(const Unit&) const {}
    __device__ __forceinline__ void done(const Unit&) const {}
};

template <class Epi, class Sched, bool STAMP = false>
__device__ __forceinline__ void gemm_phase(PG8_LAS unsigned char* lds, const Gemm g, const Sched& S, const Epi& E, unsigned long long* stamps) {
    int tid_ = threadIdx.x; asm volatile("" : "+v"(tid_));
    const int tid = tid_, wid = __builtin_amdgcn_readfirstlane(tid >> 6), lane = tid & 63, wr = wid >> 2, wc = wid & 3, fr = lane & 15, fq = lane >> 4;
    const int K = g.K, nt = K / BK;
    int ts_lo = 0, ts_hi = 0, nts = 0; const unsigned long long rt_entry = STAMP ? (unsigned long long)wall_clock64() : 0ull;
#define PG8_STAMP() do { if (STAMP && wid == 0 && nts < 64) { const unsigned long long _c = (unsigned long long)clock64(); \
        ts_lo = (lane == nts) ? (int)(unsigned)_c : ts_lo; ts_hi = (lane == nts) ? (int)(unsigned)(_c >> 32) : ts_hi; ++nts; } } while (0)
    PG8_STAMP();
    unsigned voffA[2], voffB[2];
#pragma unroll
    for (int i = 0; i < 2; ++i) { int R, C; stage_rc(tid * 16 + i * 8192, R, C); const int Rb = Epi::PERM ? ((R & ~31) + perm32(R & 31)) : R;
        voffA[i] = (unsigned)(R * K + C) * 2u; voffB[i] = (unsigned)(Rb * K + C) * 2u; }
    const size_t kstep = (size_t)(BK * 2);
    const size_t hstep = (size_t)HALF * K * 2;
    const size_t tstep = 2 * hstep;
    const unsigned ldsw = (unsigned)wid * 1024u;
    const int aoff = lds_byte(wr * 64 + fr, fq * 8), boff = lds_byte(wc * 32 + fr, fq * 8);
#define PG8_SA(b, h) (((b) * 2 + (h)) * HTB)
#define PG8_SB(b, h) ((4 + (b) * 2 + (h)) * HTB)
#define PG8_STAGE(bufoff, gbase, voff) do { _Pragma("unroll") for (int _i = 0; _i < 2; ++_i) \
        __builtin_amdgcn_global_load_lds((const unsigned*)((const char*)(gbase) + (voff)[_i]), (PG8_LAS unsigned*)(lds + (bufoff) + ldsw + _i * 8192), 16, 0, 0); } while (0)
#define PG8_LDA(dst, b, h) do { _Pragma("unroll") for (int m = 0; m < 4; ++m) _Pragma("unroll") for (int k = 0; k < 2; ++k) dst[m][k] = *(const PG8_LAS bf16x8*)(lds + PG8_SA(b, h) + aoff + m * 2048 + k * 1024); } while (0)
#define PG8_LDB(dst, b, h) do { _Pragma("unroll") for (int n = 0; n < 2; ++n) _Pragma("unroll") for (int k = 0; k < 2; ++k) dst[n][k] = *(const PG8_LAS bf16x8*)(lds + PG8_SB(b, h) + boff + n * 2048 + k * 1024); } while (0)
#define PG8_MMA(ai, bj, At, Bt) do { __builtin_amdgcn_s_setprio(1); _Pragma("unroll") for (int m = 0; m < 4; ++m) _Pragma("unroll") for (int n = 0; n < 2; ++n) _Pragma("unroll") for (int k = 0; k < 2; ++k) \
        acc[ai][bj][m][n] = __builtin_amdgcn_mfma_f32_16x16x32_bf16(Bt[n][k], At[m][k], acc[ai][bj][m][n], 0, 0, 0); __builtin_amdgcn_s_setprio(0); } while (0)
#define PG8_WAIT_V(n) asm volatile("s_waitcnt vmcnt(" #n ")" ::: "memory")
#define PG8_WAIT_L(n) asm volatile("s_waitcnt lgkmcnt(" #n ")" ::: "memory")
#define PG8_BAR __builtin_amdgcn_s_barrier()
#define PG8_SCHED __builtin_amdgcn_sched_barrier(0)
    Unit cur, nxt; int ui = 0;
    if (!S.next(0, cur)) return;
    f32x4 acc[2][2][4][2];
#pragma unroll
    for (int a = 0; a < 2; ++a)
#pragma unroll
        for (int b = 0; b < 2; ++b)
#pragma unroll
            for (int m = 0; m < 4; ++m)
#pragma unroll
                for (int n = 0; n < 2; ++n) acc[a][b][m][n] = (f32x4){0.f, 0.f, 0.f, 0.f};
    bf16x8 At[4][2], B0[2][2], B1[2][2];
    const char* cA = (const char*)g.A + (size_t)cur.pm * tstep; const char* cB = (const char*)g.Bt + (size_t)cur.pn * tstep;
    S.a_ready(cur);
    PG8_STAGE(PG8_SB(0, 0), cB, voffB); PG8_STAGE(PG8_SA(0, 0), cA, voffA); PG8_STAGE(PG8_SB(0, 1), cB + hstep, voffB); PG8_STAGE(PG8_SA(0, 1), cA + hstep, voffA);
    if (wr == 1) PG8_BAR;
    PG8_WAIT_V(4); PG8_BAR;
    PG8_STAGE(PG8_SB(1, 0), cB + kstep, voffB); PG8_STAGE(PG8_SA(1, 0), cA + kstep, voffA); PG8_STAGE(PG8_SB(1, 1), cB + hstep + kstep, voffB);
    PG8_WAIT_V(6); PG8_BAR;
    PG8_STAMP();
    for (;;) {
        const bool has_next = S.next(ui + 1, nxt);
        const char* nA = has_next ? (const char*)g.A + (size_t)nxt.pm * tstep : cA; const char* nB = has_next ? (const char*)g.Bt + (size_t)nxt.pn * tstep : cB;
        for (int t = 0; t < nt; t += 2) {
            const bool last = (t == nt - 2);
            const char* a1 = cA + (size_t)(t + 1) * kstep;
            const char* a2 = last ? nA : cA + (size_t)(t + 2) * kstep; const char* b2 = last ? nB : cB + (size_t)(t + 2) * kstep;
            const char* a3 = a2 + kstep; const char* b3 = b2 + kstep;
            if (last && has_next) S.a_ready(nxt);
            PG8_LDB(B0, 0, 0); PG8_SCHED; PG8_LDA(At, 0, 0); PG8_STAGE(PG8_SA(1, 1), a1 + hstep, voffA);
            PG8_WAIT_L(8); PG8_BAR; PG8_WAIT_L(0); PG8_MMA(0, 0, At, B0); PG8_BAR; PG8_SCHED;
            PG8_LDB(B1, 0, 1); PG8_STAGE(PG8_SB(0, 0), b2, voffB);
            PG8_BAR; PG8_WAIT_L(0); PG8_MMA(0, 1, At, B1); PG8_BAR;
            PG8_LDA(At, 0, 1); PG8_STAGE(PG8_SA(0, 0), a2, voffA);
            PG8_BAR; PG8_WAIT_L(0); PG8_MMA(1, 0, At, B0); PG8_BAR; PG8_SCHED;
            PG8_STAGE(PG8_SB(0, 1), b2 + hstep, voffB);
            PG8_WAIT_V(6); PG8_BAR; PG8_MMA(1, 1, At, B1); PG8_BAR;
            PG8_LDB(B0, 1, 0); PG8_SCHED; PG8_LDA(At, 1, 0); PG8_STAGE(PG8_SA(0, 1), a2 + hstep, voffA);
            PG8_WAIT_L(8); PG8_BAR; PG8_WAIT_L(0); PG8_MMA(0, 0, At, B0); PG8_BAR; PG8_SCHED;
            PG8_LDB(B1, 1, 1); PG8_STAGE(PG8_SB(1, 0), b3, voffB);
            PG8_BAR; PG8_WAIT_L(0); PG8_MMA(0, 1, At, B1); PG8_BAR;
            PG8_LDA(At, 1, 1); PG8_STAGE(PG8_SA(1, 0), a3, voffA);
            PG8_BAR; PG8_WAIT_L(0); PG8_MMA(1, 0, At, B0); PG8_BAR; PG8_SCHED;
            PG8_STAGE(PG8_SB(1, 1), b3 + hstep, voffB);
            PG8_WAIT_V(6); PG8_BAR; PG8_MMA(1, 1, At, B1); PG8_BAR;
        }
        PG8_STAMP();
        if constexpr (!Epi::AFTER_DRAIN) { E(acc, cur, wr, wc, fr, fq); S.done(cur); }
        PG8_STAMP();
        if (!has_next) break;
#pragma unroll
        for (int a = 0; a < 2; ++a)
#pragma unroll
            for (int b = 0; b < 2; ++b)
#pragma unroll
                for (int m = 0; m < 4; ++m)
#pragma unroll
                    for (int n = 0; n < 2; ++n) acc[a][b][m][n] = (f32x4){0.f, 0.f, 0.f, 0.f};
        cur = nxt; cA = nA; cB = nB; ++ui;
    }
    PG8_WAIT_V(0);
    if (wr == 0) PG8_BAR;
    PG8_BAR;
    if constexpr (Epi::AFTER_DRAIN) { E.fused(acc, cur, wr, wc, fr, fq, lds, wid, lane); S.done(cur); }
    PG8_STAMP();
    if (STAMP && wid == 0) { stamps[lane] = lane < nts ? (((unsigned long long)(unsigned)ts_hi << 32) | (unsigned)ts_lo) : 0ull;
        if (lane == 62) stamps[62] = rt_entry; if (lane == 63) stamps[63] = (unsigned long long)wall_clock64(); }
#undef PG8_STAMP
#undef PG8_SA
#undef PG8_SB
#undef PG8_STAGE
#undef PG8_LDA
#undef PG8_LDB
#undef PG8_MMA
#undef PG8_WAIT_V
#undef PG8_WAIT_L
#undef PG8_BAR
#undef PG8_SCHED
}
}

namespace mk {
#define LAS __attribute__((address_space(3)))
typedef unsigned short bf16;
typedef float f32x4 __attribute__((ext_vector_type(4)));
typedef float f32x16 __attribute__((ext_vector_type(16)));
typedef unsigned u32x4 __attribute__((ext_vector_type(4)));
typedef unsigned u32x2 __attribute__((ext_vector_type(2)));
typedef short bf16x8 __attribute__((ext_vector_type(8)));
typedef short s16x4 __attribute__((ext_vector_type(4)));

constexpr int D = 1024, NB = 4, SEQ = 4096, CTX = 256, PWW = 3360;
constexpr int MLAT = NB * SEQ, MT = MLAT + NB * CTX;
constexpr int NT1 = 14, N1 = NT1 * 256;
constexpr int NSLOT = 11, PLW = NSLOT * 256;
constexpr int TROW = SEQ + CTX;
constexpr int O_AQ = 0, O_AK = 128, O_AV = 256, O_AG = 512, O_LR = 768, O_BV = 800, O_BG = 1056, O_CQ = 1312, O_CK = 1568, O_CV = 1696,
              O_CG = 1824, O_DQ = 2080, O_DK = 2336, O_DV = 2592, O_DG = 2848;
constexpr int S_AQK = 0, S_AV = 1, S_AG = 2, S_BG = 3, S_CQ = 4, S_CKV = 5, S_CG = 6, S_DQ = 7, S_DK = 8, S_DV = 9, S_DG = 10;
constexpr float LOG2E = 1.4426950408889634f, QSCALE = 0.125f * LOG2E, GLA_QS = 0.17677669529663687f;

constexpr size_t WS_CTL = 0, CTL_BYTES = 65536;
constexpr size_t WS_MOD = WS_CTL + CTL_BYTES;
constexpr size_t WS_ROPE = WS_MOD + 2 * 5 * 3072 * 4;
constexpr size_t WS_WC = WS_ROPE + 2 * 64 * 16 * 4;
constexpr size_t WS_CS256 = WS_WC + 128 * 128 * 2;
constexpr size_t WS_W1T = 1u << 20;
constexpr size_t WS_W2T = WS_W1T + (size_t)2 * N1 * D * 2;
constexpr size_t WS_H = WS_W2T + (size_t)2 * D * D * 2;
constexpr size_t WS_PLB = WS_H + (size_t)MT * D * 2;
constexpr size_t WS_LA = WS_PLB + (size_t)MT * PLW * 2;
constexpr size_t WS_FA2 = WS_LA + (size_t)MT * 256 * 4;
constexpr size_t WS_CTX1 = WS_FA2 + (size_t)NB * 64 * TROW * 8 * 2;
constexpr size_t WS_SCR = WS_CTX1 + (size_t)NB * CTX * D * 4;
static_assert(WS_CS256 + 256 * 512 * 2 <= WS_W1T, "tables");

__device__ __forceinline__ float bf2f(bf16 v) { return __uint_as_float(((unsigned)v) << 16); }
__device__ __forceinline__ unsigned f2bf(float f) { unsigned u = __float_as_uint(f); return (u + 0x7fffu + ((u >> 16) & 1u)) >> 16; }
typedef float f32x2_t __attribute__((ext_vector_type(2))); typedef __bf16 bf16x2_t __attribute__((ext_vector_type(2)));
__device__ __forceinline__ unsigned pk2(float lo, float hi) { const f32x2_t v = {lo, hi}; const bf16x2_t b = __builtin_convertvector(v, bf16x2_t); return __builtin_bit_cast(unsigned, b); }
__device__ __forceinline__ float wave_sum(float v) {
#pragma unroll
  for (int o = 1; o < 64; o <<= 1) v += __shfl_xor(v, o);
  return v;
}
__device__ __forceinline__ float fsilu(float x) { return x * __builtin_amdgcn_rcpf(1.f + __expf(-x)); }
__device__ __forceinline__ float flogsig(float x) { return fminf(x, 0.f) - __logf(1.f + __expf(-fabsf(x))); }

#define GAS __attribute__((address_space(1)))
template <class T> __device__ __forceinline__ T* opq(T* p) { GAS T* g = (GAS T*)p; asm volatile("" : "+s"(g)); return (T*)g; }
__device__ __forceinline__ int crow(int r, int hi) { return (r & 3) + 8 * (r >> 2) + 4 * hi; }
struct Args {
  const float* in[19]; float* out; unsigned char* ws; int ph_lo, ph_hi;
};
struct Frame {
  int tid, lane, wave, vcu, G;
  LAS unsigned char* lds;
};
__device__ __forceinline__ Frame relaunder(const Frame& F0) {
  Frame F = F0; F.tid = threadIdx.x; asm volatile("" : "+v"(F.tid)); F.lane = F.tid & 63; asm volatile("" : "+s"(F.wave), "+s"(F.vcu), "+s"(F.G)); return F; }
}

namespace mk {
__device__ __forceinline__ void p0_ada_item(const Frame& F, const Args& a, int item) {
  LAS float* s = (LAS float*)F.lds; LAS float* red = s + 5 * 1024;
  const float* c = opq(a.in[1]); const float* cc = opq(a.in[3]);
  for (int i = F.tid; i < 5 * 1024; i += 512) { const int r = i >> 10, k = i & 1023; const float v = r < 4 ? c[r * 1024 + k] : cc[k]; s[i] = v / (1.f + expf(-v)); }
  __syncthreads();
  const int kp = F.tid / 24, cl = F.tid % 24;
  const int gcol = item * 24 + cl, l = gcol / 3072, col = gcol % 3072;
  if (kp < 21) {
    const float* w = opq(a.in[5]) + (size_t)l * 1024 * 3072 + col;
    float acc[5] = {0.f, 0.f, 0.f, 0.f, 0.f};
#pragma unroll 8
    for (int k = kp; k < 1024; k += 21) { const float wv = w[(size_t)k * 3072];
#pragma unroll
      for (int r = 0; r < 5; ++r) acc[r] += s[r * 1024 + k] * wv; }
#pragma unroll
    for (int r = 0; r < 5; ++r) red[(kp * 24 + cl) * 5 + r] = acc[r];
  }
  __syncthreads();
  if (F.tid < 120) {
    const int cl2 = F.tid / 5, r = F.tid % 5; float t = 0.f;
    for (int q = 0; q < 21; ++q) t += red[(q * 24 + cl2) * 5 + r];
    const int g2 = item * 24 + cl2, l2 = g2 / 3072, col2 = g2 % 3072;
    float* MOD = (float*)(opq(a.ws) + WS_MOD);
    MOD[((size_t)l2 * 5 + r) * 3072 + col2] = t + opq(a.in[6])[l2 * 3072 + col2];
  }
  __syncthreads();
}
__device__ __forceinline__ int rope_perm(int n) { return 16 * ((n >> 2) & 1) + 4 * (n >> 3) + (n & 3); }
__device__ __forceinline__ void p0_tr_item(const float* W, int ldw, int cbase, int permkind, float scale, bf16* dst, int k0, LAS float* scr, int lane) {
  { float t_[32];
#pragma unroll
    for (int i = 0; i < 32; ++i) t_[i] = W[(size_t)(k0 + 2 * i + (lane >> 5)) * ldw + cbase + (lane & 31)];
#pragma unroll
    for (int i = 0; i < 32; ++i) scr[(2 * i + (lane >> 5)) * 33 + (lane & 31)] = t_[i]; }
  asm volatile("s_waitcnt lgkmcnt(0)" ::: "memory");
  const int c = lane & 7;
#pragma unroll
  for (int j = 0; j < 4; ++j) { const int n = (lane >> 3) + 8 * j; const int sidx = permkind ? rope_perm(n) : n; const LAS float* sp = scr + (8 * c) * 33 + sidx;
    u32x4 o; o.x = pk2(sp[0 * 33] * scale, sp[1 * 33] * scale); o.y = pk2(sp[2 * 33] * scale, sp[3 * 33] * scale); o.z = pk2(sp[4 * 33] * scale, sp[5 * 33] * scale); o.w = pk2(sp[6 * 33] * scale, sp[7 * 33] * scale);
    *(u32x4*)(dst + (size_t)n * 1024 + k0 + 8 * c) = o; }
  asm volatile("s_waitcnt lgkmcnt(0)" ::: "memory");
}
__device__ __forceinline__ void p0_la_item(const float* Win, const float* decw  , int dir, int j0, bf16* dst, int k0, LAS float* scr, int lane) {
  float dw[16];
#pragma unroll
  for (int r = 0; r < 16; ++r) dw[r] = decw[(dir * 16 + r) * 128 + j0 + (lane & 31)];
#pragma unroll 4
  for (int i = 0; i < 32; ++i) { const int kk = 2 * i + (lane >> 5); const float* wp = Win + (size_t)(k0 + kk) * PWW + O_LR + dir * 16; float acc = 0.f;
#pragma unroll
    for (int r = 0; r < 16; ++r) acc += wp[r] * dw[r];
    scr[kk * 33 + (lane & 31)] = acc; }
  asm volatile("s_waitcnt lgkmcnt(0)" ::: "memory");
  const int c = lane & 7;
#pragma unroll
  for (int j = 0; j < 4; ++j) { const int n = (lane >> 3) + 8 * j; const LAS float* sp = scr + (8 * c) * 33 + n;
    u32x4 o; o.x = pk2(sp[0 * 33], sp[1 * 33]); o.y = pk2(sp[2 * 33], sp[3 * 33]); o.z = pk2(sp[4 * 33], sp[5 * 33]); o.w = pk2(sp[6 * 33], sp[7 * 33]);
    *(u32x4*)(dst + (size_t)n * 1024 + k0 + 8 * c) = o; }
  asm volatile("s_waitcnt lgkmcnt(0)" ::: "memory");
}
constexpr int FA_AST = 528, FA_WST = 528;
__device__ __forceinline__ void p0_fa_item(const Frame& F, const Args& a, int item) {
  const int l = item >> 4, pn = 4 + ((item >> 3) & 1), g32 = item & 7, bj = g32 >> 2, wc = g32 & 3;
  LAS float* cs = (LAS float*)F.lds; LAS float* sn = cs + 64; LAS float* wfl = sn + 64;
  LAS unsigned char* Ai = F.lds + 512 + 16384;
  LAS unsigned char* Wi = F.lds + F.wave * (32 * FA_WST);
  __syncthreads();
  if (F.tid < 64) { float s_, c_; sincospif(2.f * F.tid / 64.f, &s_, &c_); cs[F.tid] = c_; sn[F.tid] = s_; }
  const float* wf = opq(a.in[12]) + (size_t)l * 256 * 256;
  const int slice0 = 32 * (pn - 4) + 16 * bj + 4 * wc;
  for (int i = F.tid; i < 1024; i += 512) { const int r = i >> 2, q = i & 3; *(LAS f32x4*)(wfl + r * 16 + 4 * q) = *(const f32x4*)(wf + (size_t)r * 256 + 4 * slice0 + 4 * q); }
  __syncthreads();
  {
    const int c = F.tid & 255, part = F.tid >> 8, g = c >> 6, jj = c & 63;
    f32x4 acc[4];
#pragma unroll
    for (int q = 0; q < 4; ++q) acc[q] = (f32x4){0.f, 0.f, 0.f, 0.f};
#pragma unroll 4
    for (int m = 0; m < 64; ++m) { const int idx = (m * jj) & 63; const float t = part ? -sn[idx] : cs[idx];
#pragma unroll
      for (int q = 0; q < 4; ++q) acc[q] += t * *(LAS const f32x4*)(wfl + (g * 64 + m) * 16 + 4 * q); }
#pragma unroll
    for (int fq = 0; fq < 4; ++fq)
#pragma unroll
      for (int j = 0; j < 4; ++j) *(LAS unsigned short*)(Ai + (8 * fq + 4 * part + j) * FA_AST + c * 2) = (unsigned short)f2bf(acc[fq][j] * 0.125f);
  }
  __syncthreads();
  const int r32 = F.lane & 31, hi = F.lane >> 5;
  bf16x8 af[16];
#pragma unroll
  for (int s = 0; s < 16; ++s) af[s] = *(LAS const bf16x8*)(Ai + r32 * FA_AST + (16 * s + 8 * hi) * 2);
  __syncthreads();
  const float* Win = opq(a.in[7]) + (size_t)l * 1024 * PWW + O_BV;
  bf16* dst = (bf16*)(opq(a.ws) + WS_W1T) + ((size_t)l * N1 + pn * 256 + 32 * g32) * 1024;
  for (int kb = 0; kb < 4; ++kb) {
    const int k0 = F.wave * 128 + kb * 32;
#pragma unroll
    for (int rh = 0; rh < 2; ++rh) { f32x4 w[16];
#pragma unroll
      for (int r = 0; r < 16; ++r) w[r] = *(const f32x4*)(Win + (size_t)(k0 + 16 * rh + r) * PWW + 4 * F.lane);
#pragma unroll
      for (int r = 0; r < 16; ++r) *(LAS u32x2*)(Wi + (16 * rh + r) * FA_WST + 8 * F.lane) = (u32x2){pk2(w[r].x, w[r].y), pk2(w[r].z, w[r].w)}; }
    asm volatile("s_waitcnt lgkmcnt(0)" ::: "memory");
    f32x16 acc;
#pragma unroll
    for (int i = 0; i < 16; ++i) acc[i] = 0.f;
#pragma unroll
    for (int s = 0; s < 16; ++s) { const bf16x8 bfr = *(LAS const bf16x8*)(Wi + r32 * FA_WST + (16 * s + 8 * hi) * 2); acc = __builtin_amdgcn_mfma_f32_32x32x16_bf16(af[s], bfr, acc, 0, 0, 0); }
#pragma unroll
    for (int r = 0; r < 16; ++r) dst[(size_t)crow(r, hi) * 1024 + k0 + r32] = (bf16)f2bf(acc[r]);
    asm volatile("s_waitcnt lgkmcnt(0)" ::: "memory");
  }
  __syncthreads();
}
__device__ __forceinline__ void p0_prologue(const Frame& F0, const Args& a) {
 {
  const Frame F = relaunder(F0);
  unsigned char* ws = opq(a.ws);
  { const int gt = F.vcu * 512 + F.tid, GT = F.G * 512;
    float* rope = (float*)(ws + WS_ROPE);
    for (int i = gt; i < 1024; i += GT) { const int pos = i >> 4, f = i & 15; const float ang = (float)pos * powf(10000.f, -(float)f / 16.f); rope[i] = cosf(ang); rope[1024 + i] = sinf(ang); }
    bf16* wc = (bf16*)(ws + WS_WC);
    for (int i = gt; i < 128 * 128; i += GT) { const int r = i >> 7, c = i & 127, rr = r & 63, cc = c & 63; float s_, c_; sincospif(2.f * (float)((rr * cc) & 63) / 64.f, &s_, &c_);
      float v; if (r < 64) v = c < 64 ? c_ : s_; else v = c < 64 ? -s_ : c_; wc[i] = (bf16)f2bf(v * 0.125f); }
    bf16* cs256 = (bf16*)(ws + WS_CS256);
    for (int i = gt; i < 256 * 512; i += GT) { const int k = i >> 9, n = i & 511, nn = n & 255; float s_, c_; sincospif(2.f * (float)((k * nn) & 255) / 256.f, &s_, &c_); cs256[i] = (bf16)f2bf((n < 256 ? c_ : s_) * 0.0625f); }
  }
  for (int it = F.vcu; it < 256 + 32; it += F.G) { if (it < 256) p0_ada_item(F, a, it); else p0_fa_item(F, a, it - 256); }
  LAS float* scr = (LAS float*)(F.lds + F.wave * 16384);
  const int gw = F.vcu * 8 + F.wave, NGW = F.G * 8;
  constexpr int I_DIR = 11 * 8 * 16, I_LA = 8 * 16, I_W2 = 32 * 16, I_L = I_DIR + I_LA + I_W2;
  for (int it = gw; it < 2 * I_L; it += NGW) {
    const int l = it / I_L; int r = it % I_L;
    const float* Win = opq(a.in[7]) + (size_t)l * 1024 * PWW;
    bf16* W1T = (bf16*)(ws + WS_W1T) + (size_t)l * N1 * 1024;
    if (r < I_DIR) {
      const int ti = r / 128, g32 = (r >> 4) & 7, kb = r & 15;
      const int pn = ti < 3 ? ti : ti + 3;
      const int bj = g32 >> 2, wc = g32 & 3, mcb = 64 * wc + 32 * bj;
      int cbase = 0, pk = 0; float sc = 1.f;
      switch (pn) {
        case 0: if (mcb < 128) { cbase = O_AQ + mcb; sc = GLA_QS; } else cbase = O_AK + mcb - 128; break;
        case 1: cbase = O_AV + mcb; break;
        case 2: cbase = O_AG + mcb; break;
        case 6: cbase = O_BG + mcb; break;
        case 7: cbase = O_CQ + mcb; pk = 1; break;
        case 8: if (wc < 2) { cbase = O_CK + mcb; pk = 1; } else cbase = O_CV + mcb - 128; break;
        case 9: cbase = O_CG + mcb; break;
        case 10: cbase = O_DQ + mcb; break;
        case 11: cbase = O_DK + mcb; break;
        case 12: cbase = O_DV + mcb; break;
        default: cbase = O_DG + mcb; break;
      }
      p0_tr_item(Win, PWW, cbase, pk, sc, W1T + (size_t)(pn * 256 + 32 * g32) * 1024, kb * 64, scr, F.lane);
    } else if (r < I_DIR + I_LA) {
      r -= I_DIR; const int g32 = r >> 4, kb = r & 15, bj = g32 >> 2, wc = g32 & 3, mcb = 64 * wc + 32 * bj;
      p0_la_item(Win, opq(a.in[9]) + (size_t)l * 2 * 16 * 128, mcb >> 7, mcb & 127, W1T + (size_t)(3 * 256 + 32 * g32) * 1024, kb * 64, scr, F.lane);
    } else {
      r -= I_DIR + I_LA; const int g = r >> 4, kb = r & 15;
      p0_tr_item(opq(a.in[8]) + (size_t)l * 1024 * 1024, 1024, 32 * g, 0, 1.f, (bf16*)(ws + WS_W2T) + ((size_t)l * 1024 + 32 * g) * 1024, kb * 64, scr, F.lane);
    }
  }
 }
}
__device__ __forceinline__ void p1_prenorm(const Frame& F0, const Args& a, int layer) {
  const Frame F = relaunder(F0);
  const float* xin = layer == 0 ? opq(a.in[0]) : opq(a.out);
  const float* cin = layer == 0 ? opq(a.in[2]) : (const float*)(opq(a.ws) + WS_CTX1);
  const float* nw = opq(a.in[4]) + layer * 1024;
  const float* MOD = (const float*)(opq(a.ws) + WS_MOD) + (size_t)layer * 5 * 3072;
  bf16* H = (bf16*)(opq(a.ws) + WS_H);
  const int gw = F.vcu * 8 + F.wave, NGW = F.G * 8;
  constexpr int RB = 3;
  f32x4 w_[4];
#pragma unroll
  for (int j = 0; j < 4; ++j) w_[j] = *(const f32x4*)(nw + 4 * F.lane + 256 * j);
  for (int row0 = gw; row0 < MT; row0 += RB * NGW) {
    f32x4 v[RB][4], sc_[RB][4], sh_[RB][4]; float ss[RB];
#pragma unroll
    for (int q = 0; q < RB; ++q) { int row = row0 + q * NGW; row = row < MT ? row : MT - 1;
      const float* src; const float* mod;
      if (row < MLAT) { src = xin + (size_t)row * 1024; mod = MOD + (size_t)(row >> 12) * 3072; }
      else { src = cin + (size_t)(row - MLAT) * 1024; mod = MOD + (size_t)4 * 3072; }
      const f32x4* xr = (const f32x4*)src + F.lane;
#pragma unroll
      for (int j = 0; j < 4; ++j) { v[q][j] = xr[64 * j]; sc_[q][j] = *(const f32x4*)(mod + 1024 + 4 * F.lane + 256 * j); sh_[q][j] = *(const f32x4*)(mod + 4 * F.lane + 256 * j); } }
    __builtin_amdgcn_sched_barrier(0);
#pragma unroll
    for (int q = 0; q < RB; ++q) { float s_ = 0.f;
#pragma unroll
      for (int j = 0; j < 4; ++j) s_ += (v[q][j].x * v[q][j].x + v[q][j].y * v[q][j].y) + (v[q][j].z * v[q][j].z + v[q][j].w * v[q][j].w);
      ss[q] = s_; }
#pragma unroll
    for (int o = 1; o < 64; o <<= 1)
#pragma unroll
      for (int q = 0; q < RB; ++q) ss[q] += __shfl_xor(ss[q], o);
#pragma unroll
    for (int q = 0; q < RB; ++q) { const int row = row0 + q * NGW; if (row >= MT) continue;
      const float rs = 1.0f / sqrtf(ss[q] * (1.f / 1024.f) + 1e-6f);
      unsigned long long* o8 = (unsigned long long*)(H + (size_t)row * 1024) + F.lane;
#pragma unroll
      for (int j = 0; j < 4; ++j) {
        const f32x4 h = v[q][j] * rs * w_[j] * (1.f + sc_[q][j]) + sh_[q][j];
        o8[64 * j] = (unsigned long long)pk2(h.x, h.y) | ((unsigned long long)pk2(h.z, h.w) << 32);
      } }
  }
}
}

namespace mk {
using pg8::Unit;
struct EpiIn {
  static constexpr bool PERM = true, AFTER_DRAIN = false;
  bf16* PLB; float* LA; bf16* FA2; LAS const float* rope;
  __device__ __forceinline__ void operator()(const f32x4 (&acc)[2][2][4][2], const Unit& u, int wr, int wc, int fr, int fq) const {
    const int pn = u.pn;
    const bool ctxrows = u.pm >= 64;
    int kind, slot = 0; LAS const float* nw = rope; bool roped = false; float qs = 1.f;
    LAS const float* cqn = rope + 2048; LAS const float* ckn = rope + 2112; LAS const float* dqn = rope + 2176; LAS const float* dkn = rope + 2240; LAS const float* decb = rope + 2304;
    switch (pn) {
      case 0: kind = 0; slot = S_AQK; break;
      case 1: kind = 0; slot = S_AV; break;
      case 2: kind = 1; slot = S_AG; break;
      case 3: kind = 2; break;
      case 4: case 5: kind = 3; break;
      case 6: kind = 1; slot = S_BG; break;
      case 7: kind = 4; slot = S_CQ; nw = cqn; roped = true; qs = QSCALE; break;
      case 8: slot = S_CKV; if (wc < 2) { kind = 4; nw = ckn; roped = true; } else kind = 0; break;
      case 9: kind = 1; slot = S_CG; break;
      case 10: kind = 4; slot = S_DQ; nw = dqn; qs = QSCALE; break;
      case 11: kind = 4; slot = S_DK; nw = dkn; break;
      case 12: kind = 0; slot = S_DV; break;
      default: kind = 1; slot = S_DG; break;
    }
    const int row0 = u.pm * 256 + wr * 64 + fr;
    float w8[2][8];
    if (kind == 4) {
#pragma unroll
      for (int bj = 0; bj < 2; ++bj)
#pragma unroll
        for (int s = 0; s < 8; ++s) { const int d = roped ? (32 * bj + 16 * (s >> 2) + 4 * fq + (s & 3)) : (32 * bj + 8 * fq + s); w8[bj][s] = nw[d] * qs; }
    } else if (kind == 2) {
#pragma unroll
      for (int bj = 0; bj < 2; ++bj)
#pragma unroll
        for (int s = 0; s < 8; ++s) w8[bj][s] = decb[64 * wc + 32 * bj + 8 * fq + s];
    }
#pragma unroll
    for (int ai = 0; ai < 2; ++ai) {
      float rsr[4];
      if (kind == 4) {
#pragma unroll
        for (int m = 0; m < 4; ++m) { float s_ = 0.f;
#pragma unroll
          for (int bj = 0; bj < 2; ++bj)
#pragma unroll
            for (int n = 0; n < 2; ++n) { const f32x4 t = acc[ai][bj][m][n]; s_ += (t.x * t.x + t.y * t.y) + (t.z * t.z + t.w * t.w); }
          rsr[m] = s_; }
#pragma unroll
        for (int o = 16; o < 64; o <<= 1)
#pragma unroll
          for (int m = 0; m < 4; ++m) rsr[m] += __shfl_xor(rsr[m], o);
#pragma unroll
        for (int m = 0; m < 4; ++m) rsr[m] = __builtin_amdgcn_rsqf(rsr[m] * (1.f / 64.f) + 1e-6f);
      }
#pragma unroll
      for (int m = 0; m < 4; ++m) {
        const int r = row0 + ai * 128 + m * 16;
        float v[2][8];
#pragma unroll
        for (int bj = 0; bj < 2; ++bj)
#pragma unroll
          for (int n = 0; n < 2; ++n)
#pragma unroll
            for (int e = 0; e < 4; ++e) v[bj][4 * n + e] = acc[ai][bj][m][n][e];
        if (kind == 2) {
#pragma unroll
          for (int bj = 0; bj < 2; ++bj) { const int mc = 64 * wc + 32 * bj + 8 * fq; float* dp = LA + (size_t)r * 256 + mc;
            f32x4 o0, o1;
#pragma unroll
            for (int e = 0; e < 4; ++e) { o0[e] = flogsig(v[bj][e] + w8[bj][e]) * 0.0625f; o1[e] = flogsig(v[bj][4 + e] + w8[bj][4 + e]) * 0.0625f; }
            *(f32x4*)dp = o0; *(f32x4*)(dp + 4) = o1; }
        } else if (kind == 3) {
          int b, t; if (!ctxrows) { b = r >> 12; t = r & 4095; } else { const int rc = r - MLAT; b = rc >> 8; t = SEQ + (rc & 255); }
#pragma unroll
          for (int bj = 0; bj < 2; ++bj) { const int slice = 32 * (pn - 4) + 16 * bj + 4 * wc + fq;
            u32x4 o; o.x = pk2(v[bj][0], v[bj][1]); o.y = pk2(v[bj][2], v[bj][3]); o.z = pk2(v[bj][4], v[bj][5]); o.w = pk2(v[bj][6], v[bj][7]);
            *(u32x4*)(FA2 + (((size_t)b * 64 + slice) * TROW + t) * 8) = o; }
        } else {
          if (kind == 1) {
#pragma unroll
            for (int bj = 0; bj < 2; ++bj)
#pragma unroll
              for (int s = 0; s < 8; ++s) v[bj][s] = fsilu(v[bj][s]);
          } else if (kind == 4) {
            const float rs = rsr[m];
#pragma unroll
            for (int bj = 0; bj < 2; ++bj)
#pragma unroll
              for (int s = 0; s < 8; ++s) v[bj][s] *= rs * w8[bj][s];
            if (roped && !ctxrows) {
              const int t = r & 4095;
#pragma unroll
              for (int bj = 0; bj < 2; ++bj) { const int pos = bj == 0 ? (t >> 6) : (t & 63);
                const f32x4 c4 = *(LAS const f32x4*)(rope + pos * 16 + 4 * fq), s4 = *(LAS const f32x4*)(rope + 1024 + pos * 16 + 4 * fq);
#pragma unroll
                for (int e = 0; e < 4; ++e) { const float x1 = v[bj][e], x2 = v[bj][4 + e]; v[bj][e] = x1 * c4[e] - x2 * s4[e]; v[bj][4 + e] = x2 * c4[e] + x1 * s4[e]; } }
            }
          }
#pragma unroll
          for (int bj = 0; bj < 2; ++bj) { const int mc = 64 * wc + 32 * bj + 8 * fq;
            u32x4 o; o.x = pk2(v[bj][0], v[bj][1]); o.y = pk2(v[bj][2], v[bj][3]); o.z = pk2(v[bj][4], v[bj][5]); o.w = pk2(v[bj][6], v[bj][7]);
            *(u32x4*)(PLB + (size_t)r * PLW + slot * 256 + mc) = o; }
        }
        asm volatile("" ::: "memory");
      }
    }
  }
};
struct EpiOut {
  static constexpr bool PERM = true, AFTER_DRAIN = false;
  const float* xin; const float* cin; float* xout; float* cout; const float* MODl;
  __device__ __forceinline__ void operator()(const f32x4 (&acc)[2][2][4][2], const Unit& u, int wr, int wc, int fr_, int fq_) const {
    int fr = fr_, fq = fq_; asm volatile("" : "+v"(fr), "+v"(fq));
    const int row0 = u.pm * 256 + wr * 64 + fr, col0 = u.pn * 256 + wc * 32 + 8 * fq;
    const bool ctxrows = u.pm >= 64;
    const float* gate = MODl + (size_t)(ctxrows ? 4 : (u.pm >> 4)) * 3072 + 2048;
    f32x4 gv[2][2];
#pragma unroll
    for (int bj = 0; bj < 2; ++bj)
#pragma unroll
      for (int n = 0; n < 2; ++n) gv[bj][n] = *(const f32x4*)(gate + col0 + bj * 128 + n * 4);
#pragma unroll
    for (int ai = 0; ai < 2; ++ai)
#pragma unroll
      for (int m = 0; m < 4; ++m) {
        const int r = row0 + ai * 128 + m * 16;
        const float* sp; float* dp;
        if (!ctxrows) { sp = xin + (size_t)r * 1024 + col0; dp = xout + (size_t)r * 1024 + col0; }
        else { sp = cin + (size_t)(r - MLAT) * 1024 + col0; dp = cout + (size_t)(r - MLAT) * 1024 + col0; }
        f32x4 xv[2][2];
#pragma unroll
        for (int bj = 0; bj < 2; ++bj)
#pragma unroll
          for (int n = 0; n < 2; ++n) xv[bj][n] = *(const f32x4*)(sp + bj * 128 + n * 4);
#pragma unroll
        for (int bj = 0; bj < 2; ++bj)
#pragma unroll
          for (int n = 0; n < 2; ++n) *(f32x4*)(dp + bj * 128 + n * 4) = xv[bj][n] + gv[bj][n] * acc[ai][bj][m][n];
        asm volatile("" ::: "memory");
      }
  }
};
struct InOrder {
  pg8::StaticOrder S;
  static constexpr unsigned long long PACK = 0x3c817d9b0a5246ull;
  __device__ __forceinline__ bool next(int i, Unit& u) const { const bool ok = S.next(i, u); if (ok) u.pn = (int)((PACK >> (4 * u.pn)) & 15ull); return ok; }
  __device__ __forceinline__ void a_ready(const Unit&) const {}
  __device__ __forceinline__ void done(const Unit&) const {}
};
__device__ __forceinline__ void p2_inproj(const Frame& F, const Args& a, int layer) {
  unsigned char* ws = opq(a.ws);
  pg8::Gemm g{(const pg8::bf16_t*)(ws + WS_H), (const pg8::bf16_t*)(ws + WS_W1T) + (size_t)layer * N1 * 1024, MT, N1, 1024};
  InOrder S; S.S.init(MT, N1, F.G, (int)blockIdx.x);
  LAS float* ropeL = (LAS float*)(F.lds + pg8::STAGE_BYTES);
  { int tid = threadIdx.x; asm volatile("" : "+v"(tid)); const f32x4 t = *(const f32x4*)((const float*)(ws + WS_ROPE) + 4 * tid); *(LAS f32x4*)(ropeL + 4 * tid) = t;
    if (tid < 128) {
      const float* n0 = opq(a.in[13]); const float* n1 = opq(a.in[14]); const float* n2 = opq(a.in[16]); const float* n3 = opq(a.in[17]); const float* db = opq(a.in[10]);
      const int k = tid >> 4; const float* src = tid < 64 ? (k == 0 ? n0 : k == 1 ? n1 : k == 2 ? n2 : n3) + layer * 64 + 4 * (tid & 15) : db + layer * 256 + 4 * (tid - 64);
      *(LAS f32x4*)(ropeL + 2048 + 4 * tid) = *(const f32x4*)src; } }
  __syncthreads();
  EpiIn E{(bf16*)(ws + WS_PLB), (float*)(ws + WS_LA), (bf16*)(ws + WS_FA2), ropeL};
  pg8::gemm_phase<EpiIn, InOrder>(F.lds, g, S, E, nullptr);
}

__device__ __forceinline__ void ctx_out_item(const Frame& F, const Args& a, int item) {
  unsigned char* ws = opq(a.ws);
  const bf16* Yc = (const bf16*)(ws + WS_H) + (size_t)MLAT * 1024; const bf16* W2 = (const bf16*)(ws + WS_W2T);
  const int tm = item >> 4, tn = item & 15, sub = F.wave & 3, kh = F.wave >> 2, r32 = F.lane & 31, hi = F.lane >> 5;
  const int row0 = 64 * tm + 32 * (sub >> 1), col0 = 64 * tn + 32 * (sub & 1);
  const bf16* ap = Yc + (size_t)(row0 + r32) * 1024 + kh * 512 + 8 * hi;
  const bf16* bp = W2 + (size_t)(col0 + r32) * 1024 + kh * 512 + 8 * hi;
  f32x16 acc;
#pragma unroll
  for (int i = 0; i < 16; ++i) acc[i] = 0.f;
#pragma unroll 1
  for (int sb = 0; sb < 4; ++sb) {
    bf16x8 af[8], bf[8];
#pragma unroll
    for (int s = 0; s < 8; ++s) { af[s] = *(const bf16x8*)(ap + (sb * 8 + s) * 16); bf[s] = *(const bf16x8*)(bp + (sb * 8 + s) * 16); }
    __builtin_amdgcn_sched_barrier(0);
#pragma unroll
    for (int s = 0; s < 8; ++s) acc = __builtin_amdgcn_mfma_f32_32x32x16_bf16(af[s], bf[s], acc, 0, 0, 0);
  }
  LAS float* X = (LAS float*)F.lds + sub * 1024;
  __syncthreads();
  if (kh == 1) {
#pragma unroll
    for (int r = 0; r < 16; ++r) X[r * 64 + F.lane] = acc[r];
  }
  __syncthreads();
  if (kh == 0) {
    const float* cin = opq(a.in[2]); float* cout = (float*)(ws + WS_CTX1);
    const float gate = ((const float*)(ws + WS_MOD))[4 * 3072 + 2048 + col0 + r32];
    float ci[16];
#pragma unroll
    for (int r = 0; r < 16; ++r) ci[r] = cin[(size_t)(row0 + crow(r, hi)) * 1024 + col0 + r32];
    __builtin_amdgcn_sched_barrier(0);
#pragma unroll
    for (int r = 0; r < 16; ++r) { const size_t o = (size_t)(row0 + crow(r, hi)) * 1024 + col0 + r32; cout[o] = ci[r] + gate * (acc[r] + X[r * 64 + F.lane]); }
  }
}
__device__ __forceinline__ void p5_outproj(const Frame& F, const Args& a, int layer) {
  unsigned char* ws = opq(a.ws);
  const int M = MLAT;
  pg8::Gemm g{(const pg8::bf16_t*)(ws + WS_H), (const pg8::bf16_t*)(ws + WS_W2T) + (size_t)layer * 1024 * 1024, M, 1024, 1024};
  pg8::StaticOrder S; S.init(M, 1024, F.G, (int)blockIdx.x);
  EpiOut E{layer == 0 ? opq(a.in[0]) : opq(a.out), layer == 0 ? opq(a.in[2]) : (const float*)(ws + WS_CTX1), opq(a.out), (float*)(ws + WS_CTX1), (const float*)(ws + WS_MOD) + (size_t)layer * 5 * 3072};
  pg8::gemm_phase<EpiOut, pg8::StaticOrder>(F.lds, g, S, E, nullptr);
  if (layer == 0) { const Frame F2 = relaunder(F); for (int it = F2.vcu; it < 256; it += F2.G) ctx_out_item(F2, a, it); }
}
}

namespace mk {
typedef short v4i16_t __attribute__((ext_vector_type(4)));
__device__ __forceinline__ s16x4 vtr(LAS const unsigned char* p) { return __builtin_bit_cast(s16x4, __builtin_amdgcn_ds_read_tr16_b64_v4i16((LAS v4i16_t*)p)); }
struct AttnState { float m, l; f32x16 o0, o1; };
template <class MaskF>
__device__ __forceinline__ void attn_tile(AttnState& st, const bf16x8 (&qf)[4], LAS const unsigned char* Kt, LAS const unsigned char* Vt, int lane, MaskF&& maskf) {
  const int r32 = lane & 31, hi = lane >> 5;
  f32x16 p0, p1;
  const int ksw = (r32 >> 1) & 7;
  bf16x8 ka[4], kb[4];
#pragma unroll
  for (int s = 0; s < 4; ++s) { const int ch = ((2 * s + hi) ^ ksw) << 4; ka[s] = *(LAS const bf16x8*)(Kt + r32 * 128 + ch); kb[s] = *(LAS const bf16x8*)(Kt + (32 + r32) * 128 + ch); }
  { const f32x16 z = {0.f, 0.f, 0.f, 0.f, 0.f, 0.f, 0.f, 0.f, 0.f, 0.f, 0.f, 0.f, 0.f, 0.f, 0.f, 0.f};
    p0 = __builtin_amdgcn_mfma_f32_32x32x16_bf16(ka[0], qf[0], z, 0, 0, 0); p1 = __builtin_amdgcn_mfma_f32_32x32x16_bf16(kb[0], qf[0], z, 0, 0, 0); }
#pragma unroll
  for (int s = 1; s < 4; ++s) { p0 = __builtin_amdgcn_mfma_f32_32x32x16_bf16(ka[s], qf[s], p0, 0, 0, 0); p1 = __builtin_amdgcn_mfma_f32_32x32x16_bf16(kb[s], qf[s], p1, 0, 0, 0); }
  maskf(p0, p1);
  float ps = 0.f;
#pragma unroll
  for (int i = 0; i < 16; ++i) { p0[i] = __builtin_amdgcn_exp2f(p0[i]); p1[i] = __builtin_amdgcn_exp2f(p1[i]); ps += p0[i] + p1[i]; }
  st.l += ps;
  u32x4 pw[4];
#pragma unroll
  for (int k = 0; k < 2; ++k) {
    pw[k] = (u32x4){pk2(p0[8 * k + 0], p0[8 * k + 1]), pk2(p0[8 * k + 2], p0[8 * k + 3]), pk2(p0[8 * k + 4], p0[8 * k + 5]), pk2(p0[8 * k + 6], p0[8 * k + 7])};
    pw[2 + k] = (u32x4){pk2(p1[8 * k + 0], p1[8 * k + 1]), pk2(p1[8 * k + 2], p1[8 * k + 3]), pk2(p1[8 * k + 4], p1[8 * k + 5]), pk2(p1[8 * k + 6], p1[8 * k + 7])};
  }
  const int q = (lane & 15) >> 2, p = lane & 3, gsel = (lane >> 4) & 1;
  const int vrow = (4 * hi + q) * 128 + 8 * (p & 1);
  const int chb = 2 * gsel + (p >> 1);
#pragma unroll
  for (int ks = 0; ks < 4; ++ks) {
    const int c0_ = ((chb | ((0 ^ (q >> 1)) << 2)) << 4), c1_ = ((chb | ((1 ^ (q >> 1)) << 2)) << 4);
    const s16x4 l0 = vtr(Vt + ks * 2048 + vrow + c0_), h0 = vtr(Vt + ks * 2048 + 1024 + vrow + c0_), l1 = vtr(Vt + ks * 2048 + vrow + c1_), h1 = vtr(Vt + ks * 2048 + 1024 + vrow + c1_);
    const bf16x8 va0 = (bf16x8){l0[0], l0[1], l0[2], l0[3], h0[0], h0[1], h0[2], h0[3]}, va1 = (bf16x8){l1[0], l1[1], l1[2], l1[3], h1[0], h1[1], h1[2], h1[3]};
    st.o0 = __builtin_amdgcn_mfma_f32_32x32x16_bf16(va0, __builtin_bit_cast(bf16x8, pw[ks]), st.o0, 0, 0, 0);
    st.o1 = __builtin_amdgcn_mfma_f32_32x32x16_bf16(va1, __builtin_bit_cast(bf16x8, pw[ks]), st.o1, 0, 0, 0);
  }
}
template <class MaskF, class F1, class F2, class F3>
__device__ __forceinline__ void attn_tile_dma(AttnState& st, const bf16x8 (&qf)[4], LAS const unsigned char* Kt, LAS const unsigned char* Vt, int lane, MaskF&& maskf, F1&& after_k, F2&& before_v, F3&& after_v) {
  const int r32 = lane & 31, hi = lane >> 5;
  f32x16 p0, p1;
  const int ksw = (r32 >> 1) & 7;
  bf16x8 ka[4], kb[4];
#pragma unroll
  for (int s = 0; s < 4; ++s) { const int ch = ((2 * s + hi) ^ ksw) << 4; ka[s] = *(LAS const bf16x8*)(Kt + r32 * 128 + ch); kb[s] = *(LAS const bf16x8*)(Kt + (32 + r32) * 128 + ch); }
  asm volatile("s_waitcnt lgkmcnt(0)" ::: "memory");
  after_k();
  { const f32x16 z = {0.f, 0.f, 0.f, 0.f, 0.f, 0.f, 0.f, 0.f, 0.f, 0.f, 0.f, 0.f, 0.f, 0.f, 0.f, 0.f};
    p0 = __builtin_amdgcn_mfma_f32_32x32x16_bf16(ka[0], qf[0], z, 0, 0, 0); p1 = __builtin_amdgcn_mfma_f32_32x32x16_bf16(kb[0], qf[0], z, 0, 0, 0); }
#pragma unroll
  for (int s = 1; s < 4; ++s) { p0 = __builtin_amdgcn_mfma_f32_32x32x16_bf16(ka[s], qf[s], p0, 0, 0, 0); p1 = __builtin_amdgcn_mfma_f32_32x32x16_bf16(kb[s], qf[s], p1, 0, 0, 0); }
  maskf(p0, p1);
  float ps = 0.f;
#pragma unroll
  for (int i = 0; i < 16; ++i) { p0[i] = __builtin_amdgcn_exp2f(p0[i]); p1[i] = __builtin_amdgcn_exp2f(p1[i]); ps += p0[i] + p1[i]; }
  st.l += ps;
  u32x4 pw[4];
#pragma unroll
  for (int k = 0; k < 2; ++k) {
    pw[k] = (u32x4){pk2(p0[8 * k + 0], p0[8 * k + 1]), pk2(p0[8 * k + 2], p0[8 * k + 3]), pk2(p0[8 * k + 4], p0[8 * k + 5]), pk2(p0[8 * k + 6], p0[8 * k + 7])};
    pw[2 + k] = (u32x4){pk2(p1[8 * k + 0], p1[8 * k + 1]), pk2(p1[8 * k + 2], p1[8 * k + 3]), pk2(p1[8 * k + 4], p1[8 * k + 5]), pk2(p1[8 * k + 6], p1[8 * k + 7])};
  }
  before_v();
  const int q = (lane & 15) >> 2, p = lane & 3, gsel = (lane >> 4) & 1;
  const int vrow = (4 * hi + q) * 128 + 8 * (p & 1);
  const int chb = 2 * gsel + (p >> 1);
  s16x4 vl0[4], vh0[4], vl1[4], vh1[4];
#pragma unroll
  for (int ks = 0; ks < 4; ++ks) {
    const int c0_ = ((chb | ((0 ^ (q >> 1)) << 2)) << 4), c1_ = ((chb | ((1 ^ (q >> 1)) << 2)) << 4);
    vl0[ks] = vtr(Vt + ks * 2048 + vrow + c0_); vh0[ks] = vtr(Vt + ks * 2048 + 1024 + vrow + c0_); vl1[ks] = vtr(Vt + ks * 2048 + vrow + c1_); vh1[ks] = vtr(Vt + ks * 2048 + 1024 + vrow + c1_);
  }
  asm volatile("s_waitcnt lgkmcnt(0)" ::: "memory");
  after_v();
#pragma unroll
  for (int ks = 0; ks < 4; ++ks) {
    const bf16x8 va0 = (bf16x8){vl0[ks][0], vl0[ks][1], vl0[ks][2], vl0[ks][3], vh0[ks][0], vh0[ks][1], vh0[ks][2], vh0[ks][3]}, va1 = (bf16x8){vl1[ks][0], vl1[ks][1], vl1[ks][2], vl1[ks][3], vh1[ks][0], vh1[ks][1], vh1[ks][2], vh1[ks][3]};
    st.o0 = __builtin_amdgcn_mfma_f32_32x32x16_bf16(va0, __builtin_bit_cast(bf16x8, pw[ks]), st.o0, 0, 0, 0);
    st.o1 = __builtin_amdgcn_mfma_f32_32x32x16_bf16(va1, __builtin_bit_cast(bf16x8, pw[ks]), st.o1, 0, 0, 0);
  }
}
__device__ __forceinline__ void glds16(const void* sbase  , unsigned voff  , unsigned lds_dst) {
  unsigned keep;
  asm volatile("s_mov_b32 %0, m0\n\ts_mov_b32 m0, %2\n\ts_nop 0\n\tglobal_load_lds_dwordx4 %1, %3\n\ts_mov_b32 m0, %0" : "=&s"(keep) : "v"(voff), "s"(lds_dst), "s"(sbase) : "memory");
}
__device__ __forceinline__ void attn_store(const AttnState& st, float inv, const bf16* grow  , bf16* yrow  , int lane) {
  const int hi = lane >> 5;
  u32x2 gv[8];
#pragma unroll
  for (int i = 0; i < 8; ++i) gv[i] = *(const u32x2*)(grow + 32 * (i >> 2) + 8 * (i & 3) + 4 * hi);
  __builtin_amdgcn_sched_barrier(0);
#pragma unroll
  for (int d0 = 0; d0 < 2; ++d0)
#pragma unroll
    for (int gi = 0; gi < 4; ++gi) {
      const int db = 32 * d0 + 8 * gi + 4 * hi; const u32x2 g = gv[4 * d0 + gi];
      const f32x16& o = d0 == 0 ? st.o0 : st.o1;
      const float g0 = __uint_as_float(g.x << 16), g1 = __uint_as_float(g.x & 0xffff0000u), g2 = __uint_as_float(g.y << 16), g3 = __uint_as_float(g.y & 0xffff0000u);
      u32x2 ov; ov.x = pk2(o[4 * gi + 0] * inv * g0, o[4 * gi + 1] * inv * g1); ov.y = pk2(o[4 * gi + 2] * inv * g2, o[4 * gi + 3] * inv * g3);
      *(u32x2*)(yrow + db) = ov;
    }
}
template <int NH> struct TileRegs { u32x4 k[NH], v[NH]; };
template <int NH>
__device__ __forceinline__ void tile_load(TileRegs<NH>& R, const bf16* kbase  , const bf16* vbase, int tid) {
  const int key = tid >> 3, ch = tid & 7;
#pragma unroll
  for (int h = 0; h < NH; ++h) { R.k[h] = *(const u32x4*)(kbase + (size_t)key * PLW + h * 64 + ch * 8); R.v[h] = *(const u32x4*)(vbase + (size_t)key * PLW + h * 64 + ch * 8); }
}
template <int NH>
__device__ __forceinline__ void tile_store(const TileRegs<NH>& R, LAS unsigned char* buf, int tid) {
  const int key = tid >> 3, ch = tid & 7;
  const int ko = key * 128 + ((ch ^ ((key >> 1) & 7)) << 4), vo = key * 128 + ((ch ^ (((key >> 1) & 1) << 2)) << 4);
#pragma unroll
  for (int h = 0; h < NH; ++h) { *(LAS u32x4*)(buf + h * 8192 + ko) = R.k[h]; *(LAS u32x4*)(buf + NH * 8192 + h * 8192 + vo) = R.v[h]; }
}

template <int NH> struct TileRegs2 { TileRegs<NH> a, b; };
__device__ __forceinline__ void swa_item(const Frame& F0, const Args& a, int layer, int item) {
  const Frame F = relaunder(F0);
  unsigned char* ws = opq(a.ws);
  const bf16* PLB = (const bf16*)(ws + WS_PLB); bf16* Y = (bf16*)(ws + WS_H);
  const bool isctx = item >= 256;
  int b, kvh, n;
  if (!isctx) { b = item >> 6; kvh = (item >> 5) & 1; n = item & 31; } else { const int ci = item - 256; b = ci >> 2; kvh = (ci >> 1) & 1; n = ci & 1; }
  const int g = F.wave >> 2, quarter = F.wave & 3, hq = 2 * kvh + g, r32 = F.lane & 31, hi = F.lane >> 5;
  const int tq = 128 * n + 32 * quarter + r32;
  const size_t qrow = isctx ? (size_t)MLAT + b * CTX + tq : (size_t)b * SEQ + tq;
  bf16x8 qf[4];
#pragma unroll
  for (int s = 0; s < 4; ++s) qf[s] = *(const bf16x8*)(PLB + qrow * PLW + S_CQ * 256 + hq * 64 + 16 * s + 8 * hi);
  int jlo = 0, jhi = 0;
  if (!isctx) { jlo = n == 0 ? 1 : 0; jhi = n == 31 ? 2 : 3; }
  const int nloc = jhi - jlo, T = nloc + 2;
  const bf16* kcol = PLB + S_CKV * 256 + kvh * 64;
  auto tile_row = [&](int t) -> size_t { return t < nloc ? (size_t)b * SEQ + 128 * (n - 1 + jlo + t) : (size_t)MLAT + b * CTX + 128 * (t - nloc); };
  AttnState st; st.m = 0.f; st.l = 0.f;
#pragma unroll
  for (int i = 0; i < 16; ++i) { st.o0[i] = 0.f; st.o1[i] = 0.f; }
  TileRegs2<1> R;
  __syncthreads();
  { const size_t r0 = tile_row(0); tile_load<1>(R.a, kcol + r0 * PLW, kcol + 128 + r0 * PLW, F.tid); tile_load<1>(R.b, kcol + (r0 + 64) * PLW, kcol + 128 + (r0 + 64) * PLW, F.tid); }
  tile_store<1>(R.a, F.lds, F.tid); tile_store<1>(R.b, F.lds + 16384, F.tid);
  __syncthreads();
  for (int t = 0; t < T; ++t) {
    if (t + 1 < T) { const size_t r0 = tile_row(t + 1); tile_load<1>(R.a, kcol + r0 * PLW, kcol + 128 + r0 * PLW, F.tid); tile_load<1>(R.b, kcol + (r0 + 64) * PLW, kcol + 128 + (r0 + 64) * PLW, F.tid); }
    LAS const unsigned char* buf = F.lds + (t & 1) * 32768;
#pragma unroll
    for (int hf = 0; hf < 2; ++hf) {
      LAS const unsigned char* hb = buf + hf * 16384;
      if (t < nloc) {
        const int kb = 128 * (n - 1 + jlo + t) + 64 * hf, q0 = 128 * n + 32 * quarter;
        if (!(kb + 63 < q0 - 128 || kb > q0 + 31 + 128)) {
          const int dq = kb - tq;
          if (kb >= q0 + 31 - 128 && kb + 63 <= q0 + 128) attn_tile(st, qf, hb, hb + 8192, F.lane, [](f32x16&, f32x16&) {});
          else attn_tile(st, qf, hb, hb + 8192, F.lane, [&](f32x16& p0, f32x16& p1) {
#pragma unroll
            for (int r = 0; r < 16; ++r) { const int d0_ = dq + 128 + crow(r, hi), d1_ = d0_ + 32;
              p0[r] = ((unsigned)d0_ <= 256u) ? p0[r] : -INFINITY; p1[r] = ((unsigned)d1_ <= 256u) ? p1[r] : -INFINITY; } });
        }
      } else attn_tile(st, qf, hb, hb + 8192, F.lane, [](f32x16&, f32x16&) {});
    }
    if (t + 1 < T) { tile_store<1>(R.a, F.lds + ((t + 1) & 1) * 32768, F.tid); tile_store<1>(R.b, F.lds + ((t + 1) & 1) * 32768 + 16384, F.tid); }
    __syncthreads();
  }
  float l = st.l + __shfl_xor(st.l, 32);
  const float sk2 = opq(a.in[15])[layer * 4 + hq] * LOG2E;
  const float mnew = fmaxf(st.m, sk2), al = __builtin_amdgcn_exp2f(st.m - mnew);
  l = l * al + __builtin_amdgcn_exp2f(sk2 - mnew);
  int qr = (int)qrow; asm volatile("" : "+v"(qr));
  attn_store(st, al / l, PLB + (size_t)qr * PLW + S_CG * 256 + hq * 64, Y + (size_t)qr * 1024 + 512 + hq * 64, F.lane);
}
__device__ __forceinline__ void na_item(const Frame& F0, const Args& a, int layer, int item) {
  const Frame F = relaunder(F0);
  unsigned char* ws = opq(a.ws);
  const bf16* PLB = (const bf16*)(ws + WS_PLB); bf16* Y = (bf16*)(ws + WS_H);
  const bool isctx = item >= 256;
  int b, r;
  if (!isctx) { b = item >> 6; r = item & 63; } else { const int ci = item - 256; b = ci >> 2; r = ci & 3; }
  const int head = F.wave >> 1, half = F.wave & 1, r32 = F.lane & 31, hi = F.lane >> 5;
  const int qc = 32 * half + r32;
  const size_t qrow = isctx ? (size_t)MLAT + b * CTX + 64 * r + qc : (size_t)b * SEQ + 64 * r + qc;
  bf16x8 qf[4];
#pragma unroll
  for (int s = 0; s < 4; ++s) qf[s] = *(const bf16x8*)(PLB + qrow * PLW + S_DQ * 256 + head * 64 + 16 * s + 8 * hi);
  int rs = r - 4; rs = rs < 0 ? 0 : (rs > 56 ? 56 : rs);
  const int nloc = isctx ? 0 : 8, T = nloc + 4;
  auto tile_row = [&](int t) -> size_t { return t < nloc ? (size_t)b * SEQ + 64 * (rs + t) : (size_t)MLAT + b * CTX + 64 * (t - nloc); };
  const bf16* kcol = PLB + S_DK * 256 + head * 64; const bf16* vcol = PLB + S_DV * 256 + head * 64;
  LAS float* btab = (LAS float*)(F.lds + 2 * 65536);
  LAS unsigned char* Kt = F.lds + F.wave * 16384; LAS unsigned char* Vt = Kt + 8192;
  const unsigned kdst = (unsigned)(size_t)Kt, vdst = kdst + 8192u;
  const int kk = F.lane >> 3, cs = F.lane & 7;
  const unsigned ok0 = kk * (PLW * 2) + ((cs ^ (kk >> 1)) << 4), ok1 = kk * (PLW * 2) + ((cs ^ (4 + (kk >> 1))) << 4), ov = kk * (PLW * 2) + ((cs ^ (((kk >> 1) & 1) << 2)) << 4);
  auto dma_k = [&](int t) { const unsigned char* tb = (const unsigned char*)(kcol + tile_row(t) * PLW);
#pragma unroll
    for (int n = 0; n < 8; ++n) glds16(tb + (size_t)n * 8 * (PLW * 2), (n & 1) ? ok1 : ok0, kdst + n * 1024); };
  auto dma_v = [&](int t) { const unsigned char* tb = (const unsigned char*)(vcol + tile_row(t) * PLW);
#pragma unroll
    for (int n = 0; n < 8; ++n) glds16(tb + (size_t)n * 8 * (PLW * 2), ov, vdst + n * 1024); };
  AttnState st; st.m = 0.f; st.l = 0.f;
#pragma unroll
  for (int i = 0; i < 16; ++i) { st.o0[i] = 0.f; st.o1[i] = 0.f; }
#pragma unroll
  for (int s = 0; s < 4; ++s) asm volatile("" : "+v"(qf[s]));
  __syncthreads();
  dma_k(0); dma_v(0);
  {
    const float* rb = opq(a.in[18]) + (size_t)layer * 4 * 15 * 31; float t_[15];
#pragma unroll
    for (int i = 0; i < 15; ++i) { const int ix = F.tid + 512 * i, hd = ix >> 7, dx = (ix & 127) - 63; const int dc = dx < -15 ? -15 : (dx > 15 ? 15 : dx); t_[i] = rb[hd * 31 + dc + 15]; }
    __builtin_amdgcn_sched_barrier(0);
#pragma unroll
    for (int i = 0; i < 15; ++i) { const int dx = ((F.tid + 512 * i) & 127) - 63; btab[F.tid + 512 * i] = (dx >= -15 && dx <= 15) ? t_[i] * LOG2E : 0.f; } }
  __syncthreads();
  int c0 = qc - 8; c0 = c0 < 0 ? 0 : (c0 > 48 ? 48 : c0);
  for (int t = 0; t < T; ++t) {
    const bool more = t + 1 < T;
    asm volatile("s_waitcnt vmcnt(8)" ::: "memory");
    auto after_k = [&]() { if (more) dma_k(t + 1); };
    auto before_v = [&]() { if (more) asm volatile("s_waitcnt vmcnt(8)" ::: "memory"); else asm volatile("s_waitcnt vmcnt(0)" ::: "memory"); };
    auto after_v = [&]() { if (more) dma_v(t + 1); };
    if (t < nloc) {
      const int dy = rs + t - r + 7;
      const int c0l = c0;
      unsigned bta = (unsigned)(size_t)(btab + (head * 15 + dy) * 128 + 63 - qc + 4 * hi); asm volatile("" : "+v"(bta));
      LAS const float* bt = (LAS const float*)bta;
      attn_tile_dma(st, qf, Kt, Vt, F.lane, [&](f32x16& p0, f32x16& p1) {
        float bb[16];
#pragma unroll
        for (int rr = 0; rr < 16; ++rr) bb[rr] = bt[(rr & 3) + 8 * (rr >> 2)];
#pragma unroll
        for (int rr = 0; rr < 16; ++rr) p0[rr] = ((unsigned)((rr & 3) + 8 * (rr >> 2) + 4 * hi - c0l) < 16u) ? p0[rr] + bb[rr] : -INFINITY;
#pragma unroll
        for (int rr = 0; rr < 16; ++rr) bb[rr] = bt[(rr & 3) + 8 * (rr >> 2) + 32];
#pragma unroll
        for (int rr = 0; rr < 16; ++rr) p1[rr] = ((unsigned)((rr & 3) + 8 * (rr >> 2) + 32 + 4 * hi - c0l) < 16u) ? p1[rr] + bb[rr] : -INFINITY; }, after_k, before_v, after_v);
    } else attn_tile_dma(st, qf, Kt, Vt, F.lane, [](f32x16&, f32x16&) {}, after_k, before_v, after_v);
  }
  const float l = st.l + __shfl_xor(st.l, 32);
  int qr = (int)qrow; asm volatile("" : "+v"(qr));
  attn_store(st, 1.f / l, PLB + (size_t)qr * PLW + S_DG * 256 + head * 64, Y + (size_t)qr * 1024 + 768 + head * 64, F.lane);
}
}

namespace mk {
constexpr int XT_STRIDE = 272;
constexpr int FFT_WC = 256 * XT_STRIDE;
__device__ __forceinline__ void fft_item(const Frame& F0, const Args& a, int item) {
  const Frame F = relaunder(F0);
  unsigned char* ws = opq(a.ws);
  const bf16* PLB = (const bf16*)(ws + WS_PLB); bf16* Y = (bf16*)(ws + WS_H);
  const int b = item >> 6, slice = item & 63, r32 = F.lane & 31, hi = F.lane >> 5, w = F.wave;
  LAS unsigned char* Xt = F.lds; LAS unsigned char* Wl = F.lds + FFT_WC;
  __syncthreads();
  {
    const bf16* WC = (const bf16*)(ws + WS_WC);
    u32x4 wt[4];
#pragma unroll
    for (int i = 0; i < 4; ++i) { const int idx = F.tid + 512 * i, row = idx >> 4, ch = idx & 15; wt[i] = *(const u32x4*)(WC + row * 128 + ch * 8); }
    const bf16* src = (const bf16*)(ws + WS_FA2) + ((size_t)b * 64 + slice) * TROW * 8;
    u32x4 v[8];
#pragma unroll
    for (int i = 0; i < 8; ++i) v[i] = *(const u32x4*)(src + (size_t)(F.tid + 512 * i) * 8);
    __builtin_amdgcn_sched_barrier(0);
#pragma unroll
    for (int i = 0; i < 4; ++i) { const int idx = F.tid + 512 * i, row = idx >> 4, ch = idx & 15; *(LAS u32x4*)(Wl + row * XT_STRIDE + ch * 16) = wt[i]; }
#pragma unroll
    for (int i = 0; i < 8; ++i) { const int t = F.tid + 512 * i, n1 = t >> 6, n2 = t & 63;
      const unsigned vv[4] = {v[i].x, v[i].y, v[i].z, v[i].w};
#pragma unroll
      for (int j = 0; j < 8; ++j) { const int c = j & 3, part = j >> 2; const unsigned short e = (unsigned short)((j & 1) ? (vv[j >> 1] >> 16) : (vv[j >> 1] & 0xffffu));
        *(LAS unsigned short*)(Xt + (n2 * 4 + c) * XT_STRIDE + (part * 64 + n1) * 2) = e; } }
  }
  __syncthreads();
  f32x16 acc[4];
#pragma unroll
  for (int rb = 0; rb < 4; ++rb)
#pragma unroll
    for (int i = 0; i < 16; ++i) acc[rb][i] = 0.f;
  {
    bf16x8 bf[8];
#pragma unroll
    for (int s = 0; s < 8; ++s) bf[s] = *(LAS const bf16x8*)(Xt + (32 * w + r32) * XT_STRIDE + (16 * s + 8 * hi) * 2);
#pragma unroll
    for (int rb = 0; rb < 4; ++rb)
#pragma unroll
      for (int s = 0; s < 8; ++s) { const bf16x8 af = *(LAS const bf16x8*)(Wl + (32 * rb + r32) * XT_STRIDE + (16 * s + 8 * hi) * 2); acc[rb] = __builtin_amdgcn_mfma_f32_32x32x16_bf16(af, bf[s], acc[rb], 0, 0, 0); }
  }
  __syncthreads();
  {
    const int n2 = 8 * w + (r32 >> 2), c = r32 & 3;
#pragma unroll
    for (int rbp = 0; rbp < 2; ++rbp)
#pragma unroll
      for (int r = 0; r < 16; ++r) { const int k1 = 32 * rbp + crow(r, hi); float x = (float)((k1 * n2) & 4095) * (1.f / 4096.f);
        asm volatile("" : "+v"(x) :: "memory");
        const float tc = __builtin_amdgcn_cosf(x), ts = __builtin_amdgcn_sinf(x);
        const float yr = acc[rbp][r], yi = acc[rbp + 2][r];
        const float zr = yr * tc + yi * ts, zi = yi * tc - yr * ts;
        LAS unsigned char* zp = Xt + (k1 * 4 + c) * XT_STRIDE + n2 * 2;
        *(LAS unsigned short*)zp = (unsigned short)f2bf(zr); *(LAS unsigned short*)(zp + 128) = (unsigned short)f2bf(zi); }
  }
  __syncthreads();
  f32x16 o2[2];
#pragma unroll
  for (int rb = 0; rb < 2; ++rb)
#pragma unroll
    for (int i = 0; i < 16; ++i) o2[rb][i] = 0.f;
  {
    bf16x8 bf[8];
#pragma unroll
    for (int s = 0; s < 8; ++s) bf[s] = *(LAS const bf16x8*)(Xt + (32 * w + r32) * XT_STRIDE + (16 * s + 8 * hi) * 2);
#pragma unroll
    for (int rb = 0; rb < 2; ++rb)
#pragma unroll
      for (int s = 0; s < 8; ++s) { const bf16x8 af = *(LAS const bf16x8*)(Wl + (32 * rb + r32) * XT_STRIDE + (16 * s + 8 * hi) * 2); o2[rb] = __builtin_amdgcn_mfma_f32_32x32x16_bf16(af, bf[s], o2[rb], 0, 0, 0); }
  }
  __syncthreads();
  { const int k1 = 8 * w + (r32 >> 2), c = r32 & 3;
#pragma unroll
    for (int rb = 0; rb < 2; ++rb)
#pragma unroll
      for (int r = 0; r < 16; ++r) { const int k = k1 + 64 * (32 * rb + crow(r, hi)); *(LAS unsigned short*)(Xt + k * 8 + c * 2) = (unsigned short)f2bf(o2[rb][r]); }
  }
  __syncthreads();
  { const int o0 = 4 * slice; u32x2 gv[8];
#pragma unroll
    for (int i = 0; i < 8; ++i) gv[i] = *(const u32x2*)(PLB + ((size_t)b * SEQ + F.tid + 512 * i) * PLW + S_BG * 256 + o0);
    __builtin_amdgcn_sched_barrier(0);
#pragma unroll
    for (int i = 0; i < 8; ++i) { const int k = F.tid + 512 * i; const size_t row = (size_t)b * SEQ + k;
      const u32x2 ov = *(LAS const u32x2*)(Xt + k * 8);
      u32x2 y; y.x = pk2(__uint_as_float(ov.x << 16) * __uint_as_float(gv[i].x << 16), __uint_as_float(ov.x & 0xffff0000u) * __uint_as_float(gv[i].x & 0xffff0000u));
      y.y = pk2(__uint_as_float(ov.y << 16) * __uint_as_float(gv[i].y << 16), __uint_as_float(ov.y & 0xffff0000u) * __uint_as_float(gv[i].y & 0xffff0000u));
      *(u32x2*)(Y + row * 1024 + 256 + o0) = y; }
  }
}
constexpr int XC_STRIDE = 1040;
__device__ __forceinline__ void fftc_item(const Frame& F0, const Args& a, int item) {
  const Frame F = relaunder(F0);
  unsigned char* ws = opq(a.ws);
  const bf16* PLB = (const bf16*)(ws + WS_PLB); bf16* Y = (bf16*)(ws + WS_H);
  const bf16* CS = (const bf16*)(ws + WS_CS256);
  const int b = item >> 3, cs = item & 7, r32 = F.lane & 31, hi = F.lane >> 5, w = F.wave;
  LAS unsigned char* Xc = F.lds;
  __syncthreads();
  u32x4 vq[4];
#pragma unroll
  for (int i = 0; i < 4; ++i) { const int idx = F.tid + 512 * i, sl = idx >> 8, n = idx & 255;
    vq[i] = *(const u32x4*)((const bf16*)(ws + WS_FA2) + (((size_t)b * 64 + 8 * cs + sl) * TROW + SEQ + n) * 8); }
  __builtin_amdgcn_sched_barrier(0);
#pragma unroll
  for (int i = 0; i < 4; ++i) { const int idx = F.tid + 512 * i, sl = idx >> 8, n = idx & 255;
    const unsigned vv[4] = {vq[i].x, vq[i].y, vq[i].z, vq[i].w};
#pragma unroll
    for (int j = 0; j < 8; ++j) { const int c = j & 3, part = j >> 2; const unsigned short e = (unsigned short)((j & 1) ? (vv[j >> 1] >> 16) : (vv[j >> 1] & 0xffffu));
      *(LAS unsigned short*)(Xc + (4 * sl + c) * XC_STRIDE + (part * 256 + n) * 2) = e; } }
  __syncthreads();
  f32x16 acc;
#pragma unroll
  for (int i = 0; i < 16; ++i) acc[i] = 0.f;
#pragma unroll 1
  for (int s0 = 0; s0 < 32; s0 += 8) {
    bf16x8 af[8];
#pragma unroll
    for (int j = 0; j < 8; ++j) af[j] = *(const bf16x8*)(CS + (size_t)(32 * w + r32) * 512 + 16 * (s0 + j) + 8 * hi);
    __builtin_amdgcn_sched_barrier(0);
#pragma unroll
    for (int j = 0; j < 8; ++j) {
      const bf16x8 bf = *(LAS const bf16x8*)(Xc + r32 * XC_STRIDE + (16 * (s0 + j) + 8 * hi) * 2);
      acc = __builtin_amdgcn_mfma_f32_32x32x16_bf16(af[j], bf, acc, 0, 0, 0);
    }
  }
  const int o = 32 * cs + r32;
  bf16 gq[16];
#pragma unroll
  for (int r = 0; r < 16; ++r) { const size_t row = (size_t)MLAT + b * CTX + 32 * w + crow(r, hi); gq[r] = PLB[row * PLW + S_BG * 256 + o]; }
  __builtin_amdgcn_sched_barrier(0);
#pragma unroll
  for (int r = 0; r < 16; ++r) { const size_t row = (size_t)MLAT + b * CTX + 32 * w + crow(r, hi);
    Y[row * 1024 + 256 + o] = (bf16)f2bf(acc[r] * bf2f(gq[r])); }
}
}

namespace mk {
constexpr int GU_STRIDE = 2048 + 64;
constexpr size_t WS_GU = WS_SCR, WS_GS = WS_GU + (size_t)32 * 68 * GU_STRIDE * 4;
__device__ __forceinline__ size_t gla_row(int b, int c, int i) { return c < 64 ? (size_t)b * SEQ + 64 * c + i : (size_t)MLAT + b * CTX + 64 * (c - 64) + i; }
__device__ __forceinline__ int gla_pos(int c, int dir) { return c < 64 ? (dir ? 4 + 63 - c : 4 + c) : (dir ? 3 - (c - 64) : (c - 64)); }
__device__ __forceinline__ void gla_stage_v(const Frame& F, const bf16* PLB, int b, int c, LAS unsigned char* vbase) {
  const int key = F.tid >> 3, ch = F.tid & 7;
  const bf16* src = PLB + gla_row(b, c, key) * PLW + S_AV * 256 + ch * 8;
  const int vo = key * 128 + ((ch ^ (((key >> 1) & 1) << 2)) << 4);
  u32x4 t_[4];
#pragma unroll
  for (int h = 0; h < 4; ++h) t_[h] = *(const u32x4*)(src + h * 64);
#pragma unroll
  for (int h = 0; h < 4; ++h) *(LAS u32x4*)(vbase + h * 8192 + vo) = t_[h];
}
__device__ __forceinline__ void gla_cum(const float* LA, int b, int c, int h, int dir, int lane, float (&cw)[32], float& T) {
  const int d = lane & 31, half = lane >> 5;
  float a[32];
#pragma unroll
  for (int ii = 0; ii < 32; ++ii) a[ii] = LA[gla_row(b, c, 32 * half + ii) * 256 + dir * 128 + h * 32 + d];
  float run = 0.f;
#pragma unroll
  for (int ii = 0; ii < 32; ++ii) { run += a[ii]; cw[ii] = run; }
  const float other = __shfl_xor(run, 32);
  const float tot0 = half ? other : run;
  T = run + other;
#pragma unroll
  for (int ii = 0; ii < 32; ++ii) { const float cf = cw[ii] + (half ? tot0 : 0.f); cw[ii] = dir ? (T - cf + a[ii]) : cf; }
}
constexpr int KT_STRIDE = 144;
__device__ __forceinline__ void gla_local_item(const Frame& F0, const Args& a, int item) {
  const Frame F = relaunder(F0);
  unsigned char* ws = opq(a.ws);
  const bf16* PLB = (const bf16*)(ws + WS_PLB); const float* LA = (const float*)(ws + WS_LA);
  const int b = item / 68, c = item % 68, h = F.wave >> 1, dir = F.wave & 1, d = F.lane & 31, half = F.lane >> 5, r32 = d, hi = half;
  LAS unsigned char* Vt = F.lds + h * 8192; LAS unsigned char* KT = F.lds + 32768 + F.wave * (32 * KT_STRIDE);
  __syncthreads();
  gla_stage_v(F, PLB, b, c, F.lds);
  float cw[32], T;
  gla_cum(LA, b, c, h, dir, F.lane, cw, T);
  {
    unsigned pkd[16]; bf16 kr[32];
    const bf16* kp = PLB + gla_row(b, c, 32 * half) * PLW + S_AQK * 256 + 128 + h * 32 + d;
#pragma unroll
    for (int ii = 0; ii < 32; ++ii) kr[ii] = kp[(size_t)ii * PLW];
#pragma unroll
    for (int ii = 0; ii < 32; ii += 2) pkd[ii >> 1] = pk2(bf2f(kr[ii]) * __expf(T - cw[ii]), bf2f(kr[ii + 1]) * __expf(T - cw[ii + 1]));
#pragma unroll
    for (int q4 = 0; q4 < 4; ++q4) *(LAS u32x4*)(KT + d * KT_STRIDE + half * 64 + q4 * 16) = (u32x4){pkd[4 * q4], pkd[4 * q4 + 1], pkd[4 * q4 + 2], pkd[4 * q4 + 3]};
  }
  __syncthreads();
  f32x16 acc[2];
#pragma unroll
  for (int eb = 0; eb < 2; ++eb)
#pragma unroll
    for (int i = 0; i < 16; ++i) acc[eb][i] = 0.f;
  const int q = (F.lane & 15) >> 2, p = F.lane & 3, gsel = (F.lane >> 4) & 1;
  const int chb = 2 * gsel + (p >> 1);
#pragma unroll
  for (int st = 0; st < 4; ++st) {
    const bf16x8 kb = *(LAS const bf16x8*)(KT + r32 * KT_STRIDE + (16 * st + 8 * hi) * 2);
#pragma unroll
    for (int eb = 0; eb < 2; ++eb) {
      const int ch = ((chb | ((eb ^ (q >> 1)) << 2)) << 4);
      LAS const unsigned char* vp = Vt + (16 * st + 8 * hi + q) * 128 + 8 * (p & 1) + ch;
      const s16x4 lo = vtr(vp), hh = vtr(vp + 512);
      const bf16x8 va = (bf16x8){lo[0], lo[1], lo[2], lo[3], hh[0], hh[1], hh[2], hh[3]};
      acc[eb] = __builtin_amdgcn_mfma_f32_32x32x16_bf16(va, kb, acc[eb], 0, 0, 0);
    }
  }
  const int chain = (b * 4 + h) * 2 + dir, pos = gla_pos(c, dir);
  float* gu = (float*)(ws + WS_GU) + ((size_t)chain * 68 + pos) * GU_STRIDE;
#pragma unroll
  for (int eb = 0; eb < 2; ++eb)
#pragma unroll
    for (int r = 0; r < 16; ++r) gu[(32 * eb + crow(r, hi)) * 32 + r32] = acc[eb][r];
  if (half == 0) gu[2048 + d] = __expf(T);
}
__device__ __forceinline__ void gla_scan(const Frame& F0, const Args& a) {
  const Frame F = relaunder(F0);
  unsigned char* ws = opq(a.ws);
  if (F.tid >= 256) return;
  for (int gt = F.vcu * 256 + F.tid; gt < 32 * 2048; gt += F.G * 256) {
    const int chain = gt >> 11, el = gt & 2047, d = el & 31;
    const float* gu = (const float*)(ws + WS_GU) + (size_t)chain * 68 * GU_STRIDE;
    bf16* gs = (bf16*)(ws + WS_GS) + (size_t)chain * 68 * 2048 + el;
    float S = 0.f;
#pragma unroll 1
    for (int p0 = 0; p0 < 68; p0 += 34) {
      float dc[34], uu[34];
#pragma unroll
      for (int i = 0; i < 34; ++i) { dc[i] = gu[(size_t)(p0 + i) * GU_STRIDE + 2048 + d]; uu[i] = gu[(size_t)(p0 + i) * GU_STRIDE + el]; }
      __builtin_amdgcn_sched_barrier(0);
#pragma unroll
      for (int i = 0; i < 34; ++i) { gs[(size_t)(p0 + i) * 2048] = (bf16)f2bf(S); S = dc[i] * S + uu[i]; }
    }
  }
}
constexpr int QK_STRIDE = 80;
__device__ __forceinline__ void gla_out_item(const Frame& F0, const Args& a, int layer, int item) {
  const Frame F = relaunder(F0);
  unsigned char* ws = opq(a.ws);
  const bf16* PLB = (const bf16*)(ws + WS_PLB); const float* LA = (const float*)(ws + WS_LA); bf16* Y = (bf16*)(ws + WS_H);
  const int b = item / 68, c = item % 68, h = F.wave >> 1, dir = F.wave & 1, d = F.lane & 31, half = F.lane >> 5, r32 = d, hi = half;
  LAS unsigned char* Vt = F.lds + h * 8192;
  LAS unsigned char* QT = F.lds + 32768 + F.wave * (2 * 64 * QK_STRIDE); LAS unsigned char* KT = QT + 64 * QK_STRIDE;
  LAS float* X = (LAS float*)(F.lds + 32768) + h * 4096;
  __syncthreads();
  gla_stage_v(F, PLB, b, c, F.lds);
  {
    float cw[32], T;
    gla_cum(LA, b, c, h, dir, F.lane, cw, T);
    bf16 qr[32], kr[32];
    const bf16* pr = PLB + gla_row(b, c, 32 * half) * PLW + S_AQK * 256 + h * 32 + d;
#pragma unroll
    for (int ii = 0; ii < 32; ++ii) { qr[ii] = pr[(size_t)ii * PLW]; kr[ii] = pr[(size_t)ii * PLW + 128]; }
#pragma unroll
    for (int ii = 0; ii < 32; ++ii) { const int i = 32 * half + ii;
      const float ec = __expf(cw[ii]);
      *(LAS unsigned short*)(QT + i * QK_STRIDE + d * 2) = (unsigned short)f2bf(bf2f(qr[ii]) * ec);
      *(LAS unsigned short*)(KT + i * QK_STRIDE + d * 2) = (unsigned short)f2bf(bf2f(kr[ii]) * __builtin_amdgcn_rcpf(ec)); }
  }
  __syncthreads();
  f32x16 oacc[2][2];
#pragma unroll
  for (int eb = 0; eb < 2; ++eb)
#pragma unroll
    for (int ib = 0; ib < 2; ++ib)
#pragma unroll
      for (int i = 0; i < 16; ++i) oacc[eb][ib][i] = 0.f;
  bf16x8 qb[2][2];
#pragma unroll
  for (int ib = 0; ib < 2; ++ib)
#pragma unroll
    for (int st = 0; st < 2; ++st) qb[ib][st] = *(LAS const bf16x8*)(QT + (32 * ib + r32) * QK_STRIDE + (16 * st + 8 * hi) * 2);
  const int chain = (b * 4 + h) * 2 + dir, pos = gla_pos(c, dir);
  {
    const bf16* gs = (const bf16*)(ws + WS_GS) + ((size_t)chain * 68 + pos) * 2048;
#pragma unroll
    for (int eb = 0; eb < 2; ++eb)
#pragma unroll
      for (int st = 0; st < 2; ++st) { const bf16x8 sf = *(const bf16x8*)(gs + (32 * eb + r32) * 32 + 16 * st + 8 * hi);
#pragma unroll
        for (int ib = 0; ib < 2; ++ib) oacc[eb][ib] = __builtin_amdgcn_mfma_f32_32x32x16_bf16(sf, qb[ib][st], oacc[eb][ib], 0, 0, 0); }
  }
  const int q = (F.lane & 15) >> 2, p = F.lane & 3, gsel = (F.lane >> 4) & 1;
  const int vrow = (4 * hi + q) * 128 + 8 * (p & 1), chb = 2 * gsel + (p >> 1);
#pragma unroll
  for (int sb = 0; sb < 2; ++sb) {
    bf16x8 kf[2];
#pragma unroll
    for (int st = 0; st < 2; ++st) kf[st] = *(LAS const bf16x8*)(KT + (32 * sb + r32) * QK_STRIDE + (16 * st + 8 * hi) * 2);
#pragma unroll
    for (int ib = 0; ib < 2; ++ib) {
      const bool need = dir == 0 ? (sb <= ib) : (sb >= ib);
      if (!need) continue;
      f32x16 sc;
#pragma unroll
      for (int i = 0; i < 16; ++i) sc[i] = 0.f;
#pragma unroll
      for (int st = 0; st < 2; ++st) sc = __builtin_amdgcn_mfma_f32_32x32x16_bf16(kf[st], qb[ib][st], sc, 0, 0, 0);
      if (sb == ib) {
#pragma unroll
        for (int r = 0; r < 16; ++r) { const int s = crow(r, hi); const bool keep = dir == 0 ? (s <= r32) : (s >= r32); sc[r] = keep ? sc[r] : 0.f; }
      }
      u32x4 pw[2];
#pragma unroll
      for (int k = 0; k < 2; ++k) pw[k] = (u32x4){pk2(sc[8 * k + 0], sc[8 * k + 1]), pk2(sc[8 * k + 2], sc[8 * k + 3]), pk2(sc[8 * k + 4], sc[8 * k + 5]), pk2(sc[8 * k + 6], sc[8 * k + 7])};
#pragma unroll
      for (int ks = 0; ks < 2; ++ks)
#pragma unroll
        for (int eb = 0; eb < 2; ++eb) {
          const int ch = ((chb | ((eb ^ (q >> 1)) << 2)) << 4);
          const s16x4 lo = vtr(Vt + (2 * sb + ks) * 2048 + vrow + ch), hh = vtr(Vt + (2 * sb + ks) * 2048 + 1024 + vrow + ch);
          const bf16x8 va = (bf16x8){lo[0], lo[1], lo[2], lo[3], hh[0], hh[1], hh[2], hh[3]};
          oacc[eb][ib] = __builtin_amdgcn_mfma_f32_32x32x16_bf16(va, __builtin_bit_cast(bf16x8, pw[ks]), oacc[eb][ib], 0, 0, 0);
        }
    }
  }
  __syncthreads();
  if (dir == 1) {
#pragma unroll
    for (int eb = 0; eb < 2; ++eb)
#pragma unroll
      for (int ib = 0; ib < 2; ++ib)
#pragma unroll
        for (int r = 0; r < 16; ++r) X[((eb * 2 + ib) * 16 + r) * 64 + F.lane] = oacc[eb][ib][r];
  }
  __syncthreads();
  if (dir == 0) {
    const float* on = opq(a.in[11]) + layer * 64;
    f32x4 w4s[8];
#pragma unroll
    for (int i = 0; i < 8; ++i) w4s[i] = *(const f32x4*)(on + 32 * (i >> 2) + 8 * (i & 3) + 4 * hi);
#pragma unroll
    for (int ib = 0; ib < 2; ++ib) {
      float ss = 0.f;
#pragma unroll
      for (int eb = 0; eb < 2; ++eb)
#pragma unroll
        for (int r = 0; r < 16; ++r) { oacc[eb][ib][r] += X[((eb * 2 + ib) * 16 + r) * 64 + F.lane]; ss += oacc[eb][ib][r] * oacc[eb][ib][r]; }
      ss += __shfl_xor(ss, 32);
      const float rs = 1.0f / sqrtf(ss * (1.f / 64.f) + 1e-6f);
      const size_t row = gla_row(b, c, 32 * ib + r32);
      u32x2 gv8[8];
#pragma unroll
      for (int i = 0; i < 8; ++i) gv8[i] = *(const u32x2*)(PLB + row * PLW + S_AG * 256 + h * 64 + 32 * (i >> 2) + 8 * (i & 3) + 4 * hi);
      __builtin_amdgcn_sched_barrier(0);
#pragma unroll
      for (int eb = 0; eb < 2; ++eb)
#pragma unroll
        for (int gi = 0; gi < 4; ++gi) {
          const int e0 = 32 * eb + 8 * gi + 4 * hi;
          const f32x4 w4 = w4s[4 * eb + gi];
          const u32x2 gv = gv8[4 * eb + gi];
          const float g0 = __uint_as_float(gv.x << 16), g1 = __uint_as_float(gv.x & 0xffff0000u), g2 = __uint_as_float(gv.y << 16), g3 = __uint_as_float(gv.y & 0xffff0000u);
          u32x2 ov; ov.x = pk2(oacc[eb][ib][4 * gi + 0] * rs * w4[0] * g0, oacc[eb][ib][4 * gi + 1] * rs * w4[1] * g1);
          ov.y = pk2(oacc[eb][ib][4 * gi + 2] * rs * w4[2] * g2, oacc[eb][ib][4 * gi + 3] * rs * w4[3] * g3);
          *(u32x2*)(Y + row * 1024 + h * 64 + e0) = ov;
        }
    }
  }
}
}

namespace mk {
__device__ __forceinline__ void p3_mixers(const Frame& F0, const Args& a, int layer) {
  const Frame F = relaunder(F0);
  const int nx = layer == 0 ? 16 : 0, nswa = 256 + nx, nna = 256 + nx, nfc = layer == 0 ? 32 : 0;
  for (int it = F.vcu; it < 272 + 256 + nfc + nswa + nna; it += F.G) {
    int r = it;
    if (r < 272) { gla_local_item(F, a, r); continue; } r -= 272;
    if (r < 256) { fft_item(F, a, r); continue; } r -= 256;
    if (r < nfc) { fftc_item(F, a, r); continue; } r -= nfc;
    if (r < nswa) swa_item(F, a, layer, r); else na_item(F, a, layer, r - nswa);
  }
}
__device__ __forceinline__ void p4b_glaout(const Frame& F0, const Args& a, int layer) {
  const Frame F = relaunder(F0);
  for (int it = F.vcu; it < 272; it += F.G) { if (layer == 1 && (it % 68) >= 64) continue; gla_out_item(F, a, layer, it); }
}
}
#define XB_TMO      128
#define XB_XCNT(j)  (256  + 64 * (j))
#define XB_XSUB(j)  (1280 + 64 * (j))
#define XB_XGEN(j)  (2304 + 64 * (j))
#define XB_TOP      3328
#define XB_TOPGEN   3392
#define XCD_BAR_WORDS 3456
#define XB_SPIN_CAP (1u << 18)

__device__ __forceinline__ unsigned xb_ld(unsigned* p)              { return __hip_atomic_load(p, __ATOMIC_RELAXED, __HIP_MEMORY_SCOPE_AGENT); }
__device__ __forceinline__ unsigned xb_add(unsigned* p, unsigned v) { return __hip_atomic_fetch_add(p, v, __ATOMIC_RELAXED, __HIP_MEMORY_SCOPE_AGENT); }
__device__ __forceinline__ unsigned xb_xcc_id() { return (unsigned)__builtin_amdgcn_s_getreg((3 << 11) | 20) & 0xFu; }
#define XB_SPIN(cond, bar) do { unsigned _sp = 0; while (cond) { __builtin_amdgcn_s_sleep(1); \
    if ((++_sp & 255u) == 0u) { if (xb_ld(&(bar)[XB_TMO])) break; if (_sp > XB_SPIN_CAP) { atomicAdd(&(bar)[XB_TMO], 1u); break; } } } } while (0)

struct XcdBarrier {
    unsigned* bar; unsigned x;
    volatile LAS unsigned* st;
};

__device__ __forceinline__ XcdBarrier xcd_barrier_post(unsigned* bar, volatile LAS unsigned* st) {
    XcdBarrier b; b.bar = bar; b.x = xb_xcc_id(); b.st = st;
    if (threadIdx.x == 0) (void)xb_add(&bar[XB_XCNT(b.x)], 1u);
    return b;
}
__device__ __forceinline__ void xcd_barrier_complete(unsigned* bar, unsigned x, unsigned& nloc, unsigned& nx) {
    const unsigned G = gridDim.x * gridDim.y * gridDim.z;
    unsigned sum, cnt, mine, sp = 0u;
    for (;;) {
        sum = 0u; cnt = 0u; mine = 0u;
#pragma unroll
        for (unsigned j = 0; j < 16; ++j) { const unsigned c = xb_ld(&bar[XB_XCNT(j)]); sum += c; cnt += (c > 0u) ? 1u : 0u; }
        mine = xb_ld(&bar[XB_XCNT(x)]);
        if (sum == G) break;
        __builtin_amdgcn_s_sleep(1);
        if ((++sp & 255u) == 0u) { if (xb_ld(&bar[XB_TMO])) break; if (sp > XB_SPIN_CAP) { atomicAdd(&bar[XB_TMO], 1u); break; } }
    }
    nloc = mine > 0u ? mine : 1u; nx = cnt > 0u ? cnt : 1u;
}

__device__ __forceinline__ void xcd_barrier(const XcdBarrier& b) {
    asm volatile("s_waitcnt vmcnt(0)" ::: "memory");
    __syncthreads();
    if (threadIdx.x == 0) {
        unsigned* bar = b.bar;
        __builtin_amdgcn_s_waitcnt(0);
        unsigned nloc = b.st[0], nx = b.st[1];
        if (nloc == 0u) { xcd_barrier_complete(bar, b.x, nloc, nx); b.st[0] = nloc; b.st[1] = nx; }
        const unsigned old = xb_add(&bar[XB_XSUB(b.x)], 1u);
        const unsigned gen = old / nloc;
        if (old + 1u == (gen + 1u) * nloc) {
            __builtin_amdgcn_fence(__ATOMIC_RELEASE, "agent");
            asm volatile("s_waitcnt vmcnt(0)" ::: "memory");
            const unsigned og = xb_add(&bar[XB_TOP], 1u);
            const unsigned tg = og / nx;
            if (og + 1u == (tg + 1u) * nx) xb_add(&bar[XB_TOPGEN], 1u);
            else XB_SPIN(xb_ld(&bar[XB_TOPGEN]) == tg, bar);
            __builtin_amdgcn_fence(__ATOMIC_ACQUIRE, "agent");
            xb_add(&bar[XB_XGEN(b.x)], 1u);
            asm volatile("s_waitcnt vmcnt(0)" ::: "memory");
        } else {
            XB_SPIN(xb_ld(&bar[XB_XGEN(b.x)]) == gen, bar);
            __builtin_amdgcn_fence(__ATOMIC_ACQUIRE, "agent");
            asm volatile("s_waitcnt vmcnt(0)" ::: "memory");
        }
    }
    __syncthreads();
}

constexpr int LDS_BYTES = 163840, MISC_OFF = LDS_BYTES - 256;
constexpr int CW_BAR = 4096;
__global__ void __launch_bounds__(512, 2) mega(mk::Args a) {
  extern __shared__ __attribute__((aligned(16))) unsigned char lds[];
  mk::Frame F;
  F.lds = (LAS unsigned char*)lds;
  F.tid = threadIdx.x; F.lane = F.tid & 63; F.wave = __builtin_amdgcn_readfirstlane(F.tid >> 6);
  F.G = gridDim.x; { const int bx = blockIdx.x; F.vcu = (F.G % 8 == 0) ? (bx % 8) * (F.G / 8) + bx / 8 : bx; }
  volatile LAS unsigned* MISC = (volatile LAS unsigned*)(F.lds + MISC_OFF);
  if (F.tid < 64) MISC[F.tid] = 0u;
  __syncthreads();
  XcdBarrier bar; bar.bar = nullptr; bar.x = 0; bar.st = nullptr;
  const bool multi = (a.ph_hi - a.ph_lo) > 1;
  if (multi) bar = xcd_barrier_post((unsigned*)(a.ws + mk::WS_CTL) + CW_BAR, MISC + 8);
#pragma clang loop unroll(disable)
  for (int ph = a.ph_lo; ph < a.ph_hi; ++ph) {
    if (ph == 0) mk::p0_prologue(F, a);
    else {
      const int layer = (ph - 1) / 6, sub = (ph - 1) % 6;
      if (sub == 0) mk::p1_prenorm(F, a, layer);
      else if (sub == 1) mk::p2_inproj(F, a, layer);
      else if (sub == 2) mk::p3_mixers(F, a, layer);
      else if (sub == 3) mk::gla_scan(F, a);
      else if (sub == 4) mk::p4b_glaout(F, a, layer);
      else mk::p5_outproj(F, a, layer);
    }
    if (ph + 1 < a.ph_hi) xcd_barrier(bar);
  }
}

extern "C" void kernel_launch(void* const* d_in, const int* in_sizes, int n_in, void* d_out, int out_size, void* d_ws, size_t ws_size, hipStream_t stream) {
  using namespace mk;
  static int grid = 0;
  if (grid == 0) {
    int dev = 0, cus = 0, per_cu = 0; (void)hipGetDevice(&dev); (void)hipDeviceGetAttribute(&cus, hipDeviceAttributeMultiprocessorCount, dev);
    (void)hipFuncSetAttribute((const void*)mega, hipFuncAttributeMaxDynamicSharedMemorySize, LDS_BYTES);
    if (hipOccupancyMaxActiveBlocksPerMultiprocessor(&per_cu, (const void*)mega, 512, LDS_BYTES) != hipSuccess || per_cu < 1) per_cu = 1;
    (void)hipGetLastError();
    grid = (cus > 0 ? cus : 256) * (per_cu < 1 ? 1 : 1);
  }
  (void)hipMemsetAsync((char*)d_ws + WS_CTL, 0, CTL_BYTES, stream);
  Args a{};
  for (int i = 0; i < 19; ++i) a.in[i] = (const float*)d_in[i];
  a.out = (float*)d_out; a.ws = (unsigned char*)d_ws;
  a.ph_lo = 0; a.ph_hi = 13;
  void* args[] = {&a};
  if (hipLaunchCooperativeKernel((const void*)mega, dim3(grid), dim3(512), args, LDS_BYTES, stream) != hipSuccess) {
    (void)hipGetLastError();
    hipLaunchKernelGGL(mega, dim3(grid), dim3(512), LDS_BYTES, stream, a);
  }
}
```

```cpp
#include <hip/hip_runtime.h>
#include <math.h>
#include <stdint.h>

namespace pg8 {
#define PG8_LAS __attribute__((address_space(3)))
typedef unsigned short bf16_t;
typedef short bf16x8 __attribute__((ext_vector_type(8)));
typedef float f32x4 __attribute__((ext_vector_type(4)));
typedef unsigned u32x4 __attribute__((ext_vector_type(4)));
constexpr int BM = 256, BK = 64, HALF = 128, HTB = HALF * BK * 2  , STAGE_BYTES = 8 * HTB, NXCD = 8, WGM = 8;

__host__ __device__ __forceinline__ int lds_byte(int r, int c) { const int st = (r >> 4) * 2 + (c >> 5), rr = r & 15, cc = c & 31, ob = rr * 64 + cc * 2; return st * 1024 + (ob ^ (((ob >> 9) & 1) << 5)); }
__host__ __device__ __forceinline__ void stage_rc(int b, int& R, int& C) { const int st = b / 1024, sb = b % 1024, swz = sb ^ (((sb >> 9) & 1) << 5); R = (st >> 1) * 16 + swz / 64; C = (st & 1) * 32 + (swz % 64) / 2; }
__host__ __device__ __forceinline__ int perm32(int rho) { const int n = rho >> 4, i = rho & 15; return 8 * (i >> 2) + 4 * n + (i & 3); }

struct Unit { int pm, pn; };
struct Gemm { const bf16_t* A; const bf16_t* Bt; int M, N, K; };

struct StaticOrder {
    int nM, nN, nwg, G, c;
    __host__ __device__ void init(int M, int N, int G_, int c_) { nM = M / BM; nN = N / BM; nwg = nM * nN; G = G_; c = c_; }
    __host__ __device__ bool next(int i, Unit& u) const {
        const long L = (long)i * G + c; if (L >= nwg) return false;
        int wgid = (int)L; { const int q = nwg / NXCD, r = nwg % NXCD, xcd = wgid % NXCD, off = wgid / NXCD; wgid = (xcd < r ? xcd * (q + 1) : r * (q + 1) + (xcd - r) * q) + off; }
        const int nig = WGM * nN, gid = wgid / nig, fm = gid * WGM, gsz = (nM - fm) < WGM ? (nM - fm) : WGM;
        u.pm = fm + ((wgid % nig) % gsz); u.pn = (wgid % nig) / gsz; return true;
    }
    __device__ __forceinline__ void a_ready(const Unit&) const {}
    __device__ __forceinline__ void done(const Unit&) const {}
};

template <class Epi, class Sched, bool STAMP = false>
__device__ __forceinline__ void gemm_phase(PG8_LAS unsigned char* lds, const Gemm g, const Sched& S, const Epi& E, unsigned long long* stamps) {
    int tid_ = threadIdx.x; asm volatile("" : "+v"(tid_));
    const int tid = tid_, wid = __builtin_amdgcn_readfirstlane(tid >> 6), lane = tid & 63, wr = wid >> 2, wc = wid & 3, fr = lane & 15, fq = lane >> 4;
    const int K = g.K, nt = K / BK;
    int ts_lo = 0, ts_hi = 0, nts = 0; const unsigned long long rt_entry = STAMP ? (unsigned long long)wall_clock64() : 0ull;
#define PG8_STAMP() do { if (STAMP && wid == 0 && nts < 64) { const unsigned long long _c = (unsigned long long)clock64(); \
        ts_lo = (lane == nts) ? (int)(unsigned)_c : ts_lo; ts_hi = (lane == nts) ? (int)(unsigned)(_c >> 32) : ts_hi; ++nts; } } while (0)
    PG8_STAMP();
    unsigned voffA[2], voffB[2];
#pragma unroll
    for (int i = 0; i < 2; ++i) { int R, C; stage_rc(tid * 16 + i * 8192, R, C); const int Rb = Epi::PERM ? ((R & ~31) + perm32(R & 31)) : R;
        voffA[i] = (unsigned)(R * K + C) * 2u; voffB[i] = (unsigned)(Rb * K + C) * 2u; }
    const size_t kstep = (size_t)(BK * 2);
    const size_t hstep = (size_t)HALF * K * 2;
    const size_t tstep = 2 * hstep;
    const unsigned ldsw = (unsigned)wid * 1024u;
    const int aoff = lds_byte(wr * 64 + fr, fq * 8), boff = lds_byte(wc * 32 + fr, fq * 8);
#define PG8_SA(b, h) (((b) * 2 + (h)) * HTB)
#define PG8_SB(b, h) ((4 + (b) * 2 + (h)) * HTB)
#define PG8_STAGE(bufoff, gbase, voff) do { _Pragma("unroll") for (int _i = 0; _i < 2; ++_i) \
        __builtin_amdgcn_global_load_lds((const unsigned*)((const char*)(gbase) + (voff)[_i]), (PG8_LAS unsigned*)(lds + (bufoff) + ldsw + _i * 8192), 16, 0, 0); } while (0)
#define PG8_LDA(dst, b, h) do { _Pragma("unroll") for (int m = 0; m < 4; ++m) _Pragma("unroll") for (int k = 0; k < 2; ++k) dst[m][k] = *(const PG8_LAS bf16x8*)(lds + PG8_SA(b, h) + aoff + m * 2048 + k * 1024); } while (0)
#define PG8_LDB(dst, b, h) do { _Pragma("unroll") for (int n = 0; n < 2; ++n) _Pragma("unroll") for (int k = 0; k < 2; ++k) dst[n][k] = *(const PG8_LAS bf16x8*)(lds + PG8_SB(b, h) + boff + n * 2048 + k * 1024); } while (0)
#define PG8_MMA(ai, bj, At, Bt) do { __builtin_amdgcn_s_setprio(1); _Pragma("unroll") for (int m = 0; m < 4; ++m) _Pragma("unroll") for (int n = 0; n < 2; ++n) _Pragma("unroll") for (int k = 0; k < 2; ++k) \
        acc[ai][bj][m][n] = __builtin_amdgcn_mfma_f32_16x16x32_bf16(Bt[n][k], At[m][k], acc[ai][bj][m][n], 0, 0, 0); __builtin_amdgcn_s_setprio(0); } while (0)
#define PG8_WAIT_V(n) asm volatile("s_waitcnt vmcnt(" #n ")" ::: "memory")
#define PG8_WAIT_L(n) asm volatile("s_waitcnt lgkmcnt(" #n ")" ::: "memory")
#define PG8_BAR __builtin_amdgcn_s_barrier()
#define PG8_SCHED __builtin_amdgcn_sched_barrier(0)
    Unit cur, nxt; int ui = 0;
    if (!S.next(0, cur)) return;
    f32x4 acc[2][2][4][2];
#pragma unroll
    for (int a = 0; a < 2; ++a)
#pragma unroll
        for (int b = 0; b < 2; ++b)
#pragma unroll
            for (int m = 0; m < 4; ++m)
#pragma unroll
                for (int n = 0; n < 2; ++n) acc[a][b][m][n] = (f32x4){0.f, 0.f, 0.f, 0.f};
    bf16x8 At[4][2], B0[2][2], B1[2][2];
    const char* cA = (const char*)g.A + (size_t)cur.pm * tstep; const char* cB = (const char*)g.Bt + (size_t)cur.pn * tstep;
    S.a_ready(cur);
    PG8_STAGE(PG8_SB(0, 0), cB, voffB); PG8_STAGE(PG8_SA(0, 0), cA, voffA); PG8_STAGE(PG8_SB(0, 1), cB + hstep, voffB); PG8_STAGE(PG8_SA(0, 1), cA + hstep, voffA);
    if (wr == 1) PG8_BAR;
    PG8_WAIT_V(4); PG8_BAR;
    PG8_STAGE(PG8_SB(1, 0), cB + kstep, voffB); PG8_STAGE(PG8_SA(1, 0), cA + kstep, voffA); PG8_STAGE(PG8_SB(1, 1), cB + hstep + kstep, voffB);
    PG8_WAIT_V(6); PG8_BAR;
    PG8_STAMP();
    for (;;) {
        const bool has_next = S.next(ui + 1, nxt);
        const char* nA = has_next ? (const char*)g.A + (size_t)nxt.pm * tstep : cA; const char* nB = has_next ? (const char*)g.Bt + (size_t)nxt.pn * tstep : cB;
        for (int t = 0; t < nt; t += 2) {
            const bool last = (t == nt - 2);
            const char* a1 = cA + (size_t)(t + 1) * kstep;
            const char* a2 = last ? nA : cA + (size_t)(t + 2) * kstep; const char* b2 = last ? nB : cB + (size_t)(t + 2) * kstep;
            const char* a3 = a2 + kstep; const char* b3 = b2 + kstep;
            if (last && has_next) S.a_ready(nxt);
            PG8_LDB(B0, 0, 0); PG8_SCHED; PG8_LDA(At, 0, 0); PG8_STAGE(PG8_SA(1, 1), a1 + hstep, voffA);
            PG8_WAIT_L(8); PG8_BAR; PG8_WAIT_L(0); PG8_MMA(0, 0, At, B0); PG8_BAR; PG8_SCHED;
            PG8_LDB(B1, 0, 1); PG8_STAGE(PG8_SB(0, 0), b2, voffB);
            PG8_BAR; PG8_WAIT_L(0); PG8_MMA(0, 1, At, B1); PG8_BAR;
            PG8_LDA(At, 0, 1); PG8_STAGE(PG8_SA(0, 0), a2, voffA);
            PG8_BAR; PG8_WAIT_L(0); PG8_MMA(1, 0, At, B0); PG8_BAR; PG8_SCHED;
            PG8_STAGE(PG8_SB(0, 1), b2 + hstep, voffB);
            PG8_WAIT_V(6); PG8_BAR; PG8_MMA(1, 1, At, B1); PG8_BAR;
            PG8_LDB(B0, 1, 0); PG8_SCHED; PG8_LDA(At, 1, 0); PG8_STAGE(PG8_SA(0, 1), a2 + hstep, voffA);
            PG8_WAIT_L(8); PG8_BAR; PG8_WAIT_L(0); PG8_MMA(0, 0, At, B0); PG8_BAR; PG8_SCHED;
            PG8_LDB(B1, 1, 1); PG8_STAGE(PG8_SB(1, 0), b3, voffB);
            PG8_BAR; PG8_WAIT_L(0); PG8_MMA(0, 1, At, B1); PG8_BAR;
            PG8_LDA(At, 1, 1); PG8_STAGE(PG8_SA(1, 0), a3, voffA);
            PG8_BAR; PG8_WAIT_L(0); PG8_MMA(1, 0, At, B0); PG8_BAR; PG8_SCHED;
            PG8_STAGE(PG8_SB(1, 1), b3 + hstep, voffB);
            PG8_WAIT_V(6); PG8_BAR; PG8_MMA(1, 1, At, B1); PG8_BAR;
        }
        PG8_STAMP();
        if constexpr (!Epi::AFTER_DRAIN) { E(acc, cur, wr, wc, fr, fq); S.done(cur); }
        PG8_STAMP();
        if (!has_next) break;
#pragma unroll
        for (int a = 0; a < 2; ++a)
#pragma unroll
            for (int b = 0; b < 2; ++b)
#pragma unroll
                for (int m = 0; m < 4; ++m)
#pragma unroll
                    for (int n = 0; n < 2; ++n) acc[a][b][m][n] = (f32x4){0.f, 0.f, 0.f, 0.f};
        cur = nxt; cA = nA; cB = nB; ++ui;
    }
    PG8_WAIT_V(0);
    if (wr == 0) PG8_BAR;
    PG8_BAR;
    if constexpr (Epi::AFTER_DRAIN) { E.fused(acc, cur, wr, wc, fr, fq, lds, wid, lane); S.done(cur); }
    PG8_STAMP();
    if (STAMP && wid == 0) { stamps[lane] = lane < nts ? (((unsigned long long)(unsigned)ts_hi << 32) | (unsigned)ts_lo) : 0ull;
        if (lane == 62) stamps[62] = rt_entry; if (lane == 63) stamps[63] = (unsigned long long)wall_clock64(); }
#undef PG8_STAMP
#undef PG8_SA
#undef PG8_SB
#undef PG8_STAGE
#undef PG8_LDA
#undef PG8_LDB
#undef PG8_MMA
#undef PG8_WAIT_V
#undef PG8_WAIT_L
#undef PG8_BAR
#undef PG8_SCHED
}
}

namespace mk {
#define LAS __attribute__((address_space(3)))
typedef unsigned short bf16;
typedef float f32x4 __attribute__((ext_vector_type(4)));
typedef float f32x16 __attribute__((ext_vector_type(16)));
typedef unsigned u32x4 __attribute__((ext_vector_type(4)));
typedef unsigned u32x2 __attribute__((ext_vector_type(2)));
typedef short bf16x8 __attribute__((ext_vector_type(8)));
typedef short s16x4 __attribute__((ext_vector_type(4)));

constexpr int D = 1024, NB = 4, SEQ = 4096, CTX = 256, PWW = 3360;
constexpr int MLAT = NB * SEQ, MT = MLAT + NB * CTX;
constexpr int NT1 = 14, N1 = NT1 * 256;
constexpr int NSLOT = 11, PLW = NSLOT * 256;
constexpr int TROW = SEQ + CTX;
constexpr int O_AQ = 0, O_AK = 128, O_AV = 256, O_AG = 512, O_LR = 768, O_BV = 800, O_BG = 1056, O_CQ = 1312, O_CK = 1568, O_CV = 1696,
              O_CG = 1824, O_DQ = 2080, O_DK = 2336, O_DV = 2592, O_DG = 2848;
constexpr int S_AQK = 0, S_AV = 1, S_AG = 2, S_BG = 3, S_CQ = 4, S_CKV = 5, S_CG = 6, S_DQ = 7, S_DK = 8, S_DV = 9, S_DG = 10;
constexpr float LOG2E = 1.4426950408889634f, QSCALE = 0.125f * LOG2E, GLA_QS = 0.17677669529663687f;

constexpr size_t WS_CTL = 0, CTL_BYTES = 65536;
constexpr size_t WS_MOD = WS_CTL + CTL_BYTES;
constexpr size_t WS_ROPE = WS_MOD + 2 * 5 * 3072 * 4;
constexpr size_t WS_WC = WS_ROPE + 2 * 64 * 16 * 4;
constexpr size_t WS_CS256 = WS_WC + 128 * 128 * 2;
constexpr size_t WS_W1T = 1u << 20;
constexpr size_t WS_W2T = WS_W1T + (size_t)2 * N1 * D * 2;
constexpr size_t WS_H = WS_W2T + (size_t)2 * D * D * 2;
constexpr size_t WS_PLB = WS_H + (size_t)MT * D * 2;
constexpr size_t WS_LA = WS_PLB + (size_t)MT * PLW * 2;
constexpr size_t WS_FA2 = WS_LA + (size_t)MT * 256 * 4;
constexpr size_t WS_CTX1 = WS_FA2 + (size_t)NB * 64 * TROW * 8 * 2;
constexpr size_t WS_SCR = WS_CTX1 + (size_t)NB * CTX * D * 4;
static_assert(WS_CS256 + 256 * 512 * 2 <= WS_W1T, "tables");

__device__ __forceinline__ float bf2f(bf16 v) { return __uint_as_float(((unsigned)v) << 16); }
__device__ __forceinline__ unsigned f2bf(float f) { unsigned u = __float_as_uint(f); return (u + 0x7fffu + ((u >> 16) & 1u)) >> 16; }
typedef float f32x2_t __attribute__((ext_vector_type(2))); typedef __bf16 bf16x2_t __attribute__((ext_vector_type(2)));
__device__ __forceinline__ unsigned pk2(float lo, float hi) { const f32x2_t v = {lo, hi}; const bf16x2_t b = __builtin_convertvector(v, bf16x2_t); return __builtin_bit_cast(unsigned, b); }
__device__ __forceinline__ float wave_sum(float v) {
#pragma unroll
  for (int o = 1; o < 64; o <<= 1) v += __shfl_xor(v, o);
  return v;
}
__device__ __forceinline__ float fsilu(float x) { return x * __builtin_amdgcn_rcpf(1.f + __expf(-x)); }
__device__ __forceinline__ float flogsig(float x) { return fminf(x, 0.f) - __logf(1.f + __expf(-fabsf(x))); }

#define GAS __attribute__((address_space(1)))
template <class T> __device__ __forceinline__ T* opq(T* p) { GAS T* g = (GAS T*)p; asm volatile("" : "+s"(g)); return (T*)g; }
__device__ __forceinline__ int crow(int r, int hi) { return (r & 3) + 8 * (r >> 2) + 4 * hi; }
struct Args {
  const float* in[19]; float* out; unsigned char* ws; int ph_lo, ph_hi;
};
struct Frame {
  int tid, lane, wave, vcu, G;
  LAS unsigned char* lds;
};
__device__ __forceinline__ Frame relaunder(const Frame& F0) {
  Frame F = F0; F.tid = threadIdx.x; asm volatile("" : "+v"(F.tid)); F.lane = F.tid & 63; asm volatile("" : "+s"(F.wave), "+s"(F.vcu), "+s"(F.G)); return F; }
}

namespace mk {
__device__ __forceinline__ void p0_ada_item(const Frame& F, const Args& a, int item) {
  LAS float* s = (LAS float*)F.lds; LAS float* red = s + 5 * 1024;
  const float* c = opq(a.in[1]); const float* cc = opq(a.in[3]);
  for (int i = F.tid; i < 5 * 1024; i += 512) { const int r = i >> 10, k = i & 1023; const float v = r < 4 ? c[r * 1024 + k] : cc[k]; s[i] = v / (1.f + expf(-v)); }
  __syncthreads();
  const int kp = F.tid / 24, cl = F.tid % 24;
  const int gcol = item * 24 + cl, l = gcol / 3072, col = gcol % 3072;
  if (kp < 21) {
    const float* w = opq(a.in[5]) + (size_t)l * 1024 * 3072 + col;
    float acc[5] = {0.f, 0.f, 0.f, 0.f, 0.f};
#pragma unroll 8
    for (int k = kp; k < 1024; k += 21) { const float wv = w[(size_t)k * 3072];
#pragma unroll
      for (int r = 0; r < 5; ++r) acc[r] += s[r * 1024 + k] * wv; }
#pragma unroll
    for (int r = 0; r < 5; ++r) red[(kp * 24 + cl) * 5 + r] = acc[r];
  }
  __syncthreads();
  if (F.tid < 120) {
    const int cl2 = F.tid / 5, r = F.tid % 5; float t = 0.f;
    for (int q = 0; q < 21; ++q) t += red[(q * 24 + cl2) * 5 + r];
    const int g2 = item * 24 + cl2, l2 = g2 / 3072, col2 = g2 % 3072;
    float* MOD = (float*)(opq(a.ws) + WS_MOD);
    MOD[((size_t)l2 * 5 + r) * 3072 + col2] = t + opq(a.in[6])[l2 * 3072 + col2];
  }
  __syncthreads();
}
__device__ __forceinline__ int rope_perm(int n) { return 16 * ((n >> 2) & 1) + 4 * (n >> 3) + (n & 3); }
__device__ __forceinline__ void p0_tr_item(const float* W, int ldw, int cbase, int permkind, float scale, bf16* dst, int k0, LAS float* scr, int lane) {
  { float t_[32];
#pragma unroll
    for (int i = 0; i < 32; ++i) t_[i] = W[(size_t)(k0 + 2 * i + (lane >> 5)) * ldw + cbase + (lane & 31)];
#pragma unroll
    for (int i = 0; i < 32; ++i) scr[(2 * i + (lane >> 5)) * 33 + (lane & 31)] = t_[i]; }
  asm volatile("s_waitcnt lgkmcnt(0)" ::: "memory");
  const int c = lane & 7;
#pragma unroll
  for (int j = 0; j < 4; ++j) { const int n = (lane >> 3) + 8 * j; const int sidx = permkind ? rope_perm(n) : n; const LAS float* sp = scr + (8 * c) * 33 + sidx;
    u32x4 o; o.x = pk2(sp[0 * 33] * scale, sp[1 * 33] * scale); o.y = pk2(sp[2 * 33] * scale, sp[3 * 33] * scale); o.z = pk2(sp[4 * 33] * scale, sp[5 * 33] * scale); o.w = pk2(sp[6 * 33] * scale, sp[7 * 33] * scale);
    *(u32x4*)(dst + (size_t)n * 1024 + k0 + 8 * c) = o; }
  asm volatile("s_waitcnt lgkmcnt(0)" ::: "memory");
}
__device__ __forceinline__ void p0_la_item(const float* Win, const float* decw  , int dir, int j0, bf16* dst, int k0, LAS float* scr, int lane) {
  float dw[16];
#pragma unroll
  for (int r = 0; r < 16; ++r) dw[r] = decw[(dir * 16 + r) * 128 + j0 + (lane & 31)];
#pragma unroll 4
  for (int i = 0; i < 32; ++i) { const int kk = 2 * i + (lane >> 5); const float* wp = Win + (size_t)(k0 + kk) * PWW + O_LR + dir * 16; float acc = 0.f;
#pragma unroll
    for (int r = 0; r < 16; ++r) acc += wp[r] * dw[r];
    scr[kk * 33 + (lane & 31)] = acc; }
  asm volatile("s_waitcnt lgkmcnt(0)" ::: "memory");
  const int c = lane & 7;
#pragma unroll
  for (int j = 0; j < 4; ++j) { const int n = (lane >> 3) + 8 * j; const LAS float* sp = scr + (8 * c) * 33 + n;
    u32x4 o; o.x = pk2(sp[0 * 33], sp[1 * 33]); o.y = pk2(sp[2 * 33], sp[3 * 33]); o.z = pk2(sp[4 * 33], sp[5 * 33]); o.w = pk2(sp[6 * 33], sp[7 * 33]);
    *(u32x4*)(dst + (size_t)n * 1024 + k0 + 8 * c) = o; }
  asm volatile("s_waitcnt lgkmcnt(0)" ::: "memory");
}
constexpr int FA_AST = 528, FA_WST = 528;
__device__ __forceinline__ void p0_fa_item(const Frame& F, const Args& a, int item) {
  const int l = item >> 4, pn = 4 + ((item >> 3) & 1), g32 = item & 7, bj = g32 >> 2, wc = g32 & 3;
  LAS float* cs = (LAS float*)F.lds; LAS float* sn = cs + 64; LAS float* wfl = sn + 64;
  LAS unsigned char* Ai = F.lds + 512 + 16384;
  LAS unsigned char* Wi = F.lds + F.wave * (32 * FA_WST);
  __syncthreads();
  if (F.tid < 64) { float s_, c_; sincospif(2.f * F.tid / 64.f, &s_, &c_); cs[F.tid] = c_; sn[F.tid] = s_; }
  const float* wf = opq(a.in[12]) + (size_t)l * 256 * 256;
  const int slice0 = 32 * (pn - 4) + 16 * bj + 4 * wc;
  for (int i = F.tid; i < 1024; i += 512) { const int r = i >> 2, q = i & 3; *(LAS f32x4*)(wfl + r * 16 + 4 * q) = *(const f32x4*)(wf + (size_t)r * 256 + 4 * slice0 + 4 * q); }
  __syncthreads();
  {
    const int c = F.tid & 255, part = F.tid >> 8, g = c >> 6, jj = c & 63;
    f32x4 acc[4];
#pragma unroll
    for (int q = 0; q < 4; ++q) acc[q] = (f32x4){0.f, 0.f, 0.f, 0.f};
#pragma unroll 4
    for (int m = 0; m < 64; ++m) { const int idx = (m * jj) & 63; const float t = part ? -sn[idx] : cs[idx];
#pragma unroll
      for (int q = 0; q < 4; ++q) acc[q] += t * *(LAS const f32x4*)(wfl + (g * 64 + m) * 16 + 4 * q); }
#pragma unroll
    for (int fq = 0; fq < 4; ++fq)
#pragma unroll
      for (int j = 0; j < 4; ++j) *(LAS unsigned short*)(Ai + (8 * fq + 4 * part + j) * FA_AST + c * 2) = (unsigned short)f2bf(acc[fq][j] * 0.125f);
  }
  __syncthreads();
  const int r32 = F.lane & 31, hi = F.lane >> 5;
  bf16x8 af[16];
#pragma unroll
  for (int s = 0; s < 16; ++s) af[s] = *(LAS const bf16x8*)(Ai + r32 * FA_AST + (16 * s + 8 * hi) * 2);
  __syncthreads();
  const float* Win = opq(a.in[7]) + (size_t)l * 1024 * PWW + O_BV;
  bf16* dst = (bf16*)(opq(a.ws) + WS_W1T) + ((size_t)l * N1 + pn * 256 + 32 * g32) * 1024;
  for (int kb = 0; kb < 4; ++kb) {
    const int k0 = F.wave * 128 + kb * 32;
#pragma unroll
    for (int rh = 0; rh < 2; ++rh) { f32x4 w[16];
#pragma unroll
      for (int r = 0; r < 16; ++r) w[r] = *(const f32x4*)(Win + (size_t)(k0 + 16 * rh + r) * PWW + 4 * F.lane);
#pragma unroll
      for (int r = 0; r < 16; ++r) *(LAS u32x2*)(Wi + (16 * rh + r) * FA_WST + 8 * F.lane) = (u32x2){pk2(w[r].x, w[r].y), pk2(w[r].z, w[r].w)}; }
    asm volatile("s_waitcnt lgkmcnt(0)" ::: "memory");
    f32x16 acc;
#pragma unroll
    for (int i = 0; i < 16; ++i) acc[i] = 0.f;
#pragma unroll
    for (int s = 0; s < 16; ++s) { const bf16x8 bfr = *(LAS const bf16x8*)(Wi + r32 * FA_WST + (16 * s + 8 * hi) * 2); acc = __builtin_amdgcn_mfma_f32_32x32x16_bf16(af[s], bfr, acc, 0, 0, 0); }
#pragma unroll
    for (int r = 0; r < 16; ++r) dst[(size_t)crow(r, hi) * 1024 + k0 + r32] = (bf16)f2bf(acc[r]);
    asm volatile("s_waitcnt lgkmcnt(0)" ::: "memory");
  }
  __syncthreads();
}
__device__ __forceinline__ void p0_prologue(const Frame& F0, const Args& a) {
 {
  const Frame F = relaunder(F0);
  unsigned char* ws = opq(a.ws);
  { const int gt = F.vcu * 512 + F.tid, GT = F.G * 512;
    float* rope = (float*)(ws + WS_ROPE);
    for (int i = gt; i < 1024; i += GT) { const int pos = i >> 4, f = i & 15; const float ang = (float)pos * powf(10000.f, -(float)f / 16.f); rope[i] = cosf(ang); rope[1024 + i] = sinf(ang); }
    bf16* wc = (bf16*)(ws + WS_WC);
    for (int i = gt; i < 128 * 128; i += GT) { const int r = i >> 7, c = i & 127, rr = r & 63, cc = c & 63; float s_, c_; sincospif(2.f * (float)((rr * cc) & 63) / 64.f, &s_, &c_);
      float v; if (r < 64) v = c < 64 ? c_ : s_; else v = c < 64 ? -s_ : c_; wc[i] = (bf16)f2bf(v * 0.125f); }
    bf16* cs256 = (bf16*)(ws + WS_CS256);
    for (int i = gt; i < 256 * 512; i += GT) { const int k = i >> 9, n = i & 511, nn = n & 255; float s_, c_; sincospif(2.f * (float)((k * nn) & 255) / 256.f, &s_, &c_); cs256[i] = (bf16)f2bf((n < 256 ? c_ : s_) * 0.0625f); }
  }
  for (int it = F.vcu; it < 256 + 32; it += F.G) { if (it < 256) p0_ada_item(F, a, it); else p0_fa_item(F, a, it - 256); }
  LAS float* scr = (LAS float*)(F.lds + F.wave * 16384);
  const int gw = F.vcu * 8 + F.wave, NGW = F.G * 8;
  constexpr int I_DIR = 11 * 8 * 16, I_LA = 8 * 16, I_W2 = 32 * 16, I_L = I_DIR + I_LA + I_W2;
  for (int it = gw; it < 2 * I_L; it += NGW) {
    const int l = it / I_L; int r = it % I_L;
    const float* Win = opq(a.in[7]) + (size_t)l * 1024 * PWW;
    bf16* W1T = (bf16*)(ws + WS_W1T) + (size_t)l * N1 * 1024;
    if (r < I_DIR) {
      const int ti = r / 128, g32 = (r >> 4) & 7, kb = r & 15;
      const int pn = ti < 3 ? ti : ti + 3;
      const int bj = g32 >> 2, wc = g32 & 3, mcb = 64 * wc + 32 * bj;
      int cbase = 0, pk = 0; float sc = 1.f;
      switch (pn) {
        case 0: if (mcb < 128) { cbase = O_AQ + mcb; sc = GLA_QS; } else cbase = O_AK + mcb - 128; break;
        case 1: cbase = O_AV + mcb; break;
        case 2: cbase = O_AG + mcb; break;
        case 6: cbase = O_BG + mcb; break;
        case 7: cbase = O_CQ + mcb; pk = 1; break;
        case 8: if (wc < 2) { cbase = O_CK + mcb; pk = 1; } else cbase = O_CV + mcb - 128; break;
        case 9: cbase = O_CG + mcb; break;
        case 10: cbase = O_DQ + mcb; break;
        case 11: cbase = O_DK + mcb; break;
        case 12: cbase = O_DV + mcb; break;
        default: cbase = O_DG + mcb; break;
      }
      p0_tr_item(Win, PWW, cbase, pk, sc, W1T + (size_t)(pn * 256 + 32 * g32) * 1024, kb * 64, scr, F.lane);
    } else if (r < I_DIR + I_LA) {
      r -= I_DIR; const int g32 = r >> 4, kb = r & 15, bj = g32 >> 2, wc = g32 & 3, mcb = 64 * wc + 32 * bj;
      p0_la_item(Win, opq(a.in[9]) + (size_t)l * 2 * 16 * 128, mcb >> 7, mcb & 127, W1T + (size_t)(3 * 256 + 32 * g32) * 1024, kb * 64, scr, F.lane);
    } else {
      r -= I_DIR + I_LA; const int g = r >> 4, kb = r & 15;
      p0_tr_item(opq(a.in[8]) + (size_t)l * 1024 * 1024, 1024, 32 * g, 0, 1.f, (bf16*)(ws + WS_W2T) + ((size_t)l * 1024 + 32 * g) * 1024, kb * 64, scr, F.lane);
    }
  }
 }
}
__device__ __forceinline__ void p1_prenorm(const Frame& F0, const Args& a, int layer) {
  const Frame F = relaunder(F0);
  const float* xin = layer == 0 ? opq(a.in[0]) : opq(a.out);
  const float* cin = layer == 0 ? opq(a.in[2]) : (const float*)(opq(a.ws) + WS_CTX1);
  const float* nw = opq(a.in[4]) + layer * 1024;
  const float* MOD = (const float*)(opq(a.ws) + WS_MOD) + (size_t)layer * 5 * 3072;
  bf16* H = (bf16*)(opq(a.ws) + WS_H);
  const int gw = F.vcu * 8 + F.wave, NGW = F.G * 8;
  constexpr int RB = 3;
  f32x4 w_[4];
#pragma unroll
  for (int j = 0; j < 4; ++j) w_[j] = *(const f32x4*)(nw + 4 * F.lane + 256 * j);
  for (int row0 = gw; row0 < MT; row0 += RB * NGW) {
    f32x4 v[RB][4], sc_[RB][4], sh_[RB][4]; float ss[RB];
#pragma unroll
    for (int q = 0; q < RB; ++q) { int row = row0 + q * NGW; row = row < MT ? row : MT - 1;
      const float* src; const float* mod;
      if (row < MLAT) { src = xin + (size_t)row * 1024; mod = MOD + (size_t)(row >> 12) * 3072; }
      else { src = cin + (size_t)(row - MLAT) * 1024; mod = MOD + (size_t)4 * 3072; }
      const f32x4* xr = (const f32x4*)src + F.lane;
#pragma unroll
      for (int j = 0; j < 4; ++j) { v[q][j] = xr[64 * j]; sc_[q][j] = *(const f32x4*)(mod + 1024 + 4 * F.lane + 256 * j); sh_[q][j] = *(const f32x4*)(mod + 4 * F.lane + 256 * j); } }
    __builtin_amdgcn_sched_barrier(0);
#pragma unroll
    for (int q = 0; q < RB; ++q) { float s_ = 0.f;
#pragma unroll
      for (int j = 0; j < 4; ++j) s_ += (v[q][j].x * v[q][j].x + v[q][j].y * v[q][j].y) + (v[q][j].z * v[q][j].z + v[q][j].w * v[q][j].w);
      ss[q] = s_; }
#pragma unroll
    for (int o = 1; o < 64; o <<= 1)
#pragma unroll
      for (int q = 0; q < RB; ++q) ss[q] += __shfl_xor(ss[q], o);
#pragma unroll
    for (int q = 0; q < RB; ++q) { const int row = row0 + q * NGW; if (row >= MT) continue;
      const float rs = 1.0f / sqrtf(ss[q] * (1.f / 1024.f) + 1e-6f);
      unsigned long long* o8 = (unsigned long long*)(H + (size_t)row * 1024) + F.lane;
#pragma unroll
      for (int j = 0; j < 4; ++j) {
        const f32x4 h = v[q][j] * rs * w_[j] * (1.f + sc_[q][j]) + sh_[q][j];
        o8[64 * j] = (unsigned long long)pk2(h.x, h.y) | ((unsigned long long)pk2(h.z, h.w) << 32);
      } }
  }
}
}

namespace mk {
using pg8::Unit;
struct EpiIn {
  static constexpr bool PERM = true, AFTER_DRAIN = false;
  bf16* PLB; float* LA; bf16* FA2; LAS const float* rope;
  __device__ __forceinline__ void operator()(const f32x4 (&acc)[2][2][4][2], const Unit& u, int wr, int wc, int fr, int fq) const {
    const int pn = u.pn;
    const bool ctxrows = u.pm >= 64;
    int kind, slot = 0; LAS const float* nw = rope; bool roped = false; float qs = 1.f;
    LAS const float* cqn = rope + 2048; LAS const float* ckn = rope + 2112; LAS const float* dqn = rope + 2176; LAS const float* dkn = rope + 2240; LAS const float* decb = rope + 2304;
    switch (pn) {
      case 0: kind = 0; slot = S_AQK; break;
      case 1: kind = 0; slot = S_AV; break;
      case 2: kind = 1; slot = S_AG; break;
      case 3: kind = 2; break;
      case 4: case 5: kind = 3; break;
      case 6: kind = 1; slot = S_BG; break;
      case 7: kind = 4; slot = S_CQ; nw = cqn; roped = true; qs = QSCALE; break;
      case 8: slot = S_CKV; if (wc < 2) { kind = 4; nw = ckn; roped = true; } else kind = 0; break;
      case 9: kind = 1; slot = S_CG; break;
      case 10: kind = 4; slot = S_DQ; nw = dqn; qs = QSCALE; break;
      case 11: kind = 4; slot = S_DK; nw = dkn; break;
      case 12: kind = 0; slot = S_DV; break;
      default: kind = 1; slot = S_DG; break;
    }
    const int row0 = u.pm * 256 + wr * 64 + fr;
    float w8[2][8];
    if (kind == 4) {
#pragma unroll
      for (int bj = 0; bj < 2; ++bj)
#pragma unroll
        for (int s = 0; s < 8; ++s) { const int d = roped ? (32 * bj + 16 * (s >> 2) + 4 * fq + (s & 3)) : (32 * bj + 8 * fq + s); w8[bj][s] = nw[d] * qs; }
    } else if (kind == 2) {
#pragma unroll
      for (int bj = 0; bj < 2; ++bj)
#pragma unroll
        for (int s = 0; s < 8; ++s) w8[bj][s] = decb[64 * wc + 32 * bj + 8 * fq + s];
    }
#pragma unroll
    for (int ai = 0; ai < 2; ++ai) {
      float rsr[4];
      if (kind == 4) {
#pragma unroll
        for (int m = 0; m < 4; ++m) { float s_ = 0.f;
#pragma unroll
          for (int bj = 0; bj < 2; ++bj)
#pragma unroll
            for (int n = 0; n < 2; ++n) { const f32x4 t = acc[ai][bj][m][n]; s_ += (t.x * t.x + t.y * t.y) + (t.z * t.z + t.w * t.w); }
          rsr[m] = s_; }
#pragma unroll
        for (int o = 16; o < 64; o <<= 1)
#pragma unroll
          for (int m = 0; m < 4; ++m) rsr[m] += __shfl_xor(rsr[m], o);
#pragma unroll
        for (int m = 0; m < 4; ++m) rsr[m] = __builtin_amdgcn_rsqf(rsr[m] * (1.f / 64.f) + 1e-6f);
      }
#pragma unroll
      for (int m = 0; m < 4; ++m) {
        const int r = row0 + ai * 128 + m * 16;
        float v[2][8];
#pragma unroll
        for (int bj = 0; bj < 2; ++bj)
#pragma unroll
          for (int n = 0; n < 2; ++n)
#pragma unroll
            for (int e = 0; e < 4; ++e) v[bj][4 * n + e] = acc[ai][bj][m][n][e];
        if (kind == 2) {
#pragma unroll
          for (int bj = 0; bj < 2; ++bj) { const int mc = 64 * wc + 32 * bj + 8 * fq; float* dp = LA + (size_t)r * 256 + mc;
            f32x4 o0, o1;
#pragma unroll
            for (int e = 0; e < 4; ++e) { o0[e] = flogsig(v[bj][e] + w8[bj][e]) * 0.0625f; o1[e] = flogsig(v[bj][4 + e] + w8[bj][4 + e]) * 0.0625f; }
            *(f32x4*)dp = o0; *(f32x4*)(dp + 4) = o1; }
        } else if (kind == 3) {
          int b, t; if (!ctxrows) { b = r >> 12; t = r & 4095; } else { const int rc = r - MLAT; b = rc >> 8; t = SEQ + (rc & 255); }
#pragma unroll
          for (int bj = 0; bj < 2; ++bj) { const int slice = 32 * (pn - 4) + 16 * bj + 4 * wc + fq;
            u32x4 o; o.x = pk2(v[bj][0], v[bj][1]); o.y = pk2(v[bj][2], v[bj][3]); o.z = pk2(v[bj][4], v[bj][5]); o.w = pk2(v[bj][6], v[bj][7]);
            *(u32x4*)(FA2 + (((size_t)b * 64 + slice) * TROW + t) * 8) = o; }
        } else {
          if (kind == 1) {
#pragma unroll
            for (int bj = 0; bj < 2; ++bj)
#pragma unroll
              for (int s = 0; s < 8; ++s) v[bj][s] = fsilu(v[bj][s]);
          } else if (kind == 4) {
            const float rs = rsr[m];
#pragma unroll
            for (int bj = 0; bj < 2; ++bj)
#pragma unroll
              for (int s = 0; s < 8; ++s) v[bj][s] *= rs * w8[bj][s];
            if (roped && !ctxrows) {
              const int t = r & 4095;
#pragma unroll
              for (int bj = 0; bj < 2; ++bj) { const int pos = bj == 0 ? (t >> 6) : (t & 63);
                const f32x4 c4 = *(LAS const f32x4*)(rope + pos * 16 + 4 * fq), s4 = *(LAS const f32x4*)(rope + 1024 + pos * 16 + 4 * fq);
#pragma unroll
                for (int e = 0; e < 4; ++e) { const float x1 = v[bj][e], x2 = v[bj][4 + e]; v[bj][e] = x1 * c4[e] - x2 * s4[e]; v[bj][4 + e] = x2 * c4[e] + x1 * s4[e]; } }
            }
          }
#pragma unroll
          for (int bj = 0; bj < 2; ++bj) { const int mc = 64 * wc + 32 * bj + 8 * fq;
            u32x4 o; o.x = pk2(v[bj][0], v[bj][1]); o.y = pk2(v[bj][2], v[bj][3]); o.z = pk2(v[bj][4], v[bj][5]); o.w = pk2(v[bj][6], v[bj][7]);
            *(u32x4*)(PLB + (size_t)r * PLW + slot * 256 + mc) = o; }
        }
        asm volatile("" ::: "memory");
      }
    }
  }
};
struct EpiOut {
  static constexpr bool PERM = true, AFTER_DRAIN = false;
  const float* xin; const float* cin; float* xout; float* cout; const float* MODl;
  __device__ __forceinline__ void operator()(const f32x4 (&acc)[2][2][4][2], const Unit& u, int wr, int wc, int fr_, int fq_) const {
    int fr = fr_, fq = fq_; asm volatile("" : "+v"(fr), "+v"(fq));
    const int row0 = u.pm * 256 + wr * 64 + fr, col0 = u.pn * 256 + wc * 32 + 8 * fq;
    const bool ctxrows = u.pm >= 64;
    const float* gate = MODl + (size_t)(ctxrows ? 4 : (u.pm >> 4)) * 3072 + 2048;
    f32x4 gv[2][2];
#pragma unroll
    for (int bj = 0; bj < 2; ++bj)
#pragma unroll
      for (int n = 0; n < 2; ++n) gv[bj][n] = *(const f32x4*)(gate + col0 + bj * 128 + n * 4);
    const float* sp0; float* dp0;
    if (!ctxrows) { sp0 = xin + (size_t)row0 * 1024 + col0; dp0 = xout + (size_t)row0 * 1024 + col0; }
    else { sp0 = cin + (size_t)(row0 - MLAT) * 1024 + col0; dp0 = cout + (size_t)(row0 - MLAT) * 1024 + col0; }
#pragma unroll
    for (int ai = 0; ai < 2; ++ai) {
      f32x4 xv[4][2][2];
#pragma unroll
      for (int m = 0; m < 4; ++m)
#pragma unroll
        for (int bj = 0; bj < 2; ++bj)
#pragma unroll
          for (int n = 0; n < 2; ++n) xv[m][bj][n] = *(const f32x4*)(sp0 + (size_t)(ai * 128 + m * 16) * 1024 + bj * 128 + n * 4);
      __builtin_amdgcn_sched_barrier(0);
#pragma unroll
      for (int m = 0; m < 4; ++m)
#pragma unroll
        for (int bj = 0; bj < 2; ++bj)
#pragma unroll
          for (int n = 0; n < 2; ++n) *(f32x4*)(dp0 + (size_t)(ai * 128 + m * 16) * 1024 + bj * 128 + n * 4) = xv[m][bj][n] + gv[bj][n] * acc[ai][bj][m][n];
      asm volatile("" ::: "memory");
    }
  }
};
struct InOrder {
  pg8::StaticOrder S;
  static constexpr unsigned long long PACK = 0x3c817d9b0a5246ull;
  __device__ __forceinline__ bool next(int i, Unit& u) const { const bool ok = S.next(i, u); if (ok) u.pn = (int)((PACK >> (4 * u.pn)) & 15ull); return ok; }
  __device__ __forceinline__ void a_ready(const Unit&) const {}
  __device__ __forceinline__ void done(const Unit&) const {}
};
__device__ __forceinline__ void p2_inproj(const Frame& F, const Args& a, int layer) {
  unsigned char* ws = opq(a.ws);
  pg8::Gemm g{(const pg8::bf16_t*)(ws + WS_H), (const pg8::bf16_t*)(ws + WS_W1T) + (size_t)layer * N1 * 1024, MT, N1, 1024};
  InOrder S; S.S.init(MT, N1, F.G, (int)blockIdx.x);
  LAS float* ropeL = (LAS float*)(F.lds + pg8::STAGE_BYTES);
  { int tid = threadIdx.x; asm volatile("" : "+v"(tid)); const f32x4 t = *(const f32x4*)((const float*)(ws + WS_ROPE) + 4 * tid); *(LAS f32x4*)(ropeL + 4 * tid) = t;
    if (tid < 128) {
      const float* n0 = opq(a.in[13]); const float* n1 = opq(a.in[14]); const float* n2 = opq(a.in[16]); const float* n3 = opq(a.in[17]); const float* db = opq(a.in[10]);
      const int k = tid >> 4; const float* src = tid < 64 ? (k == 0 ? n0 : k == 1 ? n1 : k == 2 ? n2 : n3) + layer * 64 + 4 * (tid & 15) : db + layer * 256 + 4 * (tid - 64);
      *(LAS f32x4*)(ropeL + 2048 + 4 * tid) = *(const f32x4*)src; } }
  __syncthreads();
  EpiIn E{(bf16*)(ws + WS_PLB), (float*)(ws + WS_LA), (bf16*)(ws + WS_FA2), ropeL};
  pg8::gemm_phase<EpiIn, InOrder>(F.lds, g, S, E, nullptr);
}

__device__ __forceinline__ void ctx_out_item(const Frame& F, const Args& a, int item) {
  unsigned char* ws = opq(a.ws);
  const bf16* Yc = (const bf16*)(ws + WS_H) + (size_t)MLAT * 1024; const bf16* W2 = (const bf16*)(ws + WS_W2T);
  const int tm = item >> 4, tn = item & 15, sub = F.wave & 3, kh = F.wave >> 2, r32 = F.lane & 31, hi = F.lane >> 5;
  const int row0 = 64 * tm + 32 * (sub >> 1), col0 = 64 * tn + 32 * (sub & 1);
  const bf16* ap = Yc + (size_t)(row0 + r32) * 1024 + kh * 512 + 8 * hi;
  const bf16* bp = W2 + (size_t)(col0 + r32) * 1024 + kh * 512 + 8 * hi;
  f32x16 acc;
#pragma unroll
  for (int i = 0; i < 16; ++i) acc[i] = 0.f;
#pragma unroll 1
  for (int sb = 0; sb < 4; ++sb) {
    bf16x8 af[8], bf[8];
#pragma unroll
    for (int s = 0; s < 8; ++s) { af[s] = *(const bf16x8*)(ap + (sb * 8 + s) * 16); bf[s] = *(const bf16x8*)(bp + (sb * 8 + s) * 16); }
    __builtin_amdgcn_sched_barrier(0);
#pragma unroll
    for (int s = 0; s < 8; ++s) acc = __builtin_amdgcn_mfma_f32_32x32x16_bf16(af[s], bf[s], acc, 0, 0, 0);
  }
  LAS float* X = (LAS float*)F.lds + sub * 1024;
  __syncthreads();
  if (kh == 1) {
#pragma unroll
    for (int r = 0; r < 16; ++r) X[r * 64 + F.lane] = acc[r];
  }
  __syncthreads();
  if (kh == 0) {
    const float* cin = opq(a.in[2]); float* cout = (float*)(ws + WS_CTX1);
    const float gate = ((const float*)(ws + WS_MOD))[4 * 3072 + 2048 + col0 + r32];
    float ci[16];
#pragma unroll
    for (int r = 0; r < 16; ++r) ci[r] = cin[(size_t)(row0 + crow(r, hi)) * 1024 + col0 + r32];
    __builtin_amdgcn_sched_barrier(0);
#pragma unroll
    for (int r = 0; r < 16; ++r) { const size_t o = (size_t)(row0 + crow(r, hi)) * 1024 + col0 + r32; cout[o] = ci[r] + gate * (acc[r] + X[r * 64 + F.lane]); }
  }
}
__device__ __forceinline__ void p5_outproj(const Frame& F, const Args& a, int layer) {
  unsigned char* ws = opq(a.ws);
  const int M = MLAT;
  pg8::Gemm g{(const pg8::bf16_t*)(ws + WS_H), (const pg8::bf16_t*)(ws + WS_W2T) + (size_t)layer * 1024 * 1024, M, 1024, 1024};
  pg8::StaticOrder S; S.init(M, 1024, F.G, (int)blockIdx.x);
  EpiOut E{layer == 0 ? opq(a.in[0]) : opq(a.out), layer == 0 ? opq(a.in[2]) : (const float*)(ws + WS_CTX1), opq(a.out), (float*)(ws + WS_CTX1), (const float*)(ws + WS_MOD) + (size_t)layer * 5 * 3072};
  pg8::gemm_phase<EpiOut, pg8::StaticOrder>(F.lds, g, S, E, nullptr);
  if (layer == 0) { const Frame F2 = relaunder(F); for (int it = F2.vcu; it < 256; it += F2.G) ctx_out_item(F2, a, it); }
}
}

namespace mk {
typedef short v4i16_t __attribute__((ext_vector_type(4)));
__device__ __forceinline__ s16x4 vtr(LAS const unsigned char* p) { return __builtin_bit_cast(s16x4, __builtin_amdgcn_ds_read_tr16_b64_v4i16((LAS v4i16_t*)p)); }
struct AttnState { float m, l; f32x16 o0, o1; };
template <class MaskF>
__device__ __forceinline__ void attn_tile(AttnState& st, const bf16x8 (&qf)[4], LAS const unsigned char* Kt, LAS const unsigned char* Vt, int lane, MaskF&& maskf) {
  const int r32 = lane & 31, hi = lane >> 5;
  f32x16 p0, p1;
  const int ksw = (r32 >> 1) & 7;
  bf16x8 ka[4], kb[4];
#pragma unroll
  for (int s = 0; s < 4; ++s) { const int ch = ((2 * s + hi) ^ ksw) << 4; ka[s] = *(LAS const bf16x8*)(Kt + r32 * 128 + ch); kb[s] = *(LAS const bf16x8*)(Kt + (32 + r32) * 128 + ch); }
  { const f32x16 z = {0.f, 0.f, 0.f, 0.f, 0.f, 0.f, 0.f, 0.f, 0.f, 0.f, 0.f, 0.f, 0.f, 0.f, 0.f, 0.f};
    p0 = __builtin_amdgcn_mfma_f32_32x32x16_bf16(ka[0], qf[0], z, 0, 0, 0); p1 = __builtin_amdgcn_mfma_f32_32x32x16_bf16(kb[0], qf[0], z, 0, 0, 0); }
#pragma unroll
  for (int s = 1; s < 4; ++s) { p0 = __builtin_amdgcn_mfma_f32_32x32x16_bf16(ka[s], qf[s], p0, 0, 0, 0); p1 = __builtin_amdgcn_mfma_f32_32x32x16_bf16(kb[s], qf[s], p1, 0, 0, 0); }
  maskf(p0, p1);
  float ps = 0.f;
#pragma unroll
  for (int i = 0; i < 16; ++i) { p0[i] = __builtin_amdgcn_exp2f(p0[i]); p1[i] = __builtin_amdgcn_exp2f(p1[i]); ps += p0[i] + p1[i]; }
  st.l += ps;
  u32x4 pw[4];
#pragma unroll
  for (int k = 0; k < 2; ++k) {
    pw[k] = (u32x4){pk2(p0[8 * k + 0], p0[8 * k + 1]), pk2(p0[8 * k + 2], p0[8 * k + 3]), pk2(p0[8 * k + 4], p0[8 * k + 5]), pk2(p0[8 * k + 6], p0[8 * k + 7])};
    pw[2 + k] = (u32x4){pk2(p1[8 * k + 0], p1[8 * k + 1]), pk2(p1[8 * k + 2], p1[8 * k + 3]), pk2(p1[8 * k + 4], p1[8 * k + 5]), pk2(p1[8 * k + 6], p1[8 * k + 7])};
  }
  const int q = (lane & 15) >> 2, p = lane & 3, gsel = (lane >> 4) & 1;
  const int vrow = (4 * hi + q) * 128 + 8 * (p & 1);
  const int chb = 2 * gsel + (p >> 1);
#pragma unroll
  for (int ks = 0; ks < 4; ++ks) {
    const int c0_ = ((chb | ((0 ^ (q >> 1)) << 2)) << 4), c1_ = ((chb | ((1 ^ (q >> 1)) << 2)) << 4);
    const s16x4 l0 = vtr(Vt + ks * 2048 + vrow + c0_), h0 = vtr(Vt + ks * 2048 + 1024 + vrow + c0_), l1 = vtr(Vt + ks * 2048 + vrow + c1_), h1 = vtr(Vt + ks * 2048 + 1024 + vrow + c1_);
    const bf16x8 va0 = (bf16x8){l0[0], l0[1], l0[2], l0[3], h0[0], h0[1], h0[2], h0[3]}, va1 = (bf16x8){l1[0], l1[1], l1[2], l1[3], h1[0], h1[1], h1[2], h1[3]};
    st.o0 = __builtin_amdgcn_mfma_f32_32x32x16_bf16(va0, __builtin_bit_cast(bf16x8, pw[ks]), st.o0, 0, 0, 0);
    st.o1 = __builtin_amdgcn_mfma_f32_32x32x16_bf16(va1, __builtin_bit_cast(bf16x8, pw[ks]), st.o1, 0, 0, 0);
  }
}
template <class MaskF, class F1, class F2, class F3>
__device__ __forceinline__ void attn_tile_dma(AttnState& st, const bf16x8 (&qf)[4], LAS const unsigned char* Kt, LAS const unsigned char* Vt, int lane, MaskF&& maskf, F1&& after_k, F2&& before_v, F3&& after_v) {
  const int r32 = lane & 31, hi = lane >> 5;
  f32x16 p0, p1;
  const int ksw = (r32 >> 1) & 7;
  bf16x8 ka[4], kb[4];
#pragma unroll
  for (int s = 0; s < 4; ++s) { const int ch = ((2 * s + hi) ^ ksw) << 4; ka[s] = *(LAS const bf16x8*)(Kt + r32 * 128 + ch); kb[s] = *(LAS const bf16x8*)(Kt + (32 + r32) * 128 + ch); }
  asm volatile("s_waitcnt lgkmcnt(0)" ::: "memory");
  after_k();
  { const f32x16 z = {0.f, 0.f, 0.f, 0.f, 0.f, 0.f, 0.f, 0.f, 0.f, 0.f, 0.f, 0.f, 0.f, 0.f, 0.f, 0.f};
    p0 = __builtin_amdgcn_mfma_f32_32x32x16_bf16(ka[0], qf[0], z, 0, 0, 0); p1 = __builtin_amdgcn_mfma_f32_32x32x16_bf16(kb[0], qf[0], z, 0, 0, 0); }
#pragma unroll
  for (int s = 1; s < 4; ++s) { p0 = __builtin_amdgcn_mfma_f32_32x32x16_bf16(ka[s], qf[s], p0, 0, 0, 0); p1 = __builtin_amdgcn_mfma_f32_32x32x16_bf16(kb[s], qf[s], p1, 0, 0, 0); }
  maskf(p0, p1);
  float ps = 0.f;
#pragma unroll
  for (int i = 0; i < 16; ++i) { p0[i] = __builtin_amdgcn_exp2f(p0[i]); p1[i] = __builtin_amdgcn_exp2f(p1[i]); ps += p0[i] + p1[i]; }
  st.l += ps;
  u32x4 pw[4];
#pragma unroll
  for (int k = 0; k < 2; ++k) {
    pw[k] = (u32x4){pk2(p0[8 * k + 0], p0[8 * k + 1]), pk2(p0[8 * k + 2], p0[8 * k + 3]), pk2(p0[8 * k + 4], p0[8 * k + 5]), pk2(p0[8 * k + 6], p0[8 * k + 7])};
    pw[2 + k] = (u32x4){pk2(p1[8 * k + 0], p1[8 * k + 1]), pk2(p1[8 * k + 2], p1[8 * k + 3]), pk2(p1[8 * k + 4], p1[8 * k + 5]), pk2(p1[8 * k + 6], p1[8 * k + 7])};
  }
  before_v();
  const int q = (lane & 15) >> 2, p = lane & 3, gsel = (lane >> 4) & 1;
  const int vrow = (4 * hi + q) * 128 + 8 * (p & 1);
  const int chb = 2 * gsel + (p >> 1);
  s16x4 vl0[4], vh0[4], vl1[4], vh1[4];
#pragma unroll
  for (int ks = 0; ks < 4; ++ks) {
    const int c0_ = ((chb | ((0 ^ (q >> 1)) << 2)) << 4), c1_ = ((chb | ((1 ^ (q >> 1)) << 2)) << 4);
    vl0[ks] = vtr(Vt + ks * 2048 + vrow + c0_); vh0[ks] = vtr(Vt + ks * 2048 + 1024 + vrow + c0_); vl1[ks] = vtr(Vt + ks * 2048 + vrow + c1_); vh1[ks] = vtr(Vt + ks * 2048 + 1024 + vrow + c1_);
  }
  asm volatile("s_waitcnt lgkmcnt(0)" ::: "memory");
  after_v();
#pragma unroll
  for (int ks = 0; ks < 4; ++ks) {
    const bf16x8 va0 = (bf16x8){vl0[ks][0], vl0[ks][1], vl0[ks][2], vl0[ks][3], vh0[ks][0], vh0[ks][1], vh0[ks][2], vh0[ks][3]}, va1 = (bf16x8){vl1[ks][0], vl1[ks][1], vl1[ks][2], vl1[ks][3], vh1[ks][0], vh1[ks][1], vh1[ks][2], vh1[ks][3]};
    st.o0 = __builtin_amdgcn_mfma_f32_32x32x16_bf16(va0, __builtin_bit_cast(bf16x8, pw[ks]), st.o0, 0, 0, 0);
    st.o1 = __builtin_amdgcn_mfma_f32_32x32x16_bf16(va1, __builtin_bit_cast(bf16x8, pw[ks]), st.o1, 0, 0, 0);
  }
}
__device__ __forceinline__ void glds16(const void* sbase  , unsigned voff  , unsigned lds_dst) {
  unsigned keep;
  asm volatile("s_mov_b32 %0, m0\n\ts_mov_b32 m0, %2\n\ts_nop 0\n\tglobal_load_lds_dwordx4 %1, %3\n\ts_mov_b32 m0, %0" : "=&s"(keep) : "v"(voff), "s"(lds_dst), "s"(sbase) : "memory");
}
__device__ __forceinline__ void attn_store(const AttnState& st, float inv, const bf16* grow  , bf16* yrow  , int lane) {
  const int hi = lane >> 5;
  u32x2 gv[8];
#pragma unroll
  for (int i = 0; i < 8; ++i) gv[i] = *(const u32x2*)(grow + 32 * (i >> 2) + 8 * (i & 3) + 4 * hi);
  __builtin_amdgcn_sched_barrier(0);
#pragma unroll
  for (int d0 = 0; d0 < 2; ++d0)
#pragma unroll
    for (int gi = 0; gi < 4; ++gi) {
      const int db = 32 * d0 + 8 * gi + 4 * hi; const u32x2 g = gv[4 * d0 + gi];
      const f32x16& o = d0 == 0 ? st.o0 : st.o1;
      const float g0 = __uint_as_float(g.x << 16), g1 = __uint_as_float(g.x & 0xffff0000u), g2 = __uint_as_float(g.y << 16), g3 = __uint_as_float(g.y & 0xffff0000u);
      u32x2 ov; ov.x = pk2(o[4 * gi + 0] * inv * g0, o[4 * gi + 1] * inv * g1); ov.y = pk2(o[4 * gi + 2] * inv * g2, o[4 * gi + 3] * inv * g3);
      *(u32x2*)(yrow + db) = ov;
    }
}
template <int NH> struct TileRegs { u32x4 k[NH], v[NH]; };
template <int NH>
__device__ __forceinline__ void tile_load(TileRegs<NH>& R, const bf16* kbase  , const bf16* vbase, int tid) {
  const int key = tid >> 3, ch = tid & 7;
#pragma unroll
  for (int h = 0; h < NH; ++h) { R.k[h] = *(const u32x4*)(kbase + (size_t)key * PLW + h * 64 + ch * 8); R.v[h] = *(const u32x4*)(vbase + (size_t)key * PLW + h * 64 + ch * 8); }
}
template <int NH>
__device__ __forceinline__ void tile_store(const TileRegs<NH>& R, LAS unsigned char* buf, int tid) {
  const int key = tid >> 3, ch = tid & 7;
  const int ko = key * 128 + ((ch ^ ((key >> 1) & 7)) << 4), vo = key * 128 + ((ch ^ (((key >> 1) & 1) << 2)) << 4);
#pragma unroll
  for (int h = 0; h < NH; ++h) { *(LAS u32x4*)(buf + h * 8192 + ko) = R.k[h]; *(LAS u32x4*)(buf + NH * 8192 + h * 8192 + vo) = R.v[h]; }
}

template <int NH> struct TileRegs2 { TileRegs<NH> a, b; };
__device__ __forceinline__ void swa_item(const Frame& F0, const Args& a, int layer, int item) {
  const Frame F = relaunder(F0);
  unsigned char* ws = opq(a.ws);
  const bf16* PLB = (const bf16*)(ws + WS_PLB); bf16* Y = (bf16*)(ws + WS_H);
  const bool isctx = item >= 256;
  int b, kvh, n;
  if (!isctx) { b = item >> 6; kvh = (item >> 5) & 1; n = item & 31; } else { const int ci = item - 256; b = ci >> 2; kvh = (ci >> 1) & 1; n = ci & 1; }
  const int g = F.wave >> 2, quarter = F.wave & 3, hq = 2 * kvh + g, r32 = F.lane & 31, hi = F.lane >> 5;
  const int tq = 128 * n + 32 * quarter + r32;
  const size_t qrow = isctx ? (size_t)MLAT + b * CTX + tq : (size_t)b * SEQ + tq;
  bf16x8 qf[4];
#pragma unroll
  for (int s = 0; s < 4; ++s) qf[s] = *(const bf16x8*)(PLB + qrow * PLW + S_CQ * 256 + hq * 64 + 16 * s + 8 * hi);
  int jlo = 0, jhi = 0;
  if (!isctx) { jlo = n == 0 ? 1 : 0; jhi = n == 31 ? 2 : 3; }
  const int nloc = jhi - jlo, T = nloc + 2;
  const bf16* kcol = PLB + S_CKV * 256 + kvh * 64;
  auto tile_row = [&](int t) -> size_t { return t < nloc ? (size_t)b * SEQ + 128 * (n - 1 + jlo + t) : (size_t)MLAT + b * CTX + 128 * (t - nloc); };
  AttnState st; st.m = 0.f; st.l = 0.f;
#pragma unroll
  for (int i = 0; i < 16; ++i) { st.o0[i] = 0.f; st.o1[i] = 0.f; }
  TileRegs2<1> R;
  __syncthreads();
  { const size_t r0 = tile_row(0); tile_load<1>(R.a, kcol + r0 * PLW, kcol + 128 + r0 * PLW, F.tid); tile_load<1>(R.b, kcol + (r0 + 64) * PLW, kcol + 128 + (r0 + 64) * PLW, F.tid); }
  tile_store<1>(R.a, F.lds, F.tid); tile_store<1>(R.b, F.lds + 16384, F.tid);
  __syncthreads();
  for (int t = 0; t < T; ++t) {
    if (t + 1 < T) { const size_t r0 = tile_row(t + 1); tile_load<1>(R.a, kcol + r0 * PLW, kcol + 128 + r0 * PLW, F.tid); tile_load<1>(R.b, kcol + (r0 + 64) * PLW, kcol + 128 + (r0 + 64) * PLW, F.tid); }
    LAS const unsigned char* buf = F.lds + (t & 1) * 32768;
#pragma unroll
    for (int hf = 0; hf < 2; ++hf) {
      LAS const unsigned char* hb = buf + hf * 16384;
      if (t < nloc) {
        const int kb = 128 * (n - 1 + jlo + t) + 64 * hf, q0 = 128 * n + 32 * quarter;
        if (!(kb + 63 < q0 - 128 || kb > q0 + 31 + 128)) {
          const int dq = kb - tq;
          if (kb >= q0 + 31 - 128 && kb + 63 <= q0 + 128) attn_tile(st, qf, hb, hb + 8192, F.lane, [](f32x16&, f32x16&) {});
          else attn_tile(st, qf, hb, hb + 8192, F.lane, [&](f32x16& p0, f32x16& p1) {
#pragma unroll
            for (int r = 0; r < 16; ++r) { const int d0_ = dq + 128 + crow(r, hi), d1_ = d0_ + 32;
              p0[r] = ((unsigned)d0_ <= 256u) ? p0[r] : -INFINITY; p1[r] = ((unsigned)d1_ <= 256u) ? p1[r] : -INFINITY; } });
        }
      } else attn_tile(st, qf, hb, hb + 8192, F.lane, [](f32x16&, f32x16&) {});
    }
    if (t + 1 < T) { tile_store<1>(R.a, F.lds + ((t + 1) & 1) * 32768, F.tid); tile_store<1>(R.b, F.lds + ((t + 1) & 1) * 32768 + 16384, F.tid); }
    __syncthreads();
  }
  float l = st.l + __shfl_xor(st.l, 32);
  const float sk2 = opq(a.in[15])[layer * 4 + hq] * LOG2E;
  const float mnew = fmaxf(st.m, sk2), al = __builtin_amdgcn_exp2f(st.m - mnew);
  l = l * al + __builtin_amdgcn_exp2f(sk2 - mnew);
  int qr = (int)qrow; asm volatile("" : "+v"(qr));
  attn_store(st, al / l, PLB + (size_t)qr * PLW + S_CG * 256 + hq * 64, Y + (size_t)qr * 1024 + 512 + hq * 64, F.lane);
}
__device__ __forceinline__ void na_item(const Frame& F0, const Args& a, int layer, int item) {
  const Frame F = relaunder(F0);
  unsigned char* ws = opq(a.ws);
  const bf16* PLB = (const bf16*)(ws + WS_PLB); bf16* Y = (bf16*)(ws + WS_H);
  const bool isctx = item >= 256;
  int b, r;
  if (!isctx) { b = item >> 6; r = item & 63; } else { const int ci = item - 256; b = ci >> 2; r = ci & 3; }
  const int head = F.wave >> 1, half = F.wave & 1, r32 = F.lane & 31, hi = F.lane >> 5;
  const int qc = 32 * half + r32;
  const size_t qrow = isctx ? (size_t)MLAT + b * CTX + 64 * r + qc : (size_t)b * SEQ + 64 * r + qc;
  bf16x8 qf[4];
#pragma unroll
  for (int s = 0; s < 4; ++s) qf[s] = *(const bf16x8*)(PLB + qrow * PLW + S_DQ * 256 + head * 64 + 16 * s + 8 * hi);
  int rs = r - 4; rs = rs < 0 ? 0 : (rs > 56 ? 56 : rs);
  const int nloc = isctx ? 0 : 8, T = nloc + 4;
  auto tile_row = [&](int t) -> size_t { return t < nloc ? (size_t)b * SEQ + 64 * (rs + t) : (size_t)MLAT + b * CTX + 64 * (t - nloc); };
  const bf16* kcol = PLB + S_DK * 256 + head * 64; const bf16* vcol = PLB + S_DV * 256 + head * 64;
  LAS float* btab = (LAS float*)(F.lds + 2 * 65536);
  LAS unsigned char* Kt = F.lds + F.wave * 16384; LAS unsigned char* Vt = Kt + 8192;
  const unsigned kdst = (unsigned)(size_t)Kt, vdst = kdst + 8192u;
  const int kk = F.lane >> 3, cs = F.lane & 7;
  const unsigned ok0 = kk * (PLW * 2) + ((cs ^ (kk >> 1)) << 4), ok1 = kk * (PLW * 2) + ((cs ^ (4 + (kk >> 1))) << 4), ov = kk * (PLW * 2) + ((cs ^ (((kk >> 1) & 1) << 2)) << 4);
  auto dma_k = [&](int t) { const unsigned char* tb = (const unsigned char*)(kcol + tile_row(t) * PLW);
#pragma unroll
    for (int n = 0; n < 8; ++n) glds16(tb + (size_t)n * 8 * (PLW * 2), (n & 1) ? ok1 : ok0, kdst + n * 1024); };
  auto dma_v = [&](int t) { const unsigned char* tb = (const unsigned char*)(vcol + tile_row(t) * PLW);
#pragma unroll
    for (int n = 0; n < 8; ++n) glds16(tb + (size_t)n * 8 * (PLW * 2), ov, vdst + n * 1024); };
  AttnState st; st.m = 0.f; st.l = 0.f;
#pragma unroll
  for (int i = 0; i < 16; ++i) { st.o0[i] = 0.f; st.o1[i] = 0.f; }
#pragma unroll
  for (int s = 0; s < 4; ++s) asm volatile("" : "+v"(qf[s]));
  __syncthreads();
  dma_k(0); dma_v(0);
  {
    const float* rb = opq(a.in[18]) + (size_t)layer * 4 * 15 * 31; float t_[15];
#pragma unroll
    for (int i = 0; i < 15; ++i) { const int ix = F.tid + 512 * i, hd = ix >> 7, dx = (ix & 127) - 63; const int dc = dx < -15 ? -15 : (dx > 15 ? 15 : dx); t_[i] = rb[hd * 31 + dc + 15]; }
    __builtin_amdgcn_sched_barrier(0);
#pragma unroll
    for (int i = 0; i < 15; ++i) { const int dx = ((F.tid + 512 * i) & 127) - 63; btab[F.tid + 512 * i] = (dx >= -15 && dx <= 15) ? t_[i] * LOG2E : 0.f; } }
  __syncthreads();
  int c0 = qc - 8; c0 = c0 < 0 ? 0 : (c0 > 48 ? 48 : c0);
  for (int t = 0; t < T; ++t) {
    const bool more = t + 1 < T;
    asm volatile("s_waitcnt vmcnt(8)" ::: "memory");
    auto after_k = [&]() { if (more) dma_k(t + 1); };
    auto before_v = [&]() { if (more) asm volatile("s_waitcnt vmcnt(8)" ::: "memory"); else asm volatile("s_waitcnt vmcnt(0)" ::: "memory"); };
    auto after_v = [&]() { if (more) dma_v(t + 1); };
    if (t < nloc) {
      const int dy = rs + t - r + 7;
      const int c0l = c0;
      unsigned bta = (unsigned)(size_t)(btab + (head * 15 + dy) * 128 + 63 - qc + 4 * hi); asm volatile("" : "+v"(bta));
      LAS const float* bt = (LAS const float*)bta;
      attn_tile_dma(st, qf, Kt, Vt, F.lane, [&](f32x16& p0, f32x16& p1) {
        float bb[16];
#pragma unroll
        for (int rr = 0; rr < 16; ++rr) bb[rr] = bt[(rr & 3) + 8 * (rr >> 2)];
#pragma unroll
        for (int rr = 0; rr < 16; ++rr) p0[rr] = ((unsigned)((rr & 3) + 8 * (rr >> 2) + 4 * hi - c0l) < 16u) ? p0[rr] + bb[rr] : -INFINITY;
#pragma unroll
        for (int rr = 0; rr < 16; ++rr) bb[rr] = bt[(rr & 3) + 8 * (rr >> 2) + 32];
#pragma unroll
        for (int rr = 0; rr < 16; ++rr) p1[rr] = ((unsigned)((rr & 3) + 8 * (rr >> 2) + 32 + 4 * hi - c0l) < 16u) ? p1[rr] + bb[rr] : -INFINITY; }, after_k, before_v, after_v);
    } else attn_tile_dma(st, qf, Kt, Vt, F.lane, [](f32x16&, f32x16&) {}, after_k, before_v, after_v);
  }
  const float l = st.l + __shfl_xor(st.l, 32);
  int qr = (int)qrow; asm volatile("" : "+v"(qr));
  attn_store(st, 1.f / l, PLB + (size_t)qr * PLW + S_DG * 256 + head * 64, Y + (size_t)qr * 1024 + 768 + head * 64, F.lane);
}
}

namespace mk {
constexpr int XT_STRIDE = 272;
constexpr int FFT_WC = 256 * XT_STRIDE;
__device__ __forceinline__ void fft_item(const Frame& F0, const Args& a, int item) {
  const Frame F = relaunder(F0);
  unsigned char* ws = opq(a.ws);
  const bf16* PLB = (const bf16*)(ws + WS_PLB); bf16* Y = (bf16*)(ws + WS_H);
  const int b = item >> 6, slice = item & 63, r32 = F.lane & 31, hi = F.lane >> 5, w = F.wave;
  LAS unsigned char* Xt = F.lds; LAS unsigned char* Wl = F.lds + FFT_WC;
  __syncthreads();
  {
    const bf16* WC = (const bf16*)(ws + WS_WC);
    u32x4 wt[4];
#pragma unroll
    for (int i = 0; i < 4; ++i) { const int idx = F.tid + 512 * i, row = idx >> 4, ch = idx & 15; wt[i] = *(const u32x4*)(WC + row * 128 + ch * 8); }
    const bf16* src = (const bf16*)(ws + WS_FA2) + ((size_t)b * 64 + slice) * TROW * 8;
    u32x4 v[8];
#pragma unroll
    for (int i = 0; i < 8; ++i) v[i] = *(const u32x4*)(src + (size_t)(F.tid + 512 * i) * 8);
    __builtin_amdgcn_sched_barrier(0);
#pragma unroll
    for (int i = 0; i < 4; ++i) { const int idx = F.tid + 512 * i, row = idx >> 4, ch = idx & 15; *(LAS u32x4*)(Wl + row * XT_STRIDE + ch * 16) = wt[i]; }
#pragma unroll
    for (int i = 0; i < 8; ++i) { const int t = F.tid + 512 * i, n1 = t >> 6, n2 = t & 63;
      const unsigned vv[4] = {v[i].x, v[i].y, v[i].z, v[i].w};
#pragma unroll
      for (int j = 0; j < 8; ++j) { const int c = j & 3, part = j >> 2; const unsigned short e = (unsigned short)((j & 1) ? (vv[j >> 1] >> 16) : (vv[j >> 1] & 0xffffu));
        *(LAS unsigned short*)(Xt + (n2 * 4 + c) * XT_STRIDE + (part * 64 + n1) * 2) = e; } }
  }
  __syncthreads();
  f32x16 acc[4];
#pragma unroll
  for (int rb = 0; rb < 4; ++rb)
#pragma unroll
    for (int i = 0; i < 16; ++i) acc[rb][i] = 0.f;
  {
    bf16x8 bf[8];
#pragma unroll
    for (int s = 0; s < 8; ++s) bf[s] = *(LAS const bf16x8*)(Xt + (32 * w + r32) * XT_STRIDE + (16 * s + 8 * hi) * 2);
#pragma unroll
    for (int rb = 0; rb < 4; ++rb)
#pragma unroll
      for (int s = 0; s < 8; ++s) { const bf16x8 af = *(LAS const bf16x8*)(Wl + (32 * rb + r32) * XT_STRIDE + (16 * s + 8 * hi) * 2); acc[rb] = __builtin_amdgcn_mfma_f32_32x32x16_bf16(af, bf[s], acc[rb], 0, 0, 0); }
  }
  __syncthreads();
  {
    const int n2 = 8 * w + (r32 >> 2), c = r32 & 3;
#pragma unroll
    for (int rbp = 0; rbp < 2; ++rbp)
#pragma unroll
      for (int r = 0; r < 16; ++r) { const int k1 = 32 * rbp + crow(r, hi); float x = (float)((k1 * n2) & 4095) * (1.f / 4096.f);
        asm volatile("" : "+v"(x) :: "memory");
        const float tc = __builtin_amdgcn_cosf(x), ts = __builtin_amdgcn_sinf(x);
        const float yr = acc[rbp][r], yi = acc[rbp + 2][r];
        const float zr = yr * tc + yi * ts, zi = yi * tc - yr * ts;
        LAS unsigned char* zp = Xt + (k1 * 4 + c) * XT_STRIDE + n2 * 2;
        *(LAS unsigned short*)zp = (unsigned short)f2bf(zr); *(LAS unsigned short*)(zp + 128) = (unsigned short)f2bf(zi); }
  }
  __syncthreads();
  f32x16 o2[2];
#pragma unroll
  for (int rb = 0; rb < 2; ++rb)
#pragma unroll
    for (int i = 0; i < 16; ++i) o2[rb][i] = 0.f;
  {
    bf16x8 bf[8];
#pragma unroll
    for (int s = 0; s < 8; ++s) bf[s] = *(LAS const bf16x8*)(Xt + (32 * w + r32) * XT_STRIDE + (16 * s + 8 * hi) * 2);
#pragma unroll
    for (int rb = 0; rb < 2; ++rb)
#pragma unroll
      for (int s = 0; s < 8; ++s) { const bf16x8 af = *(LAS const bf16x8*)(Wl + (32 * rb + r32) * XT_STRIDE + (16 * s + 8 * hi) * 2); o2[rb] = __builtin_amdgcn_mfma_f32_32x32x16_bf16(af, bf[s], o2[rb], 0, 0, 0); }
  }
  __syncthreads();
  { const int k1 = 8 * w + (r32 >> 2), c = r32 & 3;
#pragma unroll
    for (int rb = 0; rb < 2; ++rb)
#pragma unroll
      for (int r = 0; r < 16; ++r) { const int k = k1 + 64 * (32 * rb + crow(r, hi)); *(LAS unsigned short*)(Xt + k * 8 + c * 2) = (unsigned short)f2bf(o2[rb][r]); }
  }
  __syncthreads();
  { const int o0 = 4 * slice; u32x2 gv[8];
#pragma unroll
    for (int i = 0; i < 8; ++i) gv[i] = *(const u32x2*)(PLB + ((size_t)b * SEQ + F.tid + 512 * i) * PLW + S_BG * 256 + o0);
    __builtin_amdgcn_sched_barrier(0);
#pragma unroll
    for (int i = 0; i < 8; ++i) { const int k = F.tid + 512 * i; const size_t row = (size_t)b * SEQ + k;
      const u32x2 ov = *(LAS const u32x2*)(Xt + k * 8);
      u32x2 y; y.x = pk2(__uint_as_float(ov.x << 16) * __uint_as_float(gv[i].x << 16), __uint_as_float(ov.x & 0xffff0000u) * __uint_as_float(gv[i].x & 0xffff0000u));
      y.y = pk2(__uint_as_float(ov.y << 16) * __uint_as_float(gv[i].y << 16), __uint_as_float(ov.y & 0xffff0000u) * __uint_as_float(gv[i].y & 0xffff0000u));
      *(u32x2*)(Y + row * 1024 + 256 + o0) = y; }
  }
}
constexpr int XC_STRIDE = 1040;
__device__ __forceinline__ void fftc_item(const Frame& F0, const Args& a, int item) {
  const Frame F = relaunder(F0);
  unsigned char* ws = opq(a.ws);
  const bf16* PLB = (const bf16*)(ws + WS_PLB); bf16* Y = (bf16*)(ws + WS_H);
  const bf16* CS = (const bf16*)(ws + WS_CS256);
  const int b = item >> 3, cs = item & 7, r32 = F.lane & 31, hi = F.lane >> 5, w = F.wave;
  LAS unsigned char* Xc = F.lds;
  __syncthreads();
  u32x4 vq[4];
#pragma unroll
  for (int i = 0; i < 4; ++i) { const int idx = F.tid + 512 * i, sl = idx >> 8, n = idx & 255;
    vq[i] = *(const u32x4*)((const bf16*)(ws + WS_FA2) + (((size_t)b * 64 + 8 * cs + sl) * TROW + SEQ + n) * 8); }
  __builtin_amdgcn_sched_barrier(0);
#pragma unroll
  for (int i = 0; i < 4; ++i) { const int idx = F.tid + 512 * i, sl = idx >> 8, n = idx & 255;
    const unsigned vv[4] = {vq[i].x, vq[i].y, vq[i].z, vq[i].w};
#pragma unroll
    for (int j = 0; j < 8; ++j) { const int c = j & 3, part = j >> 2; const unsigned short e = (unsigned short)((j & 1) ? (vv[j >> 1] >> 16) : (vv[j >> 1] & 0xffffu));
      *(LAS unsigned short*)(Xc + (4 * sl + c) * XC_STRIDE + (part * 256 + n) * 2) = e; } }
  __syncthreads();
  f32x16 acc;
#pragma unroll
  for (int i = 0; i < 16; ++i) acc[i] = 0.f;
#pragma unroll 1
  for (int s0 = 0; s0 < 32; s0 += 8) {
    bf16x8 af[8];
#pragma unroll
    for (int j = 0; j < 8; ++j) af[j] = *(const bf16x8*)(CS + (size_t)(32 * w + r32) * 512 + 16 * (s0 + j) + 8 * hi);
    __builtin_amdgcn_sched_barrier(0);
#pragma unroll
    for (int j = 0; j < 8; ++j) {
      const bf16x8 bf = *(LAS const bf16x8*)(Xc + r32 * XC_STRIDE + (16 * (s0 + j) + 8 * hi) * 2);
      acc = __builtin_amdgcn_mfma_f32_32x32x16_bf16(af[j], bf, acc, 0, 0, 0);
    }
  }
  const int o = 32 * cs + r32;
  bf16 gq[16];
#pragma unroll
  for (int r = 0; r < 16; ++r) { const size_t row = (size_t)MLAT + b * CTX + 32 * w + crow(r, hi); gq[r] = PLB[row * PLW + S_BG * 256 + o]; }
  __builtin_amdgcn_sched_barrier(0);
#pragma unroll
  for (int r = 0; r < 16; ++r) { const size_t row = (size_t)MLAT + b * CTX + 32 * w + crow(r, hi);
    Y[row * 1024 + 256 + o] = (bf16)f2bf(acc[r] * bf2f(gq[r])); }
}
}

namespace mk {
constexpr int GU_STRIDE = 2048 + 64;
constexpr size_t WS_GU = WS_SCR, WS_GS = WS_GU + (size_t)32 * 68 * GU_STRIDE * 4;
__device__ __forceinline__ size_t gla_row(int b, int c, int i) { return c < 64 ? (size_t)b * SEQ + 64 * c + i : (size_t)MLAT + b * CTX + 64 * (c - 64) + i; }
__device__ __forceinline__ int gla_pos(int c, int dir) { return c < 64 ? (dir ? 4 + 63 - c : 4 + c) : (dir ? 3 - (c - 64) : (c - 64)); }
__device__ __forceinline__ void gla_stage_v(const Frame& F, const bf16* PLB, int b, int c, LAS unsigned char* vbase) {
  const int key = F.tid >> 3, ch = F.tid & 7;
  const bf16* src = PLB + gla_row(b, c, key) * PLW + S_AV * 256 + ch * 8;
  const int vo = key * 128 + ((ch ^ (((key >> 1) & 1) << 2)) << 4);
  u32x4 t_[4];
#pragma unroll
  for (int h = 0; h < 4; ++h) t_[h] = *(const u32x4*)(src + h * 64);
#pragma unroll
  for (int h = 0; h < 4; ++h) *(LAS u32x4*)(vbase + h * 8192 + vo) = t_[h];
}
__device__ __forceinline__ void gla_cum(const float* LA, int b, int c, int h, int dir, int lane, float (&cw)[32], float& T) {
  const int d = lane & 31, half = lane >> 5;
  float a[32];
#pragma unroll
  for (int ii = 0; ii < 32; ++ii) a[ii] = LA[gla_row(b, c, 32 * half + ii) * 256 + dir * 128 + h * 32 + d];
  float run = 0.f;
#pragma unroll
  for (int ii = 0; ii < 32; ++ii) { run += a[ii]; cw[ii] = run; }
  const float other = __shfl_xor(run, 32);
  const float tot0 = half ? other : run;
  T = run + other;
#pragma unroll
  for (int ii = 0; ii < 32; ++ii) { const float cf = cw[ii] + (half ? tot0 : 0.f); cw[ii] = dir ? (T - cf + a[ii]) : cf; }
}
constexpr int KT_STRIDE = 144;
__device__ __forceinline__ void gla_local_item(const Frame& F0, const Args& a, int item) {
  const Frame F = relaunder(F0);
  unsigned char* ws = opq(a.ws);
  const bf16* PLB = (const bf16*)(ws + WS_PLB); const float* LA = (const float*)(ws + WS_LA);
  const int b = item / 68, c = item % 68, h = F.wave >> 1, dir = F.wave & 1, d = F.lane & 31, half = F.lane >> 5, r32 = d, hi = half;
  LAS unsigned char* Vt = F.lds + h * 8192; LAS unsigned char* KT = F.lds + 32768 + F.wave * (32 * KT_STRIDE);
  __syncthreads();
  gla_stage_v(F, PLB, b, c, F.lds);
  float cw[32], T;
  gla_cum(LA, b, c, h, dir, F.lane, cw, T);
  {
    unsigned pkd[16]; bf16 kr[32];
    const bf16* kp = PLB + gla_row(b, c, 32 * half) * PLW + S_AQK * 256 + 128 + h * 32 + d;
#pragma unroll
    for (int ii = 0; ii < 32; ++ii) kr[ii] = kp[(size_t)ii * PLW];
#pragma unroll
    for (int ii = 0; ii < 32; ii += 2) pkd[ii >> 1] = pk2(bf2f(kr[ii]) * __expf(T - cw[ii]), bf2f(kr[ii + 1]) * __expf(T - cw[ii + 1]));
#pragma unroll
    for (int q4 = 0; q4 < 4; ++q4) *(LAS u32x4*)(KT + d * KT_STRIDE + half * 64 + q4 * 16) = (u32x4){pkd[4 * q4], pkd[4 * q4 + 1], pkd[4 * q4 + 2], pkd[4 * q4 + 3]};
  }
  __syncthreads();
  f32x16 acc[2];
#pragma unroll
  for (int eb = 0; eb < 2; ++eb)
#pragma unroll
    for (int i = 0; i < 16; ++i) acc[eb][i] = 0.f;
  const int q = (F.lane & 15) >> 2, p = F.lane & 3, gsel = (F.lane >> 4) & 1;
  const int chb = 2 * gsel + (p >> 1);
#pragma unroll
  for (int st = 0; st < 4; ++st) {
    const bf16x8 kb = *(LAS const bf16x8*)(KT + r32 * KT_STRIDE + (16 * st + 8 * hi) * 2);
#pragma unroll
    for (int eb = 0; eb < 2; ++eb) {
      const int ch = ((chb | ((eb ^ (q >> 1)) << 2)) << 4);
      LAS const unsigned char* vp = Vt + (16 * st + 8 * hi + q) * 128 + 8 * (p & 1) + ch;
      const s16x4 lo = vtr(vp), hh = vtr(vp + 512);
      const bf16x8 va = (bf16x8){lo[0], lo[1], lo[2], lo[3], hh[0], hh[1], hh[2], hh[3]};
      acc[eb] = __builtin_amdgcn_mfma_f32_32x32x16_bf16(va, kb, acc[eb], 0, 0, 0);
    }
  }
  const int chain = (b * 4 + h) * 2 + dir, pos = gla_pos(c, dir);
  float* gu = (float*)(ws + WS_GU) + ((size_t)chain * 68 + pos) * GU_STRIDE;
#pragma unroll
  for (int eb = 0; eb < 2; ++eb)
#pragma unroll
    for (int r = 0; r < 16; ++r) gu[(32 * eb + crow(r, hi)) * 32 + r32] = acc[eb][r];
  if (half == 0) gu[2048 + d] = __expf(T);
}
__device__ __forceinline__ void gla_scan(const Frame& F0, const Args& a) {
  const Frame F = relaunder(F0);
  unsigned char* ws = opq(a.ws);
  if (F.tid >= 256) return;
  for (int gt = F.vcu * 256 + F.tid; gt < 32 * 2048; gt += F.G * 256) {
    const int chain = gt >> 11, el = gt & 2047, d = el & 31;
    const float* gu = (const float*)(ws + WS_GU) + (size_t)chain * 68 * GU_STRIDE;
    bf16* gs = (bf16*)(ws + WS_GS) + (size_t)chain * 68 * 2048 + el;
    float S = 0.f;
#pragma unroll 1
    for (int p0 = 0; p0 < 68; p0 += 34) {
      float dc[34], uu[34];
#pragma unroll
      for (int i = 0; i < 34; ++i) { dc[i] = gu[(size_t)(p0 + i) * GU_STRIDE + 2048 + d]; uu[i] = gu[(size_t)(p0 + i) * GU_STRIDE + el]; }
      __builtin_amdgcn_sched_barrier(0);
#pragma unroll
      for (int i = 0; i < 34; ++i) { gs[(size_t)(p0 + i) * 2048] = (bf16)f2bf(S); S = dc[i] * S + uu[i]; }
    }
  }
}
constexpr int QK_STRIDE = 80;
__device__ __forceinline__ void gla_out_item(const Frame& F0, const Args& a, int layer, int item) {
  const Frame F = relaunder(F0);
  unsigned char* ws = opq(a.ws);
  const bf16* PLB = (const bf16*)(ws + WS_PLB); const float* LA = (const float*)(ws + WS_LA); bf16* Y = (bf16*)(ws + WS_H);
  const int b = item / 68, c = item % 68, h = F.wave >> 1, dir = F.wave & 1, d = F.lane & 31, half = F.lane >> 5, r32 = d, hi = half;
  LAS unsigned char* Vt = F.lds + h * 8192;
  LAS unsigned char* QT = F.lds + 32768 + F.wave * (2 * 64 * QK_STRIDE); LAS unsigned char* KT = QT + 64 * QK_STRIDE;
  LAS float* X = (LAS float*)(F.lds + 32768) + h * 4096;
  __syncthreads();
  gla_stage_v(F, PLB, b, c, F.lds);
  {
    float cw[32], T;
    gla_cum(LA, b, c, h, dir, F.lane, cw, T);
    bf16 qr[32], kr[32];
    const bf16* pr = PLB + gla_row(b, c, 32 * half) * PLW + S_AQK * 256 + h * 32 + d;
#pragma unroll
    for (int ii = 0; ii < 32; ++ii) { qr[ii] = pr[(size_t)ii * PLW]; kr[ii] = pr[(size_t)ii * PLW + 128]; }
#pragma unroll
    for (int ii = 0; ii < 32; ++ii) { const int i = 32 * half + ii;
      const float ec = __expf(cw[ii]);
      *(LAS unsigned short*)(QT + i * QK_STRIDE + d * 2) = (unsigned short)f2bf(bf2f(qr[ii]) * ec);
      *(LAS unsigned short*)(KT + i * QK_STRIDE + d * 2) = (unsigned short)f2bf(bf2f(kr[ii]) * __builtin_amdgcn_rcpf(ec)); }
  }
  __syncthreads();
  f32x16 oacc[2][2];
#pragma unroll
  for (int eb = 0; eb < 2; ++eb)
#pragma unroll
    for (int ib = 0; ib < 2; ++ib)
#pragma unroll
      for (int i = 0; i < 16; ++i) oacc[eb][ib][i] = 0.f;
  bf16x8 qb[2][2];
#pragma unroll
  for (int ib = 0; ib < 2; ++ib)
#pragma unroll
    for (int st = 0; st < 2; ++st) qb[ib][st] = *(LAS const bf16x8*)(QT + (32 * ib + r32) * QK_STRIDE + (16 * st + 8 * hi) * 2);
  const int chain = (b * 4 + h) * 2 + dir, pos = gla_pos(c, dir);
  {
    const bf16* gs = (const bf16*)(ws + WS_GS) + ((size_t)chain * 68 + pos) * 2048;
#pragma unroll
    for (int eb = 0; eb < 2; ++eb)
#pragma unroll
      for (int st = 0; st < 2; ++st) { const bf16x8 sf = *(const bf16x8*)(gs + (32 * eb + r32) * 32 + 16 * st + 8 * hi);
#pragma unroll
        for (int ib = 0; ib < 2; ++ib) oacc[eb][ib] = __builtin_amdgcn_mfma_f32_32x32x16_bf16(sf, qb[ib][st], oacc[eb][ib], 0, 0, 0); }
  }
  const int q = (F.lane & 15) >> 2, p = F.lane & 3, gsel = (F.lane >> 4) & 1;
  const int vrow = (4 * hi + q) * 128 + 8 * (p & 1), chb = 2 * gsel + (p >> 1);
#pragma unroll
  for (int sb = 0; sb < 2; ++sb) {
    bf16x8 kf[2];
#pragma unroll
    for (int st = 0; st < 2; ++st) kf[st] = *(LAS const bf16x8*)(KT + (32 * sb + r32) * QK_STRIDE + (16 * st + 8 * hi) * 2);
#pragma unroll
    for (int ib = 0; ib < 2; ++ib) {
      const bool need = dir == 0 ? (sb <= ib) : (sb >= ib);
      if (!need) continue;
      f32x16 sc;
#pragma unroll
      for (int i = 0; i < 16; ++i) sc[i] = 0.f;
#pragma unroll
      for (int st = 0; st < 2; ++st) sc = __builtin_amdgcn_mfma_f32_32x32x16_bf16(kf[st], qb[ib][st], sc, 0, 0, 0);
      if (sb == ib) {
#pragma unroll
        for (int r = 0; r < 16; ++r) { const int s = crow(r, hi); const bool keep = dir == 0 ? (s <= r32) : (s >= r32); sc[r] = keep ? sc[r] : 0.f; }
      }
      u32x4 pw[2];
#pragma unroll
      for (int k = 0; k < 2; ++k) pw[k] = (u32x4){pk2(sc[8 * k + 0], sc[8 * k + 1]), pk2(sc[8 * k + 2], sc[8 * k + 3]), pk2(sc[8 * k + 4], sc[8 * k + 5]), pk2(sc[8 * k + 6], sc[8 * k + 7])};
#pragma unroll
      for (int ks = 0; ks < 2; ++ks)
#pragma unroll
        for (int eb = 0; eb < 2; ++eb) {
          const int ch = ((chb | ((eb ^ (q >> 1)) << 2)) << 4);
          const s16x4 lo = vtr(Vt + (2 * sb + ks) * 2048 + vrow + ch), hh = vtr(Vt + (2 * sb + ks) * 2048 + 1024 + vrow + ch);
          const bf16x8 va = (bf16x8){lo[0], lo[1], lo[2], lo[3], hh[0], hh[1], hh[2], hh[3]};
          oacc[eb][ib] = __builtin_amdgcn_mfma_f32_32x32x16_bf16(va, __builtin_bit_cast(bf16x8, pw[ks]), oacc[eb][ib], 0, 0, 0);
        }
    }
  }
  __syncthreads();
  if (dir == 1) {
#pragma unroll
    for (int eb = 0; eb < 2; ++eb)
#pragma unroll
      for (int ib = 0; ib < 2; ++ib)
#pragma unroll
        for (int r = 0; r < 16; ++r) X[((eb * 2 + ib) * 16 + r) * 64 + F.lane] = oacc[eb][ib][r];
  }
  __syncthreads();
  if (dir == 0) {
    const float* on = opq(a.in[11]) + layer * 64;
    f32x4 w4s[8];
#pragma unroll
    for (int i = 0; i < 8; ++i) w4s[i] = *(const f32x4*)(on + 32 * (i >> 2) + 8 * (i & 3) + 4 * hi);
#pragma unroll
    for (int ib = 0; ib < 2; ++ib) {
      float ss = 0.f;
#pragma unroll
      for (int eb = 0; eb < 2; ++eb)
#pragma unroll
        for (int r = 0; r < 16; ++r) { oacc[eb][ib][r] += X[((eb * 2 + ib) * 16 + r) * 64 + F.lane]; ss += oacc[eb][ib][r] * oacc[eb][ib][r]; }
      ss += __shfl_xor(ss, 32);
      const float rs = 1.0f / sqrtf(ss * (1.f / 64.f) + 1e-6f);
      const size_t row = gla_row(b, c, 32 * ib + r32);
      u32x2 gv8[8];
#pragma unroll
      for (int i = 0; i < 8; ++i) gv8[i] = *(const u32x2*)(PLB + row * PLW + S_AG * 256 + h * 64 + 32 * (i >> 2) + 8 * (i & 3) + 4 * hi);
      __builtin_amdgcn_sched_barrier(0);
#pragma unroll
      for (int eb = 0; eb < 2; ++eb)
#pragma unroll
        for (int gi = 0; gi < 4; ++gi) {
          const int e0 = 32 * eb + 8 * gi + 4 * hi;
          const f32x4 w4 = w4s[4 * eb + gi];
          const u32x2 gv = gv8[4 * eb + gi];
          const float g0 = __uint_as_float(gv.x << 16), g1 = __uint_as_float(gv.x & 0xffff0000u), g2 = __uint_as_float(gv.y << 16), g3 = __uint_as_float(gv.y & 0xffff0000u);
          u32x2 ov; ov.x = pk2(oacc[eb][ib][4 * gi + 0] * rs * w4[0] * g0, oacc[eb][ib][4 * gi + 1] * rs * w4[1] * g1);
          ov.y = pk2(oacc[eb][ib][4 * gi + 2] * rs * w4[2] * g2, oacc[eb][ib][4 * gi + 3] * rs * w4[3] * g3);
          *(u32x2*)(Y + row * 1024 + h * 64 + e0) = ov;
        }
    }
  }
}
}

namespace mk {
__device__ __forceinline__ void p3_mixers(const Frame& F0, const Args& a, int layer) {
  const Frame F = relaunder(F0);
  const int nx = layer == 0 ? 16 : 0, nswa = 256 + nx, nna = 256 + nx, nfc = layer == 0 ? 32 : 0;
  for (int it = F.vcu; it < 272 + 256 + nfc + nswa + nna; it += F.G) {
    int r = it;
    if (r < 272) { gla_local_item(F, a, r); continue; } r -= 272;
    if (r < 256) { fft_item(F, a, r); continue; } r -= 256;
    if (r < nfc) { fftc_item(F, a, r); continue; } r -= nfc;
    if (r < nswa) swa_item(F, a, layer, r); else na_item(F, a, layer, r - nswa);
  }
}
__device__ __forceinline__ void p4b_glaout(const Frame& F0, const Args& a, int layer) {
  const Frame F = relaunder(F0);
  for (int it = F.vcu; it < 272; it += F.G) { if (layer == 1 && (it % 68) >= 64) continue; gla_out_item(F, a, layer, it); }
}
}
#define XB_TMO      128
#define XB_XCNT(j)  (256  + 64 * (j))
#define XB_XSUB(j)  (1280 + 64 * (j))
#define XB_XGEN(j)  (2304 + 64 * (j))
#define XB_TOP      3328
#define XB_TOPGEN   3392
#define XCD_BAR_WORDS 3456
#define XB_SPIN_CAP (1u << 18)

__device__ __forceinline__ unsigned xb_ld(unsigned* p)              { return __hip_atomic_load(p, __ATOMIC_RELAXED, __HIP_MEMORY_SCOPE_AGENT); }
__device__ __forceinline__ unsigned xb_add(unsigned* p, unsigned v) { return __hip_atomic_fetch_add(p, v, __ATOMIC_RELAXED, __HIP_MEMORY_SCOPE_AGENT); }
__device__ __forceinline__ unsigned xb_xcc_id() { return (unsigned)__builtin_amdgcn_s_getreg((3 << 11) | 20) & 0xFu; }
#define XB_SPIN(cond, bar) do { unsigned _sp = 0; while (cond) { __builtin_amdgcn_s_sleep(1); \
    if ((++_sp & 255u) == 0u) { if (xb_ld(&(bar)[XB_TMO])) break; if (_sp > XB_SPIN_CAP) { atomicAdd(&(bar)[XB_TMO], 1u); break; } } } } while (0)

struct XcdBarrier {
    unsigned* bar; unsigned x;
    volatile LAS unsigned* st;
};

__device__ __forceinline__ XcdBarrier xcd_barrier_post(unsigned* bar, volatile LAS unsigned* st) {
    XcdBarrier b; b.bar = bar; b.x = xb_xcc_id(); b.st = st;
    if (threadIdx.x == 0) (void)xb_add(&bar[XB_XCNT(b.x)], 1u);
    return b;
}
__device__ __forceinline__ void xcd_barrier_complete(unsigned* bar, unsigned x, unsigned& nloc, unsigned& nx) {
    const unsigned G = gridDim.x * gridDim.y * gridDim.z;
    unsigned sum, cnt, mine, sp = 0u;
    for (;;) {
        sum = 0u; cnt = 0u; mine = 0u;
#pragma unroll
        for (unsigned j = 0; j < 16; ++j) { const unsigned c = xb_ld(&bar[XB_XCNT(j)]); sum += c; cnt += (c > 0u) ? 1u : 0u; }
        mine = xb_ld(&bar[XB_XCNT(x)]);
        if (sum == G) break;
        __builtin_amdgcn_s_sleep(1);
        if ((++sp & 255u) == 0u) { if (xb_ld(&bar[XB_TMO])) break; if (sp > XB_SPIN_CAP) { atomicAdd(&bar[XB_TMO], 1u); break; } }
    }
    nloc = mine > 0u ? mine : 1u; nx = cnt > 0u ? cnt : 1u;
}

__device__ __forceinline__ void xcd_barrier(const XcdBarrier& b) {
    asm volatile("s_waitcnt vmcnt(0)" ::: "memory");
    __syncthreads();
    if (threadIdx.x == 0) {
        unsigned* bar = b.bar;
        __builtin_amdgcn_s_waitcnt(0);
        unsigned nloc = b.st[0], nx = b.st[1];
        if (nloc == 0u) { xcd_barrier_complete(bar, b.x, nloc, nx); b.st[0] = nloc; b.st[1] = nx; }
        const unsigned old = xb_add(&bar[XB_XSUB(b.x)], 1u);
        const unsigned gen = old / nloc;
        if (old + 1u == (gen + 1u) * nloc) {
            __builtin_amdgcn_fence(__ATOMIC_RELEASE, "agent");
            asm volatile("s_waitcnt vmcnt(0)" ::: "memory");
            const unsigned og = xb_add(&bar[XB_TOP], 1u);
            const unsigned tg = og / nx;
            if (og + 1u == (tg + 1u) * nx) xb_add(&bar[XB_TOPGEN], 1u);
            else XB_SPIN(xb_ld(&bar[XB_TOPGEN]) == tg, bar);
            __builtin_amdgcn_fence(__ATOMIC_ACQUIRE, "agent");
            xb_add(&bar[XB_XGEN(b.x)], 1u);
            asm volatile("s_waitcnt vmcnt(0)" ::: "memory");
        } else {
            XB_SPIN(xb_ld(&bar[XB_XGEN(b.x)]) == gen, bar);
            __builtin_amdgcn_fence(__ATOMIC_ACQUIRE, "agent");
            asm volatile("s_waitcnt vmcnt(0)" ::: "memory");
        }
    }
    __syncthreads();
}

constexpr int LDS_BYTES = 163840, MISC_OFF = LDS_BYTES - 256;
constexpr int CW_BAR = 4096;
__global__ void __launch_bounds__(512, 2) mega(mk::Args a) {
  extern __shared__ __attribute__((aligned(16))) unsigned char lds[];
  mk::Frame F;
  F.lds = (LAS unsigned char*)lds;
  F.tid = threadIdx.x; F.lane = F.tid & 63; F.wave = __builtin_amdgcn_readfirstlane(F.tid >> 6);
  F.G = gridDim.x; { const int bx = blockIdx.x; F.vcu = (F.G % 8 == 0) ? (bx % 8) * (F.G / 8) + bx / 8 : bx; }
  volatile LAS unsigned* MISC = (volatile LAS unsigned*)(F.lds + MISC_OFF);
  if (F.tid < 64) MISC[F.tid] = 0u;
  __syncthreads();
  XcdBarrier bar; bar.bar = nullptr; bar.x = 0; bar.st = nullptr;
  const bool multi = (a.ph_hi - a.ph_lo) > 1;
  if (multi) bar = xcd_barrier_post((unsigned*)(a.ws + mk::WS_CTL) + CW_BAR, MISC + 8);
#pragma clang loop unroll(disable)
  for (int ph = a.ph_lo; ph < a.ph_hi; ++ph) {
    if (ph == 0) mk::p0_prologue(F, a);
    else {
      const int layer = (ph - 1) / 6, sub = (ph - 1) % 6;
      if (sub == 0) mk::p1_prenorm(F, a, layer);
      else if (sub == 1) mk::p2_inproj(F, a, layer);
      else if (sub == 2) mk::p3_mixers(F, a, layer);
      else if (sub == 3) mk::gla_scan(F, a);
      else if (sub == 4) mk::p4b_glaout(F, a, layer);
      else mk::p5_outproj(F, a, layer);
    }
    if (ph + 1 < a.ph_hi) xcd_barrier(bar);
  }
}

extern "C" void kernel_launch(void* const* d_in, const int* in_sizes, int n_in, void* d_out, int out_size, void* d_ws, size_t ws_size, hipStream_t stream) {
  using namespace mk;
  static int grid = 0;
  if (grid == 0) {
    int dev = 0, cus = 0, per_cu = 0; (void)hipGetDevice(&dev); (void)hipDeviceGetAttribute(&cus, hipDeviceAttributeMultiprocessorCount, dev);
    (void)hipFuncSetAttribute((const void*)mega, hipFuncAttributeMaxDynamicSharedMemorySize, LDS_BYTES);
    if (hipOccupancyMaxActiveBlocksPerMultiprocessor(&per_cu, (const void*)mega, 512, LDS_BYTES) != hipSuccess || per_cu < 1) per_cu = 1;
    (void)hipGetLastError();
    grid = (cus > 0 ? cus : 256) * (per_cu < 1 ? 1 : 1);
  }
  (void)hipMemsetAsync((char*)d_ws + WS_CTL, 0, CTL_BYTES, stream);
  Args a{};
  for (int i = 0; i < 19; ++i) a.in[i] = (const float*)d_in[i];
  a.out = (float*)d_out; a.ws = (unsigned char*)d_ws;
  a.ph_lo = 0; a.ph_hi = 13;
  void* args[] = {&a};
  if (hipLaunchCooperativeKernel((const void*)mega, dim3(grid), dim3(512), args, LDS_BYTES, stream) != hipSuccess) {
    (void)hipGetLastError();
    hipLaunchKernelGGL(mega, dim3(grid), dim3(512), LDS_BYTES, stream, a);
  }
}
```

```cpp
#include <hip/hip_runtime.h>
#include <math.h>
#include <stdint.h>

namespace pg8 {
#define PG8_LAS __attribute__((address_space(3)))
typedef unsigned short bf16_t;
typedef short bf16x8 __attribute__((ext_vector_type(8)));
typedef float f32x4 __attribute__((ext_vector_type(4)));
typedef unsigned u32x4 __attribute__((ext_vector_type(4)));
constexpr int BM = 256, BK = 64, HALF = 128, HTB = HALF * BK * 2  , STAGE_BYTES = 8 * HTB, NXCD = 8, WGM = 8;

__host__ __device__ __forceinline__ int lds_byte(int r, int c) { const int st = (r >> 4) * 2 + (c >> 5), rr = r & 15, cc = c & 31, ob = rr * 64 + cc * 2; return st * 1024 + (ob ^ (((ob >> 9) & 1) << 5)); }
__host__ __device__ __forceinline__ void stage_rc(int b, int& R, int& C) { const int st = b / 1024, sb = b % 1024, swz = sb ^ (((sb >> 9) & 1) << 5); R = (st >> 1) * 16 + swz / 64; C = (st & 1) * 32 + (swz % 64) / 2; }
__host__ __device__ __forceinline__ int perm32(int rho) { const int n = rho >> 4, i = rho & 15; return 8 * (i >> 2) + 4 * n + (i & 3); }

struct Unit { int pm, pn; };
struct Gemm { const bf16_t* A; const bf16_t* Bt; int M, N, K; };

struct StaticOrder {
    int nM, nN, nwg, G, c;
    __host__ __device__ void init(int M, int N, int G_, int c_) { nM = M / BM; nN = N / BM; nwg = nM * nN; G = G_; c = c_; }
    __host__ __device__ bool next(int i, Unit& u) const {
        const long L = (long)i * G + c; if (L >= nwg) return false;
        int wgid = (int)L; { const int q = nwg / NXCD, r = nwg % NXCD, xcd = wgid % NXCD, off = wgid / NXCD; wgid = (xcd < r ? xcd * (q + 1) : r * (q + 1) + (xcd - r) * q) + off; }
        const int nig = WGM * nN, gid = wgid / nig, fm = gid * WGM, gsz = (nM - fm) < WGM ? (nM - fm) : WGM;
        u.pm = fm + ((wgid % nig) % gsz); u.pn = (wgid % nig) / gsz; return true;
    }
    __device__ __forceinline__ void a_ready(const Unit&) const {}
    __device__ __forceinline__ void done(const Unit&) const {}
};

template <class Epi, class Sched, bool STAMP = false>
__device__ __forceinline__ void gemm_phase(PG8_LAS unsigned char* lds, const Gemm g, const Sched& S, const Epi& E, unsigned long long* stamps) {
    int tid_ = threadIdx.x; asm volatile("" : "+v"(tid_));
    const int tid = tid_, wid = __builtin_amdgcn_readfirstlane(tid >> 6), lane = tid & 63, wr = wid >> 2, wc = wid & 3, fr = lane & 15, fq = lane >> 4;
    const int K = g.K, nt = K / BK;
    int ts_lo = 0, ts_hi = 0, nts = 0; const unsigned long long rt_entry = STAMP ? (unsigned long long)wall_clock64() : 0ull;
#define PG8_STAMP() do { if (STAMP && wid == 0 && nts < 64) { const unsigned long long _c = (unsigned long long)clock64(); \
        ts_lo = (lane == nts) ? (int)(unsigned)_c : ts_lo; ts_hi = (lane == nts) ? (int)(unsigned)(_c >> 32) : ts_hi; ++nts; } } while (0)
    PG8_STAMP();
    unsigned voffA[2], voffB[2];
#pragma unroll
    for (int i = 0; i < 2; ++i) { int R, C; stage_rc(tid * 16 + i * 8192, R, C); const int Rb = Epi::PERM ? ((R & ~31) + perm32(R & 31)) : R;
        voffA[i] = (unsigned)(R * K + C) * 2u; voffB[i] = (unsigned)(Rb * K + C) * 2u; }
    const size_t kstep = (size_t)(BK * 2);
    const size_t hstep = (size_t)HALF * K * 2;
    const size_t tstep = 2 * hstep;
    const unsigned ldsw = (unsigned)wid * 1024u;
    const int aoff = lds_byte(wr * 64 + fr, fq * 8), boff = lds_byte(wc * 32 + fr, fq * 8);
#define PG8_SA(b, h) (((b) * 2 + (h)) * HTB)
#define PG8_SB(b, h) ((4 + (b) * 2 + (h)) * HTB)
#define PG8_STAGE(bufoff, gbase, voff) do { _Pragma("unroll") for (int _i = 0; _i < 2; ++_i) \
        __builtin_amdgcn_global_load_lds((const unsigned*)((const char*)(gbase) + (voff)[_i]), (PG8_LAS unsigned*)(lds + (bufoff) + ldsw + _i * 8192), 16, 0, 0); } while (0)
#define PG8_LDA(dst, b, h) do { _Pragma("unroll") for (int m = 0; m < 4; ++m) _Pragma("unroll") for (int k = 0; k < 2; ++k) dst[m][k] = *(const PG8_LAS bf16x8*)(lds + PG8_SA(b, h) + aoff + m * 2048 + k * 1024); } while (0)
#define PG8_LDB(dst, b, h) do { _Pragma("unroll") for (int n = 0; n < 2; ++n) _Pragma("unroll") for (int k = 0; k < 2; ++k) dst[n][k] = *(const PG8_LAS bf16x8*)(lds + PG8_SB(b, h) + boff + n * 2048 + k * 1024); } while (0)
#define PG8_MMA(ai, bj, At, Bt) do { __builtin_amdgcn_s_setprio(1); _Pragma("unroll") for (int m = 0; m < 4; ++m) _Pragma("unroll") for (int n = 0; n < 2; ++n) _Pragma("unroll") for (int k = 0; k < 2; ++k) \
        acc[ai][bj][m][n] = __builtin_amdgcn_mfma_f32_16x16x32_bf16(Bt[n][k], At[m][k], acc[ai][bj][m][n], 0, 0, 0); __builtin_amdgcn_s_setprio(0); } while (0)
#define PG8_WAIT_V(n) asm volatile("s_waitcnt vmcnt(" #n ")" ::: "memory")
#define PG8_WAIT_L(n) asm volatile("s_waitcnt lgkmcnt(" #n ")" ::: "memory")
#define PG8_BAR __builtin_amdgcn_s_barrier()
#define PG8_SCHED __builtin_amdgcn_sched_barrier(0)
    Unit cur, nxt; int ui = 0;
    if (!S.next(0, cur)) return;
    f32x4 acc[2][2][4][2];
#pragma unroll
    for (int a = 0; a < 2; ++a)
#pragma unroll
        for (int b = 0; b < 2; ++b)
#pragma unroll
            for (int m = 0; m < 4; ++m)
#pragma unroll
                for (int n = 0; n < 2; ++n) acc[a][b][m][n] = (f32x4){0.f, 0.f, 0.f, 0.f};
    bf16x8 At[4][2], B0[2][2], B1[2][2];
    const char* cA = (const char*)g.A + (size_t)cur.pm * tstep; const char* cB = (const char*)g.Bt + (size_t)cur.pn * tstep;
    S.a_ready(cur);
    PG8_STAGE(PG8_SB(0, 0), cB, voffB); PG8_STAGE(PG8_SA(0, 0), cA, voffA); PG8_STAGE(PG8_SB(0, 1), cB + hstep, voffB); PG8_STAGE(PG8_SA(0, 1), cA + hstep, voffA);
    if (wr == 1) PG8_BAR;
    PG8_WAIT_V(4); PG8_BAR;
    PG8_STAGE(PG8_SB(1, 0), cB + kstep, voffB); PG8_STAGE(PG8_SA(1, 0), cA + kstep, voffA); PG8_STAGE(PG8_SB(1, 1), cB + hstep + kstep, voffB);
    PG8_WAIT_V(6); PG8_BAR;
    PG8_STAMP();
    for (;;) {
        const bool has_next = S.next(ui + 1, nxt);
        const char* nA = has_next ? (const char*)g.A + (size_t)nxt.pm * tstep : cA; const char* nB = has_next ? (const char*)g.Bt + (size_t)nxt.pn * tstep : cB;
        for (int t = 0; t < nt; t += 2) {
            const bool last = (t == nt - 2);
            const char* a1 = cA + (size_t)(t + 1) * kstep;
            const char* a2 = last ? nA : cA + (size_t)(t + 2) * kstep; const char* b2 = last ? nB : cB + (size_t)(t + 2) * kstep;
            const char* a3 = a2 + kstep; const char* b3 = b2 + kstep;
            if (last && has_next) S.a_ready(nxt);
            PG8_LDB(B0, 0, 0); PG8_SCHED; PG8_LDA(At, 0, 0); PG8_STAGE(PG8_SA(1, 1), a1 + hstep, voffA);
            PG8_WAIT_L(8); PG8_BAR; PG8_WAIT_L(0); PG8_MMA(0, 0, At, B0); PG8_BAR; PG8_SCHED;
            PG8_LDB(B1, 0, 1); PG8_STAGE(PG8_SB(0, 0), b2, voffB);
            PG8_BAR; PG8_WAIT_L(0); PG8_MMA(0, 1, At, B1); PG8_BAR;
            PG8_LDA(At, 0, 1); PG8_STAGE(PG8_SA(0, 0), a2, voffA);
            PG8_BAR; PG8_WAIT_L(0); PG8_MMA(1, 0, At, B0); PG8_BAR; PG8_SCHED;
            PG8_STAGE(PG8_SB(0, 1), b2 + hstep, voffB);
            PG8_WAIT_V(6); PG8_BAR; PG8_MMA(1, 1, At, B1); PG8_BAR;
            PG8_LDB(B0, 1, 0); PG8_SCHED; PG8_LDA(At, 1, 0); PG8_STAGE(PG8_SA(0, 1), a2 + hstep, voffA);
            PG8_WAIT_L(8); PG8_BAR; PG8_WAIT_L(0); PG8_MMA(0, 0, At, B0); PG8_BAR; PG8_SCHED;
            PG8_LDB(B1, 1, 1); PG8_STAGE(PG8_SB(1, 0), b3, voffB);
            PG8_BAR; PG8_WAIT_L(0); PG8_MMA(0, 1, At, B1); PG8_BAR;
            PG8_LDA(At, 1, 1); PG8_STAGE(PG8_SA(1, 0), a3, voffA);
            PG8_BAR; PG8_WAIT_L(0); PG8_MMA(1, 0, At, B0); PG8_BAR; PG8_SCHED;
            PG8_STAGE(PG8_SB(1, 1), b3 + hstep, voffB);
            PG8_WAIT_V(6); PG8_BAR; PG8_MMA(1, 1, At, B1); PG8_BAR;
        }
        PG8_STAMP();
        if constexpr (!Epi::AFTER_DRAIN) { E(acc, cur, wr, wc, fr, fq); S.done(cur); }
        PG8_STAMP();
        if (!has_next) break;
#pragma unroll
        for (int a = 0; a < 2; ++a)
#pragma unroll
            for (int b = 0; b < 2; ++b)
#pragma unroll
                for (int m = 0; m < 4; ++m)
#pragma unroll
                    for (int n = 0; n < 2; ++n) acc[a][b][m][n] = (f32x4){0.f, 0.f, 0.f, 0.f};
        cur = nxt; cA = nA; cB = nB; ++ui;
    }
    PG8_WAIT_V(0);
    if (wr == 0) PG8_BAR;
    PG8_BAR;
    if constexpr (Epi::AFTER_DRAIN) { E.fused(acc, cur, wr, wc, fr, fq, lds, wid, lane); S.done(cur); }
    PG8_STAMP();
    if (STAMP && wid == 0) { stamps[lane] = lane < nts ? (((unsigned long long)(unsigned)ts_hi << 32) | (unsigned)ts_lo) : 0ull;
        if (lane == 62) stamps[62] = rt_entry; if (lane == 63) stamps[63] = (unsigned long long)wall_clock64(); }
#undef PG8_STAMP
#undef PG8_SA
#undef PG8_SB
#undef PG8_STAGE
#undef PG8_LDA
#undef PG8_LDB
#undef PG8_MMA
#undef PG8_WAIT_V
#undef PG8_WAIT_L
#undef PG8_BAR
#undef PG8_SCHED
}
}

namespace mk {
#define LAS __attribute__((address_space(3)))
typedef unsigned short bf16;
typedef float f32x4 __attribute__((ext_vector_type(4)));
typedef float f32x16 __attribute__((ext_vector_type(16)));
typedef unsigned u32x4 __attribute__((ext_vector_type(4)));
typedef unsigned u32x2 __attribute__((ext_vector_type(2)));
typedef short bf16x8 __attribute__((ext_vector_type(8)));
typedef short s16x4 __attribute__((ext_vector_type(4)));

constexpr int D = 1024, NB = 4, SEQ = 4096, CTX = 256, PWW = 3360;
constexpr int MLAT = NB * SEQ, MT = MLAT + NB * CTX;
constexpr int NT1 = 14, N1 = NT1 * 256;
constexpr int NSLOT = 11, PLW = NSLOT * 256;
constexpr int TROW = SEQ + CTX;
constexpr int O_AQ = 0, O_AK = 128, O_AV = 256, O_AG = 512, O_LR = 768, O_BV = 800, O_BG = 1056, O_CQ = 1312, O_CK = 1568, O_CV = 1696,
              O_CG = 1824, O_DQ = 2080, O_DK = 2336, O_DV = 2592, O_DG = 2848;
constexpr int S_AQK = 0, S_AV = 1, S_AG = 2, S_BG = 3, S_CQ = 4, S_CKV = 5, S_CG = 6, S_DQ = 7, S_DK = 8, S_DV = 9, S_DG = 10;
constexpr float LOG2E = 1.4426950408889634f, QSCALE = 0.125f * LOG2E, GLA_QS = 0.17677669529663687f;

constexpr size_t WS_CTL = 0, CTL_BYTES = 65536;
constexpr size_t WS_MOD = WS_CTL + CTL_BYTES;
constexpr size_t WS_ROPE = WS_MOD + 2 * 5 * 3072 * 4;
constexpr size_t WS_WC = WS_ROPE + 2 * 64 * 16 * 4;
constexpr size_t WS_CS256 = WS_WC + 128 * 128 * 2;
constexpr size_t WS_W1T = 1u << 20;
constexpr size_t WS_W2T = WS_W1T + (size_t)2 * N1 * D * 2;
constexpr size_t WS_H = WS_W2T + (size_t)2 * D * D * 2;
constexpr size_t WS_PLB = WS_H + (size_t)MT * D * 2;
constexpr size_t WS_LA = WS_PLB + (size_t)MT * PLW * 2;
constexpr size_t WS_FA2 = WS_LA + (size_t)MT * 256 * 4;
constexpr size_t WS_CTX1 = WS_FA2 + (size_t)NB * 64 * TROW * 8 * 2;
constexpr size_t WS_SCR = WS_CTX1 + (size_t)NB * CTX * D * 4;
static_assert(WS_CS256 + 256 * 512 * 2 <= WS_W1T, "tables");

__device__ __forceinline__ float bf2f(bf16 v) { return __uint_as_float(((unsigned)v) << 16); }
__device__ __forceinline__ unsigned f2bf(float f) { unsigned u = __float_as_uint(f); return (u + 0x7fffu + ((u >> 16) & 1u)) >> 16; }
typedef float f32x2_t __attribute__((ext_vector_type(2))); typedef __bf16 bf16x2_t __attribute__((ext_vector_type(2)));
__device__ __forceinline__ unsigned pk2(float lo, float hi) { const f32x2_t v = {lo, hi}; const bf16x2_t b = __builtin_convertvector(v, bf16x2_t); return __builtin_bit_cast(unsigned, b); }
__device__ __forceinline__ float wave_sum(float v) {
#pragma unroll
  for (int o = 1; o < 64; o <<= 1) v += __shfl_xor(v, o);
  return v;
}
__device__ __forceinline__ float fsilu(float x) { return x * __builtin_amdgcn_rcpf(1.f + __expf(-x)); }
__device__ __forceinline__ float flogsig(float x) { return fminf(x, 0.f) - __logf(1.f + __expf(-fabsf(x))); }

#define GAS __attribute__((address_space(1)))
template <class T> __device__ __forceinline__ T* opq(T* p) { GAS T* g = (GAS T*)p; asm volatile("" : "+s"(g)); return (T*)g; }
__device__ __forceinline__ int crow(int r, int hi) { return (r & 3) + 8 * (r >> 2) + 4 * hi; }
struct Args {
  const float* in[19]; float* out; unsigned char* ws; int ph_lo, ph_hi;
};
struct Frame {
  int tid, lane, wave, vcu, G;
  LAS unsigned char* lds;
};
__device__ __forceinline__ Frame relaunder(const Frame& F0) {
  Frame F = F0; F.tid = threadIdx.x; asm volatile("" : "+v"(F.tid)); F.lane = F.tid & 63; asm volatile("" : "+s"(F.wave), "+s"(F.vcu), "+s"(F.G)); return F; }
}

namespace mk {
__device__ __forceinline__ void p0_ada_item(const Frame& F, const Args& a, int item) {
  LAS float* s = (LAS float*)F.lds; LAS float* red = s + 5 * 1024;
  const float* c = opq(a.in[1]); const float* cc = opq(a.in[3]);
  for (int i = F.tid; i < 5 * 1024; i += 512) { const int r = i >> 10, k = i & 1023; const float v = r < 4 ? c[r * 1024 + k] : cc[k]; s[i] = v / (1.f + expf(-v)); }
  __syncthreads();
  const int kp = F.tid / 24, cl = F.tid % 24;
  const int gcol = item * 24 + cl, l = gcol / 3072, col = gcol % 3072;
  if (kp < 21) {
    const float* w = opq(a.in[5]) + (size_t)l * 1024 * 3072 + col;
    float acc[5] = {0.f, 0.f, 0.f, 0.f, 0.f};
#pragma unroll 1
    for (int kb = 0; kb < 2; ++kb) {
      float wv[25];
#pragma unroll
      for (int j = 0; j < 25; ++j) { const int k = kp + 21 * (25 * kb + j); wv[j] = w[(size_t)(k < 1024 ? k : 1023) * 3072]; }
      __builtin_amdgcn_sched_barrier(0);
#pragma unroll
      for (int j = 0; j < 25; ++j) { const int k = kp + 21 * (25 * kb + j); const int kc = k < 1024 ? k : 1023; const float wz = k < 1024 ? wv[j] : 0.f;
#pragma unroll
        for (int r = 0; r < 5; ++r) acc[r] += s[r * 1024 + kc] * wz; }
    }
#pragma unroll
    for (int r = 0; r < 5; ++r) red[(kp * 24 + cl) * 5 + r] = acc[r];
  }
  __syncthreads();
  if (F.tid < 120) {
    const int cl2 = F.tid / 5, r = F.tid % 5; float t = 0.f;
    for (int q = 0; q < 21; ++q) t += red[(q * 24 + cl2) * 5 + r];
    const int g2 = item * 24 + cl2, l2 = g2 / 3072, col2 = g2 % 3072;
    float* MOD = (float*)(opq(a.ws) + WS_MOD);
    MOD[((size_t)l2 * 5 + r) * 3072 + col2] = t + opq(a.in[6])[l2 * 3072 + col2];
  }
  __syncthreads();
}
__device__ __forceinline__ int rope_perm(int n) { return 16 * ((n >> 2) & 1) + 4 * (n >> 3) + (n & 3); }
__device__ __forceinline__ void p0_tr_item(const float* W, int ldw, int cbase, int permkind, float scale, bf16* dst, int k0, LAS float* scr, int lane) {
  { float t_[32];
#pragma unroll
    for (int i = 0; i < 32; ++i) t_[i] = W[(size_t)(k0 + 2 * i + (lane >> 5)) * ldw + cbase + (lane & 31)];
#pragma unroll
    for (int i = 0; i < 32; ++i) scr[(2 * i + (lane >> 5)) * 33 + (lane & 31)] = t_[i]; }
  asm volatile("s_waitcnt lgkmcnt(0)" ::: "memory");
  const int c = lane & 7;
#pragma unroll
  for (int j = 0; j < 4; ++j) { const int n = (lane >> 3) + 8 * j; const int sidx = permkind ? rope_perm(n) : n; const LAS float* sp = scr + (8 * c) * 33 + sidx;
    u32x4 o; o.x = pk2(sp[0 * 33] * scale, sp[1 * 33] * scale); o.y = pk2(sp[2 * 33] * scale, sp[3 * 33] * scale); o.z = pk2(sp[4 * 33] * scale, sp[5 * 33] * scale); o.w = pk2(sp[6 * 33] * scale, sp[7 * 33] * scale);
    *(u32x4*)(dst + (size_t)n * 1024 + k0 + 8 * c) = o; }
  asm volatile("s_waitcnt lgkmcnt(0)" ::: "memory");
}
__device__ __forceinline__ void p0_la_item(const float* Win, const float* decw  , int dir, int j0, bf16* dst, int k0, LAS float* scr, int lane) {
  float dw[16];
#pragma unroll
  for (int r = 0; r < 16; ++r) dw[r] = decw[(dir * 16 + r) * 128 + j0 + (lane & 31)];
#pragma unroll 4
  for (int i = 0; i < 32; ++i) { const int kk = 2 * i + (lane >> 5); const float* wp = Win + (size_t)(k0 + kk) * PWW + O_LR + dir * 16; float acc = 0.f;
#pragma unroll
    for (int r = 0; r < 16; ++r) acc += wp[r] * dw[r];
    scr[kk * 33 + (lane & 31)] = acc; }
  asm volatile("s_waitcnt lgkmcnt(0)" ::: "memory");
  const int c = lane & 7;
#pragma unroll
  for (int j = 0; j < 4; ++j) { const int n = (lane >> 3) + 8 * j; const LAS float* sp = scr + (8 * c) * 33 + n;
    u32x4 o; o.x = pk2(sp[0 * 33], sp[1 * 33]); o.y = pk2(sp[2 * 33], sp[3 * 33]); o.z = pk2(sp[4 * 33], sp[5 * 33]); o.w = pk2(sp[6 * 33], sp[7 * 33]);
    *(u32x4*)(dst + (size_t)n * 1024 + k0 + 8 * c) = o; }
  asm volatile("s_waitcnt lgkmcnt(0)" ::: "memory");
}
constexpr int FA_AST = 528, FA_WST = 528;
__device__ __forceinline__ void p0_fa_item(const Frame& F, const Args& a, int item) {
  const int l = item >> 4, pn = 4 + ((item >> 3) & 1), g32 = item & 7, bj = g32 >> 2, wc = g32 & 3;
  LAS float* cs = (LAS float*)F.lds; LAS float* sn = cs + 64; LAS float* wfl = sn + 64;
  LAS unsigned char* Ai = F.lds + 512 + 16384;
  LAS unsigned char* Wi = F.lds + F.wave * (32 * FA_WST);
  __syncthreads();
  if (F.tid < 64) { float s_, c_; sincospif(2.f * F.tid / 64.f, &s_, &c_); cs[F.tid] = c_; sn[F.tid] = s_; }
  const float* wf = opq(a.in[12]) + (size_t)l * 256 * 256;
  const int slice0 = 32 * (pn - 4) + 16 * bj + 4 * wc;
  for (int i = F.tid; i < 1024; i += 512) { const int r = i >> 2, q = i & 3; *(LAS f32x4*)(wfl + r * 16 + 4 * q) = *(const f32x4*)(wf + (size_t)r * 256 + 4 * slice0 + 4 * q); }
  __syncthreads();
  {
    const int c = F.tid & 255, part = F.tid >> 8, g = c >> 6, jj = c & 63;
    f32x4 acc[4];
#pragma unroll
    for (int q = 0; q < 4; ++q) acc[q] = (f32x4){0.f, 0.f, 0.f, 0.f};
#pragma unroll 4
    for (int m = 0; m < 64; ++m) { const int idx = (m * jj) & 63; const float t = part ? -sn[idx] : cs[idx];
#pragma unroll
      for (int q = 0; q < 4; ++q) acc[q] += t * *(LAS const f32x4*)(wfl + (g * 64 + m) * 16 + 4 * q); }
#pragma unroll
    for (int fq = 0; fq < 4; ++fq)
#pragma unroll
      for (int j = 0; j < 4; ++j) *(LAS unsigned short*)(Ai + (8 * fq + 4 * part + j) * FA_AST + c * 2) = (unsigned short)f2bf(acc[fq][j] * 0.125f);
  }
  __syncthreads();
  const int r32 = F.lane & 31, hi = F.lane >> 5;
  bf16x8 af[16];
#pragma unroll
  for (int s = 0; s < 16; ++s) af[s] = *(LAS const bf16x8*)(Ai + r32 * FA_AST + (16 * s + 8 * hi) * 2);
  __syncthreads();
  const float* Win = opq(a.in[7]) + (size_t)l * 1024 * PWW + O_BV;
  bf16* dst = (bf16*)(opq(a.ws) + WS_W1T) + ((size_t)l * N1 + pn * 256 + 32 * g32) * 1024;
  for (int kb = 0; kb < 4; ++kb) {
    const int k0 = F.wave * 128 + kb * 32;
#pragma unroll
    for (int rh = 0; rh < 2; ++rh) { f32x4 w[16];
#pragma unroll
      for (int r = 0; r < 16; ++r) w[r] = *(const f32x4*)(Win + (size_t)(k0 + 16 * rh + r) * PWW + 4 * F.lane);
#pragma unroll
      for (int r = 0; r < 16; ++r) *(LAS u32x2*)(Wi + (16 * rh + r) * FA_WST + 8 * F.lane) = (u32x2){pk2(w[r].x, w[r].y), pk2(w[r].z, w[r].w)}; }
    asm volatile("s_waitcnt lgkmcnt(0)" ::: "memory");
    f32x16 acc;
#pragma unroll
    for (int i = 0; i < 16; ++i) acc[i] = 0.f;
#pragma unroll
    for (int s = 0; s < 16; ++s) { const bf16x8 bfr = *(LAS const bf16x8*)(Wi + r32 * FA_WST + (16 * s + 8 * hi) * 2); acc = __builtin_amdgcn_mfma_f32_32x32x16_bf16(af[s], bfr, acc, 0, 0, 0); }
#pragma unroll
    for (int r = 0; r < 16; ++r) dst[(size_t)crow(r, hi) * 1024 + k0 + r32] = (bf16)f2bf(acc[r]);
    asm volatile("s_waitcnt lgkmcnt(0)" ::: "memory");
  }
  __syncthreads();
}
__device__ __forceinline__ void p0_prologue(const Frame& F0, const Args& a) {
 {
  const Frame F = relaunder(F0);
  unsigned char* ws = opq(a.ws);
  { const int gt = F.vcu * 512 + F.tid, GT = F.G * 512;
    float* rope = (float*)(ws + WS_ROPE);
    for (int i = gt; i < 1024; i += GT) { const int pos = i >> 4, f = i & 15; const float ang = (float)pos * powf(10000.f, -(float)f / 16.f); rope[i] = cosf(ang); rope[1024 + i] = sinf(ang); }
    bf16* wc = (bf16*)(ws + WS_WC);
    for (int i = gt; i < 128 * 128; i += GT) { const int r = i >> 7, c = i & 127, rr = r & 63, cc = c & 63; float s_, c_; sincospif(2.f * (float)((rr * cc) & 63) / 64.f, &s_, &c_);
      float v; if (r < 64) v = c < 64 ? c_ : s_; else v = c < 64 ? -s_ : c_; wc[i] = (bf16)f2bf(v * 0.125f); }
    bf16* cs256 = (bf16*)(ws + WS_CS256);
    for (int i = gt; i < 256 * 512; i += GT) { const int k = i >> 9, n = i & 511, nn = n & 255; float s_, c_; sincospif(2.f * (float)((k * nn) & 255) / 256.f, &s_, &c_); cs256[i] = (bf16)f2bf((n < 256 ? c_ : s_) * 0.0625f); }
  }
  for (int it = F.vcu; it < 256 + 32; it += F.G) { if (it < 256) p0_ada_item(F, a, it); else p0_fa_item(F, a, it - 256); }
  LAS float* scr = (LAS float*)(F.lds + F.wave * 16384);
  const bool skipfa = F.G >= 128;
  const int gw = skipfa ? (F.vcu - 32) * 8 + F.wave : F.vcu * 8 + F.wave, NGW = skipfa ? (F.G - 32) * 8 : F.G * 8;
  constexpr int I_DIR = 11 * 8 * 16, I_LA = 8 * 16, I_W2 = 32 * 16, I_L = I_DIR + I_LA + I_W2;
  for (int it = (skipfa && F.vcu < 32) ? 2 * I_L : gw; it < 2 * I_L; it += NGW) {
    const int l = it / I_L; int r = it % I_L;
    const float* Win = opq(a.in[7]) + (size_t)l * 1024 * PWW;
    bf16* W1T = (bf16*)(ws + WS_W1T) + (size_t)l * N1 * 1024;
    if (r < I_DIR) {
      const int ti = r / 128, g32 = (r >> 4) & 7, kb = r & 15;
      const int pn = ti < 3 ? ti : ti + 3;
      const int bj = g32 >> 2, wc = g32 & 3, mcb = 64 * wc + 32 * bj;
      int cbase = 0, pk = 0; float sc = 1.f;
      switch (pn) {
        case 0: if (mcb < 128) { cbase = O_AQ + mcb; sc = GLA_QS; } else cbase = O_AK + mcb - 128; break;
        case 1: cbase = O_AV + mcb; break;
        case 2: cbase = O_AG + mcb; break;
        case 6: cbase = O_BG + mcb; break;
        case 7: cbase = O_CQ + mcb; pk = 1; break;
        case 8: if (wc < 2) { cbase = O_CK + mcb; pk = 1; } else cbase = O_CV + mcb - 128; break;
        case 9: cbase = O_CG + mcb; break;
        case 10: cbase = O_DQ + mcb; break;
        case 11: cbase = O_DK + mcb; break;
        case 12: cbase = O_DV + mcb; break;
        default: cbase = O_DG + mcb; break;
      }
      p0_tr_item(Win, PWW, cbase, pk, sc, W1T + (size_t)(pn * 256 + 32 * g32) * 1024, kb * 64, scr, F.lane);
    } else if (r < I_DIR + I_LA) {
      r -= I_DIR; const int g32 = r >> 4, kb = r & 15, bj = g32 >> 2, wc = g32 & 3, mcb = 64 * wc + 32 * bj;
      p0_la_item(Win, opq(a.in[9]) + (size_t)l * 2 * 16 * 128, mcb >> 7, mcb & 127, W1T + (size_t)(3 * 256 + 32 * g32) * 1024, kb * 64, scr, F.lane);
    } else {
      r -= I_DIR + I_LA; const int g = r >> 4, kb = r & 15;
      p0_tr_item(opq(a.in[8]) + (size_t)l * 1024 * 1024, 1024, 32 * g, 0, 1.f, (bf16*)(ws + WS_W2T) + ((size_t)l * 1024 + 32 * g) * 1024, kb * 64, scr, F.lane);
    }
  }
 }
}
__device__ __forceinline__ void p1_prenorm(const Frame& F0, const Args& a, int layer) {
  const Frame F = relaunder(F0);
  const float* xin = layer == 0 ? opq(a.in[0]) : opq(a.out);
  const float* cin = layer == 0 ? opq(a.in[2]) : (const float*)(opq(a.ws) + WS_CTX1);
  const float* nw = opq(a.in[4]) + layer * 1024;
  const float* MOD = (const float*)(opq(a.ws) + WS_MOD) + (size_t)layer * 5 * 3072;
  bf16* H = (bf16*)(opq(a.ws) + WS_H);
  const int gw = F.vcu * 8 + F.wave, NGW = F.G * 8;
  constexpr int RB = 3;
  f32x4 w_[4];
#pragma unroll
  for (int j = 0; j < 4; ++j) w_[j] = *(const f32x4*)(nw + 4 * F.lane + 256 * j);
  for (int row0 = gw; row0 < MT; row0 += RB * NGW) {
    f32x4 v[RB][4], sc_[RB][4], sh_[RB][4]; float ss[RB];
#pragma unroll
    for (int q = 0; q < RB; ++q) { int row = row0 + q * NGW; row = row < MT ? row : MT - 1;
      const float* src; const float* mod;
      if (row < MLAT) { src = xin + (size_t)row * 1024; mod = MOD + (size_t)(row >> 12) * 3072; }
      else { src = cin + (size_t)(row - MLAT) * 1024; mod = MOD + (size_t)4 * 3072; }
      const f32x4* xr = (const f32x4*)src + F.lane;
#pragma unroll
      for (int j = 0; j < 4; ++j) { v[q][j] = xr[64 * j]; sc_[q][j] = *(const f32x4*)(mod + 1024 + 4 * F.lane + 256 * j); sh_[q][j] = *(const f32x4*)(mod + 4 * F.lane + 256 * j); } }
    __builtin_amdgcn_sched_barrier(0);
#pragma unroll
    for (int q = 0; q < RB; ++q) { float s_ = 0.f;
#pragma unroll
      for (int j = 0; j < 4; ++j) s_ += (v[q][j].x * v[q][j].x + v[q][j].y * v[q][j].y) + (v[q][j].z * v[q][j].z + v[q][j].w * v[q][j].w);
      ss[q] = s_; }
#pragma unroll
    for (int o = 1; o < 64; o <<= 1)
#pragma unroll
      for (int q = 0; q < RB; ++q) ss[q] += __shfl_xor(ss[q], o);
#pragma unroll
    for (int q = 0; q < RB; ++q) { const int row = row0 + q * NGW; if (row >= MT) continue;
      const float rs = 1.0f / sqrtf(ss[q] * (1.f / 1024.f) + 1e-6f);
      unsigned long long* o8 = (unsigned long long*)(H + (size_t)row * 1024) + F.lane;
#pragma unroll
      for (int j = 0; j < 4; ++j) {
        const f32x4 h = v[q][j] * rs * w_[j] * (1.f + sc_[q][j]) + sh_[q][j];
        o8[64 * j] = (unsigned long long)pk2(h.x, h.y) | ((unsigned long long)pk2(h.z, h.w) << 32);
      } }
  }
}
}

namespace mk {
using pg8::Unit;
struct EpiIn {
  static constexpr bool PERM = true, AFTER_DRAIN = false;
  bf16* PLB; float* LA; bf16* FA2; LAS const float* rope;
  __device__ __forceinline__ void operator()(const f32x4 (&acc)[2][2][4][2], const Unit& u, int wr, int wc, int fr, int fq) const {
    const int pn = u.pn;
    const bool ctxrows = u.pm >= 64;
    int kind, slot = 0; LAS const float* nw = rope; bool roped = false; float qs = 1.f;
    LAS const float* cqn = rope + 2048; LAS const float* ckn = rope + 2112; LAS const float* dqn = rope + 2176; LAS const float* dkn = rope + 2240; LAS const float* decb = rope + 2304;
    switch (pn) {
      case 0: kind = 0; slot = S_AQK; break;
      case 1: kind = 0; slot = S_AV; break;
      case 2: kind = 1; slot = S_AG; break;
      case 3: kind = 2; break;
      case 4: case 5: kind = 3; break;
      case 6: kind = 1; slot = S_BG; break;
      case 7: kind = 4; slot = S_CQ; nw = cqn; roped = true; qs = QSCALE; break;
      case 8: slot = S_CKV; if (wc < 2) { kind = 4; nw = ckn; roped = true; } else kind = 0; break;
      case 9: kind = 1; slot = S_CG; break;
      case 10: kind = 4; slot = S_DQ; nw = dqn; qs = QSCALE; break;
      case 11: kind = 4; slot = S_DK; nw = dkn; break;
      case 12: kind = 0; slot = S_DV; break;
      default: kind = 1; slot = S_DG; break;
    }
    const int row0 = u.pm * 256 + wr * 64 + fr;
    float w8[2][8];
    if (kind == 4) {
#pragma unroll
      for (int bj = 0; bj < 2; ++bj)
#pragma unroll
        for (int s = 0; s < 8; ++s) { const int d = roped ? (32 * bj + 16 * (s >> 2) + 4 * fq + (s & 3)) : (32 * bj + 8 * fq + s); w8[bj][s] = nw[d] * qs; }
    } else if (kind == 2) {
#pragma unroll
      for (int bj = 0; bj < 2; ++bj)
#pragma unroll
        for (int s = 0; s < 8; ++s) w8[bj][s] = decb[64 * wc + 32 * bj + 8 * fq + s];
    }
#pragma unroll
    for (int ai = 0; ai < 2; ++ai) {
      float rsr[4];
      if (kind == 4) {
#pragma unroll
        for (int m = 0; m < 4; ++m) { float s_ = 0.f;
#pragma unroll
          for (int bj = 0; bj < 2; ++bj)
#pragma unroll
            for (int n = 0; n < 2; ++n) { const f32x4 t = acc[ai][bj][m][n]; s_ += (t.x * t.x + t.y * t.y) + (t.z * t.z + t.w * t.w); }
          rsr[m] = s_; }
#pragma unroll
        for (int o = 16; o < 64; o <<= 1)
#pragma unroll
          for (int m = 0; m < 4; ++m) rsr[m] += __shfl_xor(rsr[m], o);
#pragma unroll
        for (int m = 0; m < 4; ++m) rsr[m] = __builtin_amdgcn_rsqf(rsr[m] * (1.f / 64.f) + 1e-6f);
      }
#pragma unroll
      for (int m = 0; m < 4; ++m) {
        const int r = row0 + ai * 128 + m * 16;
        float v[2][8];
#pragma unroll
        for (int bj = 0; bj < 2; ++bj)
#pragma unroll
          for (int n = 0; n < 2; ++n)
#pragma unroll
            for (int e = 0; e < 4; ++e) v[bj][4 * n + e] = acc[ai][bj][m][n][e];
        if (kind == 2) {
#pragma unroll
          for (int bj = 0; bj < 2; ++bj) { const int mc = 64 * wc + 32 * bj + 8 * fq; float* dp = LA + (size_t)r * 256 + mc;
            f32x4 o0, o1;
#pragma unroll
            for (int e = 0; e < 4; ++e) { o0[e] = flogsig(v[bj][e] + w8[bj][e]) * 0.0625f; o1[e] = flogsig(v[bj][4 + e] + w8[bj][4 + e]) * 0.0625f; }
            *(f32x4*)dp = o0; *(f32x4*)(dp + 4) = o1; }
        } else if (kind == 3) {
          int b, t; if (!ctxrows) { b = r >> 12; t = r & 4095; } else { const int rc = r - MLAT; b = rc >> 8; t = SEQ + (rc & 255); }
#pragma unroll
          for (int bj = 0; bj < 2; ++bj) { const int slice = 32 * (pn - 4) + 16 * bj + 4 * wc + fq;
            u32x4 o; o.x = pk2(v[bj][0], v[bj][1]); o.y = pk2(v[bj][2], v[bj][3]); o.z = pk2(v[bj][4], v[bj][5]); o.w = pk2(v[bj][6], v[bj][7]);
            *(u32x4*)(FA2 + (((size_t)b * 64 + slice) * TROW + t) * 8) = o; }
        } else {
          if (kind == 1) {
#pragma unroll
            for (int bj = 0; bj < 2; ++bj)
#pragma unroll
              for (int s = 0; s < 8; ++s) v[bj][s] = fsilu(v[bj][s]);
          } else if (kind == 4) {
            const float rs = rsr[m];
#pragma unroll
            for (int bj = 0; bj < 2; ++bj)
#pragma unroll
              for (int s = 0; s < 8; ++s) v[bj][s] *= rs * w8[bj][s];
            if (roped && !ctxrows) {
              const int t = r & 4095;
#pragma unroll
              for (int bj = 0; bj < 2; ++bj) { const int pos = bj == 0 ? (t >> 6) : (t & 63);
                const f32x4 c4 = *(LAS const f32x4*)(rope + pos * 16 + 4 * fq), s4 = *(LAS const f32x4*)(rope + 1024 + pos * 16 + 4 * fq);
#pragma unroll
                for (int e = 0; e < 4; ++e) { const float x1 = v[bj][e], x2 = v[bj][4 + e]; v[bj][e] = x1 * c4[e] - x2 * s4[e]; v[bj][4 + e] = x2 * c4[e] + x1 * s4[e]; } }
            }
          }
#pragma unroll
          for (int bj = 0; bj < 2; ++bj) { const int mc = 64 * wc + 32 * bj + 8 * fq;
            u32x4 o; o.x = pk2(v[bj][0], v[bj][1]); o.y = pk2(v[bj][2], v[bj][3]); o.z = pk2(v[bj][4], v[bj][5]); o.w = pk2(v[bj][6], v[bj][7]);
            *(u32x4*)(PLB + (size_t)r * PLW + slot * 256 + mc) = o; }
        }
        asm volatile("" ::: "memory");
      }
    }
  }
};
struct EpiOut {
  static constexpr bool PERM = true, AFTER_DRAIN = false;
  const float* xin; const float* cin; float* xout; float* cout; const float* MODl;
  __device__ __forceinline__ void operator()(const f32x4 (&acc)[2][2][4][2], const Unit& u, int wr, int wc, int fr_, int fq_) const {
    int fr = fr_, fq = fq_; asm volatile("" : "+v"(fr), "+v"(fq));
    const int row0 = u.pm * 256 + wr * 64 + fr, col0 = u.pn * 256 + wc * 32 + 8 * fq;
    const bool ctxrows = u.pm >= 64;
    const float* gate = MODl + (size_t)(ctxrows ? 4 : (u.pm >> 4)) * 3072 + 2048;
    f32x4 gv[2][2];
#pragma unroll
    for (int bj = 0; bj < 2; ++bj)
#pragma unroll
      for (int n = 0; n < 2; ++n) gv[bj][n] = *(const f32x4*)(gate + col0 + bj * 128 + n * 4);
    const float* sp0; float* dp0;
    if (!ctxrows) { sp0 = xin + (size_t)row0 * 1024 + col0; dp0 = xout + (size_t)row0 * 1024 + col0; }
    else { sp0 = cin + (size_t)(row0 - MLAT) * 1024 + col0; dp0 = cout + (size_t)(row0 - MLAT) * 1024 + col0; }
#pragma unroll
    for (int ai = 0; ai < 2; ++ai) {
      f32x4 xv[4][2][2];
#pragma unroll
      for (int m = 0; m < 4; ++m)
#pragma unroll
        for (int bj = 0; bj < 2; ++bj)
#pragma unroll
          for (int n = 0; n < 2; ++n) xv[m][bj][n] = *(const f32x4*)(sp0 + (size_t)(ai * 128 + m * 16) * 1024 + bj * 128 + n * 4);
      __builtin_amdgcn_sched_barrier(0);
#pragma unroll
      for (int m = 0; m < 4; ++m)
#pragma unroll
        for (int bj = 0; bj < 2; ++bj)
#pragma unroll
          for (int n = 0; n < 2; ++n) *(f32x4*)(dp0 + (size_t)(ai * 128 + m * 16) * 1024 + bj * 128 + n * 4) = xv[m][bj][n] + gv[bj][n] * acc[ai][bj][m][n];
      asm volatile("" ::: "memory");
    }
  }
};
struct InOrder {
  pg8::StaticOrder S;
  static constexpr unsigned long long PACK = 0x3c817d9b0a5246ull;
  __device__ __forceinline__ bool next(int i, Unit& u) const { const bool ok = S.next(i, u); if (ok) u.pn = (int)((PACK >> (4 * u.pn)) & 15ull); return ok; }
  __device__ __forceinline__ void a_ready(const Unit&) const {}
  __device__ __forceinline__ void done(const Unit&) const {}
};
__device__ __forceinline__ void p2_inproj(const Frame& F, const Args& a, int layer) {
  unsigned char* ws = opq(a.ws);
  pg8::Gemm g{(const pg8::bf16_t*)(ws + WS_H), (const pg8::bf16_t*)(ws + WS_W1T) + (size_t)layer * N1 * 1024, MT, N1, 1024};
  InOrder S; S.S.init(MT, N1, F.G, (int)blockIdx.x);
  LAS float* ropeL = (LAS float*)(F.lds + pg8::STAGE_BYTES);
  { int tid = threadIdx.x; asm volatile("" : "+v"(tid)); const f32x4 t = *(const f32x4*)((const float*)(ws + WS_ROPE) + 4 * tid); *(LAS f32x4*)(ropeL + 4 * tid) = t;
    if (tid < 128) {
      const float* n0 = opq(a.in[13]); const float* n1 = opq(a.in[14]); const float* n2 = opq(a.in[16]); const float* n3 = opq(a.in[17]); const float* db = opq(a.in[10]);
      const int k = tid >> 4; const float* src = tid < 64 ? (k == 0 ? n0 : k == 1 ? n1 : k == 2 ? n2 : n3) + layer * 64 + 4 * (tid & 15) : db + layer * 256 + 4 * (tid - 64);
      *(LAS f32x4*)(ropeL + 2048 + 4 * tid) = *(const f32x4*)src; } }
  __syncthreads();
  EpiIn E{(bf16*)(ws + WS_PLB), (float*)(ws + WS_LA), (bf16*)(ws + WS_FA2), ropeL};
  pg8::gemm_phase<EpiIn, InOrder>(F.lds, g, S, E, nullptr);
}

__device__ __forceinline__ void ctx_out_item(const Frame& F, const Args& a, int item) {
  unsigned char* ws = opq(a.ws);
  const bf16* Yc = (const bf16*)(ws + WS_H) + (size_t)MLAT * 1024; const bf16* W2 = (const bf16*)(ws + WS_W2T);
  const int tm = item >> 4, tn = item & 15, sub = F.wave & 3, kh = F.wave >> 2, r32 = F.lane & 31, hi = F.lane >> 5;
  const int row0 = 64 * tm + 32 * (sub >> 1), col0 = 64 * tn + 32 * (sub & 1);
  const bf16* ap = Yc + (size_t)(row0 + r32) * 1024 + kh * 512 + 8 * hi;
  const bf16* bp = W2 + (size_t)(col0 + r32) * 1024 + kh * 512 + 8 * hi;
  f32x16 acc;
#pragma unroll
  for (int i = 0; i < 16; ++i) acc[i] = 0.f;
#pragma unroll 1
  for (int sb = 0; sb < 4; ++sb) {
    bf16x8 af[8], bf[8];
#pragma unroll
    for (int s = 0; s < 8; ++s) { af[s] = *(const bf16x8*)(ap + (sb * 8 + s) * 16); bf[s] = *(const bf16x8*)(bp + (sb * 8 + s) * 16); }
    __builtin_amdgcn_sched_barrier(0);
#pragma unroll
    for (int s = 0; s < 8; ++s) acc = __builtin_amdgcn_mfma_f32_32x32x16_bf16(af[s], bf[s], acc, 0, 0, 0);
  }
  LAS float* X = (LAS float*)F.lds + sub * 1024;
  __syncthreads();
  if (kh == 1) {
#pragma unroll
    for (int r = 0; r < 16; ++r) X[r * 64 + F.lane] = acc[r];
  }
  __syncthreads();
  if (kh == 0) {
    const float* cin = opq(a.in[2]); float* cout = (float*)(ws + WS_CTX1);
    const float gate = ((const float*)(ws + WS_MOD))[4 * 3072 + 2048 + col0 + r32];
    float ci[16];
#pragma unroll
    for (int r = 0; r < 16; ++r) ci[r] = cin[(size_t)(row0 + crow(r, hi)) * 1024 + col0 + r32];
    __builtin_amdgcn_sched_barrier(0);
#pragma unroll
    for (int r = 0; r < 16; ++r) { const size_t o = (size_t)(row0 + crow(r, hi)) * 1024 + col0 + r32; cout[o] = ci[r] + gate * (acc[r] + X[r * 64 + F.lane]); }
  }
}
__device__ __forceinline__ void p5_outproj(const Frame& F, const Args& a, int layer) {
  unsigned char* ws = opq(a.ws);
  const int M = MLAT;
  pg8::Gemm g{(const pg8::bf16_t*)(ws + WS_H), (const pg8::bf16_t*)(ws + WS_W2T) + (size_t)layer * 1024 * 1024, M, 1024, 1024};
  pg8::StaticOrder S; S.init(M, 1024, F.G, (int)blockIdx.x);
  EpiOut E{layer == 0 ? opq(a.in[0]) : opq(a.out), layer == 0 ? opq(a.in[2]) : (const float*)(ws + WS_CTX1), opq(a.out), (float*)(ws + WS_CTX1), (const float*)(ws + WS_MOD) + (size_t)layer * 5 * 3072};
  pg8::gemm_phase<EpiOut, pg8::StaticOrder>(F.lds, g, S, E, nullptr);
  if (layer == 0) { const Frame F2 = relaunder(F); for (int it = F2.vcu; it < 256; it += F2.G) ctx_out_item(F2, a, it); }
}
}

namespace mk {
typedef short v4i16_t __attribute__((ext_vector_type(4)));
__device__ __forceinline__ s16x4 vtr(LAS const unsigned char* p) { return __builtin_bit_cast(s16x4, __builtin_amdgcn_ds_read_tr16_b64_v4i16((LAS v4i16_t*)p)); }
struct AttnState { float m, l; f32x16 o0, o1; };
template <class MaskF>
__device__ __forceinline__ void attn_tile(AttnState& st, const bf16x8 (&qf)[4], LAS const unsigned char* Kt, LAS const unsigned char* Vt, int lane, MaskF&& maskf) {
  const int r32 = lane & 31, hi = lane >> 5;
  f32x16 p0, p1;
  const int ksw = (r32 >> 1) & 7;
  bf16x8 ka[4], kb[4];
#pragma unroll
  for (int s = 0; s < 4; ++s) { const int ch = ((2 * s + hi) ^ ksw) << 4; ka[s] = *(LAS const bf16x8*)(Kt + r32 * 128 + ch); kb[s] = *(LAS const bf16x8*)(Kt + (32 + r32) * 128 + ch); }
  { const f32x16 z = {0.f, 0.f, 0.f, 0.f, 0.f, 0.f, 0.f, 0.f, 0.f, 0.f, 0.f, 0.f, 0.f, 0.f, 0.f, 0.f};
    p0 = __builtin_amdgcn_mfma_f32_32x32x16_bf16(ka[0], qf[0], z, 0, 0, 0); p1 = __builtin_amdgcn_mfma_f32_32x32x16_bf16(kb[0], qf[0], z, 0, 0, 0); }
#pragma unroll
  for (int s = 1; s < 4; ++s) { p0 = __builtin_amdgcn_mfma_f32_32x32x16_bf16(ka[s], qf[s], p0, 0, 0, 0); p1 = __builtin_amdgcn_mfma_f32_32x32x16_bf16(kb[s], qf[s], p1, 0, 0, 0); }
  maskf(p0, p1);
  float ps = 0.f;
#pragma unroll
  for (int i = 0; i < 16; ++i) { p0[i] = __builtin_amdgcn_exp2f(p0[i]); p1[i] = __builtin_amdgcn_exp2f(p1[i]); ps += p0[i] + p1[i]; }
  st.l += ps;
  u32x4 pw[4];
#pragma unroll
  for (int k = 0; k < 2; ++k) {
    pw[k] = (u32x4){pk2(p0[8 * k + 0], p0[8 * k + 1]), pk2(p0[8 * k + 2], p0[8 * k + 3]), pk2(p0[8 * k + 4], p0[8 * k + 5]), pk2(p0[8 * k + 6], p0[8 * k + 7])};
    pw[2 + k] = (u32x4){pk2(p1[8 * k + 0], p1[8 * k + 1]), pk2(p1[8 * k + 2], p1[8 * k + 3]), pk2(p1[8 * k + 4], p1[8 * k + 5]), pk2(p1[8 * k + 6], p1[8 * k + 7])};
  }
  const int q = (lane & 15) >> 2, p = lane & 3, gsel = (lane >> 4) & 1;
  const int vrow = (4 * hi + q) * 128 + 8 * (p & 1);
  const int chb = 2 * gsel + (p >> 1);
#pragma unroll
  for (int ks = 0; ks < 4; ++ks) {
    const int c0_ = ((chb | ((0 ^ (q >> 1)) << 2)) << 4), c1_ = ((chb | ((1 ^ (q >> 1)) << 2)) << 4);
    const s16x4 l0 = vtr(Vt + ks * 2048 + vrow + c0_), h0 = vtr(Vt + ks * 2048 + 1024 + vrow + c0_), l1 = vtr(Vt + ks * 2048 + vrow + c1_), h1 = vtr(Vt + ks * 2048 + 1024 + vrow + c1_);
    const bf16x8 va0 = (bf16x8){l0[0], l0[1], l0[2], l0[3], h0[0], h0[1], h0[2], h0[3]}, va1 = (bf16x8){l1[0], l1[1], l1[2], l1[3], h1[0], h1[1], h1[2], h1[3]};
    st.o0 = __builtin_amdgcn_mfma_f32_32x32x16_bf16(va0, __builtin_bit_cast(bf16x8, pw[ks]), st.o0, 0, 0, 0);
    st.o1 = __builtin_amdgcn_mfma_f32_32x32x16_bf16(va1, __builtin_bit_cast(bf16x8, pw[ks]), st.o1, 0, 0, 0);
  }
}
template <class MaskF, class F1, class F2, class F3>
__device__ __forceinline__ void attn_tile_dma(AttnState& st, const bf16x8 (&qf)[4], LAS const unsigned char* Kt, LAS const unsigned char* Vt, int lane, MaskF&& maskf, F1&& after_k, F2&& before_v, F3&& after_v) {
  const int r32 = lane & 31, hi = lane >> 5;
  f32x16 p0, p1;
  const int ksw = (r32 >> 1) & 7;
  bf16x8 ka[4], kb[4];
#pragma unroll
  for (int s = 0; s < 4; ++s) { const int ch = ((2 * s + hi) ^ ksw) << 4; ka[s] = *(LAS const bf16x8*)(Kt + r32 * 128 + ch); kb[s] = *(LAS const bf16x8*)(Kt + (32 + r32) * 128 + ch); }
  asm volatile("s_waitcnt lgkmcnt(0)" ::: "memory");
  after_k();
  { const f32x16 z = {0.f, 0.f, 0.f, 0.f, 0.f, 0.f, 0.f, 0.f, 0.f, 0.f, 0.f, 0.f, 0.f, 0.f, 0.f, 0.f};
    p0 = __builtin_amdgcn_mfma_f32_32x32x16_bf16(ka[0], qf[0], z, 0, 0, 0); p1 = __builtin_amdgcn_mfma_f32_32x32x16_bf16(kb[0], qf[0], z, 0, 0, 0); }
#pragma unroll
  for (int s = 1; s < 4; ++s) { p0 = __builtin_amdgcn_mfma_f32_32x32x16_bf16(ka[s], qf[s], p0, 0, 0, 0); p1 = __builtin_amdgcn_mfma_f32_32x32x16_bf16(kb[s], qf[s], p1, 0, 0, 0); }
  maskf(p0, p1);
  float ps = 0.f;
#pragma unroll
  for (int i = 0; i < 16; ++i) { p0[i] = __builtin_amdgcn_exp2f(p0[i]); p1[i] = __builtin_amdgcn_exp2f(p1[i]); ps += p0[i] + p1[i]; }
  st.l += ps;
  u32x4 pw[4];
#pragma unroll
  for (int k = 0; k < 2; ++k) {
    pw[k] = (u32x4){pk2(p0[8 * k + 0], p0[8 * k + 1]), pk2(p0[8 * k + 2], p0[8 * k + 3]), pk2(p0[8 * k + 4], p0[8 * k + 5]), pk2(p0[8 * k + 6], p0[8 * k + 7])};
    pw[2 + k] = (u32x4){pk2(p1[8 * k + 0], p1[8 * k + 1]), pk2(p1[8 * k + 2], p1[8 * k + 3]), pk2(p1[8 * k + 4], p1[8 * k + 5]), pk2(p1[8 * k + 6], p1[8 * k + 7])};
  }
  before_v();
  const int q = (lane & 15) >> 2, p = lane & 3, gsel = (lane >> 4) & 1;
  const int vrow = (4 * hi + q) * 128 + 8 * (p & 1);
  const int chb = 2 * gsel + (p >> 1);
  s16x4 vl0[4], vh0[4], vl1[4], vh1[4];
#pragma unroll
  for (int ks = 0; ks < 4; ++ks) {
    const int c0_ = ((chb | ((0 ^ (q >> 1)) << 2)) << 4), c1_ = ((chb | ((1 ^ (q >> 1)) << 2)) << 4);
    vl0[ks] = vtr(Vt + ks * 2048 + vrow + c0_); vh0[ks] = vtr(Vt + ks * 2048 + 1024 + vrow + c0_); vl1[ks] = vtr(Vt + ks * 2048 + vrow + c1_); vh1[ks] = vtr(Vt + ks * 2048 + 1024 + vrow + c1_);
  }
  asm volatile("s_waitcnt lgkmcnt(0)" ::: "memory");
  after_v();
#pragma unroll
  for (int ks = 0; ks < 4; ++ks) {
    const bf16x8 va0 = (bf16x8){vl0[ks][0], vl0[ks][1], vl0[ks][2], vl0[ks][3], vh0[ks][0], vh0[ks][1], vh0[ks][2], vh0[ks][3]}, va1 = (bf16x8){vl1[ks][0], vl1[ks][1], vl1[ks][2], vl1[ks][3], vh1[ks][0], vh1[ks][1], vh1[ks][2], vh1[ks][3]};
    st.o0 = __builtin_amdgcn_mfma_f32_32x32x16_bf16(va0, __builtin_bit_cast(bf16x8, pw[ks]), st.o0, 0, 0, 0);
    st.o1 = __builtin_amdgcn_mfma_f32_32x32x16_bf16(va1, __builtin_bit_cast(bf16x8, pw[ks]), st.o1, 0, 0, 0);
  }
}
__device__ __forceinline__ void glds16(const void* sbase  , unsigned voff  , unsigned lds_dst) {
  unsigned keep;
  asm volatile("s_mov_b32 %0, m0\n\ts_mov_b32 m0, %2\n\ts_nop 0\n\tglobal_load_lds_dwordx4 %1, %3\n\ts_mov_b32 m0, %0" : "=&s"(keep) : "v"(voff), "s"(lds_dst), "s"(sbase) : "memory");
}
__device__ __forceinline__ void glds16x8(const void* sbase, const unsigned (&vo)[8], unsigned lds_dst) {
  unsigned keep;
  asm volatile("s_mov_b32 %0, m0\n\ts_mov_b32 m0, %9\n\ts_nop 0\n\tglobal_load_lds_dwordx4 %1, %10\n\t"
               "s_add_u32 m0, m0, 0x400\n\ts_nop 0\n\tglobal_load_lds_dwordx4 %2, %10\n\t"
               "s_add_u32 m0, m0, 0x400\n\ts_nop 0\n\tglobal_load_lds_dwordx4 %3, %10\n\t"
               "s_add_u32 m0, m0, 0x400\n\ts_nop 0\n\tglobal_load_lds_dwordx4 %4, %10\n\t"
               "s_add_u32 m0, m0, 0x400\n\ts_nop 0\n\tglobal_load_lds_dwordx4 %5, %10\n\t"
               "s_add_u32 m0, m0, 0x400\n\ts_nop 0\n\tglobal_load_lds_dwordx4 %6, %10\n\t"
               "s_add_u32 m0, m0, 0x400\n\ts_nop 0\n\tglobal_load_lds_dwordx4 %7, %10\n\t"
               "s_add_u32 m0, m0, 0x400\n\ts_nop 0\n\tglobal_load_lds_dwordx4 %8, %10\n\t"
               "s_mov_b32 m0, %0"
               : "=&s"(keep) : "v"(vo[0]), "v"(vo[1]), "v"(vo[2]), "v"(vo[3]), "v"(vo[4]), "v"(vo[5]), "v"(vo[6]), "v"(vo[7]), "s"(lds_dst), "s"(sbase) : "memory", "scc");
}
__device__ __forceinline__ void attn_store(const AttnState& st, float inv, const bf16* grow  , bf16* yrow  , int lane) {
  const int hi = lane >> 5;
  u32x2 gv[8];
#pragma unroll
  for (int i = 0; i < 8; ++i) gv[i] = *(const u32x2*)(grow + 32 * (i >> 2) + 8 * (i & 3) + 4 * hi);
  __builtin_amdgcn_sched_barrier(0);
#pragma unroll
  for (int d0 = 0; d0 < 2; ++d0)
#pragma unroll
    for (int gi = 0; gi < 4; ++gi) {
      const int db = 32 * d0 + 8 * gi + 4 * hi; const u32x2 g = gv[4 * d0 + gi];
      const f32x16& o = d0 == 0 ? st.o0 : st.o1;
      const float g0 = __uint_as_float(g.x << 16), g1 = __uint_as_float(g.x & 0xffff0000u), g2 = __uint_as_float(g.y << 16), g3 = __uint_as_float(g.y & 0xffff0000u);
      u32x2 ov; ov.x = pk2(o[4 * gi + 0] * inv * g0, o[4 * gi + 1] * inv * g1); ov.y = pk2(o[4 * gi + 2] * inv * g2, o[4 * gi + 3] * inv * g3);
      *(u32x2*)(yrow + db) = ov;
    }
}
__device__ __forceinline__ void attn_gates(u32x2 (&gv)[8], const bf16* grow, int lane) {
  const int hi = lane >> 5;
#pragma unroll
  for (int i = 0; i < 8; ++i) gv[i] = *(const u32x2*)(grow + 32 * (i >> 2) + 8 * (i & 3) + 4 * hi);
}
__device__ __forceinline__ void attn_store_g(const AttnState& st, float inv, const u32x2 (&gv)[8], bf16* yrow, int lane) {
  const int hi = lane >> 5;
#pragma unroll
  for (int d0 = 0; d0 < 2; ++d0)
#pragma unroll
    for (int gi = 0; gi < 4; ++gi) {
      const int db = 32 * d0 + 8 * gi + 4 * hi; const u32x2 g = gv[4 * d0 + gi];
      const f32x16& o = d0 == 0 ? st.o0 : st.o1;
      const float g0 = __uint_as_float(g.x << 16), g1 = __uint_as_float(g.x & 0xffff0000u), g2 = __uint_as_float(g.y << 16), g3 = __uint_as_float(g.y & 0xffff0000u);
      u32x2 ov; ov.x = pk2(o[4 * gi + 0] * inv * g0, o[4 * gi + 1] * inv * g1); ov.y = pk2(o[4 * gi + 2] * inv * g2, o[4 * gi + 3] * inv * g3);
      *(u32x2*)(yrow + db) = ov;
    }
}
template <int NH> struct TileRegs { u32x4 k[NH], v[NH]; };
template <int NH>
__device__ __forceinline__ void tile_load(TileRegs<NH>& R, const bf16* kbase  , const bf16* vbase, int tid) {
  const int key = tid >> 3, ch = tid & 7;
#pragma unroll
  for (int h = 0; h < NH; ++h) { R.k[h] = *(const u32x4*)(kbase + (size_t)key * PLW + h * 64 + ch * 8); R.v[h] = *(const u32x4*)(vbase + (size_t)key * PLW + h * 64 + ch * 8); }
}
template <int NH>
__device__ __forceinline__ void tile_store(const TileRegs<NH>& R, LAS unsigned char* buf, int tid) {
  const int key = tid >> 3, ch = tid & 7;
  const int ko = key * 128 + ((ch ^ ((key >> 1) & 7)) << 4), vo = key * 128 + ((ch ^ (((key >> 1) & 1) << 2)) << 4);
#pragma unroll
  for (int h = 0; h < NH; ++h) { *(LAS u32x4*)(buf + h * 8192 + ko) = R.k[h]; *(LAS u32x4*)(buf + NH * 8192 + h * 8192 + vo) = R.v[h]; }
}

template <int NH> struct TileRegs2 { TileRegs<NH> a, b; };
__device__ __forceinline__ void swa_item(const Frame& F0, const Args& a, int layer, int item) {
  const Frame F = relaunder(F0);
  unsigned char* ws = opq(a.ws);
  const bf16* PLB = (const bf16*)(ws + WS_PLB); bf16* Y = (bf16*)(ws + WS_H);
  const bool isctx = item >= 256;
  int b, kvh, n;
  if (!isctx) { b = item >> 6; kvh = (item >> 5) & 1; n = item & 31; } else { const int ci = item - 256; b = ci >> 2; kvh = (ci >> 1) & 1; n = ci & 1; }
  const int g = F.wave >> 2, quarter = F.wave & 3, hq = 2 * kvh + g, r32 = F.lane & 31, hi = F.lane >> 5;
  const int tq = 128 * n + 32 * quarter + r32;
  const size_t qrow = isctx ? (size_t)MLAT + b * CTX + tq : (size_t)b * SEQ + tq;
  bf16x8 qf[4];
#pragma unroll
  for (int s = 0; s < 4; ++s) qf[s] = *(const bf16x8*)(PLB + qrow * PLW + S_CQ * 256 + hq * 64 + 16 * s + 8 * hi);
  int jlo = 0, jhi = 0;
  if (!isctx) { jlo = n == 0 ? 1 : 0; jhi = n == 31 ? 2 : 3; }
  const int nloc = jhi - jlo, T = nloc + 2;
  const bf16* kcol = PLB + S_CKV * 256 + kvh * 64;
  auto tile_row = [&](int t) -> size_t { return t < nloc ? (size_t)b * SEQ + 128 * (n - 1 + jlo + t) : (size_t)MLAT + b * CTX + 128 * (t - nloc); };
  AttnState st; st.m = 0.f; st.l = 0.f;
#pragma unroll
  for (int i = 0; i < 16; ++i) { st.o0[i] = 0.f; st.o1[i] = 0.f; }
  TileRegs2<1> R;
  __syncthreads();
  { const size_t r0 = tile_row(0); tile_load<1>(R.a, kcol + r0 * PLW, kcol + 128 + r0 * PLW, F.tid); tile_load<1>(R.b, kcol + (r0 + 64) * PLW, kcol + 128 + (r0 + 64) * PLW, F.tid); }
  tile_store<1>(R.a, F.lds, F.tid); tile_store<1>(R.b, F.lds + 16384, F.tid);
  __syncthreads();
  for (int t = 0; t < T; ++t) {
    if (t + 1 < T) { const size_t r0 = tile_row(t + 1); tile_load<1>(R.a, kcol + r0 * PLW, kcol + 128 + r0 * PLW, F.tid); tile_load<1>(R.b, kcol + (r0 + 64) * PLW, kcol + 128 + (r0 + 64) * PLW, F.tid); }
    LAS const unsigned char* buf = F.lds + (t & 1) * 32768;
#pragma unroll
    for (int hf = 0; hf < 2; ++hf) {
      LAS const unsigned char* hb = buf + hf * 16384;
      if (t < nloc) {
        const int kb = 128 * (n - 1 + jlo + t) + 64 * hf, q0 = 128 * n + 32 * quarter;
        if (!(kb + 63 < q0 - 128 || kb > q0 + 31 + 128)) {
          const int dq = kb - tq;
          if (kb >= q0 + 31 - 128 && kb + 63 <= q0 + 128) attn_tile(st, qf, hb, hb + 8192, F.lane, [](f32x16&, f32x16&) {});
          else attn_tile(st, qf, hb, hb + 8192, F.lane, [&](f32x16& p0, f32x16& p1) {
#pragma unroll
            for (int r = 0; r < 16; ++r) { const int d0_ = dq + 128 + crow(r, hi), d1_ = d0_ + 32;
              p0[r] = ((unsigned)d0_ <= 256u) ? p0[r] : -INFINITY; p1[r] = ((unsigned)d1_ <= 256u) ? p1[r] : -INFINITY; } });
        }
      } else attn_tile(st, qf, hb, hb + 8192, F.lane, [](f32x16&, f32x16&) {});
    }
    if (t + 1 < T) { tile_store<1>(R.a, F.lds + ((t + 1) & 1) * 32768, F.tid); tile_store<1>(R.b, F.lds + ((t + 1) & 1) * 32768 + 16384, F.tid); }
    __syncthreads();
  }
  float l = st.l + __shfl_xor(st.l, 32);
  const float sk2 = opq(a.in[15])[layer * 4 + hq] * LOG2E;
  const float mnew = fmaxf(st.m, sk2), al = __builtin_amdgcn_exp2f(st.m - mnew);
  l = l * al + __builtin_amdgcn_exp2f(sk2 - mnew);
  int qr = (int)qrow; asm volatile("" : "+v"(qr));
  attn_store(st, al / l, PLB + (size_t)qr * PLW + S_CG * 256 + hq * 64, Y + (size_t)qr * 1024 + 512 + hq * 64, F.lane);
}
__device__ __forceinline__ void na_item(const Frame& F0, const Args& a, int layer, int item) {
  const Frame F = relaunder(F0);
  unsigned char* ws = opq(a.ws);
  const bf16* PLB = (const bf16*)(ws + WS_PLB); bf16* Y = (bf16*)(ws + WS_H);
  const bool isctx = item >= 256;
  int b, r;
  if (!isctx) { b = item >> 6; r = item & 63; } else { const int ci = item - 256; b = ci >> 2; r = ci & 3; }
  const int head = F.wave >> 1, half = F.wave & 1, r32 = F.lane & 31, hi = F.lane >> 5;
  const int qc = 32 * half + r32;
  const size_t qrow = isctx ? (size_t)MLAT + b * CTX + 64 * r + qc : (size_t)b * SEQ + 64 * r + qc;
  bf16x8 qf[4];
#pragma unroll
  for (int s = 0; s < 4; ++s) qf[s] = *(const bf16x8*)(PLB + qrow * PLW + S_DQ * 256 + head * 64 + 16 * s + 8 * hi);
  int rs = r - 4; rs = rs < 0 ? 0 : (rs > 56 ? 56 : rs);
  const int nloc = isctx ? 0 : 8, T = nloc + 4;
  auto tile_row = [&](int t) -> size_t { return t < nloc ? (size_t)b * SEQ + 64 * (rs + t) : (size_t)MLAT + b * CTX + 64 * (t - nloc); };
  const bf16* kcol = PLB + S_DK * 256 + head * 64; const bf16* vcol = PLB + S_DV * 256 + head * 64;
  LAS float* btab = (LAS float*)(F.lds + 2 * 65536);
  LAS unsigned char* Kt = F.lds + F.wave * 16384; LAS unsigned char* Vt = Kt + 8192;
  const unsigned kdst = (unsigned)(size_t)Kt, vdst = kdst + 8192u;
  const int kk = F.lane >> 3, cs = F.lane & 7;
  const unsigned ok0 = kk * (PLW * 2) + ((cs ^ (kk >> 1)) << 4), ok1 = kk * (PLW * 2) + ((cs ^ (4 + (kk >> 1))) << 4), ov = kk * (PLW * 2) + ((cs ^ (((kk >> 1) & 1) << 2)) << 4);
  unsigned vok[8], vov[8];
#pragma unroll
  for (int n = 0; n < 8; ++n) { vok[n] = ((n & 1) ? ok1 : ok0) + n * 8 * (PLW * 2); vov[n] = ov + n * 8 * (PLW * 2); }
  auto dma_k = [&](int t) { glds16x8(kcol + tile_row(t) * PLW, vok, kdst); };
  auto dma_v = [&](int t) { glds16x8(vcol + tile_row(t) * PLW, vov, vdst); };
  AttnState st; st.m = 0.f; st.l = 0.f;
#pragma unroll
  for (int i = 0; i < 16; ++i) { st.o0[i] = 0.f; st.o1[i] = 0.f; }
  u32x2 gv[8];
  { int qr0 = (int)qrow; asm volatile("" : "+v"(qr0)); attn_gates(gv, PLB + (size_t)qr0 * PLW + S_DG * 256 + head * 64, F.lane); }
  float t_[15];
  { const float* rb = opq(a.in[18]) + (size_t)layer * 4 * 15 * 31;
#pragma unroll
    for (int i = 0; i < 15; ++i) { const int ix = F.tid + 512 * i, hd = ix >> 7, dx = (ix & 127) - 63; const int dc = dx < -15 ? -15 : (dx > 15 ? 15 : dx); t_[i] = rb[hd * 31 + dc + 15]; } }
  __builtin_amdgcn_sched_barrier(0);
#pragma unroll
  for (int s = 0; s < 4; ++s) asm volatile("" : "+v"(qf[s]));
#pragma unroll
  for (int i = 0; i < 15; ++i) asm volatile("" : "+v"(t_[i]));
#pragma unroll
  for (int i = 0; i < 8; ++i) asm volatile("" : "+v"(gv[i]));
  __syncthreads();
  dma_k(0); dma_v(0);
#pragma unroll
  for (int i = 0; i < 15; ++i) { const int dx = ((F.tid + 512 * i) & 127) - 63; btab[F.tid + 512 * i] = (dx >= -15 && dx <= 15) ? t_[i] * LOG2E : 0.f; }
  __syncthreads();
  int c0 = qc - 8; c0 = c0 < 0 ? 0 : (c0 > 48 ? 48 : c0);
  for (int t = 0; t < T; ++t) {
    const bool more = t + 1 < T;
    asm volatile("s_waitcnt vmcnt(8)" ::: "memory");
    auto after_k = [&]() { if (more) dma_k(t + 1); };
    auto before_v = [&]() { if (more) asm volatile("s_waitcnt vmcnt(8)" ::: "memory"); else asm volatile("s_waitcnt vmcnt(0)" ::: "memory"); };
    auto after_v = [&]() { if (more) dma_v(t + 1); };
    if (t < nloc) {
      const int dy = rs + t - r + 7;
      const int c0l = c0;
      unsigned bta = (unsigned)(size_t)(btab + (head * 15 + dy) * 128 + 63 - qc + 4 * hi); asm volatile("" : "+v"(bta));
      LAS const float* bt = (LAS const float*)bta;
      attn_tile_dma(st, qf, Kt, Vt, F.lane, [&](f32x16& p0, f32x16& p1) {
        float bb[16];
#pragma unroll
        for (int rr = 0; rr < 16; ++rr) bb[rr] = bt[(rr & 3) + 8 * (rr >> 2)];
#pragma unroll
        for (int rr = 0; rr < 16; ++rr) p0[rr] = ((unsigned)((rr & 3) + 8 * (rr >> 2) + 4 * hi - c0l) < 16u) ? p0[rr] + bb[rr] : -INFINITY;
#pragma unroll
        for (int rr = 0; rr < 16; ++rr) bb[rr] = bt[(rr & 3) + 8 * (rr >> 2) + 32];
#pragma unroll
        for (int rr = 0; rr < 16; ++rr) p1[rr] = ((unsigned)((rr & 3) + 8 * (rr >> 2) + 32 + 4 * hi - c0l) < 16u) ? p1[rr] + bb[rr] : -INFINITY; }, after_k, before_v, after_v);
    } else attn_tile_dma(st, qf, Kt, Vt, F.lane, [](f32x16&, f32x16&) {}, after_k, before_v, after_v);
  }
  const float l = st.l + __shfl_xor(st.l, 32);
  int qr = (int)qrow; asm volatile("" : "+v"(qr));
  attn_store_g(st, 1.f / l, gv, Y + (size_t)qr * 1024 + 768 + head * 64, F.lane);
}
}

namespace mk {
struct Attn2 { float l[2]; f32x16 o[2][2]; };
template <class ProbF, class F1, class F2, class F3>
__device__ __forceinline__ void attn2_tile(Attn2& st, const bf16x8 (&qf)[2][4], LAS const unsigned char* Kt, LAS const unsigned char* Vt, int lane, ProbF&& probf, F1&& after_k, F2&& before_v, F3&& after_v) {
  const int r32 = lane & 31, hi = lane >> 5;
  const int ksw = (r32 >> 1) & 7;
  bf16x8 ka[4], kb[4];
#pragma unroll
  for (int s = 0; s < 4; ++s) { const int ch = ((2 * s + hi) ^ ksw) << 4; ka[s] = *(LAS const bf16x8*)(Kt + r32 * 128 + ch); kb[s] = *(LAS const bf16x8*)(Kt + (32 + r32) * 128 + ch); }
  asm volatile("s_waitcnt lgkmcnt(0)" ::: "memory");
  after_k();
  u32x4 pw[2][4];
#pragma unroll
  for (int qb = 0; qb < 2; ++qb) {
    f32x16 p0, p1;
    { const f32x16 z = {0.f, 0.f, 0.f, 0.f, 0.f, 0.f, 0.f, 0.f, 0.f, 0.f, 0.f, 0.f, 0.f, 0.f, 0.f, 0.f};
      p0 = __builtin_amdgcn_mfma_f32_32x32x16_bf16(ka[0], qf[qb][0], z, 0, 0, 0); p1 = __builtin_amdgcn_mfma_f32_32x32x16_bf16(kb[0], qf[qb][0], z, 0, 0, 0); }
#pragma unroll
    for (int s = 1; s < 4; ++s) { p0 = __builtin_amdgcn_mfma_f32_32x32x16_bf16(ka[s], qf[qb][s], p0, 0, 0, 0); p1 = __builtin_amdgcn_mfma_f32_32x32x16_bf16(kb[s], qf[qb][s], p1, 0, 0, 0); }
    probf(qb, p0, p1);
    float ps = 0.f;
#pragma unroll
    for (int i = 0; i < 16; ++i) ps += p0[i] + p1[i];
    st.l[qb] += ps;
#pragma unroll
    for (int k = 0; k < 2; ++k) {
      pw[qb][k] = (u32x4){pk2(p0[8 * k + 0], p0[8 * k + 1]), pk2(p0[8 * k + 2], p0[8 * k + 3]), pk2(p0[8 * k + 4], p0[8 * k + 5]), pk2(p0[8 * k + 6], p0[8 * k + 7])};
      pw[qb][2 + k] = (u32x4){pk2(p1[8 * k + 0], p1[8 * k + 1]), pk2(p1[8 * k + 2], p1[8 * k + 3]), pk2(p1[8 * k + 4], p1[8 * k + 5]), pk2(p1[8 * k + 6], p1[8 * k + 7])};
    }
  }
  before_v();
  const int q = (lane & 15) >> 2, p = lane & 3, gsel = (lane >> 4) & 1;
  const int vrow = (4 * hi + q) * 128 + 8 * (p & 1);
  const int chb = 2 * gsel + (p >> 1);
  s16x4 vl0[4], vh0[4], vl1[4], vh1[4];
#pragma unroll
  for (int ks = 0; ks < 4; ++ks) {
    const int c0_ = ((chb | ((0 ^ (q >> 1)) << 2)) << 4), c1_ = ((chb | ((1 ^ (q >> 1)) << 2)) << 4);
    vl0[ks] = vtr(Vt + ks * 2048 + vrow + c0_); vh0[ks] = vtr(Vt + ks * 2048 + 1024 + vrow + c0_); vl1[ks] = vtr(Vt + ks * 2048 + vrow + c1_); vh1[ks] = vtr(Vt + ks * 2048 + 1024 + vrow + c1_);
  }
  asm volatile("s_waitcnt lgkmcnt(0)" ::: "memory");
  after_v();
#pragma unroll
  for (int ks = 0; ks < 4; ++ks) {
    const bf16x8 va0 = (bf16x8){vl0[ks][0], vl0[ks][1], vl0[ks][2], vl0[ks][3], vh0[ks][0], vh0[ks][1], vh0[ks][2], vh0[ks][3]}, va1 = (bf16x8){vl1[ks][0], vl1[ks][1], vl1[ks][2], vl1[ks][3], vh1[ks][0], vh1[ks][1], vh1[ks][2], vh1[ks][3]};
#pragma unroll
    for (int qb = 0; qb < 2; ++qb) {
      st.o[qb][0] = __builtin_amdgcn_mfma_f32_32x32x16_bf16(va0, __builtin_bit_cast(bf16x8, pw[qb][ks]), st.o[qb][0], 0, 0, 0);
      st.o[qb][1] = __builtin_amdgcn_mfma_f32_32x32x16_bf16(va1, __builtin_bit_cast(bf16x8, pw[qb][ks]), st.o[qb][1], 0, 0, 0);
    }
  }
}
struct DmaLane { unsigned ok0, ok1, ov; };
__device__ __forceinline__ DmaLane dma_lane(int lane) {
  const int kk = lane >> 3, cs = lane & 7; DmaLane d;
  d.ok0 = kk * (PLW * 2) + ((cs ^ (kk >> 1)) << 4); d.ok1 = kk * (PLW * 2) + ((cs ^ (4 + (kk >> 1))) << 4); d.ov = kk * (PLW * 2) + ((cs ^ (((kk >> 1) & 1) << 2)) << 4); return d;
}
__device__ __forceinline__ void dma_tile_k(const bf16* krow0  , const DmaLane& d, unsigned kdst) {
  const unsigned char* tb = (const unsigned char*)krow0;
#pragma unroll
  for (int n = 0; n < 8; ++n) glds16(tb + (size_t)n * 8 * (PLW * 2), (n & 1) ? d.ok1 : d.ok0, kdst + n * 1024);
}
__device__ __forceinline__ void dma_tile_v(const bf16* vrow0, const DmaLane& d, unsigned vdst) {
  const unsigned char* tb = (const unsigned char*)vrow0;
#pragma unroll
  for (int n = 0; n < 8; ++n) glds16(tb + (size_t)n * 8 * (PLW * 2), d.ov, vdst + n * 1024);
}
__device__ __forceinline__ void attn2_exchange(const Attn2& st, int par, AttnState& fin, const Frame& F) {
  LAS float* X = (LAS float*)(F.lds + F.wave * 16384);
  LAS const float* XP = (LAS const float*)(F.lds + (F.wave ^ 1) * 16384);
  if (par == 0) {
#pragma unroll
    for (int i = 0; i < 16; ++i) { X[i * 64 + F.lane] = st.o[1][0][i]; X[(16 + i) * 64 + F.lane] = st.o[1][1][i]; }
    X[32 * 64 + F.lane] = st.l[1];
  } else {
#pragma unroll
    for (int i = 0; i < 16; ++i) { X[i * 64 + F.lane] = st.o[0][0][i]; X[(16 + i) * 64 + F.lane] = st.o[0][1][i]; }
    X[32 * 64 + F.lane] = st.l[0];
  }
  __syncthreads();
  if (par == 0) {
#pragma unroll
    for (int i = 0; i < 16; ++i) { fin.o0[i] = st.o[0][0][i] + XP[i * 64 + F.lane]; fin.o1[i] = st.o[0][1][i] + XP[(16 + i) * 64 + F.lane]; }
    fin.l = st.l[0] + XP[32 * 64 + F.lane];
  } else {
#pragma unroll
    for (int i = 0; i < 16; ++i) { fin.o0[i] = st.o[1][0][i] + XP[i * 64 + F.lane]; fin.o1[i] = st.o[1][1][i] + XP[(16 + i) * 64 + F.lane]; }
    fin.l = st.l[1] + XP[32 * 64 + F.lane];
  }
  fin.m = 0.f;
}
__device__ __forceinline__ void exp_all(f32x16& p0, f32x16& p1) {
#pragma unroll
  for (int i = 0; i < 16; ++i) { p0[i] = __builtin_amdgcn_exp2f(p0[i]); p1[i] = __builtin_amdgcn_exp2f(p1[i]); }
}

__device__ __forceinline__ void na_item2(const Frame& F0, const Args& a, int layer, int item) {
  const Frame F = relaunder(F0);
  unsigned char* ws = opq(a.ws);
  const bf16* PLB = (const bf16*)(ws + WS_PLB); bf16* Y = (bf16*)(ws + WS_H);
  const bool isctx = item >= 256;
  int b, r;
  if (!isctx) { b = item >> 6; r = item & 63; } else { const int ci = item - 256; b = ci >> 2; r = ci & 3; }
  const int head = F.wave >> 1, par = F.wave & 1, r32 = F.lane & 31, hi = F.lane >> 5;
  const size_t qrow0 = isctx ? (size_t)MLAT + b * CTX + 64 * r : (size_t)b * SEQ + 64 * r;
  bf16x8 qf[2][4];
#pragma unroll
  for (int qb = 0; qb < 2; ++qb)
#pragma unroll
    for (int s = 0; s < 4; ++s) qf[qb][s] = *(const bf16x8*)(PLB + (qrow0 + 32 * qb + r32) * PLW + S_DQ * 256 + head * 64 + 16 * s + 8 * hi);
  int rs = r - 4; rs = rs < 0 ? 0 : (rs > 56 ? 56 : rs);
  const int T = isctx ? 4 : 12;
  auto tile_row = [&](int t) -> size_t { return t < 4 ? (size_t)MLAT + b * CTX + 64 * t : (size_t)b * SEQ + 64 * (rs + t - 4); };
  const bf16* kcol = PLB + S_DK * 256 + head * 64; const bf16* vcol = PLB + S_DV * 256 + head * 64;
  LAS float* btab = (LAS float*)(F.lds + 2 * 65536);
  LAS unsigned char* Kt = F.lds + F.wave * 16384; LAS unsigned char* Vt = Kt + 8192;
  const unsigned kdst = (unsigned)(size_t)Kt, vdst = kdst + 8192u;
  const DmaLane dl = dma_lane(F.lane);
  Attn2 st; st.l[0] = 0.f; st.l[1] = 0.f;
#pragma unroll
  for (int i = 0; i < 16; ++i) { st.o[0][0][i] = 0.f; st.o[0][1][i] = 0.f; st.o[1][0][i] = 0.f; st.o[1][1][i] = 0.f; }
#pragma unroll
  for (int qb = 0; qb < 2; ++qb)
#pragma unroll
    for (int s = 0; s < 4; ++s) asm volatile("" : "+v"(qf[qb][s]));
  __syncthreads();
  dma_tile_k(kcol + tile_row(par) * PLW, dl, kdst); dma_tile_v(vcol + tile_row(par) * PLW, dl, vdst);
  {
    const float* rb = opq(a.in[18]) + (size_t)layer * 4 * 15 * 31; float t_[15];
#pragma unroll
    for (int i = 0; i < 15; ++i) { const int ix = F.tid + 512 * i, hd = ix >> 7, dx = (ix & 127) - 63; const int dc = dx < -15 ? -15 : (dx > 15 ? 15 : dx); t_[i] = rb[hd * 31 + dc + 15]; }
    __builtin_amdgcn_sched_barrier(0);
#pragma unroll
    for (int i = 0; i < 15; ++i) { const int dx = ((F.tid + 512 * i) & 127) - 63; btab[F.tid + 512 * i] = (dx >= -15 && dx <= 15) ? t_[i] * LOG2E : 0.f; } }
  __syncthreads();
  const int c00 = r32 < 8 ? 0 : r32 - 8, c01 = r32 > 24 ? 48 : 24 + r32;
  for (int t = par; t < T; t += 2) {
    const bool more = t + 2 < T;
    asm volatile("s_waitcnt vmcnt(8)" ::: "memory");
    auto after_k = [&]() { if (more) dma_tile_k(kcol + tile_row(t + 2) * PLW, dl, kdst); };
    auto before_v = [&]() { if (more) asm volatile("s_waitcnt vmcnt(8)" ::: "memory"); else asm volatile("s_waitcnt vmcnt(0)" ::: "memory"); };
    auto after_v = [&]() { if (more) dma_tile_v(vcol + tile_row(t + 2) * PLW, dl, vdst); };
    if (t >= 4) {
      const int dy = rs + (t - 4) - r + 7;
      unsigned bta = (unsigned)(size_t)(btab + (head * 15 + dy) * 128 + 63 - r32 + 4 * hi); asm volatile("" : "+v"(bta));
      LAS const float* bt = (LAS const float*)bta;
      attn2_tile(st, qf, Kt, Vt, F.lane, [&](int qb, f32x16& p0, f32x16& p1) {
        if (qb == 0) {
#pragma unroll
          for (int rr = 0; rr < 16; ++rr) { const int kc = (rr & 3) + 8 * (rr >> 2); p0[rr] = ((unsigned)(kc + 4 * hi - c00) < 16u) ? __builtin_amdgcn_exp2f(p0[rr] + bt[kc]) : 0.f; }
#pragma unroll
          for (int rr = 0; rr < 4; ++rr) p1[rr] = ((unsigned)(32 + rr + 4 * hi - c00) < 16u) ? __builtin_amdgcn_exp2f(p1[rr] + bt[32 + rr]) : 0.f;
#pragma unroll
          for (int rr = 4; rr < 16; ++rr) p1[rr] = 0.f;
        } else {
#pragma unroll
          for (int rr = 0; rr < 12; ++rr) p0[rr] = 0.f;
#pragma unroll
          for (int rr = 12; rr < 16; ++rr) p0[rr] = ((unsigned)(12 + rr + 4 * hi - c01) < 16u) ? __builtin_amdgcn_exp2f(p0[rr] + bt[12 + rr - 32]) : 0.f;
#pragma unroll
          for (int rr = 0; rr < 16; ++rr) { const int kc = 32 + (rr & 3) + 8 * (rr >> 2); p1[rr] = ((unsigned)(kc + 4 * hi - c01) < 16u) ? __builtin_amdgcn_exp2f(p1[rr] + bt[kc - 32]) : 0.f; }
        } }, after_k, before_v, after_v);
    } else attn2_tile(st, qf, Kt, Vt, F.lane, [](int, f32x16& p0, f32x16& p1) { exp_all(p0, p1); }, after_k, before_v, after_v);
  }
  AttnState fin;
  attn2_exchange(st, par, fin, F);
  const float l = fin.l + __shfl_xor(fin.l, 32);
  int qr = (int)qrow0 + 32 * par + r32; asm volatile("" : "+v"(qr));
  attn_store(fin, 1.f / l, PLB + (size_t)qr * PLW + S_DG * 256 + head * 64, Y + (size_t)qr * 1024 + 768 + head * 64, F.lane);
}

__device__ __forceinline__ void swa_item2(const Frame& F0, const Args& a, int layer, int item) {
  const Frame F = relaunder(F0);
  unsigned char* ws = opq(a.ws);
  const bf16* PLB = (const bf16*)(ws + WS_PLB); bf16* Y = (bf16*)(ws + WS_H);
  const bool isctx = item >= 256;
  int b, kvh, n;
  if (!isctx) { b = item >> 6; kvh = (item >> 5) & 1; n = item & 31; } else { const int ci = item - 256; b = ci >> 2; kvh = (ci >> 1) & 1; n = ci & 1; }
  const int quarter = F.wave >> 1, par = F.wave & 1, r32 = F.lane & 31, hi = F.lane >> 5;
  const int q0 = 128 * n + 32 * quarter, tq = q0 + r32;
  const size_t qrow = isctx ? (size_t)MLAT + b * CTX + tq : (size_t)b * SEQ + tq;
  bf16x8 qf[2][4];
#pragma unroll
  for (int g = 0; g < 2; ++g)
#pragma unroll
    for (int s = 0; s < 4; ++s) qf[g][s] = *(const bf16x8*)(PLB + qrow * PLW + S_CQ * 256 + (2 * kvh + g) * 64 + 16 * s + 8 * hi);
  unsigned need = 0x3C0u;
  if (!isctx) {
#pragma unroll
    for (int hk = 0; hk < 6; ++hk) { const int kb = 128 * (n - 1) + 64 * hk; if (kb >= 0 && kb < SEQ && !(kb + 63 < q0 - 128 || kb > q0 + 31 + 128)) need |= 1u << hk; }
  }
  need = (unsigned)__builtin_amdgcn_readfirstlane((int)need);
  if (par) need &= need - 1u;
  auto tile_row = [&](int hk) -> size_t { return hk < 6 ? (size_t)b * SEQ + 128 * (n - 1) + 64 * hk : (size_t)MLAT + b * CTX + 64 * (hk - 6); };
  const bf16* kcol = PLB + S_CKV * 256 + kvh * 64; const bf16* vcol = kcol + 128;
  LAS unsigned char* Kt = F.lds + F.wave * 16384; LAS unsigned char* Vt = Kt + 8192;
  const unsigned kdst = (unsigned)(size_t)Kt, vdst = kdst + 8192u;
  const DmaLane dl = dma_lane(F.lane);
  Attn2 st; st.l[0] = 0.f; st.l[1] = 0.f;
#pragma unroll
  for (int i = 0; i < 16; ++i) { st.o[0][0][i] = 0.f; st.o[0][1][i] = 0.f; st.o[1][0][i] = 0.f; st.o[1][1][i] = 0.f; }
#pragma unroll
  for (int g = 0; g < 2; ++g)
#pragma unroll
    for (int s = 0; s < 4; ++s) asm volatile("" : "+v"(qf[g][s]));
  __syncthreads();
  if (need) { const int t0 = __builtin_ctz(need); dma_tile_k(kcol + tile_row(t0) * PLW, dl, kdst); dma_tile_v(vcol + tile_row(t0) * PLW, dl, vdst); }
  while (need) {
    const int t = __builtin_ctz(need);
    need &= need - 1u; need &= need - 1u;
    const bool more = need != 0u;
    const int tn = more ? __builtin_ctz(need) : 0;
    asm volatile("s_waitcnt vmcnt(8)" ::: "memory");
    auto after_k = [&]() { if (more) dma_tile_k(kcol + tile_row(tn) * PLW, dl, kdst); };
    auto before_v = [&]() { if (more) asm volatile("s_waitcnt vmcnt(8)" ::: "memory"); else asm volatile("s_waitcnt vmcnt(0)" ::: "memory"); };
    auto after_v = [&]() { if (more) dma_tile_v(vcol + tile_row(tn) * PLW, dl, vdst); };
    const int kb = 128 * (n - 1) + 64 * t;
    if (t < 6 && !(kb >= q0 + 31 - 128 && kb + 63 <= q0 + 128)) {
      const int dq = kb - tq + 128;
      attn2_tile(st, qf, Kt, Vt, F.lane, [&](int, f32x16& p0, f32x16& p1) {
#pragma unroll
        for (int rr = 0; rr < 16; ++rr) { const int d0_ = dq + crow(rr, hi), d1_ = d0_ + 32;
          p0[rr] = ((unsigned)d0_ <= 256u) ? __builtin_amdgcn_exp2f(p0[rr]) : 0.f; p1[rr] = ((unsigned)d1_ <= 256u) ? __builtin_amdgcn_exp2f(p1[rr]) : 0.f; } }, after_k, before_v, after_v);
    } else attn2_tile(st, qf, Kt, Vt, F.lane, [](int, f32x16& p0, f32x16& p1) { exp_all(p0, p1); }, after_k, before_v, after_v);
  }
  AttnState fin;
  attn2_exchange(st, par, fin, F);
  const int hq = 2 * kvh + par;
  float l = fin.l + __shfl_xor(fin.l, 32);
  const float sk2 = opq(a.in[15])[layer * 4 + hq] * LOG2E;
  const float mnew = fmaxf(0.f, sk2), al = __builtin_amdgcn_exp2f(-mnew);
  l = l * al + __builtin_amdgcn_exp2f(sk2 - mnew);
  int qr = (int)qrow; asm volatile("" : "+v"(qr));
  attn_store(fin, al / l, PLB + (size_t)qr * PLW + S_CG * 256 + hq * 64, Y + (size_t)qr * 1024 + 512 + hq * 64, F.lane);
}
}

namespace mk {
constexpr int XT_STRIDE = 272;
constexpr int FFT_WC = 256 * XT_STRIDE;
__device__ __forceinline__ void fft_item(const Frame& F0, const Args& a, int item) {
  const Frame F = relaunder(F0);
  unsigned char* ws = opq(a.ws);
  const bf16* PLB = (const bf16*)(ws + WS_PLB); bf16* Y = (bf16*)(ws + WS_H);
  const int b = item >> 6, slice = item & 63, r32 = F.lane & 31, hi = F.lane >> 5, w = F.wave;
  LAS unsigned char* Xt = F.lds; LAS unsigned char* Wl = F.lds + FFT_WC;
  __syncthreads();
  {
    const bf16* WC = (const bf16*)(ws + WS_WC);
    u32x4 wt[4];
#pragma unroll
    for (int i = 0; i < 4; ++i) { const int idx = F.tid + 512 * i, row = idx >> 4, ch = idx & 15; wt[i] = *(const u32x4*)(WC + row * 128 + ch * 8); }
    const bf16* src = (const bf16*)(ws + WS_FA2) + ((size_t)b * 64 + slice) * TROW * 8;
    u32x4 v[8];
#pragma unroll
    for (int i = 0; i < 8; ++i) v[i] = *(const u32x4*)(src + (size_t)(F.lane + 64 * (8 * w + i)) * 8);
    __builtin_amdgcn_sched_barrier(0);
#pragma unroll
    for (int i = 0; i < 4; ++i) { const int idx = F.tid + 512 * i, row = idx >> 4, ch = idx & 15; *(LAS u32x4*)(Wl + row * XT_STRIDE + ch * 16) = wt[i]; }
#pragma unroll
    for (int cc = 0; cc < 4; ++cc)
#pragma unroll
      for (int part = 0; part < 2; ++part) { const int e = cc + 4 * part, d = e >> 1; const unsigned sel = (e & 1) ? 0x07060302u : 0x05040100u;
        u32x4 o;
        o.x = __builtin_amdgcn_perm(v[1][d], v[0][d], sel); o.y = __builtin_amdgcn_perm(v[3][d], v[2][d], sel);
        o.z = __builtin_amdgcn_perm(v[5][d], v[4][d], sel); o.w = __builtin_amdgcn_perm(v[7][d], v[6][d], sel);
        *(LAS u32x4*)(Xt + (64 * cc + F.lane) * XT_STRIDE + (part * 64 + 8 * w) * 2) = o; }
  }
  __syncthreads();
  f32x16 acc[4];
#pragma unroll
  for (int rb = 0; rb < 4; ++rb)
#pragma unroll
    for (int i = 0; i < 16; ++i) acc[rb][i] = 0.f;
  {
    bf16x8 bf[8];
#pragma unroll
    for (int s = 0; s < 8; ++s) bf[s] = *(LAS const bf16x8*)(Xt + (32 * w + r32) * XT_STRIDE + (16 * s + 8 * hi) * 2);
#pragma unroll
    for (int rb = 0; rb < 4; ++rb)
#pragma unroll
      for (int s = 0; s < 8; ++s) { const bf16x8 af = *(LAS const bf16x8*)(Wl + (32 * rb + r32) * XT_STRIDE + (16 * s + 8 * hi) * 2); acc[rb] = __builtin_amdgcn_mfma_f32_32x32x16_bf16(af, bf[s], acc[rb], 0, 0, 0); }
  }
  __syncthreads();
  {
    const int n2 = 32 * (w & 1) + r32, c = w >> 1;
#pragma unroll
    for (int rbp = 0; rbp < 2; ++rbp)
#pragma unroll
      for (int r = 0; r < 16; ++r) { const int k1 = 32 * rbp + crow(r, hi); float x = (float)((k1 * n2) & 4095) * (1.f / 4096.f);
        asm volatile("" : "+v"(x) :: "memory");
        const float tc = __builtin_amdgcn_cosf(x), ts = __builtin_amdgcn_sinf(x);
        const float yr = acc[rbp][r], yi = acc[rbp + 2][r];
        const float zr = yr * tc + yi * ts, zi = yi * tc - yr * ts;
        LAS unsigned char* zp = Xt + (k1 * 4 + c) * XT_STRIDE + n2 * 2;
        *(LAS unsigned short*)zp = (unsigned short)f2bf(zr); *(LAS unsigned short*)(zp + 128) = (unsigned short)f2bf(zi); }
  }
  __syncthreads();
  f32x16 o2[2];
#pragma unroll
  for (int rb = 0; rb < 2; ++rb)
#pragma unroll
    for (int i = 0; i < 16; ++i) o2[rb][i] = 0.f;
  {
    bf16x8 bf[8];
#pragma unroll
    for (int s = 0; s < 8; ++s) bf[s] = *(LAS const bf16x8*)(Xt + (32 * w + r32) * XT_STRIDE + (16 * s + 8 * hi) * 2);
#pragma unroll
    for (int rb = 0; rb < 2; ++rb)
#pragma unroll
      for (int s = 0; s < 8; ++s) { const bf16x8 af = *(LAS const bf16x8*)(Wl + (32 * rb + r32) * XT_STRIDE + (16 * s + 8 * hi) * 2); o2[rb] = __builtin_amdgcn_mfma_f32_32x32x16_bf16(af, bf[s], o2[rb], 0, 0, 0); }
  }
  __syncthreads();
  { const int k1 = 8 * w + (r32 >> 2), c = r32 & 3;
#pragma unroll
    for (int rb = 0; rb < 2; ++rb)
#pragma unroll
      for (int r = 0; r < 16; ++r) { const int k = k1 + 64 * (32 * rb + crow(r, hi)); *(LAS unsigned short*)(Xt + k * 8 + c * 2) = (unsigned short)f2bf(o2[rb][r]); }
  }
  __syncthreads();
  { const int o0 = 4 * slice; u32x2 gv[8];
#pragma unroll
    for (int i = 0; i < 8; ++i) gv[i] = *(const u32x2*)(PLB + ((size_t)b * SEQ + F.tid + 512 * i) * PLW + S_BG * 256 + o0);
    __builtin_amdgcn_sched_barrier(0);
#pragma unroll
    for (int i = 0; i < 8; ++i) { const int k = F.tid + 512 * i; const size_t row = (size_t)b * SEQ + k;
      const u32x2 ov = *(LAS const u32x2*)(Xt + k * 8);
      u32x2 y; y.x = pk2(__uint_as_float(ov.x << 16) * __uint_as_float(gv[i].x << 16), __uint_as_float(ov.x & 0xffff0000u) * __uint_as_float(gv[i].x & 0xffff0000u));
      y.y = pk2(__uint_as_float(ov.y << 16) * __uint_as_float(gv[i].y << 16), __uint_as_float(ov.y & 0xffff0000u) * __uint_as_float(gv[i].y & 0xffff0000u));
      *(u32x2*)(Y + row * 1024 + 256 + o0) = y; }
  }
}
constexpr int XC_STRIDE = 1040;
__device__ __forceinline__ void fftc_item(const Frame& F0, const Args& a, int item) {
  const Frame F = relaunder(F0);
  unsigned char* ws = opq(a.ws);
  const bf16* PLB = (const bf16*)(ws + WS_PLB); bf16* Y = (bf16*)(ws + WS_H);
  const bf16* CS = (const bf16*)(ws + WS_CS256);
  const int b = item >> 3, cs = item & 7, r32 = F.lane & 31, hi = F.lane >> 5, w = F.wave;
  LAS unsigned char* Xc = F.lds;
  __syncthreads();
  u32x4 vq[4];
#pragma unroll
  for (int i = 0; i < 4; ++i) { const int idx = F.tid + 512 * i, sl = idx >> 8, n = idx & 255;
    vq[i] = *(const u32x4*)((const bf16*)(ws + WS_FA2) + (((size_t)b * 64 + 8 * cs + sl) * TROW + SEQ + n) * 8); }
  __builtin_amdgcn_sched_barrier(0);
#pragma unroll
  for (int i = 0; i < 4; ++i) { const int idx = F.tid + 512 * i, sl = idx >> 8, n = idx & 255;
    const unsigned vv[4] = {vq[i].x, vq[i].y, vq[i].z, vq[i].w};
#pragma unroll
    for (int j = 0; j < 8; ++j) { const int c = j & 3, part = j >> 2; const unsigned short e = (unsigned short)((j & 1) ? (vv[j >> 1] >> 16) : (vv[j >> 1] & 0xffffu));
      *(LAS unsigned short*)(Xc + (4 * sl + c) * XC_STRIDE + (part * 256 + n) * 2) = e; } }
  __syncthreads();
  f32x16 acc;
#pragma unroll
  for (int i = 0; i < 16; ++i) acc[i] = 0.f;
#pragma unroll 1
  for (int s0 = 0; s0 < 32; s0 += 8) {
    bf16x8 af[8];
#pragma unroll
    for (int j = 0; j < 8; ++j) af[j] = *(const bf16x8*)(CS + (size_t)(32 * w + r32) * 512 + 16 * (s0 + j) + 8 * hi);
    __builtin_amdgcn_sched_barrier(0);
#pragma unroll
    for (int j = 0; j < 8; ++j) {
      const bf16x8 bf = *(LAS const bf16x8*)(Xc + r32 * XC_STRIDE + (16 * (s0 + j) + 8 * hi) * 2);
      acc = __builtin_amdgcn_mfma_f32_32x32x16_bf16(af[j], bf, acc, 0, 0, 0);
    }
  }
  const int o = 32 * cs + r32;
  bf16 gq[16];
#pragma unroll
  for (int r = 0; r < 16; ++r) { const size_t row = (size_t)MLAT + b * CTX + 32 * w + crow(r, hi); gq[r] = PLB[row * PLW + S_BG * 256 + o]; }
  __builtin_amdgcn_sched_barrier(0);
#pragma unroll
  for (int r = 0; r < 16; ++r) { const size_t row = (size_t)MLAT + b * CTX + 32 * w + crow(r, hi);
    Y[row * 1024 + 256 + o] = (bf16)f2bf(acc[r] * bf2f(gq[r])); }
}
}

namespace mk {
constexpr int GU_STRIDE = 2048 + 64;
constexpr size_t WS_GU = WS_SCR, WS_GS = WS_GU + (size_t)32 * 68 * GU_STRIDE * 4;
__device__ __forceinline__ size_t gla_row(int b, int c, int i) { return c < 64 ? (size_t)b * SEQ + 64 * c + i : (size_t)MLAT + b * CTX + 64 * (c - 64) + i; }
__device__ __forceinline__ int gla_pos(int c, int dir) { return c < 64 ? (dir ? 4 + 63 - c : 4 + c) : (dir ? 3 - (c - 64) : (c - 64)); }
__device__ __forceinline__ void gla_stage_v(const Frame& F, const bf16* PLB, int b, int c, LAS unsigned char* vbase) {
  const int key = F.tid >> 3, ch = F.tid & 7;
  const bf16* src = PLB + gla_row(b, c, key) * PLW + S_AV * 256 + ch * 8;
  const int vo = key * 128 + ((ch ^ (((key >> 1) & 1) << 2)) << 4);
  u32x4 t_[4];
#pragma unroll
  for (int h = 0; h < 4; ++h) t_[h] = *(const u32x4*)(src + h * 64);
#pragma unroll
  for (int h = 0; h < 4; ++h) *(LAS u32x4*)(vbase + h * 8192 + vo) = t_[h];
}
__device__ __forceinline__ void gla_cum(const float* LA, int b, int c, int h, int dir, int lane, float (&cw)[32], float& T) {
  const int d = lane & 31, half = lane >> 5;
  float a[32];
#pragma unroll
  for (int ii = 0; ii < 32; ++ii) a[ii] = LA[gla_row(b, c, 32 * half + ii) * 256 + dir * 128 + h * 32 + d];
  float run = 0.f;
#pragma unroll
  for (int ii = 0; ii < 32; ++ii) { run += a[ii]; cw[ii] = run; }
  const float other = __shfl_xor(run, 32);
  const float tot0 = half ? other : run;
  T = run + other;
#pragma unroll
  for (int ii = 0; ii < 32; ++ii) { const float cf = cw[ii] + (half ? tot0 : 0.f); cw[ii] = dir ? (T - cf + a[ii]) : cf; }
}
constexpr int KT_STRIDE = 144;
__device__ __forceinline__ void gla_local_item(const Frame& F0, const Args& a, int item) {
  const Frame F = relaunder(F0);
  unsigned char* ws = opq(a.ws);
  const bf16* PLB = (const bf16*)(ws + WS_PLB); const float* LA = (const float*)(ws + WS_LA);
  const int b = item / 68, c = item % 68, h = F.wave >> 1, dir = F.wave & 1, d = F.lane & 31, half = F.lane >> 5, r32 = d, hi = half;
  LAS unsigned char* Vt = F.lds + h * 8192; LAS unsigned char* KT = F.lds + 32768 + F.wave * (32 * KT_STRIDE);
  __syncthreads();
  gla_stage_v(F, PLB, b, c, F.lds);
  float cw[32], T;
  gla_cum(LA, b, c, h, dir, F.lane, cw, T);
  {
    unsigned pkd[16]; bf16 kr[32];
    const bf16* kp = PLB + gla_row(b, c, 32 * half) * PLW + S_AQK * 256 + 128 + h * 32 + d;
#pragma unroll
    for (int ii = 0; ii < 32; ++ii) kr[ii] = kp[(size_t)ii * PLW];
#pragma unroll
    for (int ii = 0; ii < 32; ii += 2) pkd[ii >> 1] = pk2(bf2f(kr[ii]) * __expf(T - cw[ii]), bf2f(kr[ii + 1]) * __expf(T - cw[ii + 1]));
#pragma unroll
    for (int q4 = 0; q4 < 4; ++q4) *(LAS u32x4*)(KT + d * KT_STRIDE + half * 64 + q4 * 16) = (u32x4){pkd[4 * q4], pkd[4 * q4 + 1], pkd[4 * q4 + 2], pkd[4 * q4 + 3]};
  }
  __syncthreads();
  f32x16 acc[2];
#pragma unroll
  for (int eb = 0; eb < 2; ++eb)
#pragma unroll
    for (int i = 0; i < 16; ++i) acc[eb][i] = 0.f;
  const int q = (F.lane & 15) >> 2, p = F.lane & 3, gsel = (F.lane >> 4) & 1;
  const int chb = 2 * gsel + (p >> 1);
#pragma unroll
  for (int st = 0; st < 4; ++st) {
    const bf16x8 kb = *(LAS const bf16x8*)(KT + r32 * KT_STRIDE + (16 * st + 8 * hi) * 2);
#pragma unroll
    for (int eb = 0; eb < 2; ++eb) {
      const int ch = ((chb | ((eb ^ (q >> 1)) << 2)) << 4);
      LAS const unsigned char* vp = Vt + (16 * st + 8 * hi + q) * 128 + 8 * (p & 1) + ch;
      const s16x4 lo = vtr(vp), hh = vtr(vp + 512);
      const bf16x8 va = (bf16x8){lo[0], lo[1], lo[2], lo[3], hh[0], hh[1], hh[2], hh[3]};
      acc[eb] = __builtin_amdgcn_mfma_f32_32x32x16_bf16(va, kb, acc[eb], 0, 0, 0);
    }
  }
  const int chain = (b * 4 + h) * 2 + dir, pos = gla_pos(c, dir);
  float* gu = (float*)(ws + WS_GU) + ((size_t)chain * 68 + pos) * GU_STRIDE;
#pragma unroll
  for (int eb = 0; eb < 2; ++eb)
#pragma unroll
    for (int r = 0; r < 16; ++r) gu[(32 * eb + crow(r, hi)) * 32 + r32] = acc[eb][r];
  if (half == 0) gu[2048 + d] = __expf(T);
}
__device__ __forceinline__ void gla_scan(const Frame& F0, const Args& a) {
  const Frame F = relaunder(F0);
  unsigned char* ws = opq(a.ws);
  if (F.tid >= 256) return;
  for (int gt = F.vcu * 256 + F.tid; gt < 32 * 2048; gt += F.G * 256) {
    const int chain = gt >> 11, el = gt & 2047, d = el & 31;
    const float* gu = (const float*)(ws + WS_GU) + (size_t)chain * 68 * GU_STRIDE;
    bf16* gs = (bf16*)(ws + WS_GS) + (size_t)chain * 68 * 2048 + el;
    float S = 0.f;
#pragma unroll 1
    for (int p0 = 0; p0 < 68; p0 += 34) {
      float dc[34], uu[34];
#pragma unroll
      for (int i = 0; i < 34; ++i) { dc[i] = gu[(size_t)(p0 + i) * GU_STRIDE + 2048 + d]; uu[i] = gu[(size_t)(p0 + i) * GU_STRIDE + el]; }
      __builtin_amdgcn_sched_barrier(0);
#pragma unroll
      for (int i = 0; i < 34; ++i) { gs[(size_t)(p0 + i) * 2048] = (bf16)f2bf(S); S = dc[i] * S + uu[i]; }
    }
  }
}
constexpr int QK_STRIDE = 80;
__device__ __forceinline__ void gla_out_item(const Frame& F0, const Args& a, int layer, int item) {
  const Frame F = relaunder(F0);
  unsigned char* ws = opq(a.ws);
  const bf16* PLB = (const bf16*)(ws + WS_PLB); const float* LA = (const float*)(ws + WS_LA); bf16* Y = (bf16*)(ws + WS_H);
  const int b = item / 68, c = item % 68, h = F.wave >> 1, dir = F.wave & 1, d = F.lane & 31, half = F.lane >> 5, r32 = d, hi = half;
  LAS unsigned char* Vt = F.lds + h * 8192;
  LAS unsigned char* QT = F.lds + 32768 + F.wave * (2 * 64 * QK_STRIDE); LAS unsigned char* KT = QT + 64 * QK_STRIDE;
  LAS float* X = (LAS float*)(F.lds + 32768) + h * 4096;
  __syncthreads();
  gla_stage_v(F, PLB, b, c, F.lds);
  {
    float cw[32], T;
    gla_cum(LA, b, c, h, dir, F.lane, cw, T);
    bf16 qr[32], kr[32];
    const bf16* pr = PLB + gla_row(b, c, 32 * half) * PLW + S_AQK * 256 + h * 32 + d;
#pragma unroll
    for (int ii = 0; ii < 32; ++ii) { qr[ii] = pr[(size_t)ii * PLW]; kr[ii] = pr[(size_t)ii * PLW + 128]; }
#pragma unroll
    for (int ii = 0; ii < 32; ++ii) { const int i = 32 * half + ii;
      const float ec = __expf(cw[ii]);
      *(LAS unsigned short*)(QT + i * QK_STRIDE + d * 2) = (unsigned short)f2bf(bf2f(qr[ii]) * ec);
      *(LAS unsigned short*)(KT + i * QK_STRIDE + d * 2) = (unsigned short)f2bf(bf2f(kr[ii]) * __builtin_amdgcn_rcpf(ec)); }
  }
  __syncthreads();
  f32x16 oacc[2][2];
#pragma unroll
  for (int eb = 0; eb < 2; ++eb)
#pragma unroll
    for (int ib = 0; ib < 2; ++ib)
#pragma unroll
      for (int i = 0; i < 16; ++i) oacc[eb][ib][i] = 0.f;
  bf16x8 qb[2][2];
#pragma unroll
  for (int ib = 0; ib < 2; ++ib)
#pragma unroll
    for (int st = 0; st < 2; ++st) qb[ib][st] = *(LAS const bf16x8*)(QT + (32 * ib + r32) * QK_STRIDE + (16 * st + 8 * hi) * 2);
  const int chain = (b * 4 + h) * 2 + dir, pos = gla_pos(c, dir);
  {
    const bf16* gs = (const bf16*)(ws + WS_GS) + ((size_t)chain * 68 + pos) * 2048;
#pragma unroll
    for (int eb = 0; eb < 2; ++eb)
#pragma unroll
      for (int st = 0; st < 2; ++st) { const bf16x8 sf = *(const bf16x8*)(gs + (32 * eb + r32) * 32 + 16 * st + 8 * hi);
#pragma unroll
        for (int ib = 0; ib < 2; ++ib) oacc[eb][ib] = __builtin_amdgcn_mfma_f32_32x32x16_bf16(sf, qb[ib][st], oacc[eb][ib], 0, 0, 0); }
  }
  const int q = (F.lane & 15) >> 2, p = F.lane & 3, gsel = (F.lane >> 4) & 1;
  const int vrow = (4 * hi + q) * 128 + 8 * (p & 1), chb = 2 * gsel + (p >> 1);
#pragma unroll
  for (int sb = 0; sb < 2; ++sb) {
    bf16x8 kf[2];
#pragma unroll
    for (int st = 0; st < 2; ++st) kf[st] = *(LAS const bf16x8*)(KT + (32 * sb + r32) * QK_STRIDE + (16 * st + 8 * hi) * 2);
#pragma unroll
    for (int ib = 0; ib < 2; ++ib) {
      const bool need = dir == 0 ? (sb <= ib) : (sb >= ib);
      if (!need) continue;
      f32x16 sc;
#pragma unroll
      for (int i = 0; i < 16; ++i) sc[i] = 0.f;
#pragma unroll
      for (int st = 0; st < 2; ++st) sc = __builtin_amdgcn_mfma_f32_32x32x16_bf16(kf[st], qb[ib][st], sc, 0, 0, 0);
      if (sb == ib) {
#pragma unroll
        for (int r = 0; r < 16; ++r) { const int s = crow(r, hi); const bool keep = dir == 0 ? (s <= r32) : (s >= r32); sc[r] = keep ? sc[r] : 0.f; }
      }
      u32x4 pw[2];
#pragma unroll
      for (int k = 0; k < 2; ++k) pw[k] = (u32x4){pk2(sc[8 * k + 0], sc[8 * k + 1]), pk2(sc[8 * k + 2], sc[8 * k + 3]), pk2(sc[8 * k + 4], sc[8 * k + 5]), pk2(sc[8 * k + 6], sc[8 * k + 7])};
#pragma unroll
      for (int ks = 0; ks < 2; ++ks)
#pragma unroll
        for (int eb = 0; eb < 2; ++eb) {
          const int ch = ((chb | ((eb ^ (q >> 1)) << 2)) << 4);
          const s16x4 lo = vtr(Vt + (2 * sb + ks) * 2048 + vrow + ch), hh = vtr(Vt + (2 * sb + ks) * 2048 + 1024 + vrow + ch);
          const bf16x8 va = (bf16x8){lo[0], lo[1], lo[2], lo[3], hh[0], hh[1], hh[2], hh[3]};
          oacc[eb][ib] = __builtin_amdgcn_mfma_f32_32x32x16_bf16(va, __builtin_bit_cast(bf16x8, pw[ks]), oacc[eb][ib], 0, 0, 0);
        }
    }
  }
  __syncthreads();
  if (dir == 1) {
#pragma unroll
    for (int eb = 0; eb < 2; ++eb)
#pragma unroll
      for (int ib = 0; ib < 2; ++ib)
#pragma unroll
        for (int r = 0; r < 16; ++r) X[((eb * 2 + ib) * 16 + r) * 64 + F.lane] = oacc[eb][ib][r];
  }
  __syncthreads();
  if (dir == 0) {
    const float* on = opq(a.in[11]) + layer * 64;
    f32x4 w4s[8];
#pragma unroll
    for (int i = 0; i < 8; ++i) w4s[i] = *(const f32x4*)(on + 32 * (i >> 2) + 8 * (i & 3) + 4 * hi);
#pragma unroll
    for (int ib = 0; ib < 2; ++ib) {
      float ss = 0.f;
#pragma unroll
      for (int eb = 0; eb < 2; ++eb)
#pragma unroll
        for (int r = 0; r < 16; ++r) { oacc[eb][ib][r] += X[((eb * 2 + ib) * 16 + r) * 64 + F.lane]; ss += oacc[eb][ib][r] * oacc[eb][ib][r]; }
      ss += __shfl_xor(ss, 32);
      const float rs = 1.0f / sqrtf(ss * (1.f / 64.f) + 1e-6f);
      const size_t row = gla_row(b, c, 32 * ib + r32);
      u32x2 gv8[8];
#pragma unroll
      for (int i = 0; i < 8; ++i) gv8[i] = *(const u32x2*)(PLB + row * PLW + S_AG * 256 + h * 64 + 32 * (i >> 2) + 8 * (i & 3) + 4 * hi);
      __builtin_amdgcn_sched_barrier(0);
#pragma unroll
      for (int eb = 0; eb < 2; ++eb)
#pragma unroll
        for (int gi = 0; gi < 4; ++gi) {
          const int e0 = 32 * eb + 8 * gi + 4 * hi;
          const f32x4 w4 = w4s[4 * eb + gi];
          const u32x2 gv = gv8[4 * eb + gi];
          const float g0 = __uint_as_float(gv.x << 16), g1 = __uint_as_float(gv.x & 0xffff0000u), g2 = __uint_as_float(gv.y << 16), g3 = __uint_as_float(gv.y & 0xffff0000u);
          u32x2 ov; ov.x = pk2(oacc[eb][ib][4 * gi + 0] * rs * w4[0] * g0, oacc[eb][ib][4 * gi + 1] * rs * w4[1] * g1);
          ov.y = pk2(oacc[eb][ib][4 * gi + 2] * rs * w4[2] * g2, oacc[eb][ib][4 * gi + 3] * rs * w4[3] * g3);
          *(u32x2*)(Y + row * 1024 + h * 64 + e0) = ov;
        }
    }
  }
}
}

namespace mk {
__device__ __forceinline__ void p3_mixers(const Frame& F0, const Args& a, int layer) {
  const Frame F = relaunder(F0);
  const int nx = layer == 0 ? 16 : 0, nswa = 256 + nx, nna = 256 + nx, nfc = layer == 0 ? 32 : 0;
  for (int it = F.vcu; it < 272 + 256 + nfc + nswa + nna; it += F.G) {
    int r = it;
    if (r < 272) { gla_local_item(F, a, r); continue; } r -= 272;
    if (r < 256) { fft_item(F, a, r); continue; } r -= 256;
    if (r < nfc) { fftc_item(F, a, r); continue; } r -= nfc;
    if (r < nswa) swa_item(F, a, layer, r); else na_item(F, a, layer, r - nswa);
  }
}
__device__ __forceinline__ void p4b_glaout(const Frame& F0, const Args& a, int layer) {
  const Frame F = relaunder(F0);
  if (layer == 1) { for (int it = F.vcu; it < 256; it += F.G) gla_out_item(F, a, layer, (it >> 6) * 68 + (it & 63)); }
  else for (int it = F.vcu; it < 272; it += F.G) gla_out_item(F, a, layer, it);
}
}
#define XB_TMO      128
#define XB_XCNT(j)  (256  + 64 * (j))
#define XB_XSUB(j)  (1280 + 64 * (j))
#define XB_XGEN(j)  (2304 + 64 * (j))
#define XB_TOP      3328
#define XB_TOPGEN   3392
#define XCD_BAR_WORDS 3456
#define XB_SPIN_CAP (1u << 18)

__device__ __forceinline__ unsigned xb_ld(unsigned* p)              { return __hip_atomic_load(p, __ATOMIC_RELAXED, __HIP_MEMORY_SCOPE_AGENT); }
__device__ __forceinline__ unsigned xb_add(unsigned* p, unsigned v) { return __hip_atomic_fetch_add(p, v, __ATOMIC_RELAXED, __HIP_MEMORY_SCOPE_AGENT); }
__device__ __forceinline__ unsigned xb_xcc_id() { return (unsigned)__builtin_amdgcn_s_getreg((3 << 11) | 20) & 0xFu; }
#define XB_SPIN(cond, bar) do { unsigned _sp = 0; while (cond) { __builtin_amdgcn_s_sleep(1); \
    if ((++_sp & 255u) == 0u) { if (xb_ld(&(bar)[XB_TMO])) break; if (_sp > XB_SPIN_CAP) { atomicAdd(&(bar)[XB_TMO], 1u); break; } } } } while (0)

struct XcdBarrier {
    unsigned* bar; unsigned x;
    volatile LAS unsigned* st;
};

__device__ __forceinline__ XcdBarrier xcd_barrier_post(unsigned* bar, volatile LAS unsigned* st) {
    XcdBarrier b; b.bar = bar; b.x = xb_xcc_id(); b.st = st;
    if (threadIdx.x == 0) (void)xb_add(&bar[XB_XCNT(b.x)], 1u);
    return b;
}
__device__ __forceinline__ void xcd_barrier_complete(unsigned* bar, unsigned x, unsigned& nloc, unsigned& nx) {
    const unsigned G = gridDim.x * gridDim.y * gridDim.z;
    unsigned sum, cnt, mine, sp = 0u;
    for (;;) {
        sum = 0u; cnt = 0u; mine = 0u;
#pragma unroll
        for (unsigned j = 0; j < 16; ++j) { const unsigned c = xb_ld(&bar[XB_XCNT(j)]); sum += c; cnt += (c > 0u) ? 1u : 0u; }
        mine = xb_ld(&bar[XB_XCNT(x)]);
        if (sum == G) break;
        __builtin_amdgcn_s_sleep(1);
        if ((++sp & 255u) == 0u) { if (xb_ld(&bar[XB_TMO])) break; if (sp > XB_SPIN_CAP) { atomicAdd(&bar[XB_TMO], 1u); break; } }
    }
    nloc = mine > 0u ? mine : 1u; nx = cnt > 0u ? cnt : 1u;
}

__device__ __forceinline__ void xcd_barrier(const XcdBarrier& b) {
    asm volatile("s_waitcnt vmcnt(0)" ::: "memory");
    __syncthreads();
    if (threadIdx.x == 0) {
        unsigned* bar = b.bar;
        __builtin_amdgcn_s_waitcnt(0);
        unsigned nloc = b.st[0], nx = b.st[1];
        if (nloc == 0u) { xcd_barrier_complete(bar, b.x, nloc, nx); b.st[0] = nloc; b.st[1] = nx; }
        const unsigned old = xb_add(&bar[XB_XSUB(b.x)], 1u);
        const unsigned gen = old / nloc;
        if (old + 1u == (gen + 1u) * nloc) {
            __builtin_amdgcn_fence(__ATOMIC_RELEASE, "agent");
            asm volatile("s_waitcnt vmcnt(0)" ::: "memory");
            const unsigned og = xb_add(&bar[XB_TOP], 1u);
            const unsigned tg = og / nx;
            if (og + 1u == (tg + 1u) * nx) xb_add(&bar[XB_TOPGEN], 1u);
            else XB_SPIN(xb_ld(&bar[XB_TOPGEN]) == tg, bar);
            __builtin_amdgcn_fence(__ATOMIC_ACQUIRE, "agent");
            xb_add(&bar[XB_XGEN(b.x)], 1u);
            asm volatile("s_waitcnt vmcnt(0)" ::: "memory");
        } else {
            XB_SPIN(xb_ld(&bar[XB_XGEN(b.x)]) == gen, bar);
            __builtin_amdgcn_fence(__ATOMIC_ACQUIRE, "agent");
            asm volatile("s_waitcnt vmcnt(0)" ::: "memory");
        }
    }
    __syncthreads();
}

constexpr int LDS_BYTES = 163840, MISC_OFF = LDS_BYTES - 256;
constexpr int CW_BAR = 4096;
__global__ void __launch_bounds__(512, 2) mega(mk::Args a) {
  extern __shared__ __attribute__((aligned(16))) unsigned char lds[];
  mk::Frame F;
  F.lds = (LAS unsigned char*)lds;
  F.tid = threadIdx.x; F.lane = F.tid & 63; F.wave = __builtin_amdgcn_readfirstlane(F.tid >> 6);
  F.G = gridDim.x; { const int bx = blockIdx.x; F.vcu = (F.G % 8 == 0) ? (bx % 8) * (F.G / 8) + bx / 8 : bx; }
  volatile LAS unsigned* MISC = (volatile LAS unsigned*)(F.lds + MISC_OFF);
  if (F.tid < 64) MISC[F.tid] = 0u;
  __syncthreads();
  XcdBarrier bar; bar.bar = nullptr; bar.x = 0; bar.st = nullptr;
  const bool multi = (a.ph_hi - a.ph_lo) > 1;
  if (multi) bar = xcd_barrier_post((unsigned*)(a.ws + mk::WS_CTL) + CW_BAR, MISC + 8);
#pragma clang loop unroll(disable)
  for (int ph = a.ph_lo; ph < a.ph_hi; ++ph) {
    if (ph == 0) mk::p0_prologue(F, a);
    else {
      const int layer = (ph - 1) / 6, sub = (ph - 1) % 6;
      if (sub == 0) mk::p1_prenorm(F, a, layer);
      else if (sub == 1) mk::p2_inproj(F, a, layer);
      else if (sub == 2) mk::p3_mixers(F, a, layer);
      else if (sub == 3) mk::gla_scan(F, a);
      else if (sub == 4) mk::p4b_glaout(F, a, layer);
      else mk::p5_outproj(F, a, layer);
    }
    if (ph + 1 < a.ph_hi) xcd_barrier(bar);
  }
}

extern "C" void kernel_launch(void* const* d_in, const int* in_sizes, int n_in, void* d_out, int out_size, void* d_ws, size_t ws_size, hipStream_t stream) {
  using namespace mk;
  static int grid = 0;
  if (grid == 0) {
    int dev = 0, cus = 0, per_cu = 0; (void)hipGetDevice(&dev); (void)hipDeviceGetAttribute(&cus, hipDeviceAttributeMultiprocessorCount, dev);
    (void)hipFuncSetAttribute((const void*)mega, hipFuncAttributeMaxDynamicSharedMemorySize, LDS_BYTES);
    if (hipOccupancyMaxActiveBlocksPerMultiprocessor(&per_cu, (const void*)mega, 512, LDS_BYTES) != hipSuccess || per_cu < 1) per_cu = 1;
    (void)hipGetLastError();
    grid = (cus > 0 ? cus : 256) * (per_cu < 1 ? 1 : 1);
  }
  (void)hipMemsetAsync((char*)d_ws + WS_CTL, 0, CTL_BYTES, stream);
  Args a{};
  for (int i = 0; i < 19; ++i) a.in[i] = (const float*)d_in[i];
  a.out = (float*)d_out; a.ws = (unsigned char*)d_ws;
  a.ph_lo = 0; a.ph_hi = 13;
  void* args[] = {&a};
  if (hipLaunchCooperativeKernel((const void*)mega, dim3(grid), dim3(512), args, LDS_BYTES, stream) != hipSuccess) {
    (void)hipGetLastError();
    hipLaunchKernelGGL(mega, dim3(grid), dim3(512), LDS_BYTES, stream, a);
  }
}
```

```cpp
#include <hip/hip_runtime.h>
#include <math.h>
#include <stdint.h>

namespace pg8 {
#define PG8_LAS __attribute__((address_space(3)))
typedef unsigned short bf16_t;
typedef short bf16x8 __attribute__((ext_vector_type(8)));
typedef float f32x4 __attribute__((ext_vector_type(4)));
typedef unsigned u32x4 __attribute__((ext_vector_type(4)));
constexpr int BM = 256, BK = 64, HALF = 128, HTB = HALF * BK * 2  , STAGE_BYTES = 8 * HTB, NXCD = 8, WGM = 8;

__host__ __device__ __forceinline__ int lds_byte(int r, int c) { const int st = (r >> 4) * 2 + (c >> 5), rr = r & 15, cc = c & 31, ob = rr * 64 + cc * 2; return st * 1024 + (ob ^ (((ob >> 9) & 1) << 5)); }
__host__ __device__ __forceinline__ void stage_rc(int b, int& R, int& C) { const int st = b / 1024, sb = b % 1024, swz = sb ^ (((sb >> 9) & 1) << 5); R = (st >> 1) * 16 + swz / 64; C = (st & 1) * 32 + (swz % 64) / 2; }
__host__ __device__ __forceinline__ int perm32(int rho) { const int n = rho >> 4, i = rho & 15; return 8 * (i >> 2) + 4 * n + (i & 3); }

struct Unit { int pm, pn; };
struct Gemm { const bf16_t* A; const bf16_t* Bt; int M, N, K; };

struct StaticOrder {
    int nM, nN, nwg, G, c;
    __host__ __device__ void init(int M, int N, int G_, int c_) { nM = M / BM; nN = N / BM; nwg = nM * nN; G = G_; c = c_; }
    __host__ __device__ bool next(int i, Unit& u) const {
        const long L = (long)i * G + c; if (L >= nwg) return false;
        int wgid = (int)L; { const int q = nwg / NXCD, r = nwg % NXCD, xcd = wgid % NXCD, off = wgid / NXCD; wgid = (xcd < r ? xcd * (q + 1) : r * (q + 1) + (xcd - r) * q) + off; }
        const int nig = WGM * nN, gid = wgid / nig, fm = gid * WGM, gsz = (nM - fm) < WGM ? (nM - fm) : WGM;
        u.pm = fm + ((wgid % nig) % gsz); u.pn = (wgid % nig) / gsz; return true;
    }
    __device__ __forceinline__ void a_ready(const Unit&) const {}
    __device__ __forceinline__ void done(const Unit&) const {}
};

template <class Epi, class Sched, bool STAMP = false>
__device__ __forceinline__ void gemm_phase(PG8_LAS unsigned char* lds, const Gemm g, const Sched& S, const Epi& E, unsigned long long* stamps) {
    int tid_ = threadIdx.x; asm volatile("" : "+v"(tid_));
    const int tid = tid_, wid = __builtin_amdgcn_readfirstlane(tid >> 6), lane = tid & 63, wr = wid >> 2, wc = wid & 3, fr = lane & 15, fq = lane >> 4;
    const int K = g.K, nt = K / BK;
    int ts_lo = 0, ts_hi = 0, nts = 0; const unsigned long long rt_entry = STAMP ? (unsigned long long)wall_clock64() : 0ull;
#define PG8_STAMP() do { if (STAMP && wid == 0 && nts < 64) { const unsigned long long _c = (unsigned long long)clock64(); \
        ts_lo = (lane == nts) ? (int)(unsigned)_c : ts_lo; ts_hi = (lane == nts) ? (int)(unsigned)(_c >> 32) : ts_hi; ++nts; } } while (0)
    PG8_STAMP();
    unsigned voffA[2], voffB[2];
#pragma unroll
    for (int i = 0; i < 2; ++i) { int R, C; stage_rc(tid * 16 + i * 8192, R, C); const int Rb = Epi::PERM ? ((R & ~31) + perm32(R & 31)) : R;
        voffA[i] = (unsigned)(R * K + C) * 2u; voffB[i] = (unsigned)(Rb * K + C) * 2u; }
    const size_t kstep = (size_t)(BK * 2);
    const size_t hstep = (size_t)HALF * K * 2;
    const size_t tstep = 2 * hstep;
    const unsigned ldsw = (unsigned)wid * 1024u;
    const int aoff = lds_byte(wr * 64 + fr, fq * 8), boff = lds_byte(wc * 32 + fr, fq * 8);
#define PG8_SA(b, h) (((b) * 2 + (h)) * HTB)
#define PG8_SB(b, h) ((4 + (b) * 2 + (h)) * HTB)
#define PG8_STAGE(bufoff, gbase, voff) do { _Pragma("unroll") for (int _i = 0; _i < 2; ++_i) \
        __builtin_amdgcn_global_load_lds((const unsigned*)((const char*)(gbase) + (voff)[_i]), (PG8_LAS unsigned*)(lds + (bufoff) + ldsw + _i * 8192), 16, 0, 0); } while (0)
#define PG8_LDA(dst, b, h) do { _Pragma("unroll") for (int m = 0; m < 4; ++m) _Pragma("unroll") for (int k = 0; k < 2; ++k) dst[m][k] = *(const PG8_LAS bf16x8*)(lds + PG8_SA(b, h) + aoff + m * 2048 + k * 1024); } while (0)
#define PG8_LDB(dst, b, h) do { _Pragma("unroll") for (int n = 0; n < 2; ++n) _Pragma("unroll") for (int k = 0; k < 2; ++k) dst[n][k] = *(const PG8_LAS bf16x8*)(lds + PG8_SB(b, h) + boff + n * 2048 + k * 1024); } while (0)
#define PG8_MMA(ai, bj, At, Bt) do { __builtin_amdgcn_s_setprio(1); _Pragma("unroll") for (int m = 0; m < 4; ++m) _Pragma("unroll") for (int n = 0; n < 2; ++n) _Pragma("unroll") for (int k = 0; k < 2; ++k) \
        acc[ai][bj][m][n] = __builtin_amdgcn_mfma_f32_16x16x32_bf16(Bt[n][k], At[m][k], acc[ai][bj][m][n], 0, 0, 0); __builtin_amdgcn_s_setprio(0); } while (0)
#define PG8_WAIT_V(n) asm volatile("s_waitcnt vmcnt(" #n ")" ::: "memory")
#define PG8_WAIT_L(n) asm volatile("s_waitcnt lgkmcnt(" #n ")" ::: "memory")
#define PG8_BAR __builtin_amdgcn_s_barrier()
#define PG8_SCHED __builtin_amdgcn_sched_barrier(0)
    Unit cur, nxt; int ui = 0;
    if (!S.next(0, cur)) return;
    f32x4 acc[2][2][4][2];
#pragma unroll
    for (int a = 0; a < 2; ++a)
#pragma unroll
        for (int b = 0; b < 2; ++b)
#pragma unroll
            for (int m = 0; m < 4; ++m)
#pragma unroll
                for (int n = 0; n < 2; ++n) acc[a][b][m][n] = (f32x4){0.f, 0.f, 0.f, 0.f};
    bf16x8 At[4][2], B0[2][2], B1[2][2];
    const char* cA = (const char*)g.A + (size_t)cur.pm * tstep; const char* cB = (const char*)g.Bt + (size_t)cur.pn * tstep;
    S.a_ready(cur);
    PG8_STAGE(PG8_SB(0, 0), cB, voffB); PG8_STAGE(PG8_SA(0, 0), cA, voffA); PG8_STAGE(PG8_SB(0, 1), cB + hstep, voffB); PG8_STAGE(PG8_SA(0, 1), cA + hstep, voffA);
    if (wr == 1) PG8_BAR;
    PG8_WAIT_V(4); PG8_BAR;
    PG8_STAGE(PG8_SB(1, 0), cB + kstep, voffB); PG8_STAGE(PG8_SA(1, 0), cA + kstep, voffA); PG8_STAGE(PG8_SB(1, 1), cB + hstep + kstep, voffB);
    PG8_WAIT_V(6); PG8_BAR;
    PG8_STAMP();
    for (;;) {
        const bool has_next = S.next(ui + 1, nxt);
        const char* nA = has_next ? (const char*)g.A + (size_t)nxt.pm * tstep : cA; const char* nB = has_next ? (const char*)g.Bt + (size_t)nxt.pn * tstep : cB;
        for (int t = 0; t < nt; t += 2) {
            const bool last = (t == nt - 2);
            const char* a1 = cA + (size_t)(t + 1) * kstep;
            const char* a2 = last ? nA : cA + (size_t)(t + 2) * kstep; const char* b2 = last ? nB : cB + (size_t)(t + 2) * kstep;
            const char* a3 = a2 + kstep; const char* b3 = b2 + kstep;
            if (last && has_next) S.a_ready(nxt);
            PG8_LDB(B0, 0, 0); PG8_SCHED; PG8_LDA(At, 0, 0); PG8_STAGE(PG8_SA(1, 1), a1 + hstep, voffA);
            PG8_WAIT_L(8); PG8_BAR; PG8_WAIT_L(0); PG8_MMA(0, 0, At, B0); PG8_BAR; PG8_SCHED;
            PG8_LDB(B1, 0, 1); PG8_STAGE(PG8_SB(0, 0), b2, voffB);
            PG8_BAR; PG8_WAIT_L(0); PG8_MMA(0, 1, At, B1); PG8_BAR;
            PG8_LDA(At, 0, 1); PG8_STAGE(PG8_SA(0, 0), a2, voffA);
            PG8_BAR; PG8_WAIT_L(0); PG8_MMA(1, 0, At, B0); PG8_BAR; PG8_SCHED;
            PG8_STAGE(PG8_SB(0, 1), b2 + hstep, voffB);
            PG8_WAIT_V(6); PG8_BAR; PG8_MMA(1, 1, At, B1); PG8_BAR;
            PG8_LDB(B0, 1, 0); PG8_SCHED; PG8_LDA(At, 1, 0); PG8_STAGE(PG8_SA(0, 1), a2 + hstep, voffA);
            PG8_WAIT_L(8); PG8_BAR; PG8_WAIT_L(0); PG8_MMA(0, 0, At, B0); PG8_BAR; PG8_SCHED;
            PG8_LDB(B1, 1, 1); PG8_STAGE(PG8_SB(1, 0), b3, voffB);
            PG8_BAR; PG8_WAIT_L(0); PG8_MMA(0, 1, At, B1); PG8_BAR;
            PG8_LDA(At, 1, 1); PG8_STAGE(PG8_SA(1, 0), a3, voffA);
            PG8_BAR; PG8_WAIT_L(0); PG8_MMA(1, 0, At, B0); PG8_BAR; PG8_SCHED;
            PG8_STAGE(PG8_SB(1, 1), b3 + hstep, voffB);
            PG8_WAIT_V(6); PG8_BAR; PG8_MMA(1, 1, At, B1); PG8_BAR;
        }
        PG8_STAMP();
        if constexpr (!Epi::AFTER_DRAIN) { E(acc, cur, wr, wc, fr, fq); S.done(cur); }
        PG8_STAMP();
        if (!has_next) break;
#pragma unroll
        for (int a = 0; a < 2; ++a)
#pragma unroll
            for (int b = 0; b < 2; ++b)
#pragma unroll
                for (int m = 0; m < 4; ++m)
#pragma unroll
                    for (int n = 0; n < 2; ++n) acc[a][b][m][n] = (f32x4){0.f, 0.f, 0.f, 0.f};
        cur = nxt; cA = nA; cB = nB; ++ui;
    }
    PG8_WAIT_V(0);
    if (wr == 0) PG8_BAR;
    PG8_BAR;
    if constexpr (Epi::AFTER_DRAIN) { E.fused(acc, cur, wr, wc, fr, fq, lds, wid, lane); S.done(cur); }
    PG8_STAMP();
    if (STAMP && wid == 0) { stamps[lane] = lane < nts ? (((unsigned long long)(unsigned)ts_hi << 32) | (unsigned)ts_lo) : 0ull;
        if (lane == 62) stamps[62] = rt_entry; if (lane == 63) stamps[63] = (unsigned long long)wall_clock64(); }
#undef PG8_STAMP
#undef PG8_SA
#undef PG8_SB
#undef PG8_STAGE
#undef PG8_LDA
#undef PG8_LDB
#undef PG8_MMA
#undef PG8_WAIT_V
#undef PG8_WAIT_L
#undef PG8_BAR
#undef PG8_SCHED
}
}

namespace mk {
#define LAS __attribute__((address_space(3)))
typedef unsigned short bf16;
typedef float f32x4 __attribute__((ext_vector_type(4)));
typedef float f32x16 __attribute__((ext_vector_type(16)));
typedef unsigned u32x4 __attribute__((ext_vector_type(4)));
typedef unsigned u32x2 __attribute__((ext_vector_type(2)));
typedef short bf16x8 __attribute__((ext_vector_type(8)));
typedef short s16x4 __attribute__((ext_vector_type(4)));

constexpr int D = 1024, NB = 4, SEQ = 4096, CTX = 256, PWW = 3360;
constexpr int MLAT = NB * SEQ, MT = MLAT + NB * CTX;
constexpr int NT1 = 14, N1 = NT1 * 256;
constexpr int NSLOT = 11, PLW = NSLOT * 256;
constexpr int TROW = SEQ + CTX;
constexpr int O_AQ = 0, O_AK = 128, O_AV = 256, O_AG = 512, O_LR = 768, O_BV = 800, O_BG = 1056, O_CQ = 1312, O_CK = 1568, O_CV = 1696,
              O_CG = 1824, O_DQ = 2080, O_DK = 2336, O_DV = 2592, O_DG = 2848;
constexpr int S_AQK = 0, S_AV = 1, S_AG = 2, S_BG = 3, S_CQ = 4, S_CKV = 5, S_CG = 6, S_DQ = 7, S_DK = 8, S_DV = 9, S_DG = 10;
constexpr float LOG2E = 1.4426950408889634f, QSCALE = 0.125f * LOG2E, GLA_QS = 0.17677669529663687f;

constexpr size_t WS_CTL = 0, CTL_BYTES = 65536;
constexpr size_t WS_MOD = WS_CTL + CTL_BYTES;
constexpr size_t WS_ROPE = WS_MOD + 2 * 5 * 3072 * 4;
constexpr size_t WS_WC = WS_ROPE + 2 * 64 * 16 * 4;
constexpr size_t WS_CS256 = WS_WC + 128 * 128 * 2;
constexpr size_t WS_W1T = 1u << 20;
constexpr size_t WS_W2T = WS_W1T + (size_t)2 * N1 * D * 2;
constexpr size_t WS_H = WS_W2T + (size_t)2 * D * D * 2;
constexpr size_t WS_PLB = WS_H + (size_t)MT * D * 2;
constexpr size_t WS_LA = WS_PLB + (size_t)MT * PLW * 2;
constexpr size_t WS_FA2 = WS_LA + (size_t)MT * 256 * 4;
constexpr size_t WS_CTX1 = WS_FA2 + (size_t)NB * 64 * TROW * 8 * 2;
constexpr size_t WS_SCR = WS_CTX1 + (size_t)NB * CTX * D * 4;
static_assert(WS_CS256 + 256 * 512 * 2 <= WS_W1T, "tables");

__device__ __forceinline__ float bf2f(bf16 v) { return __uint_as_float(((unsigned)v) << 16); }
__device__ __forceinline__ unsigned f2bf(float f) { unsigned u = __float_as_uint(f); return (u + 0x7fffu + ((u >> 16) & 1u)) >> 16; }
typedef float f32x2_t __attribute__((ext_vector_type(2))); typedef __bf16 bf16x2_t __attribute__((ext_vector_type(2)));
__device__ __forceinline__ unsigned pk2(float lo, float hi) { const f32x2_t v = {lo, hi}; const bf16x2_t b = __builtin_convertvector(v, bf16x2_t); return __builtin_bit_cast(unsigned, b); }
__device__ __forceinline__ float wave_sum(float v) {
#pragma unroll
  for (int o = 1; o < 64; o <<= 1) v += __shfl_xor(v, o);
  return v;
}
__device__ __forceinline__ float fsilu(float x) { return x * __builtin_amdgcn_rcpf(1.f + __expf(-x)); }
__device__ __forceinline__ float flogsig(float x) { return fminf(x, 0.f) - __logf(1.f + __expf(-fabsf(x))); }

#define GAS __attribute__((address_space(1)))
template <class T> __device__ __forceinline__ T* opq(T* p) { GAS T* g = (GAS T*)p; asm volatile("" : "+s"(g)); return (T*)g; }
__device__ __forceinline__ int crow(int r, int hi) { return (r & 3) + 8 * (r >> 2) + 4 * hi; }
struct Args {
  const float* in[19]; float* out; unsigned char* ws; int ph_lo, ph_hi;
};
struct Frame {
  int tid, lane, wave, vcu, G;
  LAS unsigned char* lds;
};
__device__ __forceinline__ Frame relaunder(const Frame& F0) {
  Frame F = F0; F.tid = threadIdx.x; asm volatile("" : "+v"(F.tid)); F.lane = F.tid & 63; asm volatile("" : "+s"(F.wave), "+s"(F.vcu), "+s"(F.G)); return F; }
}

namespace mk {
__device__ __forceinline__ void p0_ada_item(const Frame& F, const Args& a, int item) {
  LAS float* s = (LAS float*)F.lds; LAS float* red = s + 5 * 1024;
  const float* c = opq(a.in[1]); const float* cc = opq(a.in[3]);
  for (int i = F.tid; i < 5 * 1024; i += 512) { const int r = i >> 10, k = i & 1023; const float v = r < 4 ? c[r * 1024 + k] : cc[k]; s[i] = v / (1.f + expf(-v)); }
  __syncthreads();
  const int kp = F.tid / 24, cl = F.tid % 24;
  const int gcol = item * 24 + cl, l = gcol / 3072, col = gcol % 3072;
  if (kp < 21) {
    const float* w = opq(a.in[5]) + (size_t)l * 1024 * 3072 + col;
    float acc[5] = {0.f, 0.f, 0.f, 0.f, 0.f};
#pragma unroll 1
    for (int kb = 0; kb < 2; ++kb) {
      float wv[25];
#pragma unroll
      for (int j = 0; j < 25; ++j) { const int k = kp + 21 * (25 * kb + j); wv[j] = w[(size_t)(k < 1024 ? k : 1023) * 3072]; }
      __builtin_amdgcn_sched_barrier(0);
#pragma unroll
      for (int j = 0; j < 25; ++j) { const int k = kp + 21 * (25 * kb + j); const int kc = k < 1024 ? k : 1023; const float wz = k < 1024 ? wv[j] : 0.f;
#pragma unroll
        for (int r = 0; r < 5; ++r) acc[r] += s[r * 1024 + kc] * wz; }
    }
#pragma unroll
    for (int r = 0; r < 5; ++r) red[(kp * 24 + cl) * 5 + r] = acc[r];
  }
  __syncthreads();
  if (F.tid < 120) {
    const int cl2 = F.tid / 5, r = F.tid % 5; float t = 0.f;
    for (int q = 0; q < 21; ++q) t += red[(q * 24 + cl2) * 5 + r];
    const int g2 = item * 24 + cl2, l2 = g2 / 3072, col2 = g2 % 3072;
    float* MOD = (float*)(opq(a.ws) + WS_MOD);
    MOD[((size_t)l2 * 5 + r) * 3072 + col2] = t + opq(a.in[6])[l2 * 3072 + col2];
  }
  __syncthreads();
}
__device__ __forceinline__ int rope_perm(int n) { return 16 * ((n >> 2) & 1) + 4 * (n >> 3) + (n & 3); }
__device__ __forceinline__ void p0_tr_item(const float* W, int ldw, int cbase, int permkind, float scale, bf16* dst, int k0, LAS float* scr, int lane) {
  { float t_[32];
#pragma unroll
    for (int i = 0; i < 32; ++i) t_[i] = W[(size_t)(k0 + 2 * i + (lane >> 5)) * ldw + cbase + (lane & 31)];
#pragma unroll
    for (int i = 0; i < 32; ++i) scr[(2 * i + (lane >> 5)) * 33 + (lane & 31)] = t_[i]; }
  asm volatile("s_waitcnt lgkmcnt(0)" ::: "memory");
  const int c = lane & 7;
#pragma unroll
  for (int j = 0; j < 4; ++j) { const int n = (lane >> 3) + 8 * j; const int sidx = permkind ? rope_perm(n) : n; const LAS float* sp = scr + (8 * c) * 33 + sidx;
    u32x4 o; o.x = pk2(sp[0 * 33] * scale, sp[1 * 33] * scale); o.y = pk2(sp[2 * 33] * scale, sp[3 * 33] * scale); o.z = pk2(sp[4 * 33] * scale, sp[5 * 33] * scale); o.w = pk2(sp[6 * 33] * scale, sp[7 * 33] * scale);
    *(u32x4*)(dst + (size_t)n * 1024 + k0 + 8 * c) = o; }
  asm volatile("s_waitcnt lgkmcnt(0)" ::: "memory");
}
__device__ __forceinline__ void p0_la_item(const float* Win, const float* decw  , int dir, int j0, bf16* dst, int k0, LAS float* scr, int lane) {
  float dw[16];
#pragma unroll
  for (int r = 0; r < 16; ++r) dw[r] = decw[(dir * 16 + r) * 128 + j0 + (lane & 31)];
#pragma unroll 4
  for (int i = 0; i < 32; ++i) { const int kk = 2 * i + (lane >> 5); const float* wp = Win + (size_t)(k0 + kk) * PWW + O_LR + dir * 16; float acc = 0.f;
#pragma unroll
    for (int r = 0; r < 16; ++r) acc += wp[r] * dw[r];
    scr[kk * 33 + (lane & 31)] = acc; }
  asm volatile("s_waitcnt lgkmcnt(0)" ::: "memory");
  const int c = lane & 7;
#pragma unroll
  for (int j = 0; j < 4; ++j) { const int n = (lane >> 3) + 8 * j; const LAS float* sp = scr + (8 * c) * 33 + n;
    u32x4 o; o.x = pk2(sp[0 * 33], sp[1 * 33]); o.y = pk2(sp[2 * 33], sp[3 * 33]); o.z = pk2(sp[4 * 33], sp[5 * 33]); o.w = pk2(sp[6 * 33], sp[7 * 33]);
    *(u32x4*)(dst + (size_t)n * 1024 + k0 + 8 * c) = o; }
  asm volatile("s_waitcnt lgkmcnt(0)" ::: "memory");
}
constexpr int FA_AST = 528, FA_WST = 528;
__device__ __forceinline__ void p0_fa_item(const Frame& F, const Args& a, int item) {
  const int l = item >> 4, pn = 4 + ((item >> 3) & 1), g32 = item & 7, bj = g32 >> 2, wc = g32 & 3;
  LAS float* cs = (LAS float*)F.lds; LAS float* sn = cs + 64; LAS float* wfl = sn + 64;
  LAS unsigned char* Ai = F.lds + 512 + 16384;
  LAS unsigned char* Wi = F.lds + F.wave * (32 * FA_WST);
  __syncthreads();
  if (F.tid < 64) { float s_, c_; sincospif(2.f * F.tid / 64.f, &s_, &c_); cs[F.tid] = c_; sn[F.tid] = s_; }
  const float* wf = opq(a.in[12]) + (size_t)l * 256 * 256;
  const int slice0 = 32 * (pn - 4) + 16 * bj + 4 * wc;
  for (int i = F.tid; i < 1024; i += 512) { const int r = i >> 2, q = i & 3; *(LAS f32x4*)(wfl + r * 16 + 4 * q) = *(const f32x4*)(wf + (size_t)r * 256 + 4 * slice0 + 4 * q); }
  __syncthreads();
  {
    const int c = F.tid & 255, part = F.tid >> 8, g = c >> 6, jj = c & 63;
    f32x4 acc[4];
#pragma unroll
    for (int q = 0; q < 4; ++q) acc[q] = (f32x4){0.f, 0.f, 0.f, 0.f};
#pragma unroll 4
    for (int m = 0; m < 64; ++m) { const int idx = (m * jj) & 63; const float t = part ? -sn[idx] : cs[idx];
#pragma unroll
      for (int q = 0; q < 4; ++q) acc[q] += t * *(LAS const f32x4*)(wfl + (g * 64 + m) * 16 + 4 * q); }
#pragma unroll
    for (int fq = 0; fq < 4; ++fq)
#pragma unroll
      for (int j = 0; j < 4; ++j) *(LAS unsigned short*)(Ai + (8 * fq + 4 * part + j) * FA_AST + c * 2) = (unsigned short)f2bf(acc[fq][j] * 0.125f);
  }
  __syncthreads();
  const int r32 = F.lane & 31, hi = F.lane >> 5;
  bf16x8 af[16];
#pragma unroll
  for (int s = 0; s < 16; ++s) af[s] = *(LAS const bf16x8*)(Ai + r32 * FA_AST + (16 * s + 8 * hi) * 2);
  __syncthreads();
  const float* Win = opq(a.in[7]) + (size_t)l * 1024 * PWW + O_BV;
  bf16* dst = (bf16*)(opq(a.ws) + WS_W1T) + ((size_t)l * N1 + pn * 256 + 32 * g32) * 1024;
  for (int kb = 0; kb < 4; ++kb) {
    const int k0 = F.wave * 128 + kb * 32;
#pragma unroll
    for (int rh = 0; rh < 2; ++rh) { f32x4 w[16];
#pragma unroll
      for (int r = 0; r < 16; ++r) w[r] = *(const f32x4*)(Win + (size_t)(k0 + 16 * rh + r) * PWW + 4 * F.lane);
#pragma unroll
      for (int r = 0; r < 16; ++r) *(LAS u32x2*)(Wi + (16 * rh + r) * FA_WST + 8 * F.lane) = (u32x2){pk2(w[r].x, w[r].y), pk2(w[r].z, w[r].w)}; }
    asm volatile("s_waitcnt lgkmcnt(0)" ::: "memory");
    f32x16 acc;
#pragma unroll
    for (int i = 0; i < 16; ++i) acc[i] = 0.f;
#pragma unroll
    for (int s = 0; s < 16; ++s) { const bf16x8 bfr = *(LAS const bf16x8*)(Wi + r32 * FA_WST + (16 * s + 8 * hi) * 2); acc = __builtin_amdgcn_mfma_f32_32x32x16_bf16(af[s], bfr, acc, 0, 0, 0); }
#pragma unroll
    for (int r = 0; r < 16; ++r) dst[(size_t)crow(r, hi) * 1024 + k0 + r32] = (bf16)f2bf(acc[r]);
    asm volatile("s_waitcnt lgkmcnt(0)" ::: "memory");
  }
  __syncthreads();
}
__device__ __forceinline__ void p0_prologue(const Frame& F0, const Args& a) {
 {
  const Frame F = relaunder(F0);
  unsigned char* ws = opq(a.ws);
  { const int gt = F.vcu * 512 + F.tid, GT = F.G * 512;
    float* rope = (float*)(ws + WS_ROPE);
    for (int i = gt; i < 1024; i += GT) { const int pos = i >> 4, f = i & 15; const float ang = (float)pos * powf(10000.f, -(float)f / 16.f); rope[i] = cosf(ang); rope[1024 + i] = sinf(ang); }
    bf16* wc = (bf16*)(ws + WS_WC);
    for (int i = gt; i < 128 * 128; i += GT) { const int r = i >> 7, c = i & 127, rr = r & 63, cc = c & 63; float s_, c_; sincospif(2.f * (float)((rr * cc) & 63) / 64.f, &s_, &c_);
      float v; if (r < 64) v = c < 64 ? c_ : s_; else v = c < 64 ? -s_ : c_; wc[i] = (bf16)f2bf(v * 0.125f); }
    bf16* cs256 = (bf16*)(ws + WS_CS256);
    for (int i = gt; i < 256 * 512; i += GT) { const int k = i >> 9, n = i & 511, nn = n & 255; float s_, c_; sincospif(2.f * (float)((k * nn) & 255) / 256.f, &s_, &c_); cs256[i] = (bf16)f2bf((n < 256 ? c_ : s_) * 0.0625f); }
  }
  for (int it = F.vcu; it < 256 + 32; it += F.G) { if (it < 256) p0_ada_item(F, a, it); else p0_fa_item(F, a, it - 256); }
  LAS float* scr = (LAS float*)(F.lds + F.wave * 16384);
  const bool skipfa = F.G >= 128;
  const int gw = skipfa ? (F.vcu - 32) * 8 + F.wave : F.vcu * 8 + F.wave, NGW = skipfa ? (F.G - 32) * 8 : F.G * 8;
  constexpr int I_DIR = 11 * 8 * 16, I_LA = 8 * 16, I_W2 = 32 * 16, I_L = I_DIR + I_LA + I_W2;
  for (int it = (skipfa && F.vcu < 32) ? 2 * I_L : gw; it < 2 * I_L; it += NGW) {
    const int l = it / I_L; int r = it % I_L;
    const float* Win = opq(a.in[7]) + (size_t)l * 1024 * PWW;
    bf16* W1T = (bf16*)(ws + WS_W1T) + (size_t)l * N1 * 1024;
    if (r < I_DIR) {
      const int ti = r / 128, g32 = (r >> 4) & 7, kb = r & 15;
      const int pn = ti < 3 ? ti : ti + 3;
      const int bj = g32 >> 2, wc = g32 & 3, mcb = 64 * wc + 32 * bj;
      int cbase = 0, pk = 0; float sc = 1.f;
      switch (pn) {
        case 0: if (mcb < 128) { cbase = O_AQ + mcb; sc = GLA_QS; } else cbase = O_AK + mcb - 128; break;
        case 1: cbase = O_AV + mcb; break;
        case 2: cbase = O_AG + mcb; break;
        case 6: cbase = O_BG + mcb; break;
        case 7: cbase = O_CQ + mcb; pk = 1; break;
        case 8: if (wc < 2) { cbase = O_CK + mcb; pk = 1; } else cbase = O_CV + mcb - 128; break;
        case 9: cbase = O_CG + mcb; break;
        case 10: cbase = O_DQ + mcb; break;
        case 11: cbase = O_DK + mcb; break;
        case 12: cbase = O_DV + mcb; break;
        default: cbase = O_DG + mcb; break;
      }
      p0_tr_item(Win, PWW, cbase, pk, sc, W1T + (size_t)(pn * 256 + 32 * g32) * 1024, kb * 64, scr, F.lane);
    } else if (r < I_DIR + I_LA) {
      r -= I_DIR; const int g32 = r >> 4, kb = r & 15, bj = g32 >> 2, wc = g32 & 3, mcb = 64 * wc + 32 * bj;
      p0_la_item(Win, opq(a.in[9]) + (size_t)l * 2 * 16 * 128, mcb >> 7, mcb & 127, W1T + (size_t)(3 * 256 + 32 * g32) * 1024, kb * 64, scr, F.lane);
    } else {
      r -= I_DIR + I_LA; const int g = r >> 4, kb = r & 15;
      p0_tr_item(opq(a.in[8]) + (size_t)l * 1024 * 1024, 1024, 32 * g, 0, 1.f, (bf16*)(ws + WS_W2T) + ((size_t)l * 1024 + 32 * g) * 1024, kb * 64, scr, F.lane);
    }
  }
 }
}
__device__ __forceinline__ void p1_prenorm(const Frame& F0, const Args& a, int layer) {
  const Frame F = relaunder(F0);
  const float* xin = layer == 0 ? opq(a.in[0]) : opq(a.out);
  const float* cin = layer == 0 ? opq(a.in[2]) : (const float*)(opq(a.ws) + WS_CTX1);
  const float* nw = opq(a.in[4]) + layer * 1024;
  const float* MOD = (const float*)(opq(a.ws) + WS_MOD) + (size_t)layer * 5 * 3072;
  bf16* H = (bf16*)(opq(a.ws) + WS_H);
  const int gw = F.vcu * 8 + F.wave, NGW = F.G * 8;
  constexpr int RB = 3;
  f32x4 w_[4];
#pragma unroll
  for (int j = 0; j < 4; ++j) w_[j] = *(const f32x4*)(nw + 4 * F.lane + 256 * j);
  for (int row0 = gw; row0 < MT; row0 += RB * NGW) {
    f32x4 v[RB][4], sc_[RB][4], sh_[RB][4]; float ss[RB];
#pragma unroll
    for (int q = 0; q < RB; ++q) { int row = row0 + q * NGW; row = row < MT ? row : MT - 1;
      const float* src; const float* mod;
      if (row < MLAT) { src = xin + (size_t)row * 1024; mod = MOD + (size_t)(row >> 12) * 3072; }
      else { src = cin + (size_t)(row - MLAT) * 1024; mod = MOD + (size_t)4 * 3072; }
      const f32x4* xr = (const f32x4*)src + F.lane;
#pragma unroll
      for (int j = 0; j < 4; ++j) { v[q][j] = xr[64 * j]; sc_[q][j] = *(const f32x4*)(mod + 1024 + 4 * F.lane + 256 * j); sh_[q][j] = *(const f32x4*)(mod + 4 * F.lane + 256 * j); } }
    __builtin_amdgcn_sched_barrier(0);
#pragma unroll
    for (int q = 0; q < RB; ++q) { float s_ = 0.f;
#pragma unroll
      for (int j = 0; j < 4; ++j) s_ += (v[q][j].x * v[q][j].x + v[q][j].y * v[q][j].y) + (v[q][j].z * v[q][j].z + v[q][j].w * v[q][j].w);
      ss[q] = s_; }
#pragma unroll
    for (int o = 1; o < 64; o <<= 1)
#pragma unroll
      for (int q = 0; q < RB; ++q) ss[q] += __shfl_xor(ss[q], o);
#pragma unroll
    for (int q = 0; q < RB; ++q) { const int row = row0 + q * NGW; if (row >= MT) continue;
      const float rs = 1.0f / sqrtf(ss[q] * (1.f / 1024.f) + 1e-6f);
      unsigned long long* o8 = (unsigned long long*)(H + (size_t)row * 1024) + F.lane;
#pragma unroll
      for (int j = 0; j < 4; ++j) {
        const f32x4 h = v[q][j] * rs * w_[j] * (1.f + sc_[q][j]) + sh_[q][j];
        o8[64 * j] = (unsigned long long)pk2(h.x, h.y) | ((unsigned long long)pk2(h.z, h.w) << 32);
      } }
  }
}
}

namespace mk {
using pg8::Unit;
struct EpiIn {
  static constexpr bool PERM = true, AFTER_DRAIN = false;
  bf16* PLB; float* LA; bf16* FA2; LAS const float* rope;
  __device__ __forceinline__ void operator()(const f32x4 (&acc)[2][2][4][2], const Unit& u, int wr, int wc, int fr, int fq) const {
    const int pn = u.pn;
    const bool ctxrows = u.pm >= 64;
    int kind, slot = 0; LAS const float* nw = rope; bool roped = false; float qs = 1.f;
    LAS const float* cqn = rope + 2048; LAS const float* ckn = rope + 2112; LAS const float* dqn = rope + 2176; LAS const float* dkn = rope + 2240; LAS const float* decb = rope + 2304;
    switch (pn) {
      case 0: kind = 0; slot = S_AQK; break;
      case 1: kind = 0; slot = S_AV; break;
      case 2: kind = 1; slot = S_AG; break;
      case 3: kind = 2; break;
      case 4: case 5: kind = 3; break;
      case 6: kind = 1; slot = S_BG; break;
      case 7: kind = 4; slot = S_CQ; nw = cqn; roped = true; qs = QSCALE; break;
      case 8: slot = S_CKV; if (wc < 2) { kind = 4; nw = ckn; roped = true; } else kind = 0; break;
      case 9: kind = 1; slot = S_CG; break;
      case 10: kind = 4; slot = S_DQ; nw = dqn; qs = QSCALE; break;
      case 11: kind = 4; slot = S_DK; nw = dkn; break;
      case 12: kind = 0; slot = S_DV; break;
      default: kind = 1; slot = S_DG; break;
    }
    const int row0 = u.pm * 256 + wr * 64 + fr;
    float w8[2][8];
    if (kind == 4) {
#pragma unroll
      for (int bj = 0; bj < 2; ++bj)
#pragma unroll
        for (int s = 0; s < 8; ++s) { const int d = roped ? (32 * bj + 16 * (s >> 2) + 4 * fq + (s & 3)) : (32 * bj + 8 * fq + s); w8[bj][s] = nw[d] * qs; }
    } else if (kind == 2) {
#pragma unroll
      for (int bj = 0; bj < 2; ++bj)
#pragma unroll
        for (int s = 0; s < 8; ++s) w8[bj][s] = decb[64 * wc + 32 * bj + 8 * fq + s];
    }
#pragma unroll
    for (int ai = 0; ai < 2; ++ai) {
      float rsr[4];
      if (kind == 4) {
#pragma unroll
        for (int m = 0; m < 4; ++m) { float s_ = 0.f;
#pragma unroll
          for (int bj = 0; bj < 2; ++bj)
#pragma unroll
            for (int n = 0; n < 2; ++n) { const f32x4 t = acc[ai][bj][m][n]; s_ += (t.x * t.x + t.y * t.y) + (t.z * t.z + t.w * t.w); }
          rsr[m] = s_; }
#pragma unroll
        for (int o = 16; o < 64; o <<= 1)
#pragma unroll
          for (int m = 0; m < 4; ++m) rsr[m] += __shfl_xor(rsr[m], o);
#pragma unroll
        for (int m = 0; m < 4; ++m) rsr[m] = __builtin_amdgcn_rsqf(rsr[m] * (1.f / 64.f) + 1e-6f);
      }
#pragma unroll
      for (int m = 0; m < 4; ++m) {
        const int r = row0 + ai * 128 + m * 16;
        float v[2][8];
#pragma unroll
        for (int bj = 0; bj < 2; ++bj)
#pragma unroll
          for (int n = 0; n < 2; ++n)
#pragma unroll
            for (int e = 0; e < 4; ++e) v[bj][4 * n + e] = acc[ai][bj][m][n][e];
        if (kind == 2) {
#pragma unroll
          for (int bj = 0; bj < 2; ++bj) { const int mc = 64 * wc + 32 * bj + 8 * fq; float* dp = LA + (size_t)r * 256 + mc;
            f32x4 o0, o1;
#pragma unroll
            for (int e = 0; e < 4; ++e) { o0[e] = flogsig(v[bj][e] + w8[bj][e]) * 0.0625f; o1[e] = flogsig(v[bj][4 + e] + w8[bj][4 + e]) * 0.0625f; }
            *(f32x4*)dp = o0; *(f32x4*)(dp + 4) = o1; }
        } else if (kind == 3) {
          int b, t; if (!ctxrows) { b = r >> 12; t = r & 4095; } else { const int rc = r - MLAT; b = rc >> 8; t = SEQ + (rc & 255); }
#pragma unroll
          for (int bj = 0; bj < 2; ++bj) { const int slice = 32 * (pn - 4) + 16 * bj + 4 * wc + fq;
            u32x4 o; o.x = pk2(v[bj][0], v[bj][1]); o.y = pk2(v[bj][2], v[bj][3]); o.z = pk2(v[bj][4], v[bj][5]); o.w = pk2(v[bj][6], v[bj][7]);
            *(u32x4*)(FA2 + (((size_t)b * 64 + slice) * TROW + t) * 8) = o; }
        } else {
          if (kind == 1) {
#pragma unroll
            for (int bj = 0; bj < 2; ++bj)
#pragma unroll
              for (int s = 0; s < 8; ++s) v[bj][s] = fsilu(v[bj][s]);
          } else if (kind == 4) {
            const float rs = rsr[m];
#pragma unroll
            for (int bj = 0; bj < 2; ++bj)
#pragma unroll
              for (int s = 0; s < 8; ++s) v[bj][s] *= rs * w8[bj][s];
            if (roped && !ctxrows) {
              const int t = r & 4095;
#pragma unroll
              for (int bj = 0; bj < 2; ++bj) { const int pos = bj == 0 ? (t >> 6) : (t & 63);
                const f32x4 c4 = *(LAS const f32x4*)(rope + pos * 16 + 4 * fq), s4 = *(LAS const f32x4*)(rope + 1024 + pos * 16 + 4 * fq);
#pragma unroll
                for (int e = 0; e < 4; ++e) { const float x1 = v[bj][e], x2 = v[bj][4 + e]; v[bj][e] = x1 * c4[e] - x2 * s4[e]; v[bj][4 + e] = x2 * c4[e] + x1 * s4[e]; } }
            }
          }
#pragma unroll
          for (int bj = 0; bj < 2; ++bj) { const int mc = 64 * wc + 32 * bj + 8 * fq;
            u32x4 o; o.x = pk2(v[bj][0], v[bj][1]); o.y = pk2(v[bj][2], v[bj][3]); o.z = pk2(v[bj][4], v[bj][5]); o.w = pk2(v[bj][6], v[bj][7]);
            *(u32x4*)(PLB + (size_t)r * PLW + slot * 256 + mc) = o; }
        }
        asm volatile("" ::: "memory");
      }
    }
  }
};
struct EpiOut {
  static constexpr bool PERM = true, AFTER_DRAIN = false;
  const float* xin; const float* cin; float* xout; float* cout; const float* MODl;
  __device__ __forceinline__ void operator()(const f32x4 (&acc)[2][2][4][2], const Unit& u, int wr, int wc, int fr_, int fq_) const {
    int fr = fr_, fq = fq_; asm volatile("" : "+v"(fr), "+v"(fq));
    const int row0 = u.pm * 256 + wr * 64 + fr, col0 = u.pn * 256 + wc * 32 + 8 * fq;
    const bool ctxrows = u.pm >= 64;
    const float* gate = MODl + (size_t)(ctxrows ? 4 : (u.pm >> 4)) * 3072 + 2048;
    f32x4 gv[2][2];
#pragma unroll
    for (int bj = 0; bj < 2; ++bj)
#pragma unroll
      for (int n = 0; n < 2; ++n) gv[bj][n] = *(const f32x4*)(gate + col0 + bj * 128 + n * 4);
    const float* sp0; float* dp0;
    if (!ctxrows) { sp0 = xin + (size_t)row0 * 1024 + col0; dp0 = xout + (size_t)row0 * 1024 + col0; }
    else { sp0 = cin + (size_t)(row0 - MLAT) * 1024 + col0; dp0 = cout + (size_t)(row0 - MLAT) * 1024 + col0; }
#pragma unroll
    for (int ai = 0; ai < 2; ++ai) {
      f32x4 xv[4][2][2];
#pragma unroll
      for (int m = 0; m < 4; ++m)
#pragma unroll
        for (int bj = 0; bj < 2; ++bj)
#pragma unroll
          for (int n = 0; n < 2; ++n) xv[m][bj][n] = *(const f32x4*)(sp0 + (size_t)(ai * 128 + m * 16) * 1024 + bj * 128 + n * 4);
      __builtin_amdgcn_sched_barrier(0);
#pragma unroll
      for (int m = 0; m < 4; ++m)
#pragma unroll
        for (int bj = 0; bj < 2; ++bj)
#pragma unroll
          for (int n = 0; n < 2; ++n) *(f32x4*)(dp0 + (size_t)(ai * 128 + m * 16) * 1024 + bj * 128 + n * 4) = xv[m][bj][n] + gv[bj][n] * acc[ai][bj][m][n];
      asm volatile("" ::: "memory");
    }
  }
};
struct InOrder {
  pg8::StaticOrder S;
  static constexpr unsigned long long PACK = 0x3c817d9b0a5246ull;
  __device__ __forceinline__ bool next(int i, Unit& u) const { const bool ok = S.next(i, u); if (ok) u.pn = (int)((PACK >> (4 * u.pn)) & 15ull); return ok; }
  __device__ __forceinline__ void a_ready(const Unit&) const {}
  __device__ __forceinline__ void done(const Unit&) const {}
};
__device__ __forceinline__ void p2_inproj(const Frame& F, const Args& a, int layer) {
  unsigned char* ws = opq(a.ws);
  pg8::Gemm g{(const pg8::bf16_t*)(ws + WS_H), (const pg8::bf16_t*)(ws + WS_W1T) + (size_t)layer * N1 * 1024, MT, N1, 1024};
  InOrder S; S.S.init(MT, N1, F.G, (int)blockIdx.x);
  LAS float* ropeL = (LAS float*)(F.lds + pg8::STAGE_BYTES);
  { int tid = threadIdx.x; asm volatile("" : "+v"(tid)); const f32x4 t = *(const f32x4*)((const float*)(ws + WS_ROPE) + 4 * tid); *(LAS f32x4*)(ropeL + 4 * tid) = t;
    if (tid < 128) {
      const float* n0 = opq(a.in[13]); const float* n1 = opq(a.in[14]); const float* n2 = opq(a.in[16]); const float* n3 = opq(a.in[17]); const float* db = opq(a.in[10]);
      const int k = tid >> 4; const float* src = tid < 64 ? (k == 0 ? n0 : k == 1 ? n1 : k == 2 ? n2 : n3) + layer * 64 + 4 * (tid & 15) : db + layer * 256 + 4 * (tid - 64);
      *(LAS f32x4*)(ropeL + 2048 + 4 * tid) = *(const f32x4*)src; } }
  __syncthreads();
  EpiIn E{(bf16*)(ws + WS_PLB), (float*)(ws + WS_LA), (bf16*)(ws + WS_FA2), ropeL};
  { Unit u_; if (!S.next(3, u_)) { for (int i = 0; i < 3; ++i) __builtin_amdgcn_s_sleep(127); } }
  pg8::gemm_phase<EpiIn, InOrder>(F.lds, g, S, E, nullptr);
}

__device__ __forceinline__ void ctx_out_item(const Frame& F, const Args& a, int item) {
  unsigned char* ws = opq(a.ws);
  const bf16* Yc = (const bf16*)(ws + WS_H) + (size_t)MLAT * 1024; const bf16* W2 = (const bf16*)(ws + WS_W2T);
  const int tm = item >> 4, tn = item & 15, sub = F.wave & 3, kh = F.wave >> 2, r32 = F.lane & 31, hi = F.lane >> 5;
  const int row0 = 64 * tm + 32 * (sub >> 1), col0 = 64 * tn + 32 * (sub & 1);
  const bf16* ap = Yc + (size_t)(row0 + r32) * 1024 + kh * 512 + 8 * hi;
  const bf16* bp = W2 + (size_t)(col0 + r32) * 1024 + kh * 512 + 8 * hi;
  f32x16 acc;
#pragma unroll
  for (int i = 0; i < 16; ++i) acc[i] = 0.f;
#pragma unroll 1
  for (int sb = 0; sb < 4; ++sb) {
    bf16x8 af[8], bf[8];
#pragma unroll
    for (int s = 0; s < 8; ++s) { af[s] = *(const bf16x8*)(ap + (sb * 8 + s) * 16); bf[s] = *(const bf16x8*)(bp + (sb * 8 + s) * 16); }
    __builtin_amdgcn_sched_barrier(0);
#pragma unroll
    for (int s = 0; s < 8; ++s) acc = __builtin_amdgcn_mfma_f32_32x32x16_bf16(af[s], bf[s], acc, 0, 0, 0);
  }
  LAS float* X = (LAS float*)F.lds + sub * 1024;
  __syncthreads();
  if (kh == 1) {
#pragma unroll
    for (int r = 0; r < 16; ++r) X[r * 64 + F.lane] = acc[r];
  }
  __syncthreads();
  if (kh == 0) {
    const float* cin = opq(a.in[2]); float* cout = (float*)(ws + WS_CTX1);
    const float gate = ((const float*)(ws + WS_MOD))[4 * 3072 + 2048 + col0 + r32];
    float ci[16];
#pragma unroll
    for (int r = 0; r < 16; ++r) ci[r] = cin[(size_t)(row0 + crow(r, hi)) * 1024 + col0 + r32];
    __builtin_amdgcn_sched_barrier(0);
#pragma unroll
    for (int r = 0; r < 16; ++r) { const size_t o = (size_t)(row0 + crow(r, hi)) * 1024 + col0 + r32; cout[o] = ci[r] + gate * (acc[r] + X[r * 64 + F.lane]); }
  }
}
__device__ __forceinline__ void p5_outproj(const Frame& F, const Args& a, int layer) {
  unsigned char* ws = opq(a.ws);
  const int M = MLAT;
  pg8::Gemm g{(const pg8::bf16_t*)(ws + WS_H), (const pg8::bf16_t*)(ws + WS_W2T) + (size_t)layer * 1024 * 1024, M, 1024, 1024};
  pg8::StaticOrder S; S.init(M, 1024, F.G, (int)blockIdx.x);
  EpiOut E{layer == 0 ? opq(a.in[0]) : opq(a.out), layer == 0 ? opq(a.in[2]) : (const float*)(ws + WS_CTX1), opq(a.out), (float*)(ws + WS_CTX1), (const float*)(ws + WS_MOD) + (size_t)layer * 5 * 3072};
  pg8::gemm_phase<EpiOut, pg8::StaticOrder>(F.lds, g, S, E, nullptr);
  if (layer == 0) { const Frame F2 = relaunder(F); for (int it = F2.vcu; it < 256; it += F2.G) ctx_out_item(F2, a, it); }
}
}

namespace mk {
typedef short v4i16_t __attribute__((ext_vector_type(4)));
__device__ __forceinline__ s16x4 vtr(LAS const unsigned char* p) { return __builtin_bit_cast(s16x4, __builtin_amdgcn_ds_read_tr16_b64_v4i16((LAS v4i16_t*)p)); }
struct AttnState { float m, l; f32x16 o0, o1; };
template <class MaskF>
__device__ __forceinline__ void attn_tile(AttnState& st, const bf16x8 (&qf)[4], LAS const unsigned char* Kt, LAS const unsigned char* Vt, int lane, MaskF&& maskf) {
  const int r32 = lane & 31, hi = lane >> 5;
  f32x16 p0, p1;
  const int ksw = (r32 >> 1) & 7;
  bf16x8 ka[4], kb[4];
#pragma unroll
  for (int s = 0; s < 4; ++s) { const int ch = ((2 * s + hi) ^ ksw) << 4; ka[s] = *(LAS const bf16x8*)(Kt + r32 * 128 + ch); kb[s] = *(LAS const bf16x8*)(Kt + (32 + r32) * 128 + ch); }
  { const f32x16 z = {0.f, 0.f, 0.f, 0.f, 0.f, 0.f, 0.f, 0.f, 0.f, 0.f, 0.f, 0.f, 0.f, 0.f, 0.f, 0.f};
    p0 = __builtin_amdgcn_mfma_f32_32x32x16_bf16(ka[0], qf[0], z, 0, 0, 0); p1 = __builtin_amdgcn_mfma_f32_32x32x16_bf16(kb[0], qf[0], z, 0, 0, 0); }
#pragma unroll
  for (int s = 1; s < 4; ++s) { p0 = __builtin_amdgcn_mfma_f32_32x32x16_bf16(ka[s], qf[s], p0, 0, 0, 0); p1 = __builtin_amdgcn_mfma_f32_32x32x16_bf16(kb[s], qf[s], p1, 0, 0, 0); }
  maskf(p0, p1);
  float ps = 0.f;
#pragma unroll
  for (int i = 0; i < 16; ++i) { p0[i] = __builtin_amdgcn_exp2f(p0[i]); p1[i] = __builtin_amdgcn_exp2f(p1[i]); ps += p0[i] + p1[i]; }
  st.l += ps;
  u32x4 pw[4];
#pragma unroll
  for (int k = 0; k < 2; ++k) {
    pw[k] = (u32x4){pk2(p0[8 * k + 0], p0[8 * k + 1]), pk2(p0[8 * k + 2], p0[8 * k + 3]), pk2(p0[8 * k + 4], p0[8 * k + 5]), pk2(p0[8 * k + 6], p0[8 * k + 7])};
    pw[2 + k] = (u32x4){pk2(p1[8 * k + 0], p1[8 * k + 1]), pk2(p1[8 * k + 2], p1[8 * k + 3]), pk2(p1[8 * k + 4], p1[8 * k + 5]), pk2(p1[8 * k + 6], p1[8 * k + 7])};
  }
  const int q = (lane & 15) >> 2, p = lane & 3, gsel = (lane >> 4) & 1;
  const int vrow = (4 * hi + q) * 128 + 8 * (p & 1);
  const int chb = 2 * gsel + (p >> 1);
#pragma unroll
  for (int ks = 0; ks < 4; ++ks) {
    const int c0_ = ((chb | ((0 ^ (q >> 1)) << 2)) << 4), c1_ = ((chb | ((1 ^ (q >> 1)) << 2)) << 4);
    const s16x4 l0 = vtr(Vt + ks * 2048 + vrow + c0_), h0 = vtr(Vt + ks * 2048 + 1024 + vrow + c0_), l1 = vtr(Vt + ks * 2048 + vrow + c1_), h1 = vtr(Vt + ks * 2048 + 1024 + vrow + c1_);
    const bf16x8 va0 = (bf16x8){l0[0], l0[1], l0[2], l0[3], h0[0], h0[1], h0[2], h0[3]}, va1 = (bf16x8){l1[0], l1[1], l1[2], l1[3], h1[0], h1[1], h1[2], h1[3]};
    st.o0 = __builtin_amdgcn_mfma_f32_32x32x16_bf16(va0, __builtin_bit_cast(bf16x8, pw[ks]), st.o0, 0, 0, 0);
    st.o1 = __builtin_amdgcn_mfma_f32_32x32x16_bf16(va1, __builtin_bit_cast(bf16x8, pw[ks]), st.o1, 0, 0, 0);
  }
}
template <class MaskF, class F1, class F2, class F3>
__device__ __forceinline__ void attn_tile_dma(AttnState& st, const bf16x8 (&qf)[4], LAS const unsigned char* Kt, LAS const unsigned char* Vt, int lane, MaskF&& maskf, F1&& after_k, F2&& before_v, F3&& after_v) {
  const int r32 = lane & 31, hi = lane >> 5;
  f32x16 p0, p1;
  const int ksw = (r32 >> 1) & 7;
  bf16x8 ka[4], kb[4];
#pragma unroll
  for (int s = 0; s < 4; ++s) { const int ch = ((2 * s + hi) ^ ksw) << 4; ka[s] = *(LAS const bf16x8*)(Kt + r32 * 128 + ch); kb[s] = *(LAS const bf16x8*)(Kt + (32 + r32) * 128 + ch); }
  asm volatile("s_waitcnt lgkmcnt(0)" ::: "memory");
  after_k();
  { const f32x16 z = {0.f, 0.f, 0.f, 0.f, 0.f, 0.f, 0.f, 0.f, 0.f, 0.f, 0.f, 0.f, 0.f, 0.f, 0.f, 0.f};
    p0 = __builtin_amdgcn_mfma_f32_32x32x16_bf16(ka[0], qf[0], z, 0, 0, 0); p1 = __builtin_amdgcn_mfma_f32_32x32x16_bf16(kb[0], qf[0], z, 0, 0, 0); }
#pragma unroll
  for (int s = 1; s < 4; ++s) { p0 = __builtin_amdgcn_mfma_f32_32x32x16_bf16(ka[s], qf[s], p0, 0, 0, 0); p1 = __builtin_amdgcn_mfma_f32_32x32x16_bf16(kb[s], qf[s], p1, 0, 0, 0); }
  maskf(p0, p1);
  float ps = 0.f;
#pragma unroll
  for (int i = 0; i < 16; ++i) { p0[i] = __builtin_amdgcn_exp2f(p0[i]); p1[i] = __builtin_amdgcn_exp2f(p1[i]); ps += p0[i] + p1[i]; }
  st.l += ps;
  u32x4 pw[4];
#pragma unroll
  for (int k = 0; k < 2; ++k) {
    pw[k] = (u32x4){pk2(p0[8 * k + 0], p0[8 * k + 1]), pk2(p0[8 * k + 2], p0[8 * k + 3]), pk2(p0[8 * k + 4], p0[8 * k + 5]), pk2(p0[8 * k + 6], p0[8 * k + 7])};
    pw[2 + k] = (u32x4){pk2(p1[8 * k + 0], p1[8 * k + 1]), pk2(p1[8 * k + 2], p1[8 * k + 3]), pk2(p1[8 * k + 4], p1[8 * k + 5]), pk2(p1[8 * k + 6], p1[8 * k + 7])};
  }
  before_v();
  const int q = (lane & 15) >> 2, p = lane & 3, gsel = (lane >> 4) & 1;
  const int vrow = (4 * hi + q) * 128 + 8 * (p & 1);
  const int chb = 2 * gsel + (p >> 1);
  s16x4 vl0[4], vh0[4], vl1[4], vh1[4];
#pragma unroll
  for (int ks = 0; ks < 4; ++ks) {
    const int c0_ = ((chb | ((0 ^ (q >> 1)) << 2)) << 4), c1_ = ((chb | ((1 ^ (q >> 1)) << 2)) << 4);
    vl0[ks] = vtr(Vt + ks * 2048 + vrow + c0_); vh0[ks] = vtr(Vt + ks * 2048 + 1024 + vrow + c0_); vl1[ks] = vtr(Vt + ks * 2048 + vrow + c1_); vh1[ks] = vtr(Vt + ks * 2048 + 1024 + vrow + c1_);
  }
  asm volatile("s_waitcnt lgkmcnt(0)" ::: "memory");
  after_v();
#pragma unroll
  for (int ks = 0; ks < 4; ++ks) {
    const bf16x8 va0 = (bf16x8){vl0[ks][0], vl0[ks][1], vl0[ks][2], vl0[ks][3], vh0[ks][0], vh0[ks][1], vh0[ks][2], vh0[ks][3]}, va1 = (bf16x8){vl1[ks][0], vl1[ks][1], vl1[ks][2], vl1[ks][3], vh1[ks][0], vh1[ks][1], vh1[ks][2], vh1[ks][3]};
    st.o0 = __builtin_amdgcn_mfma_f32_32x32x16_bf16(va0, __builtin_bit_cast(bf16x8, pw[ks]), st.o0, 0, 0, 0);
    st.o1 = __builtin_amdgcn_mfma_f32_32x32x16_bf16(va1, __builtin_bit_cast(bf16x8, pw[ks]), st.o1, 0, 0, 0);
  }
}
__device__ __forceinline__ void glds16(const void* sbase  , unsigned voff  , unsigned lds_dst) {
  unsigned keep;
  asm volatile("s_mov_b32 %0, m0\n\ts_mov_b32 m0, %2\n\ts_nop 0\n\tglobal_load_lds_dwordx4 %1, %3\n\ts_mov_b32 m0, %0" : "=&s"(keep) : "v"(voff), "s"(lds_dst), "s"(sbase) : "memory");
}
__device__ __forceinline__ void glds16x8(const void* sbase, const unsigned (&vo)[8], unsigned lds_dst) {
  unsigned keep;
  asm volatile("s_mov_b32 %0, m0\n\ts_mov_b32 m0, %9\n\ts_nop 0\n\tglobal_load_lds_dwordx4 %1, %10\n\t"
               "s_add_u32 m0, m0, 0x400\n\ts_nop 0\n\tglobal_load_lds_dwordx4 %2, %10\n\t"
               "s_add_u32 m0, m0, 0x400\n\ts_nop 0\n\tglobal_load_lds_dwordx4 %3, %10\n\t"
               "s_add_u32 m0, m0, 0x400\n\ts_nop 0\n\tglobal_load_lds_dwordx4 %4, %10\n\t"
               "s_add_u32 m0, m0, 0x400\n\ts_nop 0\n\tglobal_load_lds_dwordx4 %5, %10\n\t"
               "s_add_u32 m0, m0, 0x400\n\ts_nop 0\n\tglobal_load_lds_dwordx4 %6, %10\n\t"
               "s_add_u32 m0, m0, 0x400\n\ts_nop 0\n\tglobal_load_lds_dwordx4 %7, %10\n\t"
               "s_add_u32 m0, m0, 0x400\n\ts_nop 0\n\tglobal_load_lds_dwordx4 %8, %10\n\t"
               "s_mov_b32 m0, %0"
               : "=&s"(keep) : "v"(vo[0]), "v"(vo[1]), "v"(vo[2]), "v"(vo[3]), "v"(vo[4]), "v"(vo[5]), "v"(vo[6]), "v"(vo[7]), "s"(lds_dst), "s"(sbase) : "memory", "scc");
}
__device__ __forceinline__ void attn_store(const AttnState& st, float inv, const bf16* grow  , bf16* yrow  , int lane) {
  const int hi = lane >> 5;
  u32x2 gv[8];
#pragma unroll
  for (int i = 0; i < 8; ++i) gv[i] = *(const u32x2*)(grow + 32 * (i >> 2) + 8 * (i & 3) + 4 * hi);
  __builtin_amdgcn_sched_barrier(0);
#pragma unroll
  for (int d0 = 0; d0 < 2; ++d0)
#pragma unroll
    for (int gi = 0; gi < 4; ++gi) {
      const int db = 32 * d0 + 8 * gi + 4 * hi; const u32x2 g = gv[4 * d0 + gi];
      const f32x16& o = d0 == 0 ? st.o0 : st.o1;
      const float g0 = __uint_as_float(g.x << 16), g1 = __uint_as_float(g.x & 0xffff0000u), g2 = __uint_as_float(g.y << 16), g3 = __uint_as_float(g.y & 0xffff0000u);
      u32x2 ov; ov.x = pk2(o[4 * gi + 0] * inv * g0, o[4 * gi + 1] * inv * g1); ov.y = pk2(o[4 * gi + 2] * inv * g2, o[4 * gi + 3] * inv * g3);
      *(u32x2*)(yrow + db) = ov;
    }
}
__device__ __forceinline__ void attn_gates(u32x2 (&gv)[8], const bf16* grow, int lane) {
  const int hi = lane >> 5;
#pragma unroll
  for (int i = 0; i < 8; ++i) gv[i] = *(const u32x2*)(grow + 32 * (i >> 2) + 8 * (i & 3) + 4 * hi);
}
__device__ __forceinline__ void attn_store_g(const AttnState& st, float inv, const u32x2 (&gv)[8], bf16* yrow, int lane) {
  const int hi = lane >> 5;
#pragma unroll
  for (int d0 = 0; d0 < 2; ++d0)
#pragma unroll
    for (int gi = 0; gi < 4; ++gi) {
      const int db = 32 * d0 + 8 * gi + 4 * hi; const u32x2 g = gv[4 * d0 + gi];
      const f32x16& o = d0 == 0 ? st.o0 : st.o1;
      const float g0 = __uint_as_float(g.x << 16), g1 = __uint_as_float(g.x & 0xffff0000u), g2 = __uint_as_float(g.y << 16), g3 = __uint_as_float(g.y & 0xffff0000u);
      u32x2 ov; ov.x = pk2(o[4 * gi + 0] * inv * g0, o[4 * gi + 1] * inv * g1); ov.y = pk2(o[4 * gi + 2] * inv * g2, o[4 * gi + 3] * inv * g3);
      *(u32x2*)(yrow + db) = ov;
    }
}
template <int NH> struct TileRegs { u32x4 k[NH], v[NH]; };
template <int NH>
__device__ __forceinline__ void tile_load(TileRegs<NH>& R, const bf16* kbase  , const bf16* vbase, int tid) {
  const int key = tid >> 3, ch = tid & 7;
#pragma unroll
  for (int h = 0; h < NH; ++h) { R.k[h] = *(const u32x4*)(kbase + (size_t)key * PLW + h * 64 + ch * 8); R.v[h] = *(const u32x4*)(vbase + (size_t)key * PLW + h * 64 + ch * 8); }
}
template <int NH>
__device__ __forceinline__ void tile_store(const TileRegs<NH>& R, LAS unsigned char* buf, int tid) {
  const int key = tid >> 3, ch = tid & 7;
  const int ko = key * 128 + ((ch ^ ((key >> 1) & 7)) << 4), vo = key * 128 + ((ch ^ (((key >> 1) & 1) << 2)) << 4);
#pragma unroll
  for (int h = 0; h < NH; ++h) { *(LAS u32x4*)(buf + h * 8192 + ko) = R.k[h]; *(LAS u32x4*)(buf + NH * 8192 + h * 8192 + vo) = R.v[h]; }
}

template <int NH> struct TileRegs2 { TileRegs<NH> a, b; };
__device__ __forceinline__ void swa_item(const Frame& F0, const Args& a, int layer, int item) {
  const Frame F = relaunder(F0);
  unsigned char* ws = opq(a.ws);
  const bf16* PLB = (const bf16*)(ws + WS_PLB); bf16* Y = (bf16*)(ws + WS_H);
  const bool isctx = item >= 256;
  int b, kvh, n;
  if (!isctx) { b = item >> 6; kvh = (item >> 5) & 1; n = item & 31; } else { const int ci = item - 256; b = ci >> 2; kvh = (ci >> 1) & 1; n = ci & 1; }
  const int g = F.wave >> 2, quarter = F.wave & 3, hq = 2 * kvh + g, r32 = F.lane & 31, hi = F.lane >> 5;
  const int tq = 128 * n + 32 * quarter + r32;
  const size_t qrow = isctx ? (size_t)MLAT + b * CTX + tq : (size_t)b * SEQ + tq;
  bf16x8 qf[4];
#pragma unroll
  for (int s = 0; s < 4; ++s) qf[s] = *(const bf16x8*)(PLB + qrow * PLW + S_CQ * 256 + hq * 64 + 16 * s + 8 * hi);
  int jlo = 0, jhi = 0;
  if (!isctx) { jlo = n == 0 ? 1 : 0; jhi = n == 31 ? 2 : 3; }
  const int nloc = jhi - jlo, T = nloc + 2;
  const bf16* kcol = PLB + S_CKV * 256 + kvh * 64;
  auto tile_row = [&](int t) -> size_t { return t < nloc ? (size_t)b * SEQ + 128 * (n - 1 + jlo + t) : (size_t)MLAT + b * CTX + 128 * (t - nloc); };
  AttnState st; st.m = 0.f; st.l = 0.f;
#pragma unroll
  for (int i = 0; i < 16; ++i) { st.o0[i] = 0.f; st.o1[i] = 0.f; }
  TileRegs2<1> R;
  __syncthreads();
  { const size_t r0 = tile_row(0); tile_load<1>(R.a, kcol + r0 * PLW, kcol + 128 + r0 * PLW, F.tid); tile_load<1>(R.b, kcol + (r0 + 64) * PLW, kcol + 128 + (r0 + 64) * PLW, F.tid); }
  tile_store<1>(R.a, F.lds, F.tid); tile_store<1>(R.b, F.lds + 16384, F.tid);
  __syncthreads();
  for (int t = 0; t < T; ++t) {
    if (t + 1 < T) { const size_t r0 = tile_row(t + 1); tile_load<1>(R.a, kcol + r0 * PLW, kcol + 128 + r0 * PLW, F.tid); tile_load<1>(R.b, kcol + (r0 + 64) * PLW, kcol + 128 + (r0 + 64) * PLW, F.tid); }
    LAS const unsigned char* buf = F.lds + (t & 1) * 32768;
#pragma unroll
    for (int hf = 0; hf < 2; ++hf) {
      LAS const unsigned char* hb = buf + hf * 16384;
      if (t < nloc) {
        const int kb = 128 * (n - 1 + jlo + t) + 64 * hf, q0 = 128 * n + 32 * quarter;
        if (!(kb + 63 < q0 - 128 || kb > q0 + 31 + 128)) {
          const int dq = kb - tq;
          if (kb >= q0 + 31 - 128 && kb + 63 <= q0 + 128) attn_tile(st, qf, hb, hb + 8192, F.lane, [](f32x16&, f32x16&) {});
          else attn_tile(st, qf, hb, hb + 8192, F.lane, [&](f32x16& p0, f32x16& p1) {
#pragma unroll
            for (int r = 0; r < 16; ++r) { const int d0_ = dq + 128 + crow(r, hi), d1_ = d0_ + 32;
              p0[r] = ((unsigned)d0_ <= 256u) ? p0[r] : -INFINITY; p1[r] = ((unsigned)d1_ <= 256u) ? p1[r] : -INFINITY; } });
        }
      } else attn_tile(st, qf, hb, hb + 8192, F.lane, [](f32x16&, f32x16&) {});
    }
    if (t + 1 < T) { tile_store<1>(R.a, F.lds + ((t + 1) & 1) * 32768, F.tid); tile_store<1>(R.b, F.lds + ((t + 1) & 1) * 32768 + 16384, F.tid); }
    __syncthreads();
  }
  float l = st.l + __shfl_xor(st.l, 32);
  const float sk2 = opq(a.in[15])[layer * 4 + hq] * LOG2E;
  const float mnew = fmaxf(st.m, sk2), al = __builtin_amdgcn_exp2f(st.m - mnew);
  l = l * al + __builtin_amdgcn_exp2f(sk2 - mnew);
  int qr = (int)qrow; asm volatile("" : "+v"(qr));
  attn_store(st, al / l, PLB + (size_t)qr * PLW + S_CG * 256 + hq * 64, Y + (size_t)qr * 1024 + 512 + hq * 64, F.lane);
}
__device__ __forceinline__ void na_item(const Frame& F0, const Args& a, int layer, int item) {
  const Frame F = relaunder(F0);
  unsigned char* ws = opq(a.ws);
  const bf16* PLB = (const bf16*)(ws + WS_PLB); bf16* Y = (bf16*)(ws + WS_H);
  const bool isctx = item >= 256;
  int b, r;
  if (!isctx) { b = item >> 6; r = item & 63; } else { const int ci = item - 256; b = ci >> 2; r = ci & 3; }
  const int head = F.wave >> 1, half = F.wave & 1, r32 = F.lane & 31, hi = F.lane >> 5;
  const int qc = 32 * half + r32;
  const size_t qrow = isctx ? (size_t)MLAT + b * CTX + 64 * r + qc : (size_t)b * SEQ + 64 * r + qc;
  bf16x8 qf[4];
#pragma unroll
  for (int s = 0; s < 4; ++s) qf[s] = *(const bf16x8*)(PLB + qrow * PLW + S_DQ * 256 + head * 64 + 16 * s + 8 * hi);
  int rs = r - 4; rs = rs < 0 ? 0 : (rs > 56 ? 56 : rs);
  const int nloc = isctx ? 0 : 8, T = nloc + 4;
  auto tile_row = [&](int t) -> size_t { return t < nloc ? (size_t)b * SEQ + 64 * (rs + t) : (size_t)MLAT + b * CTX + 64 * (t - nloc); };
  const bf16* kcol = PLB + S_DK * 256 + head * 64; const bf16* vcol = PLB + S_DV * 256 + head * 64;
  LAS float* btab = (LAS float*)(F.lds + 2 * 65536);
  LAS unsigned char* Kt = F.lds + F.wave * 16384; LAS unsigned char* Vt = Kt + 8192;
  const unsigned kdst = (unsigned)(size_t)Kt, vdst = kdst + 8192u;
  const int kk = F.lane >> 3, cs = F.lane & 7;
  const unsigned ok0 = kk * (PLW * 2) + ((cs ^ (kk >> 1)) << 4), ok1 = kk * (PLW * 2) + ((cs ^ (4 + (kk >> 1))) << 4), ov = kk * (PLW * 2) + ((cs ^ (((kk >> 1) & 1) << 2)) << 4);
  unsigned vok[8], vov[8];
#pragma unroll
  for (int n = 0; n < 8; ++n) { vok[n] = ((n & 1) ? ok1 : ok0) + n * 8 * (PLW * 2); vov[n] = ov + n * 8 * (PLW * 2); }
  auto dma_k = [&](int t) { glds16x8(kcol + tile_row(t) * PLW, vok, kdst); };
  auto dma_v = [&](int t) { glds16x8(vcol + tile_row(t) * PLW, vov, vdst); };
  AttnState st; st.m = 0.f; st.l = 0.f;
#pragma unroll
  for (int i = 0; i < 16; ++i) { st.o0[i] = 0.f; st.o1[i] = 0.f; }
  u32x2 gv[8];
  { int qr0 = (int)qrow; asm volatile("" : "+v"(qr0)); attn_gates(gv, PLB + (size_t)qr0 * PLW + S_DG * 256 + head * 64, F.lane); }
  float t_[15];
  { const float* rb = opq(a.in[18]) + (size_t)layer * 4 * 15 * 31;
#pragma unroll
    for (int i = 0; i < 15; ++i) { const int ix = F.tid + 512 * i, hd = ix >> 7, dx = (ix & 127) - 63; const int dc = dx < -15 ? -15 : (dx > 15 ? 15 : dx); t_[i] = rb[hd * 31 + dc + 15]; } }
  __builtin_amdgcn_sched_barrier(0);
#pragma unroll
  for (int s = 0; s < 4; ++s) asm volatile("" : "+v"(qf[s]));
#pragma unroll
  for (int i = 0; i < 15; ++i) asm volatile("" : "+v"(t_[i]));
#pragma unroll
  for (int i = 0; i < 8; ++i) asm volatile("" : "+v"(gv[i]));
  __syncthreads();
  dma_k(0); dma_v(0);
#pragma unroll
  for (int i = 0; i < 15; ++i) { const int dx = ((F.tid + 512 * i) & 127) - 63; btab[F.tid + 512 * i] = (dx >= -15 && dx <= 15) ? t_[i] * LOG2E : 0.f; }
  __syncthreads();
  int c0 = qc - 8; c0 = c0 < 0 ? 0 : (c0 > 48 ? 48 : c0);
  for (int t = 0; t < T; ++t) {
    const bool more = t + 1 < T;
    asm volatile("s_waitcnt vmcnt(8)" ::: "memory");
    auto after_k = [&]() { if (more) dma_k(t + 1); };
    auto before_v = [&]() { if (more) asm volatile("s_waitcnt vmcnt(8)" ::: "memory"); else asm volatile("s_waitcnt vmcnt(0)" ::: "memory"); };
    auto after_v = [&]() { if (more) dma_v(t + 1); };
    if (t < nloc) {
      const int dy = rs + t - r + 7;
      const int c0l = c0;
      unsigned bta = (unsigned)(size_t)(btab + (head * 15 + dy) * 128 + 63 - qc + 4 * hi); asm volatile("" : "+v"(bta));
      LAS const float* bt = (LAS const float*)bta;
      attn_tile_dma(st, qf, Kt, Vt, F.lane, [&](f32x16& p0, f32x16& p1) {
        float bb[16];
#pragma unroll
        for (int rr = 0; rr < 16; ++rr) bb[rr] = bt[(rr & 3) + 8 * (rr >> 2)];
#pragma unroll
        for (int rr = 0; rr < 16; ++rr) p0[rr] = ((unsigned)((rr & 3) + 8 * (rr >> 2) + 4 * hi - c0l) < 16u) ? p0[rr] + bb[rr] : -INFINITY;
#pragma unroll
        for (int rr = 0; rr < 16; ++rr) bb[rr] = bt[(rr & 3) + 8 * (rr >> 2) + 32];
#pragma unroll
        for (int rr = 0; rr < 16; ++rr) p1[rr] = ((unsigned)((rr & 3) + 8 * (rr >> 2) + 32 + 4 * hi - c0l) < 16u) ? p1[rr] + bb[rr] : -INFINITY; }, after_k, before_v, after_v);
    } else attn_tile_dma(st, qf, Kt, Vt, F.lane, [](f32x16&, f32x16&) {}, after_k, before_v, after_v);
  }
  const float l = st.l + __shfl_xor(st.l, 32);
  int qr = (int)qrow; asm volatile("" : "+v"(qr));
  attn_store_g(st, 1.f / l, gv, Y + (size_t)qr * 1024 + 768 + head * 64, F.lane);
}
}

namespace mk {
struct Attn2 { float l[2]; f32x16 o[2][2]; };
template <class ProbF, class F1, class F2, class F3>
__device__ __forceinline__ void attn2_tile(Attn2& st, const bf16x8 (&qf)[2][4], LAS const unsigned char* Kt, LAS const unsigned char* Vt, int lane, ProbF&& probf, F1&& after_k, F2&& before_v, F3&& after_v) {
  const int r32 = lane & 31, hi = lane >> 5;
  const int ksw = (r32 >> 1) & 7;
  bf16x8 ka[4], kb[4];
#pragma unroll
  for (int s = 0; s < 4; ++s) { const int ch = ((2 * s + hi) ^ ksw) << 4; ka[s] = *(LAS const bf16x8*)(Kt + r32 * 128 + ch); kb[s] = *(LAS const bf16x8*)(Kt + (32 + r32) * 128 + ch); }
  asm volatile("s_waitcnt lgkmcnt(0)" ::: "memory");
  after_k();
  u32x4 pw[2][4];
#pragma unroll
  for (int qb = 0; qb < 2; ++qb) {
    f32x16 p0, p1;
    { const f32x16 z = {0.f, 0.f, 0.f, 0.f, 0.f, 0.f, 0.f, 0.f, 0.f, 0.f, 0.f, 0.f, 0.f, 0.f, 0.f, 0.f};
      p0 = __builtin_amdgcn_mfma_f32_32x32x16_bf16(ka[0], qf[qb][0], z, 0, 0, 0); p1 = __builtin_amdgcn_mfma_f32_32x32x16_bf16(kb[0], qf[qb][0], z, 0, 0, 0); }
#pragma unroll
    for (int s = 1; s < 4; ++s) { p0 = __builtin_amdgcn_mfma_f32_32x32x16_bf16(ka[s], qf[qb][s], p0, 0, 0, 0); p1 = __builtin_amdgcn_mfma_f32_32x32x16_bf16(kb[s], qf[qb][s], p1, 0, 0, 0); }
    probf(qb, p0, p1);
    float ps = 0.f;
#pragma unroll
    for (int i = 0; i < 16; ++i) ps += p0[i] + p1[i];
    st.l[qb] += ps;
#pragma unroll
    for (int k = 0; k < 2; ++k) {
      pw[qb][k] = (u32x4){pk2(p0[8 * k + 0], p0[8 * k + 1]), pk2(p0[8 * k + 2], p0[8 * k + 3]), pk2(p0[8 * k + 4], p0[8 * k + 5]), pk2(p0[8 * k + 6], p0[8 * k + 7])};
      pw[qb][2 + k] = (u32x4){pk2(p1[8 * k + 0], p1[8 * k + 1]), pk2(p1[8 * k + 2], p1[8 * k + 3]), pk2(p1[8 * k + 4], p1[8 * k + 5]), pk2(p1[8 * k + 6], p1[8 * k + 7])};
    }
  }
  before_v();
  const int q = (lane & 15) >> 2, p = lane & 3, gsel = (lane >> 4) & 1;
  const int vrow = (4 * hi + q) * 128 + 8 * (p & 1);
  const int chb = 2 * gsel + (p >> 1);
  s16x4 vl0[4], vh0[4], vl1[4], vh1[4];
#pragma unroll
  for (int ks = 0; ks < 4; ++ks) {
    const int c0_ = ((chb | ((0 ^ (q >> 1)) << 2)) << 4), c1_ = ((chb | ((1 ^ (q >> 1)) << 2)) << 4);
    vl0[ks] = vtr(Vt + ks * 2048 + vrow + c0_); vh0[ks] = vtr(Vt + ks * 2048 + 1024 + vrow + c0_); vl1[ks] = vtr(Vt + ks * 2048 + vrow + c1_); vh1[ks] = vtr(Vt + ks * 2048 + 1024 + vrow + c1_);
  }
  asm volatile("s_waitcnt lgkmcnt(0)" ::: "memory");
  after_v();
#pragma unroll
  for (int ks = 0; ks < 4; ++ks) {
    const bf16x8 va0 = (bf16x8){vl0[ks][0], vl0[ks][1], vl0[ks][2], vl0[ks][3], vh0[ks][0], vh0[ks][1], vh0[ks][2], vh0[ks][3]}, va1 = (bf16x8){vl1[ks][0], vl1[ks][1], vl1[ks][2], vl1[ks][3], vh1[ks][0], vh1[ks][1], vh1[ks][2], vh1[ks][3]};
#pragma unroll
    for (int qb = 0; qb < 2; ++qb) {
      st.o[qb][0] = __builtin_amdgcn_mfma_f32_32x32x16_bf16(va0, __builtin_bit_cast(bf16x8, pw[qb][ks]), st.o[qb][0], 0, 0, 0);
      st.o[qb][1] = __builtin_amdgcn_mfma_f32_32x32x16_bf16(va1, __builtin_bit_cast(bf16x8, pw[qb][ks]), st.o[qb][1], 0, 0, 0);
    }
  }
}
struct DmaLane { unsigned ok0, ok1, ov; };
__device__ __forceinline__ DmaLane dma_lane(int lane) {
  const int kk = lane >> 3, cs = lane & 7; DmaLane d;
  d.ok0 = kk * (PLW * 2) + ((cs ^ (kk >> 1)) << 4); d.ok1 = kk * (PLW * 2) + ((cs ^ (4 + (kk >> 1))) << 4); d.ov = kk * (PLW * 2) + ((cs ^ (((kk >> 1) & 1) << 2)) << 4); return d;
}
__device__ __forceinline__ void dma_tile_k(const bf16* krow0  , const DmaLane& d, unsigned kdst) {
  const unsigned char* tb = (const unsigned char*)krow0;
#pragma unroll
  for (int n = 0; n < 8; ++n) glds16(tb + (size_t)n * 8 * (PLW * 2), (n & 1) ? d.ok1 : d.ok0, kdst + n * 1024);
}
__device__ __forceinline__ void dma_tile_v(const bf16* vrow0, const DmaLane& d, unsigned vdst) {
  const unsigned char* tb = (const unsigned char*)vrow0;
#pragma unroll
  for (int n = 0; n < 8; ++n) glds16(tb + (size_t)n * 8 * (PLW * 2), d.ov, vdst + n * 1024);
}
__device__ __forceinline__ void attn2_exchange(const Attn2& st, int par, AttnState& fin, const Frame& F) {
  LAS float* X = (LAS float*)(F.lds + F.wave * 16384);
  LAS const float* XP = (LAS const float*)(F.lds + (F.wave ^ 1) * 16384);
  if (par == 0) {
#pragma unroll
    for (int i = 0; i < 16; ++i) { X[i * 64 + F.lane] = st.o[1][0][i]; X[(16 + i) * 64 + F.lane] = st.o[1][1][i]; }
    X[32 * 64 + F.lane] = st.l[1];
  } else {
#pragma unroll
    for (int i = 0; i < 16; ++i) { X[i * 64 + F.lane] = st.o[0][0][i]; X[(16 + i) * 64 + F.lane] = st.o[0][1][i]; }
    X[32 * 64 + F.lane] = st.l[0];
  }
  __syncthreads();
  if (par == 0) {
#pragma unroll
    for (int i = 0; i < 16; ++i) { fin.o0[i] = st.o[0][0][i] + XP[i * 64 + F.lane]; fin.o1[i] = st.o[0][1][i] + XP[(16 + i) * 64 + F.lane]; }
    fin.l = st.l[0] + XP[32 * 64 + F.lane];
  } else {
#pragma unroll
    for (int i = 0; i < 16; ++i) { fin.o0[i] = st.o[1][0][i] + XP[i * 64 + F.lane]; fin.o1[i] = st.o[1][1][i] + XP[(16 + i) * 64 + F.lane]; }
    fin.l = st.l[1] + XP[32 * 64 + F.lane];
  }
  fin.m = 0.f;
}
__device__ __forceinline__ void exp_all(f32x16& p0, f32x16& p1) {
#pragma unroll
  for (int i = 0; i < 16; ++i) { p0[i] = __builtin_amdgcn_exp2f(p0[i]); p1[i] = __builtin_amdgcn_exp2f(p1[i]); }
}

__device__ __forceinline__ void na_item2(const Frame& F0, const Args& a, int layer, int item) {
  const Frame F = relaunder(F0);
  unsigned char* ws = opq(a.ws);
  const bf16* PLB = (const bf16*)(ws + WS_PLB); bf16* Y = (bf16*)(ws + WS_H);
  const bool isctx = item >= 256;
  int b, r;
  if (!isctx) { b = item >> 6; r = item & 63; } else { const int ci = item - 256; b = ci >> 2; r = ci & 3; }
  const int head = F.wave >> 1, par = F.wave & 1, r32 = F.lane & 31, hi = F.lane >> 5;
  const size_t qrow0 = isctx ? (size_t)MLAT + b * CTX + 64 * r : (size_t)b * SEQ + 64 * r;
  bf16x8 qf[2][4];
#pragma unroll
  for (int qb = 0; qb < 2; ++qb)
#pragma unroll
    for (int s = 0; s < 4; ++s) qf[qb][s] = *(const bf16x8*)(PLB + (qrow0 + 32 * qb + r32) * PLW + S_DQ * 256 + head * 64 + 16 * s + 8 * hi);
  int rs = r - 4; rs = rs < 0 ? 0 : (rs > 56 ? 56 : rs);
  const int T = isctx ? 4 : 12;
  auto tile_row = [&](int t) -> size_t { return t < 4 ? (size_t)MLAT + b * CTX + 64 * t : (size_t)b * SEQ + 64 * (rs + t - 4); };
  const bf16* kcol = PLB + S_DK * 256 + head * 64; const bf16* vcol = PLB + S_DV * 256 + head * 64;
  LAS float* btab = (LAS float*)(F.lds + 2 * 65536);
  LAS unsigned char* Kt = F.lds + F.wave * 16384; LAS unsigned char* Vt = Kt + 8192;
  const unsigned kdst = (unsigned)(size_t)Kt, vdst = kdst + 8192u;
  const DmaLane dl = dma_lane(F.lane);
  Attn2 st; st.l[0] = 0.f; st.l[1] = 0.f;
#pragma unroll
  for (int i = 0; i < 16; ++i) { st.o[0][0][i] = 0.f; st.o[0][1][i] = 0.f; st.o[1][0][i] = 0.f; st.o[1][1][i] = 0.f; }
#pragma unroll
  for (int qb = 0; qb < 2; ++qb)
#pragma unroll
    for (int s = 0; s < 4; ++s) asm volatile("" : "+v"(qf[qb][s]));
  __syncthreads();
  dma_tile_k(kcol + tile_row(par) * PLW, dl, kdst); dma_tile_v(vcol + tile_row(par) * PLW, dl, vdst);
  {
    const float* rb = opq(a.in[18]) + (size_t)layer * 4 * 15 * 31; float t_[15];
#pragma unroll
    for (int i = 0; i < 15; ++i) { const int ix = F.tid + 512 * i, hd = ix >> 7, dx = (ix & 127) - 63; const int dc = dx < -15 ? -15 : (dx > 15 ? 15 : dx); t_[i] = rb[hd * 31 + dc + 15]; }
    __builtin_amdgcn_sched_barrier(0);
#pragma unroll
    for (int i = 0; i < 15; ++i) { const int dx = ((F.tid + 512 * i) & 127) - 63; btab[F.tid + 512 * i] = (dx >= -15 && dx <= 15) ? t_[i] * LOG2E : 0.f; } }
  __syncthreads();
  const int c00 = r32 < 8 ? 0 : r32 - 8, c01 = r32 > 24 ? 48 : 24 + r32;
  for (int t = par; t < T; t += 2) {
    const bool more = t + 2 < T;
    asm volatile("s_waitcnt vmcnt(8)" ::: "memory");
    auto after_k = [&]() { if (more) dma_tile_k(kcol + tile_row(t + 2) * PLW, dl, kdst); };
    auto before_v = [&]() { if (more) asm volatile("s_waitcnt vmcnt(8)" ::: "memory"); else asm volatile("s_waitcnt vmcnt(0)" ::: "memory"); };
    auto after_v = [&]() { if (more) dma_tile_v(vcol + tile_row(t + 2) * PLW, dl, vdst); };
    if (t >= 4) {
      const int dy = rs + (t - 4) - r + 7;
      unsigned bta = (unsigned)(size_t)(btab + (head * 15 + dy) * 128 + 63 - r32 + 4 * hi); asm volatile("" : "+v"(bta));
      LAS const float* bt = (LAS const float*)bta;
      attn2_tile(st, qf, Kt, Vt, F.lane, [&](int qb, f32x16& p0, f32x16& p1) {
        if (qb == 0) {
#pragma unroll
          for (int rr = 0; rr < 16; ++rr) { const int kc = (rr & 3) + 8 * (rr >> 2); p0[rr] = ((unsigned)(kc + 4 * hi - c00) < 16u) ? __builtin_amdgcn_exp2f(p0[rr] + bt[kc]) : 0.f; }
#pragma unroll
          for (int rr = 0; rr < 4; ++rr) p1[rr] = ((unsigned)(32 + rr + 4 * hi - c00) < 16u) ? __builtin_amdgcn_exp2f(p1[rr] + bt[32 + rr]) : 0.f;
#pragma unroll
          for (int rr = 4; rr < 16; ++rr) p1[rr] = 0.f;
        } else {
#pragma unroll
          for (int rr = 0; rr < 12; ++rr) p0[rr] = 0.f;
#pragma unroll
          for (int rr = 12; rr < 16; ++rr) p0[rr] = ((unsigned)(12 + rr + 4 * hi - c01) < 16u) ? __builtin_amdgcn_exp2f(p0[rr] + bt[12 + rr - 32]) : 0.f;
#pragma unroll
          for (int rr = 0; rr < 16; ++rr) { const int kc = 32 + (rr & 3) + 8 * (rr >> 2); p1[rr] = ((unsigned)(kc + 4 * hi - c01) < 16u) ? __builtin_amdgcn_exp2f(p1[rr] + bt[kc - 32]) : 0.f; }
        } }, after_k, before_v, after_v);
    } else attn2_tile(st, qf, Kt, Vt, F.lane, [](int, f32x16& p0, f32x16& p1) { exp_all(p0, p1); }, after_k, before_v, after_v);
  }
  AttnState fin;
  attn2_exchange(st, par, fin, F);
  const float l = fin.l + __shfl_xor(fin.l, 32);
  int qr = (int)qrow0 + 32 * par + r32; asm volatile("" : "+v"(qr));
  attn_store(fin, 1.f / l, PLB + (size_t)qr * PLW + S_DG * 256 + head * 64, Y + (size_t)qr * 1024 + 768 + head * 64, F.lane);
}

__device__ __forceinline__ void swa_item2(const Frame& F0, const Args& a, int layer, int item) {
  const Frame F = relaunder(F0);
  unsigned char* ws = opq(a.ws);
  const bf16* PLB = (const bf16*)(ws + WS_PLB); bf16* Y = (bf16*)(ws + WS_H);
  const bool isctx = item >= 256;
  int b, kvh, n;
  if (!isctx) { b = item >> 6; kvh = (item >> 5) & 1; n = item & 31; } else { const int ci = item - 256; b = ci >> 2; kvh = (ci >> 1) & 1; n = ci & 1; }
  const int quarter = F.wave >> 1, par = F.wave & 1, r32 = F.lane & 31, hi = F.lane >> 5;
  const int q0 = 128 * n + 32 * quarter, tq = q0 + r32;
  const size_t qrow = isctx ? (size_t)MLAT + b * CTX + tq : (size_t)b * SEQ + tq;
  bf16x8 qf[2][4];
#pragma unroll
  for (int g = 0; g < 2; ++g)
#pragma unroll
    for (int s = 0; s < 4; ++s) qf[g][s] = *(const bf16x8*)(PLB + qrow * PLW + S_CQ * 256 + (2 * kvh + g) * 64 + 16 * s + 8 * hi);
  unsigned need = 0x3C0u;
  if (!isctx) {
#pragma unroll
    for (int hk = 0; hk < 6; ++hk) { const int kb = 128 * (n - 1) + 64 * hk; if (kb >= 0 && kb < SEQ && !(kb + 63 < q0 - 128 || kb > q0 + 31 + 128)) need |= 1u << hk; }
  }
  need = (unsigned)__builtin_amdgcn_readfirstlane((int)need);
  if (par) need &= need - 1u;
  auto tile_row = [&](int hk) -> size_t { return hk < 6 ? (size_t)b * SEQ + 128 * (n - 1) + 64 * hk : (size_t)MLAT + b * CTX + 64 * (hk - 6); };
  const bf16* kcol = PLB + S_CKV * 256 + kvh * 64; const bf16* vcol = kcol + 128;
  LAS unsigned char* Kt = F.lds + F.wave * 16384; LAS unsigned char* Vt = Kt + 8192;
  const unsigned kdst = (unsigned)(size_t)Kt, vdst = kdst + 8192u;
  const DmaLane dl = dma_lane(F.lane);
  Attn2 st; st.l[0] = 0.f; st.l[1] = 0.f;
#pragma unroll
  for (int i = 0; i < 16; ++i) { st.o[0][0][i] = 0.f; st.o[0][1][i] = 0.f; st.o[1][0][i] = 0.f; st.o[1][1][i] = 0.f; }
#pragma unroll
  for (int g = 0; g < 2; ++g)
#pragma unroll
    for (int s = 0; s < 4; ++s) asm volatile("" : "+v"(qf[g][s]));
  __syncthreads();
  if (need) { const int t0 = __builtin_ctz(need); dma_tile_k(kcol + tile_row(t0) * PLW, dl, kdst); dma_tile_v(vcol + tile_row(t0) * PLW, dl, vdst); }
  while (need) {
    const int t = __builtin_ctz(need);
    need &= need - 1u; need &= need - 1u;
    const bool more = need != 0u;
    const int tn = more ? __builtin_ctz(need) : 0;
    asm volatile("s_waitcnt vmcnt(8)" ::: "memory");
    auto after_k = [&]() { if (more) dma_tile_k(kcol + tile_row(tn) * PLW, dl, kdst); };
    auto before_v = [&]() { if (more) asm volatile("s_waitcnt vmcnt(8)" ::: "memory"); else asm volatile("s_waitcnt vmcnt(0)" ::: "memory"); };
    auto after_v = [&]() { if (more) dma_tile_v(vcol + tile_row(tn) * PLW, dl, vdst); };
    const int kb = 128 * (n - 1) + 64 * t;
    if (t < 6 && !(kb >= q0 + 31 - 128 && kb + 63 <= q0 + 128)) {
      const int dq = kb - tq + 128;
      attn2_tile(st, qf, Kt, Vt, F.lane, [&](int, f32x16& p0, f32x16& p1) {
#pragma unroll
        for (int rr = 0; rr < 16; ++rr) { const int d0_ = dq + crow(rr, hi), d1_ = d0_ + 32;
          p0[rr] = ((unsigned)d0_ <= 256u) ? __builtin_amdgcn_exp2f(p0[rr]) : 0.f; p1[rr] = ((unsigned)d1_ <= 256u) ? __builtin_amdgcn_exp2f(p1[rr]) : 0.f; } }, after_k, before_v, after_v);
    } else attn2_tile(st, qf, Kt, Vt, F.lane, [](int, f32x16& p0, f32x16& p1) { exp_all(p0, p1); }, after_k, before_v, after_v);
  }
  AttnState fin;
  attn2_exchange(st, par, fin, F);
  const int hq = 2 * kvh + par;
  float l = fin.l + __shfl_xor(fin.l, 32);
  const float sk2 = opq(a.in[15])[layer * 4 + hq] * LOG2E;
  const float mnew = fmaxf(0.f, sk2), al = __builtin_amdgcn_exp2f(-mnew);
  l = l * al + __builtin_amdgcn_exp2f(sk2 - mnew);
  int qr = (int)qrow; asm volatile("" : "+v"(qr));
  attn_store(fin, al / l, PLB + (size_t)qr * PLW + S_CG * 256 + hq * 64, Y + (size_t)qr * 1024 + 512 + hq * 64, F.lane);
}
}

namespace mk {
constexpr int XT_STRIDE = 272;
constexpr int FFT_WC = 256 * XT_STRIDE;
__device__ __forceinline__ void fft_item(const Frame& F0, const Args& a, int item) {
  const Frame F = relaunder(F0);
  unsigned char* ws = opq(a.ws);
  const bf16* PLB = (const bf16*)(ws + WS_PLB); bf16* Y = (bf16*)(ws + WS_H);
  const int b = item >> 6, slice = item & 63, r32 = F.lane & 31, hi = F.lane >> 5, w = F.wave;
  LAS unsigned char* Xt = F.lds; LAS unsigned char* Wl = F.lds + FFT_WC;
  __syncthreads();
  {
    const bf16* WC = (const bf16*)(ws + WS_WC);
    u32x4 wt[4];
#pragma unroll
    for (int i = 0; i < 4; ++i) { const int idx = F.tid + 512 * i, row = idx >> 4, ch = idx & 15; wt[i] = *(const u32x4*)(WC + row * 128 + ch * 8); }
    const bf16* src = (const bf16*)(ws + WS_FA2) + ((size_t)b * 64 + slice) * TROW * 8;
    u32x4 v[8];
#pragma unroll
    for (int i = 0; i < 8; ++i) v[i] = *(const u32x4*)(src + (size_t)(F.lane + 64 * (8 * w + i)) * 8);
    __builtin_amdgcn_sched_barrier(0);
#pragma unroll
    for (int i = 0; i < 4; ++i) { const int idx = F.tid + 512 * i, row = idx >> 4, ch = idx & 15; *(LAS u32x4*)(Wl + row * XT_STRIDE + ch * 16) = wt[i]; }
#pragma unroll
    for (int cc = 0; cc < 4; ++cc)
#pragma unroll
      for (int part = 0; part < 2; ++part) { const int e = cc + 4 * part, d = e >> 1; const unsigned sel = (e & 1) ? 0x07060302u : 0x05040100u;
        u32x4 o;
        o.x = __builtin_amdgcn_perm(v[1][d], v[0][d], sel); o.y = __builtin_amdgcn_perm(v[3][d], v[2][d], sel);
        o.z = __builtin_amdgcn_perm(v[5][d], v[4][d], sel); o.w = __builtin_amdgcn_perm(v[7][d], v[6][d], sel);
        *(LAS u32x4*)(Xt + (64 * cc + F.lane) * XT_STRIDE + (part * 64 + 8 * w) * 2) = o; }
  }
  __syncthreads();
  f32x16 acc[4];
#pragma unroll
  for (int rb = 0; rb < 4; ++rb)
#pragma unroll
    for (int i = 0; i < 16; ++i) acc[rb][i] = 0.f;
  {
    bf16x8 bf[8];
#pragma unroll
    for (int s = 0; s < 8; ++s) bf[s] = *(LAS const bf16x8*)(Xt + (32 * w + r32) * XT_STRIDE + (16 * s + 8 * hi) * 2);
#pragma unroll
    for (int rb = 0; rb < 4; ++rb)
#pragma unroll
      for (int s = 0; s < 8; ++s) { const bf16x8 af = *(LAS const bf16x8*)(Wl + (32 * rb + r32) * XT_STRIDE + (16 * s + 8 * hi) * 2); acc[rb] = __builtin_amdgcn_mfma_f32_32x32x16_bf16(af, bf[s], acc[rb], 0, 0, 0); }
  }
  __syncthreads();
  {
    const int n2 = 32 * (w & 1) + r32, c = w >> 1;
#pragma unroll
    for (int rbp = 0; rbp < 2; ++rbp)
#pragma unroll
      for (int r = 0; r < 16; ++r) { const int k1 = 32 * rbp + crow(r, hi); float x = (float)((k1 * n2) & 4095) * (1.f / 4096.f);
        asm volatile("" : "+v"(x) :: "memory");
        const float tc = __builtin_amdgcn_cosf(x), ts = __builtin_amdgcn_sinf(x);
        const float yr = acc[rbp][r], yi = acc[rbp + 2][r];
        const float zr = yr * tc + yi * ts, zi = yi * tc - yr * ts;
        LAS unsigned char* zp = Xt + (k1 * 4 + c) * XT_STRIDE + n2 * 2;
        *(LAS unsigned short*)zp = (unsigned short)f2bf(zr); *(LAS unsigned short*)(zp + 128) = (unsigned short)f2bf(zi); }
  }
  __syncthreads();
  f32x16 o2[2];
#pragma unroll
  for (int rb = 0; rb < 2; ++rb)
#pragma unroll
    for (int i = 0; i < 16; ++i) o2[rb][i] = 0.f;
  {
    bf16x8 bf[8];
#pragma unroll
    for (int s = 0; s < 8; ++s) bf[s] = *(LAS const bf16x8*)(Xt + (32 * w + r32) * XT_STRIDE + (16 * s + 8 * hi) * 2);
#pragma unroll
    for (int rb = 0; rb < 2; ++rb)
#pragma unroll
      for (int s = 0; s < 8; ++s) { const bf16x8 af = *(LAS const bf16x8*)(Wl + (32 * rb + r32) * XT_STRIDE + (16 * s + 8 * hi) * 2); o2[rb] = __builtin_amdgcn_mfma_f32_32x32x16_bf16(af, bf[s], o2[rb], 0, 0, 0); }
  }
  __syncthreads();
  { const int k1 = 8 * w + (r32 >> 2), c = r32 & 3;
#pragma unroll
    for (int rb = 0; rb < 2; ++rb)
#pragma unroll
      for (int r = 0; r < 16; ++r) { const int k = k1 + 64 * (32 * rb + crow(r, hi)); *(LAS unsigned short*)(Xt + k * 8 + c * 2) = (unsigned short)f2bf(o2[rb][r]); }
  }
  __syncthreads();
  { const int o0 = 4 * slice; u32x2 gv[8];
#pragma unroll
    for (int i = 0; i < 8; ++i) gv[i] = *(const u32x2*)(PLB + ((size_t)b * SEQ + F.tid + 512 * i) * PLW + S_BG * 256 + o0);
    __builtin_amdgcn_sched_barrier(0);
#pragma unroll
    for (int i = 0; i < 8; ++i) { const int k = F.tid + 512 * i; const size_t row = (size_t)b * SEQ + k;
      const u32x2 ov = *(LAS const u32x2*)(Xt + k * 8);
      u32x2 y; y.x = pk2(__uint_as_float(ov.x << 16) * __uint_as_float(gv[i].x << 16), __uint_as_float(ov.x & 0xffff0000u) * __uint_as_float(gv[i].x & 0xffff0000u));
      y.y = pk2(__uint_as_float(ov.y << 16) * __uint_as_float(gv[i].y << 16), __uint_as_float(ov.y & 0xffff0000u) * __uint_as_float(gv[i].y & 0xffff0000u));
      *(u32x2*)(Y + row * 1024 + 256 + o0) = y; }
  }
}
constexpr int XC_STRIDE = 1040;
__device__ __forceinline__ void fftc_item(const Frame& F0, const Args& a, int item) {
  const Frame F = relaunder(F0);
  unsigned char* ws = opq(a.ws);
  const bf16* PLB = (const bf16*)(ws + WS_PLB); bf16* Y = (bf16*)(ws + WS_H);
  const bf16* CS = (const bf16*)(ws + WS_CS256);
  const int b = item >> 3, cs = item & 7, r32 = F.lane & 31, hi = F.lane >> 5, w = F.wave;
  LAS unsigned char* Xc = F.lds;
  __syncthreads();
  u32x4 vq[4];
#pragma unroll
  for (int i = 0; i < 4; ++i) { const int idx = F.tid + 512 * i, sl = idx >> 8, n = idx & 255;
    vq[i] = *(const u32x4*)((const bf16*)(ws + WS_FA2) + (((size_t)b * 64 + 8 * cs + sl) * TROW + SEQ + n) * 8); }
  __builtin_amdgcn_sched_barrier(0);
#pragma unroll
  for (int i = 0; i < 4; ++i) { const int idx = F.tid + 512 * i, sl = idx >> 8, n = idx & 255;
    const unsigned vv[4] = {vq[i].x, vq[i].y, vq[i].z, vq[i].w};
#pragma unroll
    for (int j = 0; j < 8; ++j) { const int c = j & 3, part = j >> 2; const unsigned short e = (unsigned short)((j & 1) ? (vv[j >> 1] >> 16) : (vv[j >> 1] & 0xffffu));
      *(LAS unsigned short*)(Xc + (4 * sl + c) * XC_STRIDE + (part * 256 + n) * 2) = e; } }
  __syncthreads();
  f32x16 acc;
#pragma unroll
  for (int i = 0; i < 16; ++i) acc[i] = 0.f;
#pragma unroll 1
  for (int s0 = 0; s0 < 32; s0 += 8) {
    bf16x8 af[8];
#pragma unroll
    for (int j = 0; j < 8; ++j) af[j] = *(const bf16x8*)(CS + (size_t)(32 * w + r32) * 512 + 16 * (s0 + j) + 8 * hi);
    __builtin_amdgcn_sched_barrier(0);
#pragma unroll
    for (int j = 0; j < 8; ++j) {
      const bf16x8 bf = *(LAS const bf16x8*)(Xc + r32 * XC_STRIDE + (16 * (s0 + j) + 8 * hi) * 2);
      acc = __builtin_amdgcn_mfma_f32_32x32x16_bf16(af[j], bf, acc, 0, 0, 0);
    }
  }
  const int o = 32 * cs + r32;
  bf16 gq[16];
#pragma unroll
  for (int r = 0; r < 16; ++r) { const size_t row = (size_t)MLAT + b * CTX + 32 * w + crow(r, hi); gq[r] = PLB[row * PLW + S_BG * 256 + o]; }
  __builtin_amdgcn_sched_barrier(0);
#pragma unroll
  for (int r = 0; r < 16; ++r) { const size_t row = (size_t)MLAT + b * CTX + 32 * w + crow(r, hi);
    Y[row * 1024 + 256 + o] = (bf16)f2bf(acc[r] * bf2f(gq[r])); }
}
}

namespace mk {
constexpr int GU_STRIDE = 2048 + 64;
constexpr size_t WS_GU = WS_SCR, WS_GS = WS_GU + (size_t)32 * 68 * GU_STRIDE * 4;
__device__ __forceinline__ size_t gla_row(int b, int c, int i) { return c < 64 ? (size_t)b * SEQ + 64 * c + i : (size_t)MLAT + b * CTX + 64 * (c - 64) + i; }
__device__ __forceinline__ int gla_pos(int c, int dir) { return c < 64 ? (dir ? 4 + 63 - c : 4 + c) : (dir ? 3 - (c - 64) : (c - 64)); }
__device__ __forceinline__ void gla_stage_v(const Frame& F, const bf16* PLB, int b, int c, LAS unsigned char* vbase) {
  const int key = F.tid >> 3, ch = F.tid & 7;
  const bf16* src = PLB + gla_row(b, c, key) * PLW + S_AV * 256 + ch * 8;
  const int vo = key * 128 + ((ch ^ (((key >> 1) & 1) << 2)) << 4);
  u32x4 t_[4];
#pragma unroll
  for (int h = 0; h < 4; ++h) t_[h] = *(const u32x4*)(src + h * 64);
#pragma unroll
  for (int h = 0; h < 4; ++h) *(LAS u32x4*)(vbase + h * 8192 + vo) = t_[h];
}
__device__ __forceinline__ void gla_cum(const float* LA, int b, int c, int h, int dir, int lane, float (&cw)[32], float& T) {
  const int d = lane & 31, half = lane >> 5;
  float a[32];
#pragma unroll
  for (int ii = 0; ii < 32; ++ii) a[ii] = LA[gla_row(b, c, 32 * half + ii) * 256 + dir * 128 + h * 32 + d];
  float run = 0.f;
#pragma unroll
  for (int ii = 0; ii < 32; ++ii) { run += a[ii]; cw[ii] = run; }
  const float other = __shfl_xor(run, 32);
  const float tot0 = half ? other : run;
  T = run + other;
#pragma unroll
  for (int ii = 0; ii < 32; ++ii) { const float cf = cw[ii] + (half ? tot0 : 0.f); cw[ii] = dir ? (T - cf + a[ii]) : cf; }
}
constexpr int KT_STRIDE = 144;
__device__ __forceinline__ void gla_local_item(const Frame& F0, const Args& a, int item) {
  const Frame F = relaunder(F0);
  unsigned char* ws = opq(a.ws);
  const bf16* PLB = (const bf16*)(ws + WS_PLB); const float* LA = (const float*)(ws + WS_LA);
  const int b = item / 68, c = item % 68, h = F.wave >> 1, dir = F.wave & 1, d = F.lane & 31, half = F.lane >> 5, r32 = d, hi = half;
  LAS unsigned char* Vt = F.lds + h * 8192; LAS unsigned char* KT = F.lds + 32768 + F.wave * (32 * KT_STRIDE);
  __syncthreads();
  gla_stage_v(F, PLB, b, c, F.lds);
  float cw[32], T;
  gla_cum(LA, b, c, h, dir, F.lane, cw, T);
  {
    unsigned pkd[16]; bf16 kr[32];
    const bf16* kp = PLB + gla_row(b, c, 32 * half) * PLW + S_AQK * 256 + 128 + h * 32 + d;
#pragma unroll
    for (int ii = 0; ii < 32; ++ii) kr[ii] = kp[(size_t)ii * PLW];
#pragma unroll
    for (int ii = 0; ii < 32; ii += 2) pkd[ii >> 1] = pk2(bf2f(kr[ii]) * __expf(T - cw[ii]), bf2f(kr[ii + 1]) * __expf(T - cw[ii + 1]));
#pragma unroll
    for (int q4 = 0; q4 < 4; ++q4) *(LAS u32x4*)(KT + d * KT_STRIDE + half * 64 + q4 * 16) = (u32x4){pkd[4 * q4], pkd[4 * q4 + 1], pkd[4 * q4 + 2], pkd[4 * q4 + 3]};
  }
  __syncthreads();
  f32x16 acc[2];
#pragma unroll
  for (int eb = 0; eb < 2; ++eb)
#pragma unroll
    for (int i = 0; i < 16; ++i) acc[eb][i] = 0.f;
  const int q = (F.lane & 15) >> 2, p = F.lane & 3, gsel = (F.lane >> 4) & 1;
  const int chb = 2 * gsel + (p >> 1);
#pragma unroll
  for (int st = 0; st < 4; ++st) {
    const bf16x8 kb = *(LAS const bf16x8*)(KT + r32 * KT_STRIDE + (16 * st + 8 * hi) * 2);
#pragma unroll
    for (int eb = 0; eb < 2; ++eb) {
      const int ch = ((chb | ((eb ^ (q >> 1)) << 2)) << 4);
      LAS const unsigned char* vp = Vt + (16 * st + 8 * hi + q) * 128 + 8 * (p & 1) + ch;
      const s16x4 lo = vtr(vp), hh = vtr(vp + 512);
      const bf16x8 va = (bf16x8){lo[0], lo[1], lo[2], lo[3], hh[0], hh[1], hh[2], hh[3]};
      acc[eb] = __builtin_amdgcn_mfma_f32_32x32x16_bf16(va, kb, acc[eb], 0, 0, 0);
    }
  }
  const int chain = (b * 4 + h) * 2 + dir, pos = gla_pos(c, dir);
  float* gu = (float*)(ws + WS_GU) + ((size_t)chain * 68 + pos) * GU_STRIDE;
#pragma unroll
  for (int eb = 0; eb < 2; ++eb)
#pragma unroll
    for (int r = 0; r < 16; ++r) gu[(32 * eb + crow(r, hi)) * 32 + r32] = acc[eb][r];
  if (half == 0) gu[2048 + d] = __expf(T);
}
__device__ __forceinline__ void gla_scan(const Frame& F0, const Args& a) {
  const Frame F = relaunder(F0);
  unsigned char* ws = opq(a.ws);
  if (F.tid >= 256) return;
  for (int gt = F.vcu * 256 + F.tid; gt < 32 * 2048; gt += F.G * 256) {
    const int chain = gt >> 11, el = gt & 2047, d = el & 31;
    const float* gu = (const float*)(ws + WS_GU) + (size_t)chain * 68 * GU_STRIDE;
    bf16* gs = (bf16*)(ws + WS_GS) + (size_t)chain * 68 * 2048 + el;
    float S = 0.f;
#pragma unroll 1
    for (int p0 = 0; p0 < 68; p0 += 34) {
      float dc[34], uu[34];
#pragma unroll
      for (int i = 0; i < 34; ++i) { dc[i] = gu[(size_t)(p0 + i) * GU_STRIDE + 2048 + d]; uu[i] = gu[(size_t)(p0 + i) * GU_STRIDE + el]; }
      __builtin_amdgcn_sched_barrier(0);
#pragma unroll
      for (int i = 0; i < 34; ++i) { gs[(size_t)(p0 + i) * 2048] = (bf16)f2bf(S); S = dc[i] * S + uu[i]; }
    }
  }
}
constexpr int QK_STRIDE = 80;
__device__ __forceinline__ void gla_out_item(const Frame& F0, const Args& a, int layer, int item) {
  const Frame F = relaunder(F0);
  unsigned char* ws = opq(a.ws);
  const bf16* PLB = (const bf16*)(ws + WS_PLB); const float* LA = (const float*)(ws + WS_LA); bf16* Y = (bf16*)(ws + WS_H);
  const int b = item / 68, c = item % 68, h = F.wave >> 1, dir = F.wave & 1, d = F.lane & 31, half = F.lane >> 5, r32 = d, hi = half;
  LAS unsigned char* Vt = F.lds + h * 8192;
  LAS unsigned char* QT = F.lds + 32768 + F.wave * (2 * 64 * QK_STRIDE); LAS unsigned char* KT = QT + 64 * QK_STRIDE;
  LAS float* X = (LAS float*)(F.lds + 32768) + h * 4096;
  __syncthreads();
  gla_stage_v(F, PLB, b, c, F.lds);
  {
    float cw[32], T;
    gla_cum(LA, b, c, h, dir, F.lane, cw, T);
    bf16 qr[32], kr[32];
    const bf16* pr = PLB + gla_row(b, c, 32 * half) * PLW + S_AQK * 256 + h * 32 + d;
#pragma unroll
    for (int ii = 0; ii < 32; ++ii) { qr[ii] = pr[(size_t)ii * PLW]; kr[ii] = pr[(size_t)ii * PLW + 128]; }
#pragma unroll
    for (int ii = 0; ii < 32; ++ii) { const int i = 32 * half + ii;
      const float ec = __expf(cw[ii]);
      *(LAS unsigned short*)(QT + i * QK_STRIDE + d * 2) = (unsigned short)f2bf(bf2f(qr[ii]) * ec);
      *(LAS unsigned short*)(KT + i * QK_STRIDE + d * 2) = (unsigned short)f2bf(bf2f(kr[ii]) * __builtin_amdgcn_rcpf(ec)); }
  }
  __syncthreads();
  f32x16 oacc[2][2];
#pragma unroll
  for (int eb = 0; eb < 2; ++eb)
#pragma unroll
    for (int ib = 0; ib < 2; ++ib)
#pragma unroll
      for (int i = 0; i < 16; ++i) oacc[eb][ib][i] = 0.f;
  bf16x8 qb[2][2];
#pragma unroll
  for (int ib = 0; ib < 2; ++ib)
#pragma unroll
    for (int st = 0; st < 2; ++st) qb[ib][st] = *(LAS const bf16x8*)(QT + (32 * ib + r32) * QK_STRIDE + (16 * st + 8 * hi) * 2);
  const int chain = (b * 4 + h) * 2 + dir, pos = gla_pos(c, dir);
  {
    const bf16* gs = (const bf16*)(ws + WS_GS) + ((size_t)chain * 68 + pos) * 2048;
#pragma unroll
    for (int eb = 0; eb < 2; ++eb)
#pragma unroll
      for (int st = 0; st < 2; ++st) { const bf16x8 sf = *(const bf16x8*)(gs + (32 * eb + r32) * 32 + 16 * st + 8 * hi);
#pragma unroll
        for (int ib = 0; ib < 2; ++ib) oacc[eb][ib] = __builtin_amdgcn_mfma_f32_32x32x16_bf16(sf, qb[ib][st], oacc[eb][ib], 0, 0, 0); }
  }
  const int q = (F.lane & 15) >> 2, p = F.lane & 3, gsel = (F.lane >> 4) & 1;
  const int vrow = (4 * hi + q) * 128 + 8 * (p & 1), chb = 2 * gsel + (p >> 1);
#pragma unroll
  for (int sb = 0; sb < 2; ++sb) {
    bf16x8 kf[2];
#pragma unroll
    for (int st = 0; st < 2; ++st) kf[st] = *(LAS const bf16x8*)(KT + (32 * sb + r32) * QK_STRIDE + (16 * st + 8 * hi) * 2);
#pragma unroll
    for (int ib = 0; ib < 2; ++ib) {
      const bool need = dir == 0 ? (sb <= ib) : (sb >= ib);
      if (!need) continue;
      f32x16 sc;
#pragma unroll
      for (int i = 0; i < 16; ++i) sc[i] = 0.f;
#pragma unroll
      for (int st = 0; st < 2; ++st) sc = __builtin_amdgcn_mfma_f32_32x32x16_bf16(kf[st], qb[ib][st], sc, 0, 0, 0);
      if (sb == ib) {
#pragma unroll
        for (int r = 0; r < 16; ++r) { const int s = crow(r, hi); const bool keep = dir == 0 ? (s <= r32) : (s >= r32); sc[r] = keep ? sc[r] : 0.f; }
      }
      u32x4 pw[2];
#pragma unroll
      for (int k = 0; k < 2; ++k) pw[k] = (u32x4){pk2(sc[8 * k + 0], sc[8 * k + 1]), pk2(sc[8 * k + 2], sc[8 * k + 3]), pk2(sc[8 * k + 4], sc[8 * k + 5]), pk2(sc[8 * k + 6], sc[8 * k + 7])};
#pragma unroll
      for (int ks = 0; ks < 2; ++ks)
#pragma unroll
        for (int eb = 0; eb < 2; ++eb) {
          const int ch = ((chb | ((eb ^ (q >> 1)) << 2)) << 4);
          const s16x4 lo = vtr(Vt + (2 * sb + ks) * 2048 + vrow + ch), hh = vtr(Vt + (2 * sb + ks) * 2048 + 1024 + vrow + ch);
          const bf16x8 va = (bf16x8){lo[0], lo[1], lo[2], lo[3], hh[0], hh[1], hh[2], hh[3]};
          oacc[eb][ib] = __builtin_amdgcn_mfma_f32_32x32x16_bf16(va, __builtin_bit_cast(bf16x8, pw[ks]), oacc[eb][ib], 0, 0, 0);
        }
    }
  }
  __syncthreads();
  if (dir == 1) {
#pragma unroll
    for (int eb = 0; eb < 2; ++eb)
#pragma unroll
      for (int ib = 0; ib < 2; ++ib)
#pragma unroll
        for (int r = 0; r < 16; ++r) X[((eb * 2 + ib) * 16 + r) * 64 + F.lane] = oacc[eb][ib][r];
  }
  __syncthreads();
  if (dir == 0) {
    const float* on = opq(a.in[11]) + layer * 64;
    f32x4 w4s[8];
#pragma unroll
    for (int i = 0; i < 8; ++i) w4s[i] = *(const f32x4*)(on + 32 * (i >> 2) + 8 * (i & 3) + 4 * hi);
#pragma unroll
    for (int ib = 0; ib < 2; ++ib) {
      float ss = 0.f;
#pragma unroll
      for (int eb = 0; eb < 2; ++eb)
#pragma unroll
        for (int r = 0; r < 16; ++r) { oacc[eb][ib][r] += X[((eb * 2 + ib) * 16 + r) * 64 + F.lane]; ss += oacc[eb][ib][r] * oacc[eb][ib][r]; }
      ss += __shfl_xor(ss, 32);
      const float rs = 1.0f / sqrtf(ss * (1.f / 64.f) + 1e-6f);
      const size_t row = gla_row(b, c, 32 * ib + r32);
      u32x2 gv8[8];
#pragma unroll
      for (int i = 0; i < 8; ++i) gv8[i] = *(const u32x2*)(PLB + row * PLW + S_AG * 256 + h * 64 + 32 * (i >> 2) + 8 * (i & 3) + 4 * hi);
      __builtin_amdgcn_sched_barrier(0);
#pragma unroll
      for (int eb = 0; eb < 2; ++eb)
#pragma unroll
        for (int gi = 0; gi < 4; ++gi) {
          const int e0 = 32 * eb + 8 * gi + 4 * hi;
          const f32x4 w4 = w4s[4 * eb + gi];
          const u32x2 gv = gv8[4 * eb + gi];
          const float g0 = __uint_as_float(gv.x << 16), g1 = __uint_as_float(gv.x & 0xffff0000u), g2 = __uint_as_float(gv.y << 16), g3 = __uint_as_float(gv.y & 0xffff0000u);
          u32x2 ov; ov.x = pk2(oacc[eb][ib][4 * gi + 0] * rs * w4[0] * g0, oacc[eb][ib][4 * gi + 1] * rs * w4[1] * g1);
          ov.y = pk2(oacc[eb][ib][4 * gi + 2] * rs * w4[2] * g2, oacc[eb][ib][4 * gi + 3] * rs * w4[3] * g3);
          *(u32x2*)(Y + row * 1024 + h * 64 + e0) = ov;
        }
    }
  }
}
}

namespace mk {
__device__ __forceinline__ void p3_mixers(const Frame& F0, const Args& a, int layer) {
  const Frame F = relaunder(F0);
  const int nx = layer == 0 ? 16 : 0, nswa = 256 + nx, nna = 256 + nx, nfc = layer == 0 ? 32 : 0;
  for (int it = F.vcu; it < 272 + 256 + nfc + nswa + nna; it += F.G) {
    int r = it;
    if (r < 272) { gla_local_item(F, a, r); continue; } r -= 272;
    if (r < 256) { fft_item(F, a, r); continue; } r -= 256;
    if (r < nfc) { fftc_item(F, a, r); continue; } r -= nfc;
    if (r < nswa) swa_item(F, a, layer, r); else na_item(F, a, layer, r - nswa);
  }
}
__device__ __forceinline__ void p4b_glaout(const Frame& F0, const Args& a, int layer) {
  const Frame F = relaunder(F0);
  if (layer == 1) { for (int it = F.vcu; it < 256; it += F.G) gla_out_item(F, a, layer, (it >> 6) * 68 + (it & 63)); }
  else for (int it = F.vcu; it < 272; it += F.G) gla_out_item(F, a, layer, it);
}
}
#define XB_TMO      128
#define XB_XCNT(j)  (256  + 64 * (j))
#define XB_XSUB(j)  (1280 + 64 * (j))
#define XB_XGEN(j)  (2304 + 64 * (j))
#define XB_TOP      3328
#define XB_TOPGEN   3392
#define XCD_BAR_WORDS 3456
#define XB_SPIN_CAP (1u << 18)

__device__ __forceinline__ unsigned xb_ld(unsigned* p)              { return __hip_atomic_load(p, __ATOMIC_RELAXED, __HIP_MEMORY_SCOPE_AGENT); }
__device__ __forceinline__ unsigned xb_add(unsigned* p, unsigned v) { return __hip_atomic_fetch_add(p, v, __ATOMIC_RELAXED, __HIP_MEMORY_SCOPE_AGENT); }
__device__ __forceinline__ unsigned xb_xcc_id() { return (unsigned)__builtin_amdgcn_s_getreg((3 << 11) | 20) & 0xFu; }
#define XB_SPIN(cond, bar) do { unsigned _sp = 0; while (cond) { __builtin_amdgcn_s_sleep(1); \
    if ((++_sp & 255u) == 0u) { if (xb_ld(&(bar)[XB_TMO])) break; if (_sp > XB_SPIN_CAP) { atomicAdd(&(bar)[XB_TMO], 1u); break; } } } } while (0)

struct XcdBarrier {
    unsigned* bar; unsigned x;
    volatile LAS unsigned* st;
};

__device__ __forceinline__ XcdBarrier xcd_barrier_post(unsigned* bar, volatile LAS unsigned* st) {
    XcdBarrier b; b.bar = bar; b.x = xb_xcc_id(); b.st = st;
    if (threadIdx.x == 0) (void)xb_add(&bar[XB_XCNT(b.x)], 1u);
    return b;
}
__device__ __forceinline__ void xcd_barrier_complete(unsigned* bar, unsigned x, unsigned& nloc, unsigned& nx) {
    const unsigned G = gridDim.x * gridDim.y * gridDim.z;
    unsigned sum, cnt, mine, sp = 0u;
    for (;;) {
        sum = 0u; cnt = 0u; mine = 0u;
#pragma unroll
        for (unsigned j = 0; j < 16; ++j) { const unsigned c = xb_ld(&bar[XB_XCNT(j)]); sum += c; cnt += (c > 0u) ? 1u : 0u; }
        mine = xb_ld(&bar[XB_XCNT(x)]);
        if (sum == G) break;
        __builtin_amdgcn_s_sleep(1);
        if ((++sp & 255u) == 0u) { if (xb_ld(&bar[XB_TMO])) break; if (sp > XB_SPIN_CAP) { atomicAdd(&bar[XB_TMO], 1u); break; } }
    }
    nloc = mine > 0u ? mine : 1u; nx = cnt > 0u ? cnt : 1u;
}

__device__ __forceinline__ void xcd_barrier(const XcdBarrier& b) {
    asm volatile("s_waitcnt vmcnt(0)" ::: "memory");
    __syncthreads();
    if (threadIdx.x == 0) {
        unsigned* bar = b.bar;
        __builtin_amdgcn_s_waitcnt(0);
        unsigned nloc = b.st[0], nx = b.st[1];
        if (nloc == 0u) { xcd_barrier_complete(bar, b.x, nloc, nx); b.st[0] = nloc; b.st[1] = nx; }
        const unsigned old = xb_add(&bar[XB_XSUB(b.x)], 1u);
        const unsigned gen = old / nloc;
        if (old + 1u == (gen + 1u) * nloc) {
            __builtin_amdgcn_fence(__ATOMIC_RELEASE, "agent");
            asm volatile("s_waitcnt vmcnt(0)" ::: "memory");
            const unsigned og = xb_add(&bar[XB_TOP], 1u);
            const unsigned tg = og / nx;
            if (og + 1u == (tg + 1u) * nx) xb_add(&bar[XB_TOPGEN], 1u);
            else XB_SPIN(xb_ld(&bar[XB_TOPGEN]) == tg, bar);
            __builtin_amdgcn_fence(__ATOMIC_ACQUIRE, "agent");
            xb_add(&bar[XB_XGEN(b.x)], 1u);
            asm volatile("s_waitcnt vmcnt(0)" ::: "memory");
        } else {
            XB_SPIN(xb_ld(&bar[XB_XGEN(b.x)]) == gen, bar);
            __builtin_amdgcn_fence(__ATOMIC_ACQUIRE, "agent");
            asm volatile("s_waitcnt vmcnt(0)" ::: "memory");
        }
    }
    __syncthreads();
}

constexpr int LDS_BYTES = 163840, MISC_OFF = LDS_BYTES - 256;
constexpr int CW_BAR = 4096;
__global__ void __launch_bounds__(512, 2) mega(mk::Args a) {
  extern __shared__ __attribute__((aligned(16))) unsigned char lds[];
  mk::Frame F;
  F.lds = (LAS unsigned char*)lds;
  F.tid = threadIdx.x; F.lane = F.tid & 63; F.wave = __builtin_amdgcn_readfirstlane(F.tid >> 6);
  F.G = gridDim.x; { const int bx = blockIdx.x; F.vcu = (F.G % 8 == 0) ? (bx % 8) * (F.G / 8) + bx / 8 : bx; }
  volatile LAS unsigned* MISC = (volatile LAS unsigned*)(F.lds + MISC_OFF);
  if (F.tid < 64) MISC[F.tid] = 0u;
  __syncthreads();
  XcdBarrier bar; bar.bar = nullptr; bar.x = 0; bar.st = nullptr;
  const bool multi = (a.ph_hi - a.ph_lo) > 1;
  if (multi) bar = xcd_barrier_post((unsigned*)(a.ws + mk::WS_CTL) + CW_BAR, MISC + 8);
#pragma clang loop unroll(disable)
  for (int ph = a.ph_lo; ph < a.ph_hi; ++ph) {
    if (ph == 0) mk::p0_prologue(F, a);
    else {
      const int layer = (ph - 1) / 6, sub = (ph - 1) % 6;
      if (sub == 0) mk::p1_prenorm(F, a, layer);
      else if (sub == 1) mk::p2_inproj(F, a, layer);
      else if (sub == 2) mk::p3_mixers(F, a, layer);
      else if (sub == 3) mk::gla_scan(F, a);
      else if (sub == 4) mk::p4b_glaout(F, a, layer);
      else mk::p5_outproj(F, a, layer);
    }
    if (ph + 1 < a.ph_hi) xcd_barrier(bar);
  }
}

extern "C" void kernel_launch(void* const* d_in, const int* in_sizes, int n_in, void* d_out, int out_size, void* d_ws, size_t ws_size, hipStream_t stream) {
  using namespace mk;
  static int grid = 0;
  if (grid == 0) {
    int dev = 0, cus = 0, per_cu = 0; (void)hipGetDevice(&dev); (void)hipDeviceGetAttribute(&cus, hipDeviceAttributeMultiprocessorCount, dev);
    (void)hipFuncSetAttribute((const void*)mega, hipFuncAttributeMaxDynamicSharedMemorySize, LDS_BYTES);
    if (hipOccupancyMaxActiveBlocksPerMultiprocessor(&per_cu, (const void*)mega, 512, LDS_BYTES) != hipSuccess || per_cu < 1) per_cu = 1;
    (void)hipGetLastError();
    grid = (cus > 0 ? cus : 256) * (per_cu < 1 ? 1 : 1);
  }
  (void)hipMemsetAsync((char*)d_ws + WS_CTL, 0, CTL_BYTES, stream);
  Args a{};
  for (int i = 0; i < 19; ++i) a.in[i] = (const float*)d_in[i];
  a.out = (float*)d_out; a.ws = (unsigned char*)d_ws;
  a.ph_lo = 0; a.ph_hi = 13;
  void* args[] = {&a};
  if (hipLaunchCooperativeKernel((const void*)mega, dim3(grid), dim3(512), args, LDS_BYTES, stream) != hipSuccess) {
    (void)hipGetLastError();
    hipLaunchKernelGGL(mega, dim3(grid), dim3(512), LDS_BYTES, stream, a);
  }
}
```

```cpp
#include <hip/hip_runtime.h>
#include <math.h>
#include <stdint.h>

namespace pg8 {
#define PG8_LAS __attribute__((address_space(3)))
typedef unsigned short bf16_t;
typedef short bf16x8 __attribute__((ext_vector_type(8)));
typedef float f32x4 __attribute__((ext_vector_type(4)));
typedef unsigned u32x4 __attribute__((ext_vector_type(4)));
constexpr int BM = 256, BK = 64, HALF = 128, HTB = HALF * BK * 2  , STAGE_BYTES = 8 * HTB, NXCD = 8, WGM = 8;

__host__ __device__ __forceinline__ int lds_byte(int r, int c) { const int st = (r >> 4) * 2 + (c >> 5), rr = r & 15, cc = c & 31, ob = rr * 64 + cc * 2; return st * 1024 + (ob ^ (((ob >> 9) & 1) << 5)); }
__host__ __device__ __forceinline__ void stage_rc(int b, int& R, int& C) { const int st = b / 1024, sb = b % 1024, swz = sb ^ (((sb >> 9) & 1) << 5); R = (st >> 1) * 16 + swz / 64; C = (st & 1) * 32 + (swz % 64) / 2; }
__host__ __device__ __forceinline__ int perm32(int rho) { const int n = rho >> 4, i = rho & 15; return 8 * (i >> 2) + 4 * n + (i & 3); }

struct Unit { int pm, pn; };
struct Gemm { const bf16_t* A; const bf16_t* Bt; int M, N, K; };

struct StaticOrder {
    int nM, nN, nwg, G, c;
    __host__ __device__ void init(int M, int N, int G_, int c_) { nM = M / BM; nN = N / BM; nwg = nM * nN; G = G_; c = c_; }
    __host__ __device__ bool next(int i, Unit& u) const {
        const long L = (long)i * G + c; if (L >= nwg) return false;
        int wgid = (int)L; { const int q = nwg / NXCD, r = nwg % NXCD, xcd = wgid % NXCD, off = wgid / NXCD; wgid = (xcd < r ? xcd * (q + 1) : r * (q + 1) + (xcd - r) * q) + off; }
        const int nig = WGM * nN, gid = wgid / nig, fm = gid * WGM, gsz = (nM - fm) < WGM ? (nM - fm) : WGM;
        u.pm = fm + ((wgid % nig) % gsz); u.pn = (wgid % nig) / gsz; return true;
    }
    __device__ __forceinline__ void a_ready(const Unit&) const {}
    __device__ __forceinline__ void done(const Unit&) const {}
};

template <class Epi, class Sched, bool STAMP = false>
__device__ __forceinline__ void gemm_phase(PG8_LAS unsigned char* lds, const Gemm g, const Sched& S, const Epi& E, unsigned long long* stamps) {
    int tid_ = threadIdx.x; asm volatile("" : "+v"(tid_));
    const int tid = tid_, wid = __builtin_amdgcn_readfirstlane(tid >> 6), lane = tid & 63, wr = wid >> 2, wc = wid & 3, fr = lane & 15, fq = lane >> 4;
    const int K = g.K, nt = K / BK;
    int ts_lo = 0, ts_hi = 0, nts = 0; const unsigned long long rt_entry = STAMP ? (unsigned long long)wall_clock64() : 0ull;
#define PG8_STAMP() do { if (STAMP && wid == 0 && nts < 64) { const unsigned long long _c = (unsigned long long)clock64(); \
        ts_lo = (lane == nts) ? (int)(unsigned)_c : ts_lo; ts_hi = (lane == nts) ? (int)(unsigned)(_c >> 32) : ts_hi; ++nts; } } while (0)
    PG8_STAMP();
    unsigned voffA[2], voffB[2];
#pragma unroll
    for (int i = 0; i < 2; ++i) { int R, C; stage_rc(tid * 16 + i * 8192, R, C); const int Rb = Epi::PERM ? ((R & ~31) + perm32(R & 31)) : R;
        voffA[i] = (unsigned)(R * K + C) * 2u; voffB[i] = (unsigned)(Rb * K + C) * 2u; }
    const size_t kstep = (size_t)(BK * 2);
    const size_t hstep = (size_t)HALF * K * 2;
    const size_t tstep = 2 * hstep;
    const unsigned ldsw = (unsigned)wid * 1024u;
    const int aoff = lds_byte(wr * 64 + fr, fq * 8), boff = lds_byte(wc * 32 + fr, fq * 8);
#define PG8_SA(b, h) (((b) * 2 + (h)) * HTB)
#define PG8_SB(b, h) ((4 + (b) * 2 + (h)) * HTB)
#define PG8_STAGE(bufoff, gbase, voff) do { _Pragma("unroll") for (int _i = 0; _i < 2; ++_i) \
        __builtin_amdgcn_global_load_lds((const unsigned*)((const char*)(gbase) + (voff)[_i]), (PG8_LAS unsigned*)(lds + (bufoff) + ldsw + _i * 8192), 16, 0, 0); } while (0)
#define PG8_LDA(dst, b, h) do { _Pragma("unroll") for (int m = 0; m < 4; ++m) _Pragma("unroll") for (int k = 0; k < 2; ++k) dst[m][k] = *(const PG8_LAS bf16x8*)(lds + PG8_SA(b, h) + aoff + m * 2048 + k * 1024); } while (0)
#define PG8_LDB(dst, b, h) do { _Pragma("unroll") for (int n = 0; n < 2; ++n) _Pragma("unroll") for (int k = 0; k < 2; ++k) dst[n][k] = *(const PG8_LAS bf16x8*)(lds + PG8_SB(b, h) + boff + n * 2048 + k * 1024); } while (0)
#define PG8_MMA(ai, bj, At, Bt) do { __builtin_amdgcn_s_setprio(1); _Pragma("unroll") for (int m = 0; m < 4; ++m) _Pragma("unroll") for (int n = 0; n < 2; ++n) _Pragma("unroll") for (int k = 0; k < 2; ++k) \
        acc[ai][bj][m][n] = __builtin_amdgcn_mfma_f32_16x16x32_bf16(Bt[n][k], At[m][k], acc[ai][bj][m][n], 0, 0, 0); __builtin_amdgcn_s_setprio(0); } while (0)
#define PG8_WAIT_V(n) asm volatile("s_waitcnt vmcnt(" #n ")" ::: "memory")
#define PG8_WAIT_L(n) asm volatile("s_waitcnt lgkmcnt(" #n ")" ::: "memory")
#define PG8_BAR __builtin_amdgcn_s_barrier()
#define PG8_SCHED __builtin_amdgcn_sched_barrier(0)
    Unit cur, nxt; int ui = 0;
    if (!S.next(0, cur)) return;
    f32x4 acc[2][2][4][2];
#pragma unroll
    for (int a = 0; a < 2; ++a)
#pragma unroll
        for (int b = 0; b < 2; ++b)
#pragma unroll
            for (int m = 0; m < 4; ++m)
#pragma unroll
                for (int n = 0; n < 2; ++n) acc[a][b][m][n] = (f32x4){0.f, 0.f, 0.f, 0.f};
    bf16x8 At[4][2], B0[2][2], B1[2][2];
    const char* cA = (const char*)g.A + (size_t)cur.pm * tstep; const char* cB = (const char*)g.Bt + (size_t)cur.pn * tstep;
    S.a_ready(cur);
    PG8_STAGE(PG8_SB(0, 0), cB, voffB); PG8_STAGE(PG8_SA(0, 0), cA, voffA); PG8_STAGE(PG8_SB(0, 1), cB + hstep, voffB); PG8_STAGE(PG8_SA(0, 1), cA + hstep, voffA);
    if (wr == 1) PG8_BAR;
    PG8_WAIT_V(4); PG8_BAR;
    PG8_STAGE(PG8_SB(1, 0), cB + kstep, voffB); PG8_STAGE(PG8_SA(1, 0), cA + kstep, voffA); PG8_STAGE(PG8_SB(1, 1), cB + hstep + kstep, voffB);
    PG8_WAIT_V(6); PG8_BAR;
    PG8_STAMP();
    for (;;) {
        const bool has_next = S.next(ui + 1, nxt);
        const char* nA = has_next ? (const char*)g.A + (size_t)nxt.pm * tstep : cA; const char* nB = has_next ? (const char*)g.Bt + (size_t)nxt.pn * tstep : cB;
        for (int t = 0; t < nt; t += 2) {
            const bool last = (t == nt - 2);
            const char* a1 = cA + (size_t)(t + 1) * kstep;
            const char* a2 = last ? nA : cA + (size_t)(t + 2) * kstep; const char* b2 = last ? nB : cB + (size_t)(t + 2) * kstep;
            const char* a3 = a2 + kstep; const char* b3 = b2 + kstep;
            if (last && has_next) S.a_ready(nxt);
            PG8_LDB(B0, 0, 0); PG8_SCHED; PG8_LDA(At, 0, 0); PG8_STAGE(PG8_SA(1, 1), a1 + hstep, voffA);
            PG8_WAIT_L(8); PG8_BAR; PG8_WAIT_L(0); PG8_MMA(0, 0, At, B0); PG8_BAR; PG8_SCHED;
            PG8_LDB(B1, 0, 1); PG8_STAGE(PG8_SB(0, 0), b2, voffB);
            PG8_BAR; PG8_WAIT_L(0); PG8_MMA(0, 1, At, B1); PG8_BAR;
            PG8_LDA(At, 0, 1); PG8_STAGE(PG8_SA(0, 0), a2, voffA);
            PG8_BAR; PG8_WAIT_L(0); PG8_MMA(1, 0, At, B0); PG8_BAR; PG8_SCHED;
            PG8_STAGE(PG8_SB(0, 1), b2 + hstep, voffB);
            PG8_WAIT_V(6); PG8_BAR; PG8_MMA(1, 1, At, B1); PG8_BAR;
            PG8_LDB(B0, 1, 0); PG8_SCHED; PG8_LDA(At, 1, 0); PG8_STAGE(PG8_SA(0, 1), a2 + hstep, voffA);
            PG8_WAIT_L(8); PG8_BAR; PG8_WAIT_L(0); PG8_MMA(0, 0, At, B0); PG8_BAR; PG8_SCHED;
            PG8_LDB(B1, 1, 1); PG8_STAGE(PG8_SB(1, 0), b3, voffB);
            PG8_BAR; PG8_WAIT_L(0); PG8_MMA(0, 1, At, B1); PG8_BAR;
            PG8_LDA(At, 1, 1); PG8_STAGE(PG8_SA(1, 0), a3, voffA);
            PG8_BAR; PG8_WAIT_L(0); PG8_MMA(1, 0, At, B0); PG8_BAR; PG8_SCHED;
            PG8_STAGE(PG8_SB(1, 1), b3 + hstep, voffB);
            PG8_WAIT_V(6); PG8_BAR; PG8_MMA(1, 1, At, B1); PG8_BAR;
        }
        PG8_STAMP();
        if constexpr (!Epi::AFTER_DRAIN) { E(acc, cur, wr, wc, fr, fq); S.done(cur); }
        PG8_STAMP();
        if (!has_next) break;
#pragma unroll
        for (int a = 0; a < 2; ++a)
#pragma unroll
            for (int b = 0; b < 2; ++b)
#pragma unroll
                for (int m = 0; m < 4; ++m)
#pragma unroll
                    for (int n = 0; n < 2; ++n) acc[a][b][m][n] = (f32x4){0.f, 0.f, 0.f, 0.f};
        cur = nxt; cA = nA; cB = nB; ++ui;
    }
    PG8_WAIT_V(0);
    if (wr == 0) PG8_BAR;
    PG8_BAR;
    if constexpr (Epi::AFTER_DRAIN) { E.fused(acc, cur, wr, wc, fr, fq, lds, wid, lane); S.done(cur); }
    PG8_STAMP();
    if (STAMP && wid == 0) { stamps[lane] = lane < nts ? (((unsigned long long)(unsigned)ts_hi << 32) | (unsigned)ts_lo) : 0ull;
        if (lane == 62) stamps[62] = rt_entry; if (lane == 63) stamps[63] = (unsigned long long)wall_clock64(); }
#undef PG8_STAMP
#undef PG8_SA
#undef PG8_SB
#undef PG8_STAGE
#undef PG8_LDA
#undef PG8_LDB
#undef PG8_MMA
#undef PG8_WAIT_V
#undef PG8_WAIT_L
#undef PG8_BAR
#undef PG8_SCHED
}
}

namespace mk {
#define LAS __attribute__((address_space(3)))
typedef unsigned short bf16;
typedef float f32x4 __attribute__((ext_vector_type(4)));
typedef float f32x16 __attribute__((ext_vector_type(16)));
typedef unsigned u32x4 __attribute__((ext_vector_type(4)));
typedef unsigned u32x2 __attribute__((ext_vector_type(2)));
typedef short bf16x8 __attribute__((ext_vector_type(8)));
typedef short s16x4 __attribute__((ext_vector_type(4)));

constexpr int D = 1024, NB = 4, SEQ = 4096, CTX = 256, PWW = 3360;
constexpr int MLAT = NB * SEQ, MT = MLAT + NB * CTX;
constexpr int NT1 = 14, N1 = NT1 * 256;
constexpr int NSLOT = 11, PLW = NSLOT * 256;
constexpr int TROW = SEQ + CTX;
constexpr int O_AQ = 0, O_AK = 128, O_AV = 256, O_AG = 512, O_LR = 768, O_BV = 800, O_BG = 1056, O_CQ = 1312, O_CK = 1568, O_CV = 1696,
              O_CG = 1824, O_DQ = 2080, O_DK = 2336, O_DV = 2592, O_DG = 2848;
constexpr int S_AQK = 0, S_AV = 1, S_AG = 2, S_BG = 3, S_CQ = 4, S_CKV = 5, S_CG = 6, S_DQ = 7, S_DK = 8, S_DV = 9, S_DG = 10;
constexpr float LOG2E = 1.4426950408889634f, QSCALE = 0.125f * LOG2E, GLA_QS = 0.17677669529663687f;

constexpr size_t WS_CTL = 0, CTL_BYTES = 65536;
constexpr size_t WS_MOD = WS_CTL + CTL_BYTES;
constexpr size_t WS_ROPE = WS_MOD + 2 * 5 * 3072 * 4;
constexpr size_t WS_WC = WS_ROPE + 2 * 64 * 16 * 4;
constexpr size_t WS_CS256 = WS_WC + 128 * 128 * 2;
constexpr size_t WS_W1T = 1u << 20;
constexpr size_t WS_W2T = WS_W1T + (size_t)2 * N1 * D * 2;
constexpr size_t WS_H = WS_W2T + (size_t)2 * D * D * 2;
constexpr size_t WS_PLB = WS_H + (size_t)MT * D * 2;
constexpr size_t WS_LA = WS_PLB + (size_t)MT * PLW * 2;
constexpr size_t WS_FA2 = WS_LA + (size_t)MT * 256 * 4;
constexpr size_t WS_CTX1 = WS_FA2 + (size_t)NB * 64 * TROW * 8 * 2;
constexpr size_t WS_SCR = WS_CTX1 + (size_t)NB * CTX * D * 4;
static_assert(WS_CS256 + 256 * 512 * 2 <= WS_W1T, "tables");

__device__ __forceinline__ float bf2f(bf16 v) { return __uint_as_float(((unsigned)v) << 16); }
__device__ __forceinline__ unsigned f2bf(float f) { unsigned u = __float_as_uint(f); return (u + 0x7fffu + ((u >> 16) & 1u)) >> 16; }
typedef float f32x2_t __attribute__((ext_vector_type(2))); typedef __bf16 bf16x2_t __attribute__((ext_vector_type(2)));
__device__ __forceinline__ unsigned pk2(float lo, float hi) { const f32x2_t v = {lo, hi}; const bf16x2_t b = __builtin_convertvector(v, bf16x2_t); return __builtin_bit_cast(unsigned, b); }
__device__ __forceinline__ float wave_sum(float v) {
#pragma unroll
  for (int o = 1; o < 64; o <<= 1) v += __shfl_xor(v, o);
  return v;
}
__device__ __forceinline__ float fsilu(float x) { return x * __builtin_amdgcn_rcpf(1.f + __expf(-x)); }
__device__ __forceinline__ float flogsig(float x) { return fminf(x, 0.f) - __logf(1.f + __expf(-fabsf(x))); }

#define GAS __attribute__((address_space(1)))
template <class T> __device__ __forceinline__ T* opq(T* p) { GAS T* g = (GAS T*)p; asm volatile("" : "+s"(g)); return (T*)g; }
__device__ __forceinline__ int crow(int r, int hi) { return (r & 3) + 8 * (r >> 2) + 4 * hi; }
struct Args {
  const float* in[19]; float* out; unsigned char* ws; int ph_lo, ph_hi;
};
struct Frame {
  int tid, lane, wave, vcu, G;
  LAS unsigned char* lds;
};
__device__ __forceinline__ Frame relaunder(const Frame& F0) {
  Frame F = F0; F.tid = threadIdx.x; asm volatile("" : "+v"(F.tid)); F.lane = F.tid & 63; asm volatile("" : "+s"(F.wave), "+s"(F.vcu), "+s"(F.G)); return F; }
}

namespace mk {
__device__ __forceinline__ void p0_ada_item(const Frame& F, const Args& a, int item) {
  LAS float* s = (LAS float*)F.lds; LAS float* red = s + 5 * 1024;
  const float* c = opq(a.in[1]); const float* cc = opq(a.in[3]);
  for (int i = F.tid; i < 5 * 1024; i += 512) { const int r = i >> 10, k = i & 1023; const float v = r < 4 ? c[r * 1024 + k] : cc[k]; s[i] = v / (1.f + expf(-v)); }
  __syncthreads();
  const int kp = F.tid / 24, cl = F.tid % 24;
  const int gcol = item * 24 + cl, l = gcol / 3072, col = gcol % 3072;
  if (kp < 21) {
    const float* w = opq(a.in[5]) + (size_t)l * 1024 * 3072 + col;
    float acc[5] = {0.f, 0.f, 0.f, 0.f, 0.f};
#pragma unroll 1
    for (int kb = 0; kb < 2; ++kb) {
      float wv[25];
#pragma unroll
      for (int j = 0; j < 25; ++j) { const int k = kp + 21 * (25 * kb + j); wv[j] = w[(size_t)(k < 1024 ? k : 1023) * 3072]; }
      __builtin_amdgcn_sched_barrier(0);
#pragma unroll
      for (int j = 0; j < 25; ++j) { const int k = kp + 21 * (25 * kb + j); const int kc = k < 1024 ? k : 1023; const float wz = k < 1024 ? wv[j] : 0.f;
#pragma unroll
        for (int r = 0; r < 5; ++r) acc[r] += s[r * 1024 + kc] * wz; }
    }
#pragma unroll
    for (int r = 0; r < 5; ++r) red[(kp * 24 + cl) * 5 + r] = acc[r];
  }
  __syncthreads();
  if (F.tid < 120) {
    const int cl2 = F.tid / 5, r = F.tid % 5; float t = 0.f;
    for (int q = 0; q < 21; ++q) t += red[(q * 24 + cl2) * 5 + r];
    const int g2 = item * 24 + cl2, l2 = g2 / 3072, col2 = g2 % 3072;
    float* MOD = (float*)(opq(a.ws) + WS_MOD);
    MOD[((size_t)l2 * 5 + r) * 3072 + col2] = t + opq(a.in[6])[l2 * 3072 + col2];
  }
  __syncthreads();
}
__device__ __forceinline__ int rope_perm(int n) { return 16 * ((n >> 2) & 1) + 4 * (n >> 3) + (n & 3); }
__device__ __forceinline__ void p0_tr_item(const float* W, int ldw, int cbase, int permkind, float scale, bf16* dst, int k0, LAS float* scr, int lane) {
  { float t_[32];
#pragma unroll
    for (int i = 0; i < 32; ++i) t_[i] = W[(size_t)(k0 + 2 * i + (lane >> 5)) * ldw + cbase + (lane & 31)];
#pragma unroll
    for (int i = 0; i < 32; ++i) scr[(2 * i + (lane >> 5)) * 33 + (lane & 31)] = t_[i]; }
  asm volatile("s_waitcnt lgkmcnt(0)" ::: "memory");
  const int c = lane & 7;
#pragma unroll
  for (int j = 0; j < 4; ++j) { const int n = (lane >> 3) + 8 * j; const int sidx = permkind ? rope_perm(n) : n; const LAS float* sp = scr + (8 * c) * 33 + sidx;
    u32x4 o; o.x = pk2(sp[0 * 33] * scale, sp[1 * 33] * scale); o.y = pk2(sp[2 * 33] * scale, sp[3 * 33] * scale); o.z = pk2(sp[4 * 33] * scale, sp[5 * 33] * scale); o.w = pk2(sp[6 * 33] * scale, sp[7 * 33] * scale);
    *(u32x4*)(dst + (size_t)n * 1024 + k0 + 8 * c) = o; }
  asm volatile("s_waitcnt lgkmcnt(0)" ::: "memory");
}
__device__ __forceinline__ void p0_la_item(const float* Win, const float* decw  , int dir, int j0, bf16* dst, int k0, LAS float* scr, int lane) {
  float dw[16];
#pragma unroll
  for (int r = 0; r < 16; ++r) dw[r] = decw[(dir * 16 + r) * 128 + j0 + (lane & 31)];
#pragma unroll 4
  for (int i = 0; i < 32; ++i) { const int kk = 2 * i + (lane >> 5); const float* wp = Win + (size_t)(k0 + kk) * PWW + O_LR + dir * 16; float acc = 0.f;
#pragma unroll
    for (int r = 0; r < 16; ++r) acc += wp[r] * dw[r];
    scr[kk * 33 + (lane & 31)] = acc; }
  asm volatile("s_waitcnt lgkmcnt(0)" ::: "memory");
  const int c = lane & 7;
#pragma unroll
  for (int j = 0; j < 4; ++j) { const int n = (lane >> 3) + 8 * j; const LAS float* sp = scr + (8 * c) * 33 + n;
    u32x4 o; o.x = pk2(sp[0 * 33], sp[1 * 33]); o.y = pk2(sp[2 * 33], sp[3 * 33]); o.z = pk2(sp[4 * 33], sp[5 * 33]); o.w = pk2(sp[6 * 33], sp[7 * 33]);
    *(u32x4*)(dst + (size_t)n * 1024 + k0 + 8 * c) = o; }
  asm volatile("s_waitcnt lgkmcnt(0)" ::: "memory");
}
constexpr int FA_AST = 528, FA_WST = 528;
__device__ __forceinline__ void p0_fa_item(const Frame& F, const Args& a, int item) {
  const int l = item >> 4, pn = 4 + ((item >> 3) & 1), g32 = item & 7, bj = g32 >> 2, wc = g32 & 3;
  LAS float* cs = (LAS float*)F.lds; LAS float* sn = cs + 64; LAS float* wfl = sn + 64;
  LAS unsigned char* Ai = F.lds + 512 + 16384;
  LAS unsigned char* Wi = F.lds + F.wave * (32 * FA_WST);
  __syncthreads();
  if (F.tid < 64) { float s_, c_; sincospif(2.f * F.tid / 64.f, &s_, &c_); cs[F.tid] = c_; sn[F.tid] = s_; }
  const float* wf = opq(a.in[12]) + (size_t)l * 256 * 256;
  const int slice0 = 32 * (pn - 4) + 16 * bj + 4 * wc;
  for (int i = F.tid; i < 1024; i += 512) { const int r = i >> 2, q = i & 3; *(LAS f32x4*)(wfl + r * 16 + 4 * q) = *(const f32x4*)(wf + (size_t)r * 256 + 4 * slice0 + 4 * q); }
  __syncthreads();
  {
    const int c = F.tid & 255, part = F.tid >> 8, g = c >> 6, jj = c & 63;
    f32x4 acc[4];
#pragma unroll
    for (int q = 0; q < 4; ++q) acc[q] = (f32x4){0.f, 0.f, 0.f, 0.f};
#pragma unroll 4
    for (int m = 0; m < 64; ++m) { const int idx = (m * jj) & 63; const float t = part ? -sn[idx] : cs[idx];
#pragma unroll
      for (int q = 0; q < 4; ++q) acc[q] += t * *(LAS const f32x4*)(wfl + (g * 64 + m) * 16 + 4 * q); }
#pragma unroll
    for (int fq = 0; fq < 4; ++fq)
#pragma unroll
      for (int j = 0; j < 4; ++j) *(LAS unsigned short*)(Ai + (8 * fq + 4 * part + j) * FA_AST + c * 2) = (unsigned short)f2bf(acc[fq][j] * 0.125f);
  }
  __syncthreads();
  const int r32 = F.lane & 31, hi = F.lane >> 5;
  bf16x8 af[16];
#pragma unroll
  for (int s = 0; s < 16; ++s) af[s] = *(LAS const bf16x8*)(Ai + r32 * FA_AST + (16 * s + 8 * hi) * 2);
  __syncthreads();
  const float* Win = opq(a.in[7]) + (size_t)l * 1024 * PWW + O_BV;
  bf16* dst = (bf16*)(opq(a.ws) + WS_W1T) + ((size_t)l * N1 + pn * 256 + 32 * g32) * 1024;
  for (int kb = 0; kb < 4; ++kb) {
    const int k0 = F.wave * 128 + kb * 32;
#pragma unroll
    for (int rh = 0; rh < 2; ++rh) { f32x4 w[16];
#pragma unroll
      for (int r = 0; r < 16; ++r) w[r] = *(const f32x4*)(Win + (size_t)(k0 + 16 * rh + r) * PWW + 4 * F.lane);
#pragma unroll
      for (int r = 0; r < 16; ++r) *(LAS u32x2*)(Wi + (16 * rh + r) * FA_WST + 8 * F.lane) = (u32x2){pk2(w[r].x, w[r].y), pk2(w[r].z, w[r].w)}; }
    asm volatile("s_waitcnt lgkmcnt(0)" ::: "memory");
    f32x16 acc;
#pragma unroll
    for (int i = 0; i < 16; ++i) acc[i] = 0.f;
#pragma unroll
    for (int s = 0; s < 16; ++s) { const bf16x8 bfr = *(LAS const bf16x8*)(Wi + r32 * FA_WST + (16 * s + 8 * hi) * 2); acc = __builtin_amdgcn_mfma_f32_32x32x16_bf16(af[s], bfr, acc, 0, 0, 0); }
#pragma unroll
    for (int r = 0; r < 16; ++r) dst[(size_t)crow(r, hi) * 1024 + k0 + r32] = (bf16)f2bf(acc[r]);
    asm volatile("s_waitcnt lgkmcnt(0)" ::: "memory");
  }
  __syncthreads();
}
__device__ __forceinline__ void p0_prologue(const Frame& F0, const Args& a) {
 {
  const Frame F = relaunder(F0);
  unsigned char* ws = opq(a.ws);
  { const int gt = F.vcu * 512 + F.tid, GT = F.G * 512;
    float* rope = (float*)(ws + WS_ROPE);
    for (int i = gt; i < 1024; i += GT) { const int pos = i >> 4, f = i & 15; const float ang = (float)pos * powf(10000.f, -(float)f / 16.f); rope[i] = cosf(ang); rope[1024 + i] = sinf(ang); }
    bf16* wc = (bf16*)(ws + WS_WC);
    for (int i = gt; i < 128 * 128; i += GT) { const int r = i >> 7, c = i & 127, rr = r & 63, cc = c & 63; float s_, c_; sincospif(2.f * (float)((rr * cc) & 63) / 64.f, &s_, &c_);
      float v; if (r < 64) v = c < 64 ? c_ : s_; else v = c < 64 ? -s_ : c_; wc[i] = (bf16)f2bf(v * 0.125f); }
    bf16* cs256 = (bf16*)(ws + WS_CS256);
    for (int i = gt; i < 256 * 512; i += GT) { const int k = i >> 9, n = i & 511, nn = n & 255; float s_, c_; sincospif(2.f * (float)((k * nn) & 255) / 256.f, &s_, &c_); cs256[i] = (bf16)f2bf((n < 256 ? c_ : s_) * 0.0625f); }
  }
  for (int it = F.vcu; it < 256 + 32; it += F.G) { if (it < 256) p0_ada_item(F, a, it); else p0_fa_item(F, a, it - 256); }
  LAS float* scr = (LAS float*)(F.lds + F.wave * 16384);
  const bool skipfa = F.G >= 128;
  const int gw = skipfa ? (F.vcu - 32) * 8 + F.wave : F.vcu * 8 + F.wave, NGW = skipfa ? (F.G - 32) * 8 : F.G * 8;
  constexpr int I_DIR = 11 * 8 * 16, I_LA = 8 * 16, I_W2 = 32 * 16, I_L = I_DIR + I_LA + I_W2;
  for (int it = (skipfa && F.vcu < 32) ? 2 * I_L : gw; it < 2 * I_L; it += NGW) {
    const int l = it / I_L; int r = it % I_L;
    const float* Win = opq(a.in[7]) + (size_t)l * 1024 * PWW;
    bf16* W1T = (bf16*)(ws + WS_W1T) + (size_t)l * N1 * 1024;
    if (r < I_DIR) {
      const int ti = r / 128, g32 = (r >> 4) & 7, kb = r & 15;
      const int pn = ti < 3 ? ti : ti + 3;
      const int bj = g32 >> 2, wc = g32 & 3, mcb = 64 * wc + 32 * bj;
      int cbase = 0, pk = 0; float sc = 1.f;
      switch (pn) {
        case 0: if (mcb < 128) { cbase = O_AQ + mcb; sc = GLA_QS; } else cbase = O_AK + mcb - 128; break;
        case 1: cbase = O_AV + mcb; break;
        case 2: cbase = O_AG + mcb; break;
        case 6: cbase = O_BG + mcb; break;
        case 7: cbase = O_CQ + mcb; pk = 1; break;
        case 8: if (wc < 2) { cbase = O_CK + mcb; pk = 1; } else cbase = O_CV + mcb - 128; break;
        case 9: cbase = O_CG + mcb; break;
        case 10: cbase = O_DQ + mcb; break;
        case 11: cbase = O_DK + mcb; break;
        case 12: cbase = O_DV + mcb; break;
        default: cbase = O_DG + mcb; break;
      }
      p0_tr_item(Win, PWW, cbase, pk, sc, W1T + (size_t)(pn * 256 + 32 * g32) * 1024, kb * 64, scr, F.lane);
    } else if (r < I_DIR + I_LA) {
      r -= I_DIR; const int g32 = r >> 4, kb = r & 15, bj = g32 >> 2, wc = g32 & 3, mcb = 64 * wc + 32 * bj;
      p0_la_item(Win, opq(a.in[9]) + (size_t)l * 2 * 16 * 128, mcb >> 7, mcb & 127, W1T + (size_t)(3 * 256 + 32 * g32) * 1024, kb * 64, scr, F.lane);
    } else {
      r -= I_DIR + I_LA; const int g = r >> 4, kb = r & 15;
      p0_tr_item(opq(a.in[8]) + (size_t)l * 1024 * 1024, 1024, 32 * g, 0, 1.f, (bf16*)(ws + WS_W2T) + ((size_t)l * 1024 + 32 * g) * 1024, kb * 64, scr, F.lane);
    }
  }
 }
}
__device__ __forceinline__ void p1_prenorm(const Frame& F0, const Args& a, int layer) {
  const Frame F = relaunder(F0);
  const float* xin = layer == 0 ? opq(a.in[0]) : opq(a.out);
  const float* cin = layer == 0 ? opq(a.in[2]) : (const float*)(opq(a.ws) + WS_CTX1);
  const float* nw = opq(a.in[4]) + layer * 1024;
  const float* MOD = (const float*)(opq(a.ws) + WS_MOD) + (size_t)layer * 5 * 3072;
  bf16* H = (bf16*)(opq(a.ws) + WS_H);
  const int gw = F.vcu * 8 + F.wave, NGW = F.G * 8;
  constexpr int RB = 3;
  f32x4 w_[4];
#pragma unroll
  for (int j = 0; j < 4; ++j) w_[j] = *(const f32x4*)(nw + 4 * F.lane + 256 * j);
  for (int row0 = gw; row0 < MT; row0 += RB * NGW) {
    f32x4 v[RB][4], sc_[RB][4], sh_[RB][4]; float ss[RB];
#pragma unroll
    for (int q = 0; q < RB; ++q) { int row = row0 + q * NGW; row = row < MT ? row : MT - 1;
      const float* src; const float* mod;
      if (row < MLAT) { src = xin + (size_t)row * 1024; mod = MOD + (size_t)(row >> 12) * 3072; }
      else { src = cin + (size_t)(row - MLAT) * 1024; mod = MOD + (size_t)4 * 3072; }
      const f32x4* xr = (const f32x4*)src + F.lane;
#pragma unroll
      for (int j = 0; j < 4; ++j) { v[q][j] = xr[64 * j]; sc_[q][j] = *(const f32x4*)(mod + 1024 + 4 * F.lane + 256 * j); sh_[q][j] = *(const f32x4*)(mod + 4 * F.lane + 256 * j); } }
    __builtin_amdgcn_sched_barrier(0);
#pragma unroll
    for (int q = 0; q < RB; ++q) { float s_ = 0.f;
#pragma unroll
      for (int j = 0; j < 4; ++j) s_ += (v[q][j].x * v[q][j].x + v[q][j].y * v[q][j].y) + (v[q][j].z * v[q][j].z + v[q][j].w * v[q][j].w);
      ss[q] = s_; }
#pragma unroll
    for (int o = 1; o < 64; o <<= 1)
#pragma unroll
      for (int q = 0; q < RB; ++q) ss[q] += __shfl_xor(ss[q], o);
#pragma unroll
    for (int q = 0; q < RB; ++q) { const int row = row0 + q * NGW; if (row >= MT) continue;
      const float rs = 1.0f / sqrtf(ss[q] * (1.f / 1024.f) + 1e-6f);
      unsigned long long* o8 = (unsigned long long*)(H + (size_t)row * 1024) + F.lane;
#pragma unroll
      for (int j = 0; j < 4; ++j) {
        const f32x4 h = v[q][j] * rs * w_[j] * (1.f + sc_[q][j]) + sh_[q][j];
        o8[64 * j] = (unsigned long long)pk2(h.x, h.y) | ((unsigned long long)pk2(h.z, h.w) << 32);
      } }
  }
}
}

namespace mk {
using pg8::Unit;
struct EpiIn {
  static constexpr bool PERM = true, AFTER_DRAIN = false;
  bf16* PLB; float* LA; bf16* FA2; LAS const float* rope;
  __device__ __forceinline__ void operator()(const f32x4 (&acc)[2][2][4][2], const Unit& u, int wr, int wc, int fr, int fq) const {
    const int pn = u.pn;
    const bool ctxrows = u.pm >= 64;
    int kind, slot = 0; LAS const float* nw = rope; bool roped = false; float qs = 1.f;
    LAS const float* cqn = rope + 2048; LAS const float* ckn = rope + 2112; LAS const float* dqn = rope + 2176; LAS const float* dkn = rope + 2240; LAS const float* decb = rope + 2304;
    switch (pn) {
      case 0: kind = 0; slot = S_AQK; break;
      case 1: kind = 0; slot = S_AV; break;
      case 2: kind = 1; slot = S_AG; break;
      case 3: kind = 2; break;
      case 4: case 5: kind = 3; break;
      case 6: kind = 1; slot = S_BG; break;
      case 7: kind = 4; slot = S_CQ; nw = cqn; roped = true; qs = QSCALE; break;
      case 8: slot = S_CKV; if (wc < 2) { kind = 4; nw = ckn; roped = true; } else kind = 0; break;
      case 9: kind = 1; slot = S_CG; break;
      case 10: kind = 4; slot = S_DQ; nw = dqn; qs = QSCALE; break;
      case 11: kind = 4; slot = S_DK; nw = dkn; break;
      case 12: kind = 0; slot = S_DV; break;
      default: kind = 1; slot = S_DG; break;
    }
    const int row0 = u.pm * 256 + wr * 64 + fr;
    float w8[2][8];
    if (kind == 4) {
#pragma unroll
      for (int bj = 0; bj < 2; ++bj)
#pragma unroll
        for (int s = 0; s < 8; ++s) { const int d = roped ? (32 * bj + 16 * (s >> 2) + 4 * fq + (s & 3)) : (32 * bj + 8 * fq + s); w8[bj][s] = nw[d] * qs; }
    } else if (kind == 2) {
#pragma unroll
      for (int bj = 0; bj < 2; ++bj)
#pragma unroll
        for (int s = 0; s < 8; ++s) w8[bj][s] = decb[64 * wc + 32 * bj + 8 * fq + s];
    }
#pragma unroll
    for (int ai = 0; ai < 2; ++ai) {
      float rsr[4];
      if (kind == 4) {
#pragma unroll
        for (int m = 0; m < 4; ++m) { float s_ = 0.f;
#pragma unroll
          for (int bj = 0; bj < 2; ++bj)
#pragma unroll
            for (int n = 0; n < 2; ++n) { const f32x4 t = acc[ai][bj][m][n]; s_ += (t.x * t.x + t.y * t.y) + (t.z * t.z + t.w * t.w); }
          rsr[m] = s_; }
#pragma unroll
        for (int o = 16; o < 64; o <<= 1)
#pragma unroll
          for (int m = 0; m < 4; ++m) rsr[m] += __shfl_xor(rsr[m], o);
#pragma unroll
        for (int m = 0; m < 4; ++m) rsr[m] = __builtin_amdgcn_rsqf(rsr[m] * (1.f / 64.f) + 1e-6f);
      }
#pragma unroll
      for (int m = 0; m < 4; ++m) {
        const int r = row0 + ai * 128 + m * 16;
        float v[2][8];
#pragma unroll
        for (int bj = 0; bj < 2; ++bj)
#pragma unroll
          for (int n = 0; n < 2; ++n)
#pragma unroll
            for (int e = 0; e < 4; ++e) v[bj][4 * n + e] = acc[ai][bj][m][n][e];
        if (kind == 2) {
#pragma unroll
          for (int bj = 0; bj < 2; ++bj) { const int mc = 64 * wc + 32 * bj + 8 * fq; float* dp = LA + (size_t)r * 256 + mc;
            f32x4 o0, o1;
#pragma unroll
            for (int e = 0; e < 4; ++e) { o0[e] = flogsig(v[bj][e] + w8[bj][e]) * 0.0625f; o1[e] = flogsig(v[bj][4 + e] + w8[bj][4 + e]) * 0.0625f; }
            *(f32x4*)dp = o0; *(f32x4*)(dp + 4) = o1; }
        } else if (kind == 3) {
          int b, t; if (!ctxrows) { b = r >> 12; t = r & 4095; } else { const int rc = r - MLAT; b = rc >> 8; t = SEQ + (rc & 255); }
#pragma unroll
          for (int bj = 0; bj < 2; ++bj) { const int slice = 32 * (pn - 4) + 16 * bj + 4 * wc + fq;
            u32x4 o; o.x = pk2(v[bj][0], v[bj][1]); o.y = pk2(v[bj][2], v[bj][3]); o.z = pk2(v[bj][4], v[bj][5]); o.w = pk2(v[bj][6], v[bj][7]);
            *(u32x4*)(FA2 + (((size_t)b * 64 + slice) * TROW + t) * 8) = o; }
        } else {
          if (kind == 1) {
#pragma unroll
            for (int bj = 0; bj < 2; ++bj)
#pragma unroll
              for (int s = 0; s < 8; ++s) v[bj][s] = fsilu(v[bj][s]);
          } else if (kind == 4) {
            const float rs = rsr[m];
#pragma unroll
            for (int bj = 0; bj < 2; ++bj)
#pragma unroll
              for (int s = 0; s < 8; ++s) v[bj][s] *= rs * w8[bj][s];
            if (roped && !ctxrows) {
              const int t = r & 4095;
#pragma unroll
              for (int bj = 0; bj < 2; ++bj) { const int pos = bj == 0 ? (t >> 6) : (t & 63);
                const f32x4 c4 = *(LAS const f32x4*)(rope + pos * 16 + 4 * fq), s4 = *(LAS const f32x4*)(rope + 1024 + pos * 16 + 4 * fq);
#pragma unroll
                for (int e = 0; e < 4; ++e) { const float x1 = v[bj][e], x2 = v[bj][4 + e]; v[bj][e] = x1 * c4[e] - x2 * s4[e]; v[bj][4 + e] = x2 * c4[e] + x1 * s4[e]; } }
            }
          }
#pragma unroll
          for (int bj = 0; bj < 2; ++bj) { const int mc = 64 * wc + 32 * bj + 8 * fq;
            u32x4 o; o.x = pk2(v[bj][0], v[bj][1]); o.y = pk2(v[bj][2], v[bj][3]); o.z = pk2(v[bj][4], v[bj][5]); o.w = pk2(v[bj][6], v[bj][7]);
            *(u32x4*)(PLB + (size_t)r * PLW + slot * 256 + mc) = o; }
        }
        asm volatile("" ::: "memory");
      }
    }
  }
};
struct EpiOut {
  static constexpr bool PERM = true, AFTER_DRAIN = false;
  const float* xin; const float* cin; float* xout; float* cout; const float* MODl;
  __device__ __forceinline__ void operator()(const f32x4 (&acc)[2][2][4][2], const Unit& u, int wr, int wc, int fr_, int fq_) const {
    int fr = fr_, fq = fq_; asm volatile("" : "+v"(fr), "+v"(fq));
    const int row0 = u.pm * 256 + wr * 64 + fr, col0 = u.pn * 256 + wc * 32 + 8 * fq;
    const bool ctxrows = u.pm >= 64;
    const float* gate = MODl + (size_t)(ctxrows ? 4 : (u.pm >> 4)) * 3072 + 2048;
    f32x4 gv[2][2];
#pragma unroll
    for (int bj = 0; bj < 2; ++bj)
#pragma unroll
      for (int n = 0; n < 2; ++n) gv[bj][n] = *(const f32x4*)(gate + col0 + bj * 128 + n * 4);
    const float* sp0; float* dp0;
    if (!ctxrows) { sp0 = xin + (size_t)row0 * 1024 + col0; dp0 = xout + (size_t)row0 * 1024 + col0; }
    else { sp0 = cin + (size_t)(row0 - MLAT) * 1024 + col0; dp0 = cout + (size_t)(row0 - MLAT) * 1024 + col0; }
#pragma unroll
    for (int ai = 0; ai < 2; ++ai) {
      f32x4 xv[4][2][2];
#pragma unroll
      for (int m = 0; m < 4; ++m)
#pragma unroll
        for (int bj = 0; bj < 2; ++bj)
#pragma unroll
          for (int n = 0; n < 2; ++n) xv[m][bj][n] = *(const f32x4*)(sp0 + (size_t)(ai * 128 + m * 16) * 1024 + bj * 128 + n * 4);
      __builtin_amdgcn_sched_barrier(0);
#pragma unroll
      for (int m = 0; m < 4; ++m)
#pragma unroll
        for (int bj = 0; bj < 2; ++bj)
#pragma unroll
          for (int n = 0; n < 2; ++n) *(f32x4*)(dp0 + (size_t)(ai * 128 + m * 16) * 1024 + bj * 128 + n * 4) = xv[m][bj][n] + gv[bj][n] * acc[ai][bj][m][n];
      asm volatile("" ::: "memory");
    }
  }
};
struct InOrder {
  pg8::StaticOrder S;
  static constexpr unsigned long long PACK = 0x3c817d9b0a5246ull;
  __device__ __forceinline__ bool next(int i, Unit& u) const { const bool ok = S.next(i, u); if (ok) u.pn = (int)((PACK >> (4 * u.pn)) & 15ull); return ok; }
  __device__ __forceinline__ void a_ready(const Unit&) const {}
  __device__ __forceinline__ void done(const Unit&) const {}
};
__device__ __forceinline__ void p2_inproj(const Frame& F, const Args& a, int layer) {
  unsigned char* ws = opq(a.ws);
  pg8::Gemm g{(const pg8::bf16_t*)(ws + WS_H), (const pg8::bf16_t*)(ws + WS_W1T) + (size_t)layer * N1 * 1024, MT, N1, 1024};
  InOrder S; S.S.init(MT, N1, F.G, (int)blockIdx.x);
  LAS float* ropeL = (LAS float*)(F.lds + pg8::STAGE_BYTES);
  { int tid = threadIdx.x; asm volatile("" : "+v"(tid)); const f32x4 t = *(const f32x4*)((const float*)(ws + WS_ROPE) + 4 * tid); *(LAS f32x4*)(ropeL + 4 * tid) = t;
    if (tid < 128) {
      const float* n0 = opq(a.in[13]); const float* n1 = opq(a.in[14]); const float* n2 = opq(a.in[16]); const float* n3 = opq(a.in[17]); const float* db = opq(a.in[10]);
      const int k = tid >> 4; const float* src = tid < 64 ? (k == 0 ? n0 : k == 1 ? n1 : k == 2 ? n2 : n3) + layer * 64 + 4 * (tid & 15) : db + layer * 256 + 4 * (tid - 64);
      *(LAS f32x4*)(ropeL + 2048 + 4 * tid) = *(const f32x4*)src; } }
  __syncthreads();
  EpiIn E{(bf16*)(ws + WS_PLB), (float*)(ws + WS_LA), (bf16*)(ws + WS_FA2), ropeL};
  { Unit u_; if (!S.next(3, u_)) { for (int i = 0; i < 3; ++i) __builtin_amdgcn_s_sleep(127); } }
  pg8::gemm_phase<EpiIn, InOrder>(F.lds, g, S, E, nullptr);
}

constexpr int CO_ST = 528;
constexpr int CO_OP = 64 * CO_ST, CO_BUF = 2 * CO_OP;
__device__ __forceinline__ void ctx_out_item(const Frame& F, const Args& a, int item) {
  unsigned char* ws = opq(a.ws);
  const bf16* Yc = (const bf16*)(ws + WS_H) + (size_t)MLAT * 1024; const bf16* W2 = (const bf16*)(ws + WS_W2T);
  const int tm = item >> 4, tn = item & 15, sub = F.wave & 3, kh = F.wave >> 2, r32 = F.lane & 31, hi = F.lane >> 5;
  const int row0 = 64 * tm + 32 * (sub >> 1), col0 = 64 * tn + 32 * (sub & 1);
  const int srow = F.tid >> 5, sc16 = F.tid & 31;
  const bf16* ag = Yc + (size_t)(64 * tm + srow) * 1024 + sc16 * 8; const bf16* bg = W2 + (size_t)(64 * tn + srow) * 1024 + sc16 * 8;
  LAS unsigned char* sdst = F.lds + srow * CO_ST + sc16 * 16;
  f32x16 acc;
#pragma unroll
  for (int i = 0; i < 16; ++i) acc[i] = 0.f;
  LAS const unsigned char* afp = F.lds + (32 * (sub >> 1) + r32) * CO_ST + (128 * kh + 8 * hi) * 2;
  LAS const unsigned char* bfp = F.lds + CO_OP + (32 * (sub & 1) + r32) * CO_ST + (128 * kh + 8 * hi) * 2;
  u32x4 st[2][2][4];
#pragma unroll
  for (int cp = 0; cp < 2; ++cp)
#pragma unroll
    for (int p = 0; p < 4; ++p) { st[cp][0][p] = *(const u32x4*)(ag + (size_t)(16 * p) * 1024 + cp * 256); st[cp][1][p] = *(const u32x4*)(bg + (size_t)(16 * p) * 1024 + cp * 256); }
  __syncthreads();
#pragma unroll 1
  for (int pair = 0; pair < 2; ++pair) {
#pragma unroll
    for (int cp = 0; cp < 2; ++cp)
#pragma unroll
      for (int p = 0; p < 4; ++p) { *(LAS u32x4*)(sdst + cp * CO_BUF + (16 * p) * CO_ST) = st[cp][0][p]; *(LAS u32x4*)(sdst + cp * CO_BUF + CO_OP + (16 * p) * CO_ST) = st[cp][1][p]; }
    __syncthreads();
    if (pair == 0) {
#pragma unroll
      for (int cp = 0; cp < 2; ++cp)
#pragma unroll
        for (int p = 0; p < 4; ++p) { st[cp][0][p] = *(const u32x4*)(ag + (size_t)(16 * p) * 1024 + (2 + cp) * 256); st[cp][1][p] = *(const u32x4*)(bg + (size_t)(16 * p) * 1024 + (2 + cp) * 256); }
    }
#pragma unroll
    for (int cp = 0; cp < 2; ++cp)
#pragma unroll
      for (int s = 0; s < 8; ++s) {
        const bf16x8 af = *(LAS const bf16x8*)(afp + cp * CO_BUF + s * 32), bf = *(LAS const bf16x8*)(bfp + cp * CO_BUF + s * 32);
        acc = __builtin_amdgcn_mfma_f32_32x32x16_bf16(af, bf, acc, 0, 0, 0);
      }
    __syncthreads();
  }
  LAS float* X = (LAS float*)F.lds + sub * 1024;
  __syncthreads();
  if (kh == 1) {
#pragma unroll
    for (int r = 0; r < 16; ++r) X[r * 64 + F.lane] = acc[r];
  }
  __syncthreads();
  if (kh == 0) {
    const float* cin = opq(a.in[2]); float* cout = (float*)(ws + WS_CTX1);
    const float gate = ((const float*)(ws + WS_MOD))[4 * 3072 + 2048 + col0 + r32];
    float ci[16];
#pragma unroll
    for (int r = 0; r < 16; ++r) ci[r] = cin[(size_t)(row0 + crow(r, hi)) * 1024 + col0 + r32];
    __builtin_amdgcn_sched_barrier(0);
#pragma unroll
    for (int r = 0; r < 16; ++r) { const size_t o = (size_t)(row0 + crow(r, hi)) * 1024 + col0 + r32; cout[o] = ci[r] + gate * (acc[r] + X[r * 64 + F.lane]); }
  }
}
__device__ __forceinline__ void p5_outproj(const Frame& F, const Args& a, int layer) {
  unsigned char* ws = opq(a.ws);
  const int M = MLAT;
  pg8::Gemm g{(const pg8::bf16_t*)(ws + WS_H), (const pg8::bf16_t*)(ws + WS_W2T) + (size_t)layer * 1024 * 1024, M, 1024, 1024};
  pg8::StaticOrder S; S.init(M, 1024, F.G, (int)blockIdx.x);
  EpiOut E{layer == 0 ? opq(a.in[0]) : opq(a.out), layer == 0 ? opq(a.in[2]) : (const float*)(ws + WS_CTX1), opq(a.out), (float*)(ws + WS_CTX1), (const float*)(ws + WS_MOD) + (size_t)layer * 5 * 3072};
  pg8::gemm_phase<EpiOut, pg8::StaticOrder>(F.lds, g, S, E, nullptr);
  if (layer == 0) { const Frame F2 = relaunder(F); for (int it = F2.vcu; it < 256; it += F2.G) ctx_out_item(F2, a, it); }
}
}

namespace mk {
typedef short v4i16_t __attribute__((ext_vector_type(4)));
__device__ __forceinline__ s16x4 vtr(LAS const unsigned char* p) { return __builtin_bit_cast(s16x4, __builtin_amdgcn_ds_read_tr16_b64_v4i16((LAS v4i16_t*)p)); }
struct AttnState { float m, l; f32x16 o0, o1; };
template <class MaskF>
__device__ __forceinline__ void attn_tile(AttnState& st, const bf16x8 (&qf)[4], LAS const unsigned char* Kt, LAS const unsigned char* Vt, int lane, MaskF&& maskf) {
  const int r32 = lane & 31, hi = lane >> 5;
  f32x16 p0, p1;
  const int ksw = (r32 >> 1) & 7;
  bf16x8 ka[4], kb[4];
#pragma unroll
  for (int s = 0; s < 4; ++s) { const int ch = ((2 * s + hi) ^ ksw) << 4; ka[s] = *(LAS const bf16x8*)(Kt + r32 * 128 + ch); kb[s] = *(LAS const bf16x8*)(Kt + (32 + r32) * 128 + ch); }
  { const f32x16 z = {0.f, 0.f, 0.f, 0.f, 0.f, 0.f, 0.f, 0.f, 0.f, 0.f, 0.f, 0.f, 0.f, 0.f, 0.f, 0.f};
    p0 = __builtin_amdgcn_mfma_f32_32x32x16_bf16(ka[0], qf[0], z, 0, 0, 0); p1 = __builtin_amdgcn_mfma_f32_32x32x16_bf16(kb[0], qf[0], z, 0, 0, 0); }
#pragma unroll
  for (int s = 1; s < 4; ++s) { p0 = __builtin_amdgcn_mfma_f32_32x32x16_bf16(ka[s], qf[s], p0, 0, 0, 0); p1 = __builtin_amdgcn_mfma_f32_32x32x16_bf16(kb[s], qf[s], p1, 0, 0, 0); }
  maskf(p0, p1);
  float ps = 0.f;
#pragma unroll
  for (int i = 0; i < 16; ++i) { p0[i] = __builtin_amdgcn_exp2f(p0[i]); p1[i] = __builtin_amdgcn_exp2f(p1[i]); ps += p0[i] + p1[i]; }
  st.l += ps;
  u32x4 pw[4];
#pragma unroll
  for (int k = 0; k < 2; ++k) {
    pw[k] = (u32x4){pk2(p0[8 * k + 0], p0[8 * k + 1]), pk2(p0[8 * k + 2], p0[8 * k + 3]), pk2(p0[8 * k + 4], p0[8 * k + 5]), pk2(p0[8 * k + 6], p0[8 * k + 7])};
    pw[2 + k] = (u32x4){pk2(p1[8 * k + 0], p1[8 * k + 1]), pk2(p1[8 * k + 2], p1[8 * k + 3]), pk2(p1[8 * k + 4], p1[8 * k + 5]), pk2(p1[8 * k + 6], p1[8 * k + 7])};
  }
  const int q = (lane & 15) >> 2, p = lane & 3, gsel = (lane >> 4) & 1;
  const int vrow = (4 * hi + q) * 128 + 8 * (p & 1);
  const int chb = 2 * gsel + (p >> 1);
#pragma unroll
  for (int ks = 0; ks < 4; ++ks) {
    const int c0_ = ((chb | ((0 ^ (q >> 1)) << 2)) << 4), c1_ = ((chb | ((1 ^ (q >> 1)) << 2)) << 4);
    const s16x4 l0 = vtr(Vt + ks * 2048 + vrow + c0_), h0 = vtr(Vt + ks * 2048 + 1024 + vrow + c0_), l1 = vtr(Vt + ks * 2048 + vrow + c1_), h1 = vtr(Vt + ks * 2048 + 1024 + vrow + c1_);
    const bf16x8 va0 = (bf16x8){l0[0], l0[1], l0[2], l0[3], h0[0], h0[1], h0[2], h0[3]}, va1 = (bf16x8){l1[0], l1[1], l1[2], l1[3], h1[0], h1[1], h1[2], h1[3]};
    st.o0 = __builtin_amdgcn_mfma_f32_32x32x16_bf16(va0, __builtin_bit_cast(bf16x8, pw[ks]), st.o0, 0, 0, 0);
    st.o1 = __builtin_amdgcn_mfma_f32_32x32x16_bf16(va1, __builtin_bit_cast(bf16x8, pw[ks]), st.o1, 0, 0, 0);
  }
}
template <class MaskF, class F1, class F2, class F3>
__device__ __forceinline__ void attn_tile_dma(AttnState& st, const bf16x8 (&qf)[4], LAS const unsigned char* Kt, LAS const unsigned char* Vt, int lane, MaskF&& maskf, F1&& after_k, F2&& before_v, F3&& after_v) {
  const int r32 = lane & 31, hi = lane >> 5;
  f32x16 p0, p1;
  const int ksw = (r32 >> 1) & 7;
  bf16x8 ka[4], kb[4];
#pragma unroll
  for (int s = 0; s < 4; ++s) { const int ch = ((2 * s + hi) ^ ksw) << 4; ka[s] = *(LAS const bf16x8*)(Kt + r32 * 128 + ch); kb[s] = *(LAS const bf16x8*)(Kt + (32 + r32) * 128 + ch); }
  asm volatile("s_waitcnt lgkmcnt(0)" ::: "memory");
  after_k();
  { const f32x16 z = {0.f, 0.f, 0.f, 0.f, 0.f, 0.f, 0.f, 0.f, 0.f, 0.f, 0.f, 0.f, 0.f, 0.f, 0.f, 0.f};
    p0 = __builtin_amdgcn_mfma_f32_32x32x16_bf16(ka[0], qf[0], z, 0, 0, 0); p1 = __builtin_amdgcn_mfma_f32_32x32x16_bf16(kb[0], qf[0], z, 0, 0, 0); }
#pragma unroll
  for (int s = 1; s < 4; ++s) { p0 = __builtin_amdgcn_mfma_f32_32x32x16_bf16(ka[s], qf[s], p0, 0, 0, 0); p1 = __builtin_amdgcn_mfma_f32_32x32x16_bf16(kb[s], qf[s], p1, 0, 0, 0); }
  maskf(p0, p1);
  float ps = 0.f;
#pragma unroll
  for (int i = 0; i < 16; ++i) { p0[i] = __builtin_amdgcn_exp2f(p0[i]); p1[i] = __builtin_amdgcn_exp2f(p1[i]); ps += p0[i] + p1[i]; }
  st.l += ps;
  u32x4 pw[4];
#pragma unroll
  for (int k = 0; k < 2; ++k) {
    pw[k] = (u32x4){pk2(p0[8 * k + 0], p0[8 * k + 1]), pk2(p0[8 * k + 2], p0[8 * k + 3]), pk2(p0[8 * k + 4], p0[8 * k + 5]), pk2(p0[8 * k + 6], p0[8 * k + 7])};
    pw[2 + k] = (u32x4){pk2(p1[8 * k + 0], p1[8 * k + 1]), pk2(p1[8 * k + 2], p1[8 * k + 3]), pk2(p1[8 * k + 4], p1[8 * k + 5]), pk2(p1[8 * k + 6], p1[8 * k + 7])};
  }
  before_v();
  const int q = (lane & 15) >> 2, p = lane & 3, gsel = (lane >> 4) & 1;
  const int vrow = (4 * hi + q) * 128 + 8 * (p & 1);
  const int chb = 2 * gsel + (p >> 1);
  s16x4 vl0[4], vh0[4], vl1[4], vh1[4];
#pragma unroll
  for (int ks = 0; ks < 4; ++ks) {
    const int c0_ = ((chb | ((0 ^ (q >> 1)) << 2)) << 4), c1_ = ((chb | ((1 ^ (q >> 1)) << 2)) << 4);
    vl0[ks] = vtr(Vt + ks * 2048 + vrow + c0_); vh0[ks] = vtr(Vt + ks * 2048 + 1024 + vrow + c0_); vl1[ks] = vtr(Vt + ks * 2048 + vrow + c1_); vh1[ks] = vtr(Vt + ks * 2048 + 1024 + vrow + c1_);
  }
  asm volatile("s_waitcnt lgkmcnt(0)" ::: "memory");
  after_v();
#pragma unroll
  for (int ks = 0; ks < 4; ++ks) {
    const bf16x8 va0 = (bf16x8){vl0[ks][0], vl0[ks][1], vl0[ks][2], vl0[ks][3], vh0[ks][0], vh0[ks][1], vh0[ks][2], vh0[ks][3]}, va1 = (bf16x8){vl1[ks][0], vl1[ks][1], vl1[ks][2], vl1[ks][3], vh1[ks][0], vh1[ks][1], vh1[ks][2], vh1[ks][3]};
    st.o0 = __builtin_amdgcn_mfma_f32_32x32x16_bf16(va0, __builtin_bit_cast(bf16x8, pw[ks]), st.o0, 0, 0, 0);
    st.o1 = __builtin_amdgcn_mfma_f32_32x32x16_bf16(va1, __builtin_bit_cast(bf16x8, pw[ks]), st.o1, 0, 0, 0);
  }
}
__device__ __forceinline__ void glds16(const void* sbase  , unsigned voff  , unsigned lds_dst) {
  unsigned keep;
  asm volatile("s_mov_b32 %0, m0\n\ts_mov_b32 m0, %2\n\ts_nop 0\n\tglobal_load_lds_dwordx4 %1, %3\n\ts_mov_b32 m0, %0" : "=&s"(keep) : "v"(voff), "s"(lds_dst), "s"(sbase) : "memory");
}
__device__ __forceinline__ void glds16x8(const void* sbase, const unsigned (&vo)[8], unsigned lds_dst) {
  unsigned keep;
  asm volatile("s_mov_b32 %0, m0\n\ts_mov_b32 m0, %9\n\ts_nop 0\n\tglobal_load_lds_dwordx4 %1, %10\n\t"
               "s_add_u32 m0, m0, 0x400\n\ts_nop 0\n\tglobal_load_lds_dwordx4 %2, %10\n\t"
               "s_add_u32 m0, m0, 0x400\n\ts_nop 0\n\tglobal_load_lds_dwordx4 %3, %10\n\t"
               "s_add_u32 m0, m0, 0x400\n\ts_nop 0\n\tglobal_load_lds_dwordx4 %4, %10\n\t"
               "s_add_u32 m0, m0, 0x400\n\ts_nop 0\n\tglobal_load_lds_dwordx4 %5, %10\n\t"
               "s_add_u32 m0, m0, 0x400\n\ts_nop 0\n\tglobal_load_lds_dwordx4 %6, %10\n\t"
               "s_add_u32 m0, m0, 0x400\n\ts_nop 0\n\tglobal_load_lds_dwordx4 %7, %10\n\t"
               "s_add_u32 m0, m0, 0x400\n\ts_nop 0\n\tglobal_load_lds_dwordx4 %8, %10\n\t"
               "s_mov_b32 m0, %0"
               : "=&s"(keep) : "v"(vo[0]), "v"(vo[1]), "v"(vo[2]), "v"(vo[3]), "v"(vo[4]), "v"(vo[5]), "v"(vo[6]), "v"(vo[7]), "s"(lds_dst), "s"(sbase) : "memory", "scc");
}
__device__ __forceinline__ void attn_store(const AttnState& st, float inv, const bf16* grow  , bf16* yrow  , int lane) {
  const int hi = lane >> 5;
  u32x2 gv[8];
#pragma unroll
  for (int i = 0; i < 8; ++i) gv[i] = *(const u32x2*)(grow + 32 * (i >> 2) + 8 * (i & 3) + 4 * hi);
  __builtin_amdgcn_sched_barrier(0);
#pragma unroll
  for (int d0 = 0; d0 < 2; ++d0)
#pragma unroll
    for (int gi = 0; gi < 4; ++gi) {
      const int db = 32 * d0 + 8 * gi + 4 * hi; const u32x2 g = gv[4 * d0 + gi];
      const f32x16& o = d0 == 0 ? st.o0 : st.o1;
      const float g0 = __uint_as_float(g.x << 16), g1 = __uint_as_float(g.x & 0xffff0000u), g2 = __uint_as_float(g.y << 16), g3 = __uint_as_float(g.y & 0xffff0000u);
      u32x2 ov; ov.x = pk2(o[4 * gi + 0] * inv * g0, o[4 * gi + 1] * inv * g1); ov.y = pk2(o[4 * gi + 2] * inv * g2, o[4 * gi + 3] * inv * g3);
      *(u32x2*)(yrow + db) = ov;
    }
}
__device__ __forceinline__ void attn_gates(u32x2 (&gv)[8], const bf16* grow, int lane) {
  const int hi = lane >> 5;
#pragma unroll
  for (int i = 0; i < 8; ++i) gv[i] = *(const u32x2*)(grow + 32 * (i >> 2) + 8 * (i & 3) + 4 * hi);
}
__device__ __forceinline__ void attn_store_g(const AttnState& st, float inv, const u32x2 (&gv)[8], bf16* yrow, int lane) {
  const int hi = lane >> 5;
#pragma unroll
  for (int d0 = 0; d0 < 2; ++d0)
#pragma unroll
    for (int gi = 0; gi < 4; ++gi) {
      const int db = 32 * d0 + 8 * gi + 4 * hi; const u32x2 g = gv[4 * d0 + gi];
      const f32x16& o = d0 == 0 ? st.o0 : st.o1;
      const float g0 = __uint_as_float(g.x << 16), g1 = __uint_as_float(g.x & 0xffff0000u), g2 = __uint_as_float(g.y << 16), g3 = __uint_as_float(g.y & 0xffff0000u);
      u32x2 ov; ov.x = pk2(o[4 * gi + 0] * inv * g0, o[4 * gi + 1] * inv * g1); ov.y = pk2(o[4 * gi + 2] * inv * g2, o[4 * gi + 3] * inv * g3);
      *(u32x2*)(yrow + db) = ov;
    }
}
template <int NH> struct TileRegs { u32x4 k[NH], v[NH]; };
template <int NH>
__device__ __forceinline__ void tile_load(TileRegs<NH>& R, const bf16* kbase  , const bf16* vbase, int tid) {
  const int key = tid >> 3, ch = tid & 7;
#pragma unroll
  for (int h = 0; h < NH; ++h) { R.k[h] = *(const u32x4*)(kbase + (size_t)key * PLW + h * 64 + ch * 8); R.v[h] = *(const u32x4*)(vbase + (size_t)key * PLW + h * 64 + ch * 8); }
}
template <int NH>
__device__ __forceinline__ void tile_store(const TileRegs<NH>& R, LAS unsigned char* buf, int tid) {
  const int key = tid >> 3, ch = tid & 7;
  const int ko = key * 128 + ((ch ^ ((key >> 1) & 7)) << 4), vo = key * 128 + ((ch ^ (((key >> 1) & 1) << 2)) << 4);
#pragma unroll
  for (int h = 0; h < NH; ++h) { *(LAS u32x4*)(buf + h * 8192 + ko) = R.k[h]; *(LAS u32x4*)(buf + NH * 8192 + h * 8192 + vo) = R.v[h]; }
}

template <int NH> struct TileRegs2 { TileRegs<NH> a, b; };
__device__ __forceinline__ void swa_item(const Frame& F0, const Args& a, int layer, int item) {
  const Frame F = relaunder(F0);
  unsigned char* ws = opq(a.ws);
  const bf16* PLB = (const bf16*)(ws + WS_PLB); bf16* Y = (bf16*)(ws + WS_H);
  const bool isctx = item >= 256;
  int b, kvh, n;
  if (!isctx) { b = item >> 6; kvh = (item >> 5) & 1; n = item & 31; } else { const int ci = item - 256; b = ci >> 2; kvh = (ci >> 1) & 1; n = ci & 1; }
  const int g = F.wave >> 2, quarter = F.wave & 3, hq = 2 * kvh + g, r32 = F.lane & 31, hi = F.lane >> 5;
  const int tq = 128 * n + 32 * quarter + r32;
  const size_t qrow = isctx ? (size_t)MLAT + b * CTX + tq : (size_t)b * SEQ + tq;
  bf16x8 qf[4];
#pragma unroll
  for (int s = 0; s < 4; ++s) qf[s] = *(const bf16x8*)(PLB + qrow * PLW + S_CQ * 256 + hq * 64 + 16 * s + 8 * hi);
  int jlo = 0, jhi = 0;
  if (!isctx) { jlo = n == 0 ? 1 : 0; jhi = n == 31 ? 2 : 3; }
  const int nloc = jhi - jlo, T = nloc + 2;
  const bf16* kcol = PLB + S_CKV * 256 + kvh * 64;
  auto tile_row = [&](int t) -> size_t { return t < nloc ? (size_t)b * SEQ + 128 * (n - 1 + jlo + t) : (size_t)MLAT + b * CTX + 128 * (t - nloc); };
  AttnState st; st.m = 0.f; st.l = 0.f;
#pragma unroll
  for (int i = 0; i < 16; ++i) { st.o0[i] = 0.f; st.o1[i] = 0.f; }
  TileRegs2<1> R;
  __syncthreads();
  { const size_t r0 = tile_row(0); tile_load<1>(R.a, kcol + r0 * PLW, kcol + 128 + r0 * PLW, F.tid); tile_load<1>(R.b, kcol + (r0 + 64) * PLW, kcol + 128 + (r0 + 64) * PLW, F.tid); }
  tile_store<1>(R.a, F.lds, F.tid); tile_store<1>(R.b, F.lds + 16384, F.tid);
  __syncthreads();
  for (int t = 0; t < T; ++t) {
    if (t + 1 < T) { const size_t r0 = tile_row(t + 1); tile_load<1>(R.a, kcol + r0 * PLW, kcol + 128 + r0 * PLW, F.tid); tile_load<1>(R.b, kcol + (r0 + 64) * PLW, kcol + 128 + (r0 + 64) * PLW, F.tid); }
    LAS const unsigned char* buf = F.lds + (t & 1) * 32768;
#pragma unroll
    for (int hf = 0; hf < 2; ++hf) {
      LAS const unsigned char* hb = buf + hf * 16384;
      if (t < nloc) {
        const int kb = 128 * (n - 1 + jlo + t) + 64 * hf, q0 = 128 * n + 32 * quarter;
        if (!(kb + 63 < q0 - 128 || kb > q0 + 31 + 128)) {
          const int dq = kb - tq;
          if (kb >= q0 + 31 - 128 && kb + 63 <= q0 + 128) attn_tile(st, qf, hb, hb + 8192, F.lane, [](f32x16&, f32x16&) {});
          else attn_tile(st, qf, hb, hb + 8192, F.lane, [&](f32x16& p0, f32x16& p1) {
#pragma unroll
            for (int r = 0; r < 16; ++r) { const int d0_ = dq + 128 + crow(r, hi), d1_ = d0_ + 32;
              p0[r] = ((unsigned)d0_ <= 256u) ? p0[r] : -INFINITY; p1[r] = ((unsigned)d1_ <= 256u) ? p1[r] : -INFINITY; } });
        }
      } else attn_tile(st, qf, hb, hb + 8192, F.lane, [](f32x16&, f32x16&) {});
    }
    if (t + 1 < T) { tile_store<1>(R.a, F.lds + ((t + 1) & 1) * 32768, F.tid); tile_store<1>(R.b, F.lds + ((t + 1) & 1) * 32768 + 16384, F.tid); }
    __syncthreads();
  }
  float l = st.l + __shfl_xor(st.l, 32);
  const float sk2 = opq(a.in[15])[layer * 4 + hq] * LOG2E;
  const float mnew = fmaxf(st.m, sk2), al = __builtin_amdgcn_exp2f(st.m - mnew);
  l = l * al + __builtin_amdgcn_exp2f(sk2 - mnew);
  int qr = (int)qrow; asm volatile("" : "+v"(qr));
  attn_store(st, al / l, PLB + (size_t)qr * PLW + S_CG * 256 + hq * 64, Y + (size_t)qr * 1024 + 512 + hq * 64, F.lane);
}
__device__ __forceinline__ void na_item(const Frame& F0, const Args& a, int layer, int item) {
  const Frame F = relaunder(F0);
  unsigned char* ws = opq(a.ws);
  const bf16* PLB = (const bf16*)(ws + WS_PLB); bf16* Y = (bf16*)(ws + WS_H);
  const bool isctx = item >= 256;
  int b, r;
  if (!isctx) { b = item >> 6; r = item & 63; } else { const int ci = item - 256; b = ci >> 2; r = ci & 3; }
  const int head = F.wave >> 1, half = F.wave & 1, r32 = F.lane & 31, hi = F.lane >> 5;
  const int qc = 32 * half + r32;
  const size_t qrow = isctx ? (size_t)MLAT + b * CTX + 64 * r + qc : (size_t)b * SEQ + 64 * r + qc;
  bf16x8 qf[4];
#pragma unroll
  for (int s = 0; s < 4; ++s) qf[s] = *(const bf16x8*)(PLB + qrow * PLW + S_DQ * 256 + head * 64 + 16 * s + 8 * hi);
  int rs = r - 4; rs = rs < 0 ? 0 : (rs > 56 ? 56 : rs);
  const int nloc = isctx ? 0 : 8, T = nloc + 4;
  auto tile_row = [&](int t) -> size_t { return t < nloc ? (size_t)b * SEQ + 64 * (rs + t) : (size_t)MLAT + b * CTX + 64 * (t - nloc); };
  const bf16* kcol = PLB + S_DK * 256 + head * 64; const bf16* vcol = PLB + S_DV * 256 + head * 64;
  LAS float* btab = (LAS float*)(F.lds + 2 * 65536);
  LAS unsigned char* Kt = F.lds + F.wave * 16384; LAS unsigned char* Vt = Kt + 8192;
  const unsigned kdst = (unsigned)(size_t)Kt, vdst = kdst + 8192u;
  const int kk = F.lane >> 3, cs = F.lane & 7;
  const unsigned ok0 = kk * (PLW * 2) + ((cs ^ (kk >> 1)) << 4), ok1 = kk * (PLW * 2) + ((cs ^ (4 + (kk >> 1))) << 4), ov = kk * (PLW * 2) + ((cs ^ (((kk >> 1) & 1) << 2)) << 4);
  unsigned vok[8], vov[8];
#pragma unroll
  for (int n = 0; n < 8; ++n) { vok[n] = ((n & 1) ? ok1 : ok0) + n * 8 * (PLW * 2); vov[n] = ov + n * 8 * (PLW * 2); }
  auto dma_k = [&](int t) { glds16x8(kcol + tile_row(t) * PLW, vok, kdst); };
  auto dma_v = [&](int t) { glds16x8(vcol + tile_row(t) * PLW, vov, vdst); };
  AttnState st; st.m = 0.f; st.l = 0.f;
#pragma unroll
  for (int i = 0; i < 16; ++i) { st.o0[i] = 0.f; st.o1[i] = 0.f; }
  u32x2 gv[8];
  { int qr0 = (int)qrow; asm volatile("" : "+v"(qr0)); attn_gates(gv, PLB + (size_t)qr0 * PLW + S_DG * 256 + head * 64, F.lane); }
  float t_[15];
  { const float* rb = opq(a.in[18]) + (size_t)layer * 4 * 15 * 31;
#pragma unroll
    for (int i = 0; i < 15; ++i) { const int ix = F.tid + 512 * i, hd = ix >> 7, dx = (ix & 127) - 63; const int dc = dx < -15 ? -15 : (dx > 15 ? 15 : dx); t_[i] = rb[hd * 31 + dc + 15]; } }
  __builtin_amdgcn_sched_barrier(0);
#pragma unroll
  for (int s = 0; s < 4; ++s) asm volatile("" : "+v"(qf[s]));
#pragma unroll
  for (int i = 0; i < 15; ++i) asm volatile("" : "+v"(t_[i]));
#pragma unroll
  for (int i = 0; i < 8; ++i) asm volatile("" : "+v"(gv[i]));
  __syncthreads();
  dma_k(0); dma_v(0);
#pragma unroll
  for (int i = 0; i < 15; ++i) { const int dx = ((F.tid + 512 * i) & 127) - 63; btab[F.tid + 512 * i] = (dx >= -15 && dx <= 15) ? t_[i] * LOG2E : 0.f; }
  __syncthreads();
  int c0 = qc - 8; c0 = c0 < 0 ? 0 : (c0 > 48 ? 48 : c0);
  for (int t = 0; t < T; ++t) {
    const bool more = t + 1 < T;
    asm volatile("s_waitcnt vmcnt(8)" ::: "memory");
    auto after_k = [&]() { if (more) dma_k(t + 1); };
    auto before_v = [&]() { if (more) asm volatile("s_waitcnt vmcnt(8)" ::: "memory"); else asm volatile("s_waitcnt vmcnt(0)" ::: "memory"); };
    auto after_v = [&]() { if (more) dma_v(t + 1); };
    if (t < nloc) {
      const int dy = rs + t - r + 7;
      const int c0l = c0;
      unsigned bta = (unsigned)(size_t)(btab + (head * 15 + dy) * 128 + 63 - qc + 4 * hi); asm volatile("" : "+v"(bta));
      LAS const float* bt = (LAS const float*)bta;
      attn_tile_dma(st, qf, Kt, Vt, F.lane, [&](f32x16& p0, f32x16& p1) {
        float bb[16];
#pragma unroll
        for (int rr = 0; rr < 16; ++rr) bb[rr] = bt[(rr & 3) + 8 * (rr >> 2)];
#pragma unroll
        for (int rr = 0; rr < 16; ++rr) p0[rr] = ((unsigned)((rr & 3) + 8 * (rr >> 2) + 4 * hi - c0l) < 16u) ? p0[rr] + bb[rr] : -INFINITY;
#pragma unroll
        for (int rr = 0; rr < 16; ++rr) bb[rr] = bt[(rr & 3) + 8 * (rr >> 2) + 32];
#pragma unroll
        for (int rr = 0; rr < 16; ++rr) p1[rr] = ((unsigned)((rr & 3) + 8 * (rr >> 2) + 32 + 4 * hi - c0l) < 16u) ? p1[rr] + bb[rr] : -INFINITY; }, after_k, before_v, after_v);
    } else attn_tile_dma(st, qf, Kt, Vt, F.lane, [](f32x16&, f32x16&) {}, after_k, before_v, after_v);
  }
  const float l = st.l + __shfl_xor(st.l, 32);
  int qr = (int)qrow; asm volatile("" : "+v"(qr));
  attn_store_g(st, 1.f / l, gv, Y + (size_t)qr * 1024 + 768 + head * 64, F.lane);
}
}

namespace mk {
struct Attn2 { float l[2]; f32x16 o[2][2]; };
template <class ProbF, class F1, class F2, class F3>
__device__ __forceinline__ void attn2_tile(Attn2& st, const bf16x8 (&qf)[2][4], LAS const unsigned char* Kt, LAS const unsigned char* Vt, int lane, ProbF&& probf, F1&& after_k, F2&& before_v, F3&& after_v) {
  const int r32 = lane & 31, hi = lane >> 5;
  const int ksw = (r32 >> 1) & 7;
  bf16x8 ka[4], kb[4];
#pragma unroll
  for (int s = 0; s < 4; ++s) { const int ch = ((2 * s + hi) ^ ksw) << 4; ka[s] = *(LAS const bf16x8*)(Kt + r32 * 128 + ch); kb[s] = *(LAS const bf16x8*)(Kt + (32 + r32) * 128 + ch); }
  asm volatile("s_waitcnt lgkmcnt(0)" ::: "memory");
  after_k();
  u32x4 pw[2][4];
#pragma unroll
  for (int qb = 0; qb < 2; ++qb) {
    f32x16 p0, p1;
    { const f32x16 z = {0.f, 0.f, 0.f, 0.f, 0.f, 0.f, 0.f, 0.f, 0.f, 0.f, 0.f, 0.f, 0.f, 0.f, 0.f, 0.f};
      p0 = __builtin_amdgcn_mfma_f32_32x32x16_bf16(ka[0], qf[qb][0], z, 0, 0, 0); p1 = __builtin_amdgcn_mfma_f32_32x32x16_bf16(kb[0], qf[qb][0], z, 0, 0, 0); }
#pragma unroll
    for (int s = 1; s < 4; ++s) { p0 = __builtin_amdgcn_mfma_f32_32x32x16_bf16(ka[s], qf[qb][s], p0, 0, 0, 0); p1 = __builtin_amdgcn_mfma_f32_32x32x16_bf16(kb[s], qf[qb][s], p1, 0, 0, 0); }
    probf(qb, p0, p1);
    float ps = 0.f;
#pragma unroll
    for (int i = 0; i < 16; ++i) ps += p0[i] + p1[i];
    st.l[qb] += ps;
#pragma unroll
    for (int k = 0; k < 2; ++k) {
      pw[qb][k] = (u32x4){pk2(p0[8 * k + 0], p0[8 * k + 1]), pk2(p0[8 * k + 2], p0[8 * k + 3]), pk2(p0[8 * k + 4], p0[8 * k + 5]), pk2(p0[8 * k + 6], p0[8 * k + 7])};
      pw[qb][2 + k] = (u32x4){pk2(p1[8 * k + 0], p1[8 * k + 1]), pk2(p1[8 * k + 2], p1[8 * k + 3]), pk2(p1[8 * k + 4], p1[8 * k + 5]), pk2(p1[8 * k + 6], p1[8 * k + 7])};
    }
  }
  before_v();
  const int q = (lane & 15) >> 2, p = lane & 3, gsel = (lane >> 4) & 1;
  const int vrow = (4 * hi + q) * 128 + 8 * (p & 1);
  const int chb = 2 * gsel + (p >> 1);
  s16x4 vl0[4], vh0[4], vl1[4], vh1[4];
#pragma unroll
  for (int ks = 0; ks < 4; ++ks) {
    const int c0_ = ((chb | ((0 ^ (q >> 1)) << 2)) << 4), c1_ = ((chb | ((1 ^ (q >> 1)) << 2)) << 4);
    vl0[ks] = vtr(Vt + ks * 2048 + vrow + c0_); vh0[ks] = vtr(Vt + ks * 2048 + 1024 + vrow + c0_); vl1[ks] = vtr(Vt + ks * 2048 + vrow + c1_); vh1[ks] = vtr(Vt + ks * 2048 + 1024 + vrow + c1_);
  }
  asm volatile("s_waitcnt lgkmcnt(0)" ::: "memory");
  after_v();
#pragma unroll
  for (int ks = 0; ks < 4; ++ks) {
    const bf16x8 va0 = (bf16x8){vl0[ks][0], vl0[ks][1], vl0[ks][2], vl0[ks][3], vh0[ks][0], vh0[ks][1], vh0[ks][2], vh0[ks][3]}, va1 = (bf16x8){vl1[ks][0], vl1[ks][1], vl1[ks][2], vl1[ks][3], vh1[ks][0], vh1[ks][1], vh1[ks][2], vh1[ks][3]};
#pragma unroll
    for (int qb = 0; qb < 2; ++qb) {
      st.o[qb][0] = __builtin_amdgcn_mfma_f32_32x32x16_bf16(va0, __builtin_bit_cast(bf16x8, pw[qb][ks]), st.o[qb][0], 0, 0, 0);
      st.o[qb][1] = __builtin_amdgcn_mfma_f32_32x32x16_bf16(va1, __builtin_bit_cast(bf16x8, pw[qb][ks]), st.o[qb][1], 0, 0, 0);
    }
  }
}
struct DmaLane { unsigned ok0, ok1, ov; };
__device__ __forceinline__ DmaLane dma_lane(int lane) {
  const int kk = lane >> 3, cs = lane & 7; DmaLane d;
  d.ok0 = kk * (PLW * 2) + ((cs ^ (kk >> 1)) << 4); d.ok1 = kk * (PLW * 2) + ((cs ^ (4 + (kk >> 1))) << 4); d.ov = kk * (PLW * 2) + ((cs ^ (((kk >> 1) & 1) << 2)) << 4); return d;
}
__device__ __forceinline__ void dma_tile_k(const bf16* krow0  , const DmaLane& d, unsigned kdst) {
  const unsigned char* tb = (const unsigned char*)krow0;
#pragma unroll
  for (int n = 0; n < 8; ++n) glds16(tb + (size_t)n * 8 * (PLW * 2), (n & 1) ? d.ok1 : d.ok0, kdst + n * 1024);
}
__device__ __forceinline__ void dma_tile_v(const bf16* vrow0, const DmaLane& d, unsigned vdst) {
  const unsigned char* tb = (const unsigned char*)vrow0;
#pragma unroll
  for (int n = 0; n < 8; ++n) glds16(tb + (size_t)n * 8 * (PLW * 2), d.ov, vdst + n * 1024);
}
__device__ __forceinline__ void attn2_exchange(const Attn2& st, int par, AttnState& fin, const Frame& F) {
  LAS float* X = (LAS float*)(F.lds + F.wave * 16384);
  LAS const float* XP = (LAS const float*)(F.lds + (F.wave ^ 1) * 16384);
  if (par == 0) {
#pragma unroll
    for (int i = 0; i < 16; ++i) { X[i * 64 + F.lane] = st.o[1][0][i]; X[(16 + i) * 64 + F.lane] = st.o[1][1][i]; }
    X[32 * 64 + F.lane] = st.l[1];
  } else {
#pragma unroll
    for (int i = 0; i < 16; ++i) { X[i * 64 + F.lane] = st.o[0][0][i]; X[(16 + i) * 64 + F.lane] = st.o[0][1][i]; }
    X[32 * 64 + F.lane] = st.l[0];
  }
  __syncthreads();
  if (par == 0) {
#pragma unroll
    for (int i = 0; i < 16; ++i) { fin.o0[i] = st.o[0][0][i] + XP[i * 64 + F.lane]; fin.o1[i] = st.o[0][1][i] + XP[(16 + i) * 64 + F.lane]; }
    fin.l = st.l[0] + XP[32 * 64 + F.lane];
  } else {
#pragma unroll
    for (int i = 0; i < 16; ++i) { fin.o0[i] = st.o[1][0][i] + XP[i * 64 + F.lane]; fin.o1[i] = st.o[1][1][i] + XP[(16 + i) * 64 + F.lane]; }
    fin.l = st.l[1] + XP[32 * 64 + F.lane];
  }
  fin.m = 0.f;
}
__device__ __forceinline__ void exp_all(f32x16& p0, f32x16& p1) {
#pragma unroll
  for (int i = 0; i < 16; ++i) { p0[i] = __builtin_amdgcn_exp2f(p0[i]); p1[i] = __builtin_amdgcn_exp2f(p1[i]); }
}

__device__ __forceinline__ void na_item2(const Frame& F0, const Args& a, int layer, int item) {
  const Frame F = relaunder(F0);
  unsigned char* ws = opq(a.ws);
  const bf16* PLB = (const bf16*)(ws + WS_PLB); bf16* Y = (bf16*)(ws + WS_H);
  const bool isctx = item >= 256;
  int b, r;
  if (!isctx) { b = item >> 6; r = item & 63; } else { const int ci = item - 256; b = ci >> 2; r = ci & 3; }
  const int head = F.wave >> 1, par = F.wave & 1, r32 = F.lane & 31, hi = F.lane >> 5;
  const size_t qrow0 = isctx ? (size_t)MLAT + b * CTX + 64 * r : (size_t)b * SEQ + 64 * r;
  bf16x8 qf[2][4];
#pragma unroll
  for (int qb = 0; qb < 2; ++qb)
#pragma unroll
    for (int s = 0; s < 4; ++s) qf[qb][s] = *(const bf16x8*)(PLB + (qrow0 + 32 * qb + r32) * PLW + S_DQ * 256 + head * 64 + 16 * s + 8 * hi);
  int rs = r - 4; rs = rs < 0 ? 0 : (rs > 56 ? 56 : rs);
  const int T = isctx ? 4 : 12;
  auto tile_row = [&](int t) -> size_t { return t < 4 ? (size_t)MLAT + b * CTX + 64 * t : (size_t)b * SEQ + 64 * (rs + t - 4); };
  const bf16* kcol = PLB + S_DK * 256 + head * 64; const bf16* vcol = PLB + S_DV * 256 + head * 64;
  LAS float* btab = (LAS float*)(F.lds + 2 * 65536);
  LAS unsigned char* Kt = F.lds + F.wave * 16384; LAS unsigned char* Vt = Kt + 8192;
  const unsigned kdst = (unsigned)(size_t)Kt, vdst = kdst + 8192u;
  const DmaLane dl = dma_lane(F.lane);
  Attn2 st; st.l[0] = 0.f; st.l[1] = 0.f;
#pragma unroll
  for (int i = 0; i < 16; ++i) { st.o[0][0][i] = 0.f; st.o[0][1][i] = 0.f; st.o[1][0][i] = 0.f; st.o[1][1][i] = 0.f; }
#pragma unroll
  for (int qb = 0; qb < 2; ++qb)
#pragma unroll
    for (int s = 0; s < 4; ++s) asm volatile("" : "+v"(qf[qb][s]));
  __syncthreads();
  dma_tile_k(kcol + tile_row(par) * PLW, dl, kdst); dma_tile_v(vcol + tile_row(par) * PLW, dl, vdst);
  {
    const float* rb = opq(a.in[18]) + (size_t)layer * 4 * 15 * 31; float t_[15];
#pragma unroll
    for (int i = 0; i < 15; ++i) { const int ix = F.tid + 512 * i, hd = ix >> 7, dx = (ix & 127) - 63; const int dc = dx < -15 ? -15 : (dx > 15 ? 15 : dx); t_[i] = rb[hd * 31 + dc + 15]; }
    __builtin_amdgcn_sched_barrier(0);
#pragma unroll
    for (int i = 0; i < 15; ++i) { const int dx = ((F.tid + 512 * i) & 127) - 63; btab[F.tid + 512 * i] = (dx >= -15 && dx <= 15) ? t_[i] * LOG2E : 0.f; } }
  __syncthreads();
  const int c00 = r32 < 8 ? 0 : r32 - 8, c01 = r32 > 24 ? 48 : 24 + r32;
  for (int t = par; t < T; t += 2) {
    const bool more = t + 2 < T;
    asm volatile("s_waitcnt vmcnt(8)" ::: "memory");
    auto after_k = [&]() { if (more) dma_tile_k(kcol + tile_row(t + 2) * PLW, dl, kdst); };
    auto before_v = [&]() { if (more) asm volatile("s_waitcnt vmcnt(8)" ::: "memory"); else asm volatile("s_waitcnt vmcnt(0)" ::: "memory"); };
    auto after_v = [&]() { if (more) dma_tile_v(vcol + tile_row(t + 2) * PLW, dl, vdst); };
    if (t >= 4) {
      const int dy = rs + (t - 4) - r + 7;
      unsigned bta = (unsigned)(size_t)(btab + (head * 15 + dy) * 128 + 63 - r32 + 4 * hi); asm volatile("" : "+v"(bta));
      LAS const float* bt = (LAS const float*)bta;
      attn2_tile(st, qf, Kt, Vt, F.lane, [&](int qb, f32x16& p0, f32x16& p1) {
        if (qb == 0) {
#pragma unroll
          for (int rr = 0; rr < 16; ++rr) { const int kc = (rr & 3) + 8 * (rr >> 2); p0[rr] = ((unsigned)(kc + 4 * hi - c00) < 16u) ? __builtin_amdgcn_exp2f(p0[rr] + bt[kc]) : 0.f; }
#pragma unroll
          for (int rr = 0; rr < 4; ++rr) p1[rr] = ((unsigned)(32 + rr + 4 * hi - c00) < 16u) ? __builtin_amdgcn_exp2f(p1[rr] + bt[32 + rr]) : 0.f;
#pragma unroll
          for (int rr = 4; rr < 16; ++rr) p1[rr] = 0.f;
        } else {
#pragma unroll
          for (int rr = 0; rr < 12; ++rr) p0[rr] = 0.f;
#pragma unroll
          for (int rr = 12; rr < 16; ++rr) p0[rr] = ((unsigned)(12 + rr + 4 * hi - c01) < 16u) ? __builtin_amdgcn_exp2f(p0[rr] + bt[12 + rr - 32]) : 0.f;
#pragma unroll
          for (int rr = 0; rr < 16; ++rr) { const int kc = 32 + (rr & 3) + 8 * (rr >> 2); p1[rr] = ((unsigned)(kc + 4 * hi - c01) < 16u) ? __builtin_amdgcn_exp2f(p1[rr] + bt[kc - 32]) : 0.f; }
        } }, after_k, before_v, after_v);
    } else attn2_tile(st, qf, Kt, Vt, F.lane, [](int, f32x16& p0, f32x16& p1) { exp_all(p0, p1); }, after_k, before_v, after_v);
  }
  AttnState fin;
  attn2_exchange(st, par, fin, F);
  const float l = fin.l + __shfl_xor(fin.l, 32);
  int qr = (int)qrow0 + 32 * par + r32; asm volatile("" : "+v"(qr));
  attn_store(fin, 1.f / l, PLB + (size_t)qr * PLW + S_DG * 256 + head * 64, Y + (size_t)qr * 1024 + 768 + head * 64, F.lane);
}

__device__ __forceinline__ void swa_item2(const Frame& F0, const Args& a, int layer, int item) {
  const Frame F = relaunder(F0);
  unsigned char* ws = opq(a.ws);
  const bf16* PLB = (const bf16*)(ws + WS_PLB); bf16* Y = (bf16*)(ws + WS_H);
  const bool isctx = item >= 256;
  int b, kvh, n;
  if (!isctx) { b = item >> 6; kvh = (item >> 5) & 1; n = item & 31; } else { const int ci = item - 256; b = ci >> 2; kvh = (ci >> 1) & 1; n = ci & 1; }
  const int quarter = F.wave >> 1, par = F.wave & 1, r32 = F.lane & 31, hi = F.lane >> 5;
  const int q0 = 128 * n + 32 * quarter, tq = q0 + r32;
  const size_t qrow = isctx ? (size_t)MLAT + b * CTX + tq : (size_t)b * SEQ + tq;
  bf16x8 qf[2][4];
#pragma unroll
  for (int g = 0; g < 2; ++g)
#pragma unroll
    for (int s = 0; s < 4; ++s) qf[g][s] = *(const bf16x8*)(PLB + qrow * PLW + S_CQ * 256 + (2 * kvh + g) * 64 + 16 * s + 8 * hi);
  unsigned need = 0x3C0u;
  if (!isctx) {
#pragma unroll
    for (int hk = 0; hk < 6; ++hk) { const int kb = 128 * (n - 1) + 64 * hk; if (kb >= 0 && kb < SEQ && !(kb + 63 < q0 - 128 || kb > q0 + 31 + 128)) need |= 1u << hk; }
  }
  need = (unsigned)__builtin_amdgcn_readfirstlane((int)need);
  if (par) need &= need - 1u;
  auto tile_row = [&](int hk) -> size_t { return hk < 6 ? (size_t)b * SEQ + 128 * (n - 1) + 64 * hk : (size_t)MLAT + b * CTX + 64 * (hk - 6); };
  const bf16* kcol = PLB + S_CKV * 256 + kvh * 64; const bf16* vcol = kcol + 128;
  LAS unsigned char* Kt = F.lds + F.wave * 16384; LAS unsigned char* Vt = Kt + 8192;
  const unsigned kdst = (unsigned)(size_t)Kt, vdst = kdst + 8192u;
  const DmaLane dl = dma_lane(F.lane);
  Attn2 st; st.l[0] = 0.f; st.l[1] = 0.f;
#pragma unroll
  for (int i = 0; i < 16; ++i) { st.o[0][0][i] = 0.f; st.o[0][1][i] = 0.f; st.o[1][0][i] = 0.f; st.o[1][1][i] = 0.f; }
#pragma unroll
  for (int g = 0; g < 2; ++g)
#pragma unroll
    for (int s = 0; s < 4; ++s) asm volatile("" : "+v"(qf[g][s]));
  __syncthreads();
  if (need) { const int t0 = __builtin_ctz(need); dma_tile_k(kcol + tile_row(t0) * PLW, dl, kdst); dma_tile_v(vcol + tile_row(t0) * PLW, dl, vdst); }
  while (need) {
    const int t = __builtin_ctz(need);
    need &= need - 1u; need &= need - 1u;
    const bool more = need != 0u;
    const int tn = more ? __builtin_ctz(need) : 0;
    asm volatile("s_waitcnt vmcnt(8)" ::: "memory");
    auto after_k = [&]() { if (more) dma_tile_k(kcol + tile_row(tn) * PLW, dl, kdst); };
    auto before_v = [&]() { if (more) asm volatile("s_waitcnt vmcnt(8)" ::: "memory"); else asm volatile("s_waitcnt vmcnt(0)" ::: "memory"); };
    auto after_v = [&]() { if (more) dma_tile_v(vcol + tile_row(tn) * PLW, dl, vdst); };
    const int kb = 128 * (n - 1) + 64 * t;
    if (t < 6 && !(kb >= q0 + 31 - 128 && kb + 63 <= q0 + 128)) {
      const int dq = kb - tq + 128;
      attn2_tile(st, qf, Kt, Vt, F.lane, [&](int, f32x16& p0, f32x16& p1) {
#pragma unroll
        for (int rr = 0; rr < 16; ++rr) { const int d0_ = dq + crow(rr, hi), d1_ = d0_ + 32;
          p0[rr] = ((unsigned)d0_ <= 256u) ? __builtin_amdgcn_exp2f(p0[rr]) : 0.f; p1[rr] = ((unsigned)d1_ <= 256u) ? __builtin_amdgcn_exp2f(p1[rr]) : 0.f; } }, after_k, before_v, after_v);
    } else attn2_tile(st, qf, Kt, Vt, F.lane, [](int, f32x16& p0, f32x16& p1) { exp_all(p0, p1); }, after_k, before_v, after_v);
  }
  AttnState fin;
  attn2_exchange(st, par, fin, F);
  const int hq = 2 * kvh + par;
  float l = fin.l + __shfl_xor(fin.l, 32);
  const float sk2 = opq(a.in[15])[layer * 4 + hq] * LOG2E;
  const float mnew = fmaxf(0.f, sk2), al = __builtin_amdgcn_exp2f(-mnew);
  l = l * al + __builtin_amdgcn_exp2f(sk2 - mnew);
  int qr = (int)qrow; asm volatile("" : "+v"(qr));
  attn_store(fin, al / l, PLB + (size_t)qr * PLW + S_CG * 256 + hq * 64, Y + (size_t)qr * 1024 + 512 + hq * 64, F.lane);
}
}

namespace mk {
constexpr int XT_STRIDE = 272;
constexpr int FFT_WC = 256 * XT_STRIDE;
__device__ __forceinline__ void fft_item(const Frame& F0, const Args& a, int item) {
  const Frame F = relaunder(F0);
  unsigned char* ws = opq(a.ws);
  const bf16* PLB = (const bf16*)(ws + WS_PLB); bf16* Y = (bf16*)(ws + WS_H);
  const int b = item >> 6, slice = item & 63, r32 = F.lane & 31, hi = F.lane >> 5, w = F.wave;
  LAS unsigned char* Xt = F.lds; LAS unsigned char* Wl = F.lds + FFT_WC;
  __syncthreads();
  u32x2 gv[8];
  {
    const bf16* WC = (const bf16*)(ws + WS_WC);
    u32x4 wt[4];
#pragma unroll
    for (int i = 0; i < 4; ++i) { const int idx = F.tid + 512 * i, row = idx >> 4, ch = idx & 15; wt[i] = *(const u32x4*)(WC + row * 128 + ch * 8); }
    const bf16* src = (const bf16*)(ws + WS_FA2) + ((size_t)b * 64 + slice) * TROW * 8;
#pragma unroll
    for (int i = 0; i < 8; ++i) gv[i] = *(const u32x2*)(PLB + ((size_t)b * SEQ + F.tid + 512 * i) * PLW + S_BG * 256 + 4 * slice);
    u32x4 v[8];
#pragma unroll
    for (int i = 0; i < 8; ++i) v[i] = *(const u32x4*)(src + (size_t)(F.lane + 64 * (8 * w + i)) * 8);
    __builtin_amdgcn_sched_barrier(0);
#pragma unroll
    for (int i = 0; i < 4; ++i) { const int idx = F.tid + 512 * i, row = idx >> 4, ch = idx & 15; *(LAS u32x4*)(Wl + row * XT_STRIDE + ch * 16) = wt[i]; }
#pragma unroll
    for (int cc = 0; cc < 4; ++cc)
#pragma unroll
      for (int part = 0; part < 2; ++part) { const int e = cc + 4 * part, d = e >> 1; const unsigned sel = (e & 1) ? 0x07060302u : 0x05040100u;
        u32x4 o;
        o.x = __builtin_amdgcn_perm(v[1][d], v[0][d], sel); o.y = __builtin_amdgcn_perm(v[3][d], v[2][d], sel);
        o.z = __builtin_amdgcn_perm(v[5][d], v[4][d], sel); o.w = __builtin_amdgcn_perm(v[7][d], v[6][d], sel);
        *(LAS u32x4*)(Xt + (64 * cc + F.lane) * XT_STRIDE + (part * 64 + 8 * w) * 2) = o; }
  }
  __syncthreads();
  f32x16 acc[4];
#pragma unroll
  for (int rb = 0; rb < 4; ++rb)
#pragma unroll
    for (int i = 0; i < 16; ++i) acc[rb][i] = 0.f;
  {
    bf16x8 bf[8];
#pragma unroll
    for (int s = 0; s < 8; ++s) bf[s] = *(LAS const bf16x8*)(Xt + (32 * w + r32) * XT_STRIDE + (16 * s + 8 * hi) * 2);
#pragma unroll
    for (int rb = 0; rb < 4; ++rb)
#pragma unroll
      for (int s = 0; s < 8; ++s) { const bf16x8 af = *(LAS const bf16x8*)(Wl + (32 * rb + r32) * XT_STRIDE + (16 * s + 8 * hi) * 2); acc[rb] = __builtin_amdgcn_mfma_f32_32x32x16_bf16(af, bf[s], acc[rb], 0, 0, 0); }
  }
  __syncthreads();
  {
    const int n2 = 32 * (w & 1) + r32, c = w >> 1;
#pragma unroll
    for (int rbp = 0; rbp < 2; ++rbp)
#pragma unroll
      for (int r = 0; r < 16; ++r) { const int k1 = 32 * rbp + crow(r, hi); float x = (float)((k1 * n2) & 4095) * (1.f / 4096.f);
        asm volatile("" : "+v"(x) :: "memory");
        const float tc = __builtin_amdgcn_cosf(x), ts = __builtin_amdgcn_sinf(x);
        const float yr = acc[rbp][r], yi = acc[rbp + 2][r];
        const float zr = yr * tc + yi * ts, zi = yi * tc - yr * ts;
        LAS unsigned char* zp = Xt + (k1 * 4 + c) * XT_STRIDE + n2 * 2;
        *(LAS unsigned short*)zp = (unsigned short)f2bf(zr); *(LAS unsigned short*)(zp + 128) = (unsigned short)f2bf(zi); }
  }
  __syncthreads();
  f32x16 o2[2];
#pragma unroll
  for (int rb = 0; rb < 2; ++rb)
#pragma unroll
    for (int i = 0; i < 16; ++i) o2[rb][i] = 0.f;
  {
    bf16x8 bf[8];
#pragma unroll
    for (int s = 0; s < 8; ++s) bf[s] = *(LAS const bf16x8*)(Xt + (32 * w + r32) * XT_STRIDE + (16 * s + 8 * hi) * 2);
#pragma unroll
    for (int rb = 0; rb < 2; ++rb)
#pragma unroll
      for (int s = 0; s < 8; ++s) { const bf16x8 af = *(LAS const bf16x8*)(Wl + (32 * rb + r32) * XT_STRIDE + (16 * s + 8 * hi) * 2); o2[rb] = __builtin_amdgcn_mfma_f32_32x32x16_bf16(af, bf[s], o2[rb], 0, 0, 0); }
  }
  __syncthreads();
  { const int k1 = 8 * w + (r32 >> 2), c = r32 & 3;
#pragma unroll
    for (int rb = 0; rb < 2; ++rb)
#pragma unroll
      for (int r = 0; r < 16; ++r) { const int k = k1 + 64 * (32 * rb + crow(r, hi)); *(LAS unsigned short*)(Xt + k * 8 + c * 2) = (unsigned short)f2bf(o2[rb][r]); }
  }
  __syncthreads();
  { const int o0 = 4 * slice;
#pragma unroll
    for (int i = 0; i < 8; ++i) { const int k = F.tid + 512 * i; const size_t row = (size_t)b * SEQ + k;
      const u32x2 ov = *(LAS const u32x2*)(Xt + k * 8);
      u32x2 y; y.x = pk2(__uint_as_float(ov.x << 16) * __uint_as_float(gv[i].x << 16), __uint_as_float(ov.x & 0xffff0000u) * __uint_as_float(gv[i].x & 0xffff0000u));
      y.y = pk2(__uint_as_float(ov.y << 16) * __uint_as_float(gv[i].y << 16), __uint_as_float(ov.y & 0xffff0000u) * __uint_as_float(gv[i].y & 0xffff0000u));
      *(u32x2*)(Y + row * 1024 + 256 + o0) = y; }
  }
}
constexpr int XC_STRIDE = 1040;
__device__ __forceinline__ void fftc_item(const Frame& F0, const Args& a, int item) {
  const Frame F = relaunder(F0);
  unsigned char* ws = opq(a.ws);
  const bf16* PLB = (const bf16*)(ws + WS_PLB); bf16* Y = (bf16*)(ws + WS_H);
  const bf16* CS = (const bf16*)(ws + WS_CS256);
  const int b = item >> 3, cs = item & 7, r32 = F.lane & 31, hi = F.lane >> 5, w = F.wave;
  LAS unsigned char* Xc = F.lds;
  __syncthreads();
  u32x4 vq[4];
#pragma unroll
  for (int i = 0; i < 4; ++i) { const int idx = F.tid + 512 * i, sl = idx >> 8, n = idx & 255;
    vq[i] = *(const u32x4*)((const bf16*)(ws + WS_FA2) + (((size_t)b * 64 + 8 * cs + sl) * TROW + SEQ + n) * 8); }
  __builtin_amdgcn_sched_barrier(0);
#pragma unroll
  for (int i = 0; i < 4; ++i) { const int idx = F.tid + 512 * i, sl = idx >> 8, n = idx & 255;
    const unsigned vv[4] = {vq[i].x, vq[i].y, vq[i].z, vq[i].w};
#pragma unroll
    for (int j = 0; j < 8; ++j) { const int c = j & 3, part = j >> 2; const unsigned short e = (unsigned short)((j & 1) ? (vv[j >> 1] >> 16) : (vv[j >> 1] & 0xffffu));
      *(LAS unsigned short*)(Xc + (4 * sl + c) * XC_STRIDE + (part * 256 + n) * 2) = e; } }
  __syncthreads();
  f32x16 acc;
#pragma unroll
  for (int i = 0; i < 16; ++i) acc[i] = 0.f;
#pragma unroll 1
  for (int s0 = 0; s0 < 32; s0 += 8) {
    bf16x8 af[8];
#pragma unroll
    for (int j = 0; j < 8; ++j) af[j] = *(const bf16x8*)(CS + (size_t)(32 * w + r32) * 512 + 16 * (s0 + j) + 8 * hi);
    __builtin_amdgcn_sched_barrier(0);
#pragma unroll
    for (int j = 0; j < 8; ++j) {
      const bf16x8 bf = *(LAS const bf16x8*)(Xc + r32 * XC_STRIDE + (16 * (s0 + j) + 8 * hi) * 2);
      acc = __builtin_amdgcn_mfma_f32_32x32x16_bf16(af[j], bf, acc, 0, 0, 0);
    }
  }
  const int o = 32 * cs + r32;
  bf16 gq[16];
#pragma unroll
  for (int r = 0; r < 16; ++r) { const size_t row = (size_t)MLAT + b * CTX + 32 * w + crow(r, hi); gq[r] = PLB[row * PLW + S_BG * 256 + o]; }
  __builtin_amdgcn_sched_barrier(0);
#pragma unroll
  for (int r = 0; r < 16; ++r) { const size_t row = (size_t)MLAT + b * CTX + 32 * w + crow(r, hi);
    Y[row * 1024 + 256 + o] = (bf16)f2bf(acc[r] * bf2f(gq[r])); }
}
}

namespace mk {
constexpr int GU_STRIDE = 2048 + 64;
constexpr size_t WS_GU = WS_SCR, WS_GS = WS_GU + (size_t)32 * 68 * GU_STRIDE * 4;
__device__ __forceinline__ size_t gla_row(int b, int c, int i) { return c < 64 ? (size_t)b * SEQ + 64 * c + i : (size_t)MLAT + b * CTX + 64 * (c - 64) + i; }
__device__ __forceinline__ int gla_pos(int c, int dir) { return c < 64 ? (dir ? 4 + 63 - c : 4 + c) : (dir ? 3 - (c - 64) : (c - 64)); }
__device__ __forceinline__ void gla_stage_v(const Frame& F, const bf16* PLB, int b, int c, LAS unsigned char* vbase) {
  const int key = F.tid >> 3, ch = F.tid & 7;
  const bf16* src = PLB + gla_row(b, c, key) * PLW + S_AV * 256 + ch * 8;
  const int vo = key * 128 + ((ch ^ (((key >> 1) & 1) << 2)) << 4);
  u32x4 t_[4];
#pragma unroll
  for (int h = 0; h < 4; ++h) t_[h] = *(const u32x4*)(src + h * 64);
#pragma unroll
  for (int h = 0; h < 4; ++h) *(LAS u32x4*)(vbase + h * 8192 + vo) = t_[h];
}
__device__ __forceinline__ void gla_cum(const float* LA, int b, int c, int h, int dir, int lane, float (&cw)[32], float& T) {
  const int d = lane & 31, half = lane >> 5;
  float a[32];
#pragma unroll
  for (int ii = 0; ii < 32; ++ii) a[ii] = LA[gla_row(b, c, 32 * half + ii) * 256 + dir * 128 + h * 32 + d];
  float run = 0.f;
#pragma unroll
  for (int ii = 0; ii < 32; ++ii) { run += a[ii]; cw[ii] = run; }
  const float other = __shfl_xor(run, 32);
  const float tot0 = half ? other : run;
  T = run + other;
#pragma unroll
  for (int ii = 0; ii < 32; ++ii) { const float cf = cw[ii] + (half ? tot0 : 0.f); cw[ii] = dir ? (T - cf + a[ii]) : cf; }
}
constexpr int KT_STRIDE = 144;
__device__ __forceinline__ void gla_local_item(const Frame& F0, const Args& a, int item) {
  const Frame F = relaunder(F0);
  unsigned char* ws = opq(a.ws);
  const bf16* PLB = (const bf16*)(ws + WS_PLB); const float* LA = (const float*)(ws + WS_LA);
  const int b = item / 68, c = item % 68, h = F.wave >> 1, dir = F.wave & 1, d = F.lane & 31, half = F.lane >> 5, r32 = d, hi = half;
  LAS unsigned char* Vt = F.lds + h * 8192; LAS unsigned char* KT = F.lds + 32768 + F.wave * (32 * KT_STRIDE);
  __syncthreads();
  gla_stage_v(F, PLB, b, c, F.lds);
  float cw[32], T;
  gla_cum(LA, b, c, h, dir, F.lane, cw, T);
  {
    unsigned pkd[16]; bf16 kr[32];
    const bf16* kp = PLB + gla_row(b, c, 32 * half) * PLW + S_AQK * 256 + 128 + h * 32 + d;
#pragma unroll
    for (int ii = 0; ii < 32; ++ii) kr[ii] = kp[(size_t)ii * PLW];
#pragma unroll
    for (int ii = 0; ii < 32; ii += 2) pkd[ii >> 1] = pk2(bf2f(kr[ii]) * __expf(T - cw[ii]), bf2f(kr[ii + 1]) * __expf(T - cw[ii + 1]));
#pragma unroll
    for (int q4 = 0; q4 < 4; ++q4) *(LAS u32x4*)(KT + d * KT_STRIDE + half * 64 + q4 * 16) = (u32x4){pkd[4 * q4], pkd[4 * q4 + 1], pkd[4 * q4 + 2], pkd[4 * q4 + 3]};
  }
  __syncthreads();
  f32x16 acc[2];
#pragma unroll
  for (int eb = 0; eb < 2; ++eb)
#pragma unroll
    for (int i = 0; i < 16; ++i) acc[eb][i] = 0.f;
  const int q = (F.lane & 15) >> 2, p = F.lane & 3, gsel = (F.lane >> 4) & 1;
  const int chb = 2 * gsel + (p >> 1);
#pragma unroll
  for (int st = 0; st < 4; ++st) {
    const bf16x8 kb = *(LAS const bf16x8*)(KT + r32 * KT_STRIDE + (16 * st + 8 * hi) * 2);
#pragma unroll
    for (int eb = 0; eb < 2; ++eb) {
      const int ch = ((chb | ((eb ^ (q >> 1)) << 2)) << 4);
      LAS const unsigned char* vp = Vt + (16 * st + 8 * hi + q) * 128 + 8 * (p & 1) + ch;
      const s16x4 lo = vtr(vp), hh = vtr(vp + 512);
      const bf16x8 va = (bf16x8){lo[0], lo[1], lo[2], lo[3], hh[0], hh[1], hh[2], hh[3]};
      acc[eb] = __builtin_amdgcn_mfma_f32_32x32x16_bf16(va, kb, acc[eb], 0, 0, 0);
    }
  }
  const int chain = (b * 4 + h) * 2 + dir, pos = gla_pos(c, dir);
  float* gu = (float*)(ws + WS_GU) + ((size_t)chain * 68 + pos) * GU_STRIDE;
#pragma unroll
  for (int eb = 0; eb < 2; ++eb)
#pragma unroll
    for (int r = 0; r < 16; ++r) gu[(32 * eb + crow(r, hi)) * 32 + r32] = acc[eb][r];
  if (half == 0) gu[2048 + d] = __expf(T);
}
__device__ __forceinline__ void gla_scan(const Frame& F0, const Args& a) {
  const Frame F = relaunder(F0);
  unsigned char* ws = opq(a.ws);
  if (F.tid >= 256) return;
  for (int gt = F.vcu * 256 + F.tid; gt < 32 * 2048; gt += F.G * 256) {
    const int chain = gt >> 11, el = gt & 2047, d = el & 31;
    const float* gu = (const float*)(ws + WS_GU) + (size_t)chain * 68 * GU_STRIDE;
    bf16* gs = (bf16*)(ws + WS_GS) + (size_t)chain * 68 * 2048 + el;
    float S = 0.f;
#pragma unroll 1
    for (int p0 = 0; p0 < 68; p0 += 34) {
      float dc[34], uu[34];
#pragma unroll
      for (int i = 0; i < 34; ++i) { dc[i] = gu[(size_t)(p0 + i) * GU_STRIDE + 2048 + d]; uu[i] = gu[(size_t)(p0 + i) * GU_STRIDE + el]; }
      __builtin_amdgcn_sched_barrier(0);
#pragma unroll
      for (int i = 0; i < 34; ++i) { gs[(size_t)(p0 + i) * 2048] = (bf16)f2bf(S); S = dc[i] * S + uu[i]; }
    }
  }
}
constexpr int QK_STRIDE = 80;
__device__ __forceinline__ void gla_out_item(const Frame& F0, const Args& a, int layer, int item) {
  const Frame F = relaunder(F0);
  unsigned char* ws = opq(a.ws);
  const bf16* PLB = (const bf16*)(ws + WS_PLB); const float* LA = (const float*)(ws + WS_LA); bf16* Y = (bf16*)(ws + WS_H);
  const int b = item / 68, c = item % 68, h = F.wave >> 1, dir = F.wave & 1, d = F.lane & 31, half = F.lane >> 5, r32 = d, hi = half;
  LAS unsigned char* Vt = F.lds + h * 8192;
  LAS unsigned char* QT = F.lds + 32768 + F.wave * (2 * 64 * QK_STRIDE); LAS unsigned char* KT = QT + 64 * QK_STRIDE;
  LAS float* X = (LAS float*)(F.lds + 32768) + h * 4096;
  __syncthreads();
  gla_stage_v(F, PLB, b, c, F.lds);
  {
    float cw[32], T;
    gla_cum(LA, b, c, h, dir, F.lane, cw, T);
    bf16 qr[32], kr[32];
    const bf16* pr = PLB + gla_row(b, c, 32 * half) * PLW + S_AQK * 256 + h * 32 + d;
#pragma unroll
    for (int ii = 0; ii < 32; ++ii) { qr[ii] = pr[(size_t)ii * PLW]; kr[ii] = pr[(size_t)ii * PLW + 128]; }
#pragma unroll
    for (int ii = 0; ii < 32; ++ii) { const int i = 32 * half + ii;
      const float ec = __expf(cw[ii]);
      *(LAS unsigned short*)(QT + i * QK_STRIDE + d * 2) = (unsigned short)f2bf(bf2f(qr[ii]) * ec);
      *(LAS unsigned short*)(KT + i * QK_STRIDE + d * 2) = (unsigned short)f2bf(bf2f(kr[ii]) * __builtin_amdgcn_rcpf(ec)); }
  }
  __syncthreads();
  f32x16 oacc[2][2];
#pragma unroll
  for (int eb = 0; eb < 2; ++eb)
#pragma unroll
    for (int ib = 0; ib < 2; ++ib)
#pragma unroll
      for (int i = 0; i < 16; ++i) oacc[eb][ib][i] = 0.f;
  bf16x8 qb[2][2];
#pragma unroll
  for (int ib = 0; ib < 2; ++ib)
#pragma unroll
    for (int st = 0; st < 2; ++st) qb[ib][st] = *(LAS const bf16x8*)(QT + (32 * ib + r32) * QK_STRIDE + (16 * st + 8 * hi) * 2);
  const int chain = (b * 4 + h) * 2 + dir, pos = gla_pos(c, dir);
  {
    const bf16* gs = (const bf16*)(ws + WS_GS) + ((size_t)chain * 68 + pos) * 2048;
#pragma unroll
    for (int eb = 0; eb < 2; ++eb)
#pragma unroll
      for (int st = 0; st < 2; ++st) { const bf16x8 sf = *(const bf16x8*)(gs + (32 * eb + r32) * 32 + 16 * st + 8 * hi);
#pragma unroll
        for (int ib = 0; ib < 2; ++ib) oacc[eb][ib] = __builtin_amdgcn_mfma_f32_32x32x16_bf16(sf, qb[ib][st], oacc[eb][ib], 0, 0, 0); }
  }
  const int q = (F.lane & 15) >> 2, p = F.lane & 3, gsel = (F.lane >> 4) & 1;
  const int vrow = (4 * hi + q) * 128 + 8 * (p & 1), chb = 2 * gsel + (p >> 1);
#pragma unroll
  for (int sb = 0; sb < 2; ++sb) {
    bf16x8 kf[2];
#pragma unroll
    for (int st = 0; st < 2; ++st) kf[st] = *(LAS const bf16x8*)(KT + (32 * sb + r32) * QK_STRIDE + (16 * st + 8 * hi) * 2);
#pragma unroll
    for (int ib = 0; ib < 2; ++ib) {
      const bool need = dir == 0 ? (sb <= ib) : (sb >= ib);
      if (!need) continue;
      f32x16 sc;
#pragma unroll
      for (int i = 0; i < 16; ++i) sc[i] = 0.f;
#pragma unroll
      for (int st = 0; st < 2; ++st) sc = __builtin_amdgcn_mfma_f32_32x32x16_bf16(kf[st], qb[ib][st], sc, 0, 0, 0);
      if (sb == ib) {
#pragma unroll
        for (int r = 0; r < 16; ++r) { const int s = crow(r, hi); const bool keep = dir == 0 ? (s <= r32) : (s >= r32); sc[r] = keep ? sc[r] : 0.f; }
      }
      u32x4 pw[2];
#pragma unroll
      for (int k = 0; k < 2; ++k) pw[k] = (u32x4){pk2(sc[8 * k + 0], sc[8 * k + 1]), pk2(sc[8 * k + 2], sc[8 * k + 3]), pk2(sc[8 * k + 4], sc[8 * k + 5]), pk2(sc[8 * k + 6], sc[8 * k + 7])};
#pragma unroll
      for (int ks = 0; ks < 2; ++ks)
#pragma unroll
        for (int eb = 0; eb < 2; ++eb) {
          const int ch = ((chb | ((eb ^ (q >> 1)) << 2)) << 4);
          const s16x4 lo = vtr(Vt + (2 * sb + ks) * 2048 + vrow + ch), hh = vtr(Vt + (2 * sb + ks) * 2048 + 1024 + vrow + ch);
          const bf16x8 va = (bf16x8){lo[0], lo[1], lo[2], lo[3], hh[0], hh[1], hh[2], hh[3]};
          oacc[eb][ib] = __builtin_amdgcn_mfma_f32_32x32x16_bf16(va, __builtin_bit_cast(bf16x8, pw[ks]), oacc[eb][ib], 0, 0, 0);
        }
    }
  }
  __syncthreads();
  if (dir == 1) {
#pragma unroll
    for (int eb = 0; eb < 2; ++eb)
#pragma unroll
      for (int ib = 0; ib < 2; ++ib)
#pragma unroll
        for (int r = 0; r < 16; ++r) X[((eb * 2 + ib) * 16 + r) * 64 + F.lane] = oacc[eb][ib][r];
  }
  __syncthreads();
  if (dir == 0) {
    const float* on = opq(a.in[11]) + layer * 64;
    f32x4 w4s[8];
#pragma unroll
    for (int i = 0; i < 8; ++i) w4s[i] = *(const f32x4*)(on + 32 * (i >> 2) + 8 * (i & 3) + 4 * hi);
#pragma unroll
    for (int ib = 0; ib < 2; ++ib) {
      float ss = 0.f;
#pragma unroll
      for (int eb = 0; eb < 2; ++eb)
#pragma unroll
        for (int r = 0; r < 16; ++r) { oacc[eb][ib][r] += X[((eb * 2 + ib) * 16 + r) * 64 + F.lane]; ss += oacc[eb][ib][r] * oacc[eb][ib][r]; }
      ss += __shfl_xor(ss, 32);
      const float rs = 1.0f / sqrtf(ss * (1.f / 64.f) + 1e-6f);
      const size_t row = gla_row(b, c, 32 * ib + r32);
      u32x2 gv8[8];
#pragma unroll
      for (int i = 0; i < 8; ++i) gv8[i] = *(const u32x2*)(PLB + row * PLW + S_AG * 256 + h * 64 + 32 * (i >> 2) + 8 * (i & 3) + 4 * hi);
      __builtin_amdgcn_sched_barrier(0);
#pragma unroll
      for (int eb = 0; eb < 2; ++eb)
#pragma unroll
        for (int gi = 0; gi < 4; ++gi) {
          const int e0 = 32 * eb + 8 * gi + 4 * hi;
          const f32x4 w4 = w4s[4 * eb + gi];
          const u32x2 gv = gv8[4 * eb + gi];
          const float g0 = __uint_as_float(gv.x << 16), g1 = __uint_as_float(gv.x & 0xffff0000u), g2 = __uint_as_float(gv.y << 16), g3 = __uint_as_float(gv.y & 0xffff0000u);
          u32x2 ov; ov.x = pk2(oacc[eb][ib][4 * gi + 0] * rs * w4[0] * g0, oacc[eb][ib][4 * gi + 1] * rs * w4[1] * g1);
          ov.y = pk2(oacc[eb][ib][4 * gi + 2] * rs * w4[2] * g2, oacc[eb][ib][4 * gi + 3] * rs * w4[3] * g3);
          *(u32x2*)(Y + row * 1024 + h * 64 + e0) = ov;
        }
    }
  }
}
}

namespace mk {
__device__ __forceinline__ void p3_mixers(const Frame& F0, const Args& a, int layer) {
  const Frame F = relaunder(F0);
  const int nx = layer == 0 ? 16 : 0, nswa = 256 + nx, nna = 256 + nx, nfc = layer == 0 ? 32 : 0;
  for (int it = F.vcu; it < 272 + 256 + nfc + nswa + nna; it += F.G) {
    int r = it;
    if (r < 272) { gla_local_item(F, a, r); continue; } r -= 272;
    if (r < 256) { fft_item(F, a, r); continue; } r -= 256;
    if (r < nfc) { fftc_item(F, a, r); continue; } r -= nfc;
    if (r < nswa) swa_item(F, a, layer, r); else na_item(F, a, layer, r - nswa);
  }
}
__device__ __forceinline__ void p4b_glaout(const Frame& F0, const Args& a, int layer) {
  const Frame F = relaunder(F0);
  if (layer == 1) { for (int it = F.vcu; it < 256; it += F.G) gla_out_item(F, a, layer, (it >> 6) * 68 + (it & 63)); }
  else for (int it = F.vcu; it < 272; it += F.G) gla_out_item(F, a, layer, it);
}
}
#define XB_TMO      128
#define XB_XCNT(j)  (256  + 64 * (j))
#define XB_XSUB(j)  (1280 + 64 * (j))
#define XB_XGEN(j)  (2304 + 64 * (j))
#define XB_TOP      3328
#define XB_TOPGEN   3392
#define XCD_BAR_WORDS 3456
#define XB_SPIN_CAP (1u << 18)

__device__ __forceinline__ unsigned xb_ld(unsigned* p)              { return __hip_atomic_load(p, __ATOMIC_RELAXED, __HIP_MEMORY_SCOPE_AGENT); }
__device__ __forceinline__ unsigned xb_add(unsigned* p, unsigned v) { return __hip_atomic_fetch_add(p, v, __ATOMIC_RELAXED, __HIP_MEMORY_SCOPE_AGENT); }
__device__ __forceinline__ unsigned xb_xcc_id() { return (unsigned)__builtin_amdgcn_s_getreg((3 << 11) | 20) & 0xFu; }
#define XB_SPIN(cond, bar) do { unsigned _sp = 0; while (cond) { __builtin_amdgcn_s_sleep(1); \
    if ((++_sp & 255u) == 0u) { if (xb_ld(&(bar)[XB_TMO])) break; if (_sp > XB_SPIN_CAP) { atomicAdd(&(bar)[XB_TMO], 1u); break; } } } } while (0)

struct XcdBarrier {
    unsigned* bar; unsigned x;
    volatile LAS unsigned* st;
};

__device__ __forceinline__ XcdBarrier xcd_barrier_post(unsigned* bar, volatile LAS unsigned* st) {
    XcdBarrier b; b.bar = bar; b.x = xb_xcc_id(); b.st = st;
    if (threadIdx.x == 0) (void)xb_add(&bar[XB_XCNT(b.x)], 1u);
    return b;
}
__device__ __forceinline__ void xcd_barrier_complete(unsigned* bar, unsigned x, unsigned& nloc, unsigned& nx) {
    const unsigned G = gridDim.x * gridDim.y * gridDim.z;
    unsigned sum, cnt, mine, sp = 0u;
    for (;;) {
        sum = 0u; cnt = 0u; mine = 0u;
#pragma unroll
        for (unsigned j = 0; j < 16; ++j) { const unsigned c = xb_ld(&bar[XB_XCNT(j)]); sum += c; cnt += (c > 0u) ? 1u : 0u; }
        mine = xb_ld(&bar[XB_XCNT(x)]);
        if (sum == G) break;
        __builtin_amdgcn_s_sleep(1);
        if ((++sp & 255u) == 0u) { if (xb_ld(&bar[XB_TMO])) break; if (sp > XB_SPIN_CAP) { atomicAdd(&bar[XB_TMO], 1u); break; } }
    }
    nloc = mine > 0u ? mine : 1u; nx = cnt > 0u ? cnt : 1u;
}

__device__ __forceinline__ void xcd_barrier(const XcdBarrier& b) {
    asm volatile("s_waitcnt vmcnt(0)" ::: "memory");
    __syncthreads();
    if (threadIdx.x == 0) {
        unsigned* bar = b.bar;
        __builtin_amdgcn_s_waitcnt(0);
        unsigned nloc = b.st[0], nx = b.st[1];
        if (nloc == 0u) { xcd_barrier_complete(bar, b.x, nloc, nx); b.st[0] = nloc; b.st[1] = nx; }
        const unsigned old = xb_add(&bar[XB_XSUB(b.x)], 1u);
        const unsigned gen = old / nloc;
        if (old + 1u == (gen + 1u) * nloc) {
            __builtin_amdgcn_fence(__ATOMIC_RELEASE, "agent");
            asm volatile("s_waitcnt vmcnt(0)" ::: "memory");
            const unsigned og = xb_add(&bar[XB_TOP], 1u);
            const unsigned tg = og / nx;
            if (og + 1u == (tg + 1u) * nx) xb_add(&bar[XB_TOPGEN], 1u);
            else XB_SPIN(xb_ld(&bar[XB_TOPGEN]) == tg, bar);
            __builtin_amdgcn_fence(__ATOMIC_ACQUIRE, "agent");
            xb_add(&bar[XB_XGEN(b.x)], 1u);
            asm volatile("s_waitcnt vmcnt(0)" ::: "memory");
        } else {
            XB_SPIN(xb_ld(&bar[XB_XGEN(b.x)]) == gen, bar);
            __builtin_amdgcn_fence(__ATOMIC_ACQUIRE, "agent");
            asm volatile("s_waitcnt vmcnt(0)" ::: "memory");
        }
    }
    __syncthreads();
}

constexpr int LDS_BYTES = 163840, MISC_OFF = LDS_BYTES - 256;
constexpr int CW_BAR = 4096;
__global__ void __launch_bounds__(512, 2) mega(mk::Args a) {
  extern __shared__ __attribute__((aligned(16))) unsigned char lds[];
  mk::Frame F;
  F.lds = (LAS unsigned char*)lds;
  F.tid = threadIdx.x; F.lane = F.tid & 63; F.wave = __builtin_amdgcn_readfirstlane(F.tid >> 6);
  F.G = gridDim.x; { const int bx = blockIdx.x; F.vcu = (F.G % 8 == 0) ? (bx % 8) * (F.G / 8) + bx / 8 : bx; }
  volatile LAS unsigned* MISC = (volatile LAS unsigned*)(F.lds + MISC_OFF);
  if (F.tid < 64) MISC[F.tid] = 0u;
  __syncthreads();
  XcdBarrier bar; bar.bar = nullptr; bar.x = 0; bar.st = nullptr;
  const bool multi = (a.ph_hi - a.ph_lo) > 1;
  if (multi) bar = xcd_barrier_post((unsigned*)(a.ws + mk::WS_CTL) + CW_BAR, MISC + 8);
#pragma clang loop unroll(disable)
  for (int ph = a.ph_lo; ph < a.ph_hi; ++ph) {
    if (ph == 0) mk::p0_prologue(F, a);
    else {
      const int layer = (ph - 1) / 6, sub = (ph - 1) % 6;
      if (sub == 0) mk::p1_prenorm(F, a, layer);
      else if (sub == 1) mk::p2_inproj(F, a, layer);
      else if (sub == 2) mk::p3_mixers(F, a, layer);
      else if (sub == 3) mk::gla_scan(F, a);
      else if (sub == 4) mk::p4b_glaout(F, a, layer);
      else mk::p5_outproj(F, a, layer);
    }
    if (ph + 1 < a.ph_hi) xcd_barrier(bar);
  }
}

extern "C" void kernel_launch(void* const* d_in, const int* in_sizes, int n_in, void* d_out, int out_size, void* d_ws, size_t ws_size, hipStream_t stream) {
  using namespace mk;
  static int grid = 0;
  if (grid == 0) {
    int dev = 0, cus = 0, per_cu = 0; (void)hipGetDevice(&dev); (void)hipDeviceGetAttribute(&cus, hipDeviceAttributeMultiprocessorCount, dev);
    (void)hipFuncSetAttribute((const void*)mega, hipFuncAttributeMaxDynamicSharedMemorySize, LDS_BYTES);
    if (hipOccupancyMaxActiveBlocksPerMultiprocessor(&per_cu, (const void*)mega, 512, LDS_BYTES) != hipSuccess || per_cu < 1) per_cu = 1;
    (void)hipGetLastError();
    grid = (cus > 0 ? cus : 256) * (per_cu < 1 ? 1 : 1);
  }
  (void)hipMemsetAsync((char*)d_ws + WS_CTL, 0, CTL_BYTES, stream);
  Args a{};
  for (int i = 0; i < 19; ++i) a.in[i] = (const float*)d_in[i];
  a.out = (float*)d_out; a.ws = (unsigned char*)d_ws;
  a.ph_lo = 0; a.ph_hi = 13;
  void* args[] = {&a};
  if (hipLaunchCooperativeKernel((const void*)mega, dim3(grid), dim3(512), args, LDS_BYTES, stream) != hipSuccess) {
    (void)hipGetLastError();
    hipLaunchKernelGGL(mega, dim3(grid), dim3(512), LDS_BYTES, stream, a);
  }
}
```

```cpp
#include <hip/hip_runtime.h>
#include <math.h>
#include <stdint.h>

namespace pg8 {
#define PG8_LAS __attribute__((address_space(3)))
typedef unsigned short bf16_t;
typedef short bf16x8 __attribute__((ext_vector_type(8)));
typedef float f32x4 __attribute__((ext_vector_type(4)));
typedef unsigned u32x4 __attribute__((ext_vector_type(4)));
constexpr int BM = 256, BK = 64, HALF = 128, HTB = HALF * BK * 2  , STAGE_BYTES = 8 * HTB, NXCD = 8, WGM = 8;

__host__ __device__ __forceinline__ int lds_byte(int r, int c) { const int st = (r >> 4) * 2 + (c >> 5), rr = r & 15, cc = c & 31, ob = rr * 64 + cc * 2; return st * 1024 + (ob ^ (((ob >> 9) & 1) << 5)); }
__host__ __device__ __forceinline__ void stage_rc(int b, int& R, int& C) { const int st = b / 1024, sb = b % 1024, swz = sb ^ (((sb >> 9) & 1) << 5); R = (st >> 1) * 16 + swz / 64; C = (st & 1) * 32 + (swz % 64) / 2; }
__host__ __device__ __forceinline__ int perm32(int rho) { const int n = rho >> 4, i = rho & 15; return 8 * (i >> 2) + 4 * n + (i & 3); }

struct Unit { int pm, pn; };
struct Gemm { const bf16_t* A; const bf16_t* Bt; int M, N, K; };

struct StaticOrder {
    int nM, nN, nwg, G, c;
    __host__ __device__ void init(int M, int N, int G_, int c_) { nM = M / BM; nN = N / BM; nwg = nM * nN; G = G_; c = c_; }
    __host__ __device__ bool next(int i, Unit& u) const {
        const long L = (long)i * G + c; if (L >= nwg) return false;
        int wgid = (int)L; { const int q = nwg / NXCD, r = nwg % NXCD, xcd = wgid % NXCD, off = wgid / NXCD; wgid = (xcd < r ? xcd * (q + 1) : r * (q + 1) + (xcd - r) * q) + off; }
        const int nig = WGM * nN, gid = wgid / nig, fm = gid * WGM, gsz = (nM - fm) < WGM ? (nM - fm) : WGM;
        u.pm = fm + ((wgid % nig) % gsz); u.pn = (wgid % nig) / gsz; return true;
    }
    __device__ __forceinline__ void a_ready(const Unit&) const {}
    __device__ __forceinline__ void done(const Unit&) const {}
};

template <class Epi, class Sched, bool STAMP = false>
__device__ __forceinline__ void gemm_phase(PG8_LAS unsigned char* lds, const Gemm g, const Sched& S, const Epi& E, unsigned long long* stamps) {
    int tid_ = threadIdx.x; asm volatile("" : "+v"(tid_));
    const int tid = tid_, wid = __builtin_amdgcn_readfirstlane(tid >> 6), lane = tid & 63, wr = wid >> 2, wc = wid & 3, fr = lane & 15, fq = lane >> 4;
    const int K = g.K, nt = K / BK;
    int ts_lo = 0, ts_hi = 0, nts = 0; const unsigned long long rt_entry = STAMP ? (unsigned long long)wall_clock64() : 0ull;
#define PG8_STAMP() do { if (STAMP && wid == 0 && nts < 64) { const unsigned long long _c = (unsigned long long)clock64(); \
        ts_lo = (lane == nts) ? (int)(unsigned)_c : ts_lo; ts_hi = (lane == nts) ? (int)(unsigned)(_c >> 32) : ts_hi; ++nts; } } while (0)
    PG8_STAMP();
    unsigned voffA[2], voffB[2];
#pragma unroll
    for (int i = 0; i < 2; ++i) { int R, C; stage_rc(tid * 16 + i * 8192, R, C); const int Rb = Epi::PERM ? ((R & ~31) + perm32(R & 31)) : R;
        voffA[i] = (unsigned)(R * K + C) * 2u; voffB[i] = (unsigned)(Rb * K + C) * 2u; }
    const size_t kstep = (size_t)(BK * 2);
    const size_t hstep = (size_t)HALF * K * 2;
    const size_t tstep = 2 * hstep;
    const unsigned ldsw = (unsigned)wid * 1024u;
    const int aoff = lds_byte(wr * 64 + fr, fq * 8), boff = lds_byte(wc * 32 + fr, fq * 8);
#define PG8_SA(b, h) (((b) * 2 + (h)) * HTB)
#define PG8_SB(b, h) ((4 + (b) * 2 + (h)) * HTB)
#define PG8_STAGE(bufoff, gbase, voff) do { _Pragma("unroll") for (int _i = 0; _i < 2; ++_i) \
        __builtin_amdgcn_global_load_lds((const unsigned*)((const char*)(gbase) + (voff)[_i]), (PG8_LAS unsigned*)(lds + (bufoff) + ldsw + _i * 8192), 16, 0, 0); } while (0)
#define PG8_LDA(dst, b, h) do { _Pragma("unroll") for (int m = 0; m < 4; ++m) _Pragma("unroll") for (int k = 0; k < 2; ++k) dst[m][k] = *(const PG8_LAS bf16x8*)(lds + PG8_SA(b, h) + aoff + m * 2048 + k * 1024); } while (0)
#define PG8_LDB(dst, b, h) do { _Pragma("unroll") for (int n = 0; n < 2; ++n) _Pragma("unroll") for (int k = 0; k < 2; ++k) dst[n][k] = *(const PG8_LAS bf16x8*)(lds + PG8_SB(b, h) + boff + n * 2048 + k * 1024); } while (0)
#define PG8_MMA(ai, bj, At, Bt) do { __builtin_amdgcn_s_setprio(1); _Pragma("unroll") for (int m = 0; m < 4; ++m) _Pragma("unroll") for (int n = 0; n < 2; ++n) _Pragma("unroll") for (int k = 0; k < 2; ++k) \
        acc[ai][bj][m][n] = __builtin_amdgcn_mfma_f32_16x16x32_bf16(Bt[n][k], At[m][k], acc[ai][bj][m][n], 0, 0, 0); __builtin_amdgcn_s_setprio(0); } while (0)
#define PG8_WAIT_V(n) asm volatile("s_waitcnt vmcnt(" #n ")" ::: "memory")
#define PG8_WAIT_L(n) asm volatile("s_waitcnt lgkmcnt(" #n ")" ::: "memory")
#define PG8_BAR __builtin_amdgcn_s_barrier()
#define PG8_SCHED __builtin_amdgcn_sched_barrier(0)
    Unit cur, nxt; int ui = 0;
    if (!S.next(0, cur)) return;
    f32x4 acc[2][2][4][2];
#pragma unroll
    for (int a = 0; a < 2; ++a)
#pragma unroll
        for (int b = 0; b < 2; ++b)
#pragma unroll
            for (int m = 0; m < 4; ++m)
#pragma unroll
                for (int n = 0; n < 2; ++n) acc[a][b][m][n] = (f32x4){0.f, 0.f, 0.f, 0.f};
    bf16x8 At[4][2], B0[2][2], B1[2][2];
    const char* cA = (const char*)g.A + (size_t)cur.pm * tstep; const char* cB = (const char*)g.Bt + (size_t)cur.pn * tstep;
    S.a_ready(cur);
    PG8_STAGE(PG8_SB(0, 0), cB, voffB); PG8_STAGE(PG8_SA(0, 0), cA, voffA); PG8_STAGE(PG8_SB(0, 1), cB + hstep, voffB); PG8_STAGE(PG8_SA(0, 1), cA + hstep, voffA);
    if (wr == 1) PG8_BAR;
    PG8_WAIT_V(4); PG8_BAR;
    PG8_STAGE(PG8_SB(1, 0), cB + kstep, voffB); PG8_STAGE(PG8_SA(1, 0), cA + kstep, voffA); PG8_STAGE(PG8_SB(1, 1), cB + hstep + kstep, voffB);
    PG8_WAIT_V(6); PG8_BAR;
    PG8_STAMP();
    for (;;) {
        const bool has_next = S.next(ui + 1, nxt);
        const char* nA = has_next ? (const char*)g.A + (size_t)nxt.pm * tstep : cA; const char* nB = has_next ? (const char*)g.Bt + (size_t)nxt.pn * tstep : cB;
        for (int t = 0; t < nt; t += 2) {
            const bool last = (t == nt - 2);
            const char* a1 = cA + (size_t)(t + 1) * kstep;
            const char* a2 = last ? nA : cA + (size_t)(t + 2) * kstep; const char* b2 = last ? nB : cB + (size_t)(t + 2) * kstep;
            const char* a3 = a2 + kstep; const char* b3 = b2 + kstep;
            if (last && has_next) S.a_ready(nxt);
            PG8_LDB(B0, 0, 0); PG8_SCHED; PG8_LDA(At, 0, 0); PG8_STAGE(PG8_SA(1, 1), a1 + hstep, voffA);
            PG8_WAIT_L(8); PG8_BAR; PG8_WAIT_L(0); PG8_MMA(0, 0, At, B0); PG8_BAR; PG8_SCHED;
            PG8_LDB(B1, 0, 1); PG8_STAGE(PG8_SB(0, 0), b2, voffB);
            PG8_BAR; PG8_WAIT_L(0); PG8_MMA(0, 1, At, B1); PG8_BAR;
            PG8_LDA(At, 0, 1); PG8_STAGE(PG8_SA(0, 0), a2, voffA);
            PG8_BAR; PG8_WAIT_L(0); PG8_MMA(1, 0, At, B0); PG8_BAR; PG8_SCHED;
            PG8_STAGE(PG8_SB(0, 1), b2 + hstep, voffB);
            PG8_WAIT_V(6); PG8_BAR; PG8_MMA(1, 1, At, B1); PG8_BAR;
            PG8_LDB(B0, 1, 0); PG8_SCHED; PG8_LDA(At, 1, 0); PG8_STAGE(PG8_SA(0, 1), a2 + hstep, voffA);
            PG8_WAIT_L(8); PG8_BAR; PG8_WAIT_L(0); PG8_MMA(0, 0, At, B0); PG8_BAR; PG8_SCHED;
            PG8_LDB(B1, 1, 1); PG8_STAGE(PG8_SB(1, 0), b3, voffB);
            PG8_BAR; PG8_WAIT_L(0); PG8_MMA(0, 1, At, B1); PG8_BAR;
            PG8_LDA(At, 1, 1); PG8_STAGE(PG8_SA(1, 0), a3, voffA);
            PG8_BAR; PG8_WAIT_L(0); PG8_MMA(1, 0, At, B0); PG8_BAR; PG8_SCHED;
            PG8_STAGE(PG8_SB(1, 1), b3 + hstep, voffB);
            PG8_WAIT_V(6); PG8_BAR; PG8_MMA(1, 1, At, B1); PG8_BAR;
        }
        PG8_STAMP();
        if constexpr (!Epi::AFTER_DRAIN) { E(acc, cur, wr, wc, fr, fq); S.done(cur); }
        PG8_STAMP();
        if (!has_next) break;
#pragma unroll
        for (int a = 0; a < 2; ++a)
#pragma unroll
            for (int b = 0; b < 2; ++b)
#pragma unroll
                for (int m = 0; m < 4; ++m)
#pragma unroll
                    for (int n = 0; n < 2; ++n) acc[a][b][m][n] = (f32x4){0.f, 0.f, 0.f, 0.f};
        cur = nxt; cA = nA; cB = nB; ++ui;
    }
    PG8_WAIT_V(0);
    if (wr == 0) PG8_BAR;
    PG8_BAR;
    if constexpr (Epi::AFTER_DRAIN) { E.fused(acc, cur, wr, wc, fr, fq, lds, wid, lane); S.done(cur); }
    PG8_STAMP();
    if (STAMP && wid == 0) { stamps[lane] = lane < nts ? (((unsigned long long)(unsigned)ts_hi << 32) | (unsigned)ts_lo) : 0ull;
        if (lane == 62) stamps[62] = rt_entry; if (lane == 63) stamps[63] = (unsigned long long)wall_clock64(); }
#undef PG8_STAMP
#undef PG8_SA
#undef PG8_SB
#undef PG8_STAGE
#undef PG8_LDA
#undef PG8_LDB
#undef PG8_MMA
#undef PG8_WAIT_V
#undef PG8_WAIT_L
#undef PG8_BAR
#undef PG8_SCHED
}
}

namespace mk {
#define LAS __attribute__((address_space(3)))
typedef unsigned short bf16;
typedef float f32x4 __attribute__((ext_vector_type(4)));
typedef float f32x16 __attribute__((ext_vector_type(16)));
typedef unsigned u32x4 __attribute__((ext_vector_type(4)));
typedef unsigned u32x2 __attribute__((ext_vector_type(2)));
typedef short bf16x8 __attribute__((ext_vector_type(8)));
typedef short s16x4 __attribute__((ext_vector_type(4)));

constexpr int D = 1024, NB = 4, SEQ = 4096, CTX = 256, PWW = 3360;
constexpr int MLAT = NB * SEQ, MT = MLAT + NB * CTX;
constexpr int NT1 = 14, N1 = NT1 * 256;
constexpr int NSLOT = 11, PLW = NSLOT * 256;
constexpr int TROW = SEQ + CTX;
constexpr int O_AQ = 0, O_AK = 128, O_AV = 256, O_AG = 512, O_LR = 768, O_BV = 800, O_BG = 1056, O_CQ = 1312, O_CK = 1568, O_CV = 1696,
              O_CG = 1824, O_DQ = 2080, O_DK = 2336, O_DV = 2592, O_DG = 2848;
constexpr int S_AQK = 0, S_AV = 1, S_AG = 2, S_BG = 3, S_CQ = 4, S_CKV = 5, S_CG = 6, S_DQ = 7, S_DK = 8, S_DV = 9, S_DG = 10;
constexpr float LOG2E = 1.4426950408889634f, QSCALE = 0.125f * LOG2E, GLA_QS = 0.17677669529663687f;

constexpr size_t WS_CTL = 0, CTL_BYTES = 65536;
constexpr size_t WS_MOD = WS_CTL + CTL_BYTES;
constexpr size_t WS_ROPE = WS_MOD + 2 * 5 * 3072 * 4;
constexpr size_t WS_WC = WS_ROPE + 2 * 64 * 16 * 4;
constexpr size_t WS_CS256 = WS_WC + 128 * 128 * 2;
constexpr size_t WS_W1T = 1u << 20;
constexpr size_t WS_W2T = WS_W1T + (size_t)2 * N1 * D * 2;
constexpr size_t WS_H = WS_W2T + (size_t)2 * D * D * 2;
constexpr size_t WS_PLB = WS_H + (size_t)MT * D * 2;
constexpr size_t WS_LA = WS_PLB + (size_t)MT * PLW * 2;
constexpr size_t WS_FA2 = WS_LA + (size_t)MT * 256 * 4;
constexpr size_t WS_CTX1 = WS_FA2 + (size_t)NB * 64 * TROW * 8 * 2;
constexpr size_t WS_SCR = WS_CTX1 + (size_t)NB * CTX * D * 4;
static_assert(WS_CS256 + 256 * 512 * 2 <= WS_W1T, "tables");

__device__ __forceinline__ float bf2f(bf16 v) { return __uint_as_float(((unsigned)v) << 16); }
__device__ __forceinline__ unsigned f2bf(float f) { unsigned u = __float_as_uint(f); return (u + 0x7fffu + ((u >> 16) & 1u)) >> 16; }
typedef float f32x2_t __attribute__((ext_vector_type(2))); typedef __bf16 bf16x2_t __attribute__((ext_vector_type(2)));
__device__ __forceinline__ unsigned pk2(float lo, float hi) { const f32x2_t v = {lo, hi}; const bf16x2_t b = __builtin_convertvector(v, bf16x2_t); return __builtin_bit_cast(unsigned, b); }
__device__ __forceinline__ float wave_sum(float v) {
#pragma unroll
  for (int o = 1; o < 64; o <<= 1) v += __shfl_xor(v, o);
  return v;
}
__device__ __forceinline__ float fsilu(float x) { return x * __builtin_amdgcn_rcpf(1.f + __expf(-x)); }
__device__ __forceinline__ float flogsig(float x) { return fminf(x, 0.f) - __logf(1.f + __expf(-fabsf(x))); }

#define GAS __attribute__((address_space(1)))
template <class T> __device__ __forceinline__ T* opq(T* p) { GAS T* g = (GAS T*)p; asm volatile("" : "+s"(g)); return (T*)g; }
__device__ __forceinline__ int crow(int r, int hi) { return (r & 3) + 8 * (r >> 2) + 4 * hi; }
struct Args {
  const float* in[19]; float* out; unsigned char* ws; int ph_lo, ph_hi;
};
struct Frame {
  int tid, lane, wave, vcu, G;
  LAS unsigned char* lds;
};
__device__ __forceinline__ Frame relaunder(const Frame& F0) {
  Frame F = F0; F.tid = threadIdx.x; asm volatile("" : "+v"(F.tid)); F.lane = F.tid & 63; asm volatile("" : "+s"(F.wave), "+s"(F.vcu), "+s"(F.G)); return F; }
}

namespace mk {
__device__ __forceinline__ void p0_ada_item(const Frame& F, const Args& a, int item) {
  LAS float* s = (LAS float*)F.lds; LAS float* red = s + 5 * 1024;
  const float* c = opq(a.in[1]); const float* cc = opq(a.in[3]);
  for (int i = F.tid; i < 5 * 1024; i += 512) { const int r = i >> 10, k = i & 1023; const float v = r < 4 ? c[r * 1024 + k] : cc[k]; s[i] = v / (1.f + expf(-v)); }
  __syncthreads();
  const int kp = F.tid / 24, cl = F.tid % 24;
  const int gcol = item * 24 + cl, l = gcol / 3072, col = gcol % 3072;
  if (kp < 21) {
    const float* w = opq(a.in[5]) + (size_t)l * 1024 * 3072 + col;
    float acc[5] = {0.f, 0.f, 0.f, 0.f, 0.f};
#pragma unroll 1
    for (int kb = 0; kb < 2; ++kb) {
      float wv[25];
#pragma unroll
      for (int j = 0; j < 25; ++j) { const int k = kp + 21 * (25 * kb + j); wv[j] = w[(size_t)(k < 1024 ? k : 1023) * 3072]; }
      __builtin_amdgcn_sched_barrier(0);
#pragma unroll
      for (int j = 0; j < 25; ++j) { const int k = kp + 21 * (25 * kb + j); const int kc = k < 1024 ? k : 1023; const float wz = k < 1024 ? wv[j] : 0.f;
#pragma unroll
        for (int r = 0; r < 5; ++r) acc[r] += s[r * 1024 + kc] * wz; }
    }
#pragma unroll
    for (int r = 0; r < 5; ++r) red[(kp * 24 + cl) * 5 + r] = acc[r];
  }
  __syncthreads();
  if (F.tid < 120) {
    const int cl2 = F.tid / 5, r = F.tid % 5; float t = 0.f;
    for (int q = 0; q < 21; ++q) t += red[(q * 24 + cl2) * 5 + r];
    const int g2 = item * 24 + cl2, l2 = g2 / 3072, col2 = g2 % 3072;
    float* MOD = (float*)(opq(a.ws) + WS_MOD);
    MOD[((size_t)l2 * 5 + r) * 3072 + col2] = t + opq(a.in[6])[l2 * 3072 + col2];
  }
  __syncthreads();
}
__device__ __forceinline__ int rope_perm(int n) { return 16 * ((n >> 2) & 1) + 4 * (n >> 3) + (n & 3); }
__device__ __forceinline__ void p0_tr_item(const float* W, int ldw, int cbase, int permkind, float scale, bf16* dst, int k0, LAS float* scr, int lane) {
  { float t_[32];
#pragma unroll
    for (int i = 0; i < 32; ++i) t_[i] = W[(size_t)(k0 + 2 * i + (lane >> 5)) * ldw + cbase + (lane & 31)];
#pragma unroll
    for (int i = 0; i < 32; ++i) scr[(2 * i + (lane >> 5)) * 33 + (lane & 31)] = t_[i]; }
  asm volatile("s_waitcnt lgkmcnt(0)" ::: "memory");
  const int c = lane & 7;
#pragma unroll
  for (int j = 0; j < 4; ++j) { const int n = (lane >> 3) + 8 * j; const int sidx = permkind ? rope_perm(n) : n; const LAS float* sp = scr + (8 * c) * 33 + sidx;
    u32x4 o; o.x = pk2(sp[0 * 33] * scale, sp[1 * 33] * scale); o.y = pk2(sp[2 * 33] * scale, sp[3 * 33] * scale); o.z = pk2(sp[4 * 33] * scale, sp[5 * 33] * scale); o.w = pk2(sp[6 * 33] * scale, sp[7 * 33] * scale);
    *(u32x4*)(dst + (size_t)n * 1024 + k0 + 8 * c) = o; }
  asm volatile("s_waitcnt lgkmcnt(0)" ::: "memory");
}
__device__ __forceinline__ void p0_la_item(const float* Win, const float* decw  , int dir, int j0, bf16* dst, int k0, LAS float* scr, int lane) {
  float dw[16];
#pragma unroll
  for (int r = 0; r < 16; ++r) dw[r] = decw[(dir * 16 + r) * 128 + j0 + (lane & 31)];
#pragma unroll 4
  for (int i = 0; i < 32; ++i) { const int kk = 2 * i + (lane >> 5); const float* wp = Win + (size_t)(k0 + kk) * PWW + O_LR + dir * 16; float acc = 0.f;
#pragma unroll
    for (int r = 0; r < 16; ++r) acc += wp[r] * dw[r];
    scr[kk * 33 + (lane & 31)] = acc; }
  asm volatile("s_waitcnt lgkmcnt(0)" ::: "memory");
  const int c = lane & 7;
#pragma unroll
  for (int j = 0; j < 4; ++j) { const int n = (lane >> 3) + 8 * j; const LAS float* sp = scr + (8 * c) * 33 + n;
    u32x4 o; o.x = pk2(sp[0 * 33], sp[1 * 33]); o.y = pk2(sp[2 * 33], sp[3 * 33]); o.z = pk2(sp[4 * 33], sp[5 * 33]); o.w = pk2(sp[6 * 33], sp[7 * 33]);
    *(u32x4*)(dst + (size_t)n * 1024 + k0 + 8 * c) = o; }
  asm volatile("s_waitcnt lgkmcnt(0)" ::: "memory");
}
constexpr int FA_AST = 528, FA_WST = 528;
__device__ __forceinline__ void p0_fa_item(const Frame& F, const Args& a, int item, int kb0, int kb1) {
  const int l = item >> 4, pn = 4 + ((item >> 3) & 1), g32 = item & 7, bj = g32 >> 2, wc = g32 & 3;
  LAS float* cs = (LAS float*)F.lds; LAS float* sn = cs + 64; LAS float* wfl = sn + 64;
  LAS unsigned char* Ai = F.lds + 512 + 16384;
  LAS unsigned char* Wi = F.lds + F.wave * (32 * FA_WST);
  __syncthreads();
  if (F.tid < 64) { float s_, c_; sincospif(2.f * F.tid / 64.f, &s_, &c_); cs[F.tid] = c_; sn[F.tid] = s_; }
  const float* wf = opq(a.in[12]) + (size_t)l * 256 * 256;
  const int slice0 = 32 * (pn - 4) + 16 * bj + 4 * wc;
  for (int i = F.tid; i < 1024; i += 512) { const int r = i >> 2, q = i & 3; *(LAS f32x4*)(wfl + r * 16 + 4 * q) = *(const f32x4*)(wf + (size_t)r * 256 + 4 * slice0 + 4 * q); }
  __syncthreads();
  {
    const int c = F.tid & 255, part = F.tid >> 8, g = c >> 6, jj = c & 63;
    f32x4 acc[4];
#pragma unroll
    for (int q = 0; q < 4; ++q) acc[q] = (f32x4){0.f, 0.f, 0.f, 0.f};
#pragma unroll 4
    for (int m = 0; m < 64; ++m) { const int idx = (m * jj) & 63; const float t = part ? -sn[idx] : cs[idx];
#pragma unroll
      for (int q = 0; q < 4; ++q) acc[q] += t * *(LAS const f32x4*)(wfl + (g * 64 + m) * 16 + 4 * q); }
#pragma unroll
    for (int fq = 0; fq < 4; ++fq)
#pragma unroll
      for (int j = 0; j < 4; ++j) *(LAS unsigned short*)(Ai + (8 * fq + 4 * part + j) * FA_AST + c * 2) = (unsigned short)f2bf(acc[fq][j] * 0.125f);
  }
  __syncthreads();
  const int r32 = F.lane & 31, hi = F.lane >> 5;
  bf16x8 af[16];
#pragma unroll
  for (int s = 0; s < 16; ++s) af[s] = *(LAS const bf16x8*)(Ai + r32 * FA_AST + (16 * s + 8 * hi) * 2);
  __syncthreads();
  const float* Win = opq(a.in[7]) + (size_t)l * 1024 * PWW + O_BV;
  bf16* dst = (bf16*)(opq(a.ws) + WS_W1T) + ((size_t)l * N1 + pn * 256 + 32 * g32) * 1024;
  for (int kb = kb0; kb < kb1; ++kb) {
    const int k0 = F.wave * 128 + kb * 32;
#pragma unroll
    for (int rh = 0; rh < 2; ++rh) { f32x4 w[16];
#pragma unroll
      for (int r = 0; r < 16; ++r) w[r] = *(const f32x4*)(Win + (size_t)(k0 + 16 * rh + r) * PWW + 4 * F.lane);
#pragma unroll
      for (int r = 0; r < 16; ++r) *(LAS u32x2*)(Wi + (16 * rh + r) * FA_WST + 8 * F.lane) = (u32x2){pk2(w[r].x, w[r].y), pk2(w[r].z, w[r].w)}; }
    asm volatile("s_waitcnt lgkmcnt(0)" ::: "memory");
    f32x16 acc;
#pragma unroll
    for (int i = 0; i < 16; ++i) acc[i] = 0.f;
#pragma unroll
    for (int s = 0; s < 16; ++s) { const bf16x8 bfr = *(LAS const bf16x8*)(Wi + r32 * FA_WST + (16 * s + 8 * hi) * 2); acc = __builtin_amdgcn_mfma_f32_32x32x16_bf16(af[s], bfr, acc, 0, 0, 0); }
#pragma unroll
    for (int r = 0; r < 16; ++r) dst[(size_t)crow(r, hi) * 1024 + k0 + r32] = (bf16)f2bf(acc[r]);
    asm volatile("s_waitcnt lgkmcnt(0)" ::: "memory");
  }
  __syncthreads();
}
__device__ __forceinline__ void p0_prologue(const Frame& F0, const Args& a) {
 {
  const Frame F = relaunder(F0);
  unsigned char* ws = opq(a.ws);
  { const int gt = F.vcu * 512 + F.tid, GT = F.G * 512;
    float* rope = (float*)(ws + WS_ROPE);
    for (int i = gt; i < 1024; i += GT) { const int pos = i >> 4, f = i & 15; const float ang = (float)pos * powf(10000.f, -(float)f / 16.f); rope[i] = cosf(ang); rope[1024 + i] = sinf(ang); }
    bf16* wc = (bf16*)(ws + WS_WC);
    for (int i = gt; i < 128 * 128; i += GT) { const int r = i >> 7, c = i & 127, rr = r & 63, cc = c & 63; float s_, c_; sincospif(2.f * (float)((rr * cc) & 63) / 64.f, &s_, &c_);
      float v; if (r < 64) v = c < 64 ? c_ : s_; else v = c < 64 ? -s_ : c_; wc[i] = (bf16)f2bf(v * 0.125f); }
    bf16* cs256 = (bf16*)(ws + WS_CS256);
    for (int i = gt; i < 256 * 512; i += GT) { const int k = i >> 9, n = i & 511, nn = n & 255; float s_, c_; sincospif(2.f * (float)((k * nn) & 255) / 256.f, &s_, &c_); cs256[i] = (bf16)f2bf((n < 256 ? c_ : s_) * 0.0625f); }
  }
  const bool split = F.G == 256;
  if (split) { p0_ada_item(F, a, F.vcu); if (F.vcu < 128) p0_fa_item(F, a, F.vcu >> 2, F.vcu & 3, (F.vcu & 3) + 1); }
  else for (int it = F.vcu; it < 256 + 32; it += F.G) { if (it < 256) p0_ada_item(F, a, it); else p0_fa_item(F, a, it - 256, 0, 4); }
  LAS float* scr = (LAS float*)(F.lds + F.wave * 16384);
  constexpr int I_DIR = 11 * 8 * 16, I_LA = 8 * 16, I_W2 = 32 * 16, I_L = I_DIR + I_LA + I_W2;
  static_assert(2 * I_L == 4096, "wave-level item count");
  int it0, its, itn;
  if (split) { if (F.vcu < 128) { it0 = F.vcu * 8 + F.wave; its = 0; itn = 1; } else { it0 = 1024 + (F.vcu - 128) * 8 + F.wave; its = 1024; itn = 3; } }
  else { it0 = F.vcu * 8 + F.wave; its = F.G * 8; itn = (2 * I_L - it0 + its - 1) / its; if (it0 >= 2 * I_L) itn = 0; }
  for (int ii = 0; ii < itn; ++ii) { const int it = it0 + ii * its;
    const int l = it / I_L; int r = it % I_L;
    const float* Win = opq(a.in[7]) + (size_t)l * 1024 * PWW;
    bf16* W1T = (bf16*)(ws + WS_W1T) + (size_t)l * N1 * 1024;
    if (r < I_DIR) {
      const int ti = r / 128, g32 = (r >> 4) & 7, kb = r & 15;
      const int pn = ti < 3 ? ti : ti + 3;
      const int bj = g32 >> 2, wc = g32 & 3, mcb = 64 * wc + 32 * bj;
      int cbase = 0, pk = 0; float sc = 1.f;
      switch (pn) {
        case 0: if (mcb < 128) { cbase = O_AQ + mcb; sc = GLA_QS; } else cbase = O_AK + mcb - 128; break;
        case 1: cbase = O_AV + mcb; break;
        case 2: cbase = O_AG + mcb; break;
        case 6: cbase = O_BG + mcb; break;
        case 7: cbase = O_CQ + mcb; pk = 1; break;
        case 8: if (wc < 2) { cbase = O_CK + mcb; pk = 1; } else cbase = O_CV + mcb - 128; break;
        case 9: cbase = O_CG + mcb; break;
        case 10: cbase = O_DQ + mcb; break;
        case 11: cbase = O_DK + mcb; break;
        case 12: cbase = O_DV + mcb; break;
        default: cbase = O_DG + mcb; break;
      }
      p0_tr_item(Win, PWW, cbase, pk, sc, W1T + (size_t)(pn * 256 + 32 * g32) * 1024, kb * 64, scr, F.lane);
    } else if (r < I_DIR + I_LA) {
      r -= I_DIR; const int g32 = r >> 4, kb = r & 15, bj = g32 >> 2, wc = g32 & 3, mcb = 64 * wc + 32 * bj;
      p0_la_item(Win, opq(a.in[9]) + (size_t)l * 2 * 16 * 128, mcb >> 7, mcb & 127, W1T + (size_t)(3 * 256 + 32 * g32) * 1024, kb * 64, scr, F.lane);
    } else {
      r -= I_DIR + I_LA; const int g = r >> 4, kb = r & 15;
      p0_tr_item(opq(a.in[8]) + (size_t)l * 1024 * 1024, 1024, 32 * g, 0, 1.f, (bf16*)(ws + WS_W2T) + ((size_t)l * 1024 + 32 * g) * 1024, kb * 64, scr, F.lane);
    }
  }
 }
}
__device__ __forceinline__ void p1_prenorm(const Frame& F0, const Args& a, int layer) {
  const Frame F = relaunder(F0);
  const float* xin = layer == 0 ? opq(a.in[0]) : opq(a.out);
  const float* cin = layer == 0 ? opq(a.in[2]) : (const float*)(opq(a.ws) + WS_CTX1);
  const float* nw = opq(a.in[4]) + layer * 1024;
  const float* MOD = (const float*)(opq(a.ws) + WS_MOD) + (size_t)layer * 5 * 3072;
  bf16* H = (bf16*)(opq(a.ws) + WS_H);
  const int gw = F.vcu * 8 + F.wave, NGW = F.G * 8;
  constexpr int RB = 3;
  f32x4 w_[4];
#pragma unroll
  for (int j = 0; j < 4; ++j) w_[j] = *(const f32x4*)(nw + 4 * F.lane + 256 * j);
  for (int row0 = gw; row0 < MT; row0 += RB * NGW) {
    f32x4 v[RB][4], sc_[RB][4], sh_[RB][4]; float ss[RB];
#pragma unroll
    for (int q = 0; q < RB; ++q) { int row = row0 + q * NGW; row = row < MT ? row : MT - 1;
      const float* src; const float* mod;
      if (row < MLAT) { src = xin + (size_t)row * 1024; mod = MOD + (size_t)(row >> 12) * 3072; }
      else { src = cin + (size_t)(row - MLAT) * 1024; mod = MOD + (size_t)4 * 3072; }
      const f32x4* xr = (const f32x4*)src + F.lane;
#pragma unroll
      for (int j = 0; j < 4; ++j) { v[q][j] = xr[64 * j]; sc_[q][j] = *(const f32x4*)(mod + 1024 + 4 * F.lane + 256 * j); sh_[q][j] = *(const f32x4*)(mod + 4 * F.lane + 256 * j); } }
    __builtin_amdgcn_sched_barrier(0);
#pragma unroll
    for (int q = 0; q < RB; ++q) { float s_ = 0.f;
#pragma unroll
      for (int j = 0; j < 4; ++j) s_ += (v[q][j].x * v[q][j].x + v[q][j].y * v[q][j].y) + (v[q][j].z * v[q][j].z + v[q][j].w * v[q][j].w);
      ss[q] = s_; }
#pragma unroll
    for (int o = 1; o < 64; o <<= 1)
#pragma unroll
      for (int q = 0; q < RB; ++q) ss[q] += __shfl_xor(ss[q], o);
#pragma unroll
    for (int q = 0; q < RB; ++q) { const int row = row0 + q * NGW; if (row >= MT) continue;
      const float rs = 1.0f / sqrtf(ss[q] * (1.f / 1024.f) + 1e-6f);
      unsigned long long* o8 = (unsigned long long*)(H + (size_t)row * 1024) + F.lane;
#pragma unroll
      for (int j = 0; j < 4; ++j) {
        const f32x4 h = v[q][j] * rs * w_[j] * (1.f + sc_[q][j]) + sh_[q][j];
        o8[64 * j] = (unsigned long long)pk2(h.x, h.y) | ((unsigned long long)pk2(h.z, h.w) << 32);
      } }
  }
}
}

namespace mk {
using pg8::Unit;
struct EpiIn {
  static constexpr bool PERM = true, AFTER_DRAIN = false;
  bf16* PLB; float* LA; bf16* FA2; LAS const float* rope;
  __device__ __forceinline__ void operator()(const f32x4 (&acc)[2][2][4][2], const Unit& u, int wr, int wc, int fr, int fq) const {
    const int pn = u.pn;
    const bool ctxrows = u.pm >= 64;
    int kind, slot = 0; LAS const float* nw = rope; bool roped = false; float qs = 1.f;
    LAS const float* cqn = rope + 2048; LAS const float* ckn = rope + 2112; LAS const float* dqn = rope + 2176; LAS const float* dkn = rope + 2240; LAS const float* decb = rope + 2304;
    switch (pn) {
      case 0: kind = 0; slot = S_AQK; break;
      case 1: kind = 0; slot = S_AV; break;
      case 2: kind = 1; slot = S_AG; break;
      case 3: kind = 2; break;
      case 4: case 5: kind = 3; break;
      case 6: kind = 1; slot = S_BG; break;
      case 7: kind = 4; slot = S_CQ; nw = cqn; roped = true; qs = QSCALE; break;
      case 8: slot = S_CKV; if (wc < 2) { kind = 4; nw = ckn; roped = true; } else kind = 0; break;
      case 9: kind = 1; slot = S_CG; break;
      case 10: kind = 4; slot = S_DQ; nw = dqn; qs = QSCALE; break;
      case 11: kind = 4; slot = S_DK; nw = dkn; break;
      case 12: kind = 0; slot = S_DV; break;
      default: kind = 1; slot = S_DG; break;
    }
    const int row0 = u.pm * 256 + wr * 64 + fr;
    float w8[2][8];
    if (kind == 4) {
#pragma unroll
      for (int bj = 0; bj < 2; ++bj)
#pragma unroll
        for (int s = 0; s < 8; ++s) { const int d = roped ? (32 * bj + 16 * (s >> 2) + 4 * fq + (s & 3)) : (32 * bj + 8 * fq + s); w8[bj][s] = nw[d] * qs; }
    } else if (kind == 2) {
#pragma unroll
      for (int bj = 0; bj < 2; ++bj)
#pragma unroll
        for (int s = 0; s < 8; ++s) w8[bj][s] = decb[64 * wc + 32 * bj + 8 * fq + s];
    }
#pragma unroll
    for (int ai = 0; ai < 2; ++ai) {
      float rsr[4];
      if (kind == 4) {
#pragma unroll
        for (int m = 0; m < 4; ++m) { float s_ = 0.f;
#pragma unroll
          for (int bj = 0; bj < 2; ++bj)
#pragma unroll
            for (int n = 0; n < 2; ++n) { const f32x4 t = acc[ai][bj][m][n]; s_ += (t.x * t.x + t.y * t.y) + (t.z * t.z + t.w * t.w); }
          rsr[m] = s_; }
#pragma unroll
        for (int o = 16; o < 64; o <<= 1)
#pragma unroll
          for (int m = 0; m < 4; ++m) rsr[m] += __shfl_xor(rsr[m], o);
#pragma unroll
        for (int m = 0; m < 4; ++m) rsr[m] = __builtin_amdgcn_rsqf(rsr[m] * (1.f / 64.f) + 1e-6f);
      }
#pragma unroll
      for (int m = 0; m < 4; ++m) {
        const int r = row0 + ai * 128 + m * 16;
        float v[2][8];
#pragma unroll
        for (int bj = 0; bj < 2; ++bj)
#pragma unroll
          for (int n = 0; n < 2; ++n)
#pragma unroll
            for (int e = 0; e < 4; ++e) v[bj][4 * n + e] = acc[ai][bj][m][n][e];
        if (kind == 2) {
#pragma unroll
          for (int bj = 0; bj < 2; ++bj) { const int mc = 64 * wc + 32 * bj + 8 * fq; float* dp = LA + (size_t)r * 256 + mc;
            f32x4 o0, o1;
#pragma unroll
            for (int e = 0; e < 4; ++e) { o0[e] = flogsig(v[bj][e] + w8[bj][e]) * 0.0625f; o1[e] = flogsig(v[bj][4 + e] + w8[bj][4 + e]) * 0.0625f; }
            *(f32x4*)dp = o0; *(f32x4*)(dp + 4) = o1; }
        } else if (kind == 3) {
          int b, t; if (!ctxrows) { b = r >> 12; t = r & 4095; } else { const int rc = r - MLAT; b = rc >> 8; t = SEQ + (rc & 255); }
#pragma unroll
          for (int bj = 0; bj < 2; ++bj) { const int slice = 32 * (pn - 4) + 16 * bj + 4 * wc + fq;
            u32x4 o; o.x = pk2(v[bj][0], v[bj][1]); o.y = pk2(v[bj][2], v[bj][3]); o.z = pk2(v[bj][4], v[bj][5]); o.w = pk2(v[bj][6], v[bj][7]);
            *(u32x4*)(FA2 + (((size_t)b * 64 + slice) * TROW + t) * 8) = o; }
        } else {
          if (kind == 1) {
#pragma unroll
            for (int bj = 0; bj < 2; ++bj)
#pragma unroll
              for (int s = 0; s < 8; ++s) v[bj][s] = fsilu(v[bj][s]);
          } else if (kind == 4) {
            const float rs = rsr[m];
#pragma unroll
            for (int bj = 0; bj < 2; ++bj)
#pragma unroll
              for (int s = 0; s < 8; ++s) v[bj][s] *= rs * w8[bj][s];
            if (roped && !ctxrows) {
              const int t = r & 4095;
#pragma unroll
              for (int bj = 0; bj < 2; ++bj) { const int pos = bj == 0 ? (t >> 6) : (t & 63);
                const f32x4 c4 = *(LAS const f32x4*)(rope + pos * 16 + 4 * fq), s4 = *(LAS const f32x4*)(rope + 1024 + pos * 16 + 4 * fq);
#pragma unroll
                for (int e = 0; e < 4; ++e) { const float x1 = v[bj][e], x2 = v[bj][4 + e]; v[bj][e] = x1 * c4[e] - x2 * s4[e]; v[bj][4 + e] = x2 * c4[e] + x1 * s4[e]; } }
            }
          }
#pragma unroll
          for (int bj = 0; bj < 2; ++bj) { const int mc = 64 * wc + 32 * bj + 8 * fq;
            u32x4 o; o.x = pk2(v[bj][0], v[bj][1]); o.y = pk2(v[bj][2], v[bj][3]); o.z = pk2(v[bj][4], v[bj][5]); o.w = pk2(v[bj][6], v[bj][7]);
            *(u32x4*)(PLB + (size_t)r * PLW + slot * 256 + mc) = o; }
        }
        asm volatile("" ::: "memory");
      }
    }
  }
};
struct EpiOut {
  static constexpr bool PERM = true, AFTER_DRAIN = false;
  const float* xin; const float* cin; float* xout; float* cout; const float* MODl;
  __device__ __forceinline__ void operator()(const f32x4 (&acc)[2][2][4][2], const Unit& u, int wr, int wc, int fr_, int fq_) const {
    int fr = fr_, fq = fq_; asm volatile("" : "+v"(fr), "+v"(fq));
    const int row0 = u.pm * 256 + wr * 64 + fr, col0 = u.pn * 256 + wc * 32 + 8 * fq;
    const bool ctxrows = u.pm >= 64;
    const float* gate = MODl + (size_t)(ctxrows ? 4 : (u.pm >> 4)) * 3072 + 2048;
    f32x4 gv[2][2];
#pragma unroll
    for (int bj = 0; bj < 2; ++bj)
#pragma unroll
      for (int n = 0; n < 2; ++n) gv[bj][n] = *(const f32x4*)(gate + col0 + bj * 128 + n * 4);
    const float* sp0; float* dp0;
    if (!ctxrows) { sp0 = xin + (size_t)row0 * 1024 + col0; dp0 = xout + (size_t)row0 * 1024 + col0; }
    else { sp0 = cin + (size_t)(row0 - MLAT) * 1024 + col0; dp0 = cout + (size_t)(row0 - MLAT) * 1024 + col0; }
#pragma unroll
    for (int ai = 0; ai < 2; ++ai) {
      f32x4 xv[4][2][2];
#pragma unroll
      for (int m = 0; m < 4; ++m)
#pragma unroll
        for (int bj = 0; bj < 2; ++bj)
#pragma unroll
          for (int n = 0; n < 2; ++n) xv[m][bj][n] = *(const f32x4*)(sp0 + (size_t)(ai * 128 + m * 16) * 1024 + bj * 128 + n * 4);
      __builtin_amdgcn_sched_barrier(0);
#pragma unroll
      for (int m = 0; m < 4; ++m)
#pragma unroll
        for (int bj = 0; bj < 2; ++bj)
#pragma unroll
          for (int n = 0; n < 2; ++n) *(f32x4*)(dp0 + (size_t)(ai * 128 + m * 16) * 1024 + bj * 128 + n * 4) = xv[m][bj][n] + gv[bj][n] * acc[ai][bj][m][n];
      asm volatile("" ::: "memory");
    }
  }
};
struct InOrder {
  pg8::StaticOrder S;
  static constexpr unsigned long long PACK = 0x3c817d9b0a5246ull;
  __device__ __forceinline__ bool next(int i, Unit& u) const { const bool ok = S.next(i, u); if (ok) u.pn = (int)((PACK >> (4 * u.pn)) & 15ull); return ok; }
  __device__ __forceinline__ void a_ready(const Unit&) const {}
  __device__ __forceinline__ void done(const Unit&) const {}
};
__device__ __forceinline__ void p2_inproj(const Frame& F, const Args& a, int layer) {
  unsigned char* ws = opq(a.ws);
  pg8::Gemm g{(const pg8::bf16_t*)(ws + WS_H), (const pg8::bf16_t*)(ws + WS_W1T) + (size_t)layer * N1 * 1024, MT, N1, 1024};
  InOrder S; S.S.init(MT, N1, F.G, (int)blockIdx.x);
  LAS float* ropeL = (LAS float*)(F.lds + pg8::STAGE_BYTES);
  { int tid = threadIdx.x; asm volatile("" : "+v"(tid)); const f32x4 t = *(const f32x4*)((const float*)(ws + WS_ROPE) + 4 * tid); *(LAS f32x4*)(ropeL + 4 * tid) = t;
    if (tid < 128) {
      const float* n0 = opq(a.in[13]); const float* n1 = opq(a.in[14]); const float* n2 = opq(a.in[16]); const float* n3 = opq(a.in[17]); const float* db = opq(a.in[10]);
      const int k = tid >> 4; const float* src = tid < 64 ? (k == 0 ? n0 : k == 1 ? n1 : k == 2 ? n2 : n3) + layer * 64 + 4 * (tid & 15) : db + layer * 256 + 4 * (tid - 64);
      *(LAS f32x4*)(ropeL + 2048 + 4 * tid) = *(const f32x4*)src; } }
  __syncthreads();
  EpiIn E{(bf16*)(ws + WS_PLB), (float*)(ws + WS_LA), (bf16*)(ws + WS_FA2), ropeL};
  { Unit u_; if (!S.next(3, u_)) { for (int i = 0; i < 3; ++i) __builtin_amdgcn_s_sleep(127); } }
  pg8::gemm_phase<EpiIn, InOrder>(F.lds, g, S, E, nullptr);
}

constexpr int CO_ST = 528;
constexpr int CO_OP = 64 * CO_ST, CO_BUF = 2 * CO_OP;
__device__ __forceinline__ void ctx_out_item(const Frame& F, const Args& a, int item) {
  unsigned char* ws = opq(a.ws);
  const bf16* Yc = (const bf16*)(ws + WS_H) + (size_t)MLAT * 1024; const bf16* W2 = (const bf16*)(ws + WS_W2T);
  const int tm = item >> 4, tn = item & 15, sub = F.wave & 3, kh = F.wave >> 2, r32 = F.lane & 31, hi = F.lane >> 5;
  const int row0 = 64 * tm + 32 * (sub >> 1), col0 = 64 * tn + 32 * (sub & 1);
  const int srow = F.tid >> 5, sc16 = F.tid & 31;
  const bf16* ag = Yc + (size_t)(64 * tm + srow) * 1024 + sc16 * 8; const bf16* bg = W2 + (size_t)(64 * tn + srow) * 1024 + sc16 * 8;
  LAS unsigned char* sdst = F.lds + srow * CO_ST + sc16 * 16;
  f32x16 acc;
#pragma unroll
  for (int i = 0; i < 16; ++i) acc[i] = 0.f;
  LAS const unsigned char* afp = F.lds + (32 * (sub >> 1) + r32) * CO_ST + (128 * kh + 8 * hi) * 2;
  LAS const unsigned char* bfp = F.lds + CO_OP + (32 * (sub & 1) + r32) * CO_ST + (128 * kh + 8 * hi) * 2;
  u32x4 st[2][2][4];
#pragma unroll
  for (int cp = 0; cp < 2; ++cp)
#pragma unroll
    for (int p = 0; p < 4; ++p) { st[cp][0][p] = *(const u32x4*)(ag + (size_t)(16 * p) * 1024 + cp * 256); st[cp][1][p] = *(const u32x4*)(bg + (size_t)(16 * p) * 1024 + cp * 256); }
  __syncthreads();
#pragma unroll 1
  for (int pair = 0; pair < 2; ++pair) {
#pragma unroll
    for (int cp = 0; cp < 2; ++cp)
#pragma unroll
      for (int p = 0; p < 4; ++p) { *(LAS u32x4*)(sdst + cp * CO_BUF + (16 * p) * CO_ST) = st[cp][0][p]; *(LAS u32x4*)(sdst + cp * CO_BUF + CO_OP + (16 * p) * CO_ST) = st[cp][1][p]; }
    __syncthreads();
    if (pair == 0) {
#pragma unroll
      for (int cp = 0; cp < 2; ++cp)
#pragma unroll
        for (int p = 0; p < 4; ++p) { st[cp][0][p] = *(const u32x4*)(ag + (size_t)(16 * p) * 1024 + (2 + cp) * 256); st[cp][1][p] = *(const u32x4*)(bg + (size_t)(16 * p) * 1024 + (2 + cp) * 256); }
    }
#pragma unroll
    for (int cp = 0; cp < 2; ++cp)
#pragma unroll
      for (int s = 0; s < 8; ++s) {
        const bf16x8 af = *(LAS const bf16x8*)(afp + cp * CO_BUF + s * 32), bf = *(LAS const bf16x8*)(bfp + cp * CO_BUF + s * 32);
        acc = __builtin_amdgcn_mfma_f32_32x32x16_bf16(af, bf, acc, 0, 0, 0);
      }
    __syncthreads();
  }
  LAS float* X = (LAS float*)F.lds + sub * 1024;
  __syncthreads();
  if (kh == 1) {
#pragma unroll
    for (int r = 0; r < 16; ++r) X[r * 64 + F.lane] = acc[r];
  }
  __syncthreads();
  if (kh == 0) {
    const float* cin = opq(a.in[2]); float* cout = (float*)(ws + WS_CTX1);
    const float gate = ((const float*)(ws + WS_MOD))[4 * 3072 + 2048 + col0 + r32];
    float ci[16];
#pragma unroll
    for (int r = 0; r < 16; ++r) ci[r] = cin[(size_t)(row0 + crow(r, hi)) * 1024 + col0 + r32];
    __builtin_amdgcn_sched_barrier(0);
#pragma unroll
    for (int r = 0; r < 16; ++r) { const size_t o = (size_t)(row0 + crow(r, hi)) * 1024 + col0 + r32; cout[o] = ci[r] + gate * (acc[r] + X[r * 64 + F.lane]); }
  }
}
__device__ __forceinline__ void p5_outproj(const Frame& F, const Args& a, int layer) {
  unsigned char* ws = opq(a.ws);
  const int M = MLAT;
  pg8::Gemm g{(const pg8::bf16_t*)(ws + WS_H), (const pg8::bf16_t*)(ws + WS_W2T) + (size_t)layer * 1024 * 1024, M, 1024, 1024};
  pg8::StaticOrder S; S.init(M, 1024, F.G, (int)blockIdx.x);
  EpiOut E{layer == 0 ? opq(a.in[0]) : opq(a.out), layer == 0 ? opq(a.in[2]) : (const float*)(ws + WS_CTX1), opq(a.out), (float*)(ws + WS_CTX1), (const float*)(ws + WS_MOD) + (size_t)layer * 5 * 3072};
  const bool ctx_first = layer == 0 && (F.vcu & 1);
  if (ctx_first) { const Frame F2 = relaunder(F); for (int it = F2.vcu; it < 256; it += F2.G) ctx_out_item(F2, a, it); __syncthreads(); }
  pg8::gemm_phase<EpiOut, pg8::StaticOrder>(F.lds, g, S, E, nullptr);
  if (layer == 0 && !ctx_first) { const Frame F2 = relaunder(F); for (int it = F2.vcu; it < 256; it += F2.G) ctx_out_item(F2, a, it); }
}
}

namespace mk {
typedef short v4i16_t __attribute__((ext_vector_type(4)));
__device__ __forceinline__ s16x4 vtr(LAS const unsigned char* p) { return __builtin_bit_cast(s16x4, __builtin_amdgcn_ds_read_tr16_b64_v4i16((LAS v4i16_t*)p)); }
struct AttnState { float m, l; f32x16 o0, o1; };
template <class MaskF>
__device__ __forceinline__ void attn_tile(AttnState& st, const bf16x8 (&qf)[4], LAS const unsigned char* Kt, LAS const unsigned char* Vt, int lane, MaskF&& maskf) {
  const int r32 = lane & 31, hi = lane >> 5;
  f32x16 p0, p1;
  const int ksw = (r32 >> 1) & 7;
  bf16x8 ka[4], kb[4];
#pragma unroll
  for (int s = 0; s < 4; ++s) { const int ch = ((2 * s + hi) ^ ksw) << 4; ka[s] = *(LAS const bf16x8*)(Kt + r32 * 128 + ch); kb[s] = *(LAS const bf16x8*)(Kt + (32 + r32) * 128 + ch); }
  { const f32x16 z = {0.f, 0.f, 0.f, 0.f, 0.f, 0.f, 0.f, 0.f, 0.f, 0.f, 0.f, 0.f, 0.f, 0.f, 0.f, 0.f};
    p0 = __builtin_amdgcn_mfma_f32_32x32x16_bf16(ka[0], qf[0], z, 0, 0, 0); p1 = __builtin_amdgcn_mfma_f32_32x32x16_bf16(kb[0], qf[0], z, 0, 0, 0); }
#pragma unroll
  for (int s = 1; s < 4; ++s) { p0 = __builtin_amdgcn_mfma_f32_32x32x16_bf16(ka[s], qf[s], p0, 0, 0, 0); p1 = __builtin_amdgcn_mfma_f32_32x32x16_bf16(kb[s], qf[s], p1, 0, 0, 0); }
  maskf(p0, p1);
  float ps = 0.f;
#pragma unroll
  for (int i = 0; i < 16; ++i) { p0[i] = __builtin_amdgcn_exp2f(p0[i]); p1[i] = __builtin_amdgcn_exp2f(p1[i]); ps += p0[i] + p1[i]; }
  st.l += ps;
  u32x4 pw[4];
#pragma unroll
  for (int k = 0; k < 2; ++k) {
    pw[k] = (u32x4){pk2(p0[8 * k + 0], p0[8 * k + 1]), pk2(p0[8 * k + 2], p0[8 * k + 3]), pk2(p0[8 * k + 4], p0[8 * k + 5]), pk2(p0[8 * k + 6], p0[8 * k + 7])};
    pw[2 + k] = (u32x4){pk2(p1[8 * k + 0], p1[8 * k + 1]), pk2(p1[8 * k + 2], p1[8 * k + 3]), pk2(p1[8 * k + 4], p1[8 * k + 5]), pk2(p1[8 * k + 6], p1[8 * k + 7])};
  }
  const int q = (lane & 15) >> 2, p = lane & 3, gsel = (lane >> 4) & 1;
  const int vrow = (4 * hi + q) * 128 + 8 * (p & 1);
  const int chb = 2 * gsel + (p >> 1);
#pragma unroll
  for (int ks = 0; ks < 4; ++ks) {
    const int c0_ = ((chb | ((0 ^ (q >> 1)) << 2)) << 4), c1_ = ((chb | ((1 ^ (q >> 1)) << 2)) << 4);
    const s16x4 l0 = vtr(Vt + ks * 2048 + vrow + c0_), h0 = vtr(Vt + ks * 2048 + 1024 + vrow + c0_), l1 = vtr(Vt + ks * 2048 + vrow + c1_), h1 = vtr(Vt + ks * 2048 + 1024 + vrow + c1_);
    const bf16x8 va0 = (bf16x8){l0[0], l0[1], l0[2], l0[3], h0[0], h0[1], h0[2], h0[3]}, va1 = (bf16x8){l1[0], l1[1], l1[2], l1[3], h1[0], h1[1], h1[2], h1[3]};
    st.o0 = __builtin_amdgcn_mfma_f32_32x32x16_bf16(va0, __builtin_bit_cast(bf16x8, pw[ks]), st.o0, 0, 0, 0);
    st.o1 = __builtin_amdgcn_mfma_f32_32x32x16_bf16(va1, __builtin_bit_cast(bf16x8, pw[ks]), st.o1, 0, 0, 0);
  }
}
template <class MaskF, class F1, class F2, class F3>
__device__ __forceinline__ void attn_tile_dma(AttnState& st, const bf16x8 (&qf)[4], LAS const unsigned char* Kt, LAS const unsigned char* Vt, int lane, MaskF&& maskf, F1&& after_k, F2&& before_v, F3&& after_v) {
  const int r32 = lane & 31, hi = lane >> 5;
  f32x16 p0, p1;
  const int ksw = (r32 >> 1) & 7;
  bf16x8 ka[4], kb[4];
#pragma unroll
  for (int s = 0; s < 4; ++s) { const int ch = ((2 * s + hi) ^ ksw) << 4; ka[s] = *(LAS const bf16x8*)(Kt + r32 * 128 + ch); kb[s] = *(LAS const bf16x8*)(Kt + (32 + r32) * 128 + ch); }
  asm volatile("s_waitcnt lgkmcnt(0)" ::: "memory");
  after_k();
  { const f32x16 z = {0.f, 0.f, 0.f, 0.f, 0.f, 0.f, 0.f, 0.f, 0.f, 0.f, 0.f, 0.f, 0.f, 0.f, 0.f, 0.f};
    p0 = __builtin_amdgcn_mfma_f32_32x32x16_bf16(ka[0], qf[0], z, 0, 0, 0); p1 = __builtin_amdgcn_mfma_f32_32x32x16_bf16(kb[0], qf[0], z, 0, 0, 0); }
#pragma unroll
  for (int s = 1; s < 4; ++s) { p0 = __builtin_amdgcn_mfma_f32_32x32x16_bf16(ka[s], qf[s], p0, 0, 0, 0); p1 = __builtin_amdgcn_mfma_f32_32x32x16_bf16(kb[s], qf[s], p1, 0, 0, 0); }
  maskf(p0, p1);
  float ps = 0.f;
#pragma unroll
  for (int i = 0; i < 16; ++i) { p0[i] = __builtin_amdgcn_exp2f(p0[i]); p1[i] = __builtin_amdgcn_exp2f(p1[i]); ps += p0[i] + p1[i]; }
  st.l += ps;
  u32x4 pw[4];
#pragma unroll
  for (int k = 0; k < 2; ++k) {
    pw[k] = (u32x4){pk2(p0[8 * k + 0], p0[8 * k + 1]), pk2(p0[8 * k + 2], p0[8 * k + 3]), pk2(p0[8 * k + 4], p0[8 * k + 5]), pk2(p0[8 * k + 6], p0[8 * k + 7])};
    pw[2 + k] = (u32x4){pk2(p1[8 * k + 0], p1[8 * k + 1]), pk2(p1[8 * k + 2], p1[8 * k + 3]), pk2(p1[8 * k + 4], p1[8 * k + 5]), pk2(p1[8 * k + 6], p1[8 * k + 7])};
  }
  before_v();
  const int q = (lane & 15) >> 2, p = lane & 3, gsel = (lane >> 4) & 1;
  const int vrow = (4 * hi + q) * 128 + 8 * (p & 1);
  const int chb = 2 * gsel + (p >> 1);
  s16x4 vl0[4], vh0[4], vl1[4], vh1[4];
#pragma unroll
  for (int ks = 0; ks < 4; ++ks) {
    const int c0_ = ((chb | ((0 ^ (q >> 1)) << 2)) << 4), c1_ = ((chb | ((1 ^ (q >> 1)) << 2)) << 4);
    vl0[ks] = vtr(Vt + ks * 2048 + vrow + c0_); vh0[ks] = vtr(Vt + ks * 2048 + 1024 + vrow + c0_); vl1[ks] = vtr(Vt + ks * 2048 + vrow + c1_); vh1[ks] = vtr(Vt + ks * 2048 + 1024 + vrow + c1_);
  }
  asm volatile("s_waitcnt lgkmcnt(0)" ::: "memory");
  after_v();
#pragma unroll
  for (int ks = 0; ks < 4; ++ks) {
    const bf16x8 va0 = (bf16x8){vl0[ks][0], vl0[ks][1], vl0[ks][2], vl0[ks][3], vh0[ks][0], vh0[ks][1], vh0[ks][2], vh0[ks][3]}, va1 = (bf16x8){vl1[ks][0], vl1[ks][1], vl1[ks][2], vl1[ks][3], vh1[ks][0], vh1[ks][1], vh1[ks][2], vh1[ks][3]};
    st.o0 = __builtin_amdgcn_mfma_f32_32x32x16_bf16(va0, __builtin_bit_cast(bf16x8, pw[ks]), st.o0, 0, 0, 0);
    st.o1 = __builtin_amdgcn_mfma_f32_32x32x16_bf16(va1, __builtin_bit_cast(bf16x8, pw[ks]), st.o1, 0, 0, 0);
  }
}
__device__ __forceinline__ void glds16(const void* sbase  , unsigned voff  , unsigned lds_dst) {
  unsigned keep;
  asm volatile("s_mov_b32 %0, m0\n\ts_mov_b32 m0, %2\n\ts_nop 0\n\tglobal_load_lds_dwordx4 %1, %3\n\ts_mov_b32 m0, %0" : "=&s"(keep) : "v"(voff), "s"(lds_dst), "s"(sbase) : "memory");
}
__device__ __forceinline__ void glds16x8(const void* sbase, const unsigned (&vo)[8], unsigned lds_dst) {
  unsigned keep;
  asm volatile("s_mov_b32 %0, m0\n\ts_mov_b32 m0, %9\n\ts_nop 0\n\tglobal_load_lds_dwordx4 %1, %10\n\t"
               "s_add_u32 m0, m0, 0x400\n\ts_nop 0\n\tglobal_load_lds_dwordx4 %2, %10\n\t"
               "s_add_u32 m0, m0, 0x400\n\ts_nop 0\n\tglobal_load_lds_dwordx4 %3, %10\n\t"
               "s_add_u32 m0, m0, 0x400\n\ts_nop 0\n\tglobal_load_lds_dwordx4 %4, %10\n\t"
               "s_add_u32 m0, m0, 0x400\n\ts_nop 0\n\tglobal_load_lds_dwordx4 %5, %10\n\t"
               "s_add_u32 m0, m0, 0x400\n\ts_nop 0\n\tglobal_load_lds_dwordx4 %6, %10\n\t"
               "s_add_u32 m0, m0, 0x400\n\ts_nop 0\n\tglobal_load_lds_dwordx4 %7, %10\n\t"
               "s_add_u32 m0, m0, 0x400\n\ts_nop 0\n\tglobal_load_lds_dwordx4 %8, %10\n\t"
               "s_mov_b32 m0, %0"
               : "=&s"(keep) : "v"(vo[0]), "v"(vo[1]), "v"(vo[2]), "v"(vo[3]), "v"(vo[4]), "v"(vo[5]), "v"(vo[6]), "v"(vo[7]), "s"(lds_dst), "s"(sbase) : "memory", "scc");
}
__device__ __forceinline__ void attn_store(const AttnState& st, float inv, const bf16* grow  , bf16* yrow  , int lane) {
  const int hi = lane >> 5;
  u32x2 gv[8];
#pragma unroll
  for (int i = 0; i < 8; ++i) gv[i] = *(const u32x2*)(grow + 32 * (i >> 2) + 8 * (i & 3) + 4 * hi);
  __builtin_amdgcn_sched_barrier(0);
#pragma unroll
  for (int d0 = 0; d0 < 2; ++d0)
#pragma unroll
    for (int gi = 0; gi < 4; ++gi) {
      const int db = 32 * d0 + 8 * gi + 4 * hi; const u32x2 g = gv[4 * d0 + gi];
      const f32x16& o = d0 == 0 ? st.o0 : st.o1;
      const float g0 = __uint_as_float(g.x << 16), g1 = __uint_as_float(g.x & 0xffff0000u), g2 = __uint_as_float(g.y << 16), g3 = __uint_as_float(g.y & 0xffff0000u);
      u32x2 ov; ov.x = pk2(o[4 * gi + 0] * inv * g0, o[4 * gi + 1] * inv * g1); ov.y = pk2(o[4 * gi + 2] * inv * g2, o[4 * gi + 3] * inv * g3);
      *(u32x2*)(yrow + db) = ov;
    }
}
__device__ __forceinline__ void attn_gates(u32x2 (&gv)[8], const bf16* grow, int lane) {
  const int hi = lane >> 5;
#pragma unroll
  for (int i = 0; i < 8; ++i) gv[i] = *(const u32x2*)(grow + 32 * (i >> 2) + 8 * (i & 3) + 4 * hi);
}
__device__ __forceinline__ void attn_store_g(const AttnState& st, float inv, const u32x2 (&gv)[8], bf16* yrow, int lane) {
  const int hi = lane >> 5;
#pragma unroll
  for (int d0 = 0; d0 < 2; ++d0)
#pragma unroll
    for (int gi = 0; gi < 4; ++gi) {
      const int db = 32 * d0 + 8 * gi + 4 * hi; const u32x2 g = gv[4 * d0 + gi];
      const f32x16& o = d0 == 0 ? st.o0 : st.o1;
      const float g0 = __uint_as_float(g.x << 16), g1 = __uint_as_float(g.x & 0xffff0000u), g2 = __uint_as_float(g.y << 16), g3 = __uint_as_float(g.y & 0xffff0000u);
      u32x2 ov; ov.x = pk2(o[4 * gi + 0] * inv * g0, o[4 * gi + 1] * inv * g1); ov.y = pk2(o[4 * gi + 2] * inv * g2, o[4 * gi + 3] * inv * g3);
      *(u32x2*)(yrow + db) = ov;
    }
}
template <int NH> struct TileRegs { u32x4 k[NH], v[NH]; };
template <int NH>
__device__ __forceinline__ void tile_load(TileRegs<NH>& R, const bf16* kbase  , const bf16* vbase, int tid) {
  const int key = tid >> 3, ch = tid & 7;
#pragma unroll
  for (int h = 0; h < NH; ++h) { R.k[h] = *(const u32x4*)(kbase + (size_t)key * PLW + h * 64 + ch * 8); R.v[h] = *(const u32x4*)(vbase + (size_t)key * PLW + h * 64 + ch * 8); }
}
template <int NH>
__device__ __forceinline__ void tile_store(const TileRegs<NH>& R, LAS unsigned char* buf, int tid) {
  const int key = tid >> 3, ch = tid & 7;
  const int ko = key * 128 + ((ch ^ ((key >> 1) & 7)) << 4), vo = key * 128 + ((ch ^ (((key >> 1) & 1) << 2)) << 4);
#pragma unroll
  for (int h = 0; h < NH; ++h) { *(LAS u32x4*)(buf + h * 8192 + ko) = R.k[h]; *(LAS u32x4*)(buf + NH * 8192 + h * 8192 + vo) = R.v[h]; }
}

template <int NH> struct TileRegs2 { TileRegs<NH> a, b; };
__device__ __forceinline__ void swa_item(const Frame& F0, const Args& a, int layer, int item) {
  const Frame F = relaunder(F0);
  unsigned char* ws = opq(a.ws);
  const bf16* PLB = (const bf16*)(ws + WS_PLB); bf16* Y = (bf16*)(ws + WS_H);
  const bool isctx = item >= 256;
  int b, kvh, n;
  if (!isctx) { b = item >> 6; kvh = (item >> 5) & 1; n = item & 31; } else { const int ci = item - 256; b = ci >> 2; kvh = (ci >> 1) & 1; n = ci & 1; }
  const int g = F.wave >> 2, quarter = F.wave & 3, hq = 2 * kvh + g, r32 = F.lane & 31, hi = F.lane >> 5;
  const int tq = 128 * n + 32 * quarter + r32;
  const size_t qrow = isctx ? (size_t)MLAT + b * CTX + tq : (size_t)b * SEQ + tq;
  bf16x8 qf[4];
#pragma unroll
  for (int s = 0; s < 4; ++s) qf[s] = *(const bf16x8*)(PLB + qrow * PLW + S_CQ * 256 + hq * 64 + 16 * s + 8 * hi);
  int jlo = 0, jhi = 0;
  if (!isctx) { jlo = n == 0 ? 1 : 0; jhi = n == 31 ? 2 : 3; }
  const int nloc = jhi - jlo, T = nloc + 2;
  const bf16* kcol = PLB + S_CKV * 256 + kvh * 64;
  auto tile_row = [&](int t) -> size_t { return t < nloc ? (size_t)b * SEQ + 128 * (n - 1 + jlo + t) : (size_t)MLAT + b * CTX + 128 * (t - nloc); };
  AttnState st; st.m = 0.f; st.l = 0.f;
#pragma unroll
  for (int i = 0; i < 16; ++i) { st.o0[i] = 0.f; st.o1[i] = 0.f; }
  TileRegs2<1> R;
  __syncthreads();
  { const size_t r0 = tile_row(0); tile_load<1>(R.a, kcol + r0 * PLW, kcol + 128 + r0 * PLW, F.tid); tile_load<1>(R.b, kcol + (r0 + 64) * PLW, kcol + 128 + (r0 + 64) * PLW, F.tid); }
  tile_store<1>(R.a, F.lds, F.tid); tile_store<1>(R.b, F.lds + 16384, F.tid);
  __syncthreads();
  for (int t = 0; t < T; ++t) {
    if (t + 1 < T) { const size_t r0 = tile_row(t + 1); tile_load<1>(R.a, kcol + r0 * PLW, kcol + 128 + r0 * PLW, F.tid); tile_load<1>(R.b, kcol + (r0 + 64) * PLW, kcol + 128 + (r0 + 64) * PLW, F.tid); }
    LAS const unsigned char* buf = F.lds + (t & 1) * 32768;
#pragma unroll
    for (int hf = 0; hf < 2; ++hf) {
      LAS const unsigned char* hb = buf + hf * 16384;
      if (t < nloc) {
        const int kb = 128 * (n - 1 + jlo + t) + 64 * hf, q0 = 128 * n + 32 * quarter;
        if (!(kb + 63 < q0 - 128 || kb > q0 + 31 + 128)) {
          const int dq = kb - tq;
          if (kb >= q0 + 31 - 128 && kb + 63 <= q0 + 128) attn_tile(st, qf, hb, hb + 8192, F.lane, [](f32x16&, f32x16&) {});
          else attn_tile(st, qf, hb, hb + 8192, F.lane, [&](f32x16& p0, f32x16& p1) {
#pragma unroll
            for (int r = 0; r < 16; ++r) { const int d0_ = dq + 128 + crow(r, hi), d1_ = d0_ + 32;
              p0[r] = ((unsigned)d0_ <= 256u) ? p0[r] : -INFINITY; p1[r] = ((unsigned)d1_ <= 256u) ? p1[r] : -INFINITY; } });
        }
      } else attn_tile(st, qf, hb, hb + 8192, F.lane, [](f32x16&, f32x16&) {});
    }
    if (t + 1 < T) { tile_store<1>(R.a, F.lds + ((t + 1) & 1) * 32768, F.tid); tile_store<1>(R.b, F.lds + ((t + 1) & 1) * 32768 + 16384, F.tid); }
    __syncthreads();
  }
  float l = st.l + __shfl_xor(st.l, 32);
  const float sk2 = opq(a.in[15])[layer * 4 + hq] * LOG2E;
  const float mnew = fmaxf(st.m, sk2), al = __builtin_amdgcn_exp2f(st.m - mnew);
  l = l * al + __builtin_amdgcn_exp2f(sk2 - mnew);
  int qr = (int)qrow; asm volatile("" : "+v"(qr));
  attn_store(st, al / l, PLB + (size_t)qr * PLW + S_CG * 256 + hq * 64, Y + (size_t)qr * 1024 + 512 + hq * 64, F.lane);
}
__device__ __forceinline__ void na_item(const Frame& F0, const Args& a, int layer, int item) {
  const Frame F = relaunder(F0);
  unsigned char* ws = opq(a.ws);
  const bf16* PLB = (const bf16*)(ws + WS_PLB); bf16* Y = (bf16*)(ws + WS_H);
  const bool isctx = item >= 256;
  int b, r;
  if (!isctx) { b = item >> 6; r = item & 63; } else { const int ci = item - 256; b = ci >> 2; r = ci & 3; }
  const int head = F.wave >> 1, half = F.wave & 1, r32 = F.lane & 31, hi = F.lane >> 5;
  const int qc = 32 * half + r32;
  const size_t qrow = isctx ? (size_t)MLAT + b * CTX + 64 * r + qc : (size_t)b * SEQ + 64 * r + qc;
  bf16x8 qf[4];
#pragma unroll
  for (int s = 0; s < 4; ++s) qf[s] = *(const bf16x8*)(PLB + qrow * PLW + S_DQ * 256 + head * 64 + 16 * s + 8 * hi);
  int rs = r - 4; rs = rs < 0 ? 0 : (rs > 56 ? 56 : rs);
  const int nloc = isctx ? 0 : 8, T = nloc + 4;
  auto tile_row = [&](int t) -> size_t { return t < nloc ? (size_t)b * SEQ + 64 * (rs + t) : (size_t)MLAT + b * CTX + 64 * (t - nloc); };
  const bf16* kcol = PLB + S_DK * 256 + head * 64; const bf16* vcol = PLB + S_DV * 256 + head * 64;
  LAS float* btab = (LAS float*)(F.lds + 2 * 65536);
  LAS unsigned char* Kt = F.lds + F.wave * 16384; LAS unsigned char* Vt = Kt + 8192;
  const unsigned kdst = (unsigned)(size_t)Kt, vdst = kdst + 8192u;
  const int kk = F.lane >> 3, cs = F.lane & 7;
  const unsigned ok0 = kk * (PLW * 2) + ((cs ^ (kk >> 1)) << 4), ok1 = kk * (PLW * 2) + ((cs ^ (4 + (kk >> 1))) << 4), ov = kk * (PLW * 2) + ((cs ^ (((kk >> 1) & 1) << 2)) << 4);
  unsigned vok[8], vov[8];
#pragma unroll
  for (int n = 0; n < 8; ++n) { vok[n] = ((n & 1) ? ok1 : ok0) + n * 8 * (PLW * 2); vov[n] = ov + n * 8 * (PLW * 2); }
  auto dma_k = [&](int t) { glds16x8(kcol + tile_row(t) * PLW, vok, kdst); };
  auto dma_v = [&](int t) { glds16x8(vcol + tile_row(t) * PLW, vov, vdst); };
  AttnState st; st.m = 0.f; st.l = 0.f;
#pragma unroll
  for (int i = 0; i < 16; ++i) { st.o0[i] = 0.f; st.o1[i] = 0.f; }
  u32x2 gv[8];
  { int qr0 = (int)qrow; asm volatile("" : "+v"(qr0)); attn_gates(gv, PLB + (size_t)qr0 * PLW + S_DG * 256 + head * 64, F.lane); }
  float t_[15];
  { const float* rb = opq(a.in[18]) + (size_t)layer * 4 * 15 * 31;
#pragma unroll
    for (int i = 0; i < 15; ++i) { const int ix = F.tid + 512 * i, hd = ix >> 7, dx = (ix & 127) - 63; const int dc = dx < -15 ? -15 : (dx > 15 ? 15 : dx); t_[i] = rb[hd * 31 + dc + 15]; } }
  __builtin_amdgcn_sched_barrier(0);
#pragma unroll
  for (int s = 0; s < 4; ++s) asm volatile("" : "+v"(qf[s]));
#pragma unroll
  for (int i = 0; i < 15; ++i) asm volatile("" : "+v"(t_[i]));
#pragma unroll
  for (int i = 0; i < 8; ++i) asm volatile("" : "+v"(gv[i]));
  __syncthreads();
  dma_k(0); dma_v(0);
#pragma unroll
  for (int i = 0; i < 15; ++i) { const int dx = ((F.tid + 512 * i) & 127) - 63; btab[F.tid + 512 * i] = (dx >= -15 && dx <= 15) ? t_[i] * LOG2E : 0.f; }
  __syncthreads();
  int c0 = qc - 8; c0 = c0 < 0 ? 0 : (c0 > 48 ? 48 : c0);
  for (int t = 0; t < T; ++t) {
    const bool more = t + 1 < T;
    asm volatile("s_waitcnt vmcnt(8)" ::: "memory");
    auto after_k = [&]() { if (more) dma_k(t + 1); };
    auto before_v = [&]() { if (more) asm volatile("s_waitcnt vmcnt(8)" ::: "memory"); else asm volatile("s_waitcnt vmcnt(0)" ::: "memory"); };
    auto after_v = [&]() { if (more) dma_v(t + 1); };
    if (t < nloc) {
      const int dy = rs + t - r + 7;
      const int c0l = c0;
      unsigned bta = (unsigned)(size_t)(btab + (head * 15 + dy) * 128 + 63 - qc + 4 * hi); asm volatile("" : "+v"(bta));
      LAS const float* bt = (LAS const float*)bta;
      attn_tile_dma(st, qf, Kt, Vt, F.lane, [&](f32x16& p0, f32x16& p1) {
        float bb[16];
#pragma unroll
        for (int rr = 0; rr < 16; ++rr) bb[rr] = bt[(rr & 3) + 8 * (rr >> 2)];
#pragma unroll
        for (int rr = 0; rr < 16; ++rr) p0[rr] = ((unsigned)((rr & 3) + 8 * (rr >> 2) + 4 * hi - c0l) < 16u) ? p0[rr] + bb[rr] : -INFINITY;
#pragma unroll
        for (int rr = 0; rr < 16; ++rr) bb[rr] = bt[(rr & 3) + 8 * (rr >> 2) + 32];
#pragma unroll
        for (int rr = 0; rr < 16; ++rr) p1[rr] = ((unsigned)((rr & 3) + 8 * (rr >> 2) + 32 + 4 * hi - c0l) < 16u) ? p1[rr] + bb[rr] : -INFINITY; }, after_k, before_v, after_v);
    } else attn_tile_dma(st, qf, Kt, Vt, F.lane, [](f32x16&, f32x16&) {}, after_k, before_v, after_v);
  }
  const float l = st.l + __shfl_xor(st.l, 32);
  int qr = (int)qrow; asm volatile("" : "+v"(qr));
  attn_store_g(st, 1.f / l, gv, Y + (size_t)qr * 1024 + 768 + head * 64, F.lane);
}
}

namespace mk {
struct Attn2 { float l[2]; f32x16 o[2][2]; };
template <class ProbF, class F1, class F2, class F3>
__device__ __forceinline__ void attn2_tile(Attn2& st, const bf16x8 (&qf)[2][4], LAS const unsigned char* Kt, LAS const unsigned char* Vt, int lane, ProbF&& probf, F1&& after_k, F2&& before_v, F3&& after_v) {
  const int r32 = lane & 31, hi = lane >> 5;
  const int ksw = (r32 >> 1) & 7;
  bf16x8 ka[4], kb[4];
#pragma unroll
  for (int s = 0; s < 4; ++s) { const int ch = ((2 * s + hi) ^ ksw) << 4; ka[s] = *(LAS const bf16x8*)(Kt + r32 * 128 + ch); kb[s] = *(LAS const bf16x8*)(Kt + (32 + r32) * 128 + ch); }
  asm volatile("s_waitcnt lgkmcnt(0)" ::: "memory");
  after_k();
  u32x4 pw[2][4];
#pragma unroll
  for (int qb = 0; qb < 2; ++qb) {
    f32x16 p0, p1;
    { const f32x16 z = {0.f, 0.f, 0.f, 0.f, 0.f, 0.f, 0.f, 0.f, 0.f, 0.f, 0.f, 0.f, 0.f, 0.f, 0.f, 0.f};
      p0 = __builtin_amdgcn_mfma_f32_32x32x16_bf16(ka[0], qf[qb][0], z, 0, 0, 0); p1 = __builtin_amdgcn_mfma_f32_32x32x16_bf16(kb[0], qf[qb][0], z, 0, 0, 0); }
#pragma unroll
    for (int s = 1; s < 4; ++s) { p0 = __builtin_amdgcn_mfma_f32_32x32x16_bf16(ka[s], qf[qb][s], p0, 0, 0, 0); p1 = __builtin_amdgcn_mfma_f32_32x32x16_bf16(kb[s], qf[qb][s], p1, 0, 0, 0); }
    probf(qb, p0, p1);
    float ps = 0.f;
#pragma unroll
    for (int i = 0; i < 16; ++i) ps += p0[i] + p1[i];
    st.l[qb] += ps;
#pragma unroll
    for (int k = 0; k < 2; ++k) {
      pw[qb][k] = (u32x4){pk2(p0[8 * k + 0], p0[8 * k + 1]), pk2(p0[8 * k + 2], p0[8 * k + 3]), pk2(p0[8 * k + 4], p0[8 * k + 5]), pk2(p0[8 * k + 6], p0[8 * k + 7])};
      pw[qb][2 + k] = (u32x4){pk2(p1[8 * k + 0], p1[8 * k + 1]), pk2(p1[8 * k + 2], p1[8 * k + 3]), pk2(p1[8 * k + 4], p1[8 * k + 5]), pk2(p1[8 * k + 6], p1[8 * k + 7])};
    }
  }
  before_v();
  const int q = (lane & 15) >> 2, p = lane & 3, gsel = (lane >> 4) & 1;
  const int vrow = (4 * hi + q) * 128 + 8 * (p & 1);
  const int chb = 2 * gsel + (p >> 1);
  s16x4 vl0[4], vh0[4], vl1[4], vh1[4];
#pragma unroll
  for (int ks = 0; ks < 4; ++ks) {
    const int c0_ = ((chb | ((0 ^ (q >> 1)) << 2)) << 4), c1_ = ((chb | ((1 ^ (q >> 1)) << 2)) << 4);
    vl0[ks] = vtr(Vt + ks * 2048 + vrow + c0_); vh0[ks] = vtr(Vt + ks * 2048 + 1024 + vrow + c0_); vl1[ks] = vtr(Vt + ks * 2048 + vrow + c1_); vh1[ks] = vtr(Vt + ks * 2048 + 1024 + vrow + c1_);
  }
  asm volatile("s_waitcnt lgkmcnt(0)" ::: "memory");
  after_v();
#pragma unroll
  for (int ks = 0; ks < 4; ++ks) {
    const bf16x8 va0 = (bf16x8){vl0[ks][0], vl0[ks][1], vl0[ks][2], vl0[ks][3], vh0[ks][0], vh0[ks][1], vh0[ks][2], vh0[ks][3]}, va1 = (bf16x8){vl1[ks][0], vl1[ks][1], vl1[ks][2], vl1[ks][3], vh1[ks][0], vh1[ks][1], vh1[ks][2], vh1[ks][3]};
#pragma unroll
    for (int qb = 0; qb < 2; ++qb) {
      st.o[qb][0] = __builtin_amdgcn_mfma_f32_32x32x16_bf16(va0, __builtin_bit_cast(bf16x8, pw[qb][ks]), st.o[qb][0], 0, 0, 0);
      st.o[qb][1] = __builtin_amdgcn_mfma_f32_32x32x16_bf16(va1, __builtin_bit_cast(bf16x8, pw[qb][ks]), st.o[qb][1], 0, 0, 0);
    }
  }
}
struct DmaLane { unsigned ok0, ok1, ov; };
__device__ __forceinline__ DmaLane dma_lane(int lane) {
  const int kk = lane >> 3, cs = lane & 7; DmaLane d;
  d.ok0 = kk * (PLW * 2) + ((cs ^ (kk >> 1)) << 4); d.ok1 = kk * (PLW * 2) + ((cs ^ (4 + (kk >> 1))) << 4); d.ov = kk * (PLW * 2) + ((cs ^ (((kk >> 1) & 1) << 2)) << 4); return d;
}
__device__ __forceinline__ void dma_tile_k(const bf16* krow0  , const DmaLane& d, unsigned kdst) {
  const unsigned char* tb = (const unsigned char*)krow0;
#pragma unroll
  for (int n = 0; n < 8; ++n) glds16(tb + (size_t)n * 8 * (PLW * 2), (n & 1) ? d.ok1 : d.ok0, kdst + n * 1024);
}
__device__ __forceinline__ void dma_tile_v(const bf16* vrow0, const DmaLane& d, unsigned vdst) {
  const unsigned char* tb = (const unsigned char*)vrow0;
#pragma unroll
  for (int n = 0; n < 8; ++n) glds16(tb + (size_t)n * 8 * (PLW * 2), d.ov, vdst + n * 1024);
}
__device__ __forceinline__ void attn2_exchange(const Attn2& st, int par, AttnState& fin, const Frame& F) {
  LAS float* X = (LAS float*)(F.lds + F.wave * 16384);
  LAS const float* XP = (LAS const float*)(F.lds + (F.wave ^ 1) * 16384);
  if (par == 0) {
#pragma unroll
    for (int i = 0; i < 16; ++i) { X[i * 64 + F.lane] = st.o[1][0][i]; X[(16 + i) * 64 + F.lane] = st.o[1][1][i]; }
    X[32 * 64 + F.lane] = st.l[1];
  } else {
#pragma unroll
    for (int i = 0; i < 16; ++i) { X[i * 64 + F.lane] = st.o[0][0][i]; X[(16 + i) * 64 + F.lane] = st.o[0][1][i]; }
    X[32 * 64 + F.lane] = st.l[0];
  }
  __syncthreads();
  if (par == 0) {
#pragma unroll
    for (int i = 0; i < 16; ++i) { fin.o0[i] = st.o[0][0][i] + XP[i * 64 + F.lane]; fin.o1[i] = st.o[0][1][i] + XP[(16 + i) * 64 + F.lane]; }
    fin.l = st.l[0] + XP[32 * 64 + F.lane];
  } else {
#pragma unroll
    for (int i = 0; i < 16; ++i) { fin.o0[i] = st.o[1][0][i] + XP[i * 64 + F.lane]; fin.o1[i] = st.o[1][1][i] + XP[(16 + i) * 64 + F.lane]; }
    fin.l = st.l[1] + XP[32 * 64 + F.lane];
  }
  fin.m = 0.f;
}
__device__ __forceinline__ void exp_all(f32x16& p0, f32x16& p1) {
#pragma unroll
  for (int i = 0; i < 16; ++i) { p0[i] = __builtin_amdgcn_exp2f(p0[i]); p1[i] = __builtin_amdgcn_exp2f(p1[i]); }
}

__device__ __forceinline__ void na_item2(const Frame& F0, const Args& a, int layer, int item) {
  const Frame F = relaunder(F0);
  unsigned char* ws = opq(a.ws);
  const bf16* PLB = (const bf16*)(ws + WS_PLB); bf16* Y = (bf16*)(ws + WS_H);
  const bool isctx = item >= 256;
  int b, r;
  if (!isctx) { b = item >> 6; r = item & 63; } else { const int ci = item - 256; b = ci >> 2; r = ci & 3; }
  const int head = F.wave >> 1, par = F.wave & 1, r32 = F.lane & 31, hi = F.lane >> 5;
  const size_t qrow0 = isctx ? (size_t)MLAT + b * CTX + 64 * r : (size_t)b * SEQ + 64 * r;
  bf16x8 qf[2][4];
#pragma unroll
  for (int qb = 0; qb < 2; ++qb)
#pragma unroll
    for (int s = 0; s < 4; ++s) qf[qb][s] = *(const bf16x8*)(PLB + (qrow0 + 32 * qb + r32) * PLW + S_DQ * 256 + head * 64 + 16 * s + 8 * hi);
  int rs = r - 4; rs = rs < 0 ? 0 : (rs > 56 ? 56 : rs);
  const int T = isctx ? 4 : 12;
  auto tile_row = [&](int t) -> size_t { return t < 4 ? (size_t)MLAT + b * CTX + 64 * t : (size_t)b * SEQ + 64 * (rs + t - 4); };
  const bf16* kcol = PLB + S_DK * 256 + head * 64; const bf16* vcol = PLB + S_DV * 256 + head * 64;
  LAS float* btab = (LAS float*)(F.lds + 2 * 65536);
  LAS unsigned char* Kt = F.lds + F.wave * 16384; LAS unsigned char* Vt = Kt + 8192;
  const unsigned kdst = (unsigned)(size_t)Kt, vdst = kdst + 8192u;
  const DmaLane dl = dma_lane(F.lane);
  Attn2 st; st.l[0] = 0.f; st.l[1] = 0.f;
#pragma unroll
  for (int i = 0; i < 16; ++i) { st.o[0][0][i] = 0.f; st.o[0][1][i] = 0.f; st.o[1][0][i] = 0.f; st.o[1][1][i] = 0.f; }
#pragma unroll
  for (int qb = 0; qb < 2; ++qb)
#pragma unroll
    for (int s = 0; s < 4; ++s) asm volatile("" : "+v"(qf[qb][s]));
  __syncthreads();
  dma_tile_k(kcol + tile_row(par) * PLW, dl, kdst); dma_tile_v(vcol + tile_row(par) * PLW, dl, vdst);
  {
    const float* rb = opq(a.in[18]) + (size_t)layer * 4 * 15 * 31; float t_[15];
#pragma unroll
    for (int i = 0; i < 15; ++i) { const int ix = F.tid + 512 * i, hd = ix >> 7, dx = (ix & 127) - 63; const int dc = dx < -15 ? -15 : (dx > 15 ? 15 : dx); t_[i] = rb[hd * 31 + dc + 15]; }
    __builtin_amdgcn_sched_barrier(0);
#pragma unroll
    for (int i = 0; i < 15; ++i) { const int dx = ((F.tid + 512 * i) & 127) - 63; btab[F.tid + 512 * i] = (dx >= -15 && dx <= 15) ? t_[i] * LOG2E : 0.f; } }
  __syncthreads();
  const int c00 = r32 < 8 ? 0 : r32 - 8, c01 = r32 > 24 ? 48 : 24 + r32;
  for (int t = par; t < T; t += 2) {
    const bool more = t + 2 < T;
    asm volatile("s_waitcnt vmcnt(8)" ::: "memory");
    auto after_k = [&]() { if (more) dma_tile_k(kcol + tile_row(t + 2) * PLW, dl, kdst); };
    auto before_v = [&]() { if (more) asm volatile("s_waitcnt vmcnt(8)" ::: "memory"); else asm volatile("s_waitcnt vmcnt(0)" ::: "memory"); };
    auto after_v = [&]() { if (more) dma_tile_v(vcol + tile_row(t + 2) * PLW, dl, vdst); };
    if (t >= 4) {
      const int dy = rs + (t - 4) - r + 7;
      unsigned bta = (unsigned)(size_t)(btab + (head * 15 + dy) * 128 + 63 - r32 + 4 * hi); asm volatile("" : "+v"(bta));
      LAS const float* bt = (LAS const float*)bta;
      attn2_tile(st, qf, Kt, Vt, F.lane, [&](int qb, f32x16& p0, f32x16& p1) {
        if (qb == 0) {
#pragma unroll
          for (int rr = 0; rr < 16; ++rr) { const int kc = (rr & 3) + 8 * (rr >> 2); p0[rr] = ((unsigned)(kc + 4 * hi - c00) < 16u) ? __builtin_amdgcn_exp2f(p0[rr] + bt[kc]) : 0.f; }
#pragma unroll
          for (int rr = 0; rr < 4; ++rr) p1[rr] = ((unsigned)(32 + rr + 4 * hi - c00) < 16u) ? __builtin_amdgcn_exp2f(p1[rr] + bt[32 + rr]) : 0.f;
#pragma unroll
          for (int rr = 4; rr < 16; ++rr) p1[rr] = 0.f;
        } else {
#pragma unroll
          for (int rr = 0; rr < 12; ++rr) p0[rr] = 0.f;
#pragma unroll
          for (int rr = 12; rr < 16; ++rr) p0[rr] = ((unsigned)(12 + rr + 4 * hi - c01) < 16u) ? __builtin_amdgcn_exp2f(p0[rr] + bt[12 + rr - 32]) : 0.f;
#pragma unroll
          for (int rr = 0; rr < 16; ++rr) { const int kc = 32 + (rr & 3) + 8 * (rr >> 2); p1[rr] = ((unsigned)(kc + 4 * hi - c01) < 16u) ? __builtin_amdgcn_exp2f(p1[rr] + bt[kc - 32]) : 0.f; }
        } }, after_k, before_v, after_v);
    } else attn2_tile(st, qf, Kt, Vt, F.lane, [](int, f32x16& p0, f32x16& p1) { exp_all(p0, p1); }, after_k, before_v, after_v);
  }
  AttnState fin;
  attn2_exchange(st, par, fin, F);
  const float l = fin.l + __shfl_xor(fin.l, 32);
  int qr = (int)qrow0 + 32 * par + r32; asm volatile("" : "+v"(qr));
  attn_store(fin, 1.f / l, PLB + (size_t)qr * PLW + S_DG * 256 + head * 64, Y + (size_t)qr * 1024 + 768 + head * 64, F.lane);
}

__device__ __forceinline__ void swa_item2(const Frame& F0, const Args& a, int layer, int item) {
  const Frame F = relaunder(F0);
  unsigned char* ws = opq(a.ws);
  const bf16* PLB = (const bf16*)(ws + WS_PLB); bf16* Y = (bf16*)(ws + WS_H);
  const bool isctx = item >= 256;
  int b, kvh, n;
  if (!isctx) { b = item >> 6; kvh = (item >> 5) & 1; n = item & 31; } else { const int ci = item - 256; b = ci >> 2; kvh = (ci >> 1) & 1; n = ci & 1; }
  const int quarter = F.wave >> 1, par = F.wave & 1, r32 = F.lane & 31, hi = F.lane >> 5;
  const int q0 = 128 * n + 32 * quarter, tq = q0 + r32;
  const size_t qrow = isctx ? (size_t)MLAT + b * CTX + tq : (size_t)b * SEQ + tq;
  bf16x8 qf[2][4];
#pragma unroll
  for (int g = 0; g < 2; ++g)
#pragma unroll
    for (int s = 0; s < 4; ++s) qf[g][s] = *(const bf16x8*)(PLB + qrow * PLW + S_CQ * 256 + (2 * kvh + g) * 64 + 16 * s + 8 * hi);
  unsigned need = 0x3C0u;
  if (!isctx) {
#pragma unroll
    for (int hk = 0; hk < 6; ++hk) { const int kb = 128 * (n - 1) + 64 * hk; if (kb >= 0 && kb < SEQ && !(kb + 63 < q0 - 128 || kb > q0 + 31 + 128)) need |= 1u << hk; }
  }
  need = (unsigned)__builtin_amdgcn_readfirstlane((int)need);
  if (par) need &= need - 1u;
  auto tile_row = [&](int hk) -> size_t { return hk < 6 ? (size_t)b * SEQ + 128 * (n - 1) + 64 * hk : (size_t)MLAT + b * CTX + 64 * (hk - 6); };
  const bf16* kcol = PLB + S_CKV * 256 + kvh * 64; const bf16* vcol = kcol + 128;
  LAS unsigned char* Kt = F.lds + F.wave * 16384; LAS unsigned char* Vt = Kt + 8192;
  const unsigned kdst = (unsigned)(size_t)Kt, vdst = kdst + 8192u;
  const DmaLane dl = dma_lane(F.lane);
  Attn2 st; st.l[0] = 0.f; st.l[1] = 0.f;
#pragma unroll
  for (int i = 0; i < 16; ++i) { st.o[0][0][i] = 0.f; st.o[0][1][i] = 0.f; st.o[1][0][i] = 0.f; st.o[1][1][i] = 0.f; }
#pragma unroll
  for (int g = 0; g < 2; ++g)
#pragma unroll
    for (int s = 0; s < 4; ++s) asm volatile("" : "+v"(qf[g][s]));
  __syncthreads();
  if (need) { const int t0 = __builtin_ctz(need); dma_tile_k(kcol + tile_row(t0) * PLW, dl, kdst); dma_tile_v(vcol + tile_row(t0) * PLW, dl, vdst); }
  while (need) {
    const int t = __builtin_ctz(need);
    need &= need - 1u; need &= need - 1u;
    const bool more = need != 0u;
    const int tn = more ? __builtin_ctz(need) : 0;
    asm volatile("s_waitcnt vmcnt(8)" ::: "memory");
    auto after_k = [&]() { if (more) dma_tile_k(kcol + tile_row(tn) * PLW, dl, kdst); };
    auto before_v = [&]() { if (more) asm volatile("s_waitcnt vmcnt(8)" ::: "memory"); else asm volatile("s_waitcnt vmcnt(0)" ::: "memory"); };
    auto after_v = [&]() { if (more) dma_tile_v(vcol + tile_row(tn) * PLW, dl, vdst); };
    const int kb = 128 * (n - 1) + 64 * t;
    if (t < 6 && !(kb >= q0 + 31 - 128 && kb + 63 <= q0 + 128)) {
      const int dq = kb - tq + 128;
      attn2_tile(st, qf, Kt, Vt, F.lane, [&](int, f32x16& p0, f32x16& p1) {
#pragma unroll
        for (int rr = 0; rr < 16; ++rr) { const int d0_ = dq + crow(rr, hi), d1_ = d0_ + 32;
          p0[rr] = ((unsigned)d0_ <= 256u) ? __builtin_amdgcn_exp2f(p0[rr]) : 0.f; p1[rr] = ((unsigned)d1_ <= 256u) ? __builtin_amdgcn_exp2f(p1[rr]) : 0.f; } }, after_k, before_v, after_v);
    } else attn2_tile(st, qf, Kt, Vt, F.lane, [](int, f32x16& p0, f32x16& p1) { exp_all(p0, p1); }, after_k, before_v, after_v);
  }
  AttnState fin;
  attn2_exchange(st, par, fin, F);
  const int hq = 2 * kvh + par;
  float l = fin.l + __shfl_xor(fin.l, 32);
  const float sk2 = opq(a.in[15])[layer * 4 + hq] * LOG2E;
  const float mnew = fmaxf(0.f, sk2), al = __builtin_amdgcn_exp2f(-mnew);
  l = l * al + __builtin_amdgcn_exp2f(sk2 - mnew);
  int qr = (int)qrow; asm volatile("" : "+v"(qr));
  attn_store(fin, al / l, PLB + (size_t)qr * PLW + S_CG * 256 + hq * 64, Y + (size_t)qr * 1024 + 512 + hq * 64, F.lane);
}
}

namespace mk {
constexpr int XT_STRIDE = 272;
constexpr int FFT_WC = 256 * XT_STRIDE;
__device__ __forceinline__ void fft_item(const Frame& F0, const Args& a, int item) {
  const Frame F = relaunder(F0);
  unsigned char* ws = opq(a.ws);
  const bf16* PLB = (const bf16*)(ws + WS_PLB); bf16* Y = (bf16*)(ws + WS_H);
  const int b = item >> 6, slice = item & 63, r32 = F.lane & 31, hi = F.lane >> 5, w = F.wave;
  LAS unsigned char* Xt = F.lds; LAS unsigned char* Wl = F.lds + FFT_WC;
  __syncthreads();
  u32x2 gv[8];
  {
    const bf16* WC = (const bf16*)(ws + WS_WC);
    u32x4 wt[4];
#pragma unroll
    for (int i = 0; i < 4; ++i) { const int idx = F.tid + 512 * i, row = idx >> 4, ch = idx & 15; wt[i] = *(const u32x4*)(WC + row * 128 + ch * 8); }
    const bf16* src = (const bf16*)(ws + WS_FA2) + ((size_t)b * 64 + slice) * TROW * 8;
#pragma unroll
    for (int i = 0; i < 8; ++i) gv[i] = *(const u32x2*)(PLB + ((size_t)b * SEQ + F.tid + 512 * i) * PLW + S_BG * 256 + 4 * slice);
    u32x4 v[8];
#pragma unroll
    for (int i = 0; i < 8; ++i) v[i] = *(const u32x4*)(src + (size_t)(F.lane + 64 * (8 * w + i)) * 8);
    __builtin_amdgcn_sched_barrier(0);
#pragma unroll
    for (int i = 0; i < 4; ++i) { const int idx = F.tid + 512 * i, row = idx >> 4, ch = idx & 15; *(LAS u32x4*)(Wl + row * XT_STRIDE + ch * 16) = wt[i]; }
#pragma unroll
    for (int cc = 0; cc < 4; ++cc)
#pragma unroll
      for (int part = 0; part < 2; ++part) { const int e = cc + 4 * part, d = e >> 1; const unsigned sel = (e & 1) ? 0x07060302u : 0x05040100u;
        u32x4 o;
        o.x = __builtin_amdgcn_perm(v[1][d], v[0][d], sel); o.y = __builtin_amdgcn_perm(v[3][d], v[2][d], sel);
        o.z = __builtin_amdgcn_perm(v[5][d], v[4][d], sel); o.w = __builtin_amdgcn_perm(v[7][d], v[6][d], sel);
        *(LAS u32x4*)(Xt + (64 * cc + F.lane) * XT_STRIDE + (part * 64 + 8 * w) * 2) = o; }
  }
  __syncthreads();
  f32x16 acc[4];
#pragma unroll
  for (int rb = 0; rb < 4; ++rb)
#pragma unroll
    for (int i = 0; i < 16; ++i) acc[rb][i] = 0.f;
  {
    bf16x8 bf[8];
#pragma unroll
    for (int s = 0; s < 8; ++s) bf[s] = *(LAS const bf16x8*)(Xt + (32 * w + r32) * XT_STRIDE + (16 * s + 8 * hi) * 2);
#pragma unroll
    for (int rb = 0; rb < 4; ++rb)
#pragma unroll
      for (int s = 0; s < 8; ++s) { const bf16x8 af = *(LAS const bf16x8*)(Wl + (32 * rb + r32) * XT_STRIDE + (16 * s + 8 * hi) * 2); acc[rb] = __builtin_amdgcn_mfma_f32_32x32x16_bf16(af, bf[s], acc[rb], 0, 0, 0); }
  }
  __syncthreads();
  {
    const int n2 = 32 * (w & 1) + r32, c = w >> 1;
#pragma unroll
    for (int rbp = 0; rbp < 2; ++rbp)
#pragma unroll
      for (int r = 0; r < 16; ++r) { const int k1 = 32 * rbp + crow(r, hi); float x = (float)((k1 * n2) & 4095) * (1.f / 4096.f);
        asm volatile("" : "+v"(x) :: "memory");
        const float tc = __builtin_amdgcn_cosf(x), ts = __builtin_amdgcn_sinf(x);
        const float yr = acc[rbp][r], yi = acc[rbp + 2][r];
        const float zr = yr * tc + yi * ts, zi = yi * tc - yr * ts;
        LAS unsigned char* zp = Xt + (k1 * 4 + c) * XT_STRIDE + n2 * 2;
        *(LAS unsigned short*)zp = (unsigned short)f2bf(zr); *(LAS unsigned short*)(zp + 128) = (unsigned short)f2bf(zi); }
  }
  __syncthreads();
  f32x16 o2[2];
#pragma unroll
  for (int rb = 0; rb < 2; ++rb)
#pragma unroll
    for (int i = 0; i < 16; ++i) o2[rb][i] = 0.f;
  {
    bf16x8 bf[8];
#pragma unroll
    for (int s = 0; s < 8; ++s) bf[s] = *(LAS const bf16x8*)(Xt + (32 * w + r32) * XT_STRIDE + (16 * s + 8 * hi) * 2);
#pragma unroll
    for (int rb = 0; rb < 2; ++rb)
#pragma unroll
      for (int s = 0; s < 8; ++s) { const bf16x8 af = *(LAS const bf16x8*)(Wl + (32 * rb + r32) * XT_STRIDE + (16 * s + 8 * hi) * 2); o2[rb] = __builtin_amdgcn_mfma_f32_32x32x16_bf16(af, bf[s], o2[rb], 0, 0, 0); }
  }
  __syncthreads();
  { const int k1 = 8 * w + (r32 >> 2), c = r32 & 3;
#pragma unroll
    for (int rb = 0; rb < 2; ++rb)
#pragma unroll
      for (int r = 0; r < 16; ++r) { const int k = k1 + 64 * (32 * rb + crow(r, hi)); *(LAS unsigned short*)(Xt + k * 8 + c * 2) = (unsigned short)f2bf(o2[rb][r]); }
  }
  __syncthreads();
  { const int o0 = 4 * slice;
#pragma unroll
    for (int i = 0; i < 8; ++i) { const int k = F.tid + 512 * i; const size_t row = (size_t)b * SEQ + k;
      const u32x2 ov = *(LAS const u32x2*)(Xt + k * 8);
      u32x2 y; y.x = pk2(__uint_as_float(ov.x << 16) * __uint_as_float(gv[i].x << 16), __uint_as_float(ov.x & 0xffff0000u) * __uint_as_float(gv[i].x & 0xffff0000u));
      y.y = pk2(__uint_as_float(ov.y << 16) * __uint_as_float(gv[i].y << 16), __uint_as_float(ov.y & 0xffff0000u) * __uint_as_float(gv[i].y & 0xffff0000u));
      *(u32x2*)(Y + row * 1024 + 256 + o0) = y; }
  }
}
constexpr int XC_STRIDE = 1040;
__device__ __forceinline__ void fftc_item(const Frame& F0, const Args& a, int item) {
  const Frame F = relaunder(F0);
  unsigned char* ws = opq(a.ws);
  const bf16* PLB = (const bf16*)(ws + WS_PLB); bf16* Y = (bf16*)(ws + WS_H);
  const bf16* CS = (const bf16*)(ws + WS_CS256);
  const int b = item >> 3, cs = item & 7, r32 = F.lane & 31, hi = F.lane >> 5, w = F.wave;
  LAS unsigned char* Xc = F.lds;
  __syncthreads();
  u32x4 vq[4];
#pragma unroll
  for (int i = 0; i < 4; ++i) { const int idx = F.tid + 512 * i, sl = idx >> 8, n = idx & 255;
    vq[i] = *(const u32x4*)((const bf16*)(ws + WS_FA2) + (((size_t)b * 64 + 8 * cs + sl) * TROW + SEQ + n) * 8); }
  __builtin_amdgcn_sched_barrier(0);
#pragma unroll
  for (int i = 0; i < 4; ++i) { const int idx = F.tid + 512 * i, sl = idx >> 8, n = idx & 255;
    const unsigned vv[4] = {vq[i].x, vq[i].y, vq[i].z, vq[i].w};
#pragma unroll
    for (int j = 0; j < 8; ++j) { const int c = j & 3, part = j >> 2; const unsigned short e = (unsigned short)((j & 1) ? (vv[j >> 1] >> 16) : (vv[j >> 1] & 0xffffu));
      *(LAS unsigned short*)(Xc + (4 * sl + c) * XC_STRIDE + (part * 256 + n) * 2) = e; } }
  __syncthreads();
  f32x16 acc;
#pragma unroll
  for (int i = 0; i < 16; ++i) acc[i] = 0.f;
#pragma unroll 1
  for (int s0 = 0; s0 < 32; s0 += 8) {
    bf16x8 af[8];
#pragma unroll
    for (int j = 0; j < 8; ++j) af[j] = *(const bf16x8*)(CS + (size_t)(32 * w + r32) * 512 + 16 * (s0 + j) + 8 * hi);
    __builtin_amdgcn_sched_barrier(0);
#pragma unroll
    for (int j = 0; j < 8; ++j) {
      const bf16x8 bf = *(LAS const bf16x8*)(Xc + r32 * XC_STRIDE + (16 * (s0 + j) + 8 * hi) * 2);
      acc = __builtin_amdgcn_mfma_f32_32x32x16_bf16(af[j], bf, acc, 0, 0, 0);
    }
  }
  const int o = 32 * cs + r32;
  bf16 gq[16];
#pragma unroll
  for (int r = 0; r < 16; ++r) { const size_t row = (size_t)MLAT + b * CTX + 32 * w + crow(r, hi); gq[r] = PLB[row * PLW + S_BG * 256 + o]; }
  __builtin_amdgcn_sched_barrier(0);
#pragma unroll
  for (int r = 0; r < 16; ++r) { const size_t row = (size_t)MLAT + b * CTX + 32 * w + crow(r, hi);
    Y[row * 1024 + 256 + o] = (bf16)f2bf(acc[r] * bf2f(gq[r])); }
}
}

namespace mk {
constexpr int GU_STRIDE = 2048 + 64;
constexpr size_t WS_GU = WS_SCR, WS_GS = WS_GU + (size_t)32 * 68 * GU_STRIDE * 4;
__device__ __forceinline__ size_t gla_row(int b, int c, int i) { return c < 64 ? (size_t)b * SEQ + 64 * c + i : (size_t)MLAT + b * CTX + 64 * (c - 64) + i; }
__device__ __forceinline__ int gla_pos(int c, int dir) { return c < 64 ? (dir ? 4 + 63 - c : 4 + c) : (dir ? 3 - (c - 64) : (c - 64)); }
__device__ __forceinline__ void gla_stage_v(const Frame& F, const bf16* PLB, int b, int c, LAS unsigned char* vbase) {
  const int key = F.tid >> 3, ch = F.tid & 7;
  const bf16* src = PLB + gla_row(b, c, key) * PLW + S_AV * 256 + ch * 8;
  const int vo = key * 128 + ((ch ^ (((key >> 1) & 1) << 2)) << 4);
  u32x4 t_[4];
#pragma unroll
  for (int h = 0; h < 4; ++h) t_[h] = *(const u32x4*)(src + h * 64);
#pragma unroll
  for (int h = 0; h < 4; ++h) *(LAS u32x4*)(vbase + h * 8192 + vo) = t_[h];
}
__device__ __forceinline__ void gla_cum(const float* LA, int b, int c, int h, int dir, int lane, float (&cw)[32], float& T) {
  const int d = lane & 31, half = lane >> 5;
  float a[32];
#pragma unroll
  for (int ii = 0; ii < 32; ++ii) a[ii] = LA[gla_row(b, c, 32 * half + ii) * 256 + dir * 128 + h * 32 + d];
  float run = 0.f;
#pragma unroll
  for (int ii = 0; ii < 32; ++ii) { run += a[ii]; cw[ii] = run; }
  const float other = __shfl_xor(run, 32);
  const float tot0 = half ? other : run;
  T = run + other;
#pragma unroll
  for (int ii = 0; ii < 32; ++ii) { const float cf = cw[ii] + (half ? tot0 : 0.f); cw[ii] = dir ? (T - cf + a[ii]) : cf; }
}
constexpr int KT_STRIDE = 144;
__device__ __forceinline__ void gla_local_item(const Frame& F0, const Args& a, int item) {
  const Frame F = relaunder(F0);
  unsigned char* ws = opq(a.ws);
  const bf16* PLB = (const bf16*)(ws + WS_PLB); const float* LA = (const float*)(ws + WS_LA);
  const int b = item / 68, c = item % 68, h = F.wave >> 1, dir = F.wave & 1, d = F.lane & 31, half = F.lane >> 5, r32 = d, hi = half;
  LAS unsigned char* Vt = F.lds + h * 8192; LAS unsigned char* KT = F.lds + 32768 + F.wave * (32 * KT_STRIDE);
  __syncthreads();
  gla_stage_v(F, PLB, b, c, F.lds);
  float cw[32], T;
  gla_cum(LA, b, c, h, dir, F.lane, cw, T);
  {
    unsigned pkd[16]; bf16 kr[32];
    const bf16* kp = PLB + gla_row(b, c, 32 * half) * PLW + S_AQK * 256 + 128 + h * 32 + d;
#pragma unroll
    for (int ii = 0; ii < 32; ++ii) kr[ii] = kp[(size_t)ii * PLW];
#pragma unroll
    for (int ii = 0; ii < 32; ii += 2) pkd[ii >> 1] = pk2(bf2f(kr[ii]) * __expf(T - cw[ii]), bf2f(kr[ii + 1]) * __expf(T - cw[ii + 1]));
#pragma unroll
    for (int q4 = 0; q4 < 4; ++q4) *(LAS u32x4*)(KT + d * KT_STRIDE + half * 64 + q4 * 16) = (u32x4){pkd[4 * q4], pkd[4 * q4 + 1], pkd[4 * q4 + 2], pkd[4 * q4 + 3]};
  }
  __syncthreads();
  f32x16 acc[2];
#pragma unroll
  for (int eb = 0; eb < 2; ++eb)
#pragma unroll
    for (int i = 0; i < 16; ++i) acc[eb][i] = 0.f;
  const int q = (F.lane & 15) >> 2, p = F.lane & 3, gsel = (F.lane >> 4) & 1;
  const int chb = 2 * gsel + (p >> 1);
#pragma unroll
  for (int st = 0; st < 4; ++st) {
    const bf16x8 kb = *(LAS const bf16x8*)(KT + r32 * KT_STRIDE + (16 * st + 8 * hi) * 2);
#pragma unroll
    for (int eb = 0; eb < 2; ++eb) {
      const int ch = ((chb | ((eb ^ (q >> 1)) << 2)) << 4);
      LAS const unsigned char* vp = Vt + (16 * st + 8 * hi + q) * 128 + 8 * (p & 1) + ch;
      const s16x4 lo = vtr(vp), hh = vtr(vp + 512);
      const bf16x8 va = (bf16x8){lo[0], lo[1], lo[2], lo[3], hh[0], hh[1], hh[2], hh[3]};
      acc[eb] = __builtin_amdgcn_mfma_f32_32x32x16_bf16(va, kb, acc[eb], 0, 0, 0);
    }
  }
  const int chain = (b * 4 + h) * 2 + dir, pos = gla_pos(c, dir);
  float* gu = (float*)(ws + WS_GU) + ((size_t)chain * 68 + pos) * GU_STRIDE;
#pragma unroll
  for (int eb = 0; eb < 2; ++eb)
#pragma unroll
    for (int r = 0; r < 16; ++r) gu[(32 * eb + crow(r, hi)) * 32 + r32] = acc[eb][r];
  if (half == 0) gu[2048 + d] = __expf(T);
}
__device__ __forceinline__ void gla_scan(const Frame& F0, const Args& a) {
  const Frame F = relaunder(F0);
  unsigned char* ws = opq(a.ws);
  if (F.tid >= 256) return;
  for (int gt = F.vcu * 256 + F.tid; gt < 32 * 2048; gt += F.G * 256) {
    const int chain = gt >> 11, el = gt & 2047, d = el & 31;
    const float* gu = (const float*)(ws + WS_GU) + (size_t)chain * 68 * GU_STRIDE;
    bf16* gs = (bf16*)(ws + WS_GS) + (size_t)chain * 68 * 2048 + el;
    float S = 0.f;
#pragma unroll 1
    for (int p0 = 0; p0 < 68; p0 += 34) {
      float dc[34], uu[34];
#pragma unroll
      for (int i = 0; i < 34; ++i) { dc[i] = gu[(size_t)(p0 + i) * GU_STRIDE + 2048 + d]; uu[i] = gu[(size_t)(p0 + i) * GU_STRIDE + el]; }
      __builtin_amdgcn_sched_barrier(0);
#pragma unroll
      for (int i = 0; i < 34; ++i) { gs[(size_t)(p0 + i) * 2048] = (bf16)f2bf(S); S = dc[i] * S + uu[i]; }
    }
  }
}
constexpr int QK_STRIDE = 80;
__device__ __forceinline__ void gla_out_item(const Frame& F0, const Args& a, int layer, int item) {
  const Frame F = relaunder(F0);
  unsigned char* ws = opq(a.ws);
  const bf16* PLB = (const bf16*)(ws + WS_PLB); const float* LA = (const float*)(ws + WS_LA); bf16* Y = (bf16*)(ws + WS_H);
  const int b = item / 68, c = item % 68, h = F.wave >> 1, dir = F.wave & 1, d = F.lane & 31, half = F.lane >> 5, r32 = d, hi = half;
  LAS unsigned char* Vt = F.lds + h * 8192;
  LAS unsigned char* QT = F.lds + 32768 + F.wave * (2 * 64 * QK_STRIDE); LAS unsigned char* KT = QT + 64 * QK_STRIDE;
  LAS float* X = (LAS float*)(F.lds + 32768) + h * 4096;
  __syncthreads();
  gla_stage_v(F, PLB, b, c, F.lds);
  {
    float cw[32], T;
    gla_cum(LA, b, c, h, dir, F.lane, cw, T);
    bf16 qr[32], kr[32];
    const bf16* pr = PLB + gla_row(b, c, 32 * half) * PLW + S_AQK * 256 + h * 32 + d;
#pragma unroll
    for (int ii = 0; ii < 32; ++ii) { qr[ii] = pr[(size_t)ii * PLW]; kr[ii] = pr[(size_t)ii * PLW + 128]; }
#pragma unroll
    for (int ii = 0; ii < 32; ++ii) { const int i = 32 * half + ii;
      const float ec = __expf(cw[ii]);
      *(LAS unsigned short*)(QT + i * QK_STRIDE + d * 2) = (unsigned short)f2bf(bf2f(qr[ii]) * ec);
      *(LAS unsigned short*)(KT + i * QK_STRIDE + d * 2) = (unsigned short)f2bf(bf2f(kr[ii]) * __builtin_amdgcn_rcpf(ec)); }
  }
  __syncthreads();
  f32x16 oacc[2][2];
#pragma unroll
  for (int eb = 0; eb < 2; ++eb)
#pragma unroll
    for (int ib = 0; ib < 2; ++ib)
#pragma unroll
      for (int i = 0; i < 16; ++i) oacc[eb][ib][i] = 0.f;
  bf16x8 qb[2][2];
#pragma unroll
  for (int ib = 0; ib < 2; ++ib)
#pragma unroll
    for (int st = 0; st < 2; ++st) qb[ib][st] = *(LAS const bf16x8*)(QT + (32 * ib + r32) * QK_STRIDE + (16 * st + 8 * hi) * 2);
  const int chain = (b * 4 + h) * 2 + dir, pos = gla_pos(c, dir);
  {
    const bf16* gs = (const bf16*)(ws + WS_GS) + ((size_t)chain * 68 + pos) * 2048;
#pragma unroll
    for (int eb = 0; eb < 2; ++eb)
#pragma unroll
      for (int st = 0; st < 2; ++st) { const bf16x8 sf = *(const bf16x8*)(gs + (32 * eb + r32) * 32 + 16 * st + 8 * hi);
#pragma unroll
        for (int ib = 0; ib < 2; ++ib) oacc[eb][ib] = __builtin_amdgcn_mfma_f32_32x32x16_bf16(sf, qb[ib][st], oacc[eb][ib], 0, 0, 0); }
  }
  const int q = (F.lane & 15) >> 2, p = F.lane & 3, gsel = (F.lane >> 4) & 1;
  const int vrow = (4 * hi + q) * 128 + 8 * (p & 1), chb = 2 * gsel + (p >> 1);
#pragma unroll
  for (int sb = 0; sb < 2; ++sb) {
    bf16x8 kf[2];
#pragma unroll
    for (int st = 0; st < 2; ++st) kf[st] = *(LAS const bf16x8*)(KT + (32 * sb + r32) * QK_STRIDE + (16 * st + 8 * hi) * 2);
#pragma unroll
    for (int ib = 0; ib < 2; ++ib) {
      const bool need = dir == 0 ? (sb <= ib) : (sb >= ib);
      if (!need) continue;
      f32x16 sc;
#pragma unroll
      for (int i = 0; i < 16; ++i) sc[i] = 0.f;
#pragma unroll
      for (int st = 0; st < 2; ++st) sc = __builtin_amdgcn_mfma_f32_32x32x16_bf16(kf[st], qb[ib][st], sc, 0, 0, 0);
      if (sb == ib) {
#pragma unroll
        for (int r = 0; r < 16; ++r) { const int s = crow(r, hi); const bool keep = dir == 0 ? (s <= r32) : (s >= r32); sc[r] = keep ? sc[r] : 0.f; }
      }
      u32x4 pw[2];
#pragma unroll
      for (int k = 0; k < 2; ++k) pw[k] = (u32x4){pk2(sc[8 * k + 0], sc[8 * k + 1]), pk2(sc[8 * k + 2], sc[8 * k + 3]), pk2(sc[8 * k + 4], sc[8 * k + 5]), pk2(sc[8 * k + 6], sc[8 * k + 7])};
#pragma unroll
      for (int ks = 0; ks < 2; ++ks)
#pragma unroll
        for (int eb = 0; eb < 2; ++eb) {
          const int ch = ((chb | ((eb ^ (q >> 1)) << 2)) << 4);
          const s16x4 lo = vtr(Vt + (2 * sb + ks) * 2048 + vrow + ch), hh = vtr(Vt + (2 * sb + ks) * 2048 + 1024 + vrow + ch);
          const bf16x8 va = (bf16x8){lo[0], lo[1], lo[2], lo[3], hh[0], hh[1], hh[2], hh[3]};
          oacc[eb][ib] = __builtin_amdgcn_mfma_f32_32x32x16_bf16(va, __builtin_bit_cast(bf16x8, pw[ks]), oacc[eb][ib], 0, 0, 0);
        }
    }
  }
  __syncthreads();
  if (dir == 1) {
#pragma unroll
    for (int eb = 0; eb < 2; ++eb)
#pragma unroll
      for (int ib = 0; ib < 2; ++ib)
#pragma unroll
        for (int r = 0; r < 16; ++r) X[((eb * 2 + ib) * 16 + r) * 64 + F.lane] = oacc[eb][ib][r];
  }
  __syncthreads();
  if (dir == 0) {
    const float* on = opq(a.in[11]) + layer * 64;
    f32x4 w4s[8];
#pragma unroll
    for (int i = 0; i < 8; ++i) w4s[i] = *(const f32x4*)(on + 32 * (i >> 2) + 8 * (i & 3) + 4 * hi);
#pragma unroll
    for (int ib = 0; ib < 2; ++ib) {
      float ss = 0.f;
#pragma unroll
      for (int eb = 0; eb < 2; ++eb)
#pragma unroll
        for (int r = 0; r < 16; ++r) { oacc[eb][ib][r] += X[((eb * 2 + ib) * 16 + r) * 64 + F.lane]; ss += oacc[eb][ib][r] * oacc[eb][ib][r]; }
      ss += __shfl_xor(ss, 32);
      const float rs = 1.0f / sqrtf(ss * (1.f / 64.f) + 1e-6f);
      const size_t row = gla_row(b, c, 32 * ib + r32);
      u32x2 gv8[8];
#pragma unroll
      for (int i = 0; i < 8; ++i) gv8[i] = *(const u32x2*)(PLB + row * PLW + S_AG * 256 + h * 64 + 32 * (i >> 2) + 8 * (i & 3) + 4 * hi);
      __builtin_amdgcn_sched_barrier(0);
#pragma unroll
      for (int eb = 0; eb < 2; ++eb)
#pragma unroll
        for (int gi = 0; gi < 4; ++gi) {
          const int e0 = 32 * eb + 8 * gi + 4 * hi;
          const f32x4 w4 = w4s[4 * eb + gi];
          const u32x2 gv = gv8[4 * eb + gi];
          const float g0 = __uint_as_float(gv.x << 16), g1 = __uint_as_float(gv.x & 0xffff0000u), g2 = __uint_as_float(gv.y << 16), g3 = __uint_as_float(gv.y & 0xffff0000u);
          u32x2 ov; ov.x = pk2(oacc[eb][ib][4 * gi + 0] * rs * w4[0] * g0, oacc[eb][ib][4 * gi + 1] * rs * w4[1] * g1);
          ov.y = pk2(oacc[eb][ib][4 * gi + 2] * rs * w4[2] * g2, oacc[eb][ib][4 * gi + 3] * rs * w4[3] * g3);
          *(u32x2*)(Y + row * 1024 + h * 64 + e0) = ov;
        }
    }
  }
}
}

namespace mk {
__device__ __forceinline__ void p3_mixers(const Frame& F0, const Args& a, int layer) {
  const Frame F = relaunder(F0);
  const int nx = 0, nswa = 256 + nx, nna = 256 + nx, nfc = 0;
  const int total = 272 + 256 + nfc + nswa + nna, K = F.vcu < total ? (total - F.vcu + F.G - 1) / F.G : 0;
  const int k0 = K > 0 ? (F.vcu * 8 / F.G) % K : 0;
  for (int j = 0; j < K; ++j) {
    int k = j + k0; if (k >= K) k -= K;
    const int it = F.vcu + F.G * k;
    int r = it;
    if (r < 272) { gla_local_item(F, a, r); continue; } r -= 272;
    if (r < 256) { fft_item(F, a, r); continue; } r -= 256;
    if (r < nfc) { fftc_item(F, a, r); continue; } r -= nfc;
    if (r < nswa) swa_item(F, a, layer, r); else na_item(F, a, layer, r - nswa);
  }
}
__device__ __forceinline__ void p4b_glaout(const Frame& F0, const Args& a, int layer) {
  const Frame F = relaunder(F0);
  if (layer == 1) { for (int it = F.vcu; it < 256; it += F.G) gla_out_item(F, a, layer, (it >> 6) * 68 + (it & 63)); }
  else {
    for (int it = F.vcu; it < 272; it += F.G) gla_out_item(F, a, layer, it);
    for (int e = (F.vcu + F.G - 16 % F.G) % F.G; e < 64; e += F.G) {
      if (e < 32) fftc_item(F, a, e); else if (e < 48) swa_item(F, a, 0, 256 + (e - 32)); else na_item(F, a, 0, 256 + (e - 48)); }
  }
}
}
#define XB_TMO      128
#define XB_XCNT(j)  (256  + 64 * (j))
#define XB_XSUB(j)  (1280 + 64 * (j))
#define XB_XGEN(j)  (2304 + 64 * (j))
#define XB_TOP      3328
#define XB_TOPGEN   3392
#define XCD_BAR_WORDS 3456
#define XB_SPIN_CAP (1u << 18)

__device__ __forceinline__ unsigned xb_ld(unsigned* p)              { return __hip_atomic_load(p, __ATOMIC_RELAXED, __HIP_MEMORY_SCOPE_AGENT); }
__device__ __forceinline__ unsigned xb_add(unsigned* p, unsigned v) { return __hip_atomic_fetch_add(p, v, __ATOMIC_RELAXED, __HIP_MEMORY_SCOPE_AGENT); }
__device__ __forceinline__ unsigned xb_xcc_id() { return (unsigned)__builtin_amdgcn_s_getreg((3 << 11) | 20) & 0xFu; }
#define XB_SPIN(cond, bar) do { unsigned _sp = 0; while (cond) { __builtin_amdgcn_s_sleep(1); \
    if ((++_sp & 255u) == 0u) { if (xb_ld(&(bar)[XB_TMO])) break; if (_sp > XB_SPIN_CAP) { atomicAdd(&(bar)[XB_TMO], 1u); break; } } } } while (0)

struct XcdBarrier {
    unsigned* bar; unsigned x;
    volatile LAS unsigned* st;
};

__device__ __forceinline__ XcdBarrier xcd_barrier_post(unsigned* bar, volatile LAS unsigned* st) {
    XcdBarrier b; b.bar = bar; b.x = xb_xcc_id(); b.st = st;
    if (threadIdx.x == 0) (void)xb_add(&bar[XB_XCNT(b.x)], 1u);
    return b;
}
__device__ __forceinline__ void xcd_barrier_complete(unsigned* bar, unsigned x, unsigned& nloc, unsigned& nx) {
    const unsigned G = gridDim.x * gridDim.y * gridDim.z;
    unsigned sum, cnt, mine, sp = 0u;
    for (;;) {
        sum = 0u; cnt = 0u; mine = 0u;
#pragma unroll
        for (unsigned j = 0; j < 16; ++j) { const unsigned c = xb_ld(&bar[XB_XCNT(j)]); sum += c; cnt += (c > 0u) ? 1u : 0u; }
        mine = xb_ld(&bar[XB_XCNT(x)]);
        if (sum == G) break;
        __builtin_amdgcn_s_sleep(1);
        if ((++sp & 255u) == 0u) { if (xb_ld(&bar[XB_TMO])) break; if (sp > XB_SPIN_CAP) { atomicAdd(&bar[XB_TMO], 1u); break; } }
    }
    nloc = mine > 0u ? mine : 1u; nx = cnt > 0u ? cnt : 1u;
}

__device__ __forceinline__ void xcd_barrier(const XcdBarrier& b) {
    asm volatile("s_waitcnt vmcnt(0)" ::: "memory");
    __syncthreads();
    if (threadIdx.x == 0) {
        unsigned* bar = b.bar;
        __builtin_amdgcn_s_waitcnt(0);
        unsigned nloc = b.st[0], nx = b.st[1];
        if (nloc == 0u) { xcd_barrier_complete(bar, b.x, nloc, nx); b.st[0] = nloc; b.st[1] = nx; }
        const unsigned old = xb_add(&bar[XB_XSUB(b.x)], 1u);
        const unsigned gen = old / nloc;
        if (old + 1u == (gen + 1u) * nloc) {
            __builtin_amdgcn_fence(__ATOMIC_RELEASE, "agent");
            asm volatile("s_waitcnt vmcnt(0)" ::: "memory");
            const unsigned og = xb_add(&bar[XB_TOP], 1u);
            const unsigned tg = og / nx;
            if (og + 1u == (tg + 1u) * nx) xb_add(&bar[XB_TOPGEN], 1u);
            else XB_SPIN(xb_ld(&bar[XB_TOPGEN]) == tg, bar);
            __builtin_amdgcn_fence(__ATOMIC_ACQUIRE, "agent");
            xb_add(&bar[XB_XGEN(b.x)], 1u);
            asm volatile("s_waitcnt vmcnt(0)" ::: "memory");
        } else {
            XB_SPIN(xb_ld(&bar[XB_XGEN(b.x)]) == gen, bar);
            __builtin_amdgcn_fence(__ATOMIC_ACQUIRE, "agent");
            asm volatile("s_waitcnt vmcnt(0)" ::: "memory");
        }
    }
    __syncthreads();
}

constexpr int LDS_BYTES = 163840, MISC_OFF = LDS_BYTES - 256;
constexpr int CW_BAR = 4096;
__global__ void __launch_bounds__(512, 2) mega(mk::Args a) {
  extern __shared__ __attribute__((aligned(16))) unsigned char lds[];
  mk::Frame F;
  F.lds = (LAS unsigned char*)lds;
  F.tid = threadIdx.x; F.lane = F.tid & 63; F.wave = __builtin_amdgcn_readfirstlane(F.tid >> 6);
  F.G = gridDim.x; { const int bx = blockIdx.x; F.vcu = (F.G % 8 == 0) ? (bx % 8) * (F.G / 8) + bx / 8 : bx; }
  volatile LAS unsigned* MISC = (volatile LAS unsigned*)(F.lds + MISC_OFF);
  if (F.tid < 64) MISC[F.tid] = 0u;
  __syncthreads();
  XcdBarrier bar; bar.bar = nullptr; bar.x = 0; bar.st = nullptr;
  const bool multi = (a.ph_hi - a.ph_lo) > 1;
  if (multi) bar = xcd_barrier_post((unsigned*)(a.ws + mk::WS_CTL) + CW_BAR, MISC + 8);
#pragma clang loop unroll(disable)
  for (int ph = a.ph_lo; ph < a.ph_hi; ++ph) {
    if (ph == 0) mk::p0_prologue(F, a);
    else {
      const int layer = (ph - 1) / 6, sub = (ph - 1) % 6;
      if (sub == 0) mk::p1_prenorm(F, a, layer);
      else if (sub == 1) mk::p2_inproj(F, a, layer);
      else if (sub == 2) mk::p3_mixers(F, a, layer);
      else if (sub == 3) mk::gla_scan(F, a);
      else if (sub == 4) mk::p4b_glaout(F, a, layer);
      else mk::p5_outproj(F, a, layer);
    }
    if (ph + 1 < a.ph_hi) xcd_barrier(bar);
  }
}

extern "C" void kernel_launch(void* const* d_in, const int* in_sizes, int n_in, void* d_out, int out_size, void* d_ws, size_t ws_size, hipStream_t stream) {
  using namespace mk;
  static int grid = 0;
  if (grid == 0) {
    int dev = 0, cus = 0, per_cu = 0; (void)hipGetDevice(&dev); (void)hipDeviceGetAttribute(&cus, hipDeviceAttributeMultiprocessorCount, dev);
    (void)hipFuncSetAttribute((const void*)mega, hipFuncAttributeMaxDynamicSharedMemorySize, LDS_BYTES);
    if (hipOccupancyMaxActiveBlocksPerMultiprocessor(&per_cu, (const void*)mega, 512, LDS_BYTES) != hipSuccess || per_cu < 1) per_cu = 1;
    (void)hipGetLastError();
    grid = (cus > 0 ? cus : 256) * (per_cu < 1 ? 1 : 1);
  }
  (void)hipMemsetAsync((char*)d_ws + WS_CTL, 0, CTL_BYTES, stream);
  Args a{};
  for (int i = 0; i < 19; ++i) a.in[i] = (const float*)d_in[i];
  a.out = (float*)d_out; a.ws = (unsigned char*)d_ws;
  a.ph_lo = 0; a.ph_hi = 13;
  void* args[] = {&a};
  if (hipLaunchCooperativeKernel((const void*)mega, dim3(grid), dim3(512), args, LDS_BYTES, stream) != hipSuccess) {
    (void)hipGetLastError();
    hipLaunchKernelGGL(mega, dim3(grid), dim3(512), LDS_BYTES, stream, a);
  }
}
```

```cpp
#include <hip/hip_runtime.h>
#include <math.h>
#include <stdint.h>

namespace pg8 {
#define PG8_LAS __attribute__((address_space(3)))
typedef unsigned short bf16_t;
typedef short bf16x8 __attribute__((ext_vector_type(8)));
typedef float f32x4 __attribute__((ext_vector_type(4)));
typedef unsigned u32x4 __attribute__((ext_vector_type(4)));
constexpr int BM = 256, BK = 64, HALF = 128, HTB = HALF * BK * 2  , STAGE_BYTES = 8 * HTB, NXCD = 8, WGM = 8;

__host__ __device__ __forceinline__ int lds_byte(int r, int c) { const int st = (r >> 4) * 2 + (c >> 5), rr = r & 15, cc = c & 31, ob = rr * 64 + cc * 2; return st * 1024 + (ob ^ (((ob >> 9) & 1) << 5)); }
__host__ __device__ __forceinline__ void stage_rc(int b, int& R, int& C) { const int st = b / 1024, sb = b % 1024, swz = sb ^ (((sb >> 9) & 1) << 5); R = (st >> 1) * 16 + swz / 64; C = (st & 1) * 32 + (swz % 64) / 2; }
__host__ __device__ __forceinline__ int perm32(int rho) { const int n = rho >> 4, i = rho & 15; return 8 * (i >> 2) + 4 * n + (i & 3); }

struct Unit { int pm, pn; };
struct Gemm { const bf16_t* A; const bf16_t* Bt; int M, N, K; };

struct StaticOrder {
    int nM, nN, nwg, G, c;
    __host__ __device__ void init(int M, int N, int G_, int c_) { nM = M / BM; nN = N / BM; nwg = nM * nN; G = G_; c = c_; }
    __host__ __device__ bool next(int i, Unit& u) const {
        const long L = (long)i * G + c; if (L >= nwg) return false;
        int wgid = (int)L; { const int q = nwg / NXCD, r = nwg % NXCD, xcd = wgid % NXCD, off = wgid / NXCD; wgid = (xcd < r ? xcd * (q + 1) : r * (q + 1) + (xcd - r) * q) + off; }
        const int nig = WGM * nN, gid = wgid / nig, fm = gid * WGM, gsz = (nM - fm) < WGM ? (nM - fm) : WGM;
        u.pm = fm + ((wgid % nig) % gsz); u.pn = (wgid % nig) / gsz; return true;
    }
    __device__ __forceinline__ void a_ready(const Unit&) const {}
    __device__ __forceinline__ void done(const Unit&) const {}
};

template <class Epi, class Sched, bool STAMP = false>
__device__ __forceinline__ void gemm_phase(PG8_LAS unsigned char* lds, const Gemm g, const Sched& S, const Epi& E, unsigned long long* stamps) {
    int tid_ = threadIdx.x; asm volatile("" : "+v"(tid_));
    const int tid = tid_, wid = __builtin_amdgcn_readfirstlane(tid >> 6), lane = tid & 63, wr = wid >> 2, wc = wid & 3, fr = lane & 15, fq = lane >> 4;
    const int K = g.K, nt = K / BK;
    int ts_lo = 0, ts_hi = 0, nts = 0; const unsigned long long rt_entry = STAMP ? (unsigned long long)wall_clock64() : 0ull;
#define PG8_STAMP() do { if (STAMP && wid == 0 && nts < 64) { const unsigned long long _c = (unsigned long long)clock64(); \
        ts_lo = (lane == nts) ? (int)(unsigned)_c : ts_lo; ts_hi = (lane == nts) ? (int)(unsigned)(_c >> 32) : ts_hi; ++nts; } } while (0)
    PG8_STAMP();
    unsigned voffA[2], voffB[2];
#pragma unroll
    for (int i = 0; i < 2; ++i) { int R, C; stage_rc(tid * 16 + i * 8192, R, C); const int Rb = Epi::PERM ? ((R & ~31) + perm32(R & 31)) : R;
        voffA[i] = (unsigned)(R * K + C) * 2u; voffB[i] = (unsigned)(Rb * K + C) * 2u; }
    const size_t kstep = (size_t)(BK * 2);
    const size_t hstep = (size_t)HALF * K * 2;
    const size_t tstep = 2 * hstep;
    const unsigned ldsw = (unsigned)wid * 1024u;
    const int aoff = lds_byte(wr * 64 + fr, fq * 8), boff = lds_byte(wc * 32 + fr, fq * 8);
#define PG8_SA(b, h) (((b) * 2 + (h)) * HTB)
#define PG8_SB(b, h) ((4 + (b) * 2 + (h)) * HTB)
#define PG8_STAGE(bufoff, gbase, voff) do { _Pragma("unroll") for (int _i = 0; _i < 2; ++_i) \
        __builtin_amdgcn_global_load_lds((const unsigned*)((const char*)(gbase) + (voff)[_i]), (PG8_LAS unsigned*)(lds + (bufoff) + ldsw + _i * 8192), 16, 0, 0); } while (0)
#define PG8_LDA(dst, b, h) do { _Pragma("unroll") for (int m = 0; m < 4; ++m) _Pragma("unroll") for (int k = 0; k < 2; ++k) dst[m][k] = *(const PG8_LAS bf16x8*)(lds + PG8_SA(b, h) + aoff + m * 2048 + k * 1024); } while (0)
#define PG8_LDB(dst, b, h) do { _Pragma("unroll") for (int n = 0; n < 2; ++n) _Pragma("unroll") for (int k = 0; k < 2; ++k) dst[n][k] = *(const PG8_LAS bf16x8*)(lds + PG8_SB(b, h) + boff + n * 2048 + k * 1024); } while (0)
#define PG8_MMA(ai, bj, At, Bt) do { __builtin_amdgcn_s_setprio(1); _Pragma("unroll") for (int m = 0; m < 4; ++m) _Pragma("unroll") for (int n = 0; n < 2; ++n) _Pragma("unroll") for (int k = 0; k < 2; ++k) \
        acc[ai][bj][m][n] = __builtin_amdgcn_mfma_f32_16x16x32_bf16(Bt[n][k], At[m][k], acc[ai][bj][m][n], 0, 0, 0); __builtin_amdgcn_s_setprio(0); } while (0)
#define PG8_WAIT_V(n) asm volatile("s_waitcnt vmcnt(" #n ")" ::: "memory")
#define PG8_WAIT_L(n) asm volatile("s_waitcnt lgkmcnt(" #n ")" ::: "memory")
#define PG8_BAR __builtin_amdgcn_s_barrier()
#define PG8_SCHED __builtin_amdgcn_sched_barrier(0)
    Unit cur, nxt; int ui = 0;
    if (!S.next(0, cur)) return;
    f32x4 acc[2][2][4][2];
#pragma unroll
    for (int a = 0; a < 2; ++a)
#pragma unroll
        for (int b = 0; b < 2; ++b)
#pragma unroll
            for (int m = 0; m < 4; ++m)
#pragma unroll
                for (int n = 0; n < 2; ++n) acc[a][b][m][n] = (f32x4){0.f, 0.f, 0.f, 0.f};
    bf16x8 At[4][2], B0[2][2], B1[2][2];
    const char* cA = (const char*)g.A + (size_t)cur.pm * tstep; const char* cB = (const char*)g.Bt + (size_t)cur.pn * tstep;
    S.a_ready(cur);
    PG8_STAGE(PG8_SB(0, 0), cB, voffB); PG8_STAGE(PG8_SA(0, 0), cA, voffA); PG8_STAGE(PG8_SB(0, 1), cB + hstep, voffB); PG8_STAGE(PG8_SA(0, 1), cA + hstep, voffA);
    if (wr == 1) PG8_BAR;
    PG8_WAIT_V(4); PG8_BAR;
    PG8_STAGE(PG8_SB(1, 0), cB + kstep, voffB); PG8_STAGE(PG8_SA(1, 0), cA + kstep, voffA); PG8_STAGE(PG8_SB(1, 1), cB + hstep + kstep, voffB);
    PG8_WAIT_V(6); PG8_BAR;
    PG8_STAMP();
    for (;;) {
        const bool has_next = S.next(ui + 1, nxt);
        const char* nA = has_next ? (const char*)g.A + (size_t)nxt.pm * tstep : cA; const char* nB = has_next ? (const char*)g.Bt + (size_t)nxt.pn * tstep : cB;
        for (int t = 0; t < nt; t += 2) {
            const bool last = (t == nt - 2);
            const char* a1 = cA + (size_t)(t + 1) * kstep;
            const char* a2 = last ? nA : cA + (size_t)(t + 2) * kstep; const char* b2 = last ? nB : cB + (size_t)(t + 2) * kstep;
            const char* a3 = a2 + kstep; const char* b3 = b2 + kstep;
            if (last && has_next) S.a_ready(nxt);
            PG8_LDB(B0, 0, 0); PG8_SCHED; PG8_LDA(At, 0, 0); PG8_STAGE(PG8_SA(1, 1), a1 + hstep, voffA);
            PG8_WAIT_L(8); PG8_BAR; PG8_WAIT_L(0); PG8_MMA(0, 0, At, B0); PG8_BAR; PG8_SCHED;
            PG8_LDB(B1, 0, 1); PG8_STAGE(PG8_SB(0, 0), b2, voffB);
            PG8_BAR; PG8_WAIT_L(0); PG8_MMA(0, 1, At, B1); PG8_BAR;
            PG8_LDA(At, 0, 1); PG8_STAGE(PG8_SA(0, 0), a2, voffA);
            PG8_BAR; PG8_WAIT_L(0); PG8_MMA(1, 0, At, B0); PG8_BAR; PG8_SCHED;
            PG8_STAGE(PG8_SB(0, 1), b2 + hstep, voffB);
            PG8_WAIT_V(6); PG8_BAR; PG8_MMA(1, 1, At, B1); PG8_BAR;
            PG8_LDB(B0, 1, 0); PG8_SCHED; PG8_LDA(At, 1, 0); PG8_STAGE(PG8_SA(0, 1), a2 + hstep, voffA);
            PG8_WAIT_L(8); PG8_BAR; PG8_WAIT_L(0); PG8_MMA(0, 0, At, B0); PG8_BAR; PG8_SCHED;
            PG8_LDB(B1, 1, 1); PG8_STAGE(PG8_SB(1, 0), b3, voffB);
            PG8_BAR; PG8_WAIT_L(0); PG8_MMA(0, 1, At, B1); PG8_BAR;
            PG8_LDA(At, 1, 1); PG8_STAGE(PG8_SA(1, 0), a3, voffA);
            PG8_BAR; PG8_WAIT_L(0); PG8_MMA(1, 0, At, B0); PG8_BAR; PG8_SCHED;
            PG8_STAGE(PG8_SB(1, 1), b3 + hstep, voffB);
            PG8_WAIT_V(6); PG8_BAR; PG8_MMA(1, 1, At, B1); PG8_BAR;
        }
        PG8_STAMP();
        if constexpr (!Epi::AFTER_DRAIN) { E(acc, cur, wr, wc, fr, fq); S.done(cur); }
        PG8_STAMP();
        if (!has_next) break;
#pragma unroll
        for (int a = 0; a < 2; ++a)
#pragma unroll
            for (int b = 0; b < 2; ++b)
#pragma unroll
                for (int m = 0; m < 4; ++m)
#pragma unroll
                    for (int n = 0; n < 2; ++n) acc[a][b][m][n] = (f32x4){0.f, 0.f, 0.f, 0.f};
        cur = nxt; cA = nA; cB = nB; ++ui;
    }
    PG8_WAIT_V(0);
    if (wr == 0) PG8_BAR;
    PG8_BAR;
    if constexpr (Epi::AFTER_DRAIN) { E.fused(acc, cur, wr, wc, fr, fq, lds, wid, lane); S.done(cur); }
    PG8_STAMP();
    if (STAMP && wid == 0) { stamps[lane] = lane < nts ? (((unsigned long long)(unsigned)ts_hi << 32) | (unsigned)ts_lo) : 0ull;
        if (lane == 62) stamps[62] = rt_entry; if (lane == 63) stamps[63] = (unsigned long long)wall_clock64(); }
#undef PG8_STAMP
#undef PG8_SA
#undef PG8_SB
#undef PG8_STAGE
#undef PG8_LDA
#undef PG8_LDB
#undef PG8_MMA
#undef PG8_WAIT_V
#undef PG8_WAIT_L
#undef PG8_BAR
#undef PG8_SCHED
}
}

namespace mk {
#define LAS __attribute__((address_space(3)))
typedef unsigned short bf16;
typedef float f32x4 __attribute__((ext_vector_type(4)));
typedef float f32x16 __attribute__((ext_vector_type(16)));
typedef unsigned u32x4 __attribute__((ext_vector_type(4)));
typedef unsigned u32x2 __attribute__((ext_vector_type(2)));
typedef short bf16x8 __attribute__((ext_vector_type(8)));
typedef short s16x4 __attribute__((ext_vector_type(4)));

constexpr int D = 1024, NB = 4, SEQ = 4096, CTX = 256, PWW = 3360;
constexpr int MLAT = NB * SEQ, MT = MLAT + NB * CTX;
constexpr int NT1 = 14, N1 = NT1 * 256;
constexpr int NSLOT = 11, PLW = NSLOT * 256;
constexpr int TROW = SEQ + CTX;
constexpr int O_AQ = 0, O_AK = 128, O_AV = 256, O_AG = 512, O_LR = 768, O_BV = 800, O_BG = 1056, O_CQ = 1312, O_CK = 1568, O_CV = 1696,
              O_CG = 1824, O_DQ = 2080, O_DK = 2336, O_DV = 2592, O_DG = 2848;
constexpr int S_AQK = 0, S_AV = 1, S_AG = 2, S_BG = 3, S_CQ = 4, S_CKV = 5, S_CG = 6, S_DQ = 7, S_DK = 8, S_DV = 9, S_DG = 10;
constexpr float LOG2E = 1.4426950408889634f, QSCALE = 0.125f * LOG2E, GLA_QS = 0.17677669529663687f;

constexpr size_t WS_CTL = 0, CTL_BYTES = 65536;
constexpr size_t WS_MOD = WS_CTL + CTL_BYTES;
constexpr size_t WS_ROPE = WS_MOD + 2 * 5 * 3072 * 4;
constexpr size_t WS_WC = WS_ROPE + 2 * 64 * 16 * 4;
constexpr size_t WS_CS256 = WS_WC + 128 * 128 * 2;
constexpr size_t WS_W1T = 1u << 20;
constexpr size_t WS_W2T = WS_W1T + (size_t)2 * N1 * D * 2;
constexpr size_t WS_H = WS_W2T + (size_t)2 * D * D * 2;
constexpr size_t WS_PLB = WS_H + (size_t)MT * D * 2;
constexpr size_t WS_LA = WS_PLB + (size_t)MT * PLW * 2;
constexpr size_t WS_FA2 = WS_LA + (size_t)MT * 256 * 4;
constexpr size_t WS_CTX1 = WS_FA2 + (size_t)NB * 64 * TROW * 8 * 2;
constexpr size_t WS_SCR = WS_CTX1 + (size_t)NB * CTX * D * 4;
static_assert(WS_CS256 + 256 * 512 * 2 <= WS_W1T, "tables");

__device__ __forceinline__ float bf2f(bf16 v) { return __uint_as_float(((unsigned)v) << 16); }
__device__ __forceinline__ unsigned f2bf(float f) { unsigned u = __float_as_uint(f); return (u + 0x7fffu + ((u >> 16) & 1u)) >> 16; }
typedef float f32x2_t __attribute__((ext_vector_type(2))); typedef __bf16 bf16x2_t __attribute__((ext_vector_type(2)));
__device__ __forceinline__ unsigned pk2(float lo, float hi) { const f32x2_t v = {lo, hi}; const bf16x2_t b = __builtin_convertvector(v, bf16x2_t); return __builtin_bit_cast(unsigned, b); }
__device__ __forceinline__ float wave_sum(float v) {
#pragma unroll
  for (int o = 1; o < 64; o <<= 1) v += __shfl_xor(v, o);
  return v;
}
__device__ __forceinline__ float fsilu(float x) { return x * __builtin_amdgcn_rcpf(1.f + __expf(-x)); }
__device__ __forceinline__ float flogsig(float x) { return fminf(x, 0.f) - __logf(1.f + __expf(-fabsf(x))); }

#define GAS __attribute__((address_space(1)))
template <class T> __device__ __forceinline__ T* opq(T* p) { GAS T* g = (GAS T*)p; asm volatile("" : "+s"(g)); return (T*)g; }
__device__ __forceinline__ int crow(int r, int hi) { return (r & 3) + 8 * (r >> 2) + 4 * hi; }
struct Args {
  const float* in[19]; float* out; unsigned char* ws; int ph_lo, ph_hi;
};
struct Frame {
  int tid, lane, wave, vcu, G;
  LAS unsigned char* lds;
};
__device__ __forceinline__ Frame relaunder(const Frame& F0) {
  Frame F = F0; F.tid = threadIdx.x; asm volatile("" : "+v"(F.tid)); F.lane = F.tid & 63; asm volatile("" : "+s"(F.wave), "+s"(F.vcu), "+s"(F.G)); return F; }
}

namespace mk {
__device__ __forceinline__ void p0_ada_item(const Frame& F, const Args& a, int item) {
  LAS float* s = (LAS float*)F.lds; LAS float* red = s + 5 * 1024;
  const float* c = opq(a.in[1]); const float* cc = opq(a.in[3]);
  for (int i = F.tid; i < 5 * 1024; i += 512) { const int r = i >> 10, k = i & 1023; const float v = r < 4 ? c[r * 1024 + k] : cc[k]; s[i] = v / (1.f + expf(-v)); }
  __syncthreads();
  const int kp = F.tid / 24, cl = F.tid % 24;
  const int gcol = item * 24 + cl, l = gcol / 3072, col = gcol % 3072;
  if (kp < 21) {
    const float* w = opq(a.in[5]) + (size_t)l * 1024 * 3072 + col;
    float acc[5] = {0.f, 0.f, 0.f, 0.f, 0.f};
#pragma unroll 1
    for (int kb = 0; kb < 2; ++kb) {
      float wv[25];
#pragma unroll
      for (int j = 0; j < 25; ++j) { const int k = kp + 21 * (25 * kb + j); wv[j] = w[(size_t)(k < 1024 ? k : 1023) * 3072]; }
      __builtin_amdgcn_sched_barrier(0);
#pragma unroll
      for (int j = 0; j < 25; ++j) { const int k = kp + 21 * (25 * kb + j); const int kc = k < 1024 ? k : 1023; const float wz = k < 1024 ? wv[j] : 0.f;
#pragma unroll
        for (int r = 0; r < 5; ++r) acc[r] += s[r * 1024 + kc] * wz; }
    }
#pragma unroll
    for (int r = 0; r < 5; ++r) red[(kp * 24 + cl) * 5 + r] = acc[r];
  }
  __syncthreads();
  if (F.tid < 120) {
    const int cl2 = F.tid / 5, r = F.tid % 5; float t = 0.f;
    for (int q = 0; q < 21; ++q) t += red[(q * 24 + cl2) * 5 + r];
    const int g2 = item * 24 + cl2, l2 = g2 / 3072, col2 = g2 % 3072;
    float* MOD = (float*)(opq(a.ws) + WS_MOD);
    MOD[((size_t)l2 * 5 + r) * 3072 + col2] = t + opq(a.in[6])[l2 * 3072 + col2];
  }
  __syncthreads();
}
__device__ __forceinline__ int rope_perm(int n) { return 16 * ((n >> 2) & 1) + 4 * (n >> 3) + (n & 3); }
__device__ __forceinline__ void p0_tr_item(const float* W, int ldw, int cbase, int permkind, float scale, bf16* dst, int k0, LAS float* scr, int lane) {
  { float t_[32];
#pragma unroll
    for (int i = 0; i < 32; ++i) t_[i] = W[(size_t)(k0 + 2 * i + (lane >> 5)) * ldw + cbase + (lane & 31)];
#pragma unroll
    for (int i = 0; i < 32; ++i) scr[(2 * i + (lane >> 5)) * 33 + (lane & 31)] = t_[i]; }
  asm volatile("s_waitcnt lgkmcnt(0)" ::: "memory");
  const int c = lane & 7;
#pragma unroll
  for (int j = 0; j < 4; ++j) { const int n = (lane >> 3) + 8 * j; const int sidx = permkind ? rope_perm(n) : n; const LAS float* sp = scr + (8 * c) * 33 + sidx;
    u32x4 o; o.x = pk2(sp[0 * 33] * scale, sp[1 * 33] * scale); o.y = pk2(sp[2 * 33] * scale, sp[3 * 33] * scale); o.z = pk2(sp[4 * 33] * scale, sp[5 * 33] * scale); o.w = pk2(sp[6 * 33] * scale, sp[7 * 33] * scale);
    *(u32x4*)(dst + (size_t)n * 1024 + k0 + 8 * c) = o; }
  asm volatile("s_waitcnt lgkmcnt(0)" ::: "memory");
}
__device__ __forceinline__ void p0_la_item(const float* Win, const float* decw  , int dir, int j0, bf16* dst, int k0, LAS float* scr, int lane) {
  float dw[16];
#pragma unroll
  for (int r = 0; r < 16; ++r) dw[r] = decw[(dir * 16 + r) * 128 + j0 + (lane & 31)];
#pragma unroll 4
  for (int i = 0; i < 32; ++i) { const int kk = 2 * i + (lane >> 5); const float* wp = Win + (size_t)(k0 + kk) * PWW + O_LR + dir * 16; float acc = 0.f;
#pragma unroll
    for (int r = 0; r < 16; ++r) acc += wp[r] * dw[r];
    scr[kk * 33 + (lane & 31)] = acc; }
  asm volatile("s_waitcnt lgkmcnt(0)" ::: "memory");
  const int c = lane & 7;
#pragma unroll
  for (int j = 0; j < 4; ++j) { const int n = (lane >> 3) + 8 * j; const LAS float* sp = scr + (8 * c) * 33 + n;
    u32x4 o; o.x = pk2(sp[0 * 33], sp[1 * 33]); o.y = pk2(sp[2 * 33], sp[3 * 33]); o.z = pk2(sp[4 * 33], sp[5 * 33]); o.w = pk2(sp[6 * 33], sp[7 * 33]);
    *(u32x4*)(dst + (size_t)n * 1024 + k0 + 8 * c) = o; }
  asm volatile("s_waitcnt lgkmcnt(0)" ::: "memory");
}
constexpr int FA_AST = 528, FA_WST = 528;
__device__ __forceinline__ void p0_fa_item(const Frame& F, const Args& a, int item, int kb0, int kb1) {
  const int l = item >> 4, pn = 4 + ((item >> 3) & 1), g32 = item & 7, bj = g32 >> 2, wc = g32 & 3;
  LAS float* cs = (LAS float*)F.lds; LAS float* sn = cs + 64; LAS float* wfl = sn + 64;
  LAS unsigned char* Ai = F.lds + 512 + 16384;
  LAS unsigned char* Wi = F.lds + F.wave * (32 * FA_WST);
  __syncthreads();
  if (F.tid < 64) { float s_, c_; sincospif(2.f * F.tid / 64.f, &s_, &c_); cs[F.tid] = c_; sn[F.tid] = s_; }
  const float* wf = opq(a.in[12]) + (size_t)l * 256 * 256;
  const int slice0 = 32 * (pn - 4) + 16 * bj + 4 * wc;
  for (int i = F.tid; i < 1024; i += 512) { const int r = i >> 2, q = i & 3; *(LAS f32x4*)(wfl + r * 16 + 4 * q) = *(const f32x4*)(wf + (size_t)r * 256 + 4 * slice0 + 4 * q); }
  __syncthreads();
  {
    const int c = F.tid & 255, part = F.tid >> 8, g = c >> 6, jj = c & 63;
    f32x4 acc[4];
#pragma unroll
    for (int q = 0; q < 4; ++q) acc[q] = (f32x4){0.f, 0.f, 0.f, 0.f};
#pragma unroll 4
    for (int m = 0; m < 64; ++m) { const int idx = (m * jj) & 63; const float t = part ? -sn[idx] : cs[idx];
#pragma unroll
      for (int q = 0; q < 4; ++q) acc[q] += t * *(LAS const f32x4*)(wfl + (g * 64 + m) * 16 + 4 * q); }
#pragma unroll
    for (int fq = 0; fq < 4; ++fq)
#pragma unroll
      for (int j = 0; j < 4; ++j) *(LAS unsigned short*)(Ai + (8 * fq + 4 * part + j) * FA_AST + c * 2) = (unsigned short)f2bf(acc[fq][j] * 0.125f);
  }
  __syncthreads();
  const int r32 = F.lane & 31, hi = F.lane >> 5;
  bf16x8 af[16];
#pragma unroll
  for (int s = 0; s < 16; ++s) af[s] = *(LAS const bf16x8*)(Ai + r32 * FA_AST + (16 * s + 8 * hi) * 2);
  __syncthreads();
  const float* Win = opq(a.in[7]) + (size_t)l * 1024 * PWW + O_BV;
  bf16* dst = (bf16*)(opq(a.ws) + WS_W1T) + ((size_t)l * N1 + pn * 256 + 32 * g32) * 1024;
  for (int kb = kb0; kb < kb1; ++kb) {
    const int k0 = F.wave * 128 + kb * 32;
#pragma unroll
    for (int rh = 0; rh < 2; ++rh) { f32x4 w[16];
#pragma unroll
      for (int r = 0; r < 16; ++r) w[r] = *(const f32x4*)(Win + (size_t)(k0 + 16 * rh + r) * PWW + 4 * F.lane);
#pragma unroll
      for (int r = 0; r < 16; ++r) *(LAS u32x2*)(Wi + (16 * rh + r) * FA_WST + 8 * F.lane) = (u32x2){pk2(w[r].x, w[r].y), pk2(w[r].z, w[r].w)}; }
    asm volatile("s_waitcnt lgkmcnt(0)" ::: "memory");
    f32x16 acc;
#pragma unroll
    for (int i = 0; i < 16; ++i) acc[i] = 0.f;
#pragma unroll
    for (int s = 0; s < 16; ++s) { const bf16x8 bfr = *(LAS const bf16x8*)(Wi + r32 * FA_WST + (16 * s + 8 * hi) * 2); acc = __builtin_amdgcn_mfma_f32_32x32x16_bf16(af[s], bfr, acc, 0, 0, 0); }
#pragma unroll
    for (int r = 0; r < 16; ++r) dst[(size_t)crow(r, hi) * 1024 + k0 + r32] = (bf16)f2bf(acc[r]);
    asm volatile("s_waitcnt lgkmcnt(0)" ::: "memory");
  }
  __syncthreads();
}
constexpr int I_DIR = 11 * 8 * 16, I_LA = 8 * 16, I_W2 = 32 * 16, I_L = I_DIR + I_LA + I_W2;
static_assert(I_L == 2048, "wave-level items per layer");
__device__ __forceinline__ void p0_wave_item(const Frame& F, const Args& a, int it, LAS float* scr) {
  unsigned char* ws = opq(a.ws);
  const int l = it / I_L; int r = it % I_L;
  const float* Win = opq(a.in[7]) + (size_t)l * 1024 * PWW;
  bf16* W1T = (bf16*)(ws + WS_W1T) + (size_t)l * N1 * 1024;
  if (r < I_DIR) {
    const int ti = r / 128, g32 = (r >> 4) & 7, kb = r & 15;
    const int pn = ti < 3 ? ti : ti + 3;
    const int bj = g32 >> 2, wc = g32 & 3, mcb = 64 * wc + 32 * bj;
    int cbase = 0, pk = 0; float sc = 1.f;
    switch (pn) {
      case 0: if (mcb < 128) { cbase = O_AQ + mcb; sc = GLA_QS; } else cbase = O_AK + mcb - 128; break;
      case 1: cbase = O_AV + mcb; break;
      case 2: cbase = O_AG + mcb; break;
      case 6: cbase = O_BG + mcb; break;
      case 7: cbase = O_CQ + mcb; pk = 1; break;
      case 8: if (wc < 2) { cbase = O_CK + mcb; pk = 1; } else cbase = O_CV + mcb - 128; break;
      case 9: cbase = O_CG + mcb; break;
      case 10: cbase = O_DQ + mcb; break;
      case 11: cbase = O_DK + mcb; break;
      case 12: cbase = O_DV + mcb; break;
      default: cbase = O_DG + mcb; break;
    }
    p0_tr_item(Win, PWW, cbase, pk, sc, W1T + (size_t)(pn * 256 + 32 * g32) * 1024, kb * 64, scr, F.lane);
  } else if (r < I_DIR + I_LA) {
    r -= I_DIR; const int g32 = r >> 4, kb = r & 15, bj = g32 >> 2, wc = g32 & 3, mcb = 64 * wc + 32 * bj;
    p0_la_item(Win, opq(a.in[9]) + (size_t)l * 2 * 16 * 128, mcb >> 7, mcb & 127, W1T + (size_t)(3 * 256 + 32 * g32) * 1024, kb * 64, scr, F.lane);
  } else {
    r -= I_DIR + I_LA; const int g = r >> 4, kb = r & 15;
    p0_tr_item(opq(a.in[8]) + (size_t)l * 1024 * 1024, 1024, 32 * g, 0, 1.f, (bf16*)(ws + WS_W2T) + ((size_t)l * 1024 + 32 * g) * 1024, kb * 64, scr, F.lane);
  }
}
__device__ __forceinline__ bool p0_split(const Frame& F) { return F.G == 256; }
__device__ __forceinline__ void p0_prep_layer1(const Frame& F0, const Args& a, int j  ) {
  const Frame F = relaunder(F0);
  LAS float* scr = (LAS float*)(F.lds + F.wave * 16384);
  for (int it = I_L + j * 8 + F.wave; it < 2 * I_L; it += 72 * 8) p0_wave_item(F, a, it, scr);
  __syncthreads();
}
__device__ __forceinline__ void p0_prologue(const Frame& F0, const Args& a) {
 {
  const Frame F = relaunder(F0);
  unsigned char* ws = opq(a.ws);
  { const int gt = F.vcu * 512 + F.tid, GT = F.G * 512;
    float* rope = (float*)(ws + WS_ROPE);
    for (int i = gt; i < 1024; i += GT) { const int pos = i >> 4, f = i & 15; const float ang = (float)pos * powf(10000.f, -(float)f / 16.f); rope[i] = cosf(ang); rope[1024 + i] = sinf(ang); }
    bf16* wc = (bf16*)(ws + WS_WC);
    for (int i = gt; i < 128 * 128; i += GT) { const int r = i >> 7, c = i & 127, rr = r & 63, cc = c & 63; float s_, c_; sincospif(2.f * (float)((rr * cc) & 63) / 64.f, &s_, &c_);
      float v; if (r < 64) v = c < 64 ? c_ : s_; else v = c < 64 ? -s_ : c_; wc[i] = (bf16)f2bf(v * 0.125f); }
    bf16* cs256 = (bf16*)(ws + WS_CS256);
    for (int i = gt; i < 256 * 512; i += GT) { const int k = i >> 9, n = i & 511, nn = n & 255; float s_, c_; sincospif(2.f * (float)((k * nn) & 255) / 256.f, &s_, &c_); cs256[i] = (bf16)f2bf((n < 256 ? c_ : s_) * 0.0625f); }
  }
  LAS float* scr = (LAS float*)(F.lds + F.wave * 16384);
  if (p0_split(F)) {
    p0_ada_item(F, a, F.vcu);
    if (F.vcu < 128) p0_fa_item(F, a, F.vcu >> 2, F.vcu & 3, (F.vcu & 3) + 1);
    else for (int it = (F.vcu - 128) * 8 + F.wave; it < I_L; it += 128 * 8) p0_wave_item(F, a, it, scr);
  } else {
    for (int it = F.vcu; it < 256 + 32; it += F.G) { if (it < 256) p0_ada_item(F, a, it); else p0_fa_item(F, a, it - 256, 0, 4); }
    for (int it = F.vcu * 8 + F.wave; it < 2 * I_L; it += F.G * 8) p0_wave_item(F, a, it, scr);
  }
 }
}
__device__ __forceinline__ void p1_prenorm(const Frame& F0, const Args& a, int layer) {
  const Frame F = relaunder(F0);
  const float* xin = layer == 0 ? opq(a.in[0]) : opq(a.out);
  const float* cin = layer == 0 ? opq(a.in[2]) : (const float*)(opq(a.ws) + WS_CTX1);
  const float* nw = opq(a.in[4]) + layer * 1024;
  const float* MOD = (const float*)(opq(a.ws) + WS_MOD) + (size_t)layer * 5 * 3072;
  bf16* H = (bf16*)(opq(a.ws) + WS_H);
  const int gw = F.vcu * 8 + F.wave, NGW = F.G * 8;
  constexpr int RB = 3;
  f32x4 w_[4];
#pragma unroll
  for (int j = 0; j < 4; ++j) w_[j] = *(const f32x4*)(nw + 4 * F.lane + 256 * j);
  for (int row0 = gw; row0 < MT; row0 += RB * NGW) {
    f32x4 v[RB][4], sc_[RB][4], sh_[RB][4]; float ss[RB];
#pragma unroll
    for (int q = 0; q < RB; ++q) { int row = row0 + q * NGW; row = row < MT ? row : MT - 1;
      const float* src; const float* mod;
      if (row < MLAT) { src = xin + (size_t)row * 1024; mod = MOD + (size_t)(row >> 12) * 3072; }
      else { src = cin + (size_t)(row - MLAT) * 1024; mod = MOD + (size_t)4 * 3072; }
      const f32x4* xr = (const f32x4*)src + F.lane;
#pragma unroll
      for (int j = 0; j < 4; ++j) { v[q][j] = xr[64 * j]; sc_[q][j] = *(const f32x4*)(mod + 1024 + 4 * F.lane + 256 * j); sh_[q][j] = *(const f32x4*)(mod + 4 * F.lane + 256 * j); } }
    __builtin_amdgcn_sched_barrier(0);
#pragma unroll
    for (int q = 0; q < RB; ++q) { float s_ = 0.f;
#pragma unroll
      for (int j = 0; j < 4; ++j) s_ += (v[q][j].x * v[q][j].x + v[q][j].y * v[q][j].y) + (v[q][j].z * v[q][j].z + v[q][j].w * v[q][j].w);
      ss[q] = s_; }
#pragma unroll
    for (int o = 1; o < 64; o <<= 1)
#pragma unroll
      for (int q = 0; q < RB; ++q) ss[q] += __shfl_xor(ss[q], o);
#pragma unroll
    for (int q = 0; q < RB; ++q) { const int row = row0 + q * NGW; if (row >= MT) continue;
      const float rs = 1.0f / sqrtf(ss[q] * (1.f / 1024.f) + 1e-6f);
      unsigned long long* o8 = (unsigned long long*)(H + (size_t)row * 1024) + F.lane;
#pragma unroll
      for (int j = 0; j < 4; ++j) {
        const f32x4 h = v[q][j] * rs * w_[j] * (1.f + sc_[q][j]) + sh_[q][j];
        o8[64 * j] = (unsigned long long)pk2(h.x, h.y) | ((unsigned long long)pk2(h.z, h.w) << 32);
      } }
  }
}
}

namespace mk {
using pg8::Unit;
struct EpiIn {
  static constexpr bool PERM = true, AFTER_DRAIN = false;
  bf16* PLB; float* LA; bf16* FA2; LAS const float* rope;
  __device__ __forceinline__ void operator()(const f32x4 (&acc)[2][2][4][2], const Unit& u, int wr, int wc, int fr, int fq) const {
    const int pn = u.pn;
    const bool ctxrows = u.pm >= 64;
    int kind, slot = 0; LAS const float* nw = rope; bool roped = false; float qs = 1.f;
    LAS const float* cqn = rope + 2048; LAS const float* ckn = rope + 2112; LAS const float* dqn = rope + 2176; LAS const float* dkn = rope + 2240; LAS const float* decb = rope + 2304;
    switch (pn) {
      case 0: kind = 0; slot = S_AQK; break;
      case 1: kind = 0; slot = S_AV; break;
      case 2: kind = 1; slot = S_AG; break;
      case 3: kind = 2; break;
      case 4: case 5: kind = 3; break;
      case 6: kind = 1; slot = S_BG; break;
      case 7: kind = 4; slot = S_CQ; nw = cqn; roped = true; qs = QSCALE; break;
      case 8: slot = S_CKV; if (wc < 2) { kind = 4; nw = ckn; roped = true; } else kind = 0; break;
      case 9: kind = 1; slot = S_CG; break;
      case 10: kind = 4; slot = S_DQ; nw = dqn; qs = QSCALE; break;
      case 11: kind = 4; slot = S_DK; nw = dkn; break;
      case 12: kind = 0; slot = S_DV; break;
      default: kind = 1; slot = S_DG; break;
    }
    const int row0 = u.pm * 256 + wr * 64 + fr;
    float w8[2][8];
    if (kind == 4) {
#pragma unroll
      for (int bj = 0; bj < 2; ++bj)
#pragma unroll
        for (int s = 0; s < 8; ++s) { const int d = roped ? (32 * bj + 16 * (s >> 2) + 4 * fq + (s & 3)) : (32 * bj + 8 * fq + s); w8[bj][s] = nw[d] * qs; }
    } else if (kind == 2) {
#pragma unroll
      for (int bj = 0; bj < 2; ++bj)
#pragma unroll
        for (int s = 0; s < 8; ++s) w8[bj][s] = decb[64 * wc + 32 * bj + 8 * fq + s];
    }
#pragma unroll
    for (int ai = 0; ai < 2; ++ai) {
      float rsr[4];
      if (kind == 4) {
#pragma unroll
        for (int m = 0; m < 4; ++m) { float s_ = 0.f;
#pragma unroll
          for (int bj = 0; bj < 2; ++bj)
#pragma unroll
            for (int n = 0; n < 2; ++n) { const f32x4 t = acc[ai][bj][m][n]; s_ += (t.x * t.x + t.y * t.y) + (t.z * t.z + t.w * t.w); }
          rsr[m] = s_; }
#pragma unroll
        for (int o = 16; o < 64; o <<= 1)
#pragma unroll
          for (int m = 0; m < 4; ++m) rsr[m] += __shfl_xor(rsr[m], o);
#pragma unroll
        for (int m = 0; m < 4; ++m) rsr[m] = __builtin_amdgcn_rsqf(rsr[m] * (1.f / 64.f) + 1e-6f);
      }
#pragma unroll
      for (int m = 0; m < 4; ++m) {
        const int r = row0 + ai * 128 + m * 16;
        float v[2][8];
#pragma unroll
        for (int bj = 0; bj < 2; ++bj)
#pragma unroll
          for (int n = 0; n < 2; ++n)
#pragma unroll
            for (int e = 0; e < 4; ++e) v[bj][4 * n + e] = acc[ai][bj][m][n][e];
        if (kind == 2) {
#pragma unroll
          for (int bj = 0; bj < 2; ++bj) { const int mc = 64 * wc + 32 * bj + 8 * fq; float* dp = LA + (size_t)r * 256 + mc;
            f32x4 o0, o1;
#pragma unroll
            for (int e = 0; e < 4; ++e) { o0[e] = flogsig(v[bj][e] + w8[bj][e]) * 0.0625f; o1[e] = flogsig(v[bj][4 + e] + w8[bj][4 + e]) * 0.0625f; }
            *(f32x4*)dp = o0; *(f32x4*)(dp + 4) = o1; }
        } else if (kind == 3) {
          int b, t; if (!ctxrows) { b = r >> 12; t = r & 4095; } else { const int rc = r - MLAT; b = rc >> 8; t = SEQ + (rc & 255); }
#pragma unroll
          for (int bj = 0; bj < 2; ++bj) { const int slice = 32 * (pn - 4) + 16 * bj + 4 * wc + fq;
            u32x4 o; o.x = pk2(v[bj][0], v[bj][1]); o.y = pk2(v[bj][2], v[bj][3]); o.z = pk2(v[bj][4], v[bj][5]); o.w = pk2(v[bj][6], v[bj][7]);
            *(u32x4*)(FA2 + (((size_t)b * 64 + slice) * TROW + t) * 8) = o; }
        } else {
          if (kind == 1) {
#pragma unroll
            for (int bj = 0; bj < 2; ++bj)
#pragma unroll
              for (int s = 0; s < 8; ++s) v[bj][s] = fsilu(v[bj][s]);
          } else if (kind == 4) {
            const float rs = rsr[m];
#pragma unroll
            for (int bj = 0; bj < 2; ++bj)
#pragma unroll
              for (int s = 0; s < 8; ++s) v[bj][s] *= rs * w8[bj][s];
            if (roped && !ctxrows) {
              const int t = r & 4095;
#pragma unroll
              for (int bj = 0; bj < 2; ++bj) { const int pos = bj == 0 ? (t >> 6) : (t & 63);
                const f32x4 c4 = *(LAS const f32x4*)(rope + pos * 16 + 4 * fq), s4 = *(LAS const f32x4*)(rope + 1024 + pos * 16 + 4 * fq);
#pragma unroll
                for (int e = 0; e < 4; ++e) { const float x1 = v[bj][e], x2 = v[bj][4 + e]; v[bj][e] = x1 * c4[e] - x2 * s4[e]; v[bj][4 + e] = x2 * c4[e] + x1 * s4[e]; } }
            }
          }
#pragma unroll
          for (int bj = 0; bj < 2; ++bj) { const int mc = 64 * wc + 32 * bj + 8 * fq;
            u32x4 o; o.x = pk2(v[bj][0], v[bj][1]); o.y = pk2(v[bj][2], v[bj][3]); o.z = pk2(v[bj][4], v[bj][5]); o.w = pk2(v[bj][6], v[bj][7]);
            *(u32x4*)(PLB + (size_t)r * PLW + slot * 256 + mc) = o; }
        }
        asm volatile("" ::: "memory");
      }
    }
  }
};
struct EpiOut {
  static constexpr bool PERM = true, AFTER_DRAIN = false;
  const float* xin; const float* cin; float* xout; float* cout; const float* MODl;
  __device__ __forceinline__ void operator()(const f32x4 (&acc)[2][2][4][2], const Unit& u, int wr, int wc, int fr_, int fq_) const {
    int fr = fr_, fq = fq_; asm volatile("" : "+v"(fr), "+v"(fq));
    const int row0 = u.pm * 256 + wr * 64 + fr, col0 = u.pn * 256 + wc * 32 + 8 * fq;
    const bool ctxrows = u.pm >= 64;
    const float* gate = MODl + (size_t)(ctxrows ? 4 : (u.pm >> 4)) * 3072 + 2048;
    f32x4 gv[2][2];
#pragma unroll
    for (int bj = 0; bj < 2; ++bj)
#pragma unroll
      for (int n = 0; n < 2; ++n) gv[bj][n] = *(const f32x4*)(gate + col0 + bj * 128 + n * 4);
    const float* sp0; float* dp0;
    if (!ctxrows) { sp0 = xin + (size_t)row0 * 1024 + col0; dp0 = xout + (size_t)row0 * 1024 + col0; }
    else { sp0 = cin + (size_t)(row0 - MLAT) * 1024 + col0; dp0 = cout + (size_t)(row0 - MLAT) * 1024 + col0; }
#pragma unroll
    for (int ai = 0; ai < 2; ++ai) {
      f32x4 xv[4][2][2];
#pragma unroll
      for (int m = 0; m < 4; ++m)
#pragma unroll
        for (int bj = 0; bj < 2; ++bj)
#pragma unroll
          for (int n = 0; n < 2; ++n) xv[m][bj][n] = *(const f32x4*)(sp0 + (size_t)(ai * 128 + m * 16) * 1024 + bj * 128 + n * 4);
      __builtin_amdgcn_sched_barrier(0);
#pragma unroll
      for (int m = 0; m < 4; ++m)
#pragma unroll
        for (int bj = 0; bj < 2; ++bj)
#pragma unroll
          for (int n = 0; n < 2; ++n) *(f32x4*)(dp0 + (size_t)(ai * 128 + m * 16) * 1024 + bj * 128 + n * 4) = xv[m][bj][n] + gv[bj][n] * acc[ai][bj][m][n];
      asm volatile("" ::: "memory");
    }
  }
};
struct InOrder {
  pg8::StaticOrder S;
  static constexpr unsigned long long PACK = 0x3c817d9b0a5246ull;
  __device__ __forceinline__ bool next(int i, Unit& u) const { const bool ok = S.next(i, u); if (ok) u.pn = (int)((PACK >> (4 * u.pn)) & 15ull); return ok; }
  __device__ __forceinline__ void a_ready(const Unit&) const {}
  __device__ __forceinline__ void done(const Unit&) const {}
};
__device__ __forceinline__ void p2_inproj(const Frame& F, const Args& a, int layer) {
  unsigned char* ws = opq(a.ws);
  pg8::Gemm g{(const pg8::bf16_t*)(ws + WS_H), (const pg8::bf16_t*)(ws + WS_W1T) + (size_t)layer * N1 * 1024, MT, N1, 1024};
  InOrder S; S.S.init(MT, N1, F.G, (int)blockIdx.x);
  { Unit u_; if (!S.next(3, u_)) {
      if (layer == 0 && p0_split(F)) p0_prep_layer1(F, a, (int)blockIdx.x - (MT / 256 * (N1 / 256) - 3 * 256));
      else for (int i = 0; i < 3; ++i) __builtin_amdgcn_s_sleep(127); } }
  LAS float* ropeL = (LAS float*)(F.lds + pg8::STAGE_BYTES);
  { int tid = threadIdx.x; asm volatile("" : "+v"(tid)); const f32x4 t = *(const f32x4*)((const float*)(ws + WS_ROPE) + 4 * tid); *(LAS f32x4*)(ropeL + 4 * tid) = t;
    if (tid < 128) {
      const float* n0 = opq(a.in[13]); const float* n1 = opq(a.in[14]); const float* n2 = opq(a.in[16]); const float* n3 = opq(a.in[17]); const float* db = opq(a.in[10]);
      const int k = tid >> 4; const float* src = tid < 64 ? (k == 0 ? n0 : k == 1 ? n1 : k == 2 ? n2 : n3) + layer * 64 + 4 * (tid & 15) : db + layer * 256 + 4 * (tid - 64);
      *(LAS f32x4*)(ropeL + 2048 + 4 * tid) = *(const f32x4*)src; } }
  __syncthreads();
  EpiIn E{(bf16*)(ws + WS_PLB), (float*)(ws + WS_LA), (bf16*)(ws + WS_FA2), ropeL};
  pg8::gemm_phase<EpiIn, InOrder>(F.lds, g, S, E, nullptr);
}

constexpr int CO_ST = 528;
constexpr int CO_OP = 64 * CO_ST, CO_BUF = 2 * CO_OP;
__device__ __forceinline__ void ctx_out_item(const Frame& F, const Args& a, int item) {
  unsigned char* ws = opq(a.ws);
  const bf16* Yc = (const bf16*)(ws + WS_H) + (size_t)MLAT * 1024; const bf16* W2 = (const bf16*)(ws + WS_W2T);
  const int tm = item >> 4, tn = item & 15, sub = F.wave & 3, kh = F.wave >> 2, r32 = F.lane & 31, hi = F.lane >> 5;
  const int row0 = 64 * tm + 32 * (sub >> 1), col0 = 64 * tn + 32 * (sub & 1);
  const int srow = F.tid >> 5, sc16 = F.tid & 31;
  const bf16* ag = Yc + (size_t)(64 * tm + srow) * 1024 + sc16 * 8; const bf16* bg = W2 + (size_t)(64 * tn + srow) * 1024 + sc16 * 8;
  LAS unsigned char* sdst = F.lds + srow * CO_ST + sc16 * 16;
  f32x16 acc;
#pragma unroll
  for (int i = 0; i < 16; ++i) acc[i] = 0.f;
  LAS const unsigned char* afp = F.lds + (32 * (sub >> 1) + r32) * CO_ST + (128 * kh + 8 * hi) * 2;
  LAS const unsigned char* bfp = F.lds + CO_OP + (32 * (sub & 1) + r32) * CO_ST + (128 * kh + 8 * hi) * 2;
  u32x4 st[2][2][4];
#pragma unroll
  for (int cp = 0; cp < 2; ++cp)
#pragma unroll
    for (int p = 0; p < 4; ++p) { st[cp][0][p] = *(const u32x4*)(ag + (size_t)(16 * p) * 1024 + cp * 256); st[cp][1][p] = *(const u32x4*)(bg + (size_t)(16 * p) * 1024 + cp * 256); }
  __syncthreads();
#pragma unroll 1
  for (int pair = 0; pair < 2; ++pair) {
#pragma unroll
    for (int cp = 0; cp < 2; ++cp)
#pragma unroll
      for (int p = 0; p < 4; ++p) { *(LAS u32x4*)(sdst + cp * CO_BUF + (16 * p) * CO_ST) = st[cp][0][p]; *(LAS u32x4*)(sdst + cp * CO_BUF + CO_OP + (16 * p) * CO_ST) = st[cp][1][p]; }
    __syncthreads();
    if (pair == 0) {
#pragma unroll
      for (int cp = 0; cp < 2; ++cp)
#pragma unroll
        for (int p = 0; p < 4; ++p) { st[cp][0][p] = *(const u32x4*)(ag + (size_t)(16 * p) * 1024 + (2 + cp) * 256); st[cp][1][p] = *(const u32x4*)(bg + (size_t)(16 * p) * 1024 + (2 + cp) * 256); }
    }
#pragma unroll
    for (int cp = 0; cp < 2; ++cp)
#pragma unroll
      for (int s = 0; s < 8; ++s) {
        const bf16x8 af = *(LAS const bf16x8*)(afp + cp * CO_BUF + s * 32), bf = *(LAS const bf16x8*)(bfp + cp * CO_BUF + s * 32);
        acc = __builtin_amdgcn_mfma_f32_32x32x16_bf16(af, bf, acc, 0, 0, 0);
      }
    __syncthreads();
  }
  LAS float* X = (LAS float*)F.lds + sub * 1024;
  __syncthreads();
  if (kh == 1) {
#pragma unroll
    for (int r = 0; r < 16; ++r) X[r * 64 + F.lane] = acc[r];
  }
  __syncthreads();
  if (kh == 0) {
    const float* cin = opq(a.in[2]); float* cout = (float*)(ws + WS_CTX1);
    const float gate = ((const float*)(ws + WS_MOD))[4 * 3072 + 2048 + col0 + r32];
    float ci[16];
#pragma unroll
    for (int r = 0; r < 16; ++r) ci[r] = cin[(size_t)(row0 + crow(r, hi)) * 1024 + col0 + r32];
    __builtin_amdgcn_sched_barrier(0);
#pragma unroll
    for (int r = 0; r < 16; ++r) { const size_t o = (size_t)(row0 + crow(r, hi)) * 1024 + col0 + r32; cout[o] = ci[r] + gate * (acc[r] + X[r * 64 + F.lane]); }
  }
}
__device__ __forceinline__ void p5_outproj(const Frame& F, const Args& a, int layer) {
  unsigned char* ws = opq(a.ws);
  const int M = MLAT;
  pg8::Gemm g{(const pg8::bf16_t*)(ws + WS_H), (const pg8::bf16_t*)(ws + WS_W2T) + (size_t)layer * 1024 * 1024, M, 1024, 1024};
  pg8::StaticOrder S; S.init(M, 1024, F.G, (int)blockIdx.x);
  EpiOut E{layer == 0 ? opq(a.in[0]) : opq(a.out), layer == 0 ? opq(a.in[2]) : (const float*)(ws + WS_CTX1), opq(a.out), (float*)(ws + WS_CTX1), (const float*)(ws + WS_MOD) + (size_t)layer * 5 * 3072};
  const bool ctx_first = layer == 0 && (F.vcu & 1);
  if (ctx_first) { const Frame F2 = relaunder(F); for (int it = F2.vcu; it < 256; it += F2.G) ctx_out_item(F2, a, it); __syncthreads(); }
  pg8::gemm_phase<EpiOut, pg8::StaticOrder>(F.lds, g, S, E, nullptr);
  if (layer == 0 && !ctx_first) { const Frame F2 = relaunder(F); for (int it = F2.vcu; it < 256; it += F2.G) ctx_out_item(F2, a, it); }
}
}

namespace mk {
typedef short v4i16_t __attribute__((ext_vector_type(4)));
__device__ __forceinline__ s16x4 vtr(LAS const unsigned char* p) { return __builtin_bit_cast(s16x4, __builtin_amdgcn_ds_read_tr16_b64_v4i16((LAS v4i16_t*)p)); }
struct AttnState { float m, l; f32x16 o0, o1; };
template <class MaskF>
__device__ __forceinline__ void attn_tile(AttnState& st, const bf16x8 (&qf)[4], LAS const unsigned char* Kt, LAS const unsigned char* Vt, int lane, MaskF&& maskf) {
  const int r32 = lane & 31, hi = lane >> 5;
  f32x16 p0, p1;
  const int ksw = (r32 >> 1) & 7;
  bf16x8 ka[4], kb[4];
#pragma unroll
  for (int s = 0; s < 4; ++s) { const int ch = ((2 * s + hi) ^ ksw) << 4; ka[s] = *(LAS const bf16x8*)(Kt + r32 * 128 + ch); kb[s] = *(LAS const bf16x8*)(Kt + (32 + r32) * 128 + ch); }
  { const f32x16 z = {0.f, 0.f, 0.f, 0.f, 0.f, 0.f, 0.f, 0.f, 0.f, 0.f, 0.f, 0.f, 0.f, 0.f, 0.f, 0.f};
    p0 = __builtin_amdgcn_mfma_f32_32x32x16_bf16(ka[0], qf[0], z, 0, 0, 0); p1 = __builtin_amdgcn_mfma_f32_32x32x16_bf16(kb[0], qf[0], z, 0, 0, 0); }
#pragma unroll
  for (int s = 1; s < 4; ++s) { p0 = __builtin_amdgcn_mfma_f32_32x32x16_bf16(ka[s], qf[s], p0, 0, 0, 0); p1 = __builtin_amdgcn_mfma_f32_32x32x16_bf16(kb[s], qf[s], p1, 0, 0, 0); }
  maskf(p0, p1);
  float ps = 0.f;
#pragma unroll
  for (int i = 0; i < 16; ++i) { p0[i] = __builtin_amdgcn_exp2f(p0[i]); p1[i] = __builtin_amdgcn_exp2f(p1[i]); ps += p0[i] + p1[i]; }
  st.l += ps;
  u32x4 pw[4];
#pragma unroll
  for (int k = 0; k < 2; ++k) {
    pw[k] = (u32x4){pk2(p0[8 * k + 0], p0[8 * k + 1]), pk2(p0[8 * k + 2], p0[8 * k + 3]), pk2(p0[8 * k + 4], p0[8 * k + 5]), pk2(p0[8 * k + 6], p0[8 * k + 7])};
    pw[2 + k] = (u32x4){pk2(p1[8 * k + 0], p1[8 * k + 1]), pk2(p1[8 * k + 2], p1[8 * k + 3]), pk2(p1[8 * k + 4], p1[8 * k + 5]), pk2(p1[8 * k + 6], p1[8 * k + 7])};
  }
  const int q = (lane & 15) >> 2, p = lane & 3, gsel = (lane >> 4) & 1;
  const int vrow = (4 * hi + q) * 128 + 8 * (p & 1);
  const int chb = 2 * gsel + (p >> 1);
#pragma unroll
  for (int ks = 0; ks < 4; ++ks) {
    const int c0_ = ((chb | ((0 ^ (q >> 1)) << 2)) << 4), c1_ = ((chb | ((1 ^ (q >> 1)) << 2)) << 4);
    const s16x4 l0 = vtr(Vt + ks * 2048 + vrow + c0_), h0 = vtr(Vt + ks * 2048 + 1024 + vrow + c0_), l1 = vtr(Vt + ks * 2048 + vrow + c1_), h1 = vtr(Vt + ks * 2048 + 1024 + vrow + c1_);
    const bf16x8 va0 = (bf16x8){l0[0], l0[1], l0[2], l0[3], h0[0], h0[1], h0[2], h0[3]}, va1 = (bf16x8){l1[0], l1[1], l1[2], l1[3], h1[0], h1[1], h1[2], h1[3]};
    st.o0 = __builtin_amdgcn_mfma_f32_32x32x16_bf16(va0, __builtin_bit_cast(bf16x8, pw[ks]), st.o0, 0, 0, 0);
    st.o1 = __builtin_amdgcn_mfma_f32_32x32x16_bf16(va1, __builtin_bit_cast(bf16x8, pw[ks]), st.o1, 0, 0, 0);
  }
}
template <class MaskF, class F1, class F2, class F3>
__device__ __forceinline__ void attn_tile_dma(AttnState& st, const bf16x8 (&qf)[4], LAS const unsigned char* Kt, LAS const unsigned char* Vt, int lane, MaskF&& maskf, F1&& after_k, F2&& before_v, F3&& after_v) {
  const int r32 = lane & 31, hi = lane >> 5;
  f32x16 p0, p1;
  const int ksw = (r32 >> 1) & 7;
  bf16x8 ka[4], kb[4];
#pragma unroll
  for (int s = 0; s < 4; ++s) { const int ch = ((2 * s + hi) ^ ksw) << 4; ka[s] = *(LAS const bf16x8*)(Kt + r32 * 128 + ch); kb[s] = *(LAS const bf16x8*)(Kt + (32 + r32) * 128 + ch); }
  asm volatile("s_waitcnt lgkmcnt(0)" ::: "memory");
  after_k();
  { const f32x16 z = {0.f, 0.f, 0.f, 0.f, 0.f, 0.f, 0.f, 0.f, 0.f, 0.f, 0.f, 0.f, 0.f, 0.f, 0.f, 0.f};
    p0 = __builtin_amdgcn_mfma_f32_32x32x16_bf16(ka[0], qf[0], z, 0, 0, 0); p1 = __builtin_amdgcn_mfma_f32_32x32x16_bf16(kb[0], qf[0], z, 0, 0, 0); }
#pragma unroll
  for (int s = 1; s < 4; ++s) { p0 = __builtin_amdgcn_mfma_f32_32x32x16_bf16(ka[s], qf[s], p0, 0, 0, 0); p1 = __builtin_amdgcn_mfma_f32_32x32x16_bf16(kb[s], qf[s], p1, 0, 0, 0); }
  maskf(p0, p1);
  float ps = 0.f;
#pragma unroll
  for (int i = 0; i < 16; ++i) { p0[i] = __builtin_amdgcn_exp2f(p0[i]); p1[i] = __builtin_amdgcn_exp2f(p1[i]); ps += p0[i] + p1[i]; }
  st.l += ps;
  u32x4 pw[4];
#pragma unroll
  for (int k = 0; k < 2; ++k) {
    pw[k] = (u32x4){pk2(p0[8 * k + 0], p0[8 * k + 1]), pk2(p0[8 * k + 2], p0[8 * k + 3]), pk2(p0[8 * k + 4], p0[8 * k + 5]), pk2(p0[8 * k + 6], p0[8 * k + 7])};
    pw[2 + k] = (u32x4){pk2(p1[8 * k + 0], p1[8 * k + 1]), pk2(p1[8 * k + 2], p1[8 * k + 3]), pk2(p1[8 * k + 4], p1[8 * k + 5]), pk2(p1[8 * k + 6], p1[8 * k + 7])};
  }
  before_v();
  const int q = (lane & 15) >> 2, p = lane & 3, gsel = (lane >> 4) & 1;
  const int vrow = (4 * hi + q) * 128 + 8 * (p & 1);
  const int chb = 2 * gsel + (p >> 1);
  s16x4 vl0[4], vh0[4], vl1[4], vh1[4];
#pragma unroll
  for (int ks = 0; ks < 4; ++ks) {
    const int c0_ = ((chb | ((0 ^ (q >> 1)) << 2)) << 4), c1_ = ((chb | ((1 ^ (q >> 1)) << 2)) << 4);
    vl0[ks] = vtr(Vt + ks * 2048 + vrow + c0_); vh0[ks] = vtr(Vt + ks * 2048 + 1024 + vrow + c0_); vl1[ks] = vtr(Vt + ks * 2048 + vrow + c1_); vh1[ks] = vtr(Vt + ks * 2048 + 1024 + vrow + c1_);
  }
  asm volatile("s_waitcnt lgkmcnt(0)" ::: "memory");
  after_v();
#pragma unroll
  for (int ks = 0; ks < 4; ++ks) {
    const bf16x8 va0 = (bf16x8){vl0[ks][0], vl0[ks][1], vl0[ks][2], vl0[ks][3], vh0[ks][0], vh0[ks][1], vh0[ks][2], vh0[ks][3]}, va1 = (bf16x8){vl1[ks][0], vl1[ks][1], vl1[ks][2], vl1[ks][3], vh1[ks][0], vh1[ks][1], vh1[ks][2], vh1[ks][3]};
    st.o0 = __builtin_amdgcn_mfma_f32_32x32x16_bf16(va0, __builtin_bit_cast(bf16x8, pw[ks]), st.o0, 0, 0, 0);
    st.o1 = __builtin_amdgcn_mfma_f32_32x32x16_bf16(va1, __builtin_bit_cast(bf16x8, pw[ks]), st.o1, 0, 0, 0);
  }
}
__device__ __forceinline__ void glds16(const void* sbase  , unsigned voff  , unsigned lds_dst) {
  unsigned keep;
  asm volatile("s_mov_b32 %0, m0\n\ts_mov_b32 m0, %2\n\ts_nop 0\n\tglobal_load_lds_dwordx4 %1, %3\n\ts_mov_b32 m0, %0" : "=&s"(keep) : "v"(voff), "s"(lds_dst), "s"(sbase) : "memory");
}
__device__ __forceinline__ void glds16x8(const void* sbase, const unsigned (&vo)[8], unsigned lds_dst) {
  unsigned keep;
  asm volatile("s_mov_b32 %0, m0\n\ts_mov_b32 m0, %9\n\ts_nop 0\n\tglobal_load_lds_dwordx4 %1, %10\n\t"
               "s_add_u32 m0, m0, 0x400\n\ts_nop 0\n\tglobal_load_lds_dwordx4 %2, %10\n\t"
               "s_add_u32 m0, m0, 0x400\n\ts_nop 0\n\tglobal_load_lds_dwordx4 %3, %10\n\t"
               "s_add_u32 m0, m0, 0x400\n\ts_nop 0\n\tglobal_load_lds_dwordx4 %4, %10\n\t"
               "s_add_u32 m0, m0, 0x400\n\ts_nop 0\n\tglobal_load_lds_dwordx4 %5, %10\n\t"
               "s_add_u32 m0, m0, 0x400\n\ts_nop 0\n\tglobal_load_lds_dwordx4 %6, %10\n\t"
               "s_add_u32 m0, m0, 0x400\n\ts_nop 0\n\tglobal_load_lds_dwordx4 %7, %10\n\t"
               "s_add_u32 m0, m0, 0x400\n\ts_nop 0\n\tglobal_load_lds_dwordx4 %8, %10\n\t"
               "s_mov_b32 m0, %0"
               : "=&s"(keep) : "v"(vo[0]), "v"(vo[1]), "v"(vo[2]), "v"(vo[3]), "v"(vo[4]), "v"(vo[5]), "v"(vo[6]), "v"(vo[7]), "s"(lds_dst), "s"(sbase) : "memory", "scc");
}
__device__ __forceinline__ void attn_store(const AttnState& st, float inv, const bf16* grow  , bf16* yrow  , int lane) {
  const int hi = lane >> 5;
  u32x2 gv[8];
#pragma unroll
  for (int i = 0; i < 8; ++i) gv[i] = *(const u32x2*)(grow + 32 * (i >> 2) + 8 * (i & 3) + 4 * hi);
  __builtin_amdgcn_sched_barrier(0);
#pragma unroll
  for (int d0 = 0; d0 < 2; ++d0)
#pragma unroll
    for (int gi = 0; gi < 4; ++gi) {
      const int db = 32 * d0 + 8 * gi + 4 * hi; const u32x2 g = gv[4 * d0 + gi];
      const f32x16& o = d0 == 0 ? st.o0 : st.o1;
      const float g0 = __uint_as_float(g.x << 16), g1 = __uint_as_float(g.x & 0xffff0000u), g2 = __uint_as_float(g.y << 16), g3 = __uint_as_float(g.y & 0xffff0000u);
      u32x2 ov; ov.x = pk2(o[4 * gi + 0] * inv * g0, o[4 * gi + 1] * inv * g1); ov.y = pk2(o[4 * gi + 2] * inv * g2, o[4 * gi + 3] * inv * g3);
      *(u32x2*)(yrow + db) = ov;
    }
}
__device__ __forceinline__ void attn_gates(u32x2 (&gv)[8], const bf16* grow, int lane) {
  const int hi = lane >> 5;
#pragma unroll
  for (int i = 0; i < 8; ++i) gv[i] = *(const u32x2*)(grow + 32 * (i >> 2) + 8 * (i & 3) + 4 * hi);
}
__device__ __forceinline__ void attn_store_g(const AttnState& st, float inv, const u32x2 (&gv)[8], bf16* yrow, int lane) {
  const int hi = lane >> 5;
#pragma unroll
  for (int d0 = 0; d0 < 2; ++d0)
#pragma unroll
    for (int gi = 0; gi < 4; ++gi) {
      const int db = 32 * d0 + 8 * gi + 4 * hi; const u32x2 g = gv[4 * d0 + gi];
      const f32x16& o = d0 == 0 ? st.o0 : st.o1;
      const float g0 = __uint_as_float(g.x << 16), g1 = __uint_as_float(g.x & 0xffff0000u), g2 = __uint_as_float(g.y << 16), g3 = __uint_as_float(g.y & 0xffff0000u);
      u32x2 ov; ov.x = pk2(o[4 * gi + 0] * inv * g0, o[4 * gi + 1] * inv * g1); ov.y = pk2(o[4 * gi + 2] * inv * g2, o[4 * gi + 3] * inv * g3);
      *(u32x2*)(yrow + db) = ov;
    }
}
template <int NH> struct TileRegs { u32x4 k[NH], v[NH]; };
template <int NH>
__device__ __forceinline__ void tile_load(TileRegs<NH>& R, const bf16* kbase  , const bf16* vbase, int tid) {
  const int key = tid >> 3, ch = tid & 7;
#pragma unroll
  for (int h = 0; h < NH; ++h) { R.k[h] = *(const u32x4*)(kbase + (size_t)key * PLW + h * 64 + ch * 8); R.v[h] = *(const u32x4*)(vbase + (size_t)key * PLW + h * 64 + ch * 8); }
}
template <int NH>
__device__ __forceinline__ void tile_store(const TileRegs<NH>& R, LAS unsigned char* buf, int tid) {
  const int key = tid >> 3, ch = tid & 7;
  const int ko = key * 128 + ((ch ^ ((key >> 1) & 7)) << 4), vo = key * 128 + ((ch ^ (((key >> 1) & 1) << 2)) << 4);
#pragma unroll
  for (int h = 0; h < NH; ++h) { *(LAS u32x4*)(buf + h * 8192 + ko) = R.k[h]; *(LAS u32x4*)(buf + NH * 8192 + h * 8192 + vo) = R.v[h]; }
}

template <int NH> struct TileRegs2 { TileRegs<NH> a, b; };
__device__ __forceinline__ void swa_item(const Frame& F0, const Args& a, int layer, int item) {
  const Frame F = relaunder(F0);
  unsigned char* ws = opq(a.ws);
  const bf16* PLB = (const bf16*)(ws + WS_PLB); bf16* Y = (bf16*)(ws + WS_H);
  const bool isctx = item >= 256;
  int b, kvh, n;
  if (!isctx) { b = item >> 6; kvh = (item >> 5) & 1; n = item & 31; } else { const int ci = item - 256; b = ci >> 2; kvh = (ci >> 1) & 1; n = ci & 1; }
  const int g = F.wave >> 2, quarter = F.wave & 3, hq = 2 * kvh + g, r32 = F.lane & 31, hi = F.lane >> 5;
  const int tq = 128 * n + 32 * quarter + r32;
  const size_t qrow = isctx ? (size_t)MLAT + b * CTX + tq : (size_t)b * SEQ + tq;
  bf16x8 qf[4];
#pragma unroll
  for (int s = 0; s < 4; ++s) qf[s] = *(const bf16x8*)(PLB + qrow * PLW + S_CQ * 256 + hq * 64 + 16 * s + 8 * hi);
  int jlo = 0, jhi = 0;
  if (!isctx) { jlo = n == 0 ? 1 : 0; jhi = n == 31 ? 2 : 3; }
  const int nloc = jhi - jlo, T = nloc + 2;
  const bf16* kcol = PLB + S_CKV * 256 + kvh * 64;
  auto tile_row = [&](int t) -> size_t { return t < nloc ? (size_t)b * SEQ + 128 * (n - 1 + jlo + t) : (size_t)MLAT + b * CTX + 128 * (t - nloc); };
  AttnState st; st.m = 0.f; st.l = 0.f;
#pragma unroll
  for (int i = 0; i < 16; ++i) { st.o0[i] = 0.f; st.o1[i] = 0.f; }
  TileRegs2<1> R;
  __syncthreads();
  { const size_t r0 = tile_row(0); tile_load<1>(R.a, kcol + r0 * PLW, kcol + 128 + r0 * PLW, F.tid); tile_load<1>(R.b, kcol + (r0 + 64) * PLW, kcol + 128 + (r0 + 64) * PLW, F.tid); }
  tile_store<1>(R.a, F.lds, F.tid); tile_store<1>(R.b, F.lds + 16384, F.tid);
  __syncthreads();
  for (int t = 0; t < T; ++t) {
    if (t + 1 < T) { const size_t r0 = tile_row(t + 1); tile_load<1>(R.a, kcol + r0 * PLW, kcol + 128 + r0 * PLW, F.tid); tile_load<1>(R.b, kcol + (r0 + 64) * PLW, kcol + 128 + (r0 + 64) * PLW, F.tid); }
    LAS const unsigned char* buf = F.lds + (t & 1) * 32768;
#pragma unroll
    for (int hf = 0; hf < 2; ++hf) {
      LAS const unsigned char* hb = buf + hf * 16384;
      if (t < nloc) {
        const int kb = 128 * (n - 1 + jlo + t) + 64 * hf, q0 = 128 * n + 32 * quarter;
        if (!(kb + 63 < q0 - 128 || kb > q0 + 31 + 128)) {
          const int dq = kb - tq;
          if (kb >= q0 + 31 - 128 && kb + 63 <= q0 + 128) attn_tile(st, qf, hb, hb + 8192, F.lane, [](f32x16&, f32x16&) {});
          else attn_tile(st, qf, hb, hb + 8192, F.lane, [&](f32x16& p0, f32x16& p1) {
#pragma unroll
            for (int r = 0; r < 16; ++r) { const int d0_ = dq + 128 + crow(r, hi), d1_ = d0_ + 32;
              p0[r] = ((unsigned)d0_ <= 256u) ? p0[r] : -INFINITY; p1[r] = ((unsigned)d1_ <= 256u) ? p1[r] : -INFINITY; } });
        }
      } else attn_tile(st, qf, hb, hb + 8192, F.lane, [](f32x16&, f32x16&) {});
    }
    if (t + 1 < T) { tile_store<1>(R.a, F.lds + ((t + 1) & 1) * 32768, F.tid); tile_store<1>(R.b, F.lds + ((t + 1) & 1) * 32768 + 16384, F.tid); }
    __syncthreads();
  }
  float l = st.l + __shfl_xor(st.l, 32);
  const float sk2 = opq(a.in[15])[layer * 4 + hq] * LOG2E;
  const float mnew = fmaxf(st.m, sk2), al = __builtin_amdgcn_exp2f(st.m - mnew);
  l = l * al + __builtin_amdgcn_exp2f(sk2 - mnew);
  int qr = (int)qrow; asm volatile("" : "+v"(qr));
  attn_store(st, al / l, PLB + (size_t)qr * PLW + S_CG * 256 + hq * 64, Y + (size_t)qr * 1024 + 512 + hq * 64, F.lane);
}
__device__ __forceinline__ void na_item(const Frame& F0, const Args& a, int layer, int item) {
  const Frame F = relaunder(F0);
  unsigned char* ws = opq(a.ws);
  const bf16* PLB = (const bf16*)(ws + WS_PLB); bf16* Y = (bf16*)(ws + WS_H);
  const bool isctx = item >= 256;
  int b, r;
  if (!isctx) { b = item >> 6; r = item & 63; } else { const int ci = item - 256; b = ci >> 2; r = ci & 3; }
  const int head = F.wave >> 1, half = F.wave & 1, r32 = F.lane & 31, hi = F.lane >> 5;
  const int qc = 32 * half + r32;
  const size_t qrow = isctx ? (size_t)MLAT + b * CTX + 64 * r + qc : (size_t)b * SEQ + 64 * r + qc;
  bf16x8 qf[4];
#pragma unroll
  for (int s = 0; s < 4; ++s) qf[s] = *(const bf16x8*)(PLB + qrow * PLW + S_DQ * 256 + head * 64 + 16 * s + 8 * hi);
  int rs = r - 4; rs = rs < 0 ? 0 : (rs > 56 ? 56 : rs);
  const int nloc = isctx ? 0 : 8, T = nloc + 4;
  auto tile_row = [&](int t) -> size_t { return t < nloc ? (size_t)b * SEQ + 64 * (rs + t) : (size_t)MLAT + b * CTX + 64 * (t - nloc); };
  const bf16* kcol = PLB + S_DK * 256 + head * 64; const bf16* vcol = PLB + S_DV * 256 + head * 64;
  LAS float* btab = (LAS float*)(F.lds + 2 * 65536);
  LAS unsigned char* Kt = F.lds + F.wave * 16384; LAS unsigned char* Vt = Kt + 8192;
  const unsigned kdst = (unsigned)(size_t)Kt, vdst = kdst + 8192u;
  const int kk = F.lane >> 3, cs = F.lane & 7;
  const unsigned ok0 = kk * (PLW * 2) + ((cs ^ (kk >> 1)) << 4), ok1 = kk * (PLW * 2) + ((cs ^ (4 + (kk >> 1))) << 4), ov = kk * (PLW * 2) + ((cs ^ (((kk >> 1) & 1) << 2)) << 4);
  unsigned vok[8], vov[8];
#pragma unroll
  for (int n = 0; n < 8; ++n) { vok[n] = ((n & 1) ? ok1 : ok0) + n * 8 * (PLW * 2); vov[n] = ov + n * 8 * (PLW * 2); }
  auto dma_k = [&](int t) { glds16x8(kcol + tile_row(t) * PLW, vok, kdst); };
  auto dma_v = [&](int t) { glds16x8(vcol + tile_row(t) * PLW, vov, vdst); };
  AttnState st; st.m = 0.f; st.l = 0.f;
#pragma unroll
  for (int i = 0; i < 16; ++i) { st.o0[i] = 0.f; st.o1[i] = 0.f; }
  u32x2 gv[8];
  { int qr0 = (int)qrow; asm volatile("" : "+v"(qr0)); attn_gates(gv, PLB + (size_t)qr0 * PLW + S_DG * 256 + head * 64, F.lane); }
  float t_[15];
  { const float* rb = opq(a.in[18]) + (size_t)layer * 4 * 15 * 31;
#pragma unroll
    for (int i = 0; i < 15; ++i) { const int ix = F.tid + 512 * i, hd = ix >> 7, dx = (ix & 127) - 63; const int dc = dx < -15 ? -15 : (dx > 15 ? 15 : dx); t_[i] = rb[hd * 31 + dc + 15]; } }
  __builtin_amdgcn_sched_barrier(0);
#pragma unroll
  for (int s = 0; s < 4; ++s) asm volatile("" : "+v"(qf[s]));
#pragma unroll
  for (int i = 0; i < 15; ++i) asm volatile("" : "+v"(t_[i]));
#pragma unroll
  for (int i = 0; i < 8; ++i) asm volatile("" : "+v"(gv[i]));
  __syncthreads();
  dma_k(0); dma_v(0);
#pragma unroll
  for (int i = 0; i < 15; ++i) { const int dx = ((F.tid + 512 * i) & 127) - 63; btab[F.tid + 512 * i] = (dx >= -15 && dx <= 15) ? t_[i] * LOG2E : 0.f; }
  __syncthreads();
  int c0 = qc - 8; c0 = c0 < 0 ? 0 : (c0 > 48 ? 48 : c0);
  for (int t = 0; t < T; ++t) {
    const bool more = t + 1 < T;
    asm volatile("s_waitcnt vmcnt(8)" ::: "memory");
    auto after_k = [&]() { if (more) dma_k(t + 1); };
    auto before_v = [&]() { if (more) asm volatile("s_waitcnt vmcnt(8)" ::: "memory"); else asm volatile("s_waitcnt vmcnt(0)" ::: "memory"); };
    auto after_v = [&]() { if (more) dma_v(t + 1); };
    if (t < nloc) {
      const int dy = rs + t - r + 7;
      const int c0l = c0;
      unsigned bta = (unsigned)(size_t)(btab + (head * 15 + dy) * 128 + 63 - qc + 4 * hi); asm volatile("" : "+v"(bta));
      LAS const float* bt = (LAS const float*)bta;
      attn_tile_dma(st, qf, Kt, Vt, F.lane, [&](f32x16& p0, f32x16& p1) {
        float bb[16];
#pragma unroll
        for (int rr = 0; rr < 16; ++rr) bb[rr] = bt[(rr & 3) + 8 * (rr >> 2)];
#pragma unroll
        for (int rr = 0; rr < 16; ++rr) p0[rr] = ((unsigned)((rr & 3) + 8 * (rr >> 2) + 4 * hi - c0l) < 16u) ? p0[rr] + bb[rr] : -INFINITY;
#pragma unroll
        for (int rr = 0; rr < 16; ++rr) bb[rr] = bt[(rr & 3) + 8 * (rr >> 2) + 32];
#pragma unroll
        for (int rr = 0; rr < 16; ++rr) p1[rr] = ((unsigned)((rr & 3) + 8 * (rr >> 2) + 32 + 4 * hi - c0l) < 16u) ? p1[rr] + bb[rr] : -INFINITY; }, after_k, before_v, after_v);
    } else attn_tile_dma(st, qf, Kt, Vt, F.lane, [](f32x16&, f32x16&) {}, after_k, before_v, after_v);
  }
  const float l = st.l + __shfl_xor(st.l, 32);
  int qr = (int)qrow; asm volatile("" : "+v"(qr));
  attn_store_g(st, 1.f / l, gv, Y + (size_t)qr * 1024 + 768 + head * 64, F.lane);
}
}

namespace mk {
struct Attn2 { float l[2]; f32x16 o[2][2]; };
template <class ProbF, class F1, class F2, class F3>
__device__ __forceinline__ void attn2_tile(Attn2& st, const bf16x8 (&qf)[2][4], LAS const unsigned char* Kt, LAS const unsigned char* Vt, int lane, ProbF&& probf, F1&& after_k, F2&& before_v, F3&& after_v) {
  const int r32 = lane & 31, hi = lane >> 5;
  const int ksw = (r32 >> 1) & 7;
  bf16x8 ka[4], kb[4];
#pragma unroll
  for (int s = 0; s < 4; ++s) { const int ch = ((2 * s + hi) ^ ksw) << 4; ka[s] = *(LAS const bf16x8*)(Kt + r32 * 128 + ch); kb[s] = *(LAS const bf16x8*)(Kt + (32 + r32) * 128 + ch); }
  asm volatile("s_waitcnt lgkmcnt(0)" ::: "memory");
  after_k();
  u32x4 pw[2][4];
#pragma unroll
  for (int qb = 0; qb < 2; ++qb) {
    f32x16 p0, p1;
    { const f32x16 z = {0.f, 0.f, 0.f, 0.f, 0.f, 0.f, 0.f, 0.f, 0.f, 0.f, 0.f, 0.f, 0.f, 0.f, 0.f, 0.f};
      p0 = __builtin_amdgcn_mfma_f32_32x32x16_bf16(ka[0], qf[qb][0], z, 0, 0, 0); p1 = __builtin_amdgcn_mfma_f32_32x32x16_bf16(kb[0], qf[qb][0], z, 0, 0, 0); }
#pragma unroll
    for (int s = 1; s < 4; ++s) { p0 = __builtin_amdgcn_mfma_f32_32x32x16_bf16(ka[s], qf[qb][s], p0, 0, 0, 0); p1 = __builtin_amdgcn_mfma_f32_32x32x16_bf16(kb[s], qf[qb][s], p1, 0, 0, 0); }
    probf(qb, p0, p1);
    float ps = 0.f;
#pragma unroll
    for (int i = 0; i < 16; ++i) ps += p0[i] + p1[i];
    st.l[qb] += ps;
#pragma unroll
    for (int k = 0; k < 2; ++k) {
      pw[qb][k] = (u32x4){pk2(p0[8 * k + 0], p0[8 * k + 1]), pk2(p0[8 * k + 2], p0[8 * k + 3]), pk2(p0[8 * k + 4], p0[8 * k + 5]), pk2(p0[8 * k + 6], p0[8 * k + 7])};
      pw[qb][2 + k] = (u32x4){pk2(p1[8 * k + 0], p1[8 * k + 1]), pk2(p1[8 * k + 2], p1[8 * k + 3]), pk2(p1[8 * k + 4], p1[8 * k + 5]), pk2(p1[8 * k + 6], p1[8 * k + 7])};
    }
  }
  before_v();
  const int q = (lane & 15) >> 2, p = lane & 3, gsel = (lane >> 4) & 1;
  const int vrow = (4 * hi + q) * 128 + 8 * (p & 1);
  const int chb = 2 * gsel + (p >> 1);
  s16x4 vl0[4], vh0[4], vl1[4], vh1[4];
#pragma unroll
  for (int ks = 0; ks < 4; ++ks) {
    const int c0_ = ((chb | ((0 ^ (q >> 1)) << 2)) << 4), c1_ = ((chb | ((1 ^ (q >> 1)) << 2)) << 4);
    vl0[ks] = vtr(Vt + ks * 2048 + vrow + c0_); vh0[ks] = vtr(Vt + ks * 2048 + 1024 + vrow + c0_); vl1[ks] = vtr(Vt + ks * 2048 + vrow + c1_); vh1[ks] = vtr(Vt + ks * 2048 + 1024 + vrow + c1_);
  }
  asm volatile("s_waitcnt lgkmcnt(0)" ::: "memory");
  after_v();
#pragma unroll
  for (int ks = 0; ks < 4; ++ks) {
    const bf16x8 va0 = (bf16x8){vl0[ks][0], vl0[ks][1], vl0[ks][2], vl0[ks][3], vh0[ks][0], vh0[ks][1], vh0[ks][2], vh0[ks][3]}, va1 = (bf16x8){vl1[ks][0], vl1[ks][1], vl1[ks][2], vl1[ks][3], vh1[ks][0], vh1[ks][1], vh1[ks][2], vh1[ks][3]};
#pragma unroll
    for (int qb = 0; qb < 2; ++qb) {
      st.o[qb][0] = __builtin_amdgcn_mfma_f32_32x32x16_bf16(va0, __builtin_bit_cast(bf16x8, pw[qb][ks]), st.o[qb][0], 0, 0, 0);
      st.o[qb][1] = __builtin_amdgcn_mfma_f32_32x32x16_bf16(va1, __builtin_bit_cast(bf16x8, pw[qb][ks]), st.o[qb][1], 0, 0, 0);
    }
  }
}
struct DmaLane { unsigned ok0, ok1, ov; };
__device__ __forceinline__ DmaLane dma_lane(int lane) {
  const int kk = lane >> 3, cs = lane & 7; DmaLane d;
  d.ok0 = kk * (PLW * 2) + ((cs ^ (kk >> 1)) << 4); d.ok1 = kk * (PLW * 2) + ((cs ^ (4 + (kk >> 1))) << 4); d.ov = kk * (PLW * 2) + ((cs ^ (((kk >> 1) & 1) << 2)) << 4); return d;
}
__device__ __forceinline__ void dma_tile_k(const bf16* krow0  , const DmaLane& d, unsigned kdst) {
  const unsigned char* tb = (const unsigned char*)krow0;
#pragma unroll
  for (int n = 0; n < 8; ++n) glds16(tb + (size_t)n * 8 * (PLW * 2), (n & 1) ? d.ok1 : d.ok0, kdst + n * 1024);
}
__device__ __forceinline__ void dma_tile_v(const bf16* vrow0, const DmaLane& d, unsigned vdst) {
  const unsigned char* tb = (const unsigned char*)vrow0;
#pragma unroll
  for (int n = 0; n < 8; ++n) glds16(tb + (size_t)n * 8 * (PLW * 2), d.ov, vdst + n * 1024);
}
__device__ __forceinline__ void attn2_exchange(const Attn2& st, int par, AttnState& fin, const Frame& F) {
  LAS float* X = (LAS float*)(F.lds + F.wave * 16384);
  LAS const float* XP = (LAS const float*)(F.lds + (F.wave ^ 1) * 16384);
  if (par == 0) {
#pragma unroll
    for (int i = 0; i < 16; ++i) { X[i * 64 + F.lane] = st.o[1][0][i]; X[(16 + i) * 64 + F.lane] = st.o[1][1][i]; }
    X[32 * 64 + F.lane] = st.l[1];
  } else {
#pragma unroll
    for (int i = 0; i < 16; ++i) { X[i * 64 + F.lane] = st.o[0][0][i]; X[(16 + i) * 64 + F.lane] = st.o[0][1][i]; }
    X[32 * 64 + F.lane] = st.l[0];
  }
  __syncthreads();
  if (par == 0) {
#pragma unroll
    for (int i = 0; i < 16; ++i) { fin.o0[i] = st.o[0][0][i] + XP[i * 64 + F.lane]; fin.o1[i] = st.o[0][1][i] + XP[(16 + i) * 64 + F.lane]; }
    fin.l = st.l[0] + XP[32 * 64 + F.lane];
  } else {
#pragma unroll
    for (int i = 0; i < 16; ++i) { fin.o0[i] = st.o[1][0][i] + XP[i * 64 + F.lane]; fin.o1[i] = st.o[1][1][i] + XP[(16 + i) * 64 + F.lane]; }
    fin.l = st.l[1] + XP[32 * 64 + F.lane];
  }
  fin.m = 0.f;
}
__device__ __forceinline__ void exp_all(f32x16& p0, f32x16& p1) {
#pragma unroll
  for (int i = 0; i < 16; ++i) { p0[i] = __builtin_amdgcn_exp2f(p0[i]); p1[i] = __builtin_amdgcn_exp2f(p1[i]); }
}

__device__ __forceinline__ void na_item2(const Frame& F0, const Args& a, int layer, int item) {
  const Frame F = relaunder(F0);
  unsigned char* ws = opq(a.ws);
  const bf16* PLB = (const bf16*)(ws + WS_PLB); bf16* Y = (bf16*)(ws + WS_H);
  const bool isctx = item >= 256;
  int b, r;
  if (!isctx) { b = item >> 6; r = item & 63; } else { const int ci = item - 256; b = ci >> 2; r = ci & 3; }
  const int head = F.wave >> 1, par = F.wave & 1, r32 = F.lane & 31, hi = F.lane >> 5;
  const size_t qrow0 = isctx ? (size_t)MLAT + b * CTX + 64 * r : (size_t)b * SEQ + 64 * r;
  bf16x8 qf[2][4];
#pragma unroll
  for (int qb = 0; qb < 2; ++qb)
#pragma unroll
    for (int s = 0; s < 4; ++s) qf[qb][s] = *(const bf16x8*)(PLB + (qrow0 + 32 * qb + r32) * PLW + S_DQ * 256 + head * 64 + 16 * s + 8 * hi);
  int rs = r - 4; rs = rs < 0 ? 0 : (rs > 56 ? 56 : rs);
  const int T = isctx ? 4 : 12;
  auto tile_row = [&](int t) -> size_t { return t < 4 ? (size_t)MLAT + b * CTX + 64 * t : (size_t)b * SEQ + 64 * (rs + t - 4); };
  const bf16* kcol = PLB + S_DK * 256 + head * 64; const bf16* vcol = PLB + S_DV * 256 + head * 64;
  LAS float* btab = (LAS float*)(F.lds + 2 * 65536);
  LAS unsigned char* Kt = F.lds + F.wave * 16384; LAS unsigned char* Vt = Kt + 8192;
  const unsigned kdst = (unsigned)(size_t)Kt, vdst = kdst + 8192u;
  const DmaLane dl = dma_lane(F.lane);
  Attn2 st; st.l[0] = 0.f; st.l[1] = 0.f;
#pragma unroll
  for (int i = 0; i < 16; ++i) { st.o[0][0][i] = 0.f; st.o[0][1][i] = 0.f; st.o[1][0][i] = 0.f; st.o[1][1][i] = 0.f; }
#pragma unroll
  for (int qb = 0; qb < 2; ++qb)
#pragma unroll
    for (int s = 0; s < 4; ++s) asm volatile("" : "+v"(qf[qb][s]));
  __syncthreads();
  dma_tile_k(kcol + tile_row(par) * PLW, dl, kdst); dma_tile_v(vcol + tile_row(par) * PLW, dl, vdst);
  {
    const float* rb = opq(a.in[18]) + (size_t)layer * 4 * 15 * 31; float t_[15];
#pragma unroll
    for (int i = 0; i < 15; ++i) { const int ix = F.tid + 512 * i, hd = ix >> 7, dx = (ix & 127) - 63; const int dc = dx < -15 ? -15 : (dx > 15 ? 15 : dx); t_[i] = rb[hd * 31 + dc + 15]; }
    __builtin_amdgcn_sched_barrier(0);
#pragma unroll
    for (int i = 0; i < 15; ++i) { const int dx = ((F.tid + 512 * i) & 127) - 63; btab[F.tid + 512 * i] = (dx >= -15 && dx <= 15) ? t_[i] * LOG2E : 0.f; } }
  __syncthreads();
  const int c00 = r32 < 8 ? 0 : r32 - 8, c01 = r32 > 24 ? 48 : 24 + r32;
  for (int t = par; t < T; t += 2) {
    const bool more = t + 2 < T;
    asm volatile("s_waitcnt vmcnt(8)" ::: "memory");
    auto after_k = [&]() { if (more) dma_tile_k(kcol + tile_row(t + 2) * PLW, dl, kdst); };
    auto before_v = [&]() { if (more) asm volatile("s_waitcnt vmcnt(8)" ::: "memory"); else asm volatile("s_waitcnt vmcnt(0)" ::: "memory"); };
    auto after_v = [&]() { if (more) dma_tile_v(vcol + tile_row(t + 2) * PLW, dl, vdst); };
    if (t >= 4) {
      const int dy = rs + (t - 4) - r + 7;
      unsigned bta = (unsigned)(size_t)(btab + (head * 15 + dy) * 128 + 63 - r32 + 4 * hi); asm volatile("" : "+v"(bta));
      LAS const float* bt = (LAS const float*)bta;
      attn2_tile(st, qf, Kt, Vt, F.lane, [&](int qb, f32x16& p0, f32x16& p1) {
        if (qb == 0) {
#pragma unroll
          for (int rr = 0; rr < 16; ++rr) { const int kc = (rr & 3) + 8 * (rr >> 2); p0[rr] = ((unsigned)(kc + 4 * hi - c00) < 16u) ? __builtin_amdgcn_exp2f(p0[rr] + bt[kc]) : 0.f; }
#pragma unroll
          for (int rr = 0; rr < 4; ++rr) p1[rr] = ((unsigned)(32 + rr + 4 * hi - c00) < 16u) ? __builtin_amdgcn_exp2f(p1[rr] + bt[32 + rr]) : 0.f;
#pragma unroll
          for (int rr = 4; rr < 16; ++rr) p1[rr] = 0.f;
        } else {
#pragma unroll
          for (int rr = 0; rr < 12; ++rr) p0[rr] = 0.f;
#pragma unroll
          for (int rr = 12; rr < 16; ++rr) p0[rr] = ((unsigned)(12 + rr + 4 * hi - c01) < 16u) ? __builtin_amdgcn_exp2f(p0[rr] + bt[12 + rr - 32]) : 0.f;
#pragma unroll
          for (int rr = 0; rr < 16; ++rr) { const int kc = 32 + (rr & 3) + 8 * (rr >> 2); p1[rr] = ((unsigned)(kc + 4 * hi - c01) < 16u) ? __builtin_amdgcn_exp2f(p1[rr] + bt[kc - 32]) : 0.f; }
        } }, after_k, before_v, after_v);
    } else attn2_tile(st, qf, Kt, Vt, F.lane, [](int, f32x16& p0, f32x16& p1) { exp_all(p0, p1); }, after_k, before_v, after_v);
  }
  AttnState fin;
  attn2_exchange(st, par, fin, F);
  const float l = fin.l + __shfl_xor(fin.l, 32);
  int qr = (int)qrow0 + 32 * par + r32; asm volatile("" : "+v"(qr));
  attn_store(fin, 1.f / l, PLB + (size_t)qr * PLW + S_DG * 256 + head * 64, Y + (size_t)qr * 1024 + 768 + head * 64, F.lane);
}

__device__ __forceinline__ void swa_item2(const Frame& F0, const Args& a, int layer, int item) {
  const Frame F = relaunder(F0);
  unsigned char* ws = opq(a.ws);
  const bf16* PLB = (const bf16*)(ws + WS_PLB); bf16* Y = (bf16*)(ws + WS_H);
  const bool isctx = item >= 256;
  int b, kvh, n;
  if (!isctx) { b = item >> 6; kvh = (item >> 5) & 1; n = item & 31; } else { const int ci = item - 256; b = ci >> 2; kvh = (ci >> 1) & 1; n = ci & 1; }
  const int quarter = F.wave >> 1, par = F.wave & 1, r32 = F.lane & 31, hi = F.lane >> 5;
  const int q0 = 128 * n + 32 * quarter, tq = q0 + r32;
  const size_t qrow = isctx ? (size_t)MLAT + b * CTX + tq : (size_t)b * SEQ + tq;
  bf16x8 qf[2][4];
#pragma unroll
  for (int g = 0; g < 2; ++g)
#pragma unroll
    for (int s = 0; s < 4; ++s) qf[g][s] = *(const bf16x8*)(PLB + qrow * PLW + S_CQ * 256 + (2 * kvh + g) * 64 + 16 * s + 8 * hi);
  unsigned need = 0x3C0u;
  if (!isctx) {
#pragma unroll
    for (int hk = 0; hk < 6; ++hk) { const int kb = 128 * (n - 1) + 64 * hk; if (kb >= 0 && kb < SEQ && !(kb + 63 < q0 - 128 || kb > q0 + 31 + 128)) need |= 1u << hk; }
  }
  need = (unsigned)__builtin_amdgcn_readfirstlane((int)need);
  if (par) need &= need - 1u;
  auto tile_row = [&](int hk) -> size_t { return hk < 6 ? (size_t)b * SEQ + 128 * (n - 1) + 64 * hk : (size_t)MLAT + b * CTX + 64 * (hk - 6); };
  const bf16* kcol = PLB + S_CKV * 256 + kvh * 64; const bf16* vcol = kcol + 128;
  LAS unsigned char* Kt = F.lds + F.wave * 16384; LAS unsigned char* Vt = Kt + 8192;
  const unsigned kdst = (unsigned)(size_t)Kt, vdst = kdst + 8192u;
  const DmaLane dl = dma_lane(F.lane);
  Attn2 st; st.l[0] = 0.f; st.l[1] = 0.f;
#pragma unroll
  for (int i = 0; i < 16; ++i) { st.o[0][0][i] = 0.f; st.o[0][1][i] = 0.f; st.o[1][0][i] = 0.f; st.o[1][1][i] = 0.f; }
#pragma unroll
  for (int g = 0; g < 2; ++g)
#pragma unroll
    for (int s = 0; s < 4; ++s) asm volatile("" : "+v"(qf[g][s]));
  __syncthreads();
  if (need) { const int t0 = __builtin_ctz(need); dma_tile_k(kcol + tile_row(t0) * PLW, dl, kdst); dma_tile_v(vcol + tile_row(t0) * PLW, dl, vdst); }
  while (need) {
    const int t = __builtin_ctz(need);
    need &= need - 1u; need &= need - 1u;
    const bool more = need != 0u;
    const int tn = more ? __builtin_ctz(need) : 0;
    asm volatile("s_waitcnt vmcnt(8)" ::: "memory");
    auto after_k = [&]() { if (more) dma_tile_k(kcol + tile_row(tn) * PLW, dl, kdst); };
    auto before_v = [&]() { if (more) asm volatile("s_waitcnt vmcnt(8)" ::: "memory"); else asm volatile("s_waitcnt vmcnt(0)" ::: "memory"); };
    auto after_v = [&]() { if (more) dma_tile_v(vcol + tile_row(tn) * PLW, dl, vdst); };
    const int kb = 128 * (n - 1) + 64 * t;
    if (t < 6 && !(kb >= q0 + 31 - 128 && kb + 63 <= q0 + 128)) {
      const int dq = kb - tq + 128;
      attn2_tile(st, qf, Kt, Vt, F.lane, [&](int, f32x16& p0, f32x16& p1) {
#pragma unroll
        for (int rr = 0; rr < 16; ++rr) { const int d0_ = dq + crow(rr, hi), d1_ = d0_ + 32;
          p0[rr] = ((unsigned)d0_ <= 256u) ? __builtin_amdgcn_exp2f(p0[rr]) : 0.f; p1[rr] = ((unsigned)d1_ <= 256u) ? __builtin_amdgcn_exp2f(p1[rr]) : 0.f; } }, after_k, before_v, after_v);
    } else attn2_tile(st, qf, Kt, Vt, F.lane, [](int, f32x16& p0, f32x16& p1) { exp_all(p0, p1); }, after_k, before_v, after_v);
  }
  AttnState fin;
  attn2_exchange(st, par, fin, F);
  const int hq = 2 * kvh + par;
  float l = fin.l + __shfl_xor(fin.l, 32);
  const float sk2 = opq(a.in[15])[layer * 4 + hq] * LOG2E;
  const float mnew = fmaxf(0.f, sk2), al = __builtin_amdgcn_exp2f(-mnew);
  l = l * al + __builtin_amdgcn_exp2f(sk2 - mnew);
  int qr = (int)qrow; asm volatile("" : "+v"(qr));
  attn_store(fin, al / l, PLB + (size_t)qr * PLW + S_CG * 256 + hq * 64, Y + (size_t)qr * 1024 + 512 + hq * 64, F.lane);
}
}

namespace mk {
constexpr int XT_STRIDE = 272;
constexpr int FFT_WC = 256 * XT_STRIDE;
__device__ __forceinline__ void fft_item(const Frame& F0, const Args& a, int item) {
  const Frame F = relaunder(F0);
  unsigned char* ws = opq(a.ws);
  const bf16* PLB = (const bf16*)(ws + WS_PLB); bf16* Y = (bf16*)(ws + WS_H);
  const int b = item >> 6, slice = item & 63, r32 = F.lane & 31, hi = F.lane >> 5, w = F.wave;
  LAS unsigned char* Xt = F.lds; LAS unsigned char* Wl = F.lds + FFT_WC;
  __syncthreads();
  u32x2 gv[8];
  {
    const bf16* WC = (const bf16*)(ws + WS_WC);
    u32x4 wt[4];
#pragma unroll
    for (int i = 0; i < 4; ++i) { const int idx = F.tid + 512 * i, row = idx >> 4, ch = idx & 15; wt[i] = *(const u32x4*)(WC + row * 128 + ch * 8); }
    const bf16* src = (const bf16*)(ws + WS_FA2) + ((size_t)b * 64 + slice) * TROW * 8;
#pragma unroll
    for (int i = 0; i < 8; ++i) gv[i] = *(const u32x2*)(PLB + ((size_t)b * SEQ + F.tid + 512 * i) * PLW + S_BG * 256 + 4 * slice);
    u32x4 v[8];
#pragma unroll
    for (int i = 0; i < 8; ++i) v[i] = *(const u32x4*)(src + (size_t)(F.lane + 64 * (8 * w + i)) * 8);
    __builtin_amdgcn_sched_barrier(0);
#pragma unroll
    for (int i = 0; i < 4; ++i) { const int idx = F.tid + 512 * i, row = idx >> 4, ch = idx & 15; *(LAS u32x4*)(Wl + row * XT_STRIDE + ch * 16) = wt[i]; }
#pragma unroll
    for (int cc = 0; cc < 4; ++cc)
#pragma unroll
      for (int part = 0; part < 2; ++part) { const int e = cc + 4 * part, d = e >> 1; const unsigned sel = (e & 1) ? 0x07060302u : 0x05040100u;
        u32x4 o;
        o.x = __builtin_amdgcn_perm(v[1][d], v[0][d], sel); o.y = __builtin_amdgcn_perm(v[3][d], v[2][d], sel);
        o.z = __builtin_amdgcn_perm(v[5][d], v[4][d], sel); o.w = __builtin_amdgcn_perm(v[7][d], v[6][d], sel);
        *(LAS u32x4*)(Xt + (64 * cc + F.lane) * XT_STRIDE + (part * 64 + 8 * w) * 2) = o; }
  }
  __syncthreads();
  f32x16 acc[4];
#pragma unroll
  for (int rb = 0; rb < 4; ++rb)
#pragma unroll
    for (int i = 0; i < 16; ++i) acc[rb][i] = 0.f;
  {
    bf16x8 bf[8];
#pragma unroll
    for (int s = 0; s < 8; ++s) bf[s] = *(LAS const bf16x8*)(Xt + (32 * w + r32) * XT_STRIDE + (16 * s + 8 * hi) * 2);
#pragma unroll
    for (int rb = 0; rb < 4; ++rb)
#pragma unroll
      for (int s = 0; s < 8; ++s) { const bf16x8 af = *(LAS const bf16x8*)(Wl + (32 * rb + r32) * XT_STRIDE + (16 * s + 8 * hi) * 2); acc[rb] = __builtin_amdgcn_mfma_f32_32x32x16_bf16(af, bf[s], acc[rb], 0, 0, 0); }
  }
  __syncthreads();
  {
    const int n2 = 32 * (w & 1) + r32, c = w >> 1;
#pragma unroll
    for (int rbp = 0; rbp < 2; ++rbp)
#pragma unroll
      for (int r = 0; r < 16; ++r) { const int k1 = 32 * rbp + crow(r, hi); float x = (float)((k1 * n2) & 4095) * (1.f / 4096.f);
        asm volatile("" : "+v"(x) :: "memory");
        const float tc = __builtin_amdgcn_cosf(x), ts = __builtin_amdgcn_sinf(x);
        const float yr = acc[rbp][r], yi = acc[rbp + 2][r];
        const float zr = yr * tc + yi * ts, zi = yi * tc - yr * ts;
        LAS unsigned char* zp = Xt + (k1 * 4 + c) * XT_STRIDE + n2 * 2;
        *(LAS unsigned short*)zp = (unsigned short)f2bf(zr); *(LAS unsigned short*)(zp + 128) = (unsigned short)f2bf(zi); }
  }
  __syncthreads();
  f32x16 o2[2];
#pragma unroll
  for (int rb = 0; rb < 2; ++rb)
#pragma unroll
    for (int i = 0; i < 16; ++i) o2[rb][i] = 0.f;
  {
    bf16x8 bf[8];
#pragma unroll
    for (int s = 0; s < 8; ++s) bf[s] = *(LAS const bf16x8*)(Xt + (32 * w + r32) * XT_STRIDE + (16 * s + 8 * hi) * 2);
#pragma unroll
    for (int rb = 0; rb < 2; ++rb)
#pragma unroll
      for (int s = 0; s < 8; ++s) { const bf16x8 af = *(LAS const bf16x8*)(Wl + (32 * rb + r32) * XT_STRIDE + (16 * s + 8 * hi) * 2); o2[rb] = __builtin_amdgcn_mfma_f32_32x32x16_bf16(af, bf[s], o2[rb], 0, 0, 0); }
  }
  __syncthreads();
  { const int k1 = 8 * w + (r32 >> 2), c = r32 & 3;
#pragma unroll
    for (int rb = 0; rb < 2; ++rb)
#pragma unroll
      for (int r = 0; r < 16; ++r) { const int k = k1 + 64 * (32 * rb + crow(r, hi)); *(LAS unsigned short*)(Xt + k * 8 + c * 2) = (unsigned short)f2bf(o2[rb][r]); }
  }
  __syncthreads();
  { const int o0 = 4 * slice;
#pragma unroll
    for (int i = 0; i < 8; ++i) { const int k = F.tid + 512 * i; const size_t row = (size_t)b * SEQ + k;
      const u32x2 ov = *(LAS const u32x2*)(Xt + k * 8);
      u32x2 y; y.x = pk2(__uint_as_float(ov.x << 16) * __uint_as_float(gv[i].x << 16), __uint_as_float(ov.x & 0xffff0000u) * __uint_as_float(gv[i].x & 0xffff0000u));
      y.y = pk2(__uint_as_float(ov.y << 16) * __uint_as_float(gv[i].y << 16), __uint_as_float(ov.y & 0xffff0000u) * __uint_as_float(gv[i].y & 0xffff0000u));
      *(u32x2*)(Y + row * 1024 + 256 + o0) = y; }
  }
}
constexpr int XC_STRIDE = 1040;
__device__ __forceinline__ void fftc_item(const Frame& F0, const Args& a, int item) {
  const Frame F = relaunder(F0);
  unsigned char* ws = opq(a.ws);
  const bf16* PLB = (const bf16*)(ws + WS_PLB); bf16* Y = (bf16*)(ws + WS_H);
  const bf16* CS = (const bf16*)(ws + WS_CS256);
  const int b = item >> 3, cs = item & 7, r32 = F.lane & 31, hi = F.lane >> 5, w = F.wave;
  LAS unsigned char* Xc = F.lds;
  __syncthreads();
  u32x4 vq[4];
#pragma unroll
  for (int i = 0; i < 4; ++i) { const int idx = F.tid + 512 * i, sl = idx >> 8, n = idx & 255;
    vq[i] = *(const u32x4*)((const bf16*)(ws + WS_FA2) + (((size_t)b * 64 + 8 * cs + sl) * TROW + SEQ + n) * 8); }
  __builtin_amdgcn_sched_barrier(0);
#pragma unroll
  for (int i = 0; i < 4; ++i) { const int idx = F.tid + 512 * i, sl = idx >> 8, n = idx & 255;
    const unsigned vv[4] = {vq[i].x, vq[i].y, vq[i].z, vq[i].w};
#pragma unroll
    for (int j = 0; j < 8; ++j) { const int c = j & 3, part = j >> 2; const unsigned short e = (unsigned short)((j & 1) ? (vv[j >> 1] >> 16) : (vv[j >> 1] & 0xffffu));
      *(LAS unsigned short*)(Xc + (4 * sl + c) * XC_STRIDE + (part * 256 + n) * 2) = e; } }
  __syncthreads();
  f32x16 acc;
#pragma unroll
  for (int i = 0; i < 16; ++i) acc[i] = 0.f;
#pragma unroll 1
  for (int s0 = 0; s0 < 32; s0 += 8) {
    bf16x8 af[8];
#pragma unroll
    for (int j = 0; j < 8; ++j) af[j] = *(const bf16x8*)(CS + (size_t)(32 * w + r32) * 512 + 16 * (s0 + j) + 8 * hi);
    __builtin_amdgcn_sched_barrier(0);
#pragma unroll
    for (int j = 0; j < 8; ++j) {
      const bf16x8 bf = *(LAS const bf16x8*)(Xc + r32 * XC_STRIDE + (16 * (s0 + j) + 8 * hi) * 2);
      acc = __builtin_amdgcn_mfma_f32_32x32x16_bf16(af[j], bf, acc, 0, 0, 0);
    }
  }
  const int o = 32 * cs + r32;
  bf16 gq[16];
#pragma unroll
  for (int r = 0; r < 16; ++r) { const size_t row = (size_t)MLAT + b * CTX + 32 * w + crow(r, hi); gq[r] = PLB[row * PLW + S_BG * 256 + o]; }
  __builtin_amdgcn_sched_barrier(0);
#pragma unroll
  for (int r = 0; r < 16; ++r) { const size_t row = (size_t)MLAT + b * CTX + 32 * w + crow(r, hi);
    Y[row * 1024 + 256 + o] = (bf16)f2bf(acc[r] * bf2f(gq[r])); }
}
}

namespace mk {
constexpr int GU_STRIDE = 2048 + 64;
constexpr size_t WS_GU = WS_SCR, WS_GS = WS_GU + (size_t)32 * 68 * GU_STRIDE * 4;
__device__ __forceinline__ size_t gla_row(int b, int c, int i) { return c < 64 ? (size_t)b * SEQ + 64 * c + i : (size_t)MLAT + b * CTX + 64 * (c - 64) + i; }
__device__ __forceinline__ int gla_pos(int c, int dir) { return c < 64 ? (dir ? 4 + 63 - c : 4 + c) : (dir ? 3 - (c - 64) : (c - 64)); }
__device__ __forceinline__ void gla_stage_v(const Frame& F, const bf16* PLB, int b, int c, LAS unsigned char* vbase) {
  const int key = F.tid >> 3, ch = F.tid & 7;
  const bf16* src = PLB + gla_row(b, c, key) * PLW + S_AV * 256 + ch * 8;
  const int vo = key * 128 + ((ch ^ (((key >> 1) & 1) << 2)) << 4);
  u32x4 t_[4];
#pragma unroll
  for (int h = 0; h < 4; ++h) t_[h] = *(const u32x4*)(src + h * 64);
#pragma unroll
  for (int h = 0; h < 4; ++h) *(LAS u32x4*)(vbase + h * 8192 + vo) = t_[h];
}
__device__ __forceinline__ void gla_cum(const float* LA, int b, int c, int h, int dir, int lane, float (&cw)[32], float& T) {
  const int d = lane & 31, half = lane >> 5;
  float a[32];
#pragma unroll
  for (int ii = 0; ii < 32; ++ii) a[ii] = LA[gla_row(b, c, 32 * half + ii) * 256 + dir * 128 + h * 32 + d];
  float run = 0.f;
#pragma unroll
  for (int ii = 0; ii < 32; ++ii) { run += a[ii]; cw[ii] = run; }
  const float other = __shfl_xor(run, 32);
  const float tot0 = half ? other : run;
  T = run + other;
#pragma unroll
  for (int ii = 0; ii < 32; ++ii) { const float cf = cw[ii] + (half ? tot0 : 0.f); cw[ii] = dir ? (T - cf + a[ii]) : cf; }
}
constexpr int KT_STRIDE = 144;
__device__ __forceinline__ void gla_local_item(const Frame& F0, const Args& a, int item) {
  const Frame F = relaunder(F0);
  unsigned char* ws = opq(a.ws);
  const bf16* PLB = (const bf16*)(ws + WS_PLB); const float* LA = (const float*)(ws + WS_LA);
  const int b = item / 68, c = item % 68, h = F.wave >> 1, dir = F.wave & 1, d = F.lane & 31, half = F.lane >> 5, r32 = d, hi = half;
  LAS unsigned char* Vt = F.lds + h * 8192; LAS unsigned char* KT = F.lds + 32768 + F.wave * (32 * KT_STRIDE);
  __syncthreads();
  gla_stage_v(F, PLB, b, c, F.lds);
  float cw[32], T;
  gla_cum(LA, b, c, h, dir, F.lane, cw, T);
  {
    unsigned pkd[16]; bf16 kr[32];
    const bf16* kp = PLB + gla_row(b, c, 32 * half) * PLW + S_AQK * 256 + 128 + h * 32 + d;
#pragma unroll
    for (int ii = 0; ii < 32; ++ii) kr[ii] = kp[(size_t)ii * PLW];
#pragma unroll
    for (int ii = 0; ii < 32; ii += 2) pkd[ii >> 1] = pk2(bf2f(kr[ii]) * __expf(T - cw[ii]), bf2f(kr[ii + 1]) * __expf(T - cw[ii + 1]));
#pragma unroll
    for (int q4 = 0; q4 < 4; ++q4) *(LAS u32x4*)(KT + d * KT_STRIDE + half * 64 + q4 * 16) = (u32x4){pkd[4 * q4], pkd[4 * q4 + 1], pkd[4 * q4 + 2], pkd[4 * q4 + 3]};
  }
  __syncthreads();
  f32x16 acc[2];
#pragma unroll
  for (int eb = 0; eb < 2; ++eb)
#pragma unroll
    for (int i = 0; i < 16; ++i) acc[eb][i] = 0.f;
  const int q = (F.lane & 15) >> 2, p = F.lane & 3, gsel = (F.lane >> 4) & 1;
  const int chb = 2 * gsel + (p >> 1);
#pragma unroll
  for (int st = 0; st < 4; ++st) {
    const bf16x8 kb = *(LAS const bf16x8*)(KT + r32 * KT_STRIDE + (16 * st + 8 * hi) * 2);
#pragma unroll
    for (int eb = 0; eb < 2; ++eb) {
      const int ch = ((chb | ((eb ^ (q >> 1)) << 2)) << 4);
      LAS const unsigned char* vp = Vt + (16 * st + 8 * hi + q) * 128 + 8 * (p & 1) + ch;
      const s16x4 lo = vtr(vp), hh = vtr(vp + 512);
      const bf16x8 va = (bf16x8){lo[0], lo[1], lo[2], lo[3], hh[0], hh[1], hh[2], hh[3]};
      acc[eb] = __builtin_amdgcn_mfma_f32_32x32x16_bf16(va, kb, acc[eb], 0, 0, 0);
    }
  }
  const int chain = (b * 4 + h) * 2 + dir, pos = gla_pos(c, dir);
  float* gu = (float*)(ws + WS_GU) + ((size_t)chain * 68 + pos) * GU_STRIDE;
#pragma unroll
  for (int eb = 0; eb < 2; ++eb)
#pragma unroll
    for (int r = 0; r < 16; ++r) gu[(32 * eb + crow(r, hi)) * 32 + r32] = acc[eb][r];
  if (half == 0) gu[2048 + d] = __expf(T);
}
__device__ __forceinline__ void gla_scan(const Frame& F0, const Args& a) {
  const Frame F = relaunder(F0);
  unsigned char* ws = opq(a.ws);
  if (F.tid >= 256) return;
  for (int gt = F.vcu * 256 + F.tid; gt < 32 * 2048; gt += F.G * 256) {
    const int chain = gt >> 11, el = gt & 2047, d = el & 31;
    const float* gu = (const float*)(ws + WS_GU) + (size_t)chain * 68 * GU_STRIDE;
    bf16* gs = (bf16*)(ws + WS_GS) + (size_t)chain * 68 * 2048 + el;
    float S = 0.f;
#pragma unroll 1
    for (int p0 = 0; p0 < 68; p0 += 34) {
      float dc[34], uu[34];
#pragma unroll
      for (int i = 0; i < 34; ++i) { dc[i] = gu[(size_t)(p0 + i) * GU_STRIDE + 2048 + d]; uu[i] = gu[(size_t)(p0 + i) * GU_STRIDE + el]; }
      __builtin_amdgcn_sched_barrier(0);
#pragma unroll
      for (int i = 0; i < 34; ++i) { gs[(size_t)(p0 + i) * 2048] = (bf16)f2bf(S); S = dc[i] * S + uu[i]; }
    }
  }
}
constexpr int QK_STRIDE = 80;
__device__ __forceinline__ void gla_out_item(const Frame& F0, const Args& a, int layer, int item) {
  const Frame F = relaunder(F0);
  unsigned char* ws = opq(a.ws);
  const bf16* PLB = (const bf16*)(ws + WS_PLB); const float* LA = (const float*)(ws + WS_LA); bf16* Y = (bf16*)(ws + WS_H);
  const int b = item / 68, c = item % 68, h = F.wave >> 1, dir = F.wave & 1, d = F.lane & 31, half = F.lane >> 5, r32 = d, hi = half;
  LAS unsigned char* Vt = F.lds + h * 8192;
  LAS unsigned char* QT = F.lds + 32768 + F.wave * (2 * 64 * QK_STRIDE); LAS unsigned char* KT = QT + 64 * QK_STRIDE;
  LAS float* X = (LAS float*)(F.lds + 32768) + h * 4096;
  __syncthreads();
  gla_stage_v(F, PLB, b, c, F.lds);
  {
    float cw[32], T;
    gla_cum(LA, b, c, h, dir, F.lane, cw, T);
    bf16 qr[32], kr[32];
    const bf16* pr = PLB + gla_row(b, c, 32 * half) * PLW + S_AQK * 256 + h * 32 + d;
#pragma unroll
    for (int ii = 0; ii < 32; ++ii) { qr[ii] = pr[(size_t)ii * PLW]; kr[ii] = pr[(size_t)ii * PLW + 128]; }
#pragma unroll
    for (int ii = 0; ii < 32; ++ii) { const int i = 32 * half + ii;
      const float ec = __expf(cw[ii]);
      *(LAS unsigned short*)(QT + i * QK_STRIDE + d * 2) = (unsigned short)f2bf(bf2f(qr[ii]) * ec);
      *(LAS unsigned short*)(KT + i * QK_STRIDE + d * 2) = (unsigned short)f2bf(bf2f(kr[ii]) * __builtin_amdgcn_rcpf(ec)); }
  }
  __syncthreads();
  f32x16 oacc[2][2];
#pragma unroll
  for (int eb = 0; eb < 2; ++eb)
#pragma unroll
    for (int ib = 0; ib < 2; ++ib)
#pragma unroll
      for (int i = 0; i < 16; ++i) oacc[eb][ib][i] = 0.f;
  bf16x8 qb[2][2];
#pragma unroll
  for (int ib = 0; ib < 2; ++ib)
#pragma unroll
    for (int st = 0; st < 2; ++st) qb[ib][st] = *(LAS const bf16x8*)(QT + (32 * ib + r32) * QK_STRIDE + (16 * st + 8 * hi) * 2);
  const int chain = (b * 4 + h) * 2 + dir, pos = gla_pos(c, dir);
  {
    const bf16* gs = (const bf16*)(ws + WS_GS) + ((size_t)chain * 68 + pos) * 2048;
#pragma unroll
    for (int eb = 0; eb < 2; ++eb)
#pragma unroll
      for (int st = 0; st < 2; ++st) { const bf16x8 sf = *(const bf16x8*)(gs + (32 * eb + r32) * 32 + 16 * st + 8 * hi);
#pragma unroll
        for (int ib = 0; ib < 2; ++ib) oacc[eb][ib] = __builtin_amdgcn_mfma_f32_32x32x16_bf16(sf, qb[ib][st], oacc[eb][ib], 0, 0, 0); }
  }
  const int q = (F.lane & 15) >> 2, p = F.lane & 3, gsel = (F.lane >> 4) & 1;
  const int vrow = (4 * hi + q) * 128 + 8 * (p & 1), chb = 2 * gsel + (p >> 1);
#pragma unroll
  for (int sb = 0; sb < 2; ++sb) {
    bf16x8 kf[2];
#pragma unroll
    for (int st = 0; st < 2; ++st) kf[st] = *(LAS const bf16x8*)(KT + (32 * sb + r32) * QK_STRIDE + (16 * st + 8 * hi) * 2);
#pragma unroll
    for (int ib = 0; ib < 2; ++ib) {
      const bool need = dir == 0 ? (sb <= ib) : (sb >= ib);
      if (!need) continue;
      f32x16 sc;
#pragma unroll
      for (int i = 0; i < 16; ++i) sc[i] = 0.f;
#pragma unroll
      for (int st = 0; st < 2; ++st) sc = __builtin_amdgcn_mfma_f32_32x32x16_bf16(kf[st], qb[ib][st], sc, 0, 0, 0);
      if (sb == ib) {
#pragma unroll
        for (int r = 0; r < 16; ++r) { const int s = crow(r, hi); const bool keep = dir == 0 ? (s <= r32) : (s >= r32); sc[r] = keep ? sc[r] : 0.f; }
      }
      u32x4 pw[2];
#pragma unroll
      for (int k = 0; k < 2; ++k) pw[k] = (u32x4){pk2(sc[8 * k + 0], sc[8 * k + 1]), pk2(sc[8 * k + 2], sc[8 * k + 3]), pk2(sc[8 * k + 4], sc[8 * k + 5]), pk2(sc[8 * k + 6], sc[8 * k + 7])};
#pragma unroll
      for (int ks = 0; ks < 2; ++ks)
#pragma unroll
        for (int eb = 0; eb < 2; ++eb) {
          const int ch = ((chb | ((eb ^ (q >> 1)) << 2)) << 4);
          const s16x4 lo = vtr(Vt + (2 * sb + ks) * 2048 + vrow + ch), hh = vtr(Vt + (2 * sb + ks) * 2048 + 1024 + vrow + ch);
          const bf16x8 va = (bf16x8){lo[0], lo[1], lo[2], lo[3], hh[0], hh[1], hh[2], hh[3]};
          oacc[eb][ib] = __builtin_amdgcn_mfma_f32_32x32x16_bf16(va, __builtin_bit_cast(bf16x8, pw[ks]), oacc[eb][ib], 0, 0, 0);
        }
    }
  }
  __syncthreads();
  if (dir == 1) {
#pragma unroll
    for (int eb = 0; eb < 2; ++eb)
#pragma unroll
      for (int ib = 0; ib < 2; ++ib)
#pragma unroll
        for (int r = 0; r < 16; ++r) X[((eb * 2 + ib) * 16 + r) * 64 + F.lane] = oacc[eb][ib][r];
  }
  __syncthreads();
  if (dir == 0) {
    const float* on = opq(a.in[11]) + layer * 64;
    f32x4 w4s[8];
#pragma unroll
    for (int i = 0; i < 8; ++i) w4s[i] = *(const f32x4*)(on + 32 * (i >> 2) + 8 * (i & 3) + 4 * hi);
#pragma unroll
    for (int ib = 0; ib < 2; ++ib) {
      float ss = 0.f;
#pragma unroll
      for (int eb = 0; eb < 2; ++eb)
#pragma unroll
        for (int r = 0; r < 16; ++r) { oacc[eb][ib][r] += X[((eb * 2 + ib) * 16 + r) * 64 + F.lane]; ss += oacc[eb][ib][r] * oacc[eb][ib][r]; }
      ss += __shfl_xor(ss, 32);
      const float rs = 1.0f / sqrtf(ss * (1.f / 64.f) + 1e-6f);
      const size_t row = gla_row(b, c, 32 * ib + r32);
      u32x2 gv8[8];
#pragma unroll
      for (int i = 0; i < 8; ++i) gv8[i] = *(const u32x2*)(PLB + row * PLW + S_AG * 256 + h * 64 + 32 * (i >> 2) + 8 * (i & 3) + 4 * hi);
      __builtin_amdgcn_sched_barrier(0);
#pragma unroll
      for (int eb = 0; eb < 2; ++eb)
#pragma unroll
        for (int gi = 0; gi < 4; ++gi) {
          const int e0 = 32 * eb + 8 * gi + 4 * hi;
          const f32x4 w4 = w4s[4 * eb + gi];
          const u32x2 gv = gv8[4 * eb + gi];
          const float g0 = __uint_as_float(gv.x << 16), g1 = __uint_as_float(gv.x & 0xffff0000u), g2 = __uint_as_float(gv.y << 16), g3 = __uint_as_float(gv.y & 0xffff0000u);
          u32x2 ov; ov.x = pk2(oacc[eb][ib][4 * gi + 0] * rs * w4[0] * g0, oacc[eb][ib][4 * gi + 1] * rs * w4[1] * g1);
          ov.y = pk2(oacc[eb][ib][4 * gi + 2] * rs * w4[2] * g2, oacc[eb][ib][4 * gi + 3] * rs * w4[3] * g3);
          *(u32x2*)(Y + row * 1024 + h * 64 + e0) = ov;
        }
    }
  }
}
}

namespace mk {
__device__ __forceinline__ void p3_mixers(const Frame& F0, const Args& a, int layer) {
  const Frame F = relaunder(F0);
  const int nx = 0, nswa = 256 + nx, nna = 256 + nx, nfc = 0;
  const int total = 272 + 256 + nfc + nswa + nna, K = F.vcu < total ? (total - F.vcu + F.G - 1) / F.G : 0;
  const int k0 = K > 0 ? (F.vcu * 8 / F.G) % K : 0;
  for (int j = 0; j < K; ++j) {
    int k = j + k0; if (k >= K) k -= K;
    const int it = F.vcu + F.G * k;
    int r = it;
    if (r < 272) { gla_local_item(F, a, r); continue; } r -= 272;
    if (r < 256) { fft_item(F, a, r); continue; } r -= 256;
    if (r < nfc) { fftc_item(F, a, r); continue; } r -= nfc;
    if (r < nswa) swa_item(F, a, layer, r); else na_item(F, a, layer, r - nswa);
  }
}
__device__ __forceinline__ void p4b_glaout(const Frame& F0, const Args& a, int layer) {
  const Frame F = relaunder(F0);
  if (layer == 1) { for (int it = F.vcu; it < 256; it += F.G) gla_out_item(F, a, layer, (it >> 6) * 68 + (it & 63)); }
  else {
    for (int it = F.vcu; it < 272; it += F.G) gla_out_item(F, a, layer, it);
    for (int e = (F.vcu + F.G - 16 % F.G) % F.G; e < 64; e += F.G) {
      if (e < 32) fftc_item(F, a, e); else if (e < 48) swa_item(F, a, 0, 256 + (e - 32)); else na_item(F, a, 0, 256 + (e - 48)); }
  }
}
}
#define XB_TMO      128
#define XB_XCNT(j)  (256  + 64 * (j))
#define XB_XSUB(j)  (1280 + 64 * (j))
#define XB_XGEN(j)  (2304 + 64 * (j))
#define XB_TOP      3328
#define XB_TOPGEN   3392
#define XCD_BAR_WORDS 3456
#define XB_SPIN_CAP (1u << 18)

__device__ __forceinline__ unsigned xb_ld(unsigned* p)              { return __hip_atomic_load(p, __ATOMIC_RELAXED, __HIP_MEMORY_SCOPE_AGENT); }
__device__ __forceinline__ unsigned xb_add(unsigned* p, unsigned v) { return __hip_atomic_fetch_add(p, v, __ATOMIC_RELAXED, __HIP_MEMORY_SCOPE_AGENT); }
__device__ __forceinline__ unsigned xb_xcc_id() { return (unsigned)__builtin_amdgcn_s_getreg((3 << 11) | 20) & 0xFu; }
#define XB_SPIN(cond, bar) do { unsigned _sp = 0; while (cond) { __builtin_amdgcn_s_sleep(1); \
    if ((++_sp & 255u) == 0u) { if (xb_ld(&(bar)[XB_TMO])) break; if (_sp > XB_SPIN_CAP) { atomicAdd(&(bar)[XB_TMO], 1u); break; } } } } while (0)

struct XcdBarrier {
    unsigned* bar; unsigned x;
    volatile LAS unsigned* st;
};

__device__ __forceinline__ XcdBarrier xcd_barrier_post(unsigned* bar, volatile LAS unsigned* st) {
    XcdBarrier b; b.bar = bar; b.x = xb_xcc_id(); b.st = st;
    if (threadIdx.x == 0) (void)xb_add(&bar[XB_XCNT(b.x)], 1u);
    return b;
}
__device__ __forceinline__ void xcd_barrier_complete(unsigned* bar, unsigned x, unsigned& nloc, unsigned& nx) {
    const unsigned G = gridDim.x * gridDim.y * gridDim.z;
    unsigned sum, cnt, mine, sp = 0u;
    for (;;) {
        sum = 0u; cnt = 0u; mine = 0u;
#pragma unroll
        for (unsigned j = 0; j < 16; ++j) { const unsigned c = xb_ld(&bar[XB_XCNT(j)]); sum += c; cnt += (c > 0u) ? 1u : 0u; }
        mine = xb_ld(&bar[XB_XCNT(x)]);
        if (sum == G) break;
        __builtin_amdgcn_s_sleep(1);
        if ((++sp & 255u) == 0u) { if (xb_ld(&bar[XB_TMO])) break; if (sp > XB_SPIN_CAP) { atomicAdd(&bar[XB_TMO], 1u); break; } }
    }
    nloc = mine > 0u ? mine : 1u; nx = cnt > 0u ? cnt : 1u;
}

__device__ __forceinline__ void xcd_barrier(const XcdBarrier& b) {
    asm volatile("s_waitcnt vmcnt(0)" ::: "memory");
    __syncthreads();
    if (threadIdx.x == 0) {
        unsigned* bar = b.bar;
        __builtin_amdgcn_s_waitcnt(0);
        unsigned nloc = b.st[0], nx = b.st[1];
        if (nloc == 0u) { xcd_barrier_complete(bar, b.x, nloc, nx); b.st[0] = nloc; b.st[1] = nx; }
        const unsigned old = xb_add(&bar[XB_XSUB(b.x)], 1u);
        const unsigned gen = old / nloc;
        if (old + 1u == (gen + 1u) * nloc) {
            __builtin_amdgcn_fence(__ATOMIC_RELEASE, "agent");
            asm volatile("s_waitcnt vmcnt(0)" ::: "memory");
            const unsigned og = xb_add(&bar[XB_TOP], 1u);
            const unsigned tg = og / nx;
            if (og + 1u == (tg + 1u) * nx) xb_add(&bar[XB_TOPGEN], 1u);
            else XB_SPIN(xb_ld(&bar[XB_TOPGEN]) == tg, bar);
            __builtin_amdgcn_fence(__ATOMIC_ACQUIRE, "agent");
            xb_add(&bar[XB_XGEN(b.x)], 1u);
            asm volatile("s_waitcnt vmcnt(0)" ::: "memory");
        } else {
            XB_SPIN(xb_ld(&bar[XB_XGEN(b.x)]) == gen, bar);
            __builtin_amdgcn_fence(__ATOMIC_ACQUIRE, "agent");
            asm volatile("s_waitcnt vmcnt(0)" ::: "memory");
        }
    }
    __syncthreads();
}

constexpr int LDS_BYTES = 163840, MISC_OFF = LDS_BYTES - 256;
constexpr int CW_BAR = 4096;
__global__ void __launch_bounds__(512, 2) mega(mk::Args a) {
  extern __shared__ __attribute__((aligned(16))) unsigned char lds[];
  mk::Frame F;
  F.lds = (LAS unsigned char*)lds;
  F.tid = threadIdx.x; F.lane = F.tid & 63; F.wave = __builtin_amdgcn_readfirstlane(F.tid >> 6);
  F.G = gridDim.x; { const int bx = blockIdx.x; F.vcu = (F.G % 8 == 0) ? (bx % 8) * (F.G / 8) + bx / 8 : bx; }
  volatile LAS unsigned* MISC = (volatile LAS unsigned*)(F.lds + MISC_OFF);
  if (F.tid < 64) MISC[F.tid] = 0u;
  __syncthreads();
  XcdBarrier bar; bar.bar = nullptr; bar.x = 0; bar.st = nullptr;
  const bool multi = (a.ph_hi - a.ph_lo) > 1;
  if (multi) bar = xcd_barrier_post((unsigned*)(a.ws + mk::WS_CTL) + CW_BAR, MISC + 8);
#pragma clang loop unroll(disable)
  for (int ph = a.ph_lo; ph < a.ph_hi; ++ph) {
    if (ph == 0) mk::p0_prologue(F, a);
    else {
      const int layer = (ph - 1) / 6, sub = (ph - 1) % 6;
      if (sub == 0) mk::p1_prenorm(F, a, layer);
      else if (sub == 1) mk::p2_inproj(F, a, layer);
      else if (sub == 2) mk::p3_mixers(F, a, layer);
      else if (sub == 3) mk::gla_scan(F, a);
      else if (sub == 4) mk::p4b_glaout(F, a, layer);
      else mk::p5_outproj(F, a, layer);
    }
    if (ph + 1 < a.ph_hi) xcd_barrier(bar);
  }
}

extern "C" void kernel_launch(void* const* d_in, const int* in_sizes, int n_in, void* d_out, int out_size, void* d_ws, size_t ws_size, hipStream_t stream) {
  using namespace mk;
  static int grid = 0;
  if (grid == 0) {
    int dev = 0, cus = 0, per_cu = 0; (void)hipGetDevice(&dev); (void)hipDeviceGetAttribute(&cus, hipDeviceAttributeMultiprocessorCount, dev);
    (void)hipFuncSetAttribute((const void*)mega, hipFuncAttributeMaxDynamicSharedMemorySize, LDS_BYTES);
    if (hipOccupancyMaxActiveBlocksPerMultiprocessor(&per_cu, (const void*)mega, 512, LDS_BYTES) != hipSuccess || per_cu < 1) per_cu = 1;
    (void)hipGetLastError();
    grid = (cus > 0 ? cus : 256) * (per_cu < 1 ? 1 : 1);
  }
  (void)hipMemsetAsync((char*)d_ws + WS_CTL, 0, CTL_BYTES, stream);
  Args a{};
  for (int i = 0; i < 19; ++i) a.in[i] = (const float*)d_in[i];
  a.out = (float*)d_out; a.ws = (unsigned char*)d_ws;
  a.ph_lo = 0; a.ph_hi = 13;
  void* args[] = {&a};
  if (hipLaunchCooperativeKernel((const void*)mega, dim3(grid), dim3(512), args, LDS_BYTES, stream) != hipSuccess) {
    (void)hipGetLastError();
    hipLaunchKernelGGL(mega, dim3(grid), dim3(512), LDS_BYTES, stream, a);
  }
}
```
